# Optimizing an MI355X kernel written in HIP

```python
import math
import jax, jax.numpy as jnp
from jax import lax
import numpy as np

D_MODEL = 1024
BATCH = 2
SEQ = 8192
DEPTH = 2

CHUNK = 64
N_MEM = 256
N_GROUPS = 4
GROUP = D_MODEL // N_GROUPS
D_MIX = N_GROUPS * GROUP
N_HEADS = 4
HEAD_DIM = GROUP // N_HEADS
RWKV_LORA = 32
CONV_WIDTH = 31
SB_BLOCK = 128
XATTN_HEADS = 4
XATTN_HEAD_DIM = D_MODEL // XATTN_HEADS
RMS_EPS = 1e-6
LN_EPS = 1e-5
RWKV_LN_EPS = 64e-5

N_RWKV_SHIFT = 3 * GROUP + 2 * RWKV_LORA
N_RWKV = N_RWKV_SHIFT + GROUP
N_CONV = 3 * GROUP
N_HGRN = 4 * GROUP
N_SB = 4 * GROUP
N_IN = N_RWKV + N_CONV + N_HGRN + N_SB

kernel_name = 'hybrid_parallel_heads_rwkv7_conformer_hgrn2_stickbreak'


def rms_norm(x, g):
    x32 = x.astype(jnp.float32)
    y = x32 * lax.rsqrt(jnp.mean(x32 * x32, axis=-1, keepdims=True) + RMS_EPS)
    return (y * g.astype(jnp.float32)).astype(x.dtype)


def layer_norm_f32(x, g, b, eps):
    x32 = x.astype(jnp.float32)
    mu = jnp.mean(x32, axis=-1, keepdims=True)
    xc = x32 - mu
    var = jnp.mean(xc * xc, axis=-1, keepdims=True)
    return xc * lax.rsqrt(var + eps) * g + b


def split_heads(t):
    return t.reshape(*t.shape[:-1], N_HEADS, HEAD_DIM)


def rwkv7_mixer(p_shift, gate, mu, w0, w_up, a0, a_up, k_k, k_a, r_k, ln_g, ln_b):
    B, T, _ = p_shift.shape
    p = p_shift.astype(jnp.float32)
    p_prev = jnp.pad(p, ((0, 0), (1, 0), (0, 0)))[:, :-1]
    m = p + (p_prev - p) * mu
    r, k, v, xw, xa = jnp.split(m, [GROUP, 2 * GROUP, 3 * GROUP, 3 * GROUP + RWKV_LORA], axis=-1)
    w_log = -jax.nn.softplus(-(w0 + jnp.tanh(xw) @ w_up)) - 0.5
    decay = jnp.exp(-jnp.exp(w_log))
    a = jax.nn.sigmoid(a0 + xa @ a_up)
    kk = split_heads(k * k_k)
    kk = kk / jnp.maximum(jnp.sqrt(jnp.sum(kk * kk, axis=-1, keepdims=True)), 1e-12)
    k = k * (1.0 + (a - 1.0) * k_a)
    r, k, v, decay, a = (split_heads(t) for t in (r, k, v, decay, a))
    xs = tuple(jnp.moveaxis(t, 1, 0) for t in (r, decay, k, v, -kk, kk * a))

    def step(S, inp):
        r_t, w_t, k_t, v_t, a_t, b_t = inp
        sa = jnp.einsum('bhij,bhj->bhi', S, a_t)
        S = S * w_t[:, :, None, :] + sa[..., None] * b_t[:, :, None, :] + v_t[..., None] * k_t[:, :, None, :]
        y = jnp.einsum('bhij,bhj->bhi', S, r_t)
        return S, y

    S0 = jnp.zeros((B, N_HEADS, HEAD_DIM, HEAD_DIM), jnp.float32)
    _, y = lax.scan(step, S0, xs)
    y = jnp.moveaxis(y, 0, 1)
    y = layer_norm_f32(y, ln_g.reshape(N_HEADS, HEAD_DIM), ln_b.reshape(N_HEADS, HEAD_DIM), RWKV_LN_EPS)
    bonus = jnp.sum(r * k * r_k, axis=-1, keepdims=True) * v
    out = (y + bonus).reshape(B, T, GROUP)
    return out * jax.nn.silu(gate.astype(jnp.float32))


def conformer_conv_mixer(val, glu_gate, gate, conv_w, conv_b, ln_g, ln_b):
    u = val * jax.nn.sigmoid(glu_gate)
    u = jnp.pad(u, ((0, 0), (CONV_WIDTH - 1, 0), (0, 0)))
    y = lax.conv_general_dilated(u, conv_w[:, None, :].astype(u.dtype), window_strides=(1,), padding='VALID',
                                 dimension_numbers=('NWC', 'WIO', 'NWC'), feature_group_count=GROUP)
    y = layer_norm_f32(y + conv_b, ln_g, ln_b, LN_EPS)
    y = jax.nn.silu(y)
    return y * jax.nn.silu(gate.astype(jnp.float32))


def hgrn2_mixer(q, f_pre, i, gate, lb, norm_g):
    B, T, _ = q.shape
    n_chunks = T // CHUNK
    q = jax.nn.silu(q.astype(jnp.float32))
    f = lb + (1.0 - lb) * jax.nn.sigmoid(f_pre.astype(jnp.float32))
    log_f = jnp.log(f)
    k = 1.0 - f
    v = i.astype(jnp.float32)

    def to_chunks(t):
        return t.reshape(B, n_chunks, CHUNK, N_HEADS, HEAD_DIM).transpose(1, 0, 3, 2, 4)

    qc, kc, vc = to_chunks(q), to_chunks(k), to_chunks(v)
    bc = jnp.cumsum(to_chunks(log_f), axis=3)
    causal = (jnp.arange(CHUNK)[:, None] >= jnp.arange(CHUNK)[None, :])[:, :, None]

    def chunk_step(S, inp):
        q_c, k_c, v_c, b_c = inp
        o_inter = jnp.einsum('bhtk,bhkv->bhtv', q_c * jnp.exp(b_c), S)
        rel = jnp.where(causal, b_c[:, :, :, None, :] - b_c[:, :, None, :, :], -jnp.inf)
        att = jnp.einsum('bhtk,bhsk,bhtsk->bhts', q_c, k_c, jnp.exp(rel))
        o_intra = jnp.einsum('bhts,bhsv->bhtv', att, v_c)
        b_last = b_c[:, :, -1:, :]
        S = jnp.exp(b_last[:, :, 0, :])[..., None] * S + jnp.einsum('bhsk,bhsv->bhkv', k_c * jnp.exp(b_last - b_c), v_c)
        return S, o_inter + o_intra

    S0 = jnp.zeros((B, N_HEADS, HEAD_DIM, HEAD_DIM), jnp.float32)
    _, o = lax.scan(chunk_step, S0, (qc, kc, vc, bc))
    o = o.transpose(1, 0, 3, 2, 4).reshape(B, T, N_HEADS, HEAD_DIM)
    o = o * lax.rsqrt(jnp.mean(o * o, axis=-1, keepdims=True) + RMS_EPS) * norm_g.reshape(N_HEADS, HEAD_DIM)
    return o.reshape(B, T, GROUP) * jax.nn.silu(gate.astype(jnp.float32))


def stick_breaking_mixer(q, k, v, gate):
    B, T, _ = q.shape

    def heads(t):
        return t.astype(jnp.float32).reshape(B, T, N_HEADS, HEAD_DIM).transpose(0, 2, 1, 3)

    qh, kh, vh = heads(q), heads(k), heads(v)
    scale = HEAD_DIM ** -0.5
    outs = []
    for blk in range(T // SB_BLOCK):
        lo, hi = blk * SB_BLOCK, (blk + 1) * SB_BLOCK
        z = jnp.einsum('bhtd,bhsd->bhts', qh[:, :, lo:hi], kh[:, :, :hi]) * scale
        t_idx = lo + jnp.arange(SB_BLOCK)
        mask = jnp.arange(hi)[None, :] < t_idx[:, None]
        log_keep = jnp.where(mask, jax.nn.log_sigmoid(-z), 0.0)
        tail = lax.cumsum(log_keep, axis=3, reverse=True) - log_keep
        A = jnp.where(mask, jnp.exp(jax.nn.log_sigmoid(z) + tail), 0.0)
        outs.append(jnp.einsum('bhts,bhsd->bhtd', A, vh[:, :, :hi]))
    o = jnp.concatenate(outs, axis=2).transpose(0, 2, 1, 3).reshape(B, T, GROUP)
    return o * jax.nn.silu(gate.astype(jnp.float32))


def memory_cross_attention(h, mem_n, wq, wk, wv, wo):
    B, T, _ = h.shape
    M = mem_n.shape[1]
    q = (h @ wq).reshape(B, T, XATTN_HEADS, XATTN_HEAD_DIM)
    k = (mem_n @ wk).reshape(B, M, XATTN_HEADS, XATTN_HEAD_DIM)
    v = (mem_n @ wv).reshape(B, M, XATTN_HEADS, XATTN_HEAD_DIM)
    s = jnp.einsum('bthd,bmhd->bhtm', q, k).astype(jnp.float32) * (XATTN_HEAD_DIM ** -0.5)
    p = jax.nn.softmax(s, axis=-1).astype(h.dtype)
    o = jnp.einsum('bhtm,bmhd->bthd', p, v).reshape(B, T, D_MODEL)
    return o @ wo


def setup_inputs(seed: int = 0) -> dict:
    key = jax.random.key(seed)
    ks = jax.random.split(key, 32)
    f32 = jnp.float32
    nrm = lambda k, shape, s: jax.random.normal(k, shape, f32) * s
    gain = lambda k, shape: 1.0 + 0.02 * jax.random.normal(k, shape, f32)
    L = DEPTH
    return {
        'x': jax.random.normal(ks[0], (BATCH, SEQ, D_MODEL), f32),
        'mem': jax.random.normal(ks[1], (BATCH, N_MEM, D_MODEL), f32),
        'norm_mix': gain(ks[2], (L, D_MODEL)),
        'w_in': nrm(ks[3], (L, D_MODEL, N_IN), D_MODEL ** -0.5),
        'rwkv_mu': jax.random.uniform(ks[4], (L, N_RWKV_SHIFT), f32),
        'rwkv_w0': jax.random.uniform(ks[5], (L, GROUP), f32, minval=-6.0, maxval=1.0),
        'rwkv_w_up': nrm(ks[6], (L, RWKV_LORA, GROUP), 0.1),
        'rwkv_a0': nrm(ks[7], (L, GROUP), 0.1),
        'rwkv_a_up': nrm(ks[8], (L, RWKV_LORA, GROUP), 0.1),
        'rwkv_k_k': 0.85 + 0.05 * jax.random.normal(ks[9], (L, GROUP), f32),
        'rwkv_k_a': gain(ks[10], (L, GROUP)),
        'rwkv_r_k': nrm(ks[11], (L, N_HEADS, HEAD_DIM), 0.1),
        'rwkv_ln_g': gain(ks[12], (L, GROUP)),
        'rwkv_ln_b': nrm(ks[13], (L, GROUP), 0.02),
        'conv_w': nrm(ks[14], (L, CONV_WIDTH, GROUP), CONV_WIDTH ** -0.5),
        'conv_b': nrm(ks[15], (L, GROUP), 0.02),
        'conv_ln_g': gain(ks[16], (L, GROUP)),
        'conv_ln_b': nrm(ks[17], (L, GROUP), 0.02),
        'hgrn_lb_logits': nrm(ks[18], (L, GROUP), 0.5),
        'hgrn_norm_g': gain(ks[19], (L, GROUP)),
        'w_out': nrm(ks[20], (L, D_MIX, D_MODEL), D_MIX ** -0.5),
        'norm_xattn': gain(ks[21], (L, D_MODEL)),
        'norm_mem': gain(ks[22], (L, D_MODEL)),
        'xattn_wq': nrm(ks[23], (L, D_MODEL, D_MODEL), D_MODEL ** -0.5),
        'xattn_wk': nrm(ks[24], (L, D_MODEL, D_MODEL), D_MODEL ** -0.5),
        'xattn_wv': nrm(ks[25], (L, D_MODEL, D_MODEL), D_MODEL ** -0.5),
        'xattn_wo': nrm(ks[26], (L, D_MODEL, D_MODEL), D_MODEL ** -0.5),
        'norm_final': gain(ks[27], (D_MODEL,)),
    }


def reference(x, mem, norm_mix, w_in, rwkv_mu, rwkv_w0, rwkv_w_up, rwkv_a0, rwkv_a_up, rwkv_k_k, rwkv_k_a,
              rwkv_r_k, rwkv_ln_g, rwkv_ln_b, conv_w, conv_b, conv_ln_g, conv_ln_b, hgrn_lb_logits, hgrn_norm_g,
              w_out, norm_xattn, norm_mem, xattn_wq, xattn_wk, xattn_wv, xattn_wo, norm_final):
    lb_soft = jax.nn.softmax(hgrn_lb_logits.astype(jnp.float32), axis=0)
    lower_bounds = jnp.cumsum(lb_soft, axis=0) - lb_soft[0]
    splits = [N_RWKV, N_RWKV + N_CONV, N_RWKV + N_CONV + N_HGRN]
    for l in range(DEPTH):
        h = rms_norm(x, norm_mix[l])
        p = h @ w_in[l]
        p_a, p_b, p_c, p_d = jnp.split(p, splits, axis=-1)
        y_a = rwkv7_mixer(p_a[..., :N_RWKV_SHIFT], p_a[..., N_RWKV_SHIFT:], rwkv_mu[l], rwkv_w0[l], rwkv_w_up[l],
                          rwkv_a0[l], rwkv_a_up[l], rwkv_k_k[l], rwkv_k_a[l], rwkv_r_k[l], rwkv_ln_g[l], rwkv_ln_b[l])
        c_val, c_glu, c_gate = jnp.split(p_b, 3, axis=-1)
        y_b = conformer_conv_mixer(c_val, c_glu, c_gate, conv_w[l], conv_b[l], conv_ln_g[l], conv_ln_b[l])
        g_q, g_f, g_i, g_gate = jnp.split(p_c, 4, axis=-1)
        y_c = hgrn2_mixer(g_q, g_f, g_i, g_gate, lower_bounds[l], hgrn_norm_g[l])
        s_q, s_k, s_v, s_gate = jnp.split(p_d, 4, axis=-1)
        y_d = stick_breaking_mixer(s_q, s_k, s_v, s_gate)
        y = jnp.concatenate([y_a, y_b, y_c, y_d], axis=-1).astype(x.dtype)
        x = x + y @ w_out[l]
        hx = rms_norm(x, norm_xattn[l])
        mn = rms_norm(mem, norm_mem[l])
        x = x + memory_cross_attention(hx, mn, xattn_wq[l], xattn_wk[l], xattn_wv[l], xattn_wo[l])
    return rms_norm(x, norm_final)
```

```cpp
#include <hip/hip_runtime.h>
#include <hip/hip_cooperative_groups.h>
#include <stdint.h>
#include <cstdio>
#include <cstring>
namespace cg = cooperative_groups;

typedef unsigned short bf16_t;
typedef short bf16x8 __attribute__((ext_vector_type(8)));
typedef float f32x4 __attribute__((ext_vector_type(4)));
typedef float f32x16 __attribute__((ext_vector_type(16)));
#define LAS __attribute__((address_space(3)))

#define NT 16384
#define TSEQ 8192
#define DM 1024
#define NIN 3904
#define NTHR 512
#define C_R 0
#define C_K 256
#define C_V 512
#define C_XW 768
#define C_GA 832
#define C_CVAL 1088
#define C_CGLU 1344
#define C_CGATE 1600
#define C_HQ 1856
#define C_HF 2112
#define C_HI 2368
#define C_HG 2624
#define C_SQ 2880
#define C_SK 3136
#define C_SV 3392
#define C_SG 3648
#define RW_C 16
#define RW_CL (TSEQ / RW_C)
#define RW_TT 16

#define MiB (1024ull * 1024ull)
#define WS_BAR   0ull
#define WS_WT    (1ull * MiB)
#define WT_LAYER (18ull * MiB)
#define WT_IN    0ull
#define WT_OUT   (8ull * MiB)
#define WT_Q     (10ull * MiB)
#define WT_KV    (12ull * MiB)
#define WT_O     (16ull * MiB)
#define WS_MEMN  (37ull * MiB)
#define WS_KV    (39ull * MiB)
#define WS_PQ    (43ull * MiB)
#define WS_HS    (47ull * MiB)
#define WS_HF    (63ull * MiB)
#define WS_RK    (63ull * MiB + 512ull * 1024ull)
#define WS_R1    (64ull * MiB)
#define WS_PW    WS_R1
#define WS_PV    (WS_R1 + 16ull * MiB)
#define WS_P     (120ull * MiB)
#define WS_END   (243ull * MiB)

struct Params {
  const float* in[28];
  float* out;
  unsigned char* ws;
  int never;
  int pad;
};

__device__ __forceinline__ int opaque_tid() { int t = threadIdx.x; asm volatile("" : "+v"(t)); return t; }
__device__ __forceinline__ float bf2f(bf16_t v) { return __uint_as_float(((unsigned)v) << 16); }
__device__ __forceinline__ bf16_t f2bf(float f) {
  unsigned u = __float_as_uint(f);
  u += 0x7fffu + ((u >> 16) & 1u);
  return (bf16_t)(u >> 16);
}
__device__ __forceinline__ unsigned pack2(float a, float b) { return (unsigned)f2bf(a) | ((unsigned)f2bf(b) << 16); }
__device__ __forceinline__ float sigmoidf_(float x) { return 1.0f / (1.0f + __expf(-x)); }
__device__ __forceinline__ float siluf_(float x) { return x / (1.0f + __expf(-x)); }
__device__ __forceinline__ float softplusf_(float x) { return fmaxf(x, 0.f) + log1pf(__expf(-fabsf(x))); }
__device__ __forceinline__ float wave_sum(float v) {
#pragma unroll
  for (int o = 32; o > 0; o >>= 1) v += __shfl_xor(v, o);
  return v;
}
__device__ __forceinline__ float red8(float v) {
  v += __builtin_bit_cast(float, __builtin_amdgcn_update_dpp(0, __builtin_bit_cast(int, v), 0xB1, 0xF, 0xF, true));
  v += __builtin_bit_cast(float, __builtin_amdgcn_update_dpp(0, __builtin_bit_cast(int, v), 0x4E, 0xF, 0xF, true));
  v += __builtin_bit_cast(float, __builtin_amdgcn_update_dpp(0, __builtin_bit_cast(int, v), 0x141, 0xF, 0xF, true));
  return v;
}

#define XB_TMO      128
#define XB_XCNT(j)  (256  + 64 * (j))
#define XB_XSUB(j)  (1280 + 64 * (j))
#define XB_XGEN(j)  (2304 + 64 * (j))
#define XB_TOP      3328
#define XB_TOPGEN   3392
#define XCD_BAR_WORDS 3456
#define XB_SPIN_CAP (1u << 22)
__device__ __forceinline__ unsigned xb_ld(unsigned* p) { return __hip_atomic_load(p, __ATOMIC_RELAXED, __HIP_MEMORY_SCOPE_AGENT); }
__device__ __forceinline__ unsigned xb_add(unsigned* p, unsigned v) { return __hip_atomic_fetch_add(p, v, __ATOMIC_RELAXED, __HIP_MEMORY_SCOPE_AGENT); }
__device__ __forceinline__ unsigned xb_xcc_id() { return (unsigned)__builtin_amdgcn_s_getreg((3 << 11) | 20) & 0xFu; }
#define XB_SPIN(cond, bar) do { unsigned _sp = 0; while (cond) { __builtin_amdgcn_s_sleep(1); \
    if ((++_sp & 255u) == 0u) { if (xb_ld(&(bar)[XB_TMO])) break; if (_sp > XB_SPIN_CAP) { atomicAdd(&(bar)[XB_TMO], 1u); break; } } } } while (0)
struct XcdBarrier { unsigned* bar; unsigned x; volatile LAS unsigned* st; };
__device__ __forceinline__ XcdBarrier xcd_barrier_post(unsigned* bar, volatile LAS unsigned* st) {
  XcdBarrier b; b.bar = bar; b.x = xb_xcc_id(); b.st = st;
  if (threadIdx.x == 0) (void)xb_add(&bar[XB_XCNT(b.x)], 1u);
  return b;
}
__device__ __forceinline__ void xcd_barrier_complete(unsigned* bar, unsigned x, unsigned& nloc, unsigned& nx) {
  const unsigned G = gridDim.x * gridDim.y * gridDim.z;
  unsigned sum, cnt, mine, sp = 0u;
  for (;;) {
    sum = 0u; cnt = 0u; mine = 0u;
#pragma unroll
    for (unsigned j = 0; j < 16; ++j) { const unsigned c = xb_ld(&bar[XB_XCNT(j)]); sum += c; cnt += (c > 0u) ? 1u : 0u; mine = (j == x) ? c : mine; }
    if (sum == G) break;
    __builtin_amdgcn_s_sleep(1);
    if ((++sp & 255u) == 0u) { if (xb_ld(&bar[XB_TMO])) break; if (sp > XB_SPIN_CAP) { atomicAdd(&bar[XB_TMO], 1u); break; } }
  }
  nloc = mine > 0u ? mine : 1u; nx = cnt > 0u ? cnt : 1u;
}
__device__ __forceinline__ void xcd_barrier(const XcdBarrier& b) {
  asm volatile("s_waitcnt vmcnt(0)" ::: "memory");
  __syncthreads();
  if (threadIdx.x == 0) {
    unsigned* bar = b.bar;
    __builtin_amdgcn_s_waitcnt(0);
    unsigned nloc = b.st[0], nx = b.st[1];
    if (nloc == 0u) { xcd_barrier_complete(bar, b.x, nloc, nx); b.st[0] = nloc; b.st[1] = nx; }
    const unsigned old = xb_add(&bar[XB_XSUB(b.x)], 1u);
    const unsigned gen = old / nloc;
    if (old + 1u == (gen + 1u) * nloc) {
      __builtin_amdgcn_fence(__ATOMIC_RELEASE, "agent");
      asm volatile("s_waitcnt vmcnt(0)" ::: "memory");
      const unsigned og = xb_add(&bar[XB_TOP], 1u);
      const unsigned tg = og / nx;
      if (og + 1u == (tg + 1u) * nx) xb_add(&bar[XB_TOPGEN], 1u);
      else XB_SPIN(xb_ld(&bar[XB_TOPGEN]) == tg, bar);
      __builtin_amdgcn_fence(__ATOMIC_ACQUIRE, "agent");
      xb_add(&bar[XB_XGEN(b.x)], 1u);
      asm volatile("s_waitcnt vmcnt(0)" ::: "memory");
    } else {
      XB_SPIN(xb_ld(&bar[XB_XGEN(b.x)]) == gen, bar);
      __builtin_amdgcn_fence(__ATOMIC_ACQUIRE, "agent");
      asm volatile("s_waitcnt vmcnt(0)" ::: "memory");
    }
  }
  __syncthreads();
}

#define G_STAGE 73728
#define G_BOFF 36864
template <int EPI>
__device__ __forceinline__ void gemm_tile(const bf16_t* __restrict__ A, int lda, int ao0, int ao1, int ao2, int ao3,
                                          const bf16_t* __restrict__ Bt, int m0, int n0, int N,
                                          void* out, const float* resid, int ldc, unsigned char* lds) {
#ifdef OFF_gemm_tile
  return;
#endif

  const int tid = opaque_tid(), lane = tid & 63, w = tid >> 6;
  const int wm = w >> 2, wn = w & 3, lr = lane & 31, lh = lane >> 5;
  f32x16 acc[4][2];
#pragma unroll
  for (int i = 0; i < 4; ++i)
#pragma unroll
    for (int j = 0; j < 2; ++j)
#pragma unroll
      for (int r = 0; r < 16; ++r) acc[i][j][r] = 0.f;
  uint4 ra[4], rb[4];
  const int crow = tid >> 3, ccol = (tid & 7) * 8;
  const bf16_t* Ap = A + (size_t)(m0 + crow) * lda + ccol;
  const bf16_t* Bp = Bt + (size_t)(n0 + crow) * 1024 + ccol;
#define G_LOAD(kt) { const int k0_ = (kt) * 64; const int seg_ = k0_ >> 8; const int ao_ = (seg_ == 0 ? ao0 : seg_ == 1 ? ao1 : seg_ == 2 ? ao2 : ao3) + (k0_ & 255); \
    _Pragma("unroll") for (int i_ = 0; i_ < 4; ++i_) { ra[i_] = *(const uint4*)(Ap + (size_t)(i_ * 64) * lda + ao_); rb[i_] = *(const uint4*)(Bp + (size_t)(i_ * 64) * 1024 + k0_); } }
#define G_WRITE(buf) { unsigned char* b_ = lds + (buf) * G_STAGE + crow * 144 + (tid & 7) * 16; \
    _Pragma("unroll") for (int i_ = 0; i_ < 4; ++i_) { *(uint4*)(b_ + i_ * 64 * 144) = ra[i_]; *(uint4*)(b_ + G_BOFF + i_ * 64 * 144) = rb[i_]; } }
  G_LOAD(0); G_WRITE(0); __syncthreads();
  for (int kt = 0; kt < 16; ++kt) {
    if (kt < 15) G_LOAD(kt + 1);
    const unsigned char* base = lds + (kt & 1) * G_STAGE;
    const unsigned char* ab = base + (wm * 128 + lr) * 144 + lh * 16;
    const unsigned char* bb = base + G_BOFF + (wn * 64 + lr) * 144 + lh * 16;
#pragma unroll
    for (int s = 0; s < 4; ++s) {
      bf16x8 a[4], b[2];
#pragma unroll
      for (int i = 0; i < 4; ++i) a[i] = *(const bf16x8*)(ab + i * 32 * 144 + s * 32);
#pragma unroll
      for (int j = 0; j < 2; ++j) b[j] = *(const bf16x8*)(bb + j * 32 * 144 + s * 32);
#pragma unroll
      for (int i = 0; i < 4; ++i)
#pragma unroll
        for (int j = 0; j < 2; ++j) acc[i][j] = __builtin_amdgcn_mfma_f32_32x32x16_bf16(a[i], b[j], acc[i][j], 0, 0, 0);
    }
    if (kt < 15) G_WRITE((kt + 1) & 1);
    __syncthreads();
  }
#undef G_LOAD
#undef G_WRITE
#pragma unroll
  for (int i = 0; i < 4; ++i)
#pragma unroll
    for (int j = 0; j < 2; ++j) {
      const int col = n0 + wn * 64 + j * 32 + lr;
#pragma unroll
      for (int r = 0; r < 16; ++r) {
        const int row = m0 + wm * 128 + i * 32 + (r & 3) + 8 * (r >> 2) + 4 * lh;
        if (EPI == 0) { if (col < N) ((bf16_t*)out)[(size_t)row * ldc + col] = f2bf(acc[i][j][r]); }
        else { ((float*)out)[(size_t)row * ldc + col] = resid[(size_t)row * ldc + col] + acc[i][j][r]; }
      }
    }
}

__device__ __forceinline__ void tile_map(int t, int nN, int& mi, int& ni) {
  if (nN == 16) { const int rnd = t >> 8, blk = t & 255, x = blk & 7, y = blk >> 3; mi = rnd * 16 + (x >> 1) * 4 + (y & 3); ni = (x & 1) * 8 + (y >> 2); }
  else if (nN == 4) { const int rnd = t >> 8, blk = t & 255, x = blk & 7, y = blk >> 3; mi = rnd * 64 + x * 8 + (y & 7); ni = y >> 3; }
  else { mi = t / nN; ni = t % nN; }
}

__device__ void wt_tile(const float* __restrict__ W, int N, bf16_t* __restrict__ Wt, int kt, int nt, unsigned char* lds) {
#ifdef OFF_wt_tile
  return;
#endif

  float* tl = (float*)lds;
  const int tid = opaque_tid();
  const int r = tid >> 3, c8 = (tid & 7) * 8;
  const float* src = W + (size_t)(kt * 64 + r) * N + nt * 64 + c8;
  const float4 v0 = *(const float4*)src, v1 = *(const float4*)(src + 4);
  float* d = tl + r * 65 + c8;
  d[0] = v0.x; d[1] = v0.y; d[2] = v0.z; d[3] = v0.w; d[4] = v1.x; d[5] = v1.y; d[6] = v1.z; d[7] = v1.w;
  __syncthreads();
  uint4 o;
  o.x = pack2(tl[(c8 + 0) * 65 + r], tl[(c8 + 1) * 65 + r]);
  o.y = pack2(tl[(c8 + 2) * 65 + r], tl[(c8 + 3) * 65 + r]);
  o.z = pack2(tl[(c8 + 4) * 65 + r], tl[(c8 + 5) * 65 + r]);
  o.w = pack2(tl[(c8 + 6) * 65 + r], tl[(c8 + 7) * 65 + r]);
  *(uint4*)(Wt + (size_t)(nt * 64 + r) * 1024 + kt * 64 + c8) = o;
  __syncthreads();
}

template <bool F32OUT>
__device__ void norm_rows(const float* src, const float* __restrict__ g, void* dst, int nrows) {
#ifdef OFF_norm_rows
  return;
#endif

  const int tid = opaque_tid();
  const int lane = tid & 63;
  const int gw = blockIdx.x * 8 + (tid >> 6), nw = gridDim.x * 8;
  float4 gv[4];
#pragma unroll
  for (int i = 0; i < 4; ++i) gv[i] = *(const float4*)(g + i * 256 + lane * 4);
  for (int row = gw; row < nrows; row += nw) {
    const float* s = src + (size_t)row * 1024;
    float4 v[4]; float ss = 0.f;
#pragma unroll
    for (int i = 0; i < 4; ++i) { v[i] = *(const float4*)(s + i * 256 + lane * 4); ss += v[i].x * v[i].x + v[i].y * v[i].y + v[i].z * v[i].z + v[i].w * v[i].w; }
    ss = wave_sum(ss);
    const float rs = rsqrtf(ss * (1.0f / 1024.0f) + 1e-6f);
#pragma unroll
    for (int i = 0; i < 4; ++i) {
      const float a = v[i].x * rs * gv[i].x, b = v[i].y * rs * gv[i].y, c = v[i].z * rs * gv[i].z, d = v[i].w * rs * gv[i].w;
      if (F32OUT) { *(float4*)((float*)dst + (size_t)row * 1024 + i * 256 + lane * 4) = make_float4(a, b, c, d); }
      else { uint2 o; o.x = pack2(a, b); o.y = pack2(c, d); *(uint2*)((bf16_t*)dst + (size_t)row * 1024 + i * 256 + lane * 4) = o; }
    }
  }
}

__device__ void rwkv_prep_item(const Params& P, int l, int item, unsigned char* lds) {
#ifdef OFF_rwkv_prep_item
  return;
#endif

  const bf16_t* p = (const bf16_t*)(P.ws + WS_P);
  float* PW = (float*)(P.ws + WS_PW); bf16_t* PV = (bf16_t*)(P.ws + WS_PV); float* RK = (float*)(P.ws + WS_RK);
  float* lora = (float*)lds;
  const int tid = opaque_tid(), lane = tid & 63, w = tid >> 6, head = w & 3, sub = w >> 2;
  const int c = head * 64 + lane;
  const float* mu = P.in[4] + l * 832;
  const float mur = mu[c], muk = mu[256 + c], muv = mu[512 + c], mux = mu[768 + lane];
  const float w0 = P.in[5][l * 256 + c], a0 = P.in[7][l * 256 + c];
  const float kkw = P.in[9][l * 256 + c], kaw = P.in[10][l * 256 + c], rkw = P.in[11][l * 256 + c];
  float wup[32], aup[32];
#pragma unroll
  for (int j = 0; j < 32; ++j) { wup[j] = P.in[6][(l * 32 + j) * 256 + c]; aup[j] = P.in[8][(l * 32 + j) * 256 + c]; }
  for (int i = 0; i < 16; ++i) {
    const int t = item * 32 + sub + 2 * i;
    const int tt = t & (TSEQ - 1), b = t >> 13;
    const bf16_t* pr = p + (size_t)t * NIN;
    const bool hp = tt > 0;
    float r = bf2f(pr[c]), k = bf2f(pr[256 + c]), v = bf2f(pr[512 + c]), x = bf2f(pr[768 + lane]);
    const float rp = hp ? bf2f(pr[c - NIN]) : 0.f, kp_ = hp ? bf2f(pr[256 + c - NIN]) : 0.f, vp = hp ? bf2f(pr[512 + c - NIN]) : 0.f, xp = hp ? bf2f(pr[768 + lane - NIN]) : 0.f;
    r += (rp - r) * mur; k += (kp_ - k) * muk; v += (vp - v) * muv; x += (xp - x) * mux;
    __syncthreads();
    lora[w * 64 + lane] = lane < 32 ? tanhf(x) : x;
    __syncthreads();
    float wv = w0, av = a0;
#pragma unroll
    for (int j = 0; j < 32; ++j) { wv += lora[w * 64 + j] * wup[j]; av += lora[w * 64 + 32 + j] * aup[j]; }
    const float wlog = -softplusf_(-wv) - 0.5f;
    const float decay = __expf(-__expf(wlog));
    const float ar = sigmoidf_(av);
    const float kk = k * kkw;
    const float n2 = wave_sum(kk * kk);
    const float kkn = kk / fmaxf(sqrtf(n2), 1e-12f);
    const float kmod = k * (1.0f + (ar - 1.0f) * kaw);
    const float rk = wave_sum(r * kmod * rkw);
    const size_t idx = (size_t)(b * 4 + head) * TSEQ + tt;
    PW[idx * 64 + lane] = decay;
    bf16_t* pv = PV + idx * 320;
    pv[lane] = f2bf(r); pv[64 + lane] = f2bf(kmod); pv[128 + lane] = f2bf(v); pv[192 + lane] = f2bf(-kkn); pv[256 + lane] = f2bf(kkn * ar);
    if (lane == 0) RK[idx] = rk;
  }
  __syncthreads();
}

#define RW_TILE_B (RW_TT * 1536)
__device__ __forceinline__ void rw_stage(const float* __restrict__ PW, const bf16_t* __restrict__ PV, size_t idx0, unsigned char* dstb) {
  float* dst = (float*)dstb;
  const int tid = opaque_tid();
  if (tid < RW_TT * 16) { const int s = tid >> 4, q = tid & 15; *(float4*)(dst + s * 384 + q * 4) = *(const float4*)(PW + (idx0 + s) * 64 + q * 4); }
  for (int c = tid; c < RW_TT * 40; c += NTHR) {
    const int s = c / 40, q = c % 40;
    const uint4 u = *(const uint4*)(PV + (idx0 + s) * 320 + q * 8);
    const int vec = q >> 3, off = (q & 7) * 8;
    const int slot = vec == 0 ? 4 : vec == 1 ? 3 : vec == 2 ? 5 : vec == 3 ? 1 : 2;
    float* d = dst + s * 384 + slot * 64 + off;
    *(float4*)d = make_float4(__uint_as_float(u.x << 16), __uint_as_float(u.x & 0xffff0000u), __uint_as_float(u.y << 16), __uint_as_float(u.y & 0xffff0000u));
    *(float4*)(d + 4) = make_float4(__uint_as_float(u.z << 16), __uint_as_float(u.z & 0xffff0000u), __uint_as_float(u.w << 16), __uint_as_float(u.w & 0xffff0000u));
  }
}

template <int MODE>
__device__ void rwkv_scan_item(const Params& P, int l, int bh, int chunk, unsigned char* lds) {
#ifdef OFF_rwkv_scan_item
  return;
#endif

  const float* PW = (const float*)(P.ws + WS_PW); const bf16_t* PV = (const bf16_t*)(P.ws + WS_PV); const float* RK = (const float*)(P.ws + WS_RK);
  float* PQ = (float*)(P.ws + WS_PQ);
  bf16_t* p = (bf16_t*)(P.ws + WS_P);
  const int tid = opaque_tid(), lane = tid & 63, w = tid >> 6;
  const int row = w * 8 + (lane >> 3), q = lane & 7;
  const int b = bh >> 2, head = bh & 3;
  unsigned char* tile0 = lds;
  float* ybuf = (float*)(lds + 2 * RW_TILE_B);
  float* Sl = (float*)(lds + 2 * RW_TILE_B + RW_TT * 256);
  float S[8], S2[8];
#pragma unroll
  for (int e = 0; e < 8; ++e) { S[e] = 0.f; S2[e] = 0.f; }
  if (MODE == 1) {
#pragma unroll
    for (int e = 0; e < 8; ++e) S[e] = (q * 8 + e == row) ? 1.f : 0.f;
  }
  if (MODE == 0 && chunk > 0) {
    const float* Q0 = PQ + ((size_t)(bh * RW_C + 0) * 2 + 1) * 4096;
    float* cur = Sl; float* nxt = Sl + 4096;
    for (int i = tid; i < 1024; i += NTHR) *(float4*)(cur + i * 4) = *(const float4*)(Q0 + i * 4);
    float* Pl = (float*)lds;
    for (int cc = 1; cc < chunk; ++cc) {
      const float* Pm = PQ + ((size_t)(bh * RW_C + cc) * 2 + 0) * 4096;
      const float* Qm = Pm + 4096;
      __syncthreads();
      for (int i = tid; i < 1024; i += NTHR) *(float4*)(Pl + i * 4) = *(const float4*)(Pm + i * 4);
      __syncthreads();
      const int ti = w >> 1;
#pragma unroll
      for (int jj = 0; jj < 2; ++jj) {
        const int tj = (w & 1) * 2 + jj;
        f32x4 acc = {0.f, 0.f, 0.f, 0.f};
#pragma unroll
        for (int ks = 0; ks < 16; ++ks) {
          const float a = cur[(ti * 16 + (lane & 15)) * 64 + ks * 4 + (lane >> 4)];
          const float bb = Pl[(ks * 4 + (lane >> 4)) * 64 + tj * 16 + (lane & 15)];
          acc = __builtin_amdgcn_mfma_f32_16x16x4f32(a, bb, acc, 0, 0, 0);
        }
#pragma unroll
        for (int r = 0; r < 4; ++r) {
          const int rr = ti * 16 + (lane >> 4) * 4 + r, cc2 = tj * 16 + (lane & 15);
          nxt[rr * 64 + cc2] = acc[r] + Qm[rr * 64 + cc2];
        }
      }
      float* t_ = cur; cur = nxt; nxt = t_;
    }
    __syncthreads();
#pragma unroll
    for (int e = 0; e < 8; ++e) S[e] = cur[row * 64 + q * 8 + e];
    __syncthreads();
  }
  const size_t idxb = (size_t)bh * TSEQ + (size_t)chunk * RW_CL;
  const int ntile = RW_CL / RW_TT;
  rw_stage(PW, PV, idxb, tile0);
  __syncthreads();
  for (int tl = 0; tl < ntile; ++tl) {
    if (tl + 1 < ntile) rw_stage(PW, PV, idxb + (size_t)(tl + 1) * RW_TT, tile0 + ((tl + 1) & 1) * RW_TILE_B);
    const float* tb = (const float*)(tile0 + (tl & 1) * RW_TILE_B);
#pragma unroll 2
    for (int s = 0; s < RW_TT; ++s) {
      const float* sp = tb + s * 384 + q * 8;
      const float4 w0 = *(const float4*)(sp), w1 = *(const float4*)(sp + 4);
      const float4 a0 = *(const float4*)(sp + 64), a1 = *(const float4*)(sp + 68);
      const float4 b0 = *(const float4*)(sp + 128), b1 = *(const float4*)(sp + 132);
      const float4 k0 = *(const float4*)(sp + 192), k1 = *(const float4*)(sp + 196);
      const float vi = tb[s * 384 + 320 + row];
      const float wv[8] = {w0.x, w0.y, w0.z, w0.w, w1.x, w1.y, w1.z, w1.w};
      const float av[8] = {a0.x, a0.y, a0.z, a0.w, a1.x, a1.y, a1.z, a1.w};
      const float bv[8] = {b0.x, b0.y, b0.z, b0.w, b1.x, b1.y, b1.z, b1.w};
      const float kv[8] = {k0.x, k0.y, k0.z, k0.w, k1.x, k1.y, k1.z, k1.w};
      if (MODE == 0) {
        float d0 = S[0] * av[0], d1 = S[1] * av[1];
#pragma unroll
        for (int e = 2; e < 8; e += 2) { d0 = fmaf(S[e], av[e], d0); d1 = fmaf(S[e + 1], av[e + 1], d1); }
        const float dot = red8(d0 + d1);
#pragma unroll
        for (int e = 0; e < 8; ++e) { S[e] = fmaf(S[e], wv[e], vi * kv[e]); S[e] = fmaf(dot, bv[e], S[e]); }
        const float4 r0 = *(const float4*)(sp + 256), r1 = *(const float4*)(sp + 260);
        const float rv[8] = {r0.x, r0.y, r0.z, r0.w, r1.x, r1.y, r1.z, r1.w};
        float y0 = S[0] * rv[0], y1 = S[1] * rv[1];
#pragma unroll
        for (int e = 2; e < 8; e += 2) { y0 = fmaf(S[e], rv[e], y0); y1 = fmaf(S[e + 1], rv[e + 1], y1); }
        const float y = red8(y0 + y1);
        if (q == 0) ybuf[s * 64 + row] = y;
      } else {
        float d0 = S[0] * av[0], d1 = S[1] * av[1], g0 = S2[0] * av[0], g1 = S2[1] * av[1];
#pragma unroll
        for (int e = 2; e < 8; e += 2) { d0 = fmaf(S[e], av[e], d0); d1 = fmaf(S[e + 1], av[e + 1], d1); g0 = fmaf(S2[e], av[e], g0); g1 = fmaf(S2[e + 1], av[e + 1], g1); }
        const float dotp = red8(d0 + d1), dotq = red8(g0 + g1);
#pragma unroll
        for (int e = 0; e < 8; ++e) { S[e] = fmaf(dotp, bv[e], S[e] * wv[e]); S2[e] = fmaf(S2[e], wv[e], vi * kv[e]); S2[e] = fmaf(dotq, bv[e], S2[e]); }
      }
    }
    if (MODE == 0) {
      __syncthreads();
      for (int s = w; s < RW_TT; s += 8) {
        const int tt = chunk * RW_CL + tl * RW_TT + s;
        const float y = ybuf[s * 64 + lane];
        const float mean = wave_sum(y) * (1.0f / 64.0f);
        const float dlt = y - mean;
        const float var = wave_sum(dlt * dlt) * (1.0f / 64.0f);
        const int ch = head * 64 + lane;
        float o = dlt * rsqrtf(var + 64e-5f) * P.in[12][l * 256 + ch] + P.in[13][l * 256 + ch];
        const float vv = tb[s * 384 + 320 + lane];
        o += RK[(size_t)bh * TSEQ + tt] * vv;
        bf16_t* gp = p + (size_t)(b * TSEQ + tt) * NIN + C_GA + ch;
        *gp = f2bf(o * siluf_(bf2f(*gp)));
      }
    }
    __syncthreads();
  }
  if (MODE == 1) {
    float* Pm = PQ + ((size_t)(bh * RW_C + chunk) * 2 + 0) * 4096 + row * 64 + q * 8;
    *(float4*)Pm = make_float4(S[0], S[1], S[2], S[3]); *(float4*)(Pm + 4) = make_float4(S[4], S[5], S[6], S[7]);
    *(float4*)(Pm + 4096) = make_float4(S2[0], S2[1], S2[2], S2[3]); *(float4*)(Pm + 4100) = make_float4(S2[4], S2[5], S2[6], S2[7]);
  } else if (chunk == 0) {
    float* Qm = PQ + ((size_t)(bh * RW_C + 0) * 2 + 1) * 4096 + row * 64 + q * 8;
    *(float4*)Qm = make_float4(S[0], S[1], S[2], S[3]); *(float4*)(Qm + 4) = make_float4(S[4], S[5], S[6], S[7]);
  }
  __syncthreads();
}

__device__ void conv_item(const Params& P, int l, int item, unsigned char* lds) {
#ifdef OFF_conv_item
  return;
#endif

  bf16_t* p = (bf16_t*)(P.ws + WS_P);
  float* u = (float*)lds;
  float* yb = (float*)(lds + 62 * 1024);
  const int tid = opaque_tid(), c = tid & 255, half = tid >> 8;
  const int t0 = item * 32, tt0 = t0 & (TSEQ - 1);
  for (int r = half; r < 62; r += 2) {
    const int tt = tt0 - 30 + r;
    float val = 0.f;
    if (tt >= 0) { const bf16_t* pr = p + (size_t)(t0 - 30 + r) * NIN; val = bf2f(pr[C_CVAL + c]) * sigmoidf_(bf2f(pr[C_CGLU + c])); }
    u[r * 256 + c] = val;
  }
  float wv[31];
#pragma unroll
  for (int j = 0; j < 31; ++j) wv[j] = P.in[14][(l * 31 + j) * 256 + c];
  const float bias = P.in[15][l * 256 + c];
  __syncthreads();
  for (int i = 0; i < 16; ++i) {
    const int tk = half * 16 + i;
    float acc = bias;
#pragma unroll
    for (int j = 0; j < 31; ++j) acc = fmaf(wv[j], u[(tk + j) * 256 + c], acc);
    yb[tk * 256 + c] = acc;
  }
  __syncthreads();
  const int lane = tid & 63, w = tid >> 6;
  const float4 g = *(const float4*)(P.in[16] + l * 256 + lane * 4), bb = *(const float4*)(P.in[17] + l * 256 + lane * 4);
  for (int i = 0; i < 4; ++i) {
    const int tk = w * 4 + i;
    const float4 v = *(const float4*)(yb + tk * 256 + lane * 4);
    const float mean = wave_sum(v.x + v.y + v.z + v.w) * (1.0f / 256.0f);
    const float d0 = v.x - mean, d1 = v.y - mean, d2 = v.z - mean, d3 = v.w - mean;
    const float var = wave_sum(d0 * d0 + d1 * d1 + d2 * d2 + d3 * d3) * (1.0f / 256.0f);
    const float rs = rsqrtf(var + 1e-5f);
    bf16_t* gp = p + (size_t)(t0 + tk) * NIN + C_CGATE + lane * 4;
    const uint2 gu = *(const uint2*)gp;
    const float o0 = siluf_(d0 * rs * g.x + bb.x) * siluf_(__uint_as_float(gu.x << 16));
    const float o1 = siluf_(d1 * rs * g.y + bb.y) * siluf_(__uint_as_float(gu.x & 0xffff0000u));
    const float o2 = siluf_(d2 * rs * g.z + bb.z) * siluf_(__uint_as_float(gu.y << 16));
    const float o3 = siluf_(d3 * rs * g.w + bb.w) * siluf_(__uint_as_float(gu.y & 0xffff0000u));
    uint2 o; o.x = pack2(o0, o1); o.y = pack2(o2, o3);
    *(uint2*)gp = o;
  }
  __syncthreads();
}

#define HG_WLDS 10240
__device__ __forceinline__ float hgrn_lb(const Params& P, int l, int ch) {
  if (l == 0) return 0.f;
  const float x0 = P.in[18][ch], x1 = P.in[18][256 + ch];
  return 1.0f / (1.0f + __expf(x0 - x1));
}
template <int PASS>
__device__ void hgrn_wave_item(const Params& P, int l, int wi, unsigned char* lds) {
#ifdef OFF_hgrn_wave_item
  return;
#endif

  bf16_t* p = (bf16_t*)(P.ws + WS_P);
  float* HS = (float*)(P.ws + WS_HS); float* HF = (float*)(P.ws + WS_HF);
  const int tid = opaque_tid();
  const int lane = tid & 63, w = tid >> 6;
  const int bh = wi >> 7, chunk = wi & 127, b = bh >> 2, head = bh & 3;
  float* st = (float*)(lds + w * HG_WLDS);
  float* ob = st + 2048;
  const int kg = lane & 7, vg = lane >> 3;
  const int ch = head * 64 + lane;
  const float lb = hgrn_lb(P, l, ch);
  const float ng = P.in[19][l * 256 + ch];
  float S[8][8];
  float* slot = HS + (size_t)(bh * 128 + chunk) * 4096;
  if (PASS == 1) {
#pragma unroll
    for (int i = 0; i < 8; ++i) { const float4 x0 = *(const float4*)(slot + (kg * 8 + i) * 64 + vg * 8), x1 = *(const float4*)(slot + (kg * 8 + i) * 64 + vg * 8 + 4);
      S[i][0] = x0.x; S[i][1] = x0.y; S[i][2] = x0.z; S[i][3] = x0.w; S[i][4] = x1.x; S[i][5] = x1.y; S[i][6] = x1.z; S[i][7] = x1.w; }
  } else {
#pragma unroll
    for (int i = 0; i < 8; ++i)
#pragma unroll
      for (int j = 0; j < 8; ++j) S[i][j] = 0.f;
  }
  float Fp = 1.f;
  for (int sub = 0; sub < 8; ++sub) {
    const int tbase = b * TSEQ + chunk * 64 + sub * 8;
#pragma unroll
    for (int s = 0; s < 8; ++s) {
      const bf16_t* pr = p + (size_t)(tbase + s) * NIN;
      const float f = lb + (1.0f - lb) * sigmoidf_(bf2f(pr[C_HF + ch]));
      Fp *= f;
      st[s * 256 + lane] = f; st[s * 256 + 64 + lane] = 1.0f - f;
      if (PASS == 1) st[s * 256 + 128 + lane] = siluf_(bf2f(pr[C_HQ + ch]));
      st[s * 256 + 192 + lane] = bf2f(pr[C_HI + ch]);
    }
    __builtin_amdgcn_s_waitcnt(0xc07f);
    __builtin_amdgcn_wave_barrier();
#pragma unroll 1
    for (int s = 0; s < 8; ++s) {
      const float* sp = st + s * 256;
      const float4 f0 = *(const float4*)(sp + kg * 8), f1 = *(const float4*)(sp + kg * 8 + 4);
      const float4 k0 = *(const float4*)(sp + 64 + kg * 8), k1 = *(const float4*)(sp + 64 + kg * 8 + 4);
      const float4 v0 = *(const float4*)(sp + 192 + vg * 8), v1 = *(const float4*)(sp + 192 + vg * 8 + 4);
      const float fv[8] = {f0.x, f0.y, f0.z, f0.w, f1.x, f1.y, f1.z, f1.w};
      const float kv[8] = {k0.x, k0.y, k0.z, k0.w, k1.x, k1.y, k1.z, k1.w};
      const float vv[8] = {v0.x, v0.y, v0.z, v0.w, v1.x, v1.y, v1.z, v1.w};
#pragma unroll
      for (int i = 0; i < 8; ++i)
#pragma unroll
        for (int j = 0; j < 8; ++j) S[i][j] = fmaf(fv[i], S[i][j], kv[i] * vv[j]);
      if (PASS == 1) {
        const float4 q0 = *(const float4*)(sp + 128 + kg * 8), q1 = *(const float4*)(sp + 128 + kg * 8 + 4);
        const float qv[8] = {q0.x, q0.y, q0.z, q0.w, q1.x, q1.y, q1.z, q1.w};
        float o[8];
#pragma unroll
        for (int j = 0; j < 8; ++j) { float a = qv[0] * S[0][j];
#pragma unroll
          for (int i = 1; i < 8; ++i) a = fmaf(qv[i], S[i][j], a);
          o[j] = red8(a); }
        if (kg == 0) { *(float4*)(ob + s * 64 + vg * 8) = make_float4(o[0], o[1], o[2], o[3]); *(float4*)(ob + s * 64 + vg * 8 + 4) = make_float4(o[4], o[5], o[6], o[7]); }
      }
    }
    __builtin_amdgcn_s_waitcnt(0xc07f);
    __builtin_amdgcn_wave_barrier();
    if (PASS == 1) {
#pragma unroll 1
      for (int s = 0; s < 8; ++s) {
        const float o = ob[s * 64 + lane];
        const float ms = wave_sum(o * o) * (1.0f / 64.0f);
        bf16_t* gp = p + (size_t)(tbase + s) * NIN + C_HG + ch;
        *gp = f2bf(o * rsqrtf(ms + 1e-6f) * ng * siluf_(bf2f(*gp)));
      }
      __builtin_amdgcn_s_waitcnt(0xc07f);
      __builtin_amdgcn_wave_barrier();
    }
  }
  if (PASS == 0) {
#pragma unroll
    for (int i = 0; i < 8; ++i) { *(float4*)(slot + (kg * 8 + i) * 64 + vg * 8) = make_float4(S[i][0], S[i][1], S[i][2], S[i][3]);
      *(float4*)(slot + (kg * 8 + i) * 64 + vg * 8 + 4) = make_float4(S[i][4], S[i][5], S[i][6], S[i][7]); }
    HF[(size_t)(bh * 128 + chunk) * 64 + lane] = Fp;
  }
}
__device__ void hgrn_combine_item(const Params& P, int bh) {
#ifdef OFF_hgrn_combine_item
  return;
#endif

  float* HS = (float*)(P.ws + WS_HS); const float* HF = (const float*)(P.ws + WS_HF);
  const int tid = opaque_tid();
  const int krow = tid >> 3;
  float R[8];
#pragma unroll
  for (int e = 0; e < 8; ++e) R[e] = 0.f;
  for (int c0 = 0; c0 < 128; c0 += 4) {
    float4 x[4][2]; float f[4];
#pragma unroll
    for (int u = 0; u < 4; ++u) { float* sl = HS + (size_t)(bh * 128 + c0 + u) * 4096 + tid * 8; x[u][0] = *(const float4*)sl; x[u][1] = *(const float4*)(sl + 4); f[u] = HF[(size_t)(bh * 128 + c0 + u) * 64 + krow]; }
#pragma unroll
    for (int u = 0; u < 4; ++u) {
      float* sl = HS + (size_t)(bh * 128 + c0 + u) * 4096 + tid * 8;
      *(float4*)sl = make_float4(R[0], R[1], R[2], R[3]); *(float4*)(sl + 4) = make_float4(R[4], R[5], R[6], R[7]);
      R[0] = fmaf(f[u], R[0], x[u][0].x); R[1] = fmaf(f[u], R[1], x[u][0].y); R[2] = fmaf(f[u], R[2], x[u][0].z); R[3] = fmaf(f[u], R[3], x[u][0].w);
      R[4] = fmaf(f[u], R[4], x[u][1].x); R[5] = fmaf(f[u], R[5], x[u][1].y); R[6] = fmaf(f[u], R[6], x[u][1].z); R[7] = fmaf(f[u], R[7], x[u][1].w);
    }
  }
}

__device__ void sb_item(const Params& P, int item, unsigned char* lds) {
#ifdef OFF_sb_item
  return;
#endif

  bf16_t* p = (bf16_t*)(P.ws + WS_P);
  const int tid = opaque_tid(), lane = tid & 63, w = tid >> 6;
  const int qt = item & 127, bh = item >> 7, b = bh >> 2, head = bh & 3;
  unsigned char* Qs = lds;
  unsigned char* Ks = lds + 9216;
  unsigned char* Vt = lds + 18432;
  unsigned char* As = lds + 27648;
  float* Zs = (float*)(lds + 36864);
  volatile int* flag = (volatile int*)(lds + 36864 + 64 * 65 * 4);
  const int lrow = tid >> 3, lch = (tid & 7);
  const size_t tokq = (size_t)b * TSEQ + qt * 64;
  *(uint4*)(Qs + lrow * 144 + lch * 16) = *(const uint4*)(p + (tokq + lrow) * NIN + C_SQ + head * 64 + lch * 8);
  float carry = 0.f;
  f32x4 oacc[2] = {{0.f, 0.f, 0.f, 0.f}, {0.f, 0.f, 0.f, 0.f}};
  const int qi = w >> 1, t2 = (w & 1) * 2;
  const int q = tid >> 3, seg = tid & 7;
  for (int kt = qt; kt >= 0; --kt) {
    const size_t tokk = (size_t)b * TSEQ + kt * 64;
    __syncthreads();
    *(uint4*)(Ks + lrow * 144 + lch * 16) = *(const uint4*)(p + (tokk + lrow) * NIN + C_SK + head * 64 + lch * 8);
    { const uint4 vv = *(const uint4*)(p + (tokk + lrow) * NIN + C_SV + head * 64 + lch * 8);
      const unsigned short* ve = (const unsigned short*)&vv;
#pragma unroll
      for (int e = 0; e < 8; ++e) *(unsigned short*)(Vt + (lch * 8 + e) * 144 + lrow * 2) = ve[e]; }
    if (tid == 0) *flag = 0;
    __syncthreads();
#pragma unroll
    for (int jj = 0; jj < 2; ++jj) {
      const int ki = t2 + jj;
      f32x4 acc = {0.f, 0.f, 0.f, 0.f};
#pragma unroll
      for (int s = 0; s < 2; ++s) {
        const bf16x8 a = *(const bf16x8*)(Qs + (qi * 16 + (lane & 15)) * 144 + s * 64 + (lane >> 4) * 16);
        const bf16x8 bb = *(const bf16x8*)(Ks + (ki * 16 + (lane & 15)) * 144 + s * 64 + (lane >> 4) * 16);
        acc = __builtin_amdgcn_mfma_f32_16x16x32_bf16(a, bb, acc, 0, 0, 0);
      }
#pragma unroll
      for (int r = 0; r < 4; ++r) Zs[(qi * 16 + (lane >> 4) * 4 + r) * 65 + ki * 16 + (lane & 15)] = acc[r] * 0.125f;
    }
    __syncthreads();
    {
      const int tq = qt * 64 + q;
      float z[8], lk[8];
      float tot = 0.f;
#pragma unroll
      for (int e = 0; e < 8; ++e) {
        z[e] = Zs[q * 65 + seg * 8 + e];
        const bool m = (kt * 64 + seg * 8 + e) < tq;
        lk[e] = m ? -softplusf_(z[e]) : 0.f;
        tot += lk[e];
      }
      float inc = tot;
      { float t_ = __shfl_down(inc, 1, 8); if (seg + 1 < 8) inc += t_; }
      { float t_ = __shfl_down(inc, 2, 8); if (seg + 2 < 8) inc += t_; }
      { float t_ = __shfl_down(inc, 4, 8); if (seg + 4 < 8) inc += t_; }
      const float rowtot = __shfl(inc, 0, 8);
      float tail = carry + (inc - tot);
      float av[8];
#pragma unroll
      for (int e = 7; e >= 0; --e) {
        const bool m = (kt * 64 + seg * 8 + e) < tq;
        av[e] = m ? __expf(z[e] + lk[e] + tail) : 0.f;
        tail += lk[e];
      }
      uint4 o; o.x = pack2(av[0], av[1]); o.y = pack2(av[2], av[3]); o.z = pack2(av[4], av[5]); o.w = pack2(av[6], av[7]);
      *(uint4*)(As + q * 144 + seg * 16) = o;
      carry += rowtot;
      if (carry > -100.f) *flag = 1;
    }
    __syncthreads();
#pragma unroll
    for (int jj = 0; jj < 2; ++jj) {
      const int di = t2 + jj;
#pragma unroll
      for (int s = 0; s < 2; ++s) {
        const bf16x8 a = *(const bf16x8*)(As + (qi * 16 + (lane & 15)) * 144 + s * 64 + (lane >> 4) * 16);
        const bf16x8 bb = *(const bf16x8*)(Vt + (di * 16 + (lane & 15)) * 144 + s * 64 + (lane >> 4) * 16);
        oacc[jj] = __builtin_amdgcn_mfma_f32_16x16x32_bf16(a, bb, oacc[jj], 0, 0, 0);
      }
    }
    if (*flag == 0) break;
  }
#pragma unroll
  for (int jj = 0; jj < 2; ++jj) {
    const int d = (t2 + jj) * 16 + (lane & 15);
#pragma unroll
    for (int r = 0; r < 4; ++r) {
      const int qq = qi * 16 + (lane >> 4) * 4 + r;
      bf16_t* gp = p + (tokq + qq) * NIN + C_SG + head * 64 + d;
      *gp = f2bf(oacc[jj][r] * siluf_(bf2f(*gp)));
    }
  }
  __syncthreads();
}

__device__ void xattn_item(const Params& P, int l, int item, unsigned char* lds) {
#ifdef OFF_xattn_item
  return;
#endif

  const bf16_t* qb = (const bf16_t*)(P.ws + WS_P + 32ull * MiB);
  bf16_t* ob = (bf16_t*)(P.ws + WS_P + 64ull * MiB);
  const bf16_t* kv = (const bf16_t*)(P.ws + WS_KV) + (size_t)l * 512 * 2048;
  const int tid = opaque_tid(), lane = tid & 63, w = tid >> 6;
  const int qt = item & 127, bh = item >> 7, b = bh >> 2, head = bh & 3;
  unsigned char* Qs = lds;
  unsigned char* KVs = lds + 33792;
  float* Ss = (float*)(lds + 67584);
  const size_t tok0 = (size_t)b * TSEQ + qt * 64;
  __syncthreads();
#pragma unroll
  for (int i = 0; i < 4; ++i) { const int c = tid + i * NTHR, r = c >> 5, cc = c & 31;
    *(uint4*)(Qs + r * 528 + cc * 16) = *(const uint4*)(qb + (tok0 + r) * 1024 + head * 256 + cc * 8); }
  const int qi = w >> 1, t2 = (w & 1) * 2;
  for (int kb = 0; kb < 4; ++kb) {
    __syncthreads();
#pragma unroll
    for (int i = 0; i < 4; ++i) { const int c = tid + i * NTHR, r = c >> 5, cc = c & 31;
      *(uint4*)(KVs + r * 528 + cc * 16) = *(const uint4*)(kv + (size_t)(b * 256 + kb * 64 + r) * 2048 + head * 256 + cc * 8); }
    __syncthreads();
#pragma unroll
    for (int jj = 0; jj < 2; ++jj) {
      const int ki = t2 + jj;
      f32x4 acc = {0.f, 0.f, 0.f, 0.f};
#pragma unroll
      for (int s = 0; s < 8; ++s) {
        const bf16x8 a = *(const bf16x8*)(Qs + (qi * 16 + (lane & 15)) * 528 + s * 64 + (lane >> 4) * 16);
        const bf16x8 bb = *(const bf16x8*)(KVs + (ki * 16 + (lane & 15)) * 528 + s * 64 + (lane >> 4) * 16);
        acc = __builtin_amdgcn_mfma_f32_16x16x32_bf16(a, bb, acc, 0, 0, 0);
      }
#pragma unroll
      for (int r = 0; r < 4; ++r) Ss[(qi * 16 + (lane >> 4) * 4 + r) * 260 + kb * 64 + ki * 16 + (lane & 15)] = acc[r] * 0.0625f;
    }
  }
  __syncthreads();
  {
    const int q = tid >> 3, seg = tid & 7;
    float x[32]; float mx = -3.0e38f;
#pragma unroll
    for (int i = 0; i < 8; ++i) { const float4 v = *(const float4*)(Ss + q * 260 + seg * 32 + i * 4); x[i * 4] = v.x; x[i * 4 + 1] = v.y; x[i * 4 + 2] = v.z; x[i * 4 + 3] = v.w;
      mx = fmaxf(mx, fmaxf(fmaxf(v.x, v.y), fmaxf(v.z, v.w))); }
    mx = fmaxf(mx, __shfl_xor(mx, 1)); mx = fmaxf(mx, __shfl_xor(mx, 2)); mx = fmaxf(mx, __shfl_xor(mx, 4));
    float sum = 0.f;
#pragma unroll
    for (int i = 0; i < 32; ++i) { x[i] = __expf(x[i] - mx); sum += x[i]; }
    sum += __shfl_xor(sum, 1); sum += __shfl_xor(sum, 2); sum += __shfl_xor(sum, 4);
    const float inv = 1.0f / sum;
#pragma unroll
    for (int i = 0; i < 4; ++i) { uint4 o; o.x = pack2(x[i * 8] * inv, x[i * 8 + 1] * inv); o.y = pack2(x[i * 8 + 2] * inv, x[i * 8 + 3] * inv);
      o.z = pack2(x[i * 8 + 4] * inv, x[i * 8 + 5] * inv); o.w = pack2(x[i * 8 + 6] * inv, x[i * 8 + 7] * inv);
      *(uint4*)(Qs + q * 528 + seg * 64 + i * 16) = o; }
  }
  for (int db = 0; db < 4; ++db) {
    __syncthreads();
#pragma unroll
    for (int i = 0; i < 4; ++i) { const int c = tid + i * NTHR, m = c >> 3, dc = c & 7;
      const uint4 vv = *(const uint4*)(kv + (size_t)(b * 256 + m) * 2048 + 1024 + head * 256 + db * 64 + dc * 8);
      const unsigned short* ve = (const unsigned short*)&vv;
#pragma unroll
      for (int e = 0; e < 8; ++e) *(unsigned short*)(KVs + (dc * 8 + e) * 528 + m * 2) = ve[e]; }
    __syncthreads();
#pragma unroll
    for (int jj = 0; jj < 2; ++jj) {
      const int di = t2 + jj;
      f32x4 acc = {0.f, 0.f, 0.f, 0.f};
#pragma unroll
      for (int s = 0; s < 8; ++s) {
        const bf16x8 a = *(const bf16x8*)(Qs + (qi * 16 + (lane & 15)) * 528 + s * 64 + (lane >> 4) * 16);
        const bf16x8 bb = *(const bf16x8*)(KVs + (di * 16 + (lane & 15)) * 528 + s * 64 + (lane >> 4) * 16);
        acc = __builtin_amdgcn_mfma_f32_16x16x32_bf16(a, bb, acc, 0, 0, 0);
      }
#pragma unroll
      for (int r = 0; r < 4; ++r) ob[(tok0 + qi * 16 + (lane >> 4) * 4 + r) * 1024 + head * 256 + db * 64 + di * 16 + (lane & 15)] = f2bf(acc[r]);
    }
  }
  __syncthreads();
}

__global__ void __launch_bounds__(NTHR) fwd_megakernel(Params P) {
  extern __shared__ __attribute__((aligned(16))) unsigned char lds[];
  __shared__ uint4 xb_words;
  if (threadIdx.x == 0) xb_words = make_uint4(0u, 0u, 0u, 0u);
  __syncthreads();
  XcdBarrier bar = xcd_barrier_post((unsigned*)(P.ws + WS_BAR), (volatile LAS unsigned*)&xb_words);
  if (P.never) cg::this_grid().sync();
  const int G = gridDim.x, bid = blockIdx.x;
  unsigned char* ws = P.ws;
  bf16_t* hbuf = (bf16_t*)(ws + WS_R1);
  bf16_t* pbuf = (bf16_t*)(ws + WS_P);
  bf16_t* hx = (bf16_t*)(ws + WS_P);
  bf16_t* qbuf = (bf16_t*)(ws + WS_P + 32ull * MiB);
  bf16_t* obuf = (bf16_t*)(ws + WS_P + 64ull * MiB);

  for (int it = bid; it < 2 * 2256; it += G) {
    const int l = it / 2256; int r = it % 2256;
    const float* W; int N; bf16_t* Wt; int kt, nt;
    unsigned char* wl = ws + WS_WT + l * WT_LAYER;
    if (r < 976) { W = P.in[3] + (size_t)l * 1024 * NIN; N = NIN; Wt = (bf16_t*)(wl + WT_IN); kt = r / 61; nt = r % 61; }
    else { r -= 976; const int m = r >> 8; r &= 255; kt = r >> 4; nt = r & 15; N = 1024;
      if (m == 0) { W = P.in[20] + (size_t)l * 1048576; Wt = (bf16_t*)(wl + WT_OUT); }
      else if (m == 1) { W = P.in[23] + (size_t)l * 1048576; Wt = (bf16_t*)(wl + WT_Q); }
      else if (m == 2) { W = P.in[24] + (size_t)l * 1048576; Wt = (bf16_t*)(wl + WT_KV); }
      else if (m == 3) { W = P.in[25] + (size_t)l * 1048576; Wt = (bf16_t*)(wl + WT_KV) + 1024 * 1024; }
      else { W = P.in[26] + (size_t)l * 1048576; Wt = (bf16_t*)(wl + WT_O); } }
    wt_tile(W, N, Wt, kt, nt, lds);
  }
  norm_rows<false>(P.in[1], P.in[22], (bf16_t*)(ws + WS_MEMN), 512);
  norm_rows<false>(P.in[1], P.in[22] + 1024, (bf16_t*)(ws + WS_MEMN) + 512 * 1024, 512);
  norm_rows<false>(P.in[0], P.in[2], hbuf, NT);
  xcd_barrier(bar);

#pragma unroll 1
  for (int l = 0; l < 2; ++l) {
    const unsigned char* wl = ws + WS_WT + l * WT_LAYER;
    for (int t = bid; t < 1024; t += G) {
      int mi, ni; tile_map(t, 16, mi, ni);
      gemm_tile<0>(hbuf, 1024, 0, 256, 512, 768, (const bf16_t*)(wl + WT_IN), mi * 256, ni * 256, NIN, pbuf, nullptr, NIN, lds);
    }
    xcd_barrier(bar);
    for (int it = bid; it < 640; it += G) {
      if (it < 128) hgrn_wave_item<0>(P, l, it * 8 + (threadIdx.x >> 6), lds);
      else rwkv_prep_item(P, l, it - 128, lds);
      __syncthreads();
    }
    xcd_barrier(bar);
    {
      const int n_p1 = 8 * (RW_C - 2);
      const int n_rw = n_p1 + 8;
      const int n_all = n_rw + 8 + 512 + 1024;
      for (int it = bid; it < n_all; it += G) {
        if (it < n_p1) rwkv_scan_item<1>(P, l, it & 7, 1 + (it >> 3), lds);
        else if (it < n_rw) rwkv_scan_item<0>(P, l, it - n_p1, 0, lds);
        else if (it < n_rw + 8) hgrn_combine_item(P, it - n_rw);
        else if (it < n_rw + 8 + 512) conv_item(P, l, it - n_rw - 8, lds);
        else sb_item(P, it - n_rw - 8 - 512, lds);
        __syncthreads();
      }
    }
    xcd_barrier(bar);
    {
      const int n_p3 = 8 * (RW_C - 1);
      const int n_all = n_p3 + 128 + 16;
      for (int it = bid; it < n_all; it += G) {
        if (it < n_p3) rwkv_scan_item<0>(P, l, it & 7, 1 + (it >> 3), lds);
        else if (it < n_p3 + 128) hgrn_wave_item<1>(P, l, (it - n_p3) * 8 + (threadIdx.x >> 6), lds);
        else { const int t = it - n_p3 - 128; gemm_tile<0>((const bf16_t*)(ws + WS_MEMN) + (size_t)l * 512 * 1024, 1024, 0, 256, 512, 768, (const bf16_t*)(wl + WT_KV), (t >> 3) * 256, (t & 7) * 256, 2048,
                                                          (bf16_t*)(ws + WS_KV) + (size_t)l * 512 * 2048, nullptr, 2048, lds); }
        __syncthreads();
      }
    }
    xcd_barrier(bar);
    {
      const float* resid = l == 0 ? P.in[0] : P.out;
      for (int t = bid; t < 256; t += G) {
        int mi, ni; tile_map(t, 4, mi, ni);
        gemm_tile<1>(pbuf, NIN, C_GA, C_CGATE, C_HG, C_SG, (const bf16_t*)(wl + WT_OUT), mi * 256, ni * 256, 1024, P.out, resid, 1024, lds);
      }
    }
    xcd_barrier(bar);
    norm_rows<false>(P.out, P.in[21] + l * 1024, hx, NT);
    xcd_barrier(bar);
    for (int t = bid; t < 256; t += G) {
      int mi, ni; tile_map(t, 4, mi, ni);
      gemm_tile<0>(hx, 1024, 0, 256, 512, 768, (const bf16_t*)(wl + WT_Q), mi * 256, ni * 256, 1024, qbuf, nullptr, 1024, lds);
    }
    xcd_barrier(bar);
    for (int it = bid; it < 1024; it += G) xattn_item(P, l, it, lds);
    xcd_barrier(bar);
    for (int t = bid; t < 256; t += G) {
      int mi, ni; tile_map(t, 4, mi, ni);
      gemm_tile<1>(obuf, 1024, 0, 256, 512, 768, (const bf16_t*)(wl + WT_O), mi * 256, ni * 256, 1024, P.out, P.out, 1024, lds);
    }
    xcd_barrier(bar);
    if (l == 0) { norm_rows<false>(P.out, P.in[2] + 1024, hbuf, NT); xcd_barrier(bar); }
  }
  norm_rows<true>(P.out, P.in[27], P.out, NT);
}

extern "C" void kernel_launch(void* const* d_in, const int* in_sizes, int n_in, void* d_out, int out_size, void* d_ws, size_t ws_size, hipStream_t stream) {
  constexpr size_t kDynLds = 147456;
  static int grid_blocks = 0;
  if (!grid_blocks) {
    int dev = 0, cus = 0, per_cu = 0;
    hipGetDevice(&dev);
    hipDeviceGetAttribute(&cus, hipDeviceAttributeMultiprocessorCount, dev);
    hipFuncSetAttribute((const void*)fwd_megakernel, hipFuncAttributeMaxDynamicSharedMemorySize, (int)kDynLds);
    hipOccupancyMaxActiveBlocksPerMultiprocessor(&per_cu, fwd_megakernel, NTHR, kDynLds);
    if (per_cu < 1) per_cu = 1;
    if (per_cu > 1) per_cu = 1;
    grid_blocks = cus * per_cu;
    if (grid_blocks > 256) grid_blocks = 256;
  }
  Params p;
  memset(&p, 0, sizeof(p));
  for (int i = 0; i < 28; ++i) p.in[i] = (const float*)d_in[i];
  p.out = (float*)d_out; p.ws = (unsigned char*)d_ws; p.never = 0; p.pad = 0;
  hipMemsetAsync(d_ws, 0, XCD_BAR_WORDS * 4, stream);
  void* args[] = {&p};
  hipError_t e = hipLaunchCooperativeKernel((void*)fwd_megakernel, dim3(grid_blocks), dim3(NTHR), args, kDynLds, stream);
  if (e != hipSuccess) fprintf(stderr, "cooperative launch failed: %s (grid %d)\n", hipGetErrorString(e), grid_blocks);
}
```

```cpp
#include <hip/hip_runtime.h>
#include <hip/hip_cooperative_groups.h>
#include <stdint.h>
#include <cstdio>
#include <cstring>
namespace cg = cooperative_groups;

typedef unsigned short bf16_t;
typedef short bf16x8 __attribute__((ext_vector_type(8)));
typedef float f32x4 __attribute__((ext_vector_type(4)));
typedef float f32x16 __attribute__((ext_vector_type(16)));
#define LAS __attribute__((address_space(3)))

#define NT 16384
#define TSEQ 8192
#define DM 1024
#define NIN 3904
#define NTHR 512
#define C_R 0
#define C_K 256
#define C_V 512
#define C_XW 768
#define C_GA 832
#define C_CVAL 1088
#define C_CGLU 1344
#define C_CGATE 1600
#define C_HQ 1856
#define C_HF 2112
#define C_HI 2368
#define C_HG 2624
#define C_SQ 2880
#define C_SK 3136
#define C_SV 3392
#define C_SG 3648
#define RW_C 16
#define RW_CL (TSEQ / RW_C)
#define RW_TT 16

#define MiB (1024ull * 1024ull)
#define WS_BAR   0ull
#define WS_WT    (1ull * MiB)
#define WT_LAYER (18ull * MiB)
#define WT_IN    0ull
#define WT_OUT   (8ull * MiB)
#define WT_Q     (10ull * MiB)
#define WT_KV    (12ull * MiB)
#define WT_O     (16ull * MiB)
#define WS_MEMN  (37ull * MiB)
#define WS_KV    (39ull * MiB)
#define WS_PQ    (43ull * MiB)
#define WS_HS    (47ull * MiB)
#define WS_HF    (63ull * MiB)
#define WS_RK    (63ull * MiB + 512ull * 1024ull)
#define WS_R1    (64ull * MiB)
#define WS_PW    WS_R1
#define WS_PV    (WS_R1 + 16ull * MiB)
#define WS_P     (120ull * MiB)
#define WS_END   (243ull * MiB)

struct Params {
  const float* in[28];
  float* out;
  unsigned char* ws;
  int never;
  int pad;
};

__device__ __forceinline__ int opaque_tid() { int t = threadIdx.x; asm volatile("" : "+v"(t)); return t; }
__device__ __forceinline__ float bf2f(bf16_t v) { return __uint_as_float(((unsigned)v) << 16); }
__device__ __forceinline__ bf16_t f2bf(float f) {
  unsigned u = __float_as_uint(f);
  u += 0x7fffu + ((u >> 16) & 1u);
  return (bf16_t)(u >> 16);
}
__device__ __forceinline__ unsigned pack2(float a, float b) { return (unsigned)f2bf(a) | ((unsigned)f2bf(b) << 16); }
__device__ __forceinline__ float sigmoidf_(float x) { return 1.0f / (1.0f + __expf(-x)); }
__device__ __forceinline__ float siluf_(float x) { return x / (1.0f + __expf(-x)); }
__device__ __forceinline__ float softplusf_(float x) { return fmaxf(x, 0.f) + log1pf(__expf(-fabsf(x))); }
__device__ __forceinline__ float wave_sum(float v) {
#pragma unroll
  for (int o = 32; o > 0; o >>= 1) v += __shfl_xor(v, o);
  return v;
}
__device__ __forceinline__ float red8(float v) {
  v += __builtin_bit_cast(float, __builtin_amdgcn_update_dpp(0, __builtin_bit_cast(int, v), 0xB1, 0xF, 0xF, true));
  v += __builtin_bit_cast(float, __builtin_amdgcn_update_dpp(0, __builtin_bit_cast(int, v), 0x4E, 0xF, 0xF, true));
  v += __builtin_bit_cast(float, __builtin_amdgcn_update_dpp(0, __builtin_bit_cast(int, v), 0x141, 0xF, 0xF, true));
  return v;
}

#define XB_TMO      128
#define XB_XCNT(j)  (256  + 64 * (j))
#define XB_XSUB(j)  (1280 + 64 * (j))
#define XB_XGEN(j)  (2304 + 64 * (j))
#define XB_TOP      3328
#define XB_TOPGEN   3392
#define XCD_BAR_WORDS 3456
#define XB_SPIN_CAP (1u << 22)
__device__ __forceinline__ unsigned xb_ld(unsigned* p) { return __hip_atomic_load(p, __ATOMIC_RELAXED, __HIP_MEMORY_SCOPE_AGENT); }
__device__ __forceinline__ unsigned xb_add(unsigned* p, unsigned v) { return __hip_atomic_fetch_add(p, v, __ATOMIC_RELAXED, __HIP_MEMORY_SCOPE_AGENT); }
__device__ __forceinline__ unsigned xb_xcc_id() { return (unsigned)__builtin_amdgcn_s_getreg((3 << 11) | 20) & 0xFu; }
#define XB_SPIN(cond, bar) do { unsigned _sp = 0; while (cond) { __builtin_amdgcn_s_sleep(1); \
    if ((++_sp & 255u) == 0u) { if (xb_ld(&(bar)[XB_TMO])) break; if (_sp > XB_SPIN_CAP) { atomicAdd(&(bar)[XB_TMO], 1u); break; } } } } while (0)
struct XcdBarrier { unsigned* bar; unsigned x; volatile LAS unsigned* st; };
__device__ __forceinline__ XcdBarrier xcd_barrier_post(unsigned* bar, volatile LAS unsigned* st) {
  XcdBarrier b; b.bar = bar; b.x = xb_xcc_id(); b.st = st;
  if (threadIdx.x == 0) (void)xb_add(&bar[XB_XCNT(b.x)], 1u);
  return b;
}
__device__ __forceinline__ void xcd_barrier_complete(unsigned* bar, unsigned x, unsigned& nloc, unsigned& nx) {
  const unsigned G = gridDim.x * gridDim.y * gridDim.z;
  unsigned sum, cnt, mine, sp = 0u;
  for (;;) {
    sum = 0u; cnt = 0u; mine = 0u;
#pragma unroll
    for (unsigned j = 0; j < 16; ++j) { const unsigned c = xb_ld(&bar[XB_XCNT(j)]); sum += c; cnt += (c > 0u) ? 1u : 0u; mine = (j == x) ? c : mine; }
    if (sum == G) break;
    __builtin_amdgcn_s_sleep(1);
    if ((++sp & 255u) == 0u) { if (xb_ld(&bar[XB_TMO])) break; if (sp > XB_SPIN_CAP) { atomicAdd(&bar[XB_TMO], 1u); break; } }
  }
  nloc = mine > 0u ? mine : 1u; nx = cnt > 0u ? cnt : 1u;
}
__device__ __forceinline__ void xcd_barrier(const XcdBarrier& b) {
  asm volatile("s_waitcnt vmcnt(0)" ::: "memory");
  __syncthreads();
  if (threadIdx.x == 0) {
    unsigned* bar = b.bar;
    __builtin_amdgcn_s_waitcnt(0);
    unsigned nloc = b.st[0], nx = b.st[1];
    if (nloc == 0u) { xcd_barrier_complete(bar, b.x, nloc, nx); b.st[0] = nloc; b.st[1] = nx; }
    const unsigned old = xb_add(&bar[XB_XSUB(b.x)], 1u);
    const unsigned gen = old / nloc;
    if (old + 1u == (gen + 1u) * nloc) {
      __builtin_amdgcn_fence(__ATOMIC_RELEASE, "agent");
      asm volatile("s_waitcnt vmcnt(0)" ::: "memory");
      const unsigned og = xb_add(&bar[XB_TOP], 1u);
      const unsigned tg = og / nx;
      if (og + 1u == (tg + 1u) * nx) xb_add(&bar[XB_TOPGEN], 1u);
      else XB_SPIN(xb_ld(&bar[XB_TOPGEN]) == tg, bar);
      __builtin_amdgcn_fence(__ATOMIC_ACQUIRE, "agent");
      xb_add(&bar[XB_XGEN(b.x)], 1u);
      asm volatile("s_waitcnt vmcnt(0)" ::: "memory");
    } else {
      XB_SPIN(xb_ld(&bar[XB_XGEN(b.x)]) == gen, bar);
      __builtin_amdgcn_fence(__ATOMIC_ACQUIRE, "agent");
      asm volatile("s_waitcnt vmcnt(0)" ::: "memory");
    }
  }
  __syncthreads();
}

#define G_STAGE 73728
#define G_BOFF 36864
template <int EPI>
__device__ __forceinline__ void gemm_tile(const bf16_t* __restrict__ A, int lda, int ao0, int ao1, int ao2, int ao3,
                                          const bf16_t* __restrict__ Bt, int m0, int n0, int N,
                                          void* out, const float* resid, int ldc, unsigned char* lds) {
#ifdef OFF_gemm_tile
  return;
#endif

  const int tid = opaque_tid(), lane = tid & 63, w = tid >> 6;
  const int wm = w >> 2, wn = w & 3, lr = lane & 31, lh = lane >> 5;
  f32x16 acc[4][2];
#pragma unroll
  for (int i = 0; i < 4; ++i)
#pragma unroll
    for (int j = 0; j < 2; ++j)
#pragma unroll
      for (int r = 0; r < 16; ++r) acc[i][j][r] = 0.f;
  uint4 ra[4], rb[4];
  const int crow = tid >> 3, ccol = (tid & 7) * 8;
  const bf16_t* Ap = A + (size_t)(m0 + crow) * lda + ccol;
  const bf16_t* Bp = Bt + (size_t)(n0 + crow) * 1024 + ccol;
#define G_LOAD(kt) { const int k0_ = (kt) * 64; const int seg_ = k0_ >> 8; const int ao_ = (seg_ == 0 ? ao0 : seg_ == 1 ? ao1 : seg_ == 2 ? ao2 : ao3) + (k0_ & 255); \
    _Pragma("unroll") for (int i_ = 0; i_ < 4; ++i_) { ra[i_] = *(const uint4*)(Ap + (size_t)(i_ * 64) * lda + ao_); rb[i_] = *(const uint4*)(Bp + (size_t)(i_ * 64) * 1024 + k0_); } }
#define G_WRITE(buf) { unsigned char* b_ = lds + (buf) * G_STAGE + crow * 144 + (tid & 7) * 16; \
    _Pragma("unroll") for (int i_ = 0; i_ < 4; ++i_) { *(uint4*)(b_ + i_ * 64 * 144) = ra[i_]; *(uint4*)(b_ + G_BOFF + i_ * 64 * 144) = rb[i_]; } }
  G_LOAD(0); G_WRITE(0); __syncthreads();
  for (int kt = 0; kt < 16; ++kt) {
    if (kt < 15) G_LOAD(kt + 1);
    const unsigned char* base = lds + (kt & 1) * G_STAGE;
    const unsigned char* ab = base + (wm * 128 + lr) * 144 + lh * 16;
    const unsigned char* bb = base + G_BOFF + (wn * 64 + lr) * 144 + lh * 16;
#pragma unroll
    for (int s = 0; s < 4; ++s) {
      bf16x8 a[4], b[2];
#pragma unroll
      for (int i = 0; i < 4; ++i) a[i] = *(const bf16x8*)(ab + i * 32 * 144 + s * 32);
#pragma unroll
      for (int j = 0; j < 2; ++j) b[j] = *(const bf16x8*)(bb + j * 32 * 144 + s * 32);
#pragma unroll
      for (int i = 0; i < 4; ++i)
#pragma unroll
        for (int j = 0; j < 2; ++j) acc[i][j] = __builtin_amdgcn_mfma_f32_32x32x16_bf16(a[i], b[j], acc[i][j], 0, 0, 0);
    }
    if (kt < 15) G_WRITE((kt + 1) & 1);
    __syncthreads();
  }
#undef G_LOAD
#undef G_WRITE
#pragma unroll
  for (int i = 0; i < 4; ++i)
#pragma unroll
    for (int j = 0; j < 2; ++j) {
      const int col = n0 + wn * 64 + j * 32 + lr;
#pragma unroll
      for (int r = 0; r < 16; ++r) {
        const int row = m0 + wm * 128 + i * 32 + (r & 3) + 8 * (r >> 2) + 4 * lh;
        if (EPI == 0) { if (col < N) ((bf16_t*)out)[(size_t)row * ldc + col] = f2bf(acc[i][j][r]); }
        else { ((float*)out)[(size_t)row * ldc + col] = resid[(size_t)row * ldc + col] + acc[i][j][r]; }
      }
    }
}

__device__ __forceinline__ void tile_map(int t, int nN, int& mi, int& ni) {
  if (nN == 16) { const int rnd = t >> 8, blk = t & 255, x = blk & 7, y = blk >> 3; mi = rnd * 16 + (x >> 1) * 4 + (y & 3); ni = (x & 1) * 8 + (y >> 2); }
  else if (nN == 4) { const int rnd = t >> 8, blk = t & 255, x = blk & 7, y = blk >> 3; mi = rnd * 64 + x * 8 + (y & 7); ni = y >> 3; }
  else { mi = t / nN; ni = t % nN; }
}

__device__ void wt_tile(const float* __restrict__ W, int N, bf16_t* __restrict__ Wt, int kt, int nt, unsigned char* lds) {
#ifdef OFF_wt_tile
  return;
#endif

  float* tl = (float*)lds;
  const int tid = opaque_tid();
  const int r = tid >> 3, c8 = (tid & 7) * 8;
  const float* src = W + (size_t)(kt * 64 + r) * N + nt * 64 + c8;
  const float4 v0 = *(const float4*)src, v1 = *(const float4*)(src + 4);
  float* d = tl + r * 65 + c8;
  d[0] = v0.x; d[1] = v0.y; d[2] = v0.z; d[3] = v0.w; d[4] = v1.x; d[5] = v1.y; d[6] = v1.z; d[7] = v1.w;
  __syncthreads();
  uint4 o;
  o.x = pack2(tl[(c8 + 0) * 65 + r], tl[(c8 + 1) * 65 + r]);
  o.y = pack2(tl[(c8 + 2) * 65 + r], tl[(c8 + 3) * 65 + r]);
  o.z = pack2(tl[(c8 + 4) * 65 + r], tl[(c8 + 5) * 65 + r]);
  o.w = pack2(tl[(c8 + 6) * 65 + r], tl[(c8 + 7) * 65 + r]);
  *(uint4*)(Wt + (size_t)(nt * 64 + r) * 1024 + kt * 64 + c8) = o;
  __syncthreads();
}

template <bool F32OUT>
__device__ void norm_rows(const float* src, const float* __restrict__ g, void* dst, int nrows, float pd = 0.f) {
#ifdef OFF_norm_rows
  return;
#endif

  const int tid = opaque_tid();
  const int lane = tid & 63;
  const int gw = blockIdx.x * 8 + (tid >> 6), nw = gridDim.x * 8;
  float4 gv[4];
#pragma unroll
  for (int i = 0; i < 4; ++i) gv[i] = *(const float4*)(g + i * 256 + lane * 4);
  for (int row = gw; row < nrows; row += nw) {
    const float* s = src + (size_t)row * 1024;
    float4 v[4]; float ss = 0.f;
#pragma unroll
    for (int i = 0; i < 4; ++i) { v[i] = *(const float4*)(s + i * 256 + lane * 4); ss += v[i].x * v[i].x + v[i].y * v[i].y + v[i].z * v[i].z + v[i].w * v[i].w; }
    ss = wave_sum(ss);
    const float rs = rsqrtf(ss * (1.0f / 1024.0f) + 1e-6f);
#pragma unroll
    for (int i = 0; i < 4; ++i) {
      const float a = v[i].x * rs * gv[i].x, b = v[i].y * rs * gv[i].y, c = v[i].z * rs * gv[i].z, d = v[i].w * rs * gv[i].w;
      if (F32OUT) { *(float4*)((float*)dst + (size_t)row * 1024 + i * 256 + lane * 4) = make_float4(a + pd, b + pd, c + pd, d + pd); }
      else { uint2 o; o.x = pack2(a, b); o.y = pack2(c, d); *(uint2*)((bf16_t*)dst + (size_t)row * 1024 + i * 256 + lane * 4) = o; }
    }
  }
}

__device__ void rwkv_prep_item(const Params& P, int l, int item, unsigned char* lds) {
#ifdef OFF_rwkv_prep_item
  return;
#endif

  const bf16_t* p = (const bf16_t*)(P.ws + WS_P);
  float* PW = (float*)(P.ws + WS_PW); bf16_t* PV = (bf16_t*)(P.ws + WS_PV); float* RK = (float*)(P.ws + WS_RK);
  float* lora = (float*)lds;
  const int tid = opaque_tid(), lane = tid & 63, w = tid >> 6, head = w & 3, sub = w >> 2;
  const int c = head * 64 + lane;
  const float* mu = P.in[4] + l * 832;
  const float mur = mu[c], muk = mu[256 + c], muv = mu[512 + c], mux = mu[768 + lane];
  const float w0 = P.in[5][l * 256 + c], a0 = P.in[7][l * 256 + c];
  const float kkw = P.in[9][l * 256 + c], kaw = P.in[10][l * 256 + c], rkw = P.in[11][l * 256 + c];
  float wup[32], aup[32];
#pragma unroll
  for (int j = 0; j < 32; ++j) { wup[j] = P.in[6][(l * 32 + j) * 256 + c]; aup[j] = P.in[8][(l * 32 + j) * 256 + c]; }
  bf16_t raw[4][8];
#define PREP_LOAD(g) { _Pragma("unroll") for (int j_ = 0; j_ < 4; ++j_) { const int t_ = item * 32 + sub + 2 * ((g) * 4 + j_); const bool hp_ = (t_ & (TSEQ - 1)) > 0; \
      const bf16_t* pr_ = p + (size_t)t_ * NIN; raw[j_][0] = pr_[c]; raw[j_][1] = pr_[256 + c]; raw[j_][2] = pr_[512 + c]; raw[j_][3] = pr_[768 + lane]; \
      raw[j_][4] = hp_ ? pr_[c - NIN] : (bf16_t)0; raw[j_][5] = hp_ ? pr_[256 + c - NIN] : (bf16_t)0; raw[j_][6] = hp_ ? pr_[512 + c - NIN] : (bf16_t)0; raw[j_][7] = hp_ ? pr_[768 + lane - NIN] : (bf16_t)0; } }
  PREP_LOAD(0);
#pragma unroll 1
  for (int g = 0; g < 4; ++g) {
    float rr[4], kk4[4], vv4[4];
#pragma unroll
    for (int j = 0; j < 4; ++j) {
      float r = bf2f(raw[j][0]), k = bf2f(raw[j][1]), v = bf2f(raw[j][2]), x = bf2f(raw[j][3]);
      r += (bf2f(raw[j][4]) - r) * mur; k += (bf2f(raw[j][5]) - k) * muk; v += (bf2f(raw[j][6]) - v) * muv; x += (bf2f(raw[j][7]) - x) * mux;
      rr[j] = r; kk4[j] = k; vv4[j] = v;
      lora[(w * 4 + j) * 64 + lane] = lane < 32 ? tanhf(x) : x;
    }
    if (g < 3) PREP_LOAD(g + 1);
    __builtin_amdgcn_s_waitcnt(0xc07f);
    __builtin_amdgcn_wave_barrier();
#pragma unroll
    for (int j = 0; j < 4; ++j) {
      const int t = item * 32 + sub + 2 * (g * 4 + j);
      const int tt = t & (TSEQ - 1), b = t >> 13;
      const float r = rr[j], k = kk4[j], v = vv4[j];
      float wv = w0, av = a0;
      const float* lo = lora + (w * 4 + j) * 64;
#pragma unroll
      for (int jj = 0; jj < 32; ++jj) { wv += lo[jj] * wup[jj]; av += lo[32 + jj] * aup[jj]; }
      const float wlog = -softplusf_(-wv) - 0.5f;
      const float decay = __expf(-__expf(wlog));
      const float ar = sigmoidf_(av);
      const float kk = k * kkw;
      const float n2 = wave_sum(kk * kk);
      const float kkn = kk / fmaxf(sqrtf(n2), 1e-12f);
      const float kmod = k * (1.0f + (ar - 1.0f) * kaw);
      const float rk = wave_sum(r * kmod * rkw);
      const size_t idx = (size_t)(b * 4 + head) * TSEQ + tt;
      PW[idx * 64 + lane] = decay;
      bf16_t* pv = PV + idx * 320;
      pv[lane] = f2bf(r); pv[64 + lane] = f2bf(kmod); pv[128 + lane] = f2bf(v); pv[192 + lane] = f2bf(-kkn); pv[256 + lane] = f2bf(kkn * ar);
      if (lane == 0) RK[idx] = rk;
    }
    __builtin_amdgcn_s_waitcnt(0xc07f);
    __builtin_amdgcn_wave_barrier();
  }
#undef PREP_LOAD
  __syncthreads();
}

#define RW_TILE_B (RW_TT * 1536)
struct RwRegs { float4 pw; uint4 pv0, pv1; };
__device__ __forceinline__ void rw_issue(const float* __restrict__ PW, const bf16_t* __restrict__ PV, size_t idx0, int tid, RwRegs& r) {
  if (tid < RW_TT * 16) { const int s = tid >> 4, q = tid & 15; r.pw = *(const float4*)(PW + (idx0 + s) * 64 + q * 4); }
  { const int c = tid; const int s = c / 40, q = c % 40; r.pv0 = *(const uint4*)(PV + (idx0 + s) * 320 + q * 8); }
  if (tid < RW_TT * 40 - NTHR) { const int c = tid + NTHR; const int s = c / 40, q = c % 40; r.pv1 = *(const uint4*)(PV + (idx0 + s) * 320 + q * 8); }
}
__device__ __forceinline__ void rw_put(float* dst, int c, const uint4 u) {
  const int s = c / 40, q = c % 40;
  const int vec = q >> 3, off = (q & 7) * 8;
  const int slot = vec == 0 ? 4 : vec == 1 ? 3 : vec == 2 ? 5 : vec == 3 ? 1 : 2;
  float* d = dst + s * 384 + slot * 64 + off;
  *(float4*)d = make_float4(__uint_as_float(u.x << 16), __uint_as_float(u.x & 0xffff0000u), __uint_as_float(u.y << 16), __uint_as_float(u.y & 0xffff0000u));
  *(float4*)(d + 4) = make_float4(__uint_as_float(u.z << 16), __uint_as_float(u.z & 0xffff0000u), __uint_as_float(u.w << 16), __uint_as_float(u.w & 0xffff0000u));
}
__device__ __forceinline__ void rw_commit(unsigned char* dstb, int tid, const RwRegs& r) {
  float* dst = (float*)dstb;
  if (tid < RW_TT * 16) { const int s = tid >> 4, q = tid & 15; *(float4*)(dst + s * 384 + q * 4) = r.pw; }
  rw_put(dst, tid, r.pv0);
  if (tid < RW_TT * 40 - NTHR) rw_put(dst, tid + NTHR, r.pv1);
}

template <int MODE>
__device__ void rwkv_scan_item(const Params& P, int l, int bh, int chunk, unsigned char* lds) {
#ifdef OFF_rwkv_scan_item
  return;
#endif

  const float* PW = (const float*)(P.ws + WS_PW); const bf16_t* PV = (const bf16_t*)(P.ws + WS_PV); const float* RK = (const float*)(P.ws + WS_RK);
  float* PQ = (float*)(P.ws + WS_PQ);
  bf16_t* p = (bf16_t*)(P.ws + WS_P);
  const int tid = opaque_tid(), lane = tid & 63, w = tid >> 6;
  const int row = w * 8 + (lane >> 3), q = lane & 7;
  const int b = bh >> 2, head = bh & 3;
  unsigned char* tile0 = lds;
  float* ybuf = (float*)(lds + 2 * RW_TILE_B);
  float* Sl = (float*)(lds + 2 * RW_TILE_B + RW_TT * 256);
  float S[8], S2[8];
#pragma unroll
  for (int e = 0; e < 8; ++e) { S[e] = 0.f; S2[e] = 0.f; }
  if (MODE == 1) {
#pragma unroll
    for (int e = 0; e < 8; ++e) S[e] = (q * 8 + e == row) ? 1.f : 0.f;
  }
  if (MODE == 0 && chunk > 0) {
    const float* Q0 = PQ + ((size_t)(bh * RW_C + 0) * 2 + 1) * 4096;
    float* cur = Sl; float* nxt = Sl + 4096;
    for (int i = tid; i < 1024; i += NTHR) *(float4*)(cur + i * 4) = *(const float4*)(Q0 + i * 4);
    float* Pl = (float*)lds;
    for (int cc = 1; cc < chunk; ++cc) {
      const float* Pm = PQ + ((size_t)(bh * RW_C + cc) * 2 + 0) * 4096;
      const float* Qm = Pm + 4096;
      __syncthreads();
      for (int i = tid; i < 1024; i += NTHR) *(float4*)(Pl + i * 4) = *(const float4*)(Pm + i * 4);
      __syncthreads();
      const int ti = w >> 1;
#pragma unroll
      for (int jj = 0; jj < 2; ++jj) {
        const int tj = (w & 1) * 2 + jj;
        f32x4 acc = {0.f, 0.f, 0.f, 0.f};
#pragma unroll
        for (int ks = 0; ks < 16; ++ks) {
          const float a = cur[(ti * 16 + (lane & 15)) * 64 + ks * 4 + (lane >> 4)];
          const float bb = Pl[(ks * 4 + (lane >> 4)) * 64 + tj * 16 + (lane & 15)];
          acc = __builtin_amdgcn_mfma_f32_16x16x4f32(a, bb, acc, 0, 0, 0);
        }
#pragma unroll
        for (int r = 0; r < 4; ++r) {
          const int rr = ti * 16 + (lane >> 4) * 4 + r, cc2 = tj * 16 + (lane & 15);
          nxt[rr * 64 + cc2] = acc[r] + Qm[rr * 64 + cc2];
        }
      }
      float* t_ = cur; cur = nxt; nxt = t_;
    }
    __syncthreads();
#pragma unroll
    for (int e = 0; e < 8; ++e) S[e] = cur[row * 64 + q * 8 + e];
    __syncthreads();
  }
  const size_t idxb = (size_t)bh * TSEQ + (size_t)chunk * RW_CL;
  const int ntile = RW_CL / RW_TT;
  RwRegs rr;
  rw_issue(PW, PV, idxb, tid, rr);
  rw_commit(tile0, tid, rr);
  const int chh = head * 64 + lane;
  const float lng = P.in[12][l * 256 + chh], lnb = P.in[13][l * 256 + chh];
  __syncthreads();
  for (int tl = 0; tl < ntile; ++tl) {
    if (tl + 1 < ntile) rw_issue(PW, PV, idxb + (size_t)(tl + 1) * RW_TT, tid, rr);
    bf16_t gpre[RW_TT / 8]; float rkpre[RW_TT / 8];
    if (MODE == 0) {
#pragma unroll
      for (int u = 0; u < RW_TT / 8; ++u) {
        const int tt = chunk * RW_CL + tl * RW_TT + w + 8 * u;
        gpre[u] = p[(size_t)(b * TSEQ + tt) * NIN + C_GA + chh];
        rkpre[u] = RK[(size_t)bh * TSEQ + tt];
      }
    }
    const float* tb = (const float*)(tile0 + (tl & 1) * RW_TILE_B);
#pragma unroll 2
    for (int s = 0; s < RW_TT; ++s) {
      const float* sp = tb + s * 384 + q * 8;
      const float4 w0 = *(const float4*)(sp), w1 = *(const float4*)(sp + 4);
      const float4 a0 = *(const float4*)(sp + 64), a1 = *(const float4*)(sp + 68);
      const float4 b0 = *(const float4*)(sp + 128), b1 = *(const float4*)(sp + 132);
      const float4 k0 = *(const float4*)(sp + 192), k1 = *(const float4*)(sp + 196);
      const float vi = tb[s * 384 + 320 + row];
      const float wv[8] = {w0.x, w0.y, w0.z, w0.w, w1.x, w1.y, w1.z, w1.w};
      const float av[8] = {a0.x, a0.y, a0.z, a0.w, a1.x, a1.y, a1.z, a1.w};
      const float bv[8] = {b0.x, b0.y, b0.z, b0.w, b1.x, b1.y, b1.z, b1.w};
      const float kv[8] = {k0.x, k0.y, k0.z, k0.w, k1.x, k1.y, k1.z, k1.w};
      if (MODE == 0) {
        float d0 = S[0] * av[0], d1 = S[1] * av[1];
#pragma unroll
        for (int e = 2; e < 8; e += 2) { d0 = fmaf(S[e], av[e], d0); d1 = fmaf(S[e + 1], av[e + 1], d1); }
        const float dot = red8(d0 + d1);
#pragma unroll
        for (int e = 0; e < 8; ++e) { S[e] = fmaf(S[e], wv[e], vi * kv[e]); S[e] = fmaf(dot, bv[e], S[e]); }
        const float4 r0 = *(const float4*)(sp + 256), r1 = *(const float4*)(sp + 260);
        const float rv[8] = {r0.x, r0.y, r0.z, r0.w, r1.x, r1.y, r1.z, r1.w};
        float y0 = S[0] * rv[0], y1 = S[1] * rv[1];
#pragma unroll
        for (int e = 2; e < 8; e += 2) { y0 = fmaf(S[e], rv[e], y0); y1 = fmaf(S[e + 1], rv[e + 1], y1); }
        const float y = red8(y0 + y1);
        if (q == 0) ybuf[s * 64 + row] = y;
      } else {
        float d0 = S[0] * av[0], d1 = S[1] * av[1], g0 = S2[0] * av[0], g1 = S2[1] * av[1];
#pragma unroll
        for (int e = 2; e < 8; e += 2) { d0 = fmaf(S[e], av[e], d0); d1 = fmaf(S[e + 1], av[e + 1], d1); g0 = fmaf(S2[e], av[e], g0); g1 = fmaf(S2[e + 1], av[e + 1], g1); }
        const float dotp = red8(d0 + d1), dotq = red8(g0 + g1);
#pragma unroll
        for (int e = 0; e < 8; ++e) { S[e] = fmaf(dotp, bv[e], S[e] * wv[e]); S2[e] = fmaf(S2[e], wv[e], vi * kv[e]); S2[e] = fmaf(dotq, bv[e], S2[e]); }
      }
    }
    if (tl + 1 < ntile) rw_commit(tile0 + ((tl + 1) & 1) * RW_TILE_B, tid, rr);
    if (MODE == 0) {
      __syncthreads();
#pragma unroll
      for (int u = 0; u < RW_TT / 8; ++u) {
        const int s = w + 8 * u;
        const int tt = chunk * RW_CL + tl * RW_TT + s;
        const float y = ybuf[s * 64 + lane];
        const float mean = wave_sum(y) * (1.0f / 64.0f);
        const float dlt = y - mean;
        const float var = wave_sum(dlt * dlt) * (1.0f / 64.0f);
        float o = dlt * rsqrtf(var + 64e-5f) * lng + lnb;
        const float vv = tb[s * 384 + 320 + lane];
        o += rkpre[u] * vv;
        p[(size_t)(b * TSEQ + tt) * NIN + C_GA + chh] = f2bf(o * siluf_(bf2f(gpre[u])));
      }
    }
    __syncthreads();
  }
  if (MODE == 1) {
    float* Pm = PQ + ((size_t)(bh * RW_C + chunk) * 2 + 0) * 4096 + row * 64 + q * 8;
    *(float4*)Pm = make_float4(S[0], S[1], S[2], S[3]); *(float4*)(Pm + 4) = make_float4(S[4], S[5], S[6], S[7]);
    *(float4*)(Pm + 4096) = make_float4(S2[0], S2[1], S2[2], S2[3]); *(float4*)(Pm + 4100) = make_float4(S2[4], S2[5], S2[6], S2[7]);
  } else if (chunk == 0) {
    float* Qm = PQ + ((size_t)(bh * RW_C + 0) * 2 + 1) * 4096 + row * 64 + q * 8;
    *(float4*)Qm = make_float4(S[0], S[1], S[2], S[3]); *(float4*)(Qm + 4) = make_float4(S[4], S[5], S[6], S[7]);
  }
  __syncthreads();
}

__device__ void conv_item(const Params& P, int l, int item, unsigned char* lds) {
#ifdef OFF_conv_item
  return;
#endif

  bf16_t* p = (bf16_t*)(P.ws + WS_P);
  float* u = (float*)lds;
  float* yb = (float*)(lds + 62 * 1024);
  const int tid = opaque_tid(), c = tid & 255, half = tid >> 8;
  const int t0 = item * 32, tt0 = t0 & (TSEQ - 1);
  for (int r = half; r < 62; r += 2) {
    const int tt = tt0 - 30 + r;
    float val = 0.f;
    if (tt >= 0) { const bf16_t* pr = p + (size_t)(t0 - 30 + r) * NIN; val = bf2f(pr[C_CVAL + c]) * sigmoidf_(bf2f(pr[C_CGLU + c])); }
    u[r * 256 + c] = val;
  }
  float wv[31];
#pragma unroll
  for (int j = 0; j < 31; ++j) wv[j] = P.in[14][(l * 31 + j) * 256 + c];
  const float bias = P.in[15][l * 256 + c];
  __syncthreads();
  for (int i = 0; i < 16; ++i) {
    const int tk = half * 16 + i;
    float acc = bias;
#pragma unroll
    for (int j = 0; j < 31; ++j) acc = fmaf(wv[j], u[(tk + j) * 256 + c], acc);
    yb[tk * 256 + c] = acc;
  }
  __syncthreads();
  const int lane = tid & 63, w = tid >> 6;
  const float4 g = *(const float4*)(P.in[16] + l * 256 + lane * 4), bb = *(const float4*)(P.in[17] + l * 256 + lane * 4);
  uint2 gpre[4];
#pragma unroll
  for (int i = 0; i < 4; ++i) gpre[i] = *(const uint2*)(p + (size_t)(t0 + w * 4 + i) * NIN + C_CGATE + lane * 4);
#pragma unroll
  for (int i = 0; i < 4; ++i) {
    const int tk = w * 4 + i;
    const float4 v = *(const float4*)(yb + tk * 256 + lane * 4);
    const float mean = wave_sum(v.x + v.y + v.z + v.w) * (1.0f / 256.0f);
    const float d0 = v.x - mean, d1 = v.y - mean, d2 = v.z - mean, d3 = v.w - mean;
    const float var = wave_sum(d0 * d0 + d1 * d1 + d2 * d2 + d3 * d3) * (1.0f / 256.0f);
    const float rs = rsqrtf(var + 1e-5f);
    bf16_t* gp = p + (size_t)(t0 + tk) * NIN + C_CGATE + lane * 4;
    const uint2 gu = gpre[i];
    const float o0 = siluf_(d0 * rs * g.x + bb.x) * siluf_(__uint_as_float(gu.x << 16));
    const float o1 = siluf_(d1 * rs * g.y + bb.y) * siluf_(__uint_as_float(gu.x & 0xffff0000u));
    const float o2 = siluf_(d2 * rs * g.z + bb.z) * siluf_(__uint_as_float(gu.y << 16));
    const float o3 = siluf_(d3 * rs * g.w + bb.w) * siluf_(__uint_as_float(gu.y & 0xffff0000u));
    uint2 o; o.x = pack2(o0, o1); o.y = pack2(o2, o3);
    *(uint2*)gp = o;
  }
  __syncthreads();
}

#define HG_WLDS 10240
__device__ __forceinline__ float hgrn_lb(const Params& P, int l, int ch) {
  if (l == 0) return 0.f;
  const float x0 = P.in[18][ch], x1 = P.in[18][256 + ch];
  return 1.0f / (1.0f + __expf(x0 - x1));
}
template <int PASS>
__device__ void hgrn_wave_item(const Params& P, int l, int wi, unsigned char* lds) {
#ifdef OFF_hgrn_wave_item
  return;
#endif

  bf16_t* p = (bf16_t*)(P.ws + WS_P);
  float* HS = (float*)(P.ws + WS_HS); float* HF = (float*)(P.ws + WS_HF);
  const int tid = opaque_tid();
  const int lane = tid & 63, w = tid >> 6;
  const int bh = wi >> 7, chunk = wi & 127, b = bh >> 2, head = bh & 3;
  float* st = (float*)(lds + w * HG_WLDS);
  float* ob = st + 2048;
  const int kg = lane & 7, vg = lane >> 3;
  const int ch = head * 64 + lane;
  const float lb = hgrn_lb(P, l, ch);
  const float ng = P.in[19][l * 256 + ch];
  float S[8][8];
  float* slot = HS + (size_t)(bh * 128 + chunk) * 4096;
  if (PASS == 1) {
#pragma unroll
    for (int i = 0; i < 8; ++i) { const float4 x0 = *(const float4*)(slot + (kg * 8 + i) * 64 + vg * 8), x1 = *(const float4*)(slot + (kg * 8 + i) * 64 + vg * 8 + 4);
      S[i][0] = x0.x; S[i][1] = x0.y; S[i][2] = x0.z; S[i][3] = x0.w; S[i][4] = x1.x; S[i][5] = x1.y; S[i][6] = x1.z; S[i][7] = x1.w; }
  } else {
#pragma unroll
    for (int i = 0; i < 8; ++i)
#pragma unroll
      for (int j = 0; j < 8; ++j) S[i][j] = 0.f;
  }
  float Fp = 1.f;
  bf16_t rf[8], ri[8], rq[8], rg[8];
  {
    const int tb0 = b * TSEQ + chunk * 64;
#pragma unroll
    for (int s = 0; s < 8; ++s) { const bf16_t* pr = p + (size_t)(tb0 + s) * NIN; rf[s] = pr[C_HF + ch]; ri[s] = pr[C_HI + ch]; if (PASS == 1) { rq[s] = pr[C_HQ + ch]; rg[s] = pr[C_HG + ch]; } }
  }
#pragma unroll 1
  for (int sub = 0; sub < 8; ++sub) {
    const int tbase = b * TSEQ + chunk * 64 + sub * 8;
    bf16_t gc[8];
#pragma unroll
    for (int s = 0; s < 8; ++s) {
      const float f = lb + (1.0f - lb) * sigmoidf_(bf2f(rf[s]));
      Fp *= f;
      st[s * 256 + lane] = f; st[s * 256 + 64 + lane] = 1.0f - f;
      if (PASS == 1) { st[s * 256 + 128 + lane] = siluf_(bf2f(rq[s])); gc[s] = rg[s]; }
      st[s * 256 + 192 + lane] = bf2f(ri[s]);
    }
    if (sub < 7) {
#pragma unroll
      for (int s = 0; s < 8; ++s) { const bf16_t* pr = p + (size_t)(tbase + 8 + s) * NIN; rf[s] = pr[C_HF + ch]; ri[s] = pr[C_HI + ch]; if (PASS == 1) { rq[s] = pr[C_HQ + ch]; rg[s] = pr[C_HG + ch]; } }
    }
    __builtin_amdgcn_s_waitcnt(0xc07f);
    __builtin_amdgcn_wave_barrier();
#pragma unroll 1
    for (int s = 0; s < 8; ++s) {
      const float* sp = st + s * 256;
      const float4 f0 = *(const float4*)(sp + kg * 8), f1 = *(const float4*)(sp + kg * 8 + 4);
      const float4 k0 = *(const float4*)(sp + 64 + kg * 8), k1 = *(const float4*)(sp + 64 + kg * 8 + 4);
      const float4 v0 = *(const float4*)(sp + 192 + vg * 8), v1 = *(const float4*)(sp + 192 + vg * 8 + 4);
      const float fv[8] = {f0.x, f0.y, f0.z, f0.w, f1.x, f1.y, f1.z, f1.w};
      const float kv[8] = {k0.x, k0.y, k0.z, k0.w, k1.x, k1.y, k1.z, k1.w};
      const float vv[8] = {v0.x, v0.y, v0.z, v0.w, v1.x, v1.y, v1.z, v1.w};
#pragma unroll
      for (int i = 0; i < 8; ++i)
#pragma unroll
        for (int j = 0; j < 8; ++j) S[i][j] = fmaf(fv[i], S[i][j], kv[i] * vv[j]);
      if (PASS == 1) {
        const float4 q0 = *(const float4*)(sp + 128 + kg * 8), q1 = *(const float4*)(sp + 128 + kg * 8 + 4);
        const float qv[8] = {q0.x, q0.y, q0.z, q0.w, q1.x, q1.y, q1.z, q1.w};
        float o[8];
#pragma unroll
        for (int j = 0; j < 8; ++j) { float a = qv[0] * S[0][j];
#pragma unroll
          for (int i = 1; i < 8; ++i) a = fmaf(qv[i], S[i][j], a);
          o[j] = red8(a); }
        if (kg == 0) { *(float4*)(ob + s * 64 + vg * 8) = make_float4(o[0], o[1], o[2], o[3]); *(float4*)(ob + s * 64 + vg * 8 + 4) = make_float4(o[4], o[5], o[6], o[7]); }
      }
    }
    __builtin_amdgcn_s_waitcnt(0xc07f);
    __builtin_amdgcn_wave_barrier();
    if (PASS == 1) {
#pragma unroll
      for (int s = 0; s < 8; ++s) {
        const float o = ob[s * 64 + lane];
        const float ms = wave_sum(o * o) * (1.0f / 64.0f);
        p[(size_t)(tbase + s) * NIN + C_HG + ch] = f2bf(o * rsqrtf(ms + 1e-6f) * ng * siluf_(bf2f(gc[s])));
      }
      __builtin_amdgcn_s_waitcnt(0xc07f);
      __builtin_amdgcn_wave_barrier();
    }
  }
  if (PASS == 0) {
#pragma unroll
    for (int i = 0; i < 8; ++i) { *(float4*)(slot + (kg * 8 + i) * 64 + vg * 8) = make_float4(S[i][0], S[i][1], S[i][2], S[i][3]);
      *(float4*)(slot + (kg * 8 + i) * 64 + vg * 8 + 4) = make_float4(S[i][4], S[i][5], S[i][6], S[i][7]); }
    HF[(size_t)(bh * 128 + chunk) * 64 + lane] = Fp;
  }
}
__device__ void hgrn_combine_item(const Params& P, int bh) {
#ifdef OFF_hgrn_combine_item
  return;
#endif

  float* HS = (float*)(P.ws + WS_HS); const float* HF = (const float*)(P.ws + WS_HF);
  const int tid = opaque_tid();
  const int krow = tid >> 3;
  float R[8];
#pragma unroll
  for (int e = 0; e < 8; ++e) R[e] = 0.f;
  float4 xa[8][2]; float fa[8];
#pragma unroll
  for (int u = 0; u < 8; ++u) { const float* sl = HS + (size_t)(bh * 128 + u) * 4096 + tid * 8; xa[u][0] = *(const float4*)sl; xa[u][1] = *(const float4*)(sl + 4); fa[u] = HF[(size_t)(bh * 128 + u) * 64 + krow]; }
#pragma unroll 1
  for (int c0 = 0; c0 < 128; c0 += 8) {
    float4 xn[8][2]; float fn[8];
    if (c0 + 8 < 128) {
#pragma unroll
      for (int u = 0; u < 8; ++u) { const float* sl = HS + (size_t)(bh * 128 + c0 + 8 + u) * 4096 + tid * 8; xn[u][0] = *(const float4*)sl; xn[u][1] = *(const float4*)(sl + 4); fn[u] = HF[(size_t)(bh * 128 + c0 + 8 + u) * 64 + krow]; }
    }
#pragma unroll
    for (int u = 0; u < 8; ++u) {
      float* sl = HS + (size_t)(bh * 128 + c0 + u) * 4096 + tid * 8;
      *(float4*)sl = make_float4(R[0], R[1], R[2], R[3]); *(float4*)(sl + 4) = make_float4(R[4], R[5], R[6], R[7]);
      const float f = fa[u];
      R[0] = fmaf(f, R[0], xa[u][0].x); R[1] = fmaf(f, R[1], xa[u][0].y); R[2] = fmaf(f, R[2], xa[u][0].z); R[3] = fmaf(f, R[3], xa[u][0].w);
      R[4] = fmaf(f, R[4], xa[u][1].x); R[5] = fmaf(f, R[5], xa[u][1].y); R[6] = fmaf(f, R[6], xa[u][1].z); R[7] = fmaf(f, R[7], xa[u][1].w);
    }
    if (c0 + 8 < 128) {
#pragma unroll
      for (int u = 0; u < 8; ++u) { xa[u][0] = xn[u][0]; xa[u][1] = xn[u][1]; fa[u] = fn[u]; }
    }
  }
}

__device__ void sb_item(const Params& P, int item, unsigned char* lds) {
#ifdef OFF_sb_item
  return;
#endif

  bf16_t* p = (bf16_t*)(P.ws + WS_P);
  const int tid = opaque_tid(), lane = tid & 63, w = tid >> 6;
  const int qt = item & 127, bh = item >> 7, b = bh >> 2, head = bh & 3;
  unsigned char* Qs = lds;
  unsigned char* Ks = lds + 9216;
  unsigned char* Vt = lds + 18432;
  unsigned char* As = lds + 27648;
  float* Zs = (float*)(lds + 36864);
  volatile int* flag = (volatile int*)(lds + 36864 + 64 * 65 * 4);
  const int lrow = tid >> 3, lch = (tid & 7);
  const size_t tokq = (size_t)b * TSEQ + qt * 64;
  *(uint4*)(Qs + lrow * 144 + lch * 16) = *(const uint4*)(p + (tokq + lrow) * NIN + C_SQ + head * 64 + lch * 8);
  float carry = 0.f;
  f32x4 oacc[2] = {{0.f, 0.f, 0.f, 0.f}, {0.f, 0.f, 0.f, 0.f}};
  const int qi = w >> 1, t2 = (w & 1) * 2;
  const int q = tid >> 3, seg = tid & 7;
  uint4 kreg = *(const uint4*)(p + (tokq + lrow) * NIN + C_SK + head * 64 + lch * 8);
  uint4 vreg = *(const uint4*)(p + (tokq + lrow) * NIN + C_SV + head * 64 + lch * 8);
  for (int kt = qt; kt >= 0; --kt) {
    __syncthreads();
    *(uint4*)(Ks + lrow * 144 + lch * 16) = kreg;
    { const unsigned vw[4] = {vreg.x, vreg.y, vreg.z, vreg.w};
#pragma unroll
      for (int e = 0; e < 8; ++e) *(unsigned short*)(Vt + (lch * 8 + e) * 144 + lrow * 2) = (unsigned short)((e & 1) ? (vw[e >> 1] >> 16) : (vw[e >> 1] & 0xffffu)); }
    if (tid == 0) *flag = 0;
    if (kt > 0) { const size_t tokn = (size_t)b * TSEQ + (kt - 1) * 64;
      kreg = *(const uint4*)(p + (tokn + lrow) * NIN + C_SK + head * 64 + lch * 8);
      vreg = *(const uint4*)(p + (tokn + lrow) * NIN + C_SV + head * 64 + lch * 8); }
    __syncthreads();
#pragma unroll
    for (int jj = 0; jj < 2; ++jj) {
      const int ki = t2 + jj;
      f32x4 acc = {0.f, 0.f, 0.f, 0.f};
#pragma unroll
      for (int s = 0; s < 2; ++s) {
        const bf16x8 a = *(const bf16x8*)(Qs + (qi * 16 + (lane & 15)) * 144 + s * 64 + (lane >> 4) * 16);
        const bf16x8 bb = *(const bf16x8*)(Ks + (ki * 16 + (lane & 15)) * 144 + s * 64 + (lane >> 4) * 16);
        acc = __builtin_amdgcn_mfma_f32_16x16x32_bf16(a, bb, acc, 0, 0, 0);
      }
#pragma unroll
      for (int r = 0; r < 4; ++r) Zs[(qi * 16 + (lane >> 4) * 4 + r) * 65 + ki * 16 + (lane & 15)] = acc[r] * 0.125f;
    }
    __syncthreads();
    {
      const int tq = qt * 64 + q;
      float z[8], lk[8];
      float tot = 0.f;
#pragma unroll
      for (int e = 0; e < 8; ++e) {
        z[e] = Zs[q * 65 + seg * 8 + e];
        const bool m = (kt * 64 + seg * 8 + e) < tq;
        lk[e] = m ? -softplusf_(z[e]) : 0.f;
        tot += lk[e];
      }
      float inc = tot;
      { float t_ = __shfl_down(inc, 1, 8); if (seg + 1 < 8) inc += t_; }
      { float t_ = __shfl_down(inc, 2, 8); if (seg + 2 < 8) inc += t_; }
      { float t_ = __shfl_down(inc, 4, 8); if (seg + 4 < 8) inc += t_; }
      const float rowtot = __shfl(inc, 0, 8);
      float tail = carry + (inc - tot);
      float av[8];
#pragma unroll
      for (int e = 7; e >= 0; --e) {
        const bool m = (kt * 64 + seg * 8 + e) < tq;
        av[e] = m ? __expf(z[e] + lk[e] + tail) : 0.f;
        tail += lk[e];
      }
      uint4 o; o.x = pack2(av[0], av[1]); o.y = pack2(av[2], av[3]); o.z = pack2(av[4], av[5]); o.w = pack2(av[6], av[7]);
      *(uint4*)(As + q * 144 + seg * 16) = o;
      carry += rowtot;
      if (carry > -100.f) *flag = 1;
    }
    __syncthreads();
#pragma unroll
    for (int jj = 0; jj < 2; ++jj) {
      const int di = t2 + jj;
#pragma unroll
      for (int s = 0; s < 2; ++s) {
        const bf16x8 a = *(const bf16x8*)(As + (qi * 16 + (lane & 15)) * 144 + s * 64 + (lane >> 4) * 16);
        const bf16x8 bb = *(const bf16x8*)(Vt + (di * 16 + (lane & 15)) * 144 + s * 64 + (lane >> 4) * 16);
        oacc[jj] = __builtin_amdgcn_mfma_f32_16x16x32_bf16(a, bb, oacc[jj], 0, 0, 0);
      }
    }
    if (*flag == 0) break;
  }
#pragma unroll
  for (int jj = 0; jj < 2; ++jj) {
    const int d = (t2 + jj) * 16 + (lane & 15);
#pragma unroll
    for (int r = 0; r < 4; ++r) {
      const int qq = qi * 16 + (lane >> 4) * 4 + r;
      bf16_t* gp = p + (tokq + qq) * NIN + C_SG + head * 64 + d;
      *gp = f2bf(oacc[jj][r] * siluf_(bf2f(*gp)));
    }
  }
  __syncthreads();
}

__device__ void xattn_item(const Params& P, int l, int item, unsigned char* lds) {
#ifdef OFF_xattn_item
  return;
#endif

  const bf16_t* qb = (const bf16_t*)(P.ws + WS_P + 32ull * MiB);
  bf16_t* ob = (bf16_t*)(P.ws + WS_P + 64ull * MiB);
  const bf16_t* kv = (const bf16_t*)(P.ws + WS_KV) + (size_t)l * 512 * 2048;
  const int tid = opaque_tid(), lane = tid & 63, w = tid >> 6;
  const int qt = item & 127, bh = item >> 7, b = bh >> 2, head = bh & 3;
  unsigned char* Qs = lds;
  unsigned char* KVs = lds + 33792;
  float* Ss = (float*)(lds + 67584);
  const size_t tok0 = (size_t)b * TSEQ + qt * 64;
  __syncthreads();
#pragma unroll
  for (int i = 0; i < 4; ++i) { const int c = tid + i * NTHR, r = c >> 5, cc = c & 31;
    *(uint4*)(Qs + r * 528 + cc * 16) = *(const uint4*)(qb + (tok0 + r) * 1024 + head * 256 + cc * 8); }
  const int qi = w >> 1, t2 = (w & 1) * 2;
  for (int kb = 0; kb < 4; ++kb) {
    __syncthreads();
#pragma unroll
    for (int i = 0; i < 4; ++i) { const int c = tid + i * NTHR, r = c >> 5, cc = c & 31;
      *(uint4*)(KVs + r * 528 + cc * 16) = *(const uint4*)(kv + (size_t)(b * 256 + kb * 64 + r) * 2048 + head * 256 + cc * 8); }
    __syncthreads();
#pragma unroll
    for (int jj = 0; jj < 2; ++jj) {
      const int ki = t2 + jj;
      f32x4 acc = {0.f, 0.f, 0.f, 0.f};
#pragma unroll
      for (int s = 0; s < 8; ++s) {
        const bf16x8 a = *(const bf16x8*)(Qs + (qi * 16 + (lane & 15)) * 528 + s * 64 + (lane >> 4) * 16);
        const bf16x8 bb = *(const bf16x8*)(KVs + (ki * 16 + (lane & 15)) * 528 + s * 64 + (lane >> 4) * 16);
        acc = __builtin_amdgcn_mfma_f32_16x16x32_bf16(a, bb, acc, 0, 0, 0);
      }
#pragma unroll
      for (int r = 0; r < 4; ++r) Ss[(qi * 16 + (lane >> 4) * 4 + r) * 260 + kb * 64 + ki * 16 + (lane & 15)] = acc[r] * 0.0625f;
    }
  }
  __syncthreads();
  {
    const int q = tid >> 3, seg = tid & 7;
    float x[32]; float mx = -3.0e38f;
#pragma unroll
    for (int i = 0; i < 8; ++i) { const float4 v = *(const float4*)(Ss + q * 260 + seg * 32 + i * 4); x[i * 4] = v.x; x[i * 4 + 1] = v.y; x[i * 4 + 2] = v.z; x[i * 4 + 3] = v.w;
      mx = fmaxf(mx, fmaxf(fmaxf(v.x, v.y), fmaxf(v.z, v.w))); }
    mx = fmaxf(mx, __shfl_xor(mx, 1)); mx = fmaxf(mx, __shfl_xor(mx, 2)); mx = fmaxf(mx, __shfl_xor(mx, 4));
    float sum = 0.f;
#pragma unroll
    for (int i = 0; i < 32; ++i) { x[i] = __expf(x[i] - mx); sum += x[i]; }
    sum += __shfl_xor(sum, 1); sum += __shfl_xor(sum, 2); sum += __shfl_xor(sum, 4);
    const float inv = 1.0f / sum;
#pragma unroll
    for (int i = 0; i < 4; ++i) { uint4 o; o.x = pack2(x[i * 8] * inv, x[i * 8 + 1] * inv); o.y = pack2(x[i * 8 + 2] * inv, x[i * 8 + 3] * inv);
      o.z = pack2(x[i * 8 + 4] * inv, x[i * 8 + 5] * inv); o.w = pack2(x[i * 8 + 6] * inv, x[i * 8 + 7] * inv);
      *(uint4*)(Qs + q * 528 + seg * 64 + i * 16) = o; }
  }
  for (int db = 0; db < 4; ++db) {
    __syncthreads();
#pragma unroll
    for (int i = 0; i < 4; ++i) { const int c = tid + i * NTHR, m = c >> 3, dc = c & 7;
      const uint4 vv = *(const uint4*)(kv + (size_t)(b * 256 + m) * 2048 + 1024 + head * 256 + db * 64 + dc * 8);
      const unsigned short* ve = (const unsigned short*)&vv;
#pragma unroll
      for (int e = 0; e < 8; ++e) *(unsigned short*)(KVs + (dc * 8 + e) * 528 + m * 2) = ve[e]; }
    __syncthreads();
#pragma unroll
    for (int jj = 0; jj < 2; ++jj) {
      const int di = t2 + jj;
      f32x4 acc = {0.f, 0.f, 0.f, 0.f};
#pragma unroll
      for (int s = 0; s < 8; ++s) {
        const bf16x8 a = *(const bf16x8*)(Qs + (qi * 16 + (lane & 15)) * 528 + s * 64 + (lane >> 4) * 16);
        const bf16x8 bb = *(const bf16x8*)(KVs + (di * 16 + (lane & 15)) * 528 + s * 64 + (lane >> 4) * 16);
        acc = __builtin_amdgcn_mfma_f32_16x16x32_bf16(a, bb, acc, 0, 0, 0);
      }
#pragma unroll
      for (int r = 0; r < 4; ++r) ob[(tok0 + qi * 16 + (lane >> 4) * 4 + r) * 1024 + head * 256 + db * 64 + di * 16 + (lane & 15)] = f2bf(acc[r]);
    }
  }
  __syncthreads();
}

__global__ void __launch_bounds__(NTHR) fwd_megakernel(Params P) {
  extern __shared__ __attribute__((aligned(16))) unsigned char lds[];
  __shared__ uint4 xb_words;
  if (threadIdx.x == 0) xb_words = make_uint4(0u, 0u, 0u, 0u);
  __syncthreads();
#ifdef PROBE_J
  __shared__ unsigned long long tacc[16];
  __shared__ unsigned long long tlast;
  __shared__ float pdelta;
  if (threadIdx.x == 0) { for (int i = 0; i < 16; ++i) tacc[i] = 0ull; tlast = __builtin_amdgcn_s_memrealtime(); pdelta = 0.f; }
#define STAMP(k) if (threadIdx.x == 0) { const unsigned long long n_ = __builtin_amdgcn_s_memrealtime(); tacc[k] += n_ - tlast; tlast = n_; }
#else
#define STAMP(k)
#endif
  XcdBarrier bar = xcd_barrier_post((unsigned*)(P.ws + WS_BAR), (volatile LAS unsigned*)&xb_words);
  if (P.never) cg::this_grid().sync();
  const int G = gridDim.x, bid = blockIdx.x;
  unsigned char* ws = P.ws;
  bf16_t* hbuf = (bf16_t*)(ws + WS_R1);
  bf16_t* pbuf = (bf16_t*)(ws + WS_P);
  bf16_t* hx = (bf16_t*)(ws + WS_P);
  bf16_t* qbuf = (bf16_t*)(ws + WS_P + 32ull * MiB);
  bf16_t* obuf = (bf16_t*)(ws + WS_P + 64ull * MiB);

  for (int it = bid; it < 2 * 2256; it += G) {
    const int l = it / 2256; int r = it % 2256;
    const float* W; int N; bf16_t* Wt; int kt, nt;
    unsigned char* wl = ws + WS_WT + l * WT_LAYER;
    if (r < 976) { W = P.in[3] + (size_t)l * 1024 * NIN; N = NIN; Wt = (bf16_t*)(wl + WT_IN); kt = r / 61; nt = r % 61; }
    else { r -= 976; const int m = r >> 8; r &= 255; kt = r >> 4; nt = r & 15; N = 1024;
      if (m == 0) { W = P.in[20] + (size_t)l * 1048576; Wt = (bf16_t*)(wl + WT_OUT); }
      else if (m == 1) { W = P.in[23] + (size_t)l * 1048576; Wt = (bf16_t*)(wl + WT_Q); }
      else if (m == 2) { W = P.in[24] + (size_t)l * 1048576; Wt = (bf16_t*)(wl + WT_KV); }
      else if (m == 3) { W = P.in[25] + (size_t)l * 1048576; Wt = (bf16_t*)(wl + WT_KV) + 1024 * 1024; }
      else { W = P.in[26] + (size_t)l * 1048576; Wt = (bf16_t*)(wl + WT_O); } }
    wt_tile(W, N, Wt, kt, nt, lds);
  }
  norm_rows<false>(P.in[1], P.in[22], (bf16_t*)(ws + WS_MEMN), 512);
  norm_rows<false>(P.in[1], P.in[22] + 1024, (bf16_t*)(ws + WS_MEMN) + 512 * 1024, 512);
  norm_rows<false>(P.in[0], P.in[2], hbuf, NT);
  xcd_barrier(bar); STAMP(0)

#pragma unroll 1
  for (int l = 0; l < 2; ++l) {
    const unsigned char* wl = ws + WS_WT + l * WT_LAYER;
    for (int t = bid; t < 1024; t += G) {
      int mi, ni; tile_map(t, 16, mi, ni);
      gemm_tile<0>(hbuf, 1024, 0, 256, 512, 768, (const bf16_t*)(wl + WT_IN), mi * 256, ni * 256, NIN, pbuf, nullptr, NIN, lds);
    }
    xcd_barrier(bar); STAMP(1)
    for (int it = bid; it < 640; it += G) {
      if (it < 128) hgrn_wave_item<0>(P, l, it * 8 + (threadIdx.x >> 6), lds);
      else rwkv_prep_item(P, l, it - 128, lds);
      __syncthreads();
    }
    xcd_barrier(bar); STAMP(2)
    {
      const int n_p1 = 8 * (RW_C - 2);
      const int n_rw = n_p1 + 8;
      const int n_oth = 8 + 512 + 1024;
      if (G > n_rw + 32) {
        if (bid < n_rw) {
          if (bid < n_p1) rwkv_scan_item<1>(P, l, bid & 7, 1 + (bid >> 3), lds);
          else rwkv_scan_item<0>(P, l, bid - n_p1, 0, lds);
        } else {
          for (int it = bid - n_rw; it < n_oth; it += G - n_rw) {
            if (it < 8) hgrn_combine_item(P, it);
            else if (it < 8 + 512) conv_item(P, l, it - 8, lds);
            else sb_item(P, it - 8 - 512, lds);
            __syncthreads();
          }
        }
      } else {
        for (int it = bid; it < n_rw + n_oth; it += G) {
          if (it < n_p1) rwkv_scan_item<1>(P, l, it & 7, 1 + (it >> 3), lds);
          else if (it < n_rw) rwkv_scan_item<0>(P, l, it - n_p1, 0, lds);
          else if (it < n_rw + 8) hgrn_combine_item(P, it - n_rw);
          else if (it < n_rw + 8 + 512) conv_item(P, l, it - n_rw - 8, lds);
          else sb_item(P, it - n_rw - 8 - 512, lds);
          __syncthreads();
        }
      }
    }
    xcd_barrier(bar); STAMP(3)
    {
      const int n_p3 = 8 * (RW_C - 1);
      const int n_all = n_p3 + 128 + 16;
      for (int it = bid; it < n_all; it += G) {
        if (it < n_p3) rwkv_scan_item<0>(P, l, it & 7, 1 + (it >> 3), lds);
        else if (it < n_p3 + 128) hgrn_wave_item<1>(P, l, (it - n_p3) * 8 + (threadIdx.x >> 6), lds);
        else { const int t = it - n_p3 - 128; gemm_tile<0>((const bf16_t*)(ws + WS_MEMN) + (size_t)l * 512 * 1024, 1024, 0, 256, 512, 768, (const bf16_t*)(wl + WT_KV), (t >> 3) * 256, (t & 7) * 256, 2048,
                                                          (bf16_t*)(ws + WS_KV) + (size_t)l * 512 * 2048, nullptr, 2048, lds); }
        __syncthreads();
      }
    }
    xcd_barrier(bar); STAMP(4)
    {
      const float* resid = l == 0 ? P.in[0] : P.out;
      for (int t = bid; t < 256; t += G) {
        int mi, ni; tile_map(t, 4, mi, ni);
        gemm_tile<1>(pbuf, NIN, C_GA, C_CGATE, C_HG, C_SG, (const bf16_t*)(wl + WT_OUT), mi * 256, ni * 256, 1024, P.out, resid, 1024, lds);
      }
    }
    xcd_barrier(bar); STAMP(5)
    norm_rows<false>(P.out, P.in[21] + l * 1024, hx, NT);
    xcd_barrier(bar); STAMP(6)
    for (int t = bid; t < 256; t += G) {
      int mi, ni; tile_map(t, 4, mi, ni);
      gemm_tile<0>(hx, 1024, 0, 256, 512, 768, (const bf16_t*)(wl + WT_Q), mi * 256, ni * 256, 1024, qbuf, nullptr, 1024, lds);
    }
    xcd_barrier(bar); STAMP(7)
    for (int it = bid; it < 1024; it += G) xattn_item(P, l, it, lds);
    xcd_barrier(bar); STAMP(8)
    for (int t = bid; t < 256; t += G) {
      int mi, ni; tile_map(t, 4, mi, ni);
      gemm_tile<1>(obuf, 1024, 0, 256, 512, 768, (const bf16_t*)(wl + WT_O), mi * 256, ni * 256, 1024, P.out, P.out, 1024, lds);
    }
    xcd_barrier(bar); STAMP(9)
    if (l == 0) { norm_rows<false>(P.out, P.in[2] + 1024, hbuf, NT); xcd_barrier(bar); STAMP(6) }
  }
#ifdef PROBE_J
  if (bid == 0) {
    if (threadIdx.x == 0) {
      unsigned long long tot = 0ull; for (int i = 0; i < 10; ++i) tot += tacc[i];
      pdelta = sqrtf(0.0128f * (float)tacc[PROBE_J] / (float)tot);
    }
    __syncthreads();
  }
  const float pd_ = (bid == 0) ? pdelta : 0.f;
  norm_rows<true>(P.out, P.in[27], P.out, NT, pd_);
  if (bid == 0 && threadIdx.x == 0) {
    const unsigned long long t0_ = __builtin_amdgcn_s_memrealtime();
    const unsigned long long w_ = 4ull * tacc[PROBE_K];
    while (__builtin_amdgcn_s_memrealtime() - t0_ < w_) __builtin_amdgcn_s_sleep(8);
  }
#else
  norm_rows<true>(P.out, P.in[27], P.out, NT);
#endif
}

extern "C" void kernel_launch(void* const* d_in, const int* in_sizes, int n_in, void* d_out, int out_size, void* d_ws, size_t ws_size, hipStream_t stream) {
  constexpr size_t kDynLds = 147456;
  static int grid_blocks = 0;
  if (!grid_blocks) {
    int dev = 0, cus = 0, per_cu = 0;
    hipGetDevice(&dev);
    hipDeviceGetAttribute(&cus, hipDeviceAttributeMultiprocessorCount, dev);
    hipFuncSetAttribute((const void*)fwd_megakernel, hipFuncAttributeMaxDynamicSharedMemorySize, (int)kDynLds);
    hipOccupancyMaxActiveBlocksPerMultiprocessor(&per_cu, fwd_megakernel, NTHR, kDynLds);
    if (per_cu < 1) per_cu = 1;
    if (per_cu > 1) per_cu = 1;
    grid_blocks = cus * per_cu;
    if (grid_blocks > 256) grid_blocks = 256;
  }
  Params p;
  memset(&p, 0, sizeof(p));
  for (int i = 0; i < 28; ++i) p.in[i] = (const float*)d_in[i];
  p.out = (float*)d_out; p.ws = (unsigned char*)d_ws; p.never = 0; p.pad = 0;
  hipMemsetAsync(d_ws, 0, XCD_BAR_WORDS * 4, stream);
  void* args[] = {&p};
  hipError_t e = hipLaunchCooperativeKernel((void*)fwd_megakernel, dim3(grid_blocks), dim3(NTHR), args, kDynLds, stream);
  if (e != hipSuccess) fprintf(stderr, "cooperative launch failed: %s (grid %d)\n", hipGetErrorString(e), grid_blocks);
}
```

```cpp
#include <hip/hip_runtime.h>
#include <hip/hip_cooperative_groups.h>
#include <stdint.h>
#include <cstdio>
#include <cstring>
namespace cg = cooperative_groups;

typedef unsigned short bf16_t;
typedef short bf16x8 __attribute__((ext_vector_type(8)));
typedef float f32x4 __attribute__((ext_vector_type(4)));
typedef float f32x16 __attribute__((ext_vector_type(16)));
typedef float f32x2 __attribute__((ext_vector_type(2)));
#define LAS __attribute__((address_space(3)))

#define NT 16384
#define TSEQ 8192
#define DM 1024
#define NIN 3904
#define NTHR 512
#define C_R 0
#define C_K 256
#define C_V 512
#define C_XW 768
#define C_GA 832
#define C_CVAL 1088
#define C_CGLU 1344
#define C_CGATE 1600
#define C_HQ 1856
#define C_HF 2112
#define C_HI 2368
#define C_HG 2624
#define C_SQ 2880
#define C_SK 3136
#define C_SV 3392
#define C_SG 3648
#define RW_C 16
#define RW_CL (TSEQ / RW_C)
#define RW_TT 16

#define MiB (1024ull * 1024ull)
#define WS_BAR   0ull
#define WS_WT    (1ull * MiB)
#define WT_LAYER (18ull * MiB)
#define WT_IN    0ull
#define WT_OUT   (8ull * MiB)
#define WT_Q     (10ull * MiB)
#define WT_KV    (12ull * MiB)
#define WT_O     (16ull * MiB)
#define WS_MEMN  (37ull * MiB)
#define WS_KV    (39ull * MiB)
#define WS_PQ    (43ull * MiB)
#define WS_HS    (47ull * MiB)
#define WS_HF    (63ull * MiB)
#define WS_RK    (63ull * MiB + 512ull * 1024ull)
#define WS_R1    (64ull * MiB)
#define WS_PW    WS_R1
#define WS_PV    (WS_R1 + 16ull * MiB)
#define WS_P     (120ull * MiB)
#define WS_END   (243ull * MiB)

struct Params {
  const float* in[28];
  float* out;
  unsigned char* ws;
  int never;
  int pad;
};

__device__ __forceinline__ int opaque_tid() { int t = threadIdx.x; asm volatile("" : "+v"(t)); return t; }
__device__ __forceinline__ float bf2f(bf16_t v) { return __uint_as_float(((unsigned)v) << 16); }
__device__ __forceinline__ bf16_t f2bf(float f) {
  unsigned u = __float_as_uint(f);
  u += 0x7fffu + ((u >> 16) & 1u);
  return (bf16_t)(u >> 16);
}
__device__ __forceinline__ unsigned pack2(float a, float b) { return (unsigned)f2bf(a) | ((unsigned)f2bf(b) << 16); }
__device__ __forceinline__ float sigmoidf_(float x) { return 1.0f / (1.0f + __expf(-x)); }
__device__ __forceinline__ float siluf_(float x) { return x / (1.0f + __expf(-x)); }
__device__ __forceinline__ float softplusf_(float x) { return fmaxf(x, 0.f) + log1pf(__expf(-fabsf(x))); }
__device__ __forceinline__ float softplus_fast(float x) { return fmaxf(x, 0.f) + __logf(1.0f + __expf(-fabsf(x))); }
__device__ __forceinline__ float dpp_add(float v, const int ctrl_sel) {
  return v;
}
__device__ __forceinline__ float wave_sum(float v) {
  v += __builtin_bit_cast(float, __builtin_amdgcn_update_dpp(0, __builtin_bit_cast(int, v), 0xB1, 0xF, 0xF, true));
  v += __builtin_bit_cast(float, __builtin_amdgcn_update_dpp(0, __builtin_bit_cast(int, v), 0x4E, 0xF, 0xF, true));
  v += __builtin_bit_cast(float, __builtin_amdgcn_update_dpp(0, __builtin_bit_cast(int, v), 0x141, 0xF, 0xF, true));
  v += __builtin_bit_cast(float, __builtin_amdgcn_update_dpp(0, __builtin_bit_cast(int, v), 0x140, 0xF, 0xF, true));
  v += __shfl_xor(v, 16);
  v += __shfl_xor(v, 32);
  return v;
}
__device__ __forceinline__ float red8(float v) {
  v += __builtin_bit_cast(float, __builtin_amdgcn_update_dpp(0, __builtin_bit_cast(int, v), 0xB1, 0xF, 0xF, true));
  v += __builtin_bit_cast(float, __builtin_amdgcn_update_dpp(0, __builtin_bit_cast(int, v), 0x4E, 0xF, 0xF, true));
  v += __builtin_bit_cast(float, __builtin_amdgcn_update_dpp(0, __builtin_bit_cast(int, v), 0x141, 0xF, 0xF, true));
  return v;
}

#define XB_TMO      128
#define XB_XCNT(j)  (256  + 64 * (j))
#define XB_XSUB(j)  (1280 + 64 * (j))
#define XB_XGEN(j)  (2304 + 64 * (j))
#define XB_TOP      3328
#define XB_TOPGEN   3392
#define XCD_BAR_WORDS 3456
#define XB_SPIN_CAP (1u << 22)
__device__ __forceinline__ unsigned xb_ld(unsigned* p) { return __hip_atomic_load(p, __ATOMIC_RELAXED, __HIP_MEMORY_SCOPE_AGENT); }
__device__ __forceinline__ unsigned xb_add(unsigned* p, unsigned v) { return __hip_atomic_fetch_add(p, v, __ATOMIC_RELAXED, __HIP_MEMORY_SCOPE_AGENT); }
__device__ __forceinline__ unsigned xb_xcc_id() { return (unsigned)__builtin_amdgcn_s_getreg((3 << 11) | 20) & 0xFu; }
#define XB_SPIN(cond, bar) do { unsigned _sp = 0; while (cond) { __builtin_amdgcn_s_sleep(1); \
    if ((++_sp & 255u) == 0u) { if (xb_ld(&(bar)[XB_TMO])) break; if (_sp > XB_SPIN_CAP) { atomicAdd(&(bar)[XB_TMO], 1u); break; } } } } while (0)
struct XcdBarrier { unsigned* bar; unsigned x; volatile LAS unsigned* st; };
__device__ __forceinline__ XcdBarrier xcd_barrier_post(unsigned* bar, volatile LAS unsigned* st) {
  XcdBarrier b; b.bar = bar; b.x = xb_xcc_id(); b.st = st;
  if (threadIdx.x == 0) (void)xb_add(&bar[XB_XCNT(b.x)], 1u);
  return b;
}
__device__ __forceinline__ void xcd_barrier_complete(unsigned* bar, unsigned x, unsigned& nloc, unsigned& nx) {
  const unsigned G = gridDim.x * gridDim.y * gridDim.z;
  unsigned sum, cnt, mine, sp = 0u;
  for (;;) {
    sum = 0u; cnt = 0u; mine = 0u;
#pragma unroll
    for (unsigned j = 0; j < 16; ++j) { const unsigned c = xb_ld(&bar[XB_XCNT(j)]); sum += c; cnt += (c > 0u) ? 1u : 0u; mine = (j == x) ? c : mine; }
    if (sum == G) break;
    __builtin_amdgcn_s_sleep(1);
    if ((++sp & 255u) == 0u) { if (xb_ld(&bar[XB_TMO])) break; if (sp > XB_SPIN_CAP) { atomicAdd(&bar[XB_TMO], 1u); break; } }
  }
  nloc = mine > 0u ? mine : 1u; nx = cnt > 0u ? cnt : 1u;
}
__device__ __forceinline__ void xcd_barrier(const XcdBarrier& b) {
  asm volatile("s_waitcnt vmcnt(0)" ::: "memory");
  __syncthreads();
  if (threadIdx.x == 0) {
    unsigned* bar = b.bar;
    __builtin_amdgcn_s_waitcnt(0);
    unsigned nloc = b.st[0], nx = b.st[1];
    if (nloc == 0u) { xcd_barrier_complete(bar, b.x, nloc, nx); b.st[0] = nloc; b.st[1] = nx; }
    const unsigned old = xb_add(&bar[XB_XSUB(b.x)], 1u);
    const unsigned gen = old / nloc;
    if (old + 1u == (gen + 1u) * nloc) {
      __builtin_amdgcn_fence(__ATOMIC_RELEASE, "agent");
      asm volatile("s_waitcnt vmcnt(0)" ::: "memory");
      const unsigned og = xb_add(&bar[XB_TOP], 1u);
      const unsigned tg = og / nx;
      if (og + 1u == (tg + 1u) * nx) xb_add(&bar[XB_TOPGEN], 1u);
      else XB_SPIN(xb_ld(&bar[XB_TOPGEN]) == tg, bar);
      __builtin_amdgcn_fence(__ATOMIC_ACQUIRE, "agent");
      xb_add(&bar[XB_XGEN(b.x)], 1u);
      asm volatile("s_waitcnt vmcnt(0)" ::: "memory");
    } else {
      XB_SPIN(xb_ld(&bar[XB_XGEN(b.x)]) == gen, bar);
      __builtin_amdgcn_fence(__ATOMIC_ACQUIRE, "agent");
      asm volatile("s_waitcnt vmcnt(0)" ::: "memory");
    }
  }
  __syncthreads();
}

#define G_STAGE 73728
#define G_BOFF 36864
template <int EPI>
__device__ __forceinline__ void gemm_tile(const bf16_t* __restrict__ A, int lda, int ao0, int ao1, int ao2, int ao3,
                                          const bf16_t* __restrict__ Bt, int m0, int n0, int N,
                                          void* out, const float* resid, int ldc, unsigned char* lds) {
#ifdef OFF_gemm_tile
  return;
#endif

  const int tid = opaque_tid(), lane = tid & 63, w = tid >> 6;
  const int wm = w >> 2, wn = w & 3, lr = lane & 31, lh = lane >> 5;
  f32x16 acc[4][2];
#pragma unroll
  for (int i = 0; i < 4; ++i)
#pragma unroll
    for (int j = 0; j < 2; ++j)
#pragma unroll
      for (int r = 0; r < 16; ++r) acc[i][j][r] = 0.f;
  uint4 ra[4], rb[4];
  const int crow = tid >> 3, ccol = (tid & 7) * 8;
  const bf16_t* Ap = A + (size_t)(m0 + crow) * lda + ccol;
  const bf16_t* Bp = Bt + (size_t)(n0 + crow) * 1024 + ccol;
#define G_LOAD(kt) { const int k0_ = (kt) * 64; const int seg_ = k0_ >> 8; const int ao_ = (seg_ == 0 ? ao0 : seg_ == 1 ? ao1 : seg_ == 2 ? ao2 : ao3) + (k0_ & 255); \
    _Pragma("unroll") for (int i_ = 0; i_ < 4; ++i_) { ra[i_] = *(const uint4*)(Ap + (size_t)(i_ * 64) * lda + ao_); rb[i_] = *(const uint4*)(Bp + (size_t)(i_ * 64) * 1024 + k0_); } }
#define G_WRITE(buf) { unsigned char* b_ = lds + (buf) * G_STAGE + crow * 144 + (tid & 7) * 16; \
    _Pragma("unroll") for (int i_ = 0; i_ < 4; ++i_) { *(uint4*)(b_ + i_ * 64 * 144) = ra[i_]; *(uint4*)(b_ + G_BOFF + i_ * 64 * 144) = rb[i_]; } }
  G_LOAD(0); G_WRITE(0); __syncthreads();
  for (int kt = 0; kt < 16; ++kt) {
    if (kt < 15) G_LOAD(kt + 1);
    const unsigned char* base = lds + (kt & 1) * G_STAGE;
    const unsigned char* ab = base + (wm * 128 + lr) * 144 + lh * 16;
    const unsigned char* bb = base + G_BOFF + (wn * 64 + lr) * 144 + lh * 16;
#pragma unroll
    for (int s = 0; s < 4; ++s) {
      bf16x8 a[4], b[2];
#pragma unroll
      for (int i = 0; i < 4; ++i) a[i] = *(const bf16x8*)(ab + i * 32 * 144 + s * 32);
#pragma unroll
      for (int j = 0; j < 2; ++j) b[j] = *(const bf16x8*)(bb + j * 32 * 144 + s * 32);
#pragma unroll
      for (int i = 0; i < 4; ++i)
#pragma unroll
        for (int j = 0; j < 2; ++j) acc[i][j] = __builtin_amdgcn_mfma_f32_32x32x16_bf16(a[i], b[j], acc[i][j], 0, 0, 0);
    }
    if (kt < 15) G_WRITE((kt + 1) & 1);
    __syncthreads();
  }
#undef G_LOAD
#undef G_WRITE
#pragma unroll
  for (int i = 0; i < 4; ++i)
#pragma unroll
    for (int j = 0; j < 2; ++j) {
      const int col = n0 + wn * 64 + j * 32 + lr;
#pragma unroll
      for (int r = 0; r < 16; ++r) {
        const int row = m0 + wm * 128 + i * 32 + (r & 3) + 8 * (r >> 2) + 4 * lh;
        if (EPI == 0) { if (col < N) ((bf16_t*)out)[(size_t)row * ldc + col] = f2bf(acc[i][j][r]); }
        else { ((float*)out)[(size_t)row * ldc + col] = resid[(size_t)row * ldc + col] + acc[i][j][r]; }
      }
    }
}

__device__ __forceinline__ void tile_map(int t, int nN, int& mi, int& ni) {
  if (nN == 16) { const int rnd = t >> 8, blk = t & 255, x = blk & 7, y = blk >> 3; mi = rnd * 16 + (x >> 1) * 4 + (y & 3); ni = (x & 1) * 8 + (y >> 2); }
  else if (nN == 4) { const int rnd = t >> 8, blk = t & 255, x = blk & 7, y = blk >> 3; mi = rnd * 64 + x * 8 + (y & 7); ni = y >> 3; }
  else { mi = t / nN; ni = t % nN; }
}

__device__ void wt_tile(const float* __restrict__ W, int N, bf16_t* __restrict__ Wt, int kt, int nt, unsigned char* lds) {
#ifdef OFF_wt_tile
  return;
#endif

  float* tl = (float*)lds;
  const int tid = opaque_tid();
  const int r = tid >> 3, c8 = (tid & 7) * 8;
  const float* src = W + (size_t)(kt * 64 + r) * N + nt * 64 + c8;
  const float4 v0 = *(const float4*)src, v1 = *(const float4*)(src + 4);
  float* d = tl + r * 65 + c8;
  d[0] = v0.x; d[1] = v0.y; d[2] = v0.z; d[3] = v0.w; d[4] = v1.x; d[5] = v1.y; d[6] = v1.z; d[7] = v1.w;
  __syncthreads();
  uint4 o;
  o.x = pack2(tl[(c8 + 0) * 65 + r], tl[(c8 + 1) * 65 + r]);
  o.y = pack2(tl[(c8 + 2) * 65 + r], tl[(c8 + 3) * 65 + r]);
  o.z = pack2(tl[(c8 + 4) * 65 + r], tl[(c8 + 5) * 65 + r]);
  o.w = pack2(tl[(c8 + 6) * 65 + r], tl[(c8 + 7) * 65 + r]);
  *(uint4*)(Wt + (size_t)(nt * 64 + r) * 1024 + kt * 64 + c8) = o;
  __syncthreads();
}

template <bool F32OUT>
__device__ void norm_rows(const float* src, const float* __restrict__ g, void* dst, int nrows, float pd = 0.f) {
#ifdef OFF_norm_rows
  return;
#endif

  const int tid = opaque_tid();
  const int lane = tid & 63;
  const int gw = blockIdx.x * 8 + (tid >> 6), nw = gridDim.x * 8;
  float4 gv[4];
#pragma unroll
  for (int i = 0; i < 4; ++i) gv[i] = *(const float4*)(g + i * 256 + lane * 4);
  for (int row = gw; row < nrows; row += nw) {
    const float* s = src + (size_t)row * 1024;
    float4 v[4]; float ss = 0.f;
#pragma unroll
    for (int i = 0; i < 4; ++i) { v[i] = *(const float4*)(s + i * 256 + lane * 4); ss += v[i].x * v[i].x + v[i].y * v[i].y + v[i].z * v[i].z + v[i].w * v[i].w; }
    ss = wave_sum(ss);
    const float rs = rsqrtf(ss * (1.0f / 1024.0f) + 1e-6f);
#pragma unroll
    for (int i = 0; i < 4; ++i) {
      const float a = v[i].x * rs * gv[i].x, b = v[i].y * rs * gv[i].y, c = v[i].z * rs * gv[i].z, d = v[i].w * rs * gv[i].w;
      if (F32OUT) { *(float4*)((float*)dst + (size_t)row * 1024 + i * 256 + lane * 4) = make_float4(a + pd, b + pd, c + pd, d + pd); }
      else { uint2 o; o.x = pack2(a, b); o.y = pack2(c, d); *(uint2*)((bf16_t*)dst + (size_t)row * 1024 + i * 256 + lane * 4) = o; }
    }
  }
}

__device__ void rwkv_prep_item(const Params& P, int l, int item, unsigned char* lds) {
#ifdef OFF_rwkv_prep_item
  return;
#endif

  const bf16_t* p = (const bf16_t*)(P.ws + WS_P);
  float* PW = (float*)(P.ws + WS_PW); bf16_t* PV = (bf16_t*)(P.ws + WS_PV); float* RK = (float*)(P.ws + WS_RK);
  float* lora = (float*)lds;
  const int tid = opaque_tid(), lane = tid & 63, w = tid >> 6, head = w & 3, sub = w >> 2;
  const int c = head * 64 + lane;
  const float* mu = P.in[4] + l * 832;
  const float mur = mu[c], muk = mu[256 + c], muv = mu[512 + c], mux = mu[768 + lane];
  const float w0 = P.in[5][l * 256 + c], a0 = P.in[7][l * 256 + c];
  const float kkw = P.in[9][l * 256 + c], kaw = P.in[10][l * 256 + c], rkw = P.in[11][l * 256 + c];
  float wup[32], aup[32];
#pragma unroll
  for (int j = 0; j < 32; ++j) { wup[j] = P.in[6][(l * 32 + j) * 256 + c]; aup[j] = P.in[8][(l * 32 + j) * 256 + c]; }
  bf16_t raw[4][8];
#define PREP_LOAD(g) { _Pragma("unroll") for (int j_ = 0; j_ < 4; ++j_) { const int t_ = item * 32 + sub + 2 * ((g) * 4 + j_); const bool hp_ = (t_ & (TSEQ - 1)) > 0; \
      const bf16_t* pr_ = p + (size_t)t_ * NIN; raw[j_][0] = pr_[c]; raw[j_][1] = pr_[256 + c]; raw[j_][2] = pr_[512 + c]; raw[j_][3] = pr_[768 + lane]; \
      raw[j_][4] = hp_ ? pr_[c - NIN] : (bf16_t)0; raw[j_][5] = hp_ ? pr_[256 + c - NIN] : (bf16_t)0; raw[j_][6] = hp_ ? pr_[512 + c - NIN] : (bf16_t)0; raw[j_][7] = hp_ ? pr_[768 + lane - NIN] : (bf16_t)0; } }
  PREP_LOAD(0);
#pragma unroll 1
  for (int g = 0; g < 4; ++g) {
    float rr[4], kk4[4], vv4[4];
#pragma unroll
    for (int j = 0; j < 4; ++j) {
      float r = bf2f(raw[j][0]), k = bf2f(raw[j][1]), v = bf2f(raw[j][2]), x = bf2f(raw[j][3]);
      r += (bf2f(raw[j][4]) - r) * mur; k += (bf2f(raw[j][5]) - k) * muk; v += (bf2f(raw[j][6]) - v) * muv; x += (bf2f(raw[j][7]) - x) * mux;
      rr[j] = r; kk4[j] = k; vv4[j] = v;
      lora[(w * 4 + j) * 64 + lane] = lane < 32 ? tanhf(x) : x;
    }
    if (g < 3) PREP_LOAD(g + 1);
    __builtin_amdgcn_s_waitcnt(0xc07f);
    __builtin_amdgcn_wave_barrier();
#pragma unroll
    for (int j = 0; j < 4; ++j) {
      const int t = item * 32 + sub + 2 * (g * 4 + j);
      const int tt = t & (TSEQ - 1), b = t >> 13;
      const float r = rr[j], k = kk4[j], v = vv4[j];
      float wv = w0, av = a0;
      const float* lo = lora + (w * 4 + j) * 64;
#pragma unroll
      for (int jj = 0; jj < 32; ++jj) { wv += lo[jj] * wup[jj]; av += lo[32 + jj] * aup[jj]; }
      const float wlog = -softplusf_(-wv) - 0.5f;
      const float decay = __expf(-__expf(wlog));
      const float ar = sigmoidf_(av);
      const float kk = k * kkw;
      const float n2 = wave_sum(kk * kk);
      const float kkn = kk / fmaxf(sqrtf(n2), 1e-12f);
      const float kmod = k * (1.0f + (ar - 1.0f) * kaw);
      const float rk = wave_sum(r * kmod * rkw);
      const size_t idx = (size_t)(b * 4 + head) * TSEQ + tt;
      PW[idx * 64 + lane] = decay;
      bf16_t* pv = PV + idx * 320;
      pv[lane] = f2bf(r); pv[64 + lane] = f2bf(kmod); pv[128 + lane] = f2bf(v); pv[192 + lane] = f2bf(-kkn); pv[256 + lane] = f2bf(kkn * ar);
      if (lane == 0) RK[idx] = rk;
    }
    __builtin_amdgcn_s_waitcnt(0xc07f);
    __builtin_amdgcn_wave_barrier();
  }
#undef PREP_LOAD
  __syncthreads();
}

#define RW_TILE_B (RW_TT * 1536)
struct RwRegs { float4 pw; uint4 pv0, pv1; };
__device__ __forceinline__ void rw_issue(const float* __restrict__ PW, const bf16_t* __restrict__ PV, size_t idx0, int tid, RwRegs& r) {
  if (tid < RW_TT * 16) { const int s = tid >> 4, q = tid & 15; r.pw = *(const float4*)(PW + (idx0 + s) * 64 + q * 4); }
  { const int c = tid; const int s = c / 40, q = c % 40; r.pv0 = *(const uint4*)(PV + (idx0 + s) * 320 + q * 8); }
  if (tid < RW_TT * 40 - NTHR) { const int c = tid + NTHR; const int s = c / 40, q = c % 40; r.pv1 = *(const uint4*)(PV + (idx0 + s) * 320 + q * 8); }
}
__device__ __forceinline__ void rw_put(float* dst, int c, const uint4 u) {
  const int s = c / 40, q = c % 40;
  const int vec = q >> 3, off = (q & 7) * 8;
  const int slot = vec == 0 ? 4 : vec == 1 ? 3 : vec == 2 ? 5 : vec == 3 ? 1 : 2;
  float* d = dst + s * 384 + slot * 64 + off;
  *(float4*)d = make_float4(__uint_as_float(u.x << 16), __uint_as_float(u.x & 0xffff0000u), __uint_as_float(u.y << 16), __uint_as_float(u.y & 0xffff0000u));
  *(float4*)(d + 4) = make_float4(__uint_as_float(u.z << 16), __uint_as_float(u.z & 0xffff0000u), __uint_as_float(u.w << 16), __uint_as_float(u.w & 0xffff0000u));
}
__device__ __forceinline__ void rw_commit(unsigned char* dstb, int tid, const RwRegs& r) {
  float* dst = (float*)dstb;
  if (tid < RW_TT * 16) { const int s = tid >> 4, q = tid & 15; *(float4*)(dst + s * 384 + q * 4) = r.pw; }
  rw_put(dst, tid, r.pv0);
  if (tid < RW_TT * 40 - NTHR) rw_put(dst, tid + NTHR, r.pv1);
}

#define LD8(dst, ptr) { const float4 x0_ = *(const float4*)(ptr), x1_ = *(const float4*)((ptr) + 4); dst[0] = (f32x2){x0_.x, x0_.y}; dst[1] = (f32x2){x0_.z, x0_.w}; dst[2] = (f32x2){x1_.x, x1_.y}; dst[3] = (f32x2){x1_.z, x1_.w}; }
template <int MODE>
__device__ void rwkv_scan_item(const Params& P, int l, int bh, int chunk, unsigned char* lds) {
  const float* PW = (const float*)(P.ws + WS_PW); const bf16_t* PV = (const bf16_t*)(P.ws + WS_PV); const float* RK = (const float*)(P.ws + WS_RK);
  float* PQ = (float*)(P.ws + WS_PQ);
  bf16_t* p = (bf16_t*)(P.ws + WS_P);
  const int tid = opaque_tid(), lane = tid & 63, w = tid >> 6;
  const int q = lane & 7;
  const int rowA = (MODE == 0) ? ((w & 3) * 16 + (lane >> 3)) : (w * 8 + (lane >> 3));
  const int rowB = rowA + 8;
  const int b = bh >> 2, head = bh & 3;
  unsigned char* tile0 = lds;
  float* ybuf = (float*)(lds + 3 * RW_TILE_B);
  float* Sl = (float*)(lds + 3 * RW_TILE_B + 2 * RW_TT * 256);
  f32x2 SA[4], SB[4];
#pragma unroll
  for (int e = 0; e < 4; ++e) { SA[e] = (f32x2){0.f, 0.f}; SB[e] = (f32x2){0.f, 0.f}; }
  if (MODE == 1) {
#pragma unroll
    for (int e = 0; e < 4; ++e) SA[e] = (f32x2){(q * 8 + 2 * e == rowA) ? 1.f : 0.f, (q * 8 + 2 * e + 1 == rowA) ? 1.f : 0.f};
  }
  if (MODE == 0 && chunk > 0) {
    const float* Q0 = PQ + ((size_t)(bh * RW_C + 0) * 2 + 1) * 4096;
    float* cur = Sl; float* nxt = Sl + 4096;
    for (int i = tid; i < 1024; i += NTHR) *(float4*)(cur + i * 4) = *(const float4*)(Q0 + i * 4);
    float* Pl = (float*)lds;
    float4 pre0 = make_float4(0.f, 0.f, 0.f, 0.f), pre1 = pre0;
    if (chunk > 1) { const float* Pm = PQ + ((size_t)(bh * RW_C + 1) * 2 + 0) * 4096; pre0 = *(const float4*)(Pm + tid * 4); pre1 = *(const float4*)(Pm + (tid + NTHR) * 4); }
    for (int cc = 1; cc < chunk; ++cc) {
      const float* Pm = PQ + ((size_t)(bh * RW_C + cc) * 2 + 0) * 4096;
      const float* Qm = Pm + 4096;
      __syncthreads();
      *(float4*)(Pl + tid * 4) = pre0; *(float4*)(Pl + (tid + NTHR) * 4) = pre1;
      if (cc + 1 < chunk) { const float* Pn = Pm + 8192; pre0 = *(const float4*)(Pn + tid * 4); pre1 = *(const float4*)(Pn + (tid + NTHR) * 4); }
      const int ti = w >> 1;
      float qv[2][4];
#pragma unroll
      for (int jj = 0; jj < 2; ++jj)
#pragma unroll
        for (int r = 0; r < 4; ++r) qv[jj][r] = Qm[(ti * 16 + (lane >> 4) * 4 + r) * 64 + ((w & 1) * 2 + jj) * 16 + (lane & 15)];
      __syncthreads();
#pragma unroll
      for (int jj = 0; jj < 2; ++jj) {
        const int tj = (w & 1) * 2 + jj;
        f32x4 acc = {qv[jj][0], qv[jj][1], qv[jj][2], qv[jj][3]};
#pragma unroll
        for (int ks = 0; ks < 16; ++ks) {
          const float a = cur[(ti * 16 + (lane & 15)) * 64 + ks * 4 + (lane >> 4)];
          const float bb = Pl[(ks * 4 + (lane >> 4)) * 64 + tj * 16 + (lane & 15)];
          acc = __builtin_amdgcn_mfma_f32_16x16x4f32(a, bb, acc, 0, 0, 0);
        }
#pragma unroll
        for (int r = 0; r < 4; ++r) nxt[(ti * 16 + (lane >> 4) * 4 + r) * 64 + tj * 16 + (lane & 15)] = acc[r];
      }
      float* t_ = cur; cur = nxt; nxt = t_;
    }
    __syncthreads();
    LD8(SA, cur + rowA * 64 + q * 8);
    LD8(SB, cur + rowB * 64 + q * 8);
    __syncthreads();
  }
  const size_t idxb = (size_t)bh * TSEQ + (size_t)chunk * RW_CL;
  const int ntile = RW_CL / RW_TT;
  RwRegs rr;
  rw_issue(PW, PV, idxb, tid, rr);
  rw_commit(tile0, tid, rr);
  const int chh = head * 64 + lane;
  const float lng = P.in[12][l * 256 + chh], lnb = P.in[13][l * 256 + chh];
  f32x4 gnx = {0.f, 0.f, 0.f, 0.f}, gcu = {0.f, 0.f, 0.f, 0.f}, rknx = {0.f, 0.f, 0.f, 0.f}, rkcu = {0.f, 0.f, 0.f, 0.f};
  __syncthreads();
  const int nit = (MODE == 0) ? ntile + 1 : ntile;
  for (int tl = 0; tl < nit; ++tl) {
    if (tl + 1 < ntile) rw_issue(PW, PV, idxb + (size_t)(tl + 1) * RW_TT, tid, rr);
    if (MODE == 1 || w < 4) {
      if (tl < ntile) {
        const float* tb = (const float*)(tile0 + (tl % 3) * RW_TILE_B);
        float* yb = ybuf + (tl & 1) * (RW_TT * 64);
#pragma unroll 2
        for (int s = 0; s < RW_TT; ++s) {
          const float* sp = tb + s * 384 + q * 8;
          f32x2 wv[4], av[4], bv[4], kv[4];
          LD8(wv, sp); LD8(av, sp + 64); LD8(bv, sp + 128); LD8(kv, sp + 192);
          const float vA = tb[s * 384 + 320 + rowA];
          if (MODE == 0) {
            const float vB = tb[s * 384 + 320 + rowB];
            f32x2 dA = SA[0] * av[0], dB = SB[0] * av[0];
#pragma unroll
            for (int e = 1; e < 4; ++e) { dA = SA[e] * av[e] + dA; dB = SB[e] * av[e] + dB; }
            const float dotA = red8(dA.x + dA.y), dotB = red8(dB.x + dB.y);
            const f32x2 vA2 = {vA, vA}, vB2 = {vB, vB}, dA2 = {dotA, dotA}, dB2 = {dotB, dotB};
#pragma unroll
            for (int e = 0; e < 4; ++e) { SA[e] = SA[e] * wv[e] + vA2 * kv[e]; SA[e] = dA2 * bv[e] + SA[e]; SB[e] = SB[e] * wv[e] + vB2 * kv[e]; SB[e] = dB2 * bv[e] + SB[e]; }
            f32x2 rv[4]; LD8(rv, sp + 256);
            f32x2 yA = SA[0] * rv[0], yB = SB[0] * rv[0];
#pragma unroll
            for (int e = 1; e < 4; ++e) { yA = SA[e] * rv[e] + yA; yB = SB[e] * rv[e] + yB; }
            const float ya = red8(yA.x + yA.y), ybv = red8(yB.x + yB.y);
            if (q == 0) { yb[s * 64 + rowA] = ya; yb[s * 64 + rowB] = ybv; }
          } else {
            f32x2 dA = SA[0] * av[0], dB = SB[0] * av[0];
#pragma unroll
            for (int e = 1; e < 4; ++e) { dA = SA[e] * av[e] + dA; dB = SB[e] * av[e] + dB; }
            const float dotp = red8(dA.x + dA.y), dotq = red8(dB.x + dB.y);
            const f32x2 vA2 = {vA, vA}, dA2 = {dotp, dotp}, dB2 = {dotq, dotq};
#pragma unroll
            for (int e = 0; e < 4; ++e) { SA[e] = dA2 * bv[e] + SA[e] * wv[e]; SB[e] = SB[e] * wv[e] + vA2 * kv[e]; SB[e] = dB2 * bv[e] + SB[e]; }
          }
        }
      }
    } else {
      const int fw = w - 4;
      if (tl < ntile) {
#pragma unroll
        for (int u = 0; u < 4; ++u) { const int tt = chunk * RW_CL + tl * RW_TT + fw + 4 * u;
          gnx[u] = bf2f(p[(size_t)(b * TSEQ + tt) * NIN + C_GA + chh]); rknx[u] = RK[(size_t)bh * TSEQ + tt]; }
      }
      if (tl > 0) {
        const float* tb = (const float*)(tile0 + ((tl - 1) % 3) * RW_TILE_B);
        const float* yb = ybuf + ((tl - 1) & 1) * (RW_TT * 64);
#pragma unroll
        for (int u = 0; u < 4; ++u) {
          const int s = fw + 4 * u;
          const int tt = chunk * RW_CL + (tl - 1) * RW_TT + s;
          const float y = yb[s * 64 + lane];
          const float mean = wave_sum(y) * (1.0f / 64.0f);
          const float dlt = y - mean;
          const float var = wave_sum(dlt * dlt) * (1.0f / 64.0f);
          float o = dlt * rsqrtf(var + 64e-5f) * lng + lnb;
          const float vv = tb[s * 384 + 320 + lane];
          o += rkcu[u] * vv;
          p[(size_t)(b * TSEQ + tt) * NIN + C_GA + chh] = f2bf(o * siluf_(gcu[u]));
        }
      }
      gcu = gnx; rkcu = rknx;
    }
    if (tl + 1 < ntile) rw_commit(tile0 + ((tl + 1) % 3) * RW_TILE_B, tid, rr);
    __syncthreads();
  }
  if (MODE == 1) {
    float* Pm = PQ + ((size_t)(bh * RW_C + chunk) * 2 + 0) * 4096 + rowA * 64 + q * 8;
    *(float4*)Pm = make_float4(SA[0].x, SA[0].y, SA[1].x, SA[1].y); *(float4*)(Pm + 4) = make_float4(SA[2].x, SA[2].y, SA[3].x, SA[3].y);
    *(float4*)(Pm + 4096) = make_float4(SB[0].x, SB[0].y, SB[1].x, SB[1].y); *(float4*)(Pm + 4100) = make_float4(SB[2].x, SB[2].y, SB[3].x, SB[3].y);
  } else if (chunk == 0 && w < 4) {
    float* Qm = PQ + ((size_t)(bh * RW_C + 0) * 2 + 1) * 4096 + q * 8;
    *(float4*)(Qm + rowA * 64) = make_float4(SA[0].x, SA[0].y, SA[1].x, SA[1].y); *(float4*)(Qm + rowA * 64 + 4) = make_float4(SA[2].x, SA[2].y, SA[3].x, SA[3].y);
    *(float4*)(Qm + rowB * 64) = make_float4(SB[0].x, SB[0].y, SB[1].x, SB[1].y); *(float4*)(Qm + rowB * 64 + 4) = make_float4(SB[2].x, SB[2].y, SB[3].x, SB[3].y);
  }
  __syncthreads();
}

__device__ void conv_item(const Params& P, int l, int item, unsigned char* lds) {
#ifdef OFF_conv_item
  return;
#endif

  bf16_t* p = (bf16_t*)(P.ws + WS_P);
  float* u = (float*)lds;
  float* yb = (float*)(lds + 62 * 1024);
  const int tid = opaque_tid(), c = tid & 255, half = tid >> 8;
  const int t0 = item * 32, tt0 = t0 & (TSEQ - 1);
  {
    bf16_t rv[31], rg[31];
#pragma unroll
    for (int i = 0; i < 31; ++i) { const int r = half + 2 * i; const bool ok = (tt0 - 30 + r) >= 0; const bf16_t* pr = p + (size_t)(t0 - 30 + r) * NIN;
      rv[i] = ok ? pr[C_CVAL + c] : (bf16_t)0; rg[i] = ok ? pr[C_CGLU + c] : (bf16_t)0; }
#pragma unroll
    for (int i = 0; i < 31; ++i) u[(half + 2 * i) * 256 + c] = bf2f(rv[i]) * sigmoidf_(bf2f(rg[i]));
  }
  float wv[31];
#pragma unroll
  for (int j = 0; j < 31; ++j) wv[j] = P.in[14][(l * 31 + j) * 256 + c];
  const float bias = P.in[15][l * 256 + c];
  __syncthreads();
  {
    float win[46];
#pragma unroll
    for (int i = 0; i < 46; ++i) win[i] = u[(half * 16 + i) * 256 + c];
#pragma unroll
    for (int i = 0; i < 16; ++i) {
      float acc = bias;
#pragma unroll
      for (int j = 0; j < 31; ++j) acc = fmaf(wv[j], win[i + j], acc);
      yb[(half * 16 + i) * 256 + c] = acc;
    }
  }
  __syncthreads();
  const int lane = tid & 63, w = tid >> 6;
  const float4 g = *(const float4*)(P.in[16] + l * 256 + lane * 4), bb = *(const float4*)(P.in[17] + l * 256 + lane * 4);
  uint2 gpre[4];
#pragma unroll
  for (int i = 0; i < 4; ++i) gpre[i] = *(const uint2*)(p + (size_t)(t0 + w * 4 + i) * NIN + C_CGATE + lane * 4);
#pragma unroll
  for (int i = 0; i < 4; ++i) {
    const int tk = w * 4 + i;
    const float4 v = *(const float4*)(yb + tk * 256 + lane * 4);
    const float mean = wave_sum(v.x + v.y + v.z + v.w) * (1.0f / 256.0f);
    const float d0 = v.x - mean, d1 = v.y - mean, d2 = v.z - mean, d3 = v.w - mean;
    const float var = wave_sum(d0 * d0 + d1 * d1 + d2 * d2 + d3 * d3) * (1.0f / 256.0f);
    const float rs = rsqrtf(var + 1e-5f);
    bf16_t* gp = p + (size_t)(t0 + tk) * NIN + C_CGATE + lane * 4;
    const uint2 gu = gpre[i];
    const float o0 = siluf_(d0 * rs * g.x + bb.x) * siluf_(__uint_as_float(gu.x << 16));
    const float o1 = siluf_(d1 * rs * g.y + bb.y) * siluf_(__uint_as_float(gu.x & 0xffff0000u));
    const float o2 = siluf_(d2 * rs * g.z + bb.z) * siluf_(__uint_as_float(gu.y << 16));
    const float o3 = siluf_(d3 * rs * g.w + bb.w) * siluf_(__uint_as_float(gu.y & 0xffff0000u));
    uint2 o; o.x = pack2(o0, o1); o.y = pack2(o2, o3);
    *(uint2*)gp = o;
  }
  __syncthreads();
}

#define HG_WLDS 10240
__device__ __forceinline__ float hgrn_lb(const Params& P, int l, int ch) {
  if (l == 0) return 0.f;
  const float x0 = P.in[18][ch], x1 = P.in[18][256 + ch];
  return 1.0f / (1.0f + __expf(x0 - x1));
}
template <int PASS>
__device__ void hgrn_wave_item(const Params& P, int l, int wi, unsigned char* lds) {
#ifdef OFF_hgrn_wave_item
  return;
#endif

  bf16_t* p = (bf16_t*)(P.ws + WS_P);
  float* HS = (float*)(P.ws + WS_HS); float* HF = (float*)(P.ws + WS_HF);
  const int tid = opaque_tid();
  const int lane = tid & 63, w = tid >> 6;
  const int bh = wi >> 7, chunk = wi & 127, b = bh >> 2, head = bh & 3;
  float* st = (float*)(lds + w * HG_WLDS);
  float* ob = st + 2048;
  const int kg = lane & 7, vg = lane >> 3;
  const int ch = head * 64 + lane;
  const float lb = hgrn_lb(P, l, ch);
  const float ng = P.in[19][l * 256 + ch];
  float S[8][8];
  float* slot = HS + (size_t)(bh * 128 + chunk) * 4096;
  if (PASS == 1) {
#pragma unroll
    for (int i = 0; i < 8; ++i) { const float4 x0 = *(const float4*)(slot + (kg * 8 + i) * 64 + vg * 8), x1 = *(const float4*)(slot + (kg * 8 + i) * 64 + vg * 8 + 4);
      S[i][0] = x0.x; S[i][1] = x0.y; S[i][2] = x0.z; S[i][3] = x0.w; S[i][4] = x1.x; S[i][5] = x1.y; S[i][6] = x1.z; S[i][7] = x1.w; }
  } else {
#pragma unroll
    for (int i = 0; i < 8; ++i)
#pragma unroll
      for (int j = 0; j < 8; ++j) S[i][j] = 0.f;
  }
  float Fp = 1.f;
  bf16_t rf[8], ri[8], rq[8], rg[8];
  {
    const int tb0 = b * TSEQ + chunk * 64;
#pragma unroll
    for (int s = 0; s < 8; ++s) { const bf16_t* pr = p + (size_t)(tb0 + s) * NIN; rf[s] = pr[C_HF + ch]; ri[s] = pr[C_HI + ch]; if (PASS == 1) { rq[s] = pr[C_HQ + ch]; rg[s] = pr[C_HG + ch]; } }
  }
#pragma unroll 1
  for (int sub = 0; sub < 8; ++sub) {
    const int tbase = b * TSEQ + chunk * 64 + sub * 8;
    bf16_t gc[8];
#pragma unroll
    for (int s = 0; s < 8; ++s) {
      const float f = lb + (1.0f - lb) * sigmoidf_(bf2f(rf[s]));
      Fp *= f;
      st[s * 256 + lane] = f; st[s * 256 + 64 + lane] = 1.0f - f;
      if (PASS == 1) { st[s * 256 + 128 + lane] = siluf_(bf2f(rq[s])); gc[s] = rg[s]; }
      st[s * 256 + 192 + lane] = bf2f(ri[s]);
    }
    if (sub < 7) {
#pragma unroll
      for (int s = 0; s < 8; ++s) { const bf16_t* pr = p + (size_t)(tbase + 8 + s) * NIN; rf[s] = pr[C_HF + ch]; ri[s] = pr[C_HI + ch]; if (PASS == 1) { rq[s] = pr[C_HQ + ch]; rg[s] = pr[C_HG + ch]; } }
    }
    __builtin_amdgcn_s_waitcnt(0xc07f);
    __builtin_amdgcn_wave_barrier();
#pragma unroll 1
    for (int s = 0; s < 8; ++s) {
      const float* sp = st + s * 256;
      const float4 f0 = *(const float4*)(sp + kg * 8), f1 = *(const float4*)(sp + kg * 8 + 4);
      const float4 k0 = *(const float4*)(sp + 64 + kg * 8), k1 = *(const float4*)(sp + 64 + kg * 8 + 4);
      const float4 v0 = *(const float4*)(sp + 192 + vg * 8), v1 = *(const float4*)(sp + 192 + vg * 8 + 4);
      const float fv[8] = {f0.x, f0.y, f0.z, f0.w, f1.x, f1.y, f1.z, f1.w};
      const float kv[8] = {k0.x, k0.y, k0.z, k0.w, k1.x, k1.y, k1.z, k1.w};
      const float vv[8] = {v0.x, v0.y, v0.z, v0.w, v1.x, v1.y, v1.z, v1.w};
#pragma unroll
      for (int i = 0; i < 8; ++i)
#pragma unroll
        for (int j = 0; j < 8; ++j) S[i][j] = fmaf(fv[i], S[i][j], kv[i] * vv[j]);
      if (PASS == 1) {
        const float4 q0 = *(const float4*)(sp + 128 + kg * 8), q1 = *(const float4*)(sp + 128 + kg * 8 + 4);
        const float qv[8] = {q0.x, q0.y, q0.z, q0.w, q1.x, q1.y, q1.z, q1.w};
        float o[8];
#pragma unroll
        for (int j = 0; j < 8; ++j) { float a = qv[0] * S[0][j];
#pragma unroll
          for (int i = 1; i < 8; ++i) a = fmaf(qv[i], S[i][j], a);
          o[j] = red8(a); }
        if (kg == 0) { *(float4*)(ob + s * 64 + vg * 8) = make_float4(o[0], o[1], o[2], o[3]); *(float4*)(ob + s * 64 + vg * 8 + 4) = make_float4(o[4], o[5], o[6], o[7]); }
      }
    }
    __builtin_amdgcn_s_waitcnt(0xc07f);
    __builtin_amdgcn_wave_barrier();
    if (PASS == 1) {
#pragma unroll
      for (int s = 0; s < 8; ++s) {
        const float o = ob[s * 64 + lane];
        const float ms = wave_sum(o * o) * (1.0f / 64.0f);
        p[(size_t)(tbase + s) * NIN + C_HG + ch] = f2bf(o * rsqrtf(ms + 1e-6f) * ng * siluf_(bf2f(gc[s])));
      }
      __builtin_amdgcn_s_waitcnt(0xc07f);
      __builtin_amdgcn_wave_barrier();
    }
  }
  if (PASS == 0) {
#pragma unroll
    for (int i = 0; i < 8; ++i) { *(float4*)(slot + (kg * 8 + i) * 64 + vg * 8) = make_float4(S[i][0], S[i][1], S[i][2], S[i][3]);
      *(float4*)(slot + (kg * 8 + i) * 64 + vg * 8 + 4) = make_float4(S[i][4], S[i][5], S[i][6], S[i][7]); }
    HF[(size_t)(bh * 128 + chunk) * 64 + lane] = Fp;
  }
}
__device__ void hgrn_combine_item(const Params& P, int bh) {
#ifdef OFF_hgrn_combine_item
  return;
#endif

  float* HS = (float*)(P.ws + WS_HS); const float* HF = (const float*)(P.ws + WS_HF);
  const int tid = opaque_tid();
  const int krow = tid >> 3;
  float R[8];
#pragma unroll
  for (int e = 0; e < 8; ++e) R[e] = 0.f;
  float4 xa[8][2]; float fa[8];
#pragma unroll
  for (int u = 0; u < 8; ++u) { const float* sl = HS + (size_t)(bh * 128 + u) * 4096 + tid * 8; xa[u][0] = *(const float4*)sl; xa[u][1] = *(const float4*)(sl + 4); fa[u] = HF[(size_t)(bh * 128 + u) * 64 + krow]; }
#pragma unroll 1
  for (int c0 = 0; c0 < 128; c0 += 8) {
    float4 xn[8][2]; float fn[8];
    if (c0 + 8 < 128) {
#pragma unroll
      for (int u = 0; u < 8; ++u) { const float* sl = HS + (size_t)(bh * 128 + c0 + 8 + u) * 4096 + tid * 8; xn[u][0] = *(const float4*)sl; xn[u][1] = *(const float4*)(sl + 4); fn[u] = HF[(size_t)(bh * 128 + c0 + 8 + u) * 64 + krow]; }
    }
#pragma unroll
    for (int u = 0; u < 8; ++u) {
      float* sl = HS + (size_t)(bh * 128 + c0 + u) * 4096 + tid * 8;
      *(float4*)sl = make_float4(R[0], R[1], R[2], R[3]); *(float4*)(sl + 4) = make_float4(R[4], R[5], R[6], R[7]);
      const float f = fa[u];
      R[0] = fmaf(f, R[0], xa[u][0].x); R[1] = fmaf(f, R[1], xa[u][0].y); R[2] = fmaf(f, R[2], xa[u][0].z); R[3] = fmaf(f, R[3], xa[u][0].w);
      R[4] = fmaf(f, R[4], xa[u][1].x); R[5] = fmaf(f, R[5], xa[u][1].y); R[6] = fmaf(f, R[6], xa[u][1].z); R[7] = fmaf(f, R[7], xa[u][1].w);
    }
    if (c0 + 8 < 128) {
#pragma unroll
      for (int u = 0; u < 8; ++u) { xa[u][0] = xn[u][0]; xa[u][1] = xn[u][1]; fa[u] = fn[u]; }
    }
  }
}

__device__ void sb_item(const Params& P, int item, unsigned char* lds) {
#ifdef OFF_sb_item
  return;
#endif

  bf16_t* p = (bf16_t*)(P.ws + WS_P);
  const int tid = opaque_tid(), lane = tid & 63, w = tid >> 6;
  const int qt = item & 127, bh = item >> 7, b = bh >> 2, head = bh & 3;
  unsigned char* Qs = lds;
  unsigned char* Ks = lds + 9216;
  unsigned char* Vt = lds + 18432;
  unsigned char* As = lds + 27648;
  float* Zs = (float*)(lds + 36864);
  volatile int* flag = (volatile int*)(lds + 36864 + 64 * 65 * 4);
  const int lrow = tid >> 3, lch = (tid & 7);
  const size_t tokq = (size_t)b * TSEQ + qt * 64;
  *(uint4*)(Qs + lrow * 144 + lch * 16) = *(const uint4*)(p + (tokq + lrow) * NIN + C_SQ + head * 64 + lch * 8);
  float carry = 0.f;
  f32x4 oacc[2] = {{0.f, 0.f, 0.f, 0.f}, {0.f, 0.f, 0.f, 0.f}};
  const int qi = w >> 1, t2 = (w & 1) * 2;
  const int q = tid >> 3, seg = tid & 7;
  uint4 kreg = *(const uint4*)(p + (tokq + lrow) * NIN + C_SK + head * 64 + lch * 8);
  uint4 vreg = *(const uint4*)(p + (tokq + lrow) * NIN + C_SV + head * 64 + lch * 8);
  for (int kt = qt; kt >= 0; --kt) {
    __syncthreads();
    *(uint4*)(Ks + lrow * 144 + lch * 16) = kreg;
    { const unsigned vw[4] = {vreg.x, vreg.y, vreg.z, vreg.w};
#pragma unroll
      for (int e = 0; e < 8; ++e) *(unsigned short*)(Vt + (lch * 8 + e) * 144 + lrow * 2) = (unsigned short)((e & 1) ? (vw[e >> 1] >> 16) : (vw[e >> 1] & 0xffffu)); }
    if (tid == 0) *flag = 0;
    if (kt > 0) { const size_t tokn = (size_t)b * TSEQ + (kt - 1) * 64;
      kreg = *(const uint4*)(p + (tokn + lrow) * NIN + C_SK + head * 64 + lch * 8);
      vreg = *(const uint4*)(p + (tokn + lrow) * NIN + C_SV + head * 64 + lch * 8); }
    __syncthreads();
#pragma unroll
    for (int jj = 0; jj < 2; ++jj) {
      const int ki = t2 + jj;
      f32x4 acc = {0.f, 0.f, 0.f, 0.f};
#pragma unroll
      for (int s = 0; s < 2; ++s) {
        const bf16x8 a = *(const bf16x8*)(Qs + (qi * 16 + (lane & 15)) * 144 + s * 64 + (lane >> 4) * 16);
        const bf16x8 bb = *(const bf16x8*)(Ks + (ki * 16 + (lane & 15)) * 144 + s * 64 + (lane >> 4) * 16);
        acc = __builtin_amdgcn_mfma_f32_16x16x32_bf16(a, bb, acc, 0, 0, 0);
      }
#pragma unroll
      for (int r = 0; r < 4; ++r) Zs[(qi * 16 + (lane >> 4) * 4 + r) * 65 + ki * 16 + (lane & 15)] = acc[r] * 0.125f;
    }
    __syncthreads();
    {
      const int tq = qt * 64 + q;
      float z[8], lk[8];
      float tot = 0.f;
#pragma unroll
      for (int e = 0; e < 8; ++e) {
        z[e] = Zs[q * 65 + seg * 8 + e];
        const bool m = (kt * 64 + seg * 8 + e) < tq;
        lk[e] = m ? -softplus_fast(z[e]) : 0.f;
        tot += lk[e];
      }
      float inc = tot;
      { float t_ = __shfl_down(inc, 1, 8); if (seg + 1 < 8) inc += t_; }
      { float t_ = __shfl_down(inc, 2, 8); if (seg + 2 < 8) inc += t_; }
      { float t_ = __shfl_down(inc, 4, 8); if (seg + 4 < 8) inc += t_; }
      const float rowtot = __shfl(inc, 0, 8);
      float tail = carry + (inc - tot);
      float av[8];
#pragma unroll
      for (int e = 7; e >= 0; --e) {
        const bool m = (kt * 64 + seg * 8 + e) < tq;
        av[e] = m ? __expf(z[e] + lk[e] + tail) : 0.f;
        tail += lk[e];
      }
      uint4 o; o.x = pack2(av[0], av[1]); o.y = pack2(av[2], av[3]); o.z = pack2(av[4], av[5]); o.w = pack2(av[6], av[7]);
      *(uint4*)(As + q * 144 + seg * 16) = o;
      carry += rowtot;
      if (carry > -100.f) *flag = 1;
    }
    __syncthreads();
#pragma unroll
    for (int jj = 0; jj < 2; ++jj) {
      const int di = t2 + jj;
#pragma unroll
      for (int s = 0; s < 2; ++s) {
        const bf16x8 a = *(const bf16x8*)(As + (qi * 16 + (lane & 15)) * 144 + s * 64 + (lane >> 4) * 16);
        const bf16x8 bb = *(const bf16x8*)(Vt + (di * 16 + (lane & 15)) * 144 + s * 64 + (lane >> 4) * 16);
        oacc[jj] = __builtin_amdgcn_mfma_f32_16x16x32_bf16(a, bb, oacc[jj], 0, 0, 0);
      }
    }
    if (*flag == 0) break;
  }
#pragma unroll
  for (int jj = 0; jj < 2; ++jj) {
    const int d = (t2 + jj) * 16 + (lane & 15);
#pragma unroll
    for (int r = 0; r < 4; ++r) {
      const int qq = qi * 16 + (lane >> 4) * 4 + r;
      bf16_t* gp = p + (tokq + qq) * NIN + C_SG + head * 64 + d;
      *gp = f2bf(oacc[jj][r] * siluf_(bf2f(*gp)));
    }
  }
  __syncthreads();
}

__device__ void xattn_item(const Params& P, int l, int item, unsigned char* lds) {
#ifdef OFF_xattn_item
  return;
#endif

  const bf16_t* qb = (const bf16_t*)(P.ws + WS_P + 32ull * MiB);
  bf16_t* ob = (bf16_t*)(P.ws + WS_P + 64ull * MiB);
  const bf16_t* kv = (const bf16_t*)(P.ws + WS_KV) + (size_t)l * 512 * 2048;
  const int tid = opaque_tid(), lane = tid & 63, w = tid >> 6;
  const int qt = item & 127, bh = item >> 7, b = bh >> 2, head = bh & 3;
  unsigned char* Qs = lds;
  unsigned char* KVs = lds + 33792;
  float* Ss = (float*)(lds + 67584);
  const size_t tok0 = (size_t)b * TSEQ + qt * 64;
  __syncthreads();
#pragma unroll
  for (int i = 0; i < 4; ++i) { const int c = tid + i * NTHR, r = c >> 5, cc = c & 31;
    *(uint4*)(Qs + r * 528 + cc * 16) = *(const uint4*)(qb + (tok0 + r) * 1024 + head * 256 + cc * 8); }
  const int qi = w >> 1, t2 = (w & 1) * 2;
  for (int kb = 0; kb < 4; ++kb) {
    __syncthreads();
#pragma unroll
    for (int i = 0; i < 4; ++i) { const int c = tid + i * NTHR, r = c >> 5, cc = c & 31;
      *(uint4*)(KVs + r * 528 + cc * 16) = *(const uint4*)(kv + (size_t)(b * 256 + kb * 64 + r) * 2048 + head * 256 + cc * 8); }
    __syncthreads();
#pragma unroll
    for (int jj = 0; jj < 2; ++jj) {
      const int ki = t2 + jj;
      f32x4 acc = {0.f, 0.f, 0.f, 0.f};
#pragma unroll
      for (int s = 0; s < 8; ++s) {
        const bf16x8 a = *(const bf16x8*)(Qs + (qi * 16 + (lane & 15)) * 528 + s * 64 + (lane >> 4) * 16);
        const bf16x8 bb = *(const bf16x8*)(KVs + (ki * 16 + (lane & 15)) * 528 + s * 64 + (lane >> 4) * 16);
        acc = __builtin_amdgcn_mfma_f32_16x16x32_bf16(a, bb, acc, 0, 0, 0);
      }
#pragma unroll
      for (int r = 0; r < 4; ++r) Ss[(qi * 16 + (lane >> 4) * 4 + r) * 260 + kb * 64 + ki * 16 + (lane & 15)] = acc[r] * 0.0625f;
    }
  }
  __syncthreads();
  {
    const int q = tid >> 3, seg = tid & 7;
    float x[32]; float mx = -3.0e38f;
#pragma unroll
    for (int i = 0; i < 8; ++i) { const float4 v = *(const float4*)(Ss + q * 260 + seg * 32 + i * 4); x[i * 4] = v.x; x[i * 4 + 1] = v.y; x[i * 4 + 2] = v.z; x[i * 4 + 3] = v.w;
      mx = fmaxf(mx, fmaxf(fmaxf(v.x, v.y), fmaxf(v.z, v.w))); }
    mx = fmaxf(mx, __shfl_xor(mx, 1)); mx = fmaxf(mx, __shfl_xor(mx, 2)); mx = fmaxf(mx, __shfl_xor(mx, 4));
    float sum = 0.f;
#pragma unroll
    for (int i = 0; i < 32; ++i) { x[i] = __expf(x[i] - mx); sum += x[i]; }
    sum += __shfl_xor(sum, 1); sum += __shfl_xor(sum, 2); sum += __shfl_xor(sum, 4);
    const float inv = 1.0f / sum;
#pragma unroll
    for (int i = 0; i < 4; ++i) { uint4 o; o.x = pack2(x[i * 8] * inv, x[i * 8 + 1] * inv); o.y = pack2(x[i * 8 + 2] * inv, x[i * 8 + 3] * inv);
      o.z = pack2(x[i * 8 + 4] * inv, x[i * 8 + 5] * inv); o.w = pack2(x[i * 8 + 6] * inv, x[i * 8 + 7] * inv);
      *(uint4*)(Qs + q * 528 + seg * 64 + i * 16) = o; }
  }
  for (int db = 0; db < 4; ++db) {
    __syncthreads();
#pragma unroll
    for (int i = 0; i < 4; ++i) { const int c = tid + i * NTHR, m = c >> 3, dc = c & 7;
      const uint4 vv = *(const uint4*)(kv + (size_t)(b * 256 + m) * 2048 + 1024 + head * 256 + db * 64 + dc * 8);
      const unsigned short* ve = (const unsigned short*)&vv;
#pragma unroll
      for (int e = 0; e < 8; ++e) *(unsigned short*)(KVs + (dc * 8 + e) * 528 + m * 2) = ve[e]; }
    __syncthreads();
#pragma unroll
    for (int jj = 0; jj < 2; ++jj) {
      const int di = t2 + jj;
      f32x4 acc = {0.f, 0.f, 0.f, 0.f};
#pragma unroll
      for (int s = 0; s < 8; ++s) {
        const bf16x8 a = *(const bf16x8*)(Qs + (qi * 16 + (lane & 15)) * 528 + s * 64 + (lane >> 4) * 16);
        const bf16x8 bb = *(const bf16x8*)(KVs + (di * 16 + (lane & 15)) * 528 + s * 64 + (lane >> 4) * 16);
        acc = __builtin_amdgcn_mfma_f32_16x16x32_bf16(a, bb, acc, 0, 0, 0);
      }
#pragma unroll
      for (int r = 0; r < 4; ++r) ob[(tok0 + qi * 16 + (lane >> 4) * 4 + r) * 1024 + head * 256 + db * 64 + di * 16 + (lane & 15)] = f2bf(acc[r]);
    }
  }
  __syncthreads();
}

__global__ void __launch_bounds__(NTHR) fwd_megakernel(Params P) {
  extern __shared__ __attribute__((aligned(16))) unsigned char lds[];
  __shared__ uint4 xb_words;
  if (threadIdx.x == 0) xb_words = make_uint4(0u, 0u, 0u, 0u);
  __syncthreads();
#ifdef PROBE_J
  __shared__ unsigned long long tacc[16];
  __shared__ unsigned long long tlast;
  __shared__ float pdelta;
  if (threadIdx.x == 0) { for (int i = 0; i < 16; ++i) tacc[i] = 0ull; tlast = __builtin_amdgcn_s_memrealtime(); pdelta = 0.f; }
#define STAMP(k) if (threadIdx.x == 0) { const unsigned long long n_ = __builtin_amdgcn_s_memrealtime(); tacc[k] += n_ - tlast; tlast = n_; }
#else
#define STAMP(k)
#endif
  XcdBarrier bar = xcd_barrier_post((unsigned*)(P.ws + WS_BAR), (volatile LAS unsigned*)&xb_words);
  if (P.never) cg::this_grid().sync();
  const int G = gridDim.x, bid = blockIdx.x;
  unsigned char* ws = P.ws;
  bf16_t* hbuf = (bf16_t*)(ws + WS_R1);
  bf16_t* pbuf = (bf16_t*)(ws + WS_P);
  bf16_t* hx = (bf16_t*)(ws + WS_P);
  bf16_t* qbuf = (bf16_t*)(ws + WS_P + 32ull * MiB);
  bf16_t* obuf = (bf16_t*)(ws + WS_P + 64ull * MiB);

  for (int it = bid; it < 2 * 2256; it += G) {
    const int l = it / 2256; int r = it % 2256;
    const float* W; int N; bf16_t* Wt; int kt, nt;
    unsigned char* wl = ws + WS_WT + l * WT_LAYER;
    if (r < 976) { W = P.in[3] + (size_t)l * 1024 * NIN; N = NIN; Wt = (bf16_t*)(wl + WT_IN); kt = r / 61; nt = r % 61; }
    else { r -= 976; const int m = r >> 8; r &= 255; kt = r >> 4; nt = r & 15; N = 1024;
      if (m == 0) { W = P.in[20] + (size_t)l * 1048576; Wt = (bf16_t*)(wl + WT_OUT); }
      else if (m == 1) { W = P.in[23] + (size_t)l * 1048576; Wt = (bf16_t*)(wl + WT_Q); }
      else if (m == 2) { W = P.in[24] + (size_t)l * 1048576; Wt = (bf16_t*)(wl + WT_KV); }
      else if (m == 3) { W = P.in[25] + (size_t)l * 1048576; Wt = (bf16_t*)(wl + WT_KV) + 1024 * 1024; }
      else { W = P.in[26] + (size_t)l * 1048576; Wt = (bf16_t*)(wl + WT_O); } }
    wt_tile(W, N, Wt, kt, nt, lds);
  }
  norm_rows<false>(P.in[1], P.in[22], (bf16_t*)(ws + WS_MEMN), 512);
  norm_rows<false>(P.in[1], P.in[22] + 1024, (bf16_t*)(ws + WS_MEMN) + 512 * 1024, 512);
  norm_rows<false>(P.in[0], P.in[2], hbuf, NT);
  xcd_barrier(bar); STAMP(0)

#pragma unroll 1
  for (int l = 0; l < 2; ++l) {
    const unsigned char* wl = ws + WS_WT + l * WT_LAYER;
    for (int t = bid; t < 1024; t += G) {
      int mi, ni; tile_map(t, 16, mi, ni);
      gemm_tile<0>(hbuf, 1024, 0, 256, 512, 768, (const bf16_t*)(wl + WT_IN), mi * 256, ni * 256, NIN, pbuf, nullptr, NIN, lds);
    }
    xcd_barrier(bar); STAMP(1)
    for (int it = bid; it < 640; it += G) {
      if (it < 128) hgrn_wave_item<0>(P, l, it * 8 + (threadIdx.x >> 6), lds);
      else rwkv_prep_item(P, l, it - 128, lds);
      __syncthreads();
    }
    xcd_barrier(bar); STAMP(2)
    {
      const int n_p1 = 8 * (RW_C - 2);
      const int n_rw = n_p1 + 8;
      const int n_oth = 8 + 512 + 1024;
      if (G > n_rw + 32) {
        if (bid < n_rw) {
          if (bid < n_p1) rwkv_scan_item<1>(P, l, bid & 7, 1 + (bid >> 3), lds);
          else rwkv_scan_item<0>(P, l, bid - n_p1, 0, lds);
        } else {
          for (int it = bid - n_rw; it < n_oth; it += G - n_rw) {
            if (it < 8) hgrn_combine_item(P, it);
            else if (it < 8 + 512) conv_item(P, l, it - 8, lds);
            else sb_item(P, it - 8 - 512, lds);
            __syncthreads();
          }
        }
      } else {
        for (int it = bid; it < n_rw + n_oth; it += G) {
          if (it < n_p1) rwkv_scan_item<1>(P, l, it & 7, 1 + (it >> 3), lds);
          else if (it < n_rw) rwkv_scan_item<0>(P, l, it - n_p1, 0, lds);
          else if (it < n_rw + 8) hgrn_combine_item(P, it - n_rw);
          else if (it < n_rw + 8 + 512) conv_item(P, l, it - n_rw - 8, lds);
          else sb_item(P, it - n_rw - 8 - 512, lds);
          __syncthreads();
        }
      }
    }
    xcd_barrier(bar); STAMP(3)
    {
      const int n_p3 = 8 * (RW_C - 1);
      const int n_all = n_p3 + 128 + 16;
      for (int it = bid; it < n_all; it += G) {
        if (it < n_p3) rwkv_scan_item<0>(P, l, it & 7, 1 + (it >> 3), lds);
        else if (it < n_p3 + 128) hgrn_wave_item<1>(P, l, (it - n_p3) * 8 + (threadIdx.x >> 6), lds);
        else { const int t = it - n_p3 - 128; gemm_tile<0>((const bf16_t*)(ws + WS_MEMN) + (size_t)l * 512 * 1024, 1024, 0, 256, 512, 768, (const bf16_t*)(wl + WT_KV), (t >> 3) * 256, (t & 7) * 256, 2048,
                                                          (bf16_t*)(ws + WS_KV) + (size_t)l * 512 * 2048, nullptr, 2048, lds); }
        __syncthreads();
      }
    }
    xcd_barrier(bar); STAMP(4)
    {
      const float* resid = l == 0 ? P.in[0] : P.out;
      for (int t = bid; t < 256; t += G) {
        int mi, ni; tile_map(t, 4, mi, ni);
        gemm_tile<1>(pbuf, NIN, C_GA, C_CGATE, C_HG, C_SG, (const bf16_t*)(wl + WT_OUT), mi * 256, ni * 256, 1024, P.out, resid, 1024, lds);
      }
    }
    xcd_barrier(bar); STAMP(5)
    norm_rows<false>(P.out, P.in[21] + l * 1024, hx, NT);
    xcd_barrier(bar); STAMP(6)
    for (int t = bid; t < 256; t += G) {
      int mi, ni; tile_map(t, 4, mi, ni);
      gemm_tile<0>(hx, 1024, 0, 256, 512, 768, (const bf16_t*)(wl + WT_Q), mi * 256, ni * 256, 1024, qbuf, nullptr, 1024, lds);
    }
    xcd_barrier(bar); STAMP(7)
    for (int it = bid; it < 1024; it += G) xattn_item(P, l, it, lds);
    xcd_barrier(bar); STAMP(8)
    for (int t = bid; t < 256; t += G) {
      int mi, ni; tile_map(t, 4, mi, ni);
      gemm_tile<1>(obuf, 1024, 0, 256, 512, 768, (const bf16_t*)(wl + WT_O), mi * 256, ni * 256, 1024, P.out, P.out, 1024, lds);
    }
    xcd_barrier(bar); STAMP(9)
    if (l == 0) { norm_rows<false>(P.out, P.in[2] + 1024, hbuf, NT); xcd_barrier(bar); STAMP(6) }
  }
#ifdef PROBE_J
  if (bid == 0) {
    if (threadIdx.x == 0) {
      unsigned long long tot = 0ull; for (int i = 0; i < 10; ++i) tot += tacc[i];
      pdelta = sqrtf(0.0128f * (float)tacc[PROBE_J] / (float)tot);
    }
    __syncthreads();
  }
  const float pd_ = (bid == 0) ? pdelta : 0.f;
  norm_rows<true>(P.out, P.in[27], P.out, NT, pd_);
  if (bid == 0 && threadIdx.x == 0) {
    const unsigned long long t0_ = __builtin_amdgcn_s_memrealtime();
    const unsigned long long w_ = 4ull * tacc[PROBE_K];
    while (__builtin_amdgcn_s_memrealtime() - t0_ < w_) __builtin_amdgcn_s_sleep(8);
  }
#else
  norm_rows<true>(P.out, P.in[27], P.out, NT);
#endif
}

extern "C" void kernel_launch(void* const* d_in, const int* in_sizes, int n_in, void* d_out, int out_size, void* d_ws, size_t ws_size, hipStream_t stream) {
  constexpr size_t kDynLds = 147456;
  static int grid_blocks = 0;
  if (!grid_blocks) {
    int dev = 0, cus = 0, per_cu = 0;
    hipGetDevice(&dev);
    hipDeviceGetAttribute(&cus, hipDeviceAttributeMultiprocessorCount, dev);
    hipFuncSetAttribute((const void*)fwd_megakernel, hipFuncAttributeMaxDynamicSharedMemorySize, (int)kDynLds);
    hipOccupancyMaxActiveBlocksPerMultiprocessor(&per_cu, fwd_megakernel, NTHR, kDynLds);
    if (per_cu < 1) per_cu = 1;
    if (per_cu > 1) per_cu = 1;
    grid_blocks = cus * per_cu;
    if (grid_blocks > 256) grid_blocks = 256;
  }
  Params p;
  memset(&p, 0, sizeof(p));
  for (int i = 0; i < 28; ++i) p.in[i] = (const float*)d_in[i];
  p.out = (float*)d_out; p.ws = (unsigned char*)d_ws; p.never = 0; p.pad = 0;
  hipMemsetAsync(d_ws, 0, XCD_BAR_WORDS * 4, stream);
  void* args[] = {&p};
  hipError_t e = hipLaunchCooperativeKernel((void*)fwd_megakernel, dim3(grid_blocks), dim3(NTHR), args, kDynLds, stream);
  if (e != hipSuccess) fprintf(stderr, "cooperative launch failed: %s (grid %d)\n", hipGetErrorString(e), grid_blocks);
}
```

```cpp
#include <hip/hip_runtime.h>
#include <hip/hip_cooperative_groups.h>
#include <stdint.h>
#include <cstdio>
#include <cstring>
namespace cg = cooperative_groups;

typedef unsigned short bf16_t;
typedef short bf16x8 __attribute__((ext_vector_type(8)));
typedef float f32x4 __attribute__((ext_vector_type(4)));
typedef float f32x16 __attribute__((ext_vector_type(16)));
typedef float f32x2 __attribute__((ext_vector_type(2)));
#define LAS __attribute__((address_space(3)))

#define NT 16384
#define TSEQ 8192
#define DM 1024
#define NIN 3904
#define NTHR 512
#define C_R 0
#define C_K 256
#define C_V 512
#define C_XW 768
#define C_GA 832
#define C_CVAL 1088
#define C_CGLU 1344
#define C_CGATE 1600
#define C_HQ 1856
#define C_HF 2112
#define C_HI 2368
#define C_HG 2624
#define C_SQ 2880
#define C_SK 3136
#define C_SV 3392
#define C_SG 3648
#define RW_C 16
#define RW_CL (TSEQ / RW_C)
#define RW_TT 16

#define MiB (1024ull * 1024ull)
#define WS_BAR   0ull
#define WS_WT    (1ull * MiB)
#define WT_LAYER (18ull * MiB)
#define WT_IN    0ull
#define WT_OUT   (8ull * MiB)
#define WT_Q     (10ull * MiB)
#define WT_KV    (12ull * MiB)
#define WT_O     (16ull * MiB)
#define WS_MEMN  (37ull * MiB)
#define WS_KV    (39ull * MiB)
#define WS_PQ    (43ull * MiB)
#define WS_HS    (47ull * MiB)
#define WS_HF    (63ull * MiB)
#define WS_RK    (63ull * MiB + 512ull * 1024ull)
#define WS_R1    (64ull * MiB)
#define WS_PW    WS_R1
#define WS_PV    (WS_R1 + 16ull * MiB)
#define WS_P     (120ull * MiB)
#define WS_END   (243ull * MiB)

struct Params {
  const float* in[28];
  float* out;
  unsigned char* ws;
  int never;
  int pad;
};

__device__ __forceinline__ int opaque_tid() { int t = threadIdx.x; asm volatile("" : "+v"(t)); return t; }
__device__ __forceinline__ float bf2f(bf16_t v) { return __uint_as_float(((unsigned)v) << 16); }
__device__ __forceinline__ bf16_t f2bf(float f) {
  unsigned u = __float_as_uint(f);
  u += 0x7fffu + ((u >> 16) & 1u);
  return (bf16_t)(u >> 16);
}
__device__ __forceinline__ unsigned pack2(float a, float b) { return (unsigned)f2bf(a) | ((unsigned)f2bf(b) << 16); }
__device__ __forceinline__ float sigmoidf_(float x) { return __builtin_amdgcn_rcpf(1.0f + __expf(-x)); }
__device__ __forceinline__ float siluf_(float x) { return x * __builtin_amdgcn_rcpf(1.0f + __expf(-x)); }
__device__ __forceinline__ float softplusf_(float x) { return fmaxf(x, 0.f) + log1pf(__expf(-fabsf(x))); }
__device__ __forceinline__ float softplus_fast(float x) { return fmaxf(x, 0.f) + __logf(1.0f + __expf(-fabsf(x))); }
__device__ __forceinline__ float dpp_add(float v, const int ctrl_sel) {
  return v;
}
__device__ __forceinline__ float wave_sum(float v) {
  v += __builtin_bit_cast(float, __builtin_amdgcn_update_dpp(0, __builtin_bit_cast(int, v), 0xB1, 0xF, 0xF, true));
  v += __builtin_bit_cast(float, __builtin_amdgcn_update_dpp(0, __builtin_bit_cast(int, v), 0x4E, 0xF, 0xF, true));
  v += __builtin_bit_cast(float, __builtin_amdgcn_update_dpp(0, __builtin_bit_cast(int, v), 0x141, 0xF, 0xF, true));
  v += __builtin_bit_cast(float, __builtin_amdgcn_update_dpp(0, __builtin_bit_cast(int, v), 0x140, 0xF, 0xF, true));
  v += __shfl_xor(v, 16);
  v += __shfl_xor(v, 32);
  return v;
}
__device__ __forceinline__ float red8(float v) {
  v += __builtin_bit_cast(float, __builtin_amdgcn_update_dpp(0, __builtin_bit_cast(int, v), 0xB1, 0xF, 0xF, true));
  v += __builtin_bit_cast(float, __builtin_amdgcn_update_dpp(0, __builtin_bit_cast(int, v), 0x4E, 0xF, 0xF, true));
  v += __builtin_bit_cast(float, __builtin_amdgcn_update_dpp(0, __builtin_bit_cast(int, v), 0x141, 0xF, 0xF, true));
  return v;
}

#define XB_TMO      128
#define XB_XCNT(j)  (256  + 64 * (j))
#define XB_XSUB(j)  (1280 + 64 * (j))
#define XB_XGEN(j)  (2304 + 64 * (j))
#define XB_TOP      3328
#define XB_TOPGEN   3392
#define XCD_BAR_WORDS 3456
#define XB_SPIN_CAP (1u << 22)
__device__ __forceinline__ unsigned xb_ld(unsigned* p) { return __hip_atomic_load(p, __ATOMIC_RELAXED, __HIP_MEMORY_SCOPE_AGENT); }
__device__ __forceinline__ unsigned xb_add(unsigned* p, unsigned v) { return __hip_atomic_fetch_add(p, v, __ATOMIC_RELAXED, __HIP_MEMORY_SCOPE_AGENT); }
__device__ __forceinline__ unsigned xb_xcc_id() { return (unsigned)__builtin_amdgcn_s_getreg((3 << 11) | 20) & 0xFu; }
#define XB_SPIN(cond, bar) do { unsigned _sp = 0; while (cond) { __builtin_amdgcn_s_sleep(1); \
    if ((++_sp & 255u) == 0u) { if (xb_ld(&(bar)[XB_TMO])) break; if (_sp > XB_SPIN_CAP) { atomicAdd(&(bar)[XB_TMO], 1u); break; } } } } while (0)
struct XcdBarrier { unsigned* bar; unsigned x; volatile LAS unsigned* st; };
__device__ __forceinline__ XcdBarrier xcd_barrier_post(unsigned* bar, volatile LAS unsigned* st) {
  XcdBarrier b; b.bar = bar; b.x = xb_xcc_id(); b.st = st;
  if (threadIdx.x == 0) (void)xb_add(&bar[XB_XCNT(b.x)], 1u);
  return b;
}
__device__ __forceinline__ void xcd_barrier_complete(unsigned* bar, unsigned x, unsigned& nloc, unsigned& nx) {
  const unsigned G = gridDim.x * gridDim.y * gridDim.z;
  unsigned sum, cnt, mine, sp = 0u;
  for (;;) {
    sum = 0u; cnt = 0u; mine = 0u;
#pragma unroll
    for (unsigned j = 0; j < 16; ++j) { const unsigned c = xb_ld(&bar[XB_XCNT(j)]); sum += c; cnt += (c > 0u) ? 1u : 0u; mine = (j == x) ? c : mine; }
    if (sum == G) break;
    __builtin_amdgcn_s_sleep(1);
    if ((++sp & 255u) == 0u) { if (xb_ld(&bar[XB_TMO])) break; if (sp > XB_SPIN_CAP) { atomicAdd(&bar[XB_TMO], 1u); break; } }
  }
  nloc = mine > 0u ? mine : 1u; nx = cnt > 0u ? cnt : 1u;
}
__device__ __forceinline__ void xcd_barrier(const XcdBarrier& b) {
  asm volatile("s_waitcnt vmcnt(0)" ::: "memory");
  __syncthreads();
  if (threadIdx.x == 0) {
    unsigned* bar = b.bar;
    __builtin_amdgcn_s_waitcnt(0);
    unsigned nloc = b.st[0], nx = b.st[1];
    if (nloc == 0u) { xcd_barrier_complete(bar, b.x, nloc, nx); b.st[0] = nloc; b.st[1] = nx; }
    const unsigned old = xb_add(&bar[XB_XSUB(b.x)], 1u);
    const unsigned gen = old / nloc;
    if (old + 1u == (gen + 1u) * nloc) {
      __builtin_amdgcn_fence(__ATOMIC_RELEASE, "agent");
      asm volatile("s_waitcnt vmcnt(0)" ::: "memory");
      const unsigned og = xb_add(&bar[XB_TOP], 1u);
      const unsigned tg = og / nx;
      if (og + 1u == (tg + 1u) * nx) xb_add(&bar[XB_TOPGEN], 1u);
      else XB_SPIN(xb_ld(&bar[XB_TOPGEN]) == tg, bar);
      __builtin_amdgcn_fence(__ATOMIC_ACQUIRE, "agent");
      xb_add(&bar[XB_XGEN(b.x)], 1u);
      asm volatile("s_waitcnt vmcnt(0)" ::: "memory");
    } else {
      XB_SPIN(xb_ld(&bar[XB_XGEN(b.x)]) == gen, bar);
      __builtin_amdgcn_fence(__ATOMIC_ACQUIRE, "agent");
      asm volatile("s_waitcnt vmcnt(0)" ::: "memory");
    }
  }
  __syncthreads();
}

#define G_STAGE 73728
#define G_BOFF 36864
template <int EPI>
__device__ __forceinline__ void gemm_tile(const bf16_t* __restrict__ A, int lda, int ao0, int ao1, int ao2, int ao3,
                                          const bf16_t* __restrict__ Bt, int m0, int n0, int N,
                                          void* out, const float* resid, int ldc, unsigned char* lds) {
#ifdef OFF_gemm_tile
  return;
#endif

  const int tid = opaque_tid(), lane = tid & 63, w = tid >> 6;
  const int wm = w >> 2, wn = w & 3, lr = lane & 31, lh = lane >> 5;
  f32x16 acc[4][2];
#pragma unroll
  for (int i = 0; i < 4; ++i)
#pragma unroll
    for (int j = 0; j < 2; ++j)
#pragma unroll
      for (int r = 0; r < 16; ++r) acc[i][j][r] = 0.f;
  uint4 ra[4], rb[4];
  const int crow = tid >> 3, ccol = (tid & 7) * 8;
  const bf16_t* Ap = A + (size_t)(m0 + crow) * lda + ccol;
  const bf16_t* Bp = Bt + (size_t)(n0 + crow) * 1024 + ccol;
#define G_LOAD(kt) { const int k0_ = (kt) * 64; const int seg_ = k0_ >> 8; const int ao_ = (seg_ == 0 ? ao0 : seg_ == 1 ? ao1 : seg_ == 2 ? ao2 : ao3) + (k0_ & 255); \
    _Pragma("unroll") for (int i_ = 0; i_ < 4; ++i_) { ra[i_] = *(const uint4*)(Ap + (size_t)(i_ * 64) * lda + ao_); rb[i_] = *(const uint4*)(Bp + (size_t)(i_ * 64) * 1024 + k0_); } }
#define G_WRITE(buf) { unsigned char* b_ = lds + (buf) * G_STAGE + crow * 144 + (tid & 7) * 16; \
    _Pragma("unroll") for (int i_ = 0; i_ < 4; ++i_) { *(uint4*)(b_ + i_ * 64 * 144) = ra[i_]; *(uint4*)(b_ + G_BOFF + i_ * 64 * 144) = rb[i_]; } }
  G_LOAD(0); G_WRITE(0); __syncthreads();
  for (int kt = 0; kt < 16; ++kt) {
    if (kt < 15) G_LOAD(kt + 1);
    const unsigned char* base = lds + (kt & 1) * G_STAGE;
    const unsigned char* ab = base + (wm * 128 + lr) * 144 + lh * 16;
    const unsigned char* bb = base + G_BOFF + (wn * 64 + lr) * 144 + lh * 16;
#pragma unroll
    for (int s = 0; s < 4; ++s) {
      bf16x8 a[4], b[2];
#pragma unroll
      for (int i = 0; i < 4; ++i) a[i] = *(const bf16x8*)(ab + i * 32 * 144 + s * 32);
#pragma unroll
      for (int j = 0; j < 2; ++j) b[j] = *(const bf16x8*)(bb + j * 32 * 144 + s * 32);
#pragma unroll
      for (int i = 0; i < 4; ++i)
#pragma unroll
        for (int j = 0; j < 2; ++j) acc[i][j] = __builtin_amdgcn_mfma_f32_32x32x16_bf16(a[i], b[j], acc[i][j], 0, 0, 0);
    }
    if (kt < 15) G_WRITE((kt + 1) & 1);
    __syncthreads();
  }
#undef G_LOAD
#undef G_WRITE
#pragma unroll
  for (int i = 0; i < 4; ++i)
#pragma unroll
    for (int j = 0; j < 2; ++j) {
      const int col = n0 + wn * 64 + j * 32 + lr;
#pragma unroll
      for (int r = 0; r < 16; ++r) {
        const int row = m0 + wm * 128 + i * 32 + (r & 3) + 8 * (r >> 2) + 4 * lh;
        if (EPI == 0) { if (col < N) ((bf16_t*)out)[(size_t)row * ldc + col] = f2bf(acc[i][j][r]); }
        else { ((float*)out)[(size_t)row * ldc + col] = resid[(size_t)row * ldc + col] + acc[i][j][r]; }
      }
    }
}

__device__ __forceinline__ void tile_map(int t, int nN, int& mi, int& ni) {
  if (nN == 16) { const int rnd = t >> 8, blk = t & 255, x = blk & 7, y = blk >> 3; mi = rnd * 16 + (x >> 1) * 4 + (y & 3); ni = (x & 1) * 8 + (y >> 2); }
  else if (nN == 4) { const int rnd = t >> 8, blk = t & 255, x = blk & 7, y = blk >> 3; mi = rnd * 64 + x * 8 + (y & 7); ni = y >> 3; }
  else { mi = t / nN; ni = t % nN; }
}

__device__ void wt_tile(const float* __restrict__ W, int N, bf16_t* __restrict__ Wt, int kt, int nt, unsigned char* lds) {
#ifdef OFF_wt_tile
  return;
#endif

  float* tl = (float*)lds;
  const int tid = opaque_tid();
  const int r = tid >> 3, c8 = (tid & 7) * 8;
  const float* src = W + (size_t)(kt * 64 + r) * N + nt * 64 + c8;
  const float4 v0 = *(const float4*)src, v1 = *(const float4*)(src + 4);
  float* d = tl + r * 65 + c8;
  d[0] = v0.x; d[1] = v0.y; d[2] = v0.z; d[3] = v0.w; d[4] = v1.x; d[5] = v1.y; d[6] = v1.z; d[7] = v1.w;
  __syncthreads();
  uint4 o;
  o.x = pack2(tl[(c8 + 0) * 65 + r], tl[(c8 + 1) * 65 + r]);
  o.y = pack2(tl[(c8 + 2) * 65 + r], tl[(c8 + 3) * 65 + r]);
  o.z = pack2(tl[(c8 + 4) * 65 + r], tl[(c8 + 5) * 65 + r]);
  o.w = pack2(tl[(c8 + 6) * 65 + r], tl[(c8 + 7) * 65 + r]);
  *(uint4*)(Wt + (size_t)(nt * 64 + r) * 1024 + kt * 64 + c8) = o;
  __syncthreads();
}

template <bool F32OUT>
__device__ void norm_rows(const float* src, const float* __restrict__ g, void* dst, int nrows, float pd = 0.f) {
#ifdef OFF_norm_rows
  return;
#endif

  const int tid = opaque_tid();
  const int lane = tid & 63;
  const int gw = blockIdx.x * 8 + (tid >> 6), nw = gridDim.x * 8;
  float4 gv[4];
#pragma unroll
  for (int i = 0; i < 4; ++i) gv[i] = *(const float4*)(g + i * 256 + lane * 4);
  for (int row = gw; row < nrows; row += nw) {
    const float* s = src + (size_t)row * 1024;
    float4 v[4]; float ss = 0.f;
#pragma unroll
    for (int i = 0; i < 4; ++i) { v[i] = *(const float4*)(s + i * 256 + lane * 4); ss += v[i].x * v[i].x + v[i].y * v[i].y + v[i].z * v[i].z + v[i].w * v[i].w; }
    ss = wave_sum(ss);
    const float rs = rsqrtf(ss * (1.0f / 1024.0f) + 1e-6f);
#pragma unroll
    for (int i = 0; i < 4; ++i) {
      const float a = v[i].x * rs * gv[i].x, b = v[i].y * rs * gv[i].y, c = v[i].z * rs * gv[i].z, d = v[i].w * rs * gv[i].w;
      if (F32OUT) { *(float4*)((float*)dst + (size_t)row * 1024 + i * 256 + lane * 4) = make_float4(a + pd, b + pd, c + pd, d + pd); }
      else { uint2 o; o.x = pack2(a, b); o.y = pack2(c, d); *(uint2*)((bf16_t*)dst + (size_t)row * 1024 + i * 256 + lane * 4) = o; }
    }
  }
}

__device__ void rwkv_prep_item(const Params& P, int l, int item, unsigned char* lds) {
#ifdef OFF_rwkv_prep_item
  return;
#endif

  const bf16_t* p = (const bf16_t*)(P.ws + WS_P);
  float* PW = (float*)(P.ws + WS_PW); bf16_t* PV = (bf16_t*)(P.ws + WS_PV); float* RK = (float*)(P.ws + WS_RK);
  float* lora = (float*)lds;
  const int tid = opaque_tid(), lane = tid & 63, w = tid >> 6, head = w & 3, sub = w >> 2;
  const int c = head * 64 + lane;
  const float* mu = P.in[4] + l * 832;
  const float mur = mu[c], muk = mu[256 + c], muv = mu[512 + c], mux = mu[768 + lane];
  const float w0 = P.in[5][l * 256 + c], a0 = P.in[7][l * 256 + c];
  const float kkw = P.in[9][l * 256 + c], kaw = P.in[10][l * 256 + c], rkw = P.in[11][l * 256 + c];
  float wup[32], aup[32];
#pragma unroll
  for (int j = 0; j < 32; ++j) { wup[j] = P.in[6][(l * 32 + j) * 256 + c]; aup[j] = P.in[8][(l * 32 + j) * 256 + c]; }
  bf16_t raw[4][8];
#define PREP_LOAD(g) { _Pragma("unroll") for (int j_ = 0; j_ < 4; ++j_) { const int t_ = item * 32 + sub + 2 * ((g) * 4 + j_); const bool hp_ = (t_ & (TSEQ - 1)) > 0; \
      const bf16_t* pr_ = p + (size_t)t_ * NIN; raw[j_][0] = pr_[c]; raw[j_][1] = pr_[256 + c]; raw[j_][2] = pr_[512 + c]; raw[j_][3] = pr_[768 + lane]; \
      raw[j_][4] = hp_ ? pr_[c - NIN] : (bf16_t)0; raw[j_][5] = hp_ ? pr_[256 + c - NIN] : (bf16_t)0; raw[j_][6] = hp_ ? pr_[512 + c - NIN] : (bf16_t)0; raw[j_][7] = hp_ ? pr_[768 + lane - NIN] : (bf16_t)0; } }
  PREP_LOAD(0);
#pragma unroll 1
  for (int g = 0; g < 4; ++g) {
    float rr[4], kk4[4], vv4[4];
#pragma unroll
    for (int j = 0; j < 4; ++j) {
      float r = bf2f(raw[j][0]), k = bf2f(raw[j][1]), v = bf2f(raw[j][2]), x = bf2f(raw[j][3]);
      r += (bf2f(raw[j][4]) - r) * mur; k += (bf2f(raw[j][5]) - k) * muk; v += (bf2f(raw[j][6]) - v) * muv; x += (bf2f(raw[j][7]) - x) * mux;
      rr[j] = r; kk4[j] = k; vv4[j] = v;
      lora[(w * 4 + j) * 64 + lane] = lane < 32 ? tanhf(x) : x;
    }
    if (g < 3) PREP_LOAD(g + 1);
    __builtin_amdgcn_s_waitcnt(0xc07f);
    __builtin_amdgcn_wave_barrier();
#pragma unroll
    for (int j = 0; j < 4; ++j) {
      const int t = item * 32 + sub + 2 * (g * 4 + j);
      const int tt = t & (TSEQ - 1), b = t >> 13;
      const float r = rr[j], k = kk4[j], v = vv4[j];
      float wv = w0, av = a0;
      const float* lo = lora + (w * 4 + j) * 64;
#pragma unroll
      for (int jj = 0; jj < 32; ++jj) { wv += lo[jj] * wup[jj]; av += lo[32 + jj] * aup[jj]; }
      const float wlog = -softplusf_(-wv) - 0.5f;
      const float decay = __expf(-__expf(wlog));
      const float ar = sigmoidf_(av);
      const float kk = k * kkw;
      const float n2 = wave_sum(kk * kk);
      const float kkn = kk / fmaxf(sqrtf(n2), 1e-12f);
      const float kmod = k * (1.0f + (ar - 1.0f) * kaw);
      const float rk = wave_sum(r * kmod * rkw);
      const size_t idx = (size_t)(b * 4 + head) * TSEQ + tt;
      PW[idx * 64 + lane] = decay;
      bf16_t* pv = PV + idx * 320;
      pv[lane] = f2bf(r); pv[64 + lane] = f2bf(kmod); pv[128 + lane] = f2bf(v); pv[192 + lane] = f2bf(-kkn); pv[256 + lane] = f2bf(kkn * ar);
      if (lane == 0) RK[idx] = rk;
    }
    __builtin_amdgcn_s_waitcnt(0xc07f);
    __builtin_amdgcn_wave_barrier();
  }
#undef PREP_LOAD
  __syncthreads();
}

#define RW_TILE_B (RW_TT * 1536)
struct RwRegs { float4 pw; uint4 pv0, pv1; };
__device__ __forceinline__ void rw_issue(const float* __restrict__ PW, const bf16_t* __restrict__ PV, size_t idx0, int tid, RwRegs& r) {
  if (tid < RW_TT * 16) { const int s = tid >> 4, q = tid & 15; r.pw = *(const float4*)(PW + (idx0 + s) * 64 + q * 4); }
  { const int c = tid; const int s = c / 40, q = c % 40; r.pv0 = *(const uint4*)(PV + (idx0 + s) * 320 + q * 8); }
  if (tid < RW_TT * 40 - NTHR) { const int c = tid + NTHR; const int s = c / 40, q = c % 40; r.pv1 = *(const uint4*)(PV + (idx0 + s) * 320 + q * 8); }
}
__device__ __forceinline__ void rw_put(float* dst, int c, const uint4 u) {
  const int s = c / 40, q = c % 40;
  const int vec = q >> 3, off = (q & 7) * 8;
  const int slot = vec == 0 ? 4 : vec == 1 ? 3 : vec == 2 ? 5 : vec == 3 ? 1 : 2;
  float* d = dst + s * 384 + slot * 64 + off;
  *(float4*)d = make_float4(__uint_as_float(u.x << 16), __uint_as_float(u.x & 0xffff0000u), __uint_as_float(u.y << 16), __uint_as_float(u.y & 0xffff0000u));
  *(float4*)(d + 4) = make_float4(__uint_as_float(u.z << 16), __uint_as_float(u.z & 0xffff0000u), __uint_as_float(u.w << 16), __uint_as_float(u.w & 0xffff0000u));
}
__device__ __forceinline__ void rw_commit(unsigned char* dstb, int tid, const RwRegs& r) {
  float* dst = (float*)dstb;
  if (tid < RW_TT * 16) { const int s = tid >> 4, q = tid & 15; *(float4*)(dst + s * 384 + q * 4) = r.pw; }
  rw_put(dst, tid, r.pv0);
  if (tid < RW_TT * 40 - NTHR) rw_put(dst, tid + NTHR, r.pv1);
}

#define LD8(dst, ptr) { const float4 x0_ = *(const float4*)(ptr), x1_ = *(const float4*)((ptr) + 4); dst[0] = (f32x2){x0_.x, x0_.y}; dst[1] = (f32x2){x0_.z, x0_.w}; dst[2] = (f32x2){x1_.x, x1_.y}; dst[3] = (f32x2){x1_.z, x1_.w}; }
struct RwOps { f32x2 w[4], a[4], b[4], k[4], r[4]; float vA, vB; };
template <int MODE>
__device__ __forceinline__ void rw_ldops(RwOps& o, const float* tb, int s, int q, int rowA, int rowB) {
  const float* sp = tb + s * 384 + q * 8;
  LD8(o.w, sp); LD8(o.a, sp + 64); LD8(o.b, sp + 128); LD8(o.k, sp + 192);
  o.vA = tb[s * 384 + 320 + rowA];
  if (MODE == 0) { LD8(o.r, sp + 256); o.vB = tb[s * 384 + 320 + rowB]; }
}
template <int MODE>
__device__ __forceinline__ void rw_step(const RwOps& o, f32x2 (&SA)[4], f32x2 (&SB)[4], float* yb, int s, int q, int rowA, int rowB) {
  f32x2 dA = SA[0] * o.a[0], dB = SB[0] * o.a[0];
#pragma unroll
  for (int e = 1; e < 4; ++e) { dA = SA[e] * o.a[e] + dA; dB = SB[e] * o.a[e] + dB; }
  const float dotA = red8(dA.x + dA.y), dotB = red8(dB.x + dB.y);
  const f32x2 dA2 = {dotA, dotA}, dB2 = {dotB, dotB}, vA2 = {o.vA, o.vA};
  if (MODE == 0) {
    const f32x2 vB2 = {o.vB, o.vB};
#pragma unroll
    for (int e = 0; e < 4; ++e) { SA[e] = SA[e] * o.w[e] + vA2 * o.k[e]; SA[e] = dA2 * o.b[e] + SA[e]; SB[e] = SB[e] * o.w[e] + vB2 * o.k[e]; SB[e] = dB2 * o.b[e] + SB[e]; }
    f32x2 yA = SA[0] * o.r[0], yB = SB[0] * o.r[0];
#pragma unroll
    for (int e = 1; e < 4; ++e) { yA = SA[e] * o.r[e] + yA; yB = SB[e] * o.r[e] + yB; }
    const float ya = red8(yA.x + yA.y), ybv = red8(yB.x + yB.y);
    if (q == 0) { yb[s * 64 + rowA] = ya; yb[s * 64 + rowB] = ybv; }
  } else {
#pragma unroll
    for (int e = 0; e < 4; ++e) { SA[e] = dA2 * o.b[e] + SA[e] * o.w[e]; SB[e] = SB[e] * o.w[e] + vA2 * o.k[e]; SB[e] = dB2 * o.b[e] + SB[e]; }
  }
}
template <int MODE>
__device__ void rwkv_scan_item(const Params& P, int l, int bh, int chunk, unsigned char* lds) {
  const float* PW = (const float*)(P.ws + WS_PW); const bf16_t* PV = (const bf16_t*)(P.ws + WS_PV); const float* RK = (const float*)(P.ws + WS_RK);
  float* PQ = (float*)(P.ws + WS_PQ);
  bf16_t* p = (bf16_t*)(P.ws + WS_P);
  const int tid = opaque_tid(), lane = tid & 63, w = tid >> 6;
  const int q = lane & 7;
  const int rowA = (MODE == 0) ? ((w & 3) * 16 + (lane >> 3)) : (w * 8 + (lane >> 3));
  const int rowB = rowA + 8;
  const int b = bh >> 2, head = bh & 3;
  unsigned char* tile0 = lds;
  float* ybuf = (float*)(lds + 3 * RW_TILE_B);
  float* Sl = (float*)(lds + 3 * RW_TILE_B + 2 * RW_TT * 256);
  f32x2 SA[4], SB[4];
#pragma unroll
  for (int e = 0; e < 4; ++e) { SA[e] = (f32x2){0.f, 0.f}; SB[e] = (f32x2){0.f, 0.f}; }
  if (MODE == 1) {
#pragma unroll
    for (int e = 0; e < 4; ++e) SA[e] = (f32x2){(q * 8 + 2 * e == rowA) ? 1.f : 0.f, (q * 8 + 2 * e + 1 == rowA) ? 1.f : 0.f};
  }
  if (MODE == 0 && chunk > 0) {
    const float* Q0 = PQ + ((size_t)(bh * RW_C + 0) * 2 + 1) * 4096;
    float* cur = Sl; float* nxt = Sl + 4096;
    for (int i = tid; i < 1024; i += NTHR) *(float4*)(cur + i * 4) = *(const float4*)(Q0 + i * 4);
    float* Pl = (float*)lds;
    float4 pre0 = make_float4(0.f, 0.f, 0.f, 0.f), pre1 = pre0;
    if (chunk > 1) { const float* Pm = PQ + ((size_t)(bh * RW_C + 1) * 2 + 0) * 4096; pre0 = *(const float4*)(Pm + tid * 4); pre1 = *(const float4*)(Pm + (tid + NTHR) * 4); }
    for (int cc = 1; cc < chunk; ++cc) {
      const float* Pm = PQ + ((size_t)(bh * RW_C + cc) * 2 + 0) * 4096;
      const float* Qm = Pm + 4096;
      __syncthreads();
      *(float4*)(Pl + tid * 4) = pre0; *(float4*)(Pl + (tid + NTHR) * 4) = pre1;
      if (cc + 1 < chunk) { const float* Pn = Pm + 8192; pre0 = *(const float4*)(Pn + tid * 4); pre1 = *(const float4*)(Pn + (tid + NTHR) * 4); }
      const int ti = w >> 1;
      float qv[2][4];
#pragma unroll
      for (int jj = 0; jj < 2; ++jj)
#pragma unroll
        for (int r = 0; r < 4; ++r) qv[jj][r] = Qm[(ti * 16 + (lane >> 4) * 4 + r) * 64 + ((w & 1) * 2 + jj) * 16 + (lane & 15)];
      __syncthreads();
#pragma unroll
      for (int jj = 0; jj < 2; ++jj) {
        const int tj = (w & 1) * 2 + jj;
        f32x4 acc = {qv[jj][0], qv[jj][1], qv[jj][2], qv[jj][3]};
#pragma unroll
        for (int ks = 0; ks < 16; ++ks) {
          const float a = cur[(ti * 16 + (lane & 15)) * 64 + ks * 4 + (lane >> 4)];
          const float bb = Pl[(ks * 4 + (lane >> 4)) * 64 + tj * 16 + (lane & 15)];
          acc = __builtin_amdgcn_mfma_f32_16x16x4f32(a, bb, acc, 0, 0, 0);
        }
#pragma unroll
        for (int r = 0; r < 4; ++r) nxt[(ti * 16 + (lane >> 4) * 4 + r) * 64 + tj * 16 + (lane & 15)] = acc[r];
      }
      float* t_ = cur; cur = nxt; nxt = t_;
    }
    __syncthreads();
    LD8(SA, cur + rowA * 64 + q * 8);
    LD8(SB, cur + rowB * 64 + q * 8);
    __syncthreads();
  }
  const size_t idxb = (size_t)bh * TSEQ + (size_t)chunk * RW_CL;
  const int ntile = RW_CL / RW_TT;
  RwRegs rr;
  rw_issue(PW, PV, idxb, tid, rr);
  rw_commit(tile0, tid, rr);
  const int chh = head * 64 + lane;
  const float lng = P.in[12][l * 256 + chh], lnb = P.in[13][l * 256 + chh];
  __syncthreads();
  const int nit = (MODE == 0) ? ntile + 1 : ntile;
  for (int tl = 0; tl < nit; ++tl) {
    if (tl + 1 < ntile) rw_issue(PW, PV, idxb + (size_t)(tl + 1) * RW_TT, tid, rr);
    if (MODE == 1 || w < 4) {
      if (tl < ntile) {
        const float* tb = (const float*)(tile0 + (tl % 3) * RW_TILE_B);
        float* yb = ybuf + (tl & 1) * (RW_TT * 64);
        RwOps oa, ob;
        rw_ldops<MODE>(oa, tb, 0, q, rowA, rowB);
        __builtin_amdgcn_sched_barrier(0);
#pragma unroll 1
        for (int s = 0; s < RW_TT; s += 2) {
          rw_ldops<MODE>(ob, tb, s + 1, q, rowA, rowB);
          __builtin_amdgcn_sched_barrier(0);
          rw_step<MODE>(oa, SA, SB, yb, s, q, rowA, rowB);
          __builtin_amdgcn_sched_barrier(0);
          if (s + 2 < RW_TT) rw_ldops<MODE>(oa, tb, s + 2, q, rowA, rowB);
          __builtin_amdgcn_sched_barrier(0);
          rw_step<MODE>(ob, SA, SB, yb, s + 1, q, rowA, rowB);
          __builtin_amdgcn_sched_barrier(0);
        }
      }
    } else {
      const int fw = w - 4;
      if (tl > 0) {
        f32x4 gcu, rkcu;
#pragma unroll
        for (int u = 0; u < 4; ++u) { const int tt = chunk * RW_CL + (tl - 1) * RW_TT + fw + 4 * u;
          gcu[u] = bf2f(p[(size_t)(b * TSEQ + tt) * NIN + C_GA + chh]); rkcu[u] = RK[(size_t)bh * TSEQ + tt]; }
        const float* tb = (const float*)(tile0 + ((tl - 1) % 3) * RW_TILE_B);
        const float* yb = ybuf + ((tl - 1) & 1) * (RW_TT * 64);
#pragma unroll
        for (int u = 0; u < 4; ++u) {
          const int s = fw + 4 * u;
          const int tt = chunk * RW_CL + (tl - 1) * RW_TT + s;
          const float y = yb[s * 64 + lane];
          const float mean = wave_sum(y) * (1.0f / 64.0f);
          const float dlt = y - mean;
          const float var = wave_sum(dlt * dlt) * (1.0f / 64.0f);
          float o = dlt * rsqrtf(var + 64e-5f) * lng + lnb;
          const float vv = tb[s * 384 + 320 + lane];
          o += rkcu[u] * vv;
          p[(size_t)(b * TSEQ + tt) * NIN + C_GA + chh] = f2bf(o * siluf_(gcu[u]));
        }
      }
    }
    if (tl + 1 < ntile) rw_commit(tile0 + ((tl + 1) % 3) * RW_TILE_B, tid, rr);
    __syncthreads();
  }
  if (MODE == 1) {
    float* Pm = PQ + ((size_t)(bh * RW_C + chunk) * 2 + 0) * 4096 + rowA * 64 + q * 8;
    *(float4*)Pm = make_float4(SA[0].x, SA[0].y, SA[1].x, SA[1].y); *(float4*)(Pm + 4) = make_float4(SA[2].x, SA[2].y, SA[3].x, SA[3].y);
    *(float4*)(Pm + 4096) = make_float4(SB[0].x, SB[0].y, SB[1].x, SB[1].y); *(float4*)(Pm + 4100) = make_float4(SB[2].x, SB[2].y, SB[3].x, SB[3].y);
  } else if (chunk == 0 && w < 4) {
    float* Qm = PQ + ((size_t)(bh * RW_C + 0) * 2 + 1) * 4096 + q * 8;
    *(float4*)(Qm + rowA * 64) = make_float4(SA[0].x, SA[0].y, SA[1].x, SA[1].y); *(float4*)(Qm + rowA * 64 + 4) = make_float4(SA[2].x, SA[2].y, SA[3].x, SA[3].y);
    *(float4*)(Qm + rowB * 64) = make_float4(SB[0].x, SB[0].y, SB[1].x, SB[1].y); *(float4*)(Qm + rowB * 64 + 4) = make_float4(SB[2].x, SB[2].y, SB[3].x, SB[3].y);
  }
  __syncthreads();
}

__device__ void conv_item(const Params& P, int l, int item, unsigned char* lds) {
#ifdef OFF_conv_item
  return;
#endif

  bf16_t* p = (bf16_t*)(P.ws + WS_P);
  float* u = (float*)lds;
  float* yb = (float*)(lds + 62 * 1024);
  const int tid = opaque_tid(), c = tid & 255, half = tid >> 8;
  const int t0 = item * 32, tt0 = t0 & (TSEQ - 1);
  {
    bf16_t rv[31], rg[31];
#pragma unroll
    for (int i = 0; i < 31; ++i) { const int r = half + 2 * i; const bool ok = (tt0 - 30 + r) >= 0; const bf16_t* pr = p + (size_t)(t0 - 30 + r) * NIN;
      rv[i] = ok ? pr[C_CVAL + c] : (bf16_t)0; rg[i] = ok ? pr[C_CGLU + c] : (bf16_t)0; }
#pragma unroll
    for (int i = 0; i < 31; ++i) u[(half + 2 * i) * 256 + c] = bf2f(rv[i]) * sigmoidf_(bf2f(rg[i]));
  }
  float wv[31];
#pragma unroll
  for (int j = 0; j < 31; ++j) wv[j] = P.in[14][(l * 31 + j) * 256 + c];
  const float bias = P.in[15][l * 256 + c];
  __syncthreads();
  {
    float win[46];
#pragma unroll
    for (int i = 0; i < 46; ++i) win[i] = u[(half * 16 + i) * 256 + c];
#pragma unroll
    for (int i = 0; i < 16; ++i) {
      float acc = bias;
#pragma unroll
      for (int j = 0; j < 31; ++j) acc = fmaf(wv[j], win[i + j], acc);
      yb[(half * 16 + i) * 256 + c] = acc;
    }
  }
  __syncthreads();
  const int lane = tid & 63, w = tid >> 6;
  const float4 g = *(const float4*)(P.in[16] + l * 256 + lane * 4), bb = *(const float4*)(P.in[17] + l * 256 + lane * 4);
  uint2 gpre[4];
#pragma unroll
  for (int i = 0; i < 4; ++i) gpre[i] = *(const uint2*)(p + (size_t)(t0 + w * 4 + i) * NIN + C_CGATE + lane * 4);
#pragma unroll
  for (int i = 0; i < 4; ++i) {
    const int tk = w * 4 + i;
    const float4 v = *(const float4*)(yb + tk * 256 + lane * 4);
    const float mean = wave_sum(v.x + v.y + v.z + v.w) * (1.0f / 256.0f);
    const float d0 = v.x - mean, d1 = v.y - mean, d2 = v.z - mean, d3 = v.w - mean;
    const float var = wave_sum(d0 * d0 + d1 * d1 + d2 * d2 + d3 * d3) * (1.0f / 256.0f);
    const float rs = rsqrtf(var + 1e-5f);
    bf16_t* gp = p + (size_t)(t0 + tk) * NIN + C_CGATE + lane * 4;
    const uint2 gu = gpre[i];
    const float o0 = siluf_(d0 * rs * g.x + bb.x) * siluf_(__uint_as_float(gu.x << 16));
    const float o1 = siluf_(d1 * rs * g.y + bb.y) * siluf_(__uint_as_float(gu.x & 0xffff0000u));
    const float o2 = siluf_(d2 * rs * g.z + bb.z) * siluf_(__uint_as_float(gu.y << 16));
    const float o3 = siluf_(d3 * rs * g.w + bb.w) * siluf_(__uint_as_float(gu.y & 0xffff0000u));
    uint2 o; o.x = pack2(o0, o1); o.y = pack2(o2, o3);
    *(uint2*)gp = o;
  }
  __syncthreads();
}

#define HG_WLDS 10240
__device__ __forceinline__ float hgrn_lb(const Params& P, int l, int ch) {
  if (l == 0) return 0.f;
  const float x0 = P.in[18][ch], x1 = P.in[18][256 + ch];
  return __builtin_amdgcn_rcpf(1.0f + __expf(x0 - x1));
}
template <int PASS>
__device__ void hgrn_wave_item(const Params& P, int l, int wi, unsigned char* lds) {
#ifdef OFF_hgrn_wave_item
  return;
#endif

  bf16_t* p = (bf16_t*)(P.ws + WS_P);
  float* HS = (float*)(P.ws + WS_HS); float* HF = (float*)(P.ws + WS_HF);
  const int tid = opaque_tid();
  const int lane = tid & 63, w = tid >> 6;
  const int bh = wi >> 7, chunk = wi & 127, b = bh >> 2, head = bh & 3;
  float* st = (float*)(lds + w * HG_WLDS);
  float* ob = st + 2048;
  const int kg = lane & 7, vg = lane >> 3;
  const int ch = head * 64 + lane;
  const float lb = hgrn_lb(P, l, ch);
  const float ng = P.in[19][l * 256 + ch];
  float S[8][8];
  float* slot = HS + (size_t)(bh * 128 + chunk) * 4096;
  if (PASS == 1) {
#pragma unroll
    for (int i = 0; i < 8; ++i) { const float4 x0 = *(const float4*)(slot + (kg * 8 + i) * 64 + vg * 8), x1 = *(const float4*)(slot + (kg * 8 + i) * 64 + vg * 8 + 4);
      S[i][0] = x0.x; S[i][1] = x0.y; S[i][2] = x0.z; S[i][3] = x0.w; S[i][4] = x1.x; S[i][5] = x1.y; S[i][6] = x1.z; S[i][7] = x1.w; }
  } else {
#pragma unroll
    for (int i = 0; i < 8; ++i)
#pragma unroll
      for (int j = 0; j < 8; ++j) S[i][j] = 0.f;
  }
  float Fp = 1.f;
  bf16_t rf[8], ri[8], rq[8], rg[8];
  {
    const int tb0 = b * TSEQ + chunk * 64;
#pragma unroll
    for (int s = 0; s < 8; ++s) { const bf16_t* pr = p + (size_t)(tb0 + s) * NIN; rf[s] = pr[C_HF + ch]; ri[s] = pr[C_HI + ch]; if (PASS == 1) { rq[s] = pr[C_HQ + ch]; rg[s] = pr[C_HG + ch]; } }
  }
#pragma unroll 1
  for (int sub = 0; sub < 8; ++sub) {
    const int tbase = b * TSEQ + chunk * 64 + sub * 8;
    bf16_t gc[8];
#pragma unroll
    for (int s = 0; s < 8; ++s) {
      const float f = lb + (1.0f - lb) * sigmoidf_(bf2f(rf[s]));
      Fp *= f;
      st[s * 256 + lane] = f; st[s * 256 + 64 + lane] = 1.0f - f;
      if (PASS == 1) { st[s * 256 + 128 + lane] = siluf_(bf2f(rq[s])); gc[s] = rg[s]; }
      st[s * 256 + 192 + lane] = bf2f(ri[s]);
    }
    if (sub < 7) {
#pragma unroll
      for (int s = 0; s < 8; ++s) { const bf16_t* pr = p + (size_t)(tbase + 8 + s) * NIN; rf[s] = pr[C_HF + ch]; ri[s] = pr[C_HI + ch]; if (PASS == 1) { rq[s] = pr[C_HQ + ch]; rg[s] = pr[C_HG + ch]; } }
    }
    __builtin_amdgcn_s_waitcnt(0xc07f);
    __builtin_amdgcn_wave_barrier();
#pragma unroll 1
    for (int s = 0; s < 8; ++s) {
      const float* sp = st + s * 256;
      const float4 f0 = *(const float4*)(sp + kg * 8), f1 = *(const float4*)(sp + kg * 8 + 4);
      const float4 k0 = *(const float4*)(sp + 64 + kg * 8), k1 = *(const float4*)(sp + 64 + kg * 8 + 4);
      const float4 v0 = *(const float4*)(sp + 192 + vg * 8), v1 = *(const float4*)(sp + 192 + vg * 8 + 4);
      const float fv[8] = {f0.x, f0.y, f0.z, f0.w, f1.x, f1.y, f1.z, f1.w};
      const float kv[8] = {k0.x, k0.y, k0.z, k0.w, k1.x, k1.y, k1.z, k1.w};
      const float vv[8] = {v0.x, v0.y, v0.z, v0.w, v1.x, v1.y, v1.z, v1.w};
#pragma unroll
      for (int i = 0; i < 8; ++i)
#pragma unroll
        for (int j = 0; j < 8; ++j) S[i][j] = fmaf(fv[i], S[i][j], kv[i] * vv[j]);
      if (PASS == 1) {
        const float4 q0 = *(const float4*)(sp + 128 + kg * 8), q1 = *(const float4*)(sp + 128 + kg * 8 + 4);
        const float qv[8] = {q0.x, q0.y, q0.z, q0.w, q1.x, q1.y, q1.z, q1.w};
        float o[8];
#pragma unroll
        for (int j = 0; j < 8; ++j) { float a = qv[0] * S[0][j];
#pragma unroll
          for (int i = 1; i < 8; ++i) a = fmaf(qv[i], S[i][j], a);
          o[j] = red8(a); }
        if (kg == 0) { *(float4*)(ob + s * 64 + vg * 8) = make_float4(o[0], o[1], o[2], o[3]); *(float4*)(ob + s * 64 + vg * 8 + 4) = make_float4(o[4], o[5], o[6], o[7]); }
      }
    }
    __builtin_amdgcn_s_waitcnt(0xc07f);
    __builtin_amdgcn_wave_barrier();
    if (PASS == 1) {
#pragma unroll
      for (int s = 0; s < 8; ++s) {
        const float o = ob[s * 64 + lane];
        const float ms = wave_sum(o * o) * (1.0f / 64.0f);
        p[(size_t)(tbase + s) * NIN + C_HG + ch] = f2bf(o * rsqrtf(ms + 1e-6f) * ng * siluf_(bf2f(gc[s])));
      }
      __builtin_amdgcn_s_waitcnt(0xc07f);
      __builtin_amdgcn_wave_barrier();
    }
  }
  if (PASS == 0) {
#pragma unroll
    for (int i = 0; i < 8; ++i) { *(float4*)(slot + (kg * 8 + i) * 64 + vg * 8) = make_float4(S[i][0], S[i][1], S[i][2], S[i][3]);
      *(float4*)(slot + (kg * 8 + i) * 64 + vg * 8 + 4) = make_float4(S[i][4], S[i][5], S[i][6], S[i][7]); }
    HF[(size_t)(bh * 128 + chunk) * 64 + lane] = Fp;
  }
}
__device__ void hgrn_combine_item(const Params& P, int bh) {
#ifdef OFF_hgrn_combine_item
  return;
#endif

  float* HS = (float*)(P.ws + WS_HS); const float* HF = (const float*)(P.ws + WS_HF);
  const int tid = opaque_tid();
  const int krow = tid >> 3;
  float R[8];
#pragma unroll
  for (int e = 0; e < 8; ++e) R[e] = 0.f;
  float4 xa[8][2]; float fa[8];
#pragma unroll
  for (int u = 0; u < 8; ++u) { const float* sl = HS + (size_t)(bh * 128 + u) * 4096 + tid * 8; xa[u][0] = *(const float4*)sl; xa[u][1] = *(const float4*)(sl + 4); fa[u] = HF[(size_t)(bh * 128 + u) * 64 + krow]; }
#pragma unroll 1
  for (int c0 = 0; c0 < 128; c0 += 8) {
    float4 xn[8][2]; float fn[8];
    if (c0 + 8 < 128) {
#pragma unroll
      for (int u = 0; u < 8; ++u) { const float* sl = HS + (size_t)(bh * 128 + c0 + 8 + u) * 4096 + tid * 8; xn[u][0] = *(const float4*)sl; xn[u][1] = *(const float4*)(sl + 4); fn[u] = HF[(size_t)(bh * 128 + c0 + 8 + u) * 64 + krow]; }
    }
#pragma unroll
    for (int u = 0; u < 8; ++u) {
      float* sl = HS + (size_t)(bh * 128 + c0 + u) * 4096 + tid * 8;
      *(float4*)sl = make_float4(R[0], R[1], R[2], R[3]); *(float4*)(sl + 4) = make_float4(R[4], R[5], R[6], R[7]);
      const float f = fa[u];
      R[0] = fmaf(f, R[0], xa[u][0].x); R[1] = fmaf(f, R[1], xa[u][0].y); R[2] = fmaf(f, R[2], xa[u][0].z); R[3] = fmaf(f, R[3], xa[u][0].w);
      R[4] = fmaf(f, R[4], xa[u][1].x); R[5] = fmaf(f, R[5], xa[u][1].y); R[6] = fmaf(f, R[6], xa[u][1].z); R[7] = fmaf(f, R[7], xa[u][1].w);
    }
    if (c0 + 8 < 128) {
#pragma unroll
      for (int u = 0; u < 8; ++u) { xa[u][0] = xn[u][0]; xa[u][1] = xn[u][1]; fa[u] = fn[u]; }
    }
  }
}

__device__ void sb_item(const Params& P, int item, unsigned char* lds) {
#ifdef OFF_sb_item
  return;
#endif

  bf16_t* p = (bf16_t*)(P.ws + WS_P);
  const int tid = opaque_tid(), lane = tid & 63, w = tid >> 6;
  const int qt = item & 127, bh = item >> 7, b = bh >> 2, head = bh & 3;
  unsigned char* Qs = lds;
  unsigned char* Ks = lds + 9216;
  unsigned char* Vt = lds + 18432;
  unsigned char* As = lds + 27648;
  float* Zs = (float*)(lds + 36864);
  volatile int* flag = (volatile int*)(lds + 36864 + 64 * 65 * 4);
  const int lrow = tid >> 3, lch = (tid & 7);
  const size_t tokq = (size_t)b * TSEQ + qt * 64;
  *(uint4*)(Qs + lrow * 144 + lch * 16) = *(const uint4*)(p + (tokq + lrow) * NIN + C_SQ + head * 64 + lch * 8);
  float carry = 0.f;
  f32x4 oacc[2] = {{0.f, 0.f, 0.f, 0.f}, {0.f, 0.f, 0.f, 0.f}};
  const int qi = w >> 1, t2 = (w & 1) * 2;
  const int q = tid >> 3, seg = tid & 7;
  uint4 kreg = *(const uint4*)(p + (tokq + lrow) * NIN + C_SK + head * 64 + lch * 8);
  uint4 vreg = *(const uint4*)(p + (tokq + lrow) * NIN + C_SV + head * 64 + lch * 8);
  for (int kt = qt; kt >= 0; --kt) {
    __syncthreads();
    *(uint4*)(Ks + lrow * 144 + lch * 16) = kreg;
    { const unsigned vw[4] = {vreg.x, vreg.y, vreg.z, vreg.w};
#pragma unroll
      for (int e = 0; e < 8; ++e) *(unsigned short*)(Vt + (lch * 8 + e) * 144 + lrow * 2) = (unsigned short)((e & 1) ? (vw[e >> 1] >> 16) : (vw[e >> 1] & 0xffffu)); }
    if (tid == 0) *flag = 0;
    if (kt > 0) { const size_t tokn = (size_t)b * TSEQ + (kt - 1) * 64;
      kreg = *(const uint4*)(p + (tokn + lrow) * NIN + C_SK + head * 64 + lch * 8);
      vreg = *(const uint4*)(p + (tokn + lrow) * NIN + C_SV + head * 64 + lch * 8); }
    __syncthreads();
#pragma unroll
    for (int jj = 0; jj < 2; ++jj) {
      const int ki = t2 + jj;
      f32x4 acc = {0.f, 0.f, 0.f, 0.f};
#pragma unroll
      for (int s = 0; s < 2; ++s) {
        const bf16x8 a = *(const bf16x8*)(Qs + (qi * 16 + (lane & 15)) * 144 + s * 64 + (lane >> 4) * 16);
        const bf16x8 bb = *(const bf16x8*)(Ks + (ki * 16 + (lane & 15)) * 144 + s * 64 + (lane >> 4) * 16);
        acc = __builtin_amdgcn_mfma_f32_16x16x32_bf16(a, bb, acc, 0, 0, 0);
      }
#pragma unroll
      for (int r = 0; r < 4; ++r) Zs[(qi * 16 + (lane >> 4) * 4 + r) * 65 + ki * 16 + (lane & 15)] = acc[r] * 0.125f;
    }
    __syncthreads();
    {
      const int tq = qt * 64 + q;
      float z[8], lk[8];
      float tot = 0.f;
#pragma unroll
      for (int e = 0; e < 8; ++e) {
        z[e] = Zs[q * 65 + seg * 8 + e];
        const bool m = (kt * 64 + seg * 8 + e) < tq;
        lk[e] = m ? -softplus_fast(z[e]) : 0.f;
        tot += lk[e];
      }
      float inc = tot;
      { float t_ = __shfl_down(inc, 1, 8); if (seg + 1 < 8) inc += t_; }
      { float t_ = __shfl_down(inc, 2, 8); if (seg + 2 < 8) inc += t_; }
      { float t_ = __shfl_down(inc, 4, 8); if (seg + 4 < 8) inc += t_; }
      const float rowtot = __shfl(inc, 0, 8);
      float tail = carry + (inc - tot);
      float av[8];
#pragma unroll
      for (int e = 7; e >= 0; --e) {
        const bool m = (kt * 64 + seg * 8 + e) < tq;
        av[e] = m ? __expf(z[e] + lk[e] + tail) : 0.f;
        tail += lk[e];
      }
      uint4 o; o.x = pack2(av[0], av[1]); o.y = pack2(av[2], av[3]); o.z = pack2(av[4], av[5]); o.w = pack2(av[6], av[7]);
      *(uint4*)(As + q * 144 + seg * 16) = o;
      carry += rowtot;
      if (carry > -100.f) *flag = 1;
    }
    __syncthreads();
#pragma unroll
    for (int jj = 0; jj < 2; ++jj) {
      const int di = t2 + jj;
#pragma unroll
      for (int s = 0; s < 2; ++s) {
        const bf16x8 a = *(const bf16x8*)(As + (qi * 16 + (lane & 15)) * 144 + s * 64 + (lane >> 4) * 16);
        const bf16x8 bb = *(const bf16x8*)(Vt + (di * 16 + (lane & 15)) * 144 + s * 64 + (lane >> 4) * 16);
        oacc[jj] = __builtin_amdgcn_mfma_f32_16x16x32_bf16(a, bb, oacc[jj], 0, 0, 0);
      }
    }
    if (*flag == 0) break;
  }
#pragma unroll
  for (int jj = 0; jj < 2; ++jj) {
    const int d = (t2 + jj) * 16 + (lane & 15);
#pragma unroll
    for (int r = 0; r < 4; ++r) {
      const int qq = qi * 16 + (lane >> 4) * 4 + r;
      bf16_t* gp = p + (tokq + qq) * NIN + C_SG + head * 64 + d;
      *gp = f2bf(oacc[jj][r] * siluf_(bf2f(*gp)));
    }
  }
  __syncthreads();
}

__device__ void xattn_item(const Params& P, int l, int item, unsigned char* lds) {
#ifdef OFF_xattn_item
  return;
#endif

  const bf16_t* qb = (const bf16_t*)(P.ws + WS_P + 32ull * MiB);
  bf16_t* ob = (bf16_t*)(P.ws + WS_P + 64ull * MiB);
  const bf16_t* kv = (const bf16_t*)(P.ws + WS_KV) + (size_t)l * 512 * 2048;
  const int tid = opaque_tid(), lane = tid & 63, w = tid >> 6;
  const int qt = item & 127, bh = item >> 7, b = bh >> 2, head = bh & 3;
  unsigned char* Qs = lds;
  unsigned char* KVs = lds + 33792;
  float* Ss = (float*)(lds + 67584);
  const size_t tok0 = (size_t)b * TSEQ + qt * 64;
  __syncthreads();
#pragma unroll
  for (int i = 0; i < 4; ++i) { const int c = tid + i * NTHR, r = c >> 5, cc = c & 31;
    *(uint4*)(Qs + r * 528 + cc * 16) = *(const uint4*)(qb + (tok0 + r) * 1024 + head * 256 + cc * 8); }
  const int qi = w >> 1, t2 = (w & 1) * 2;
  for (int kb = 0; kb < 4; ++kb) {
    __syncthreads();
#pragma unroll
    for (int i = 0; i < 4; ++i) { const int c = tid + i * NTHR, r = c >> 5, cc = c & 31;
      *(uint4*)(KVs + r * 528 + cc * 16) = *(const uint4*)(kv + (size_t)(b * 256 + kb * 64 + r) * 2048 + head * 256 + cc * 8); }
    __syncthreads();
#pragma unroll
    for (int jj = 0; jj < 2; ++jj) {
      const int ki = t2 + jj;
      f32x4 acc = {0.f, 0.f, 0.f, 0.f};
#pragma unroll
      for (int s = 0; s < 8; ++s) {
        const bf16x8 a = *(const bf16x8*)(Qs + (qi * 16 + (lane & 15)) * 528 + s * 64 + (lane >> 4) * 16);
        const bf16x8 bb = *(const bf16x8*)(KVs + (ki * 16 + (lane & 15)) * 528 + s * 64 + (lane >> 4) * 16);
        acc = __builtin_amdgcn_mfma_f32_16x16x32_bf16(a, bb, acc, 0, 0, 0);
      }
#pragma unroll
      for (int r = 0; r < 4; ++r) Ss[(qi * 16 + (lane >> 4) * 4 + r) * 260 + kb * 64 + ki * 16 + (lane & 15)] = acc[r] * 0.0625f;
    }
  }
  __syncthreads();
  {
    const int q = tid >> 3, seg = tid & 7;
    float x[32]; float mx = -3.0e38f;
#pragma unroll
    for (int i = 0; i < 8; ++i) { const float4 v = *(const float4*)(Ss + q * 260 + seg * 32 + i * 4); x[i * 4] = v.x; x[i * 4 + 1] = v.y; x[i * 4 + 2] = v.z; x[i * 4 + 3] = v.w;
      mx = fmaxf(mx, fmaxf(fmaxf(v.x, v.y), fmaxf(v.z, v.w))); }
    mx = fmaxf(mx, __shfl_xor(mx, 1)); mx = fmaxf(mx, __shfl_xor(mx, 2)); mx = fmaxf(mx, __shfl_xor(mx, 4));
    float sum = 0.f;
#pragma unroll
    for (int i = 0; i < 32; ++i) { x[i] = __expf(x[i] - mx); sum += x[i]; }
    sum += __shfl_xor(sum, 1); sum += __shfl_xor(sum, 2); sum += __shfl_xor(sum, 4);
    const float inv = __builtin_amdgcn_rcpf(sum);
#pragma unroll
    for (int i = 0; i < 4; ++i) { uint4 o; o.x = pack2(x[i * 8] * inv, x[i * 8 + 1] * inv); o.y = pack2(x[i * 8 + 2] * inv, x[i * 8 + 3] * inv);
      o.z = pack2(x[i * 8 + 4] * inv, x[i * 8 + 5] * inv); o.w = pack2(x[i * 8 + 6] * inv, x[i * 8 + 7] * inv);
      *(uint4*)(Qs + q * 528 + seg * 64 + i * 16) = o; }
  }
  for (int db = 0; db < 4; ++db) {
    __syncthreads();
#pragma unroll
    for (int i = 0; i < 4; ++i) { const int c = tid + i * NTHR, m = c >> 3, dc = c & 7;
      const uint4 vv = *(const uint4*)(kv + (size_t)(b * 256 + m) * 2048 + 1024 + head * 256 + db * 64 + dc * 8);
      const unsigned short* ve = (const unsigned short*)&vv;
#pragma unroll
      for (int e = 0; e < 8; ++e) *(unsigned short*)(KVs + (dc * 8 + e) * 528 + m * 2) = ve[e]; }
    __syncthreads();
#pragma unroll
    for (int jj = 0; jj < 2; ++jj) {
      const int di = t2 + jj;
      f32x4 acc = {0.f, 0.f, 0.f, 0.f};
#pragma unroll
      for (int s = 0; s < 8; ++s) {
        const bf16x8 a = *(const bf16x8*)(Qs + (qi * 16 + (lane & 15)) * 528 + s * 64 + (lane >> 4) * 16);
        const bf16x8 bb = *(const bf16x8*)(KVs + (di * 16 + (lane & 15)) * 528 + s * 64 + (lane >> 4) * 16);
        acc = __builtin_amdgcn_mfma_f32_16x16x32_bf16(a, bb, acc, 0, 0, 0);
      }
#pragma unroll
      for (int r = 0; r < 4; ++r) ob[(tok0 + qi * 16 + (lane >> 4) * 4 + r) * 1024 + head * 256 + db * 64 + di * 16 + (lane & 15)] = f2bf(acc[r]);
    }
  }
  __syncthreads();
}

__global__ void __launch_bounds__(NTHR) fwd_megakernel(Params P) {
  extern __shared__ __attribute__((aligned(16))) unsigned char lds[];
  __shared__ uint4 xb_words;
  if (threadIdx.x == 0) xb_words = make_uint4(0u, 0u, 0u, 0u);
  __syncthreads();
#ifdef PROBE_J
  __shared__ unsigned long long tacc[32];
  __shared__ unsigned long long tlast;
  __shared__ float pdelta;
  if (threadIdx.x == 0) { for (int i = 0; i < 32; ++i) tacc[i] = 0ull; tlast = __builtin_amdgcn_s_memrealtime(); pdelta = 0.f; }
#define STAMP(k) if (threadIdx.x == 0) { const unsigned long long n_ = __builtin_amdgcn_s_memrealtime(); tacc[k] += n_ - tlast; tlast = n_; }
#else
#define STAMP(k)
#endif
  XcdBarrier bar = xcd_barrier_post((unsigned*)(P.ws + WS_BAR), (volatile LAS unsigned*)&xb_words);
  if (P.never) cg::this_grid().sync();
  const int G = gridDim.x, bid = blockIdx.x;
  unsigned char* ws = P.ws;
  bf16_t* hbuf = (bf16_t*)(ws + WS_R1);
  bf16_t* pbuf = (bf16_t*)(ws + WS_P);
  bf16_t* hx = (bf16_t*)(ws + WS_P);
  bf16_t* qbuf = (bf16_t*)(ws + WS_P + 32ull * MiB);
  bf16_t* obuf = (bf16_t*)(ws + WS_P + 64ull * MiB);

  for (int it = bid; it < 2 * 2256; it += G) {
    const int l = it / 2256; int r = it % 2256;
    const float* W; int N; bf16_t* Wt; int kt, nt;
    unsigned char* wl = ws + WS_WT + l * WT_LAYER;
    if (r < 976) { W = P.in[3] + (size_t)l * 1024 * NIN; N = NIN; Wt = (bf16_t*)(wl + WT_IN); kt = r / 61; nt = r % 61; }
    else { r -= 976; const int m = r >> 8; r &= 255; kt = r >> 4; nt = r & 15; N = 1024;
      if (m == 0) { W = P.in[20] + (size_t)l * 1048576; Wt = (bf16_t*)(wl + WT_OUT); }
      else if (m == 1) { W = P.in[23] + (size_t)l * 1048576; Wt = (bf16_t*)(wl + WT_Q); }
      else if (m == 2) { W = P.in[24] + (size_t)l * 1048576; Wt = (bf16_t*)(wl + WT_KV); }
      else if (m == 3) { W = P.in[25] + (size_t)l * 1048576; Wt = (bf16_t*)(wl + WT_KV) + 1024 * 1024; }
      else { W = P.in[26] + (size_t)l * 1048576; Wt = (bf16_t*)(wl + WT_O); } }
    wt_tile(W, N, Wt, kt, nt, lds);
  }
  norm_rows<false>(P.in[1], P.in[22], (bf16_t*)(ws + WS_MEMN), 512);
  norm_rows<false>(P.in[1], P.in[22] + 1024, (bf16_t*)(ws + WS_MEMN) + 512 * 1024, 512);
  norm_rows<false>(P.in[0], P.in[2], hbuf, NT);
  STAMP(16 + 0); xcd_barrier(bar); STAMP(0)

#pragma unroll 1
  for (int l = 0; l < 2; ++l) {
    const unsigned char* wl = ws + WS_WT + l * WT_LAYER;
    for (int t = bid; t < 1024; t += G) {
      int mi, ni; tile_map(t, 16, mi, ni);
      gemm_tile<0>(hbuf, 1024, 0, 256, 512, 768, (const bf16_t*)(wl + WT_IN), mi * 256, ni * 256, NIN, pbuf, nullptr, NIN, lds);
    }
    STAMP(16 + 1); xcd_barrier(bar); STAMP(1)
    for (int it = bid; it < 640; it += G) {
      if (it < 128) hgrn_wave_item<0>(P, l, it * 8 + (threadIdx.x >> 6), lds);
      else rwkv_prep_item(P, l, it - 128, lds);
      __syncthreads();
    }
    STAMP(16 + 2); xcd_barrier(bar); STAMP(2)
    {
      const int n_p1 = 8 * (RW_C - 2);
      const int n_rw = n_p1 + 8;
      const int n_oth = 8 + 512 + 1024;
      if (G > n_rw + 32) {
        if (bid < n_rw) {
          if (bid < n_p1) rwkv_scan_item<1>(P, l, bid & 7, 1 + (bid >> 3), lds);
          else rwkv_scan_item<0>(P, l, bid - n_p1, 0, lds);
        } else {
          for (int it = bid - n_rw; it < n_oth; it += G - n_rw) {
            if (it < 8) hgrn_combine_item(P, it);
            else if (it < 8 + 512) conv_item(P, l, it - 8, lds);
            else sb_item(P, it - 8 - 512, lds);
            __syncthreads();
          }
        }
      } else {
        for (int it = bid; it < n_rw + n_oth; it += G) {
          if (it < n_p1) rwkv_scan_item<1>(P, l, it & 7, 1 + (it >> 3), lds);
          else if (it < n_rw) rwkv_scan_item<0>(P, l, it - n_p1, 0, lds);
          else if (it < n_rw + 8) hgrn_combine_item(P, it - n_rw);
          else if (it < n_rw + 8 + 512) conv_item(P, l, it - n_rw - 8, lds);
          else sb_item(P, it - n_rw - 8 - 512, lds);
          __syncthreads();
        }
      }
    }
    STAMP(16 + 3); xcd_barrier(bar); STAMP(3)
    {
      const int n_p3 = 8 * (RW_C - 1);
      const int n_all = n_p3 + 128 + 16;
      for (int it = bid; it < n_all; it += G) {
        if (it < n_p3) rwkv_scan_item<0>(P, l, it & 7, 1 + (it >> 3), lds);
        else if (it < n_p3 + 128) hgrn_wave_item<1>(P, l, (it - n_p3) * 8 + (threadIdx.x >> 6), lds);
        else { const int t = it - n_p3 - 128; gemm_tile<0>((const bf16_t*)(ws + WS_MEMN) + (size_t)l * 512 * 1024, 1024, 0, 256, 512, 768, (const bf16_t*)(wl + WT_KV), (t >> 3) * 256, (t & 7) * 256, 2048,
                                                          (bf16_t*)(ws + WS_KV) + (size_t)l * 512 * 2048, nullptr, 2048, lds); }
        __syncthreads();
      }
    }
    STAMP(16 + 4); xcd_barrier(bar); STAMP(4)
    {
      const float* resid = l == 0 ? P.in[0] : P.out;
      for (int t = bid; t < 256; t += G) {
        int mi, ni; tile_map(t, 4, mi, ni);
        gemm_tile<1>(pbuf, NIN, C_GA, C_CGATE, C_HG, C_SG, (const bf16_t*)(wl + WT_OUT), mi * 256, ni * 256, 1024, P.out, resid, 1024, lds);
      }
    }
    STAMP(16 + 5); xcd_barrier(bar); STAMP(5)
    norm_rows<false>(P.out, P.in[21] + l * 1024, hx, NT);
    STAMP(16 + 6); xcd_barrier(bar); STAMP(6)
    for (int t = bid; t < 256; t += G) {
      int mi, ni; tile_map(t, 4, mi, ni);
      gemm_tile<0>(hx, 1024, 0, 256, 512, 768, (const bf16_t*)(wl + WT_Q), mi * 256, ni * 256, 1024, qbuf, nullptr, 1024, lds);
    }
    STAMP(16 + 7); xcd_barrier(bar); STAMP(7)
    for (int it = bid; it < 1024; it += G) xattn_item(P, l, it, lds);
    STAMP(16 + 8); xcd_barrier(bar); STAMP(8)
    for (int t = bid; t < 256; t += G) {
      int mi, ni; tile_map(t, 4, mi, ni);
      gemm_tile<1>(obuf, 1024, 0, 256, 512, 768, (const bf16_t*)(wl + WT_O), mi * 256, ni * 256, 1024, P.out, P.out, 1024, lds);
    }
    STAMP(16 + 9); xcd_barrier(bar); STAMP(9)
    if (l == 0) { norm_rows<false>(P.out, P.in[2] + 1024, hbuf, NT); STAMP(16 + 6); xcd_barrier(bar); STAMP(6) }
  }
#ifdef PROBE_J
  if (bid == PROBE_B) {
    if (threadIdx.x == 0) {
      unsigned long long tot = 0ull; for (int i = 0; i < 10; ++i) tot += tacc[i] + tacc[16 + i];
      pdelta = sqrtf(0.0128f * (float)tacc[PROBE_J] / (float)tot);
    }
    __syncthreads();
  }
  const float pd_ = (bid == PROBE_B) ? pdelta : 0.f;
  norm_rows<true>(P.out, P.in[27], P.out, NT, pd_);
  if (bid == PROBE_B && threadIdx.x == 0) {
    const unsigned long long t0_ = __builtin_amdgcn_s_memrealtime();
    const unsigned long long w_ = 4ull * tacc[PROBE_K];
    while (__builtin_amdgcn_s_memrealtime() - t0_ < w_) __builtin_amdgcn_s_sleep(8);
  }
#else
  norm_rows<true>(P.out, P.in[27], P.out, NT);
#endif
}

extern "C" void kernel_launch(void* const* d_in, const int* in_sizes, int n_in, void* d_out, int out_size, void* d_ws, size_t ws_size, hipStream_t stream) {
  constexpr size_t kDynLds = 147456;
  static int grid_blocks = 0;
  if (!grid_blocks) {
    int dev = 0, cus = 0, per_cu = 0;
    hipGetDevice(&dev);
    hipDeviceGetAttribute(&cus, hipDeviceAttributeMultiprocessorCount, dev);
    hipFuncSetAttribute((const void*)fwd_megakernel, hipFuncAttributeMaxDynamicSharedMemorySize, (int)kDynLds);
    hipOccupancyMaxActiveBlocksPerMultiprocessor(&per_cu, fwd_megakernel, NTHR, kDynLds);
    if (per_cu < 1) per_cu = 1;
    if (per_cu > 1) per_cu = 1;
    grid_blocks = cus * per_cu;
    if (grid_blocks > 256) grid_blocks = 256;
  }
  Params p;
  memset(&p, 0, sizeof(p));
  for (int i = 0; i < 28; ++i) p.in[i] = (const float*)d_in[i];
  p.out = (float*)d_out; p.ws = (unsigned char*)d_ws; p.never = 0; p.pad = 0;
  hipMemsetAsync(d_ws, 0, XCD_BAR_WORDS * 4, stream);
  void* args[] = {&p};
  hipError_t e = hipLaunchCooperativeKernel((void*)fwd_megakernel, dim3(grid_blocks), dim3(NTHR), args, kDynLds, stream);
  if (e != hipSuccess) fprintf(stderr, "cooperative launch failed: %s (grid %d)\n", hipGetErrorString(e), grid_blocks);
}
```

```cpp
#include <hip/hip_runtime.h>
#include <hip/hip_cooperative_groups.h>
#include <stdint.h>
#include <cstdio>
#include <cstring>
namespace cg = cooperative_groups;

typedef unsigned short bf16_t;
typedef short bf16x8 __attribute__((ext_vector_type(8)));
typedef float f32x4 __attribute__((ext_vector_type(4)));
typedef float f32x16 __attribute__((ext_vector_type(16)));
typedef float f32x2 __attribute__((ext_vector_type(2)));
#define LAS __attribute__((address_space(3)))

#define NT 16384
#define TSEQ 8192
#define DM 1024
#define NIN 3904
#define NTHR 512
#define C_R 0
#define C_K 256
#define C_V 512
#define C_XW 768
#define C_GA 832
#define C_CVAL 1088
#define C_CGLU 1344
#define C_CGATE 1600
#define C_HQ 1856
#define C_HF 2112
#define C_HI 2368
#define C_HG 2624
#define C_SQ 2880
#define C_SK 3136
#define C_SV 3392
#define C_SG 3648
#define RW_C 16
#define RW_CL (TSEQ / RW_C)
#define RW_TT 16

#define MiB (1024ull * 1024ull)
#define WS_BAR   0ull
#define WS_WT    (1ull * MiB)
#define WT_LAYER (18ull * MiB)
#define WT_IN    0ull
#define WT_OUT   (8ull * MiB)
#define WT_Q     (10ull * MiB)
#define WT_KV    (12ull * MiB)
#define WT_O     (16ull * MiB)
#define WS_MEMN  (37ull * MiB)
#define WS_KV    (39ull * MiB)
#define WS_PQ    (43ull * MiB)
#define WS_HS    (47ull * MiB)
#define WS_HF    (63ull * MiB)
#define WS_RK    (63ull * MiB + 512ull * 1024ull)
#define WS_R1    (64ull * MiB)
#define WS_PW    WS_R1
#define WS_PV    (WS_R1 + 16ull * MiB)
#define WS_P     (120ull * MiB)
#define WS_END   (243ull * MiB)

struct Params {
  const float* in[28];
  float* out;
  unsigned char* ws;
  int never;
  int pad;
};

typedef const __attribute__((address_space(4))) Params* KP;
__device__ __forceinline__ int lane_id_() { return (int)__builtin_amdgcn_mbcnt_hi(~0u, __builtin_amdgcn_mbcnt_lo(~0u, 0u)); }
__device__ __forceinline__ int opaque_tid(int wv_) { int t; asm volatile("v_mbcnt_lo_u32_b32 %0, -1, 0\n\tv_mbcnt_hi_u32_b32 %0, -1, %0\n\tv_lshl_add_u32 %0, %1, 6, %0" : "=&v"(t) : "s"(wv_)); return t; }
__device__ __forceinline__ float bf2f(bf16_t v) { return __uint_as_float(((unsigned)v) << 16); }
__device__ __forceinline__ bf16_t f2bf(float f) {
  unsigned u = __float_as_uint(f);
  u += 0x7fffu + ((u >> 16) & 1u);
  return (bf16_t)(u >> 16);
}
__device__ __forceinline__ unsigned pack2(float a, float b) { return (unsigned)f2bf(a) | ((unsigned)f2bf(b) << 16); }
__device__ __forceinline__ float sigmoidf_(float x) { return __builtin_amdgcn_rcpf(1.0f + __expf(-x)); }
__device__ __forceinline__ float siluf_(float x) { return x * __builtin_amdgcn_rcpf(1.0f + __expf(-x)); }
__device__ __forceinline__ float softplusf_(float x) { return fmaxf(x, 0.f) + log1pf(__expf(-fabsf(x))); }
__device__ __forceinline__ float softplus_fast(float x) { return fmaxf(x, 0.f) + __logf(1.0f + __expf(-fabsf(x))); }
__device__ __forceinline__ float dpp_add(float v, const int ctrl_sel) {
  return v;
}
__device__ __forceinline__ float bperm(float v, int srclane) { return __builtin_bit_cast(float, __builtin_amdgcn_ds_bpermute(srclane << 2, __builtin_bit_cast(int, v))); }
__device__ __forceinline__ float wave_sum(float v, int lane) {
  v += __builtin_bit_cast(float, __builtin_amdgcn_update_dpp(0, __builtin_bit_cast(int, v), 0xB1, 0xF, 0xF, true));
  v += __builtin_bit_cast(float, __builtin_amdgcn_update_dpp(0, __builtin_bit_cast(int, v), 0x4E, 0xF, 0xF, true));
  v += __builtin_bit_cast(float, __builtin_amdgcn_update_dpp(0, __builtin_bit_cast(int, v), 0x141, 0xF, 0xF, true));
  v += __builtin_bit_cast(float, __builtin_amdgcn_update_dpp(0, __builtin_bit_cast(int, v), 0x140, 0xF, 0xF, true));
  v += bperm(v, lane ^ 16);
  v += bperm(v, lane ^ 32);
  return v;
}
__device__ __forceinline__ float max8(float v) {
  v = fmaxf(v, __builtin_bit_cast(float, __builtin_amdgcn_update_dpp(0, __builtin_bit_cast(int, v), 0xB1, 0xF, 0xF, true)));
  v = fmaxf(v, __builtin_bit_cast(float, __builtin_amdgcn_update_dpp(0, __builtin_bit_cast(int, v), 0x4E, 0xF, 0xF, true)));
  v = fmaxf(v, __builtin_bit_cast(float, __builtin_amdgcn_update_dpp(0, __builtin_bit_cast(int, v), 0x141, 0xF, 0xF, true)));
  return v;
}
__device__ __forceinline__ float red8(float v) {
  v += __builtin_bit_cast(float, __builtin_amdgcn_update_dpp(0, __builtin_bit_cast(int, v), 0xB1, 0xF, 0xF, true));
  v += __builtin_bit_cast(float, __builtin_amdgcn_update_dpp(0, __builtin_bit_cast(int, v), 0x4E, 0xF, 0xF, true));
  v += __builtin_bit_cast(float, __builtin_amdgcn_update_dpp(0, __builtin_bit_cast(int, v), 0x141, 0xF, 0xF, true));
  return v;
}

#define XB_TMO      128
#define XB_XCNT(j)  (256  + 64 * (j))
#define XB_XSUB(j)  (1280 + 64 * (j))
#define XB_XGEN(j)  (2304 + 64 * (j))
#define XB_TOP      3328
#define XB_TOPGEN   3392
#define XCD_BAR_WORDS 3456
#define XB_SPIN_CAP (1u << 22)
__device__ __forceinline__ unsigned xb_ld(unsigned* p) { return __hip_atomic_load(p, __ATOMIC_RELAXED, __HIP_MEMORY_SCOPE_AGENT); }
__device__ __forceinline__ unsigned xb_add(unsigned* p, unsigned v) { return __hip_atomic_fetch_add(p, v, __ATOMIC_RELAXED, __HIP_MEMORY_SCOPE_AGENT); }
__device__ __forceinline__ unsigned xb_xcc_id() { return (unsigned)__builtin_amdgcn_s_getreg((3 << 11) | 20) & 0xFu; }
#define XB_SPIN(cond, bar) do { unsigned _sp = 0; while (cond) { __builtin_amdgcn_s_sleep(1); \
    if ((++_sp & 255u) == 0u) { if (xb_ld(&(bar)[XB_TMO])) break; if (_sp > XB_SPIN_CAP) { atomicAdd(&(bar)[XB_TMO], 1u); break; } } } } while (0)
struct XcdBarrier { unsigned* bar; unsigned x; volatile LAS unsigned* st; };
__device__ __forceinline__ XcdBarrier xcd_barrier_post(unsigned* bar, volatile LAS unsigned* st, int wv_) {
  XcdBarrier b; b.bar = bar; b.x = xb_xcc_id(); b.st = st;
  if (opaque_tid(wv_) == 0) (void)xb_add(&bar[XB_XCNT(b.x)], 1u);
  return b;
}
__device__ __forceinline__ void xcd_barrier_complete(unsigned* bar, unsigned x, unsigned& nloc, unsigned& nx) {
  const unsigned G = gridDim.x * gridDim.y * gridDim.z;
  unsigned sum, cnt, mine, sp = 0u;
  for (;;) {
    sum = 0u; cnt = 0u; mine = 0u;
#pragma unroll
    for (unsigned j = 0; j < 16; ++j) { const unsigned c = xb_ld(&bar[XB_XCNT(j)]); sum += c; cnt += (c > 0u) ? 1u : 0u; mine = (j == x) ? c : mine; }
    if (sum == G) break;
    __builtin_amdgcn_s_sleep(1);
    if ((++sp & 255u) == 0u) { if (xb_ld(&bar[XB_TMO])) break; if (sp > XB_SPIN_CAP) { atomicAdd(&bar[XB_TMO], 1u); break; } }
  }
  nloc = mine > 0u ? mine : 1u; nx = cnt > 0u ? cnt : 1u;
}
__device__ __forceinline__ void xcd_barrier(const XcdBarrier& b, int wv_) {
  asm volatile("s_waitcnt vmcnt(0)" ::: "memory");
  __syncthreads();
  if (opaque_tid(wv_) == 0) {
    unsigned* bar = b.bar;
    __builtin_amdgcn_s_waitcnt(0);
    unsigned bx = b.x; asm volatile("" : "+s"(bx));
    unsigned nloc = b.st[0], nx = b.st[1];
    if (nloc == 0u) { xcd_barrier_complete(bar, bx, nloc, nx); b.st[0] = nloc; b.st[1] = nx; }
    const unsigned old = xb_add(&bar[XB_XSUB(bx)], 1u);
    const unsigned gen = old / nloc;
    if (old + 1u == (gen + 1u) * nloc) {
      __builtin_amdgcn_fence(__ATOMIC_RELEASE, "agent");
      asm volatile("s_waitcnt vmcnt(0)" ::: "memory");
      const unsigned og = xb_add(&bar[XB_TOP], 1u);
      const unsigned tg = og / nx;
      if (og + 1u == (tg + 1u) * nx) xb_add(&bar[XB_TOPGEN], 1u);
      else XB_SPIN(xb_ld(&bar[XB_TOPGEN]) == tg, bar);
      __builtin_amdgcn_fence(__ATOMIC_ACQUIRE, "agent");
      xb_add(&bar[XB_XGEN(bx)], 1u);
      asm volatile("s_waitcnt vmcnt(0)" ::: "memory");
    } else {
      XB_SPIN(xb_ld(&bar[XB_XGEN(bx)]) == gen, bar);
      __builtin_amdgcn_fence(__ATOMIC_ACQUIRE, "agent");
      asm volatile("s_waitcnt vmcnt(0)" ::: "memory");
    }
  }
  __syncthreads();
}

#define G_STAGE 73728
#define G_BOFF 36864
template <int EPI>
__device__ __forceinline__ void gemm_tile(const bf16_t* __restrict__ A, int lda, int ao0, int ao1, int ao2, int ao3,
                                          const bf16_t* __restrict__ Bt, int m0, int n0, int N,
                                          void* out, const float* resid, int ldc, unsigned char* lds, int wv_) {
#ifdef OFF_gemm_tile
  return;
#endif

  const int tid = opaque_tid(wv_), lane = tid & 63, w = tid >> 6;
  const int wm = w >> 2, wn = w & 3, lr = lane & 31, lh = lane >> 5;
  f32x16 acc[4][2];
#pragma unroll
  for (int i = 0; i < 4; ++i)
#pragma unroll
    for (int j = 0; j < 2; ++j)
#pragma unroll
      for (int r = 0; r < 16; ++r) acc[i][j][r] = 0.f;
  uint4 ra[4], rb[4];
  const int crow = tid >> 3, ccol = (tid & 7) * 8;
  const bf16_t* Ap = A + (size_t)(m0 + crow) * lda + ccol;
  const bf16_t* Bp = Bt + (size_t)(n0 + crow) * 1024 + ccol;
#define G_LOAD(kt) { const int k0_ = (kt) * 64; const int seg_ = k0_ >> 8; const int ao_ = (seg_ == 0 ? ao0 : seg_ == 1 ? ao1 : seg_ == 2 ? ao2 : ao3) + (k0_ & 255); \
    _Pragma("unroll") for (int i_ = 0; i_ < 4; ++i_) { ra[i_] = *(const uint4*)(Ap + (size_t)(i_ * 64) * lda + ao_); rb[i_] = *(const uint4*)(Bp + (size_t)(i_ * 64) * 1024 + k0_); } }
#define G_WRITE(buf) { unsigned char* b_ = lds + (buf) * G_STAGE + crow * 144 + (tid & 7) * 16; \
    _Pragma("unroll") for (int i_ = 0; i_ < 4; ++i_) { *(uint4*)(b_ + i_ * 64 * 144) = ra[i_]; *(uint4*)(b_ + G_BOFF + i_ * 64 * 144) = rb[i_]; } }
  G_LOAD(0); G_WRITE(0); __syncthreads();
  for (int kt = 0; kt < 16; ++kt) {
    if (kt < 15) G_LOAD(kt + 1);
    const unsigned char* base = lds + (kt & 1) * G_STAGE;
    const unsigned char* ab = base + (wm * 128 + lr) * 144 + lh * 16;
    const unsigned char* bb = base + G_BOFF + (wn * 64 + lr) * 144 + lh * 16;
#pragma unroll
    for (int s = 0; s < 4; ++s) {
      bf16x8 a[4], b[2];
#pragma unroll
      for (int i = 0; i < 4; ++i) a[i] = *(const bf16x8*)(ab + i * 32 * 144 + s * 32);
#pragma unroll
      for (int j = 0; j < 2; ++j) b[j] = *(const bf16x8*)(bb + j * 32 * 144 + s * 32);
#pragma unroll
      for (int i = 0; i < 4; ++i)
#pragma unroll
        for (int j = 0; j < 2; ++j) acc[i][j] = __builtin_amdgcn_mfma_f32_32x32x16_bf16(a[i], b[j], acc[i][j], 0, 0, 0);
    }
    if (kt < 15) G_WRITE((kt + 1) & 1);
    __syncthreads();
  }
#undef G_LOAD
#undef G_WRITE
#pragma unroll
  for (int i = 0; i < 4; ++i)
#pragma unroll
    for (int j = 0; j < 2; ++j) {
      const int col = n0 + wn * 64 + j * 32 + lr;
#pragma unroll
      for (int r = 0; r < 16; ++r) {
        const int row = m0 + wm * 128 + i * 32 + (r & 3) + 8 * (r >> 2) + 4 * lh;
        if (EPI == 0) { if (col < N) ((bf16_t*)out)[(size_t)row * ldc + col] = f2bf(acc[i][j][r]); }
        else { ((float*)out)[(size_t)row * ldc + col] = resid[(size_t)row * ldc + col] + acc[i][j][r]; }
      }
    }
}

__device__ __forceinline__ void tile_map(int t, int nN, int& mi, int& ni) {
  const int rnd = t >> 8, blk = t & 255, x = blk & 7, y = blk >> 3;
  if (nN == 16) { mi = rnd * 16 + (x >> 1) * 4 + (y & 3); ni = (x & 1) * 8 + (y >> 2); }
  else { mi = rnd * 64 + x * 8 + (y & 7); ni = y >> 3; }
}

namespace pg8 {
#define PG8_LAS __attribute__((address_space(3)))
typedef unsigned u32x4 __attribute__((ext_vector_type(4)));
constexpr int BM = 256, BK = 64, HALF = 128, HTB = HALF * BK * 2  , STAGE_BYTES = 8 * HTB, NXCD = 8, WGM = 8;

__host__ __device__ __forceinline__ int lds_byte(int r, int c) { const int st = (r >> 4) * 2 + (c >> 5), rr = r & 15, cc = c & 31, ob = rr * 64 + cc * 2; return st * 1024 + (ob ^ (((ob >> 9) & 1) << 5)); }
__host__ __device__ __forceinline__ void stage_rc(int b, int& R, int& C) { const int st = b / 1024, sb = b % 1024, swz = sb ^ (((sb >> 9) & 1) << 5); R = (st >> 1) * 16 + swz / 64; C = (st & 1) * 32 + (swz % 64) / 2; }
__host__ __device__ __forceinline__ int perm32(int rho) { const int n = rho >> 4, i = rho & 15; return 8 * (i >> 2) + 4 * n + (i & 3); }

struct Unit { int pm, pn; };
struct Gemm { const bf16_t* A; const bf16_t* Bt; int M, N, K; int lda; int ao0, ao1, ao2, ao3; };

struct TileSched {
    int nt, G, c, nN;
    __device__ __forceinline__ bool next(int i, Unit& u) const { const int t = i * G + c; if (t >= nt) return false; tile_map(t, nN, u.pm, u.pn); return true; }
    __device__ __forceinline__ void a_ready(const Unit&) const {}
    __device__ __forceinline__ void done(const Unit&) const {}
};
__device__ __forceinline__ unsigned cvt_pk_bf16(float lo, float hi) { unsigned r; asm volatile("v_cvt_pk_bf16_f32 %0, %1, %2" : "=v"(r) : "v"(lo), "v"(hi)); return r; }
struct EpiStoreBf16 {
    static constexpr bool PERM = true, AFTER_DRAIN = false;
    bf16_t* O; int ldc; int N;
    __device__ __forceinline__ void operator()(const f32x4 (&acc)[2][2][4][2], const Unit& u, int wr, int wc, int fr, int fq) const {
        const int row0 = u.pm * BM + wr * 64 + fr, col0 = u.pn * BM + wc * 32 + 8 * fq;
#pragma unroll
        for (int ai = 0; ai < 2; ++ai)
#pragma unroll
            for (int m = 0; m < 4; ++m) { bf16_t* rowp = O + (size_t)(row0 + ai * HALF + m * 16) * ldc + col0;
#pragma unroll
                for (int bj = 0; bj < 2; ++bj) { if (col0 + bj * HALF < N) { const f32x4 v0 = acc[ai][bj][m][0], v1 = acc[ai][bj][m][1];
                    u32x4 w; w.x = cvt_pk_bf16(v0[0], v0[1]); w.y = cvt_pk_bf16(v0[2], v0[3]); w.z = cvt_pk_bf16(v1[0], v1[1]); w.w = cvt_pk_bf16(v1[2], v1[3]);
                    *(u32x4*)(rowp + bj * HALF) = w; } } }
    }
};
struct EpiDyn {
    static constexpr bool PERM = true, AFTER_DRAIN = false;
    int mode; bf16_t* O; int ldc; int N; const float* resid; float* out;
    __device__ __forceinline__ void operator()(const f32x4 (&acc)[2][2][4][2], const Unit& u, int wr, int wc, int fr, int fq) const {
        const int row0 = u.pm * BM + wr * 64 + fr, col0 = u.pn * BM + wc * 32 + 8 * fq;
        if (mode == 0) {
#pragma unroll
            for (int ai = 0; ai < 2; ++ai)
#pragma unroll
                for (int m = 0; m < 4; ++m) { bf16_t* rowp = O + (size_t)(row0 + ai * HALF + m * 16) * ldc + col0;
#pragma unroll
                    for (int bj = 0; bj < 2; ++bj) { if (col0 + bj * HALF < N) { const f32x4 v0 = acc[ai][bj][m][0], v1 = acc[ai][bj][m][1];
                        u32x4 w; w.x = cvt_pk_bf16(v0[0], v0[1]); w.y = cvt_pk_bf16(v0[2], v0[3]); w.z = cvt_pk_bf16(v1[0], v1[1]); w.w = cvt_pk_bf16(v1[2], v1[3]);
                        *(u32x4*)(rowp + bj * HALF) = w; } } }
        } else {
#pragma unroll
            for (int ai = 0; ai < 2; ++ai)
#pragma unroll
                for (int m = 0; m < 4; ++m) { const size_t off = (size_t)(row0 + ai * HALF + m * 16) * ldc + col0;
#pragma unroll
                    for (int bj = 0; bj < 2; ++bj) { const f32x4 r0 = *(const f32x4*)(resid + off + bj * HALF), r1 = *(const f32x4*)(resid + off + bj * HALF + 4);
                        *(f32x4*)(out + off + bj * HALF) = r0 + acc[ai][bj][m][0]; *(f32x4*)(out + off + bj * HALF + 4) = r1 + acc[ai][bj][m][1]; } }
        }
    }
};
struct EpiResid {
    static constexpr bool PERM = true, AFTER_DRAIN = false;
    const float* resid; float* out; int ldc;
    __device__ __forceinline__ void operator()(const f32x4 (&acc)[2][2][4][2], const Unit& u, int wr, int wc, int fr, int fq) const {
        const int row0 = u.pm * BM + wr * 64 + fr, col0 = u.pn * BM + wc * 32 + 8 * fq;
#pragma unroll
        for (int ai = 0; ai < 2; ++ai)
#pragma unroll
            for (int m = 0; m < 4; ++m) { const size_t off = (size_t)(row0 + ai * HALF + m * 16) * ldc + col0;
#pragma unroll
                for (int bj = 0; bj < 2; ++bj) { const f32x4 r0 = *(const f32x4*)(resid + off + bj * HALF), r1 = *(const f32x4*)(resid + off + bj * HALF + 4);
                    *(f32x4*)(out + off + bj * HALF) = r0 + acc[ai][bj][m][0]; *(f32x4*)(out + off + bj * HALF + 4) = r1 + acc[ai][bj][m][1]; } }
    }
};

static_assert(true, "pg8 body adapted: SP2 path only is valid with lda/segment offsets");
template <class Epi, class Sched, bool ALIGN_EPI = false, bool SP2 = false>
__device__ __forceinline__ void gemm_phase(PG8_LAS unsigned char* lds, const Gemm g, const Sched& S, const Epi& E, int wv_) {
    const int tid = opaque_tid(wv_), wid = __builtin_amdgcn_readfirstlane(tid >> 6), lane = tid & 63, wr = wid >> 2, wc = wid & 3, fr = lane & 15, fq = lane >> 4;
    const int K = g.K, nt = K / BK;
    unsigned voffA[2], voffB[2];
#pragma unroll
    for (int i = 0; i < 2; ++i) { int R, C; stage_rc(tid * 16 + i * 8192, R, C); const int Rb = Epi::PERM ? ((R & ~31) + perm32(R & 31)) : R;
        voffA[i] = (unsigned)(R * g.lda + C) * 2u; voffB[i] = (unsigned)(Rb * K + C) * 2u; }
    const size_t kstep = (size_t)(BK * 2);
    const size_t hstep = (size_t)HALF * K * 2; const size_t hstepA = (size_t)HALF * g.lda * 2, tstepA = 2 * hstepA;
#define PG8_KA(t_) ((size_t)((((t_) >> 2) == 0 ? g.ao0 : ((t_) >> 2) == 1 ? g.ao1 : ((t_) >> 2) == 2 ? g.ao2 : g.ao3) + ((t_) & 3) * 64) * 2)
    const size_t tstep = 2 * hstep;
    const unsigned ldsw = (unsigned)wid * 1024u;
    int aoff, boff;
#define PG8_SA(b, h) (((b) * 2 + (h)) * HTB)
#define PG8_SB(b, h) ((4 + (b) * 2 + (h)) * HTB)
#define PG8_STAGE(bufoff, gbase, voff) do { _Pragma("unroll") for (int _i = 0; _i < 2; ++_i) \
        __builtin_amdgcn_global_load_lds((const unsigned*)((const char*)(gbase) + (voff)[_i]), (PG8_LAS unsigned*)(lds + (bufoff) + ldsw + _i * 8192), 16, 0, 0); } while (0)
#define PG8_LDA(dst, b, h) do { _Pragma("unroll") for (int m = 0; m < 4; ++m) _Pragma("unroll") for (int k = 0; k < 2; ++k) dst[m][k] = *(const PG8_LAS bf16x8*)(lds + PG8_SA(b, h) + aoff + m * 2048 + k * 1024); } while (0)
#define PG8_LDB(dst, b, h) do { _Pragma("unroll") for (int n = 0; n < 2; ++n) _Pragma("unroll") for (int k = 0; k < 2; ++k) dst[n][k] = *(const PG8_LAS bf16x8*)(lds + PG8_SB(b, h) + boff + n * 2048 + k * 1024); } while (0)
#define PG8_MMA(ai, bj, At, Bt) do { __builtin_amdgcn_s_setprio(1); _Pragma("unroll") for (int m = 0; m < 4; ++m) _Pragma("unroll") for (int n = 0; n < 2; ++n) _Pragma("unroll") for (int k = 0; k < 2; ++k) \
        acc[ai][bj][m][n] = __builtin_amdgcn_mfma_f32_16x16x32_bf16(Bt[n][k], At[m][k], acc[ai][bj][m][n], 0, 0, 0); __builtin_amdgcn_s_setprio(0); } while (0)
#define PG8_WAIT_V(n) asm volatile("s_waitcnt vmcnt(" #n ")" ::: "memory")
#define PG8_WAIT_L(n) asm volatile("s_waitcnt lgkmcnt(" #n ")" ::: "memory")
#define PG8_BAR __builtin_amdgcn_s_barrier()
#define PG8_SCHED __builtin_amdgcn_sched_barrier(0)
    Unit cur, nxt; int ui = 0;
    if (!S.next(0, cur)) return;
    f32x4 acc[2][2][4][2];
#pragma unroll
    for (int a = 0; a < 2; ++a)
#pragma unroll
        for (int b = 0; b < 2; ++b)
#pragma unroll
            for (int m = 0; m < 4; ++m)
#pragma unroll
                for (int n = 0; n < 2; ++n) acc[a][b][m][n] = (f32x4){0.f, 0.f, 0.f, 0.f};
    bf16x8 At[4][2], B0[2][2], B1[2][2];
    const char* cA = (const char*)g.A + (size_t)cur.pm * tstepA; const char* cB = (const char*)g.Bt + (size_t)cur.pn * tstep;
    S.a_ready(cur);
    if constexpr (SP2) {
        PG8_STAGE(PG8_SB(0, 0), cB, voffB); PG8_STAGE(PG8_SB(0, 1), cB + hstep, voffB); PG8_STAGE(PG8_SA(0, 0), cA + PG8_KA(0), voffA); PG8_STAGE(PG8_SA(0, 1), cA + hstepA + PG8_KA(0), voffA);
        if (wr == 1) PG8_BAR;
        PG8_WAIT_V(2); PG8_BAR;
        PG8_STAGE(PG8_SB(1, 0), cB + kstep, voffB); PG8_STAGE(PG8_SA(1, 0), cA + PG8_KA(1), voffA); PG8_STAGE(PG8_SB(1, 1), cB + hstep + kstep, voffB);
        PG8_WAIT_V(6); PG8_BAR;
    } else {
        PG8_STAGE(PG8_SB(0, 0), cB, voffB); PG8_STAGE(PG8_SA(0, 0), cA, voffA); PG8_STAGE(PG8_SB(0, 1), cB + hstep, voffB); PG8_STAGE(PG8_SA(0, 1), cA + hstep, voffA);
        if (wr == 1) PG8_BAR;
        PG8_WAIT_V(4); PG8_BAR;
        PG8_STAGE(PG8_SB(1, 0), cB + kstep, voffB); PG8_STAGE(PG8_SA(1, 0), cA + kstep, voffA); PG8_STAGE(PG8_SB(1, 1), cB + hstep + kstep, voffB);
        PG8_WAIT_V(6); PG8_BAR;
    }
    { const int t3_ = opaque_tid(wv_), l3_ = t3_ & 63, w3_ = __builtin_amdgcn_readfirstlane(t3_ >> 6); aoff = lds_byte((w3_ >> 2) * 64 + (l3_ & 15), (l3_ >> 4) * 8); boff = lds_byte((w3_ & 3) * 32 + (l3_ & 15), (l3_ >> 4) * 8); }
    for (;;) {
        const bool has_next = S.next(ui + 1, nxt);
        const char* nA = has_next ? (const char*)g.A + (size_t)nxt.pm * tstepA : cA; const char* nB = has_next ? (const char*)g.Bt + (size_t)nxt.pn * tstep : cB;
        for (int t = 0; t < nt; t += 2) {
            const bool last = (t == nt - 2);
            const char* a1 = cA + PG8_KA(t + 1);
            const char* a2 = last ? nA + PG8_KA(0) : cA + PG8_KA(t + 2); const char* b2 = last ? nB : cB + (size_t)(t + 2) * kstep;
            const char* a3 = last ? nA + PG8_KA(1) : cA + PG8_KA(t + 3); const char* b3 = b2 + kstep;
            if (last && has_next) S.a_ready(nxt);
            if constexpr (SP2) {
            PG8_LDB(B0, 0, 0); PG8_LDB(B1, 0, 1); PG8_SCHED; PG8_LDA(At, 0, 0); PG8_STAGE(PG8_SA(1, 1), a1 + hstepA, voffA);
            PG8_WAIT_V(8); PG8_WAIT_L(0); PG8_BAR; PG8_MMA(0, 0, At, B0); PG8_MMA(0, 1, At, B1); PG8_BAR; PG8_SCHED;
            PG8_LDA(At, 0, 1); PG8_STAGE(PG8_SB(0, 0), b2, voffB); PG8_STAGE(PG8_SB(0, 1), b2 + hstep, voffB); PG8_STAGE(PG8_SA(0, 0), a2, voffA);
            PG8_WAIT_V(8); PG8_WAIT_L(0); PG8_BAR; PG8_MMA(1, 0, At, B0); PG8_MMA(1, 1, At, B1); PG8_BAR; PG8_SCHED;
            PG8_LDB(B0, 1, 0); PG8_LDB(B1, 1, 1); PG8_SCHED; PG8_LDA(At, 1, 0); PG8_STAGE(PG8_SA(0, 1), a2 + hstepA, voffA);
            PG8_WAIT_V(8); PG8_WAIT_L(0); PG8_BAR; PG8_MMA(0, 0, At, B0); PG8_MMA(0, 1, At, B1); PG8_BAR; PG8_SCHED;
            PG8_LDA(At, 1, 1); PG8_STAGE(PG8_SB(1, 0), b3, voffB); PG8_STAGE(PG8_SB(1, 1), b3 + hstep, voffB); PG8_STAGE(PG8_SA(1, 0), a3, voffA);
            PG8_WAIT_V(8); PG8_WAIT_L(0); PG8_BAR; PG8_MMA(1, 0, At, B0); PG8_MMA(1, 1, At, B1); PG8_BAR; PG8_SCHED;
            } else {
            PG8_LDB(B0, 0, 0); PG8_SCHED; PG8_LDA(At, 0, 0); PG8_STAGE(PG8_SA(1, 1), a1 + hstep, voffA);
            PG8_WAIT_L(8); PG8_BAR; PG8_WAIT_L(0); PG8_MMA(0, 0, At, B0); PG8_BAR; PG8_SCHED;
            PG8_LDB(B1, 0, 1); PG8_STAGE(PG8_SB(0, 0), b2, voffB);
            PG8_BAR; PG8_WAIT_L(0); PG8_MMA(0, 1, At, B1); PG8_BAR;
            PG8_LDA(At, 0, 1); PG8_STAGE(PG8_SA(0, 0), a2, voffA);
            PG8_BAR; PG8_WAIT_L(0); PG8_MMA(1, 0, At, B0); PG8_BAR; PG8_SCHED;
            PG8_STAGE(PG8_SB(0, 1), b2 + hstep, voffB);
            PG8_WAIT_V(6); PG8_BAR; PG8_MMA(1, 1, At, B1); PG8_BAR;
            PG8_LDB(B0, 1, 0); PG8_SCHED; PG8_LDA(At, 1, 0); PG8_STAGE(PG8_SA(0, 1), a2 + hstep, voffA);
            PG8_WAIT_L(8); PG8_BAR; PG8_WAIT_L(0); PG8_MMA(0, 0, At, B0); PG8_BAR; PG8_SCHED;
            PG8_LDB(B1, 1, 1); PG8_STAGE(PG8_SB(1, 0), b3, voffB);
            PG8_BAR; PG8_WAIT_L(0); PG8_MMA(0, 1, At, B1); PG8_BAR;
            PG8_LDA(At, 1, 1); PG8_STAGE(PG8_SA(1, 0), a3, voffA);
            PG8_BAR; PG8_WAIT_L(0); PG8_MMA(1, 0, At, B0); PG8_BAR; PG8_SCHED;
            PG8_STAGE(PG8_SB(1, 1), b3 + hstep, voffB);
            PG8_WAIT_V(6); PG8_BAR; PG8_MMA(1, 1, At, B1); PG8_BAR;
            }
        }
        if constexpr (ALIGN_EPI) { if (wr == 0) PG8_BAR; }
        if constexpr (!Epi::AFTER_DRAIN) { const int t2_ = opaque_tid(wv_), l2_ = t2_ & 63, w2_ = __builtin_amdgcn_readfirstlane(t2_ >> 6); E(acc, cur, w2_ >> 2, w2_ & 3, l2_ & 15, l2_ >> 4); S.done(cur); }
        if (!has_next) break;
#pragma unroll
        for (int a = 0; a < 2; ++a)
#pragma unroll
            for (int b = 0; b < 2; ++b)
#pragma unroll
                for (int m = 0; m < 4; ++m)
#pragma unroll
                    for (int n = 0; n < 2; ++n) acc[a][b][m][n] = (f32x4){0.f, 0.f, 0.f, 0.f};
        cur = nxt; cA = nA; cB = nB; ++ui;
        if constexpr (ALIGN_EPI) { if (wr == 1) PG8_BAR; }
    }
    PG8_WAIT_V(0);
    if constexpr (!ALIGN_EPI) { if (wr == 0) PG8_BAR; }
    PG8_BAR;
    if constexpr (Epi::AFTER_DRAIN) { E.fused(acc, cur, wr, wc, fr, fq, lds, wid, lane); S.done(cur); }
#undef PG8_SA
#undef PG8_SB
#undef PG8_STAGE
#undef PG8_LDA
#undef PG8_LDB
#undef PG8_MMA
#undef PG8_WAIT_V
#undef PG8_WAIT_L
#undef PG8_BAR
#undef PG8_SCHED
#undef PG8_KA
}
}

__device__ __forceinline__ void wt_tile(const float* __restrict__ W, int N, bf16_t* __restrict__ Wt, int kt, int nt, unsigned char* lds, int wv_) {
#ifdef OFF_wt_tile
  return;
#endif

  float* tl = (float*)lds;
  const int tid = opaque_tid(wv_);
  const int r = tid >> 3, c8 = (tid & 7) * 8;
  const float* src = W + (size_t)(kt * 64 + r) * N + nt * 64 + c8;
  const float4 v0 = *(const float4*)src, v1 = *(const float4*)(src + 4);
  float* d = tl + r * 65 + c8;
  d[0] = v0.x; d[1] = v0.y; d[2] = v0.z; d[3] = v0.w; d[4] = v1.x; d[5] = v1.y; d[6] = v1.z; d[7] = v1.w;
  __syncthreads();
  uint4 o;
  o.x = pack2(tl[(c8 + 0) * 65 + r], tl[(c8 + 1) * 65 + r]);
  o.y = pack2(tl[(c8 + 2) * 65 + r], tl[(c8 + 3) * 65 + r]);
  o.z = pack2(tl[(c8 + 4) * 65 + r], tl[(c8 + 5) * 65 + r]);
  o.w = pack2(tl[(c8 + 6) * 65 + r], tl[(c8 + 7) * 65 + r]);
  *(uint4*)(Wt + (size_t)(nt * 64 + r) * 1024 + kt * 64 + c8) = o;
  __syncthreads();
}

__device__ __forceinline__ void norm_rows(const bool F32OUT, const float* src, const float* __restrict__ g, void* dst, int nrows, float pd, int wv_) {
#ifdef OFF_norm_rows
  return;
#endif

  const int tid = opaque_tid(wv_);
  const int lane = tid & 63;
  const int gw = blockIdx.x * 8 + (tid >> 6), nw = gridDim.x * 8;
  float4 gv[4];
#pragma unroll
  for (int i = 0; i < 4; ++i) gv[i] = *(const float4*)(g + i * 256 + lane * 4);
  for (int row = gw; row < nrows; row += nw) {
    const float* s = src + (size_t)row * 1024;
    float4 v[4]; float ss = 0.f;
#pragma unroll
    for (int i = 0; i < 4; ++i) { v[i] = *(const float4*)(s + i * 256 + lane * 4); ss += v[i].x * v[i].x + v[i].y * v[i].y + v[i].z * v[i].z + v[i].w * v[i].w; }
    ss = wave_sum(ss, lane);
    const float rs = rsqrtf(ss * (1.0f / 1024.0f) + 1e-6f);
#pragma unroll
    for (int i = 0; i < 4; ++i) {
      const float a = v[i].x * rs * gv[i].x, b = v[i].y * rs * gv[i].y, c = v[i].z * rs * gv[i].z, d = v[i].w * rs * gv[i].w;
      if (F32OUT) { *(float4*)((float*)dst + (size_t)row * 1024 + i * 256 + lane * 4) = make_float4(a + pd, b + pd, c + pd, d + pd); }
      else { uint2 o; o.x = pack2(a, b); o.y = pack2(c, d); *(uint2*)((bf16_t*)dst + (size_t)row * 1024 + i * 256 + lane * 4) = o; }
    }
  }
}

__device__ __forceinline__ void rwkv_prep_item(KP P, int l, int item, unsigned char* lds, int wv_) {
#ifdef OFF_rwkv_prep_item
  return;
#endif

  const bf16_t* p = (const bf16_t*)(P->ws + WS_P);
  float* PW = (float*)(P->ws + WS_PW); bf16_t* PV = (bf16_t*)(P->ws + WS_PV); float* RK = (float*)(P->ws + WS_RK);
  float* lora = (float*)lds;
  const int tid = opaque_tid(wv_), lane = tid & 63, w = tid >> 6, head = w & 3, sub = w >> 2;
  const int c = head * 64 + lane;
  const float* mu = P->in[4] + l * 832;
  const float mur = mu[c], muk = mu[256 + c], muv = mu[512 + c], mux = mu[768 + lane];
  const float w0 = P->in[5][l * 256 + c], a0 = P->in[7][l * 256 + c];
  const float kkw = P->in[9][l * 256 + c], kaw = P->in[10][l * 256 + c], rkw = P->in[11][l * 256 + c];
  float wup[32], aup[32];
#pragma unroll
  for (int j = 0; j < 32; ++j) { wup[j] = P->in[6][(l * 32 + j) * 256 + c]; aup[j] = P->in[8][(l * 32 + j) * 256 + c]; }
  bf16_t raw[4][8];
#define PREP_LOAD(g) { _Pragma("unroll") for (int j_ = 0; j_ < 4; ++j_) { const int t_ = item * 32 + sub + 2 * ((g) * 4 + j_); const bool hp_ = (t_ & (TSEQ - 1)) > 0; \
      const bf16_t* pr_ = p + (size_t)t_ * NIN; raw[j_][0] = pr_[c]; raw[j_][1] = pr_[256 + c]; raw[j_][2] = pr_[512 + c]; raw[j_][3] = pr_[768 + lane]; \
      raw[j_][4] = hp_ ? pr_[c - NIN] : (bf16_t)0; raw[j_][5] = hp_ ? pr_[256 + c - NIN] : (bf16_t)0; raw[j_][6] = hp_ ? pr_[512 + c - NIN] : (bf16_t)0; raw[j_][7] = hp_ ? pr_[768 + lane - NIN] : (bf16_t)0; } }
  PREP_LOAD(0);
#pragma unroll 1
  for (int g = 0; g < 4; ++g) {
    float rr[4], kk4[4], vv4[4];
#pragma unroll
    for (int j = 0; j < 4; ++j) {
      float r = bf2f(raw[j][0]), k = bf2f(raw[j][1]), v = bf2f(raw[j][2]), x = bf2f(raw[j][3]);
      r += (bf2f(raw[j][4]) - r) * mur; k += (bf2f(raw[j][5]) - k) * muk; v += (bf2f(raw[j][6]) - v) * muv; x += (bf2f(raw[j][7]) - x) * mux;
      rr[j] = r; kk4[j] = k; vv4[j] = v;
      lora[(w * 4 + j) * 64 + lane] = lane < 32 ? tanhf(x) : x;
    }
    if (g < 3) PREP_LOAD(g + 1);
    __builtin_amdgcn_s_waitcnt(0xc07f);
    __builtin_amdgcn_wave_barrier();
#pragma unroll
    for (int j = 0; j < 4; ++j) {
      const int t = item * 32 + sub + 2 * (g * 4 + j);
      const int tt = t & (TSEQ - 1), b = t >> 13;
      const float r = rr[j], k = kk4[j], v = vv4[j];
      float wv = w0, av = a0;
      const float* lo = lora + (w * 4 + j) * 64;
#pragma unroll
      for (int jj = 0; jj < 32; ++jj) { wv += lo[jj] * wup[jj]; av += lo[32 + jj] * aup[jj]; }
      const float wlog = -softplusf_(-wv) - 0.5f;
      const float decay = __expf(-__expf(wlog));
      const float ar = sigmoidf_(av);
      const float kk = k * kkw;
      const float n2 = wave_sum(kk * kk, lane);
      const float kkn = kk / fmaxf(sqrtf(n2), 1e-12f);
      const float kmod = k * (1.0f + (ar - 1.0f) * kaw);
      const float rk = wave_sum(r * kmod * rkw, lane);
      const size_t idx = (size_t)(b * 4 + head) * TSEQ + tt;
      PW[idx * 64 + lane] = decay;
      bf16_t* pv = PV + idx * 320;
      pv[lane] = f2bf(r); pv[64 + lane] = f2bf(kmod); pv[128 + lane] = f2bf(v); pv[192 + lane] = f2bf(-kkn); pv[256 + lane] = f2bf(kkn * ar);
      if (lane == 0) RK[idx] = rk;
    }
    __builtin_amdgcn_s_waitcnt(0xc07f);
    __builtin_amdgcn_wave_barrier();
  }
#undef PREP_LOAD
  __syncthreads();
}

#define RW_TILE_B (RW_TT * 1536)
struct RwRegs { float4 pw; uint4 pv0, pv1; };
__device__ __forceinline__ void rw_issue(const float* __restrict__ PW, const bf16_t* __restrict__ PV, size_t idx0, int tid, RwRegs& r) {
  if (tid < RW_TT * 16) { const int s = tid >> 4, q = tid & 15; r.pw = *(const float4*)(PW + (idx0 + s) * 64 + q * 4); }
  { const int c = tid; const int s = c / 40, q = c % 40; r.pv0 = *(const uint4*)(PV + (idx0 + s) * 320 + q * 8); }
  if (tid < RW_TT * 40 - NTHR) { const int c = tid + NTHR; const int s = c / 40, q = c % 40; r.pv1 = *(const uint4*)(PV + (idx0 + s) * 320 + q * 8); }
}
__device__ __forceinline__ void rw_put(float* dst, int c, const uint4 u) {
  const int s = c / 40, q = c % 40;
  const int vec = q >> 3, off = (q & 7) * 8;
  const int slot = vec == 0 ? 4 : vec == 1 ? 3 : vec == 2 ? 5 : vec == 3 ? 1 : 2;
  float* d = dst + s * 384 + slot * 64 + off;
  *(float4*)d = make_float4(__uint_as_float(u.x << 16), __uint_as_float(u.x & 0xffff0000u), __uint_as_float(u.y << 16), __uint_as_float(u.y & 0xffff0000u));
  *(float4*)(d + 4) = make_float4(__uint_as_float(u.z << 16), __uint_as_float(u.z & 0xffff0000u), __uint_as_float(u.w << 16), __uint_as_float(u.w & 0xffff0000u));
}
__device__ __forceinline__ void rw_commit(unsigned char* dstb, int tid, const RwRegs& r) {
  float* dst = (float*)dstb;
  if (tid < RW_TT * 16) { const int s = tid >> 4, q = tid & 15; *(float4*)(dst + s * 384 + q * 4) = r.pw; }
  rw_put(dst, tid, r.pv0);
  if (tid < RW_TT * 40 - NTHR) rw_put(dst, tid + NTHR, r.pv1);
}

#define LD8(dst, ptr) { const float4 x0_ = *(const float4*)(ptr), x1_ = *(const float4*)((ptr) + 4); dst[0] = (f32x2){x0_.x, x0_.y}; dst[1] = (f32x2){x0_.z, x0_.w}; dst[2] = (f32x2){x1_.x, x1_.y}; dst[3] = (f32x2){x1_.z, x1_.w}; }
struct RwOps { f32x2 w[4], a[4], b[4], k[4], r[4]; float vA, vB; };
template <int MODE>
__device__ __forceinline__ void rw_ldops(RwOps& o, const float* tb, int s, int q, int rowA, int rowB) {
  const float* sp = tb + s * 384 + q * 8;
  LD8(o.w, sp); LD8(o.a, sp + 64); LD8(o.b, sp + 128); LD8(o.k, sp + 192);
  o.vA = tb[s * 384 + 320 + rowA];
  if (MODE == 0) { LD8(o.r, sp + 256); o.vB = tb[s * 384 + 320 + rowB]; }
}
template <int MODE>
__device__ __forceinline__ void rw_step(const RwOps& o, f32x2 (&SA)[4], f32x2 (&SB)[4], float* yb, int s, int q, int rowA, int rowB) {
  f32x2 dA = SA[0] * o.a[0], dB = SB[0] * o.a[0];
#pragma unroll
  for (int e = 1; e < 4; ++e) { dA = SA[e] * o.a[e] + dA; dB = SB[e] * o.a[e] + dB; }
  const float dotA = red8(dA.x + dA.y), dotB = red8(dB.x + dB.y);
  const f32x2 dA2 = {dotA, dotA}, dB2 = {dotB, dotB}, vA2 = {o.vA, o.vA};
  if (MODE == 0) {
    const f32x2 vB2 = {o.vB, o.vB};
#pragma unroll
    for (int e = 0; e < 4; ++e) { SA[e] = SA[e] * o.w[e] + vA2 * o.k[e]; SA[e] = dA2 * o.b[e] + SA[e]; SB[e] = SB[e] * o.w[e] + vB2 * o.k[e]; SB[e] = dB2 * o.b[e] + SB[e]; }
    f32x2 yA = SA[0] * o.r[0], yB = SB[0] * o.r[0];
#pragma unroll
    for (int e = 1; e < 4; ++e) { yA = SA[e] * o.r[e] + yA; yB = SB[e] * o.r[e] + yB; }
    const float ya = red8(yA.x + yA.y), ybv = red8(yB.x + yB.y);
    if (q == 0) { yb[s * 64 + rowA] = ya; yb[s * 64 + rowB] = ybv; }
  } else {
#pragma unroll
    for (int e = 0; e < 4; ++e) { SA[e] = dA2 * o.b[e] + SA[e] * o.w[e]; SB[e] = SB[e] * o.w[e] + vA2 * o.k[e]; SB[e] = dB2 * o.b[e] + SB[e]; }
  }
}
template <int MODE>
__device__ __forceinline__ void rwkv_scan_item(KP P, int l, int bh, int chunk, unsigned char* lds, int wv_) {
  const float* PW = (const float*)(P->ws + WS_PW); const bf16_t* PV = (const bf16_t*)(P->ws + WS_PV); const float* RK = (const float*)(P->ws + WS_RK);
  float* PQ = (float*)(P->ws + WS_PQ);
  bf16_t* p = (bf16_t*)(P->ws + WS_P);
  const int tid = opaque_tid(wv_), lane = tid & 63, w = tid >> 6;
  const int q = lane & 7;
  const int rowA = (MODE == 0) ? ((w & 3) * 16 + (lane >> 3)) : (w * 8 + (lane >> 3));
  const int rowB = rowA + 8;
  const int b = bh >> 2, head = bh & 3;
  unsigned char* tile0 = lds;
  float* ybuf = (float*)(lds + 3 * RW_TILE_B);
  float* Sl = (float*)(lds + 3 * RW_TILE_B + 2 * RW_TT * 256);
  f32x2 SA[4], SB[4];
#pragma unroll
  for (int e = 0; e < 4; ++e) { SA[e] = (f32x2){0.f, 0.f}; SB[e] = (f32x2){0.f, 0.f}; }
  if (MODE == 1) {
#pragma unroll
    for (int e = 0; e < 4; ++e) SA[e] = (f32x2){(q * 8 + 2 * e == rowA) ? 1.f : 0.f, (q * 8 + 2 * e + 1 == rowA) ? 1.f : 0.f};
  }
  if (MODE == 0 && chunk > 0) {
    const float* Q0 = PQ + ((size_t)(bh * RW_C + 0) * 2 + 1) * 4096;
    float* cur = Sl; float* nxt = Sl + 4096;
    for (int i = tid; i < 1024; i += NTHR) *(float4*)(cur + i * 4) = *(const float4*)(Q0 + i * 4);
    float* Pl = (float*)lds;
    float4 pre0 = make_float4(0.f, 0.f, 0.f, 0.f), pre1 = pre0;
    if (chunk > 1) { const float* Pm = PQ + ((size_t)(bh * RW_C + 1) * 2 + 0) * 4096; pre0 = *(const float4*)(Pm + tid * 4); pre1 = *(const float4*)(Pm + (tid + NTHR) * 4); }
    for (int cc = 1; cc < chunk; ++cc) {
      const float* Pm = PQ + ((size_t)(bh * RW_C + cc) * 2 + 0) * 4096;
      const float* Qm = Pm + 4096;
      __syncthreads();
      *(float4*)(Pl + tid * 4) = pre0; *(float4*)(Pl + (tid + NTHR) * 4) = pre1;
      if (cc + 1 < chunk) { const float* Pn = Pm + 8192; pre0 = *(const float4*)(Pn + tid * 4); pre1 = *(const float4*)(Pn + (tid + NTHR) * 4); }
      const int ti = w >> 1;
      float qv[2][4];
#pragma unroll
      for (int jj = 0; jj < 2; ++jj)
#pragma unroll
        for (int r = 0; r < 4; ++r) qv[jj][r] = Qm[(ti * 16 + (lane >> 4) * 4 + r) * 64 + ((w & 1) * 2 + jj) * 16 + (lane & 15)];
      __syncthreads();
#pragma unroll
      for (int jj = 0; jj < 2; ++jj) {
        const int tj = (w & 1) * 2 + jj;
        f32x4 acc = {qv[jj][0], qv[jj][1], qv[jj][2], qv[jj][3]};
#pragma unroll
        for (int ks = 0; ks < 16; ++ks) {
          const float a = cur[(ti * 16 + (lane & 15)) * 64 + ks * 4 + (lane >> 4)];
          const float bb = Pl[(ks * 4 + (lane >> 4)) * 64 + tj * 16 + (lane & 15)];
          acc = __builtin_amdgcn_mfma_f32_16x16x4f32(a, bb, acc, 0, 0, 0);
        }
#pragma unroll
        for (int r = 0; r < 4; ++r) nxt[(ti * 16 + (lane >> 4) * 4 + r) * 64 + tj * 16 + (lane & 15)] = acc[r];
      }
      float* t_ = cur; cur = nxt; nxt = t_;
    }
    __syncthreads();
    LD8(SA, cur + rowA * 64 + q * 8);
    LD8(SB, cur + rowB * 64 + q * 8);
    __syncthreads();
  }
  const size_t idxb = (size_t)bh * TSEQ + (size_t)chunk * RW_CL;
  const int ntile = RW_CL / RW_TT;
  RwRegs rr;
  rw_issue(PW, PV, idxb, tid, rr);
  rw_commit(tile0, tid, rr);
  const int chh = head * 64 + lane;
  const float lng = P->in[12][l * 256 + chh], lnb = P->in[13][l * 256 + chh];
  __syncthreads();
  const int nit = (MODE == 0) ? ntile + 1 : ntile;
  for (int tl = 0; tl < nit; ++tl) {
    if (tl + 1 < ntile) rw_issue(PW, PV, idxb + (size_t)(tl + 1) * RW_TT, tid, rr);
    if (MODE == 1 || w < 4) {
      if (tl < ntile) {
        const float* tb = (const float*)(tile0 + (tl % 3) * RW_TILE_B);
        float* yb = ybuf + (tl & 1) * (RW_TT * 64);
        RwOps oa, ob;
        rw_ldops<MODE>(oa, tb, 0, q, rowA, rowB);
        __builtin_amdgcn_sched_barrier(0);
#pragma unroll 1
        for (int s = 0; s < RW_TT; s += 2) {
          rw_ldops<MODE>(ob, tb, s + 1, q, rowA, rowB);
          __builtin_amdgcn_sched_barrier(0);
          rw_step<MODE>(oa, SA, SB, yb, s, q, rowA, rowB);
          __builtin_amdgcn_sched_barrier(0);
          if (s + 2 < RW_TT) rw_ldops<MODE>(oa, tb, s + 2, q, rowA, rowB);
          __builtin_amdgcn_sched_barrier(0);
          rw_step<MODE>(ob, SA, SB, yb, s + 1, q, rowA, rowB);
          __builtin_amdgcn_sched_barrier(0);
        }
      }
    } else {
      const int fw = w - 4;
      if (tl > 0) {
        f32x4 gcu, rkcu;
#pragma unroll
        for (int u = 0; u < 4; ++u) { const int tt = chunk * RW_CL + (tl - 1) * RW_TT + fw + 4 * u;
          gcu[u] = bf2f(p[(size_t)(b * TSEQ + tt) * NIN + C_GA + chh]); rkcu[u] = RK[(size_t)bh * TSEQ + tt]; }
        const float* tb = (const float*)(tile0 + ((tl - 1) % 3) * RW_TILE_B);
        const float* yb = ybuf + ((tl - 1) & 1) * (RW_TT * 64);
#pragma unroll
        for (int u = 0; u < 4; ++u) {
          const int s = fw + 4 * u;
          const int tt = chunk * RW_CL + (tl - 1) * RW_TT + s;
          const float y = yb[s * 64 + lane];
          const float mean = wave_sum(y, lane) * (1.0f / 64.0f);
          const float dlt = y - mean;
          const float var = wave_sum(dlt * dlt, lane) * (1.0f / 64.0f);
          float o = dlt * rsqrtf(var + 64e-5f) * lng + lnb;
          const float vv = tb[s * 384 + 320 + lane];
          o += rkcu[u] * vv;
          p[(size_t)(b * TSEQ + tt) * NIN + C_GA + chh] = f2bf(o * siluf_(gcu[u]));
        }
      }
    }
    if (tl + 1 < ntile) rw_commit(tile0 + ((tl + 1) % 3) * RW_TILE_B, tid, rr);
    __syncthreads();
  }
  if (MODE == 1) {
    float* Pm = PQ + ((size_t)(bh * RW_C + chunk) * 2 + 0) * 4096 + rowA * 64 + q * 8;
    *(float4*)Pm = make_float4(SA[0].x, SA[0].y, SA[1].x, SA[1].y); *(float4*)(Pm + 4) = make_float4(SA[2].x, SA[2].y, SA[3].x, SA[3].y);
    *(float4*)(Pm + 4096) = make_float4(SB[0].x, SB[0].y, SB[1].x, SB[1].y); *(float4*)(Pm + 4100) = make_float4(SB[2].x, SB[2].y, SB[3].x, SB[3].y);
  } else if (chunk == 0 && w < 4) {
    float* Qm = PQ + ((size_t)(bh * RW_C + 0) * 2 + 1) * 4096 + q * 8;
    *(float4*)(Qm + rowA * 64) = make_float4(SA[0].x, SA[0].y, SA[1].x, SA[1].y); *(float4*)(Qm + rowA * 64 + 4) = make_float4(SA[2].x, SA[2].y, SA[3].x, SA[3].y);
    *(float4*)(Qm + rowB * 64) = make_float4(SB[0].x, SB[0].y, SB[1].x, SB[1].y); *(float4*)(Qm + rowB * 64 + 4) = make_float4(SB[2].x, SB[2].y, SB[3].x, SB[3].y);
  }
  __syncthreads();
}

__device__ __forceinline__ void conv_item(KP P, int l, int item, unsigned char* lds, int wv_) {
#ifdef OFF_conv_item
  return;
#endif

  bf16_t* p = (bf16_t*)(P->ws + WS_P);
  float* u = (float*)lds;
  float* yb = (float*)(lds + 62 * 1024);
  const int tid = opaque_tid(wv_), c = tid & 255, half = tid >> 8;
  const int t0 = item * 32, tt0 = t0 & (TSEQ - 1);
  {
    bf16_t rv[31], rg[31];
#pragma unroll
    for (int i = 0; i < 31; ++i) { const int r = half + 2 * i; const bool ok = (tt0 - 30 + r) >= 0; const bf16_t* pr = p + (size_t)(t0 - 30 + r) * NIN;
      rv[i] = ok ? pr[C_CVAL + c] : (bf16_t)0; rg[i] = ok ? pr[C_CGLU + c] : (bf16_t)0; }
#pragma unroll
    for (int i = 0; i < 31; ++i) u[(half + 2 * i) * 256 + c] = bf2f(rv[i]) * sigmoidf_(bf2f(rg[i]));
  }
  float wv[31];
#pragma unroll
  for (int j = 0; j < 31; ++j) wv[j] = P->in[14][(l * 31 + j) * 256 + c];
  const float bias = P->in[15][l * 256 + c];
  __syncthreads();
  {
    float win[46];
#pragma unroll
    for (int i = 0; i < 46; ++i) win[i] = u[(half * 16 + i) * 256 + c];
#pragma unroll
    for (int i = 0; i < 16; ++i) {
      float acc = bias;
#pragma unroll
      for (int j = 0; j < 31; ++j) acc = fmaf(wv[j], win[i + j], acc);
      yb[(half * 16 + i) * 256 + c] = acc;
    }
  }
  __syncthreads();
  const int lane = tid & 63, w = tid >> 6;
  const float4 g = *(const float4*)(P->in[16] + l * 256 + lane * 4), bb = *(const float4*)(P->in[17] + l * 256 + lane * 4);
  uint2 gpre[4];
#pragma unroll
  for (int i = 0; i < 4; ++i) gpre[i] = *(const uint2*)(p + (size_t)(t0 + w * 4 + i) * NIN + C_CGATE + lane * 4);
#pragma unroll
  for (int i = 0; i < 4; ++i) {
    const int tk = w * 4 + i;
    const float4 v = *(const float4*)(yb + tk * 256 + lane * 4);
    const float mean = wave_sum(v.x + v.y + v.z + v.w, lane) * (1.0f / 256.0f);
    const float d0 = v.x - mean, d1 = v.y - mean, d2 = v.z - mean, d3 = v.w - mean;
    const float var = wave_sum(d0 * d0 + d1 * d1 + d2 * d2 + d3 * d3, lane) * (1.0f / 256.0f);
    const float rs = rsqrtf(var + 1e-5f);
    bf16_t* gp = p + (size_t)(t0 + tk) * NIN + C_CGATE + lane * 4;
    const uint2 gu = gpre[i];
    const float o0 = siluf_(d0 * rs * g.x + bb.x) * siluf_(__uint_as_float(gu.x << 16));
    const float o1 = siluf_(d1 * rs * g.y + bb.y) * siluf_(__uint_as_float(gu.x & 0xffff0000u));
    const float o2 = siluf_(d2 * rs * g.z + bb.z) * siluf_(__uint_as_float(gu.y << 16));
    const float o3 = siluf_(d3 * rs * g.w + bb.w) * siluf_(__uint_as_float(gu.y & 0xffff0000u));
    uint2 o; o.x = pack2(o0, o1); o.y = pack2(o2, o3);
    *(uint2*)gp = o;
  }
  __syncthreads();
}

#define HG_WLDS 10240
__device__ __forceinline__ float hgrn_lb(KP P, int l, int ch) {
  if (l == 0) return 0.f;
  const float x0 = P->in[18][ch], x1 = P->in[18][256 + ch];
  return __builtin_amdgcn_rcpf(1.0f + __expf(x0 - x1));
}
template <int PASS>
__device__ __forceinline__ void hgrn_wave_item(KP P, int l, int wi, unsigned char* lds, int wv_) {
#ifdef OFF_hgrn_wave_item
  return;
#endif

  bf16_t* p = (bf16_t*)(P->ws + WS_P);
  float* HS = (float*)(P->ws + WS_HS); float* HF = (float*)(P->ws + WS_HF);
  const int tid = opaque_tid(wv_);
  const int lane = tid & 63, w = tid >> 6;
  const int bh = wi >> 7, chunk = wi & 127, b = bh >> 2, head = bh & 3;
  float* st = (float*)(lds + w * HG_WLDS);
  float* ob = st + 2048;
  const int kg = lane & 7, vg = lane >> 3;
  const int ch = head * 64 + lane;
  const float lb = hgrn_lb(P, l, ch);
  const float ng = P->in[19][l * 256 + ch];
  float S[8][8];
  float* slot = HS + (size_t)(bh * 128 + chunk) * 4096;
  if (PASS == 1) {
#pragma unroll
    for (int i = 0; i < 8; ++i) { const float4 x0 = *(const float4*)(slot + (kg * 8 + i) * 64 + vg * 8), x1 = *(const float4*)(slot + (kg * 8 + i) * 64 + vg * 8 + 4);
      S[i][0] = x0.x; S[i][1] = x0.y; S[i][2] = x0.z; S[i][3] = x0.w; S[i][4] = x1.x; S[i][5] = x1.y; S[i][6] = x1.z; S[i][7] = x1.w; }
  } else {
#pragma unroll
    for (int i = 0; i < 8; ++i)
#pragma unroll
      for (int j = 0; j < 8; ++j) S[i][j] = 0.f;
  }
  float Fp = 1.f;
  bf16_t rf[8], ri[8], rq[8], rg[8];
  {
    const int tb0 = b * TSEQ + chunk * 64;
#pragma unroll
    for (int s = 0; s < 8; ++s) { const bf16_t* pr = p + (size_t)(tb0 + s) * NIN; rf[s] = pr[C_HF + ch]; ri[s] = pr[C_HI + ch]; if (PASS == 1) { rq[s] = pr[C_HQ + ch]; rg[s] = pr[C_HG + ch]; } }
  }
#pragma unroll 1
  for (int sub = 0; sub < 8; ++sub) {
    const int tbase = b * TSEQ + chunk * 64 + sub * 8;
    bf16_t gc[8];
#pragma unroll
    for (int s = 0; s < 8; ++s) {
      const float f = lb + (1.0f - lb) * sigmoidf_(bf2f(rf[s]));
      Fp *= f;
      st[s * 256 + lane] = f; st[s * 256 + 64 + lane] = 1.0f - f;
      if (PASS == 1) { st[s * 256 + 128 + lane] = siluf_(bf2f(rq[s])); gc[s] = rg[s]; }
      st[s * 256 + 192 + lane] = bf2f(ri[s]);
    }
    if (sub < 7) {
#pragma unroll
      for (int s = 0; s < 8; ++s) { const bf16_t* pr = p + (size_t)(tbase + 8 + s) * NIN; rf[s] = pr[C_HF + ch]; ri[s] = pr[C_HI + ch]; if (PASS == 1) { rq[s] = pr[C_HQ + ch]; rg[s] = pr[C_HG + ch]; } }
    }
    __builtin_amdgcn_s_waitcnt(0xc07f);
    __builtin_amdgcn_wave_barrier();
#pragma unroll 1
    for (int s = 0; s < 8; ++s) {
      const float* sp = st + s * 256;
      const float4 f0 = *(const float4*)(sp + kg * 8), f1 = *(const float4*)(sp + kg * 8 + 4);
      const float4 k0 = *(const float4*)(sp + 64 + kg * 8), k1 = *(const float4*)(sp + 64 + kg * 8 + 4);
      const float4 v0 = *(const float4*)(sp + 192 + vg * 8), v1 = *(const float4*)(sp + 192 + vg * 8 + 4);
      const float fv[8] = {f0.x, f0.y, f0.z, f0.w, f1.x, f1.y, f1.z, f1.w};
      const float kv[8] = {k0.x, k0.y, k0.z, k0.w, k1.x, k1.y, k1.z, k1.w};
      const float vv[8] = {v0.x, v0.y, v0.z, v0.w, v1.x, v1.y, v1.z, v1.w};
#pragma unroll
      for (int i = 0; i < 8; ++i)
#pragma unroll
        for (int j = 0; j < 8; ++j) S[i][j] = fmaf(fv[i], S[i][j], kv[i] * vv[j]);
      if (PASS == 1) {
        const float4 q0 = *(const float4*)(sp + 128 + kg * 8), q1 = *(const float4*)(sp + 128 + kg * 8 + 4);
        const float qv[8] = {q0.x, q0.y, q0.z, q0.w, q1.x, q1.y, q1.z, q1.w};
        float o[8];
#pragma unroll
        for (int j = 0; j < 8; ++j) { float a = qv[0] * S[0][j];
#pragma unroll
          for (int i = 1; i < 8; ++i) a = fmaf(qv[i], S[i][j], a);
          o[j] = red8(a); }
        if (kg == 0) { *(float4*)(ob + s * 64 + vg * 8) = make_float4(o[0], o[1], o[2], o[3]); *(float4*)(ob + s * 64 + vg * 8 + 4) = make_float4(o[4], o[5], o[6], o[7]); }
      }
    }
    __builtin_amdgcn_s_waitcnt(0xc07f);
    __builtin_amdgcn_wave_barrier();
    if (PASS == 1) {
#pragma unroll
      for (int s = 0; s < 8; ++s) {
        const float o = ob[s * 64 + lane];
        const float ms = wave_sum(o * o, lane) * (1.0f / 64.0f);
        p[(size_t)(tbase + s) * NIN + C_HG + ch] = f2bf(o * rsqrtf(ms + 1e-6f) * ng * siluf_(bf2f(gc[s])));
      }
      __builtin_amdgcn_s_waitcnt(0xc07f);
      __builtin_amdgcn_wave_barrier();
    }
  }
  if (PASS == 0) {
#pragma unroll
    for (int i = 0; i < 8; ++i) { *(float4*)(slot + (kg * 8 + i) * 64 + vg * 8) = make_float4(S[i][0], S[i][1], S[i][2], S[i][3]);
      *(float4*)(slot + (kg * 8 + i) * 64 + vg * 8 + 4) = make_float4(S[i][4], S[i][5], S[i][6], S[i][7]); }
    HF[(size_t)(bh * 128 + chunk) * 64 + lane] = Fp;
  }
}
__device__ __forceinline__ void hgrn_combine_item(KP P, int bh, int wv_) {
#ifdef OFF_hgrn_combine_item
  return;
#endif

  float* HS = (float*)(P->ws + WS_HS); const float* HF = (const float*)(P->ws + WS_HF);
  const int tid = opaque_tid(wv_);
  const int krow = tid >> 3;
  float R[8];
#pragma unroll
  for (int e = 0; e < 8; ++e) R[e] = 0.f;
  float4 xa[8][2]; float fa[8];
#pragma unroll
  for (int u = 0; u < 8; ++u) { const float* sl = HS + (size_t)(bh * 128 + u) * 4096 + tid * 8; xa[u][0] = *(const float4*)sl; xa[u][1] = *(const float4*)(sl + 4); fa[u] = HF[(size_t)(bh * 128 + u) * 64 + krow]; }
#pragma unroll 1
  for (int c0 = 0; c0 < 128; c0 += 8) {
    float4 xn[8][2]; float fn[8];
    if (c0 + 8 < 128) {
#pragma unroll
      for (int u = 0; u < 8; ++u) { const float* sl = HS + (size_t)(bh * 128 + c0 + 8 + u) * 4096 + tid * 8; xn[u][0] = *(const float4*)sl; xn[u][1] = *(const float4*)(sl + 4); fn[u] = HF[(size_t)(bh * 128 + c0 + 8 + u) * 64 + krow]; }
    }
#pragma unroll
    for (int u = 0; u < 8; ++u) {
      float* sl = HS + (size_t)(bh * 128 + c0 + u) * 4096 + tid * 8;
      *(float4*)sl = make_float4(R[0], R[1], R[2], R[3]); *(float4*)(sl + 4) = make_float4(R[4], R[5], R[6], R[7]);
      const float f = fa[u];
      R[0] = fmaf(f, R[0], xa[u][0].x); R[1] = fmaf(f, R[1], xa[u][0].y); R[2] = fmaf(f, R[2], xa[u][0].z); R[3] = fmaf(f, R[3], xa[u][0].w);
      R[4] = fmaf(f, R[4], xa[u][1].x); R[5] = fmaf(f, R[5], xa[u][1].y); R[6] = fmaf(f, R[6], xa[u][1].z); R[7] = fmaf(f, R[7], xa[u][1].w);
    }
    if (c0 + 8 < 128) {
#pragma unroll
      for (int u = 0; u < 8; ++u) { xa[u][0] = xn[u][0]; xa[u][1] = xn[u][1]; fa[u] = fn[u]; }
    }
  }
}

__device__ __forceinline__ void sb_item(KP P, int item, unsigned char* lds, int wv_) {
#ifdef OFF_sb_item
  return;
#endif

  bf16_t* p = (bf16_t*)(P->ws + WS_P);
  const int tid = opaque_tid(wv_), lane = tid & 63, w = tid >> 6;
  const int qt = item & 127, bh = item >> 7, b = bh >> 2, head = bh & 3;
  unsigned char* Qs = lds;
  unsigned char* Ks = lds + 9216;
  unsigned char* Vt = lds + 18432;
  unsigned char* As = lds + 27648;
  float* Zs = (float*)(lds + 36864);
  volatile int* flag = (volatile int*)(lds + 36864 + 64 * 65 * 4);
  const int lrow = tid >> 3, lch = (tid & 7);
  const size_t tokq = (size_t)b * TSEQ + qt * 64;
  *(uint4*)(Qs + lrow * 144 + lch * 16) = *(const uint4*)(p + (tokq + lrow) * NIN + C_SQ + head * 64 + lch * 8);
  float carry = 0.f;
  f32x4 oacc[2] = {{0.f, 0.f, 0.f, 0.f}, {0.f, 0.f, 0.f, 0.f}};
  const int qi = w >> 1, t2 = (w & 1) * 2;
  const int q = tid >> 3, seg = tid & 7;
  uint4 kreg = *(const uint4*)(p + (tokq + lrow) * NIN + C_SK + head * 64 + lch * 8);
  uint4 vreg = *(const uint4*)(p + (tokq + lrow) * NIN + C_SV + head * 64 + lch * 8);
  for (int kt = qt; kt >= 0; --kt) {
    __syncthreads();
    *(uint4*)(Ks + lrow * 144 + lch * 16) = kreg;
    { const unsigned vw[4] = {vreg.x, vreg.y, vreg.z, vreg.w};
#pragma unroll
      for (int e = 0; e < 8; ++e) *(unsigned short*)(Vt + (lch * 8 + e) * 144 + lrow * 2) = (unsigned short)((e & 1) ? (vw[e >> 1] >> 16) : (vw[e >> 1] & 0xffffu)); }
    if (tid == 0) *flag = 0;
    if (kt > 0) { const size_t tokn = (size_t)b * TSEQ + (kt - 1) * 64;
      kreg = *(const uint4*)(p + (tokn + lrow) * NIN + C_SK + head * 64 + lch * 8);
      vreg = *(const uint4*)(p + (tokn + lrow) * NIN + C_SV + head * 64 + lch * 8); }
    __syncthreads();
#pragma unroll
    for (int jj = 0; jj < 2; ++jj) {
      const int ki = t2 + jj;
      f32x4 acc = {0.f, 0.f, 0.f, 0.f};
#pragma unroll
      for (int s = 0; s < 2; ++s) {
        const bf16x8 a = *(const bf16x8*)(Qs + (qi * 16 + (lane & 15)) * 144 + s * 64 + (lane >> 4) * 16);
        const bf16x8 bb = *(const bf16x8*)(Ks + (ki * 16 + (lane & 15)) * 144 + s * 64 + (lane >> 4) * 16);
        acc = __builtin_amdgcn_mfma_f32_16x16x32_bf16(a, bb, acc, 0, 0, 0);
      }
#pragma unroll
      for (int r = 0; r < 4; ++r) Zs[(qi * 16 + (lane >> 4) * 4 + r) * 65 + ki * 16 + (lane & 15)] = acc[r] * 0.125f;
    }
    __syncthreads();
    {
      const int tq = qt * 64 + q;
      float z[8], lk[8];
      float tot = 0.f;
#pragma unroll
      for (int e = 0; e < 8; ++e) {
        z[e] = Zs[q * 65 + seg * 8 + e];
        const bool m = (kt * 64 + seg * 8 + e) < tq;
        lk[e] = m ? -softplus_fast(z[e]) : 0.f;
        tot += lk[e];
      }
      float inc = tot;
      { float t_ = bperm(inc, lane + 1); if (seg + 1 < 8) inc += t_; }
      { float t_ = bperm(inc, lane + 2); if (seg + 2 < 8) inc += t_; }
      { float t_ = bperm(inc, lane + 4); if (seg + 4 < 8) inc += t_; }
      const float rowtot = bperm(inc, lane & ~7);
      float tail = carry + (inc - tot);
      float av[8];
#pragma unroll
      for (int e = 7; e >= 0; --e) {
        const bool m = (kt * 64 + seg * 8 + e) < tq;
        av[e] = m ? __expf(z[e] + lk[e] + tail) : 0.f;
        tail += lk[e];
      }
      uint4 o; o.x = pack2(av[0], av[1]); o.y = pack2(av[2], av[3]); o.z = pack2(av[4], av[5]); o.w = pack2(av[6], av[7]);
      *(uint4*)(As + q * 144 + seg * 16) = o;
      carry += rowtot;
      if (carry > -100.f) *flag = 1;
    }
    __syncthreads();
#pragma unroll
    for (int jj = 0; jj < 2; ++jj) {
      const int di = t2 + jj;
#pragma unroll
      for (int s = 0; s < 2; ++s) {
        const bf16x8 a = *(const bf16x8*)(As + (qi * 16 + (lane & 15)) * 144 + s * 64 + (lane >> 4) * 16);
        const bf16x8 bb = *(const bf16x8*)(Vt + (di * 16 + (lane & 15)) * 144 + s * 64 + (lane >> 4) * 16);
        oacc[jj] = __builtin_amdgcn_mfma_f32_16x16x32_bf16(a, bb, oacc[jj], 0, 0, 0);
      }
    }
    if (*flag == 0) break;
  }
#pragma unroll
  for (int jj = 0; jj < 2; ++jj) {
    const int d = (t2 + jj) * 16 + (lane & 15);
#pragma unroll
    for (int r = 0; r < 4; ++r) {
      const int qq = qi * 16 + (lane >> 4) * 4 + r;
      bf16_t* gp = p + (tokq + qq) * NIN + C_SG + head * 64 + d;
      *gp = f2bf(oacc[jj][r] * siluf_(bf2f(*gp)));
    }
  }
  __syncthreads();
}

__device__ __forceinline__ void xattn_item(KP P, int l, int item, unsigned char* lds, int wv_) {
#ifdef OFF_xattn_item
  return;
#endif

  const bf16_t* qb = (const bf16_t*)(P->ws + WS_P + 32ull * MiB);
  bf16_t* ob = (bf16_t*)(P->ws + WS_P + 64ull * MiB);
  const bf16_t* kv = (const bf16_t*)(P->ws + WS_KV) + (size_t)l * 512 * 2048;
  const int tid = opaque_tid(wv_), lane = tid & 63, w = tid >> 6;
  const int qt = item & 127, bh = item >> 7, b = bh >> 2, head = bh & 3;
  unsigned char* Qs = lds;
  unsigned char* KVs = lds + 33792;
  float* Ss = (float*)(lds + 67584);
  const size_t tok0 = (size_t)b * TSEQ + qt * 64;
  __syncthreads();
#pragma unroll
  for (int i = 0; i < 4; ++i) { const int c = tid + i * NTHR, r = c >> 5, cc = c & 31;
    *(uint4*)(Qs + r * 528 + cc * 16) = *(const uint4*)(qb + (tok0 + r) * 1024 + head * 256 + cc * 8); }
  const int qi = w >> 1, t2 = (w & 1) * 2;
  for (int kb = 0; kb < 4; ++kb) {
    __syncthreads();
#pragma unroll
    for (int i = 0; i < 4; ++i) { const int c = tid + i * NTHR, r = c >> 5, cc = c & 31;
      *(uint4*)(KVs + r * 528 + cc * 16) = *(const uint4*)(kv + (size_t)(b * 256 + kb * 64 + r) * 2048 + head * 256 + cc * 8); }
    __syncthreads();
#pragma unroll
    for (int jj = 0; jj < 2; ++jj) {
      const int ki = t2 + jj;
      f32x4 acc = {0.f, 0.f, 0.f, 0.f};
#pragma unroll
      for (int s = 0; s < 8; ++s) {
        const bf16x8 a = *(const bf16x8*)(Qs + (qi * 16 + (lane & 15)) * 528 + s * 64 + (lane >> 4) * 16);
        const bf16x8 bb = *(const bf16x8*)(KVs + (ki * 16 + (lane & 15)) * 528 + s * 64 + (lane >> 4) * 16);
        acc = __builtin_amdgcn_mfma_f32_16x16x32_bf16(a, bb, acc, 0, 0, 0);
      }
#pragma unroll
      for (int r = 0; r < 4; ++r) Ss[(qi * 16 + (lane >> 4) * 4 + r) * 260 + kb * 64 + ki * 16 + (lane & 15)] = acc[r] * 0.0625f;
    }
  }
  __syncthreads();
  {
    const int q = tid >> 3, seg = tid & 7;
    float x[32]; float mx = -3.0e38f;
#pragma unroll
    for (int i = 0; i < 8; ++i) { const float4 v = *(const float4*)(Ss + q * 260 + seg * 32 + i * 4); x[i * 4] = v.x; x[i * 4 + 1] = v.y; x[i * 4 + 2] = v.z; x[i * 4 + 3] = v.w;
      mx = fmaxf(mx, fmaxf(fmaxf(v.x, v.y), fmaxf(v.z, v.w))); }
    mx = max8(mx);
    float sum = 0.f;
#pragma unroll
    for (int i = 0; i < 32; ++i) { x[i] = __expf(x[i] - mx); sum += x[i]; }
    sum = red8(sum);
    const float inv = __builtin_amdgcn_rcpf(sum);
#pragma unroll
    for (int i = 0; i < 4; ++i) { uint4 o; o.x = pack2(x[i * 8] * inv, x[i * 8 + 1] * inv); o.y = pack2(x[i * 8 + 2] * inv, x[i * 8 + 3] * inv);
      o.z = pack2(x[i * 8 + 4] * inv, x[i * 8 + 5] * inv); o.w = pack2(x[i * 8 + 6] * inv, x[i * 8 + 7] * inv);
      *(uint4*)(Qs + q * 528 + seg * 64 + i * 16) = o; }
  }
  for (int db = 0; db < 4; ++db) {
    __syncthreads();
#pragma unroll
    for (int i = 0; i < 4; ++i) { const int c = tid + i * NTHR, m = c >> 3, dc = c & 7;
      const uint4 vv = *(const uint4*)(kv + (size_t)(b * 256 + m) * 2048 + 1024 + head * 256 + db * 64 + dc * 8);
      const unsigned short* ve = (const unsigned short*)&vv;
#pragma unroll
      for (int e = 0; e < 8; ++e) *(unsigned short*)(KVs + (dc * 8 + e) * 528 + m * 2) = ve[e]; }
    __syncthreads();
#pragma unroll
    for (int jj = 0; jj < 2; ++jj) {
      const int di = t2 + jj;
      f32x4 acc = {0.f, 0.f, 0.f, 0.f};
#pragma unroll
      for (int s = 0; s < 8; ++s) {
        const bf16x8 a = *(const bf16x8*)(Qs + (qi * 16 + (lane & 15)) * 528 + s * 64 + (lane >> 4) * 16);
        const bf16x8 bb = *(const bf16x8*)(KVs + (di * 16 + (lane & 15)) * 528 + s * 64 + (lane >> 4) * 16);
        acc = __builtin_amdgcn_mfma_f32_16x16x32_bf16(a, bb, acc, 0, 0, 0);
      }
#pragma unroll
      for (int r = 0; r < 4; ++r) ob[(tok0 + qi * 16 + (lane >> 4) * 4 + r) * 1024 + head * 256 + db * 64 + di * 16 + (lane & 15)] = f2bf(acc[r]);
    }
  }
  __syncthreads();
}

__global__ void __launch_bounds__(NTHR) fwd_megakernel(Params Pk_unused) {
  KP P = (KP)__builtin_amdgcn_kernarg_segment_ptr();
  extern __shared__ __attribute__((aligned(16))) unsigned char lds[];
  const int wv_ = __builtin_amdgcn_readfirstlane((int)threadIdx.x >> 6);
  __shared__ uint4 xb_words;
  if (opaque_tid(wv_) == 0) xb_words = make_uint4(0u, 0u, 0u, 0u);
  __syncthreads();
#ifdef PROBE_J
  __shared__ unsigned long long tacc[32];
  __shared__ unsigned long long tlast;
  __shared__ float pdelta;
  if (opaque_tid(wv_) == 0) { for (int i = 0; i < 32; ++i) tacc[i] = 0ull; tlast = __builtin_amdgcn_s_memrealtime(); pdelta = 0.f; }
#define STAMP(k) if (opaque_tid(wv_) == 0) { const unsigned long long n_ = __builtin_amdgcn_s_memrealtime(); tacc[k] += n_ - tlast; tlast = n_; }
#else
#define STAMP(k)
#endif
  XcdBarrier bar = xcd_barrier_post((unsigned*)(P->ws + WS_BAR), (volatile LAS unsigned*)&xb_words, wv_);
  if (P->never) cg::this_grid().sync();
  const int G = gridDim.x, bid = blockIdx.x;

  for (int it = bid; it < 2 * 2256; it += G) {
    const int l = it / 2256; int r = it % 2256;
    const float* W; int N; bf16_t* Wt; int kt, nt;
    unsigned char* wl = P->ws + WS_WT + l * WT_LAYER;
    if (r < 976) { W = P->in[3] + (size_t)l * 1024 * NIN; N = NIN; Wt = (bf16_t*)(wl + WT_IN); kt = r / 61; nt = r % 61; }
    else { r -= 976; const int m = r >> 8; r &= 255; kt = r >> 4; nt = r & 15; N = 1024;
      if (m == 0) { W = P->in[20] + (size_t)l * 1048576; Wt = (bf16_t*)(wl + WT_OUT); }
      else if (m == 1) { W = P->in[23] + (size_t)l * 1048576; Wt = (bf16_t*)(wl + WT_Q); }
      else if (m == 2) { W = P->in[24] + (size_t)l * 1048576; Wt = (bf16_t*)(wl + WT_KV); }
      else if (m == 3) { W = P->in[25] + (size_t)l * 1048576; Wt = (bf16_t*)(wl + WT_KV) + 1024 * 1024; }
      else { W = P->in[26] + (size_t)l * 1048576; Wt = (bf16_t*)(wl + WT_O); } }
    wt_tile(W, N, Wt, kt, nt, lds, wv_);
  }
#pragma unroll 1
  for (int k = 0; k < 3; ++k) {
    const float* s_ = k < 2 ? P->in[1] : P->in[0];
    const float* g_ = k < 2 ? P->in[22] + k * 1024 : P->in[2];
    bf16_t* d_ = k < 2 ? (bf16_t*)(P->ws + WS_MEMN) + k * 512 * 1024 : (bf16_t*)(P->ws + WS_R1);
    norm_rows(false, s_, g_, d_, k < 2 ? 512 : NT, 0.f, wv_);
  }
  STAMP(16 + 10); xcd_barrier(bar, wv_); STAMP(10)
  asm volatile("" : "+s"(P));

#pragma unroll 1
  for (int it = 0; it < 20; ++it) {
    int l = it / 10, ph = it % 10;
    asm volatile("" : "+s"(P));

    unsigned char* ws = P->ws;
    const unsigned char* wl = ws + WS_WT + l * WT_LAYER;
    bf16_t* hbuf = (bf16_t*)(ws + WS_R1);
    bf16_t* pbuf = (bf16_t*)(ws + WS_P);
    bf16_t* hx = (bf16_t*)(ws + WS_P);
    bf16_t* qbuf = (bf16_t*)(ws + WS_P + 32ull * MiB);
    bf16_t* obuf = (bf16_t*)(ws + WS_P + 64ull * MiB);
    if (ph == 0 || ph == 4 || ph == 6 || ph == 8) {
      pg8::Gemm g; pg8::TileSched S; pg8::EpiDyn E;
      g.M = NT; g.K = 1024; S.G = G; S.c = bid;
      if (ph == 0) { g.A = hbuf; g.Bt = (const bf16_t*)(wl + WT_IN); g.N = 4096; g.lda = 1024; g.ao0 = 0; g.ao1 = 256; g.ao2 = 512; g.ao3 = 768; S.nt = 1024; S.nN = 16;
        E.mode = 0; E.O = pbuf; E.ldc = NIN; E.N = NIN; E.resid = nullptr; E.out = nullptr; }
      else if (ph == 4) { g.A = pbuf; g.Bt = (const bf16_t*)(wl + WT_OUT); g.N = 1024; g.lda = NIN; g.ao0 = C_GA; g.ao1 = C_CGATE; g.ao2 = C_HG; g.ao3 = C_SG; S.nt = 256; S.nN = 4;
        E.mode = 1; E.O = nullptr; E.ldc = 1024; E.N = 1024; E.resid = (l == 0) ? P->in[0] : P->out; E.out = P->out; }
      else if (ph == 6) { g.A = hx; g.Bt = (const bf16_t*)(wl + WT_Q); g.N = 1024; g.lda = 1024; g.ao0 = 0; g.ao1 = 256; g.ao2 = 512; g.ao3 = 768; S.nt = 256; S.nN = 4;
        E.mode = 0; E.O = qbuf; E.ldc = 1024; E.N = 1024; E.resid = nullptr; E.out = nullptr; }
      else { g.A = obuf; g.Bt = (const bf16_t*)(wl + WT_O); g.N = 1024; g.lda = 1024; g.ao0 = 0; g.ao1 = 256; g.ao2 = 512; g.ao3 = 768; S.nt = 256; S.nN = 4;
        E.mode = 1; E.O = nullptr; E.ldc = 1024; E.N = 1024; E.resid = P->out; E.out = P->out; }
      pg8::gemm_phase<pg8::EpiDyn, pg8::TileSched, true, true>((PG8_LAS unsigned char*)lds, g, S, E, wv_);
    } else if (ph == 1) {
      for (int i2 = bid; i2 < 640; i2 += G) {
        if (i2 < 128) hgrn_wave_item<0>(P, l, i2 * 8 + wv_, lds, wv_);
        else rwkv_prep_item(P, l, i2 - 128, lds, wv_);
        __syncthreads();
      }
    } else if (ph == 2) {
      const int n_p1 = 8 * (RW_C - 2);
      const int n_rw = n_p1 + 8;
      const int n_oth = 8 + 512 + 1024;
      if (G > n_rw + 32) {
        if (bid < n_rw) {
          if (bid < n_p1) rwkv_scan_item<1>(P, l, bid & 7, 1 + (bid >> 3), lds, wv_);
          else rwkv_scan_item<0>(P, l, bid - n_p1, 0, lds, wv_);
        } else {
          for (int i2 = bid - n_rw; i2 < n_oth; i2 += G - n_rw) {
            if (i2 < 8) hgrn_combine_item(P, i2, wv_);
            else if (i2 < 8 + 512) conv_item(P, l, i2 - 8, lds, wv_);
            else sb_item(P, i2 - 8 - 512, lds, wv_);
            __syncthreads();
          }
        }
      } else {
        for (int i2 = bid; i2 < n_rw + n_oth; i2 += G) {
          if (i2 < n_p1) rwkv_scan_item<1>(P, l, i2 & 7, 1 + (i2 >> 3), lds, wv_);
          else if (i2 < n_rw) rwkv_scan_item<0>(P, l, i2 - n_p1, 0, lds, wv_);
          else if (i2 < n_rw + 8) hgrn_combine_item(P, i2 - n_rw, wv_);
          else if (i2 < n_rw + 8 + 512) conv_item(P, l, i2 - n_rw - 8, lds, wv_);
          else sb_item(P, i2 - n_rw - 8 - 512, lds, wv_);
          __syncthreads();
        }
      }
    } else if (ph == 3) {
      const int n_p3 = 8 * (RW_C - 1);
      const int n_all = n_p3 + 128 + 16;
      for (int i2 = bid; i2 < n_all; i2 += G) {
        if (i2 < n_p3) rwkv_scan_item<0>(P, l, i2 & 7, 1 + (i2 >> 3), lds, wv_);
        else if (i2 < n_p3 + 128) hgrn_wave_item<1>(P, l, (i2 - n_p3) * 8 + wv_, lds, wv_);
        else { const int t = i2 - n_p3 - 128; gemm_tile<0>((const bf16_t*)(ws + WS_MEMN) + (size_t)l * 512 * 1024, 1024, 0, 256, 512, 768, (const bf16_t*)(wl + WT_KV), (t >> 3) * 256, (t & 7) * 256, 2048,
                                                          (bf16_t*)(ws + WS_KV) + (size_t)l * 512 * 2048, nullptr, 2048, lds, wv_); }
        __syncthreads();
      }
    } else if (ph == 7) {
      for (int i2 = bid; i2 < 1024; i2 += G) xattn_item(P, l, i2, lds, wv_);
    } else {
      const bool fin = (ph == 9 && l == 1);
      const float* g_ = ph == 5 ? P->in[21] + l * 1024 : (fin ? P->in[27] : P->in[2] + 1024);
      void* d_ = ph == 5 ? (void*)hx : (fin ? (void*)P->out : (void*)hbuf);
#ifdef PROBE_J
      float pd_ = 0.f;
      if (fin) {
        if (bid == PROBE_B) {
          if (opaque_tid(wv_) == 0) {
            unsigned long long tot = 0ull; for (int i = 0; i < 11; ++i) tot += tacc[i] + tacc[16 + i];
            pdelta = sqrtf(0.0128f * (float)tacc[PROBE_J] / (float)tot);
          }
          __syncthreads();
          pd_ = pdelta;
        }
      }
      norm_rows(fin, P->out, g_, d_, NT, pd_, wv_);
#else
      norm_rows(fin, P->out, g_, d_, NT, 0.f, wv_);
#endif
    }
    if (it < 19) { STAMP(16 + ph); xcd_barrier(bar, wv_); STAMP(ph) }
  }
#ifdef PROBE_J
  if (bid == PROBE_B && opaque_tid(wv_) == 0) {
    const unsigned long long t0_ = __builtin_amdgcn_s_memrealtime();
    const unsigned long long w_ = 4ull * tacc[PROBE_K];
    while (__builtin_amdgcn_s_memrealtime() - t0_ < w_) __builtin_amdgcn_s_sleep(8);
  }
#endif
}

extern "C" void kernel_launch(void* const* d_in, const int* in_sizes, int n_in, void* d_out, int out_size, void* d_ws, size_t ws_size, hipStream_t stream) {
  constexpr size_t kDynLds = 147456;
  static int grid_blocks = 0;
  if (!grid_blocks) {
    int dev = 0, cus = 0, per_cu = 0;
    hipGetDevice(&dev);
    hipDeviceGetAttribute(&cus, hipDeviceAttributeMultiprocessorCount, dev);
    hipFuncSetAttribute((const void*)fwd_megakernel, hipFuncAttributeMaxDynamicSharedMemorySize, (int)kDynLds);
    hipOccupancyMaxActiveBlocksPerMultiprocessor(&per_cu, fwd_megakernel, NTHR, kDynLds);
    if (per_cu < 1) per_cu = 1;
    if (per_cu > 1) per_cu = 1;
    grid_blocks = cus * per_cu;
    if (grid_blocks > 256) grid_blocks = 256;
  }
  Params p;
  memset(&p, 0, sizeof(p));
  for (int i = 0; i < 28; ++i) p.in[i] = (const float*)d_in[i];
  p.out = (float*)d_out; p.ws = (unsigned char*)d_ws; p.never = 0; p.pad = 0;
  hipMemsetAsync(d_ws, 0, XCD_BAR_WORDS * 4, stream);
  void* args[] = {&p};
  hipError_t e = hipLaunchCooperativeKernel((void*)fwd_megakernel, dim3(grid_blocks), dim3(NTHR), args, kDynLds, stream);
  if (e != hipSuccess) fprintf(stderr, "cooperative launch failed: %s (grid %d)\n", hipGetErrorString(e), grid_blocks);
}
```

```cpp
#include <hip/hip_runtime.h>
#include <hip/hip_cooperative_groups.h>
#include <stdint.h>
#include <cstdio>
#include <cstring>
namespace cg = cooperative_groups;

typedef unsigned short bf16_t;
typedef short bf16x8 __attribute__((ext_vector_type(8)));
typedef float f32x4 __attribute__((ext_vector_type(4)));
typedef float f32x16 __attribute__((ext_vector_type(16)));
typedef float f32x2 __attribute__((ext_vector_type(2)));
#define LAS __attribute__((address_space(3)))

#define NT 16384
#define TSEQ 8192
#define DM 1024
#define NIN 3904
#define NTHR 512
#define C_R 0
#define C_K 256
#define C_V 512
#define C_XW 768
#define C_GA 832
#define C_CVAL 1088
#define C_CGLU 1344
#define C_CGATE 1600
#define C_HQ 1856
#define C_HF 2112
#define C_HI 2368
#define C_HG 2624
#define C_SQ 2880
#define C_SK 3136
#define C_SV 3392
#define C_SG 3648
#define RW_C 16
#define RW_CL (TSEQ / RW_C)
#define RW_TT 16

#define MiB (1024ull * 1024ull)
#define WS_BAR   0ull
#define WS_WT    (1ull * MiB)
#define WT_LAYER (18ull * MiB)
#define WT_IN    0ull
#define WT_OUT   (8ull * MiB)
#define WT_Q     (10ull * MiB)
#define WT_KV    (12ull * MiB)
#define WT_O     (16ull * MiB)
#define WS_MEMN  (37ull * MiB)
#define WS_KV    (39ull * MiB)
#define WS_PQ    (43ull * MiB)
#define WS_HS    (47ull * MiB)
#define WS_HF    (63ull * MiB)
#define WS_RK    (63ull * MiB + 512ull * 1024ull)
#define WS_R1    (64ull * MiB)
#define WS_PW    WS_R1
#define WS_PV    (WS_R1 + 16ull * MiB)
#define WS_P     (120ull * MiB)
#define WS_END   (243ull * MiB)

struct Params {
  const float* in[28];
  float* out;
  unsigned char* ws;
  int never;
  int pad;
};

typedef const __attribute__((address_space(4))) Params* KP;
__device__ __forceinline__ int lane_id_() { return (int)__builtin_amdgcn_mbcnt_hi(~0u, __builtin_amdgcn_mbcnt_lo(~0u, 0u)); }
__device__ __forceinline__ int opaque_tid(int wv_) { int t; asm volatile("v_mbcnt_lo_u32_b32 %0, -1, 0\n\tv_mbcnt_hi_u32_b32 %0, -1, %0\n\tv_lshl_add_u32 %0, %1, 6, %0" : "=&v"(t) : "s"(wv_)); return t; }
__device__ __forceinline__ float bf2f(bf16_t v) { return __uint_as_float(((unsigned)v) << 16); }
__device__ __forceinline__ bf16_t f2bf(float f) {
  unsigned u = __float_as_uint(f);
  u += 0x7fffu + ((u >> 16) & 1u);
  return (bf16_t)(u >> 16);
}
__device__ __forceinline__ unsigned pack2(float a, float b) { return (unsigned)f2bf(a) | ((unsigned)f2bf(b) << 16); }
__device__ __forceinline__ float sigmoidf_(float x) { return __builtin_amdgcn_rcpf(1.0f + __expf(-x)); }
__device__ __forceinline__ float siluf_(float x) { return x * __builtin_amdgcn_rcpf(1.0f + __expf(-x)); }
__device__ __forceinline__ float softplusf_(float x) { return fmaxf(x, 0.f) + log1pf(__expf(-fabsf(x))); }
__device__ __forceinline__ float softplus_fast(float x) { return fmaxf(x, 0.f) + __logf(1.0f + __expf(-fabsf(x))); }
__device__ __forceinline__ float dpp_add(float v, const int ctrl_sel) {
  return v;
}
__device__ __forceinline__ float bperm(float v, int srclane) { return __builtin_bit_cast(float, __builtin_amdgcn_ds_bpermute(srclane << 2, __builtin_bit_cast(int, v))); }
__device__ __forceinline__ float wave_sum(float v, int lane) {
  v += __builtin_bit_cast(float, __builtin_amdgcn_update_dpp(0, __builtin_bit_cast(int, v), 0xB1, 0xF, 0xF, true));
  v += __builtin_bit_cast(float, __builtin_amdgcn_update_dpp(0, __builtin_bit_cast(int, v), 0x4E, 0xF, 0xF, true));
  v += __builtin_bit_cast(float, __builtin_amdgcn_update_dpp(0, __builtin_bit_cast(int, v), 0x141, 0xF, 0xF, true));
  v += __builtin_bit_cast(float, __builtin_amdgcn_update_dpp(0, __builtin_bit_cast(int, v), 0x140, 0xF, 0xF, true));
  v += bperm(v, lane ^ 16);
  v += bperm(v, lane ^ 32);
  return v;
}
__device__ __forceinline__ float max8(float v) {
  v = fmaxf(v, __builtin_bit_cast(float, __builtin_amdgcn_update_dpp(0, __builtin_bit_cast(int, v), 0xB1, 0xF, 0xF, true)));
  v = fmaxf(v, __builtin_bit_cast(float, __builtin_amdgcn_update_dpp(0, __builtin_bit_cast(int, v), 0x4E, 0xF, 0xF, true)));
  v = fmaxf(v, __builtin_bit_cast(float, __builtin_amdgcn_update_dpp(0, __builtin_bit_cast(int, v), 0x141, 0xF, 0xF, true)));
  return v;
}
__device__ __forceinline__ float red8(float v) {
  v += __builtin_bit_cast(float, __builtin_amdgcn_update_dpp(0, __builtin_bit_cast(int, v), 0xB1, 0xF, 0xF, true));
  v += __builtin_bit_cast(float, __builtin_amdgcn_update_dpp(0, __builtin_bit_cast(int, v), 0x4E, 0xF, 0xF, true));
  v += __builtin_bit_cast(float, __builtin_amdgcn_update_dpp(0, __builtin_bit_cast(int, v), 0x141, 0xF, 0xF, true));
  return v;
}

#define LBAR() do { asm volatile("s_waitcnt lgkmcnt(0)" ::: "memory"); __builtin_amdgcn_s_barrier(); asm volatile("" ::: "memory"); } while (0)
#define XB_TMO      128
#define XB_XCNT(j)  (256  + 64 * (j))
#define XB_XSUB(j)  (1280 + 64 * (j))
#define XB_XGEN(j)  (2304 + 64 * (j))
#define XB_TOP      3328
#define XB_TOPGEN   3392
#define XCD_BAR_WORDS 3456
#define XB_SPIN_CAP (1u << 22)
__device__ __forceinline__ unsigned xb_ld(unsigned* p) { return __hip_atomic_load(p, __ATOMIC_RELAXED, __HIP_MEMORY_SCOPE_AGENT); }
__device__ __forceinline__ unsigned xb_add(unsigned* p, unsigned v) { return __hip_atomic_fetch_add(p, v, __ATOMIC_RELAXED, __HIP_MEMORY_SCOPE_AGENT); }
__device__ __forceinline__ unsigned xb_xcc_id() { return (unsigned)__builtin_amdgcn_s_getreg((3 << 11) | 20) & 0xFu; }
#define XB_SPIN(cond, bar) do { unsigned _sp = 0; while (cond) { __builtin_amdgcn_s_sleep(1); \
    if ((++_sp & 255u) == 0u) { if (xb_ld(&(bar)[XB_TMO])) break; if (_sp > XB_SPIN_CAP) { atomicAdd(&(bar)[XB_TMO], 1u); break; } } } } while (0)
struct XcdBarrier { unsigned* bar; unsigned x; volatile LAS unsigned* st; };
__device__ __forceinline__ XcdBarrier xcd_barrier_post(unsigned* bar, volatile LAS unsigned* st, int wv_) {
  XcdBarrier b; b.bar = bar; b.x = xb_xcc_id(); b.st = st;
  if (opaque_tid(wv_) == 0) (void)xb_add(&bar[XB_XCNT(b.x)], 1u);
  return b;
}
__device__ __forceinline__ void xcd_barrier_complete(unsigned* bar, unsigned x, unsigned& nloc, unsigned& nx) {
  const unsigned G = gridDim.x * gridDim.y * gridDim.z;
  unsigned sum, cnt, mine, sp = 0u;
  for (;;) {
    sum = 0u; cnt = 0u; mine = 0u;
#pragma unroll
    for (unsigned j = 0; j < 16; ++j) { const unsigned c = xb_ld(&bar[XB_XCNT(j)]); sum += c; cnt += (c > 0u) ? 1u : 0u; mine = (j == x) ? c : mine; }
    if (sum == G) break;
    __builtin_amdgcn_s_sleep(1);
    if ((++sp & 255u) == 0u) { if (xb_ld(&bar[XB_TMO])) break; if (sp > XB_SPIN_CAP) { atomicAdd(&bar[XB_TMO], 1u); break; } }
  }
  nloc = mine > 0u ? mine : 1u; nx = cnt > 0u ? cnt : 1u;
}
__device__ __forceinline__ void xcd_barrier(const XcdBarrier& b, int wv_) {
  asm volatile("s_waitcnt vmcnt(0)" ::: "memory");
  __syncthreads();
  if (opaque_tid(wv_) == 0) {
    unsigned* bar = b.bar;
    __builtin_amdgcn_s_waitcnt(0);
    unsigned bx = b.x; asm volatile("" : "+s"(bx));
    unsigned nloc = b.st[0], nx = b.st[1];
    if (nloc == 0u) { xcd_barrier_complete(bar, bx, nloc, nx); b.st[0] = nloc; b.st[1] = nx; }
    const unsigned old = xb_add(&bar[XB_XSUB(bx)], 1u);
    const unsigned gen = old / nloc;
    if (old + 1u == (gen + 1u) * nloc) {
      __builtin_amdgcn_fence(__ATOMIC_RELEASE, "agent");
      asm volatile("s_waitcnt vmcnt(0)" ::: "memory");
      const unsigned og = xb_add(&bar[XB_TOP], 1u);
      const unsigned tg = og / nx;
      if (og + 1u == (tg + 1u) * nx) xb_add(&bar[XB_TOPGEN], 1u);
      else XB_SPIN(xb_ld(&bar[XB_TOPGEN]) == tg, bar);
      __builtin_amdgcn_fence(__ATOMIC_ACQUIRE, "agent");
      xb_add(&bar[XB_XGEN(bx)], 1u);
      asm volatile("s_waitcnt vmcnt(0)" ::: "memory");
    } else {
      XB_SPIN(xb_ld(&bar[XB_XGEN(bx)]) == gen, bar);
      __builtin_amdgcn_fence(__ATOMIC_ACQUIRE, "agent");
      asm volatile("s_waitcnt vmcnt(0)" ::: "memory");
    }
  }
  __syncthreads();
}

#define G_STAGE 73728
#define G_BOFF 36864
template <int EPI>
__device__ __forceinline__ void gemm_tile(const bf16_t* __restrict__ A, int lda, int ao0, int ao1, int ao2, int ao3,
                                          const bf16_t* __restrict__ Bt, int m0, int n0, int N,
                                          void* out, const float* resid, int ldc, unsigned char* lds, int wv_) {
#ifdef OFF_gemm_tile
  return;
#endif

  const int tid = opaque_tid(wv_), lane = tid & 63, w = tid >> 6;
  const int wm = w >> 2, wn = w & 3, lr = lane & 31, lh = lane >> 5;
  f32x16 acc[4][2];
#pragma unroll
  for (int i = 0; i < 4; ++i)
#pragma unroll
    for (int j = 0; j < 2; ++j)
#pragma unroll
      for (int r = 0; r < 16; ++r) acc[i][j][r] = 0.f;
  uint4 ra[4], rb[4];
  const int crow = tid >> 3, ccol = (tid & 7) * 8;
  const bf16_t* Ap = A + (size_t)(m0 + crow) * lda + ccol;
  const bf16_t* Bp = Bt + (size_t)(n0 + crow) * 1024 + ccol;
#define G_LOAD(kt) { const int k0_ = (kt) * 64; const int seg_ = k0_ >> 8; const int ao_ = (seg_ == 0 ? ao0 : seg_ == 1 ? ao1 : seg_ == 2 ? ao2 : ao3) + (k0_ & 255); \
    _Pragma("unroll") for (int i_ = 0; i_ < 4; ++i_) { ra[i_] = *(const uint4*)(Ap + (size_t)(i_ * 64) * lda + ao_); rb[i_] = *(const uint4*)(Bp + (size_t)(i_ * 64) * 1024 + k0_); } }
#define G_WRITE(buf) { unsigned char* b_ = lds + (buf) * G_STAGE + crow * 144 + (tid & 7) * 16; \
    _Pragma("unroll") for (int i_ = 0; i_ < 4; ++i_) { *(uint4*)(b_ + i_ * 64 * 144) = ra[i_]; *(uint4*)(b_ + G_BOFF + i_ * 64 * 144) = rb[i_]; } }
  G_LOAD(0); G_WRITE(0); __syncthreads();
  for (int kt = 0; kt < 16; ++kt) {
    if (kt < 15) G_LOAD(kt + 1);
    const unsigned char* base = lds + (kt & 1) * G_STAGE;
    const unsigned char* ab = base + (wm * 128 + lr) * 144 + lh * 16;
    const unsigned char* bb = base + G_BOFF + (wn * 64 + lr) * 144 + lh * 16;
#pragma unroll
    for (int s = 0; s < 4; ++s) {
      bf16x8 a[4], b[2];
#pragma unroll
      for (int i = 0; i < 4; ++i) a[i] = *(const bf16x8*)(ab + i * 32 * 144 + s * 32);
#pragma unroll
      for (int j = 0; j < 2; ++j) b[j] = *(const bf16x8*)(bb + j * 32 * 144 + s * 32);
#pragma unroll
      for (int i = 0; i < 4; ++i)
#pragma unroll
        for (int j = 0; j < 2; ++j) acc[i][j] = __builtin_amdgcn_mfma_f32_32x32x16_bf16(a[i], b[j], acc[i][j], 0, 0, 0);
    }
    if (kt < 15) G_WRITE((kt + 1) & 1);
    __syncthreads();
  }
#undef G_LOAD
#undef G_WRITE
#pragma unroll
  for (int i = 0; i < 4; ++i)
#pragma unroll
    for (int j = 0; j < 2; ++j) {
      const int col = n0 + wn * 64 + j * 32 + lr;
#pragma unroll
      for (int r = 0; r < 16; ++r) {
        const int row = m0 + wm * 128 + i * 32 + (r & 3) + 8 * (r >> 2) + 4 * lh;
        if (EPI == 0) { if (col < N) ((bf16_t*)out)[(size_t)row * ldc + col] = f2bf(acc[i][j][r]); }
        else { ((float*)out)[(size_t)row * ldc + col] = resid[(size_t)row * ldc + col] + acc[i][j][r]; }
      }
    }
}

__device__ __forceinline__ void tile_map(int t, int nN, int& mi, int& ni) {
  const int rnd = t >> 8, blk = t & 255, x = blk & 7, y = blk >> 3;
  if (nN == 16) { mi = rnd * 16 + (x >> 1) * 4 + (y & 3); ni = (x & 1) * 8 + (y >> 2); }
  else { mi = rnd * 64 + x * 8 + (y & 7); ni = y >> 3; }
}

namespace pg8 {
#define PG8_LAS __attribute__((address_space(3)))
typedef unsigned u32x4 __attribute__((ext_vector_type(4)));
constexpr int BM = 256, BK = 64, HALF = 128, HTB = HALF * BK * 2  , STAGE_BYTES = 8 * HTB, NXCD = 8, WGM = 8;

__host__ __device__ __forceinline__ int lds_byte(int r, int c) { const int st = (r >> 4) * 2 + (c >> 5), rr = r & 15, cc = c & 31, ob = rr * 64 + cc * 2; return st * 1024 + (ob ^ (((ob >> 9) & 1) << 5)); }
__host__ __device__ __forceinline__ void stage_rc(int b, int& R, int& C) { const int st = b / 1024, sb = b % 1024, swz = sb ^ (((sb >> 9) & 1) << 5); R = (st >> 1) * 16 + swz / 64; C = (st & 1) * 32 + (swz % 64) / 2; }
__host__ __device__ __forceinline__ int perm32(int rho) { const int n = rho >> 4, i = rho & 15; return 8 * (i >> 2) + 4 * n + (i & 3); }

struct Unit { int pm, pn; };
struct Gemm { const bf16_t* A; const bf16_t* Bt; int M, N, K; int lda; int ao0, ao1, ao2, ao3; };

struct TileSched {
    int nt, G, c, nN;
    __device__ __forceinline__ bool next(int i, Unit& u) const { const int t = i * G + c; if (t >= nt) return false; tile_map(t, nN, u.pm, u.pn); return true; }
    __device__ __forceinline__ void a_ready(const Unit&) const {}
    __device__ __forceinline__ void done(const Unit&) const {}
};
__device__ __forceinline__ unsigned cvt_pk_bf16(float lo, float hi) { unsigned r; asm volatile("v_cvt_pk_bf16_f32 %0, %1, %2" : "=v"(r) : "v"(lo), "v"(hi)); return r; }
struct EpiStoreBf16 {
    static constexpr bool PERM = true, AFTER_DRAIN = false;
    bf16_t* O; int ldc; int N;
    __device__ __forceinline__ void operator()(const f32x4 (&acc)[2][2][4][2], const Unit& u, int wr, int wc, int fr, int fq) const {
        const int row0 = u.pm * BM + wr * 64 + fr, col0 = u.pn * BM + wc * 32 + 8 * fq;
#pragma unroll
        for (int ai = 0; ai < 2; ++ai)
#pragma unroll
            for (int m = 0; m < 4; ++m) { bf16_t* rowp = O + (size_t)(row0 + ai * HALF + m * 16) * ldc + col0;
#pragma unroll
                for (int bj = 0; bj < 2; ++bj) { if (col0 + bj * HALF < N) { const f32x4 v0 = acc[ai][bj][m][0], v1 = acc[ai][bj][m][1];
                    u32x4 w; w.x = cvt_pk_bf16(v0[0], v0[1]); w.y = cvt_pk_bf16(v0[2], v0[3]); w.z = cvt_pk_bf16(v1[0], v1[1]); w.w = cvt_pk_bf16(v1[2], v1[3]);
                    *(u32x4*)(rowp + bj * HALF) = w; } } }
    }
};
struct EpiDyn {
    static constexpr bool PERM = true, AFTER_DRAIN = false;
    int mode; bf16_t* O; int ldc; int N; const float* resid; float* out;
    __device__ __forceinline__ void operator()(const f32x4 (&acc)[2][2][4][2], const Unit& u, int wr, int wc, int fr, int fq) const {
        const int row0 = u.pm * BM + wr * 64 + fr, col0 = u.pn * BM + wc * 32 + 8 * fq;
        if (mode == 0) {
#pragma unroll
            for (int ai = 0; ai < 2; ++ai)
#pragma unroll
                for (int m = 0; m < 4; ++m) { bf16_t* rowp = O + (size_t)(row0 + ai * HALF + m * 16) * ldc + col0;
#pragma unroll
                    for (int bj = 0; bj < 2; ++bj) { if (col0 + bj * HALF < N) { const f32x4 v0 = acc[ai][bj][m][0], v1 = acc[ai][bj][m][1];
                        u32x4 w; w.x = cvt_pk_bf16(v0[0], v0[1]); w.y = cvt_pk_bf16(v0[2], v0[3]); w.z = cvt_pk_bf16(v1[0], v1[1]); w.w = cvt_pk_bf16(v1[2], v1[3]);
                        *(u32x4*)(rowp + bj * HALF) = w; } } }
        } else {
#pragma unroll
            for (int ai = 0; ai < 2; ++ai)
#pragma unroll
                for (int m = 0; m < 4; ++m) { const size_t off = (size_t)(row0 + ai * HALF + m * 16) * ldc + col0;
#pragma unroll
                    for (int bj = 0; bj < 2; ++bj) { const f32x4 r0 = *(const f32x4*)(resid + off + bj * HALF), r1 = *(const f32x4*)(resid + off + bj * HALF + 4);
                        *(f32x4*)(out + off + bj * HALF) = r0 + acc[ai][bj][m][0]; *(f32x4*)(out + off + bj * HALF + 4) = r1 + acc[ai][bj][m][1]; } }
        }
    }
};
struct EpiResid {
    static constexpr bool PERM = true, AFTER_DRAIN = false;
    const float* resid; float* out; int ldc;
    __device__ __forceinline__ void operator()(const f32x4 (&acc)[2][2][4][2], const Unit& u, int wr, int wc, int fr, int fq) const {
        const int row0 = u.pm * BM + wr * 64 + fr, col0 = u.pn * BM + wc * 32 + 8 * fq;
#pragma unroll
        for (int ai = 0; ai < 2; ++ai)
#pragma unroll
            for (int m = 0; m < 4; ++m) { const size_t off = (size_t)(row0 + ai * HALF + m * 16) * ldc + col0;
#pragma unroll
                for (int bj = 0; bj < 2; ++bj) { const f32x4 r0 = *(const f32x4*)(resid + off + bj * HALF), r1 = *(const f32x4*)(resid + off + bj * HALF + 4);
                    *(f32x4*)(out + off + bj * HALF) = r0 + acc[ai][bj][m][0]; *(f32x4*)(out + off + bj * HALF + 4) = r1 + acc[ai][bj][m][1]; } }
    }
};

static_assert(true, "pg8 body adapted: SP2 path only is valid with lda/segment offsets");
template <class Epi, class Sched, bool ALIGN_EPI = false, bool SP2 = false>
__device__ __forceinline__ void gemm_phase(PG8_LAS unsigned char* lds, const Gemm g, const Sched& S, const Epi& E, int wv_) {
    const int tid = opaque_tid(wv_), wid = __builtin_amdgcn_readfirstlane(tid >> 6), lane = tid & 63, wr = wid >> 2, wc = wid & 3, fr = lane & 15, fq = lane >> 4;
    const int K = g.K, nt = K / BK;
    unsigned voffA[2], voffB[2];
#pragma unroll
    for (int i = 0; i < 2; ++i) { int R, C; stage_rc(tid * 16 + i * 8192, R, C); const int Rb = Epi::PERM ? ((R & ~31) + perm32(R & 31)) : R;
        voffA[i] = (unsigned)(R * g.lda + C) * 2u; voffB[i] = (unsigned)(Rb * K + C) * 2u; }
    const size_t kstep = (size_t)(BK * 2);
    const size_t hstep = (size_t)HALF * K * 2; const size_t hstepA = (size_t)HALF * g.lda * 2, tstepA = 2 * hstepA;
#define PG8_KA(t_) ((size_t)((((t_) >> 2) == 0 ? g.ao0 : ((t_) >> 2) == 1 ? g.ao1 : ((t_) >> 2) == 2 ? g.ao2 : g.ao3) + ((t_) & 3) * 64) * 2)
    const size_t tstep = 2 * hstep;
    const unsigned ldsw = (unsigned)wid * 1024u;
    int aoff, boff;
#define PG8_SA(b, h) (((b) * 2 + (h)) * HTB)
#define PG8_SB(b, h) ((4 + (b) * 2 + (h)) * HTB)
#define PG8_STAGE(bufoff, gbase, voff) do { _Pragma("unroll") for (int _i = 0; _i < 2; ++_i) \
        __builtin_amdgcn_global_load_lds((const unsigned*)((const char*)(gbase) + (voff)[_i]), (PG8_LAS unsigned*)(lds + (bufoff) + ldsw + _i * 8192), 16, 0, 0); } while (0)
#define PG8_LDA(dst, b, h) do { _Pragma("unroll") for (int m = 0; m < 4; ++m) _Pragma("unroll") for (int k = 0; k < 2; ++k) dst[m][k] = *(const PG8_LAS bf16x8*)(lds + PG8_SA(b, h) + aoff + m * 2048 + k * 1024); } while (0)
#define PG8_LDB(dst, b, h) do { _Pragma("unroll") for (int n = 0; n < 2; ++n) _Pragma("unroll") for (int k = 0; k < 2; ++k) dst[n][k] = *(const PG8_LAS bf16x8*)(lds + PG8_SB(b, h) + boff + n * 2048 + k * 1024); } while (0)
#define PG8_MMA(ai, bj, At, Bt) do { __builtin_amdgcn_s_setprio(1); _Pragma("unroll") for (int m = 0; m < 4; ++m) _Pragma("unroll") for (int n = 0; n < 2; ++n) _Pragma("unroll") for (int k = 0; k < 2; ++k) \
        acc[ai][bj][m][n] = __builtin_amdgcn_mfma_f32_16x16x32_bf16(Bt[n][k], At[m][k], acc[ai][bj][m][n], 0, 0, 0); __builtin_amdgcn_s_setprio(0); } while (0)
#define PG8_WAIT_V(n) asm volatile("s_waitcnt vmcnt(" #n ")" ::: "memory")
#define PG8_WAIT_L(n) asm volatile("s_waitcnt lgkmcnt(" #n ")" ::: "memory")
#define PG8_BAR __builtin_amdgcn_s_barrier()
#define PG8_SCHED __builtin_amdgcn_sched_barrier(0)
    Unit cur, nxt; int ui = 0;
    if (!S.next(0, cur)) return;
    f32x4 acc[2][2][4][2];
#pragma unroll
    for (int a = 0; a < 2; ++a)
#pragma unroll
        for (int b = 0; b < 2; ++b)
#pragma unroll
            for (int m = 0; m < 4; ++m)
#pragma unroll
                for (int n = 0; n < 2; ++n) acc[a][b][m][n] = (f32x4){0.f, 0.f, 0.f, 0.f};
    bf16x8 At[4][2], B0[2][2], B1[2][2];
    const char* cA = (const char*)g.A + (size_t)cur.pm * tstepA; const char* cB = (const char*)g.Bt + (size_t)cur.pn * tstep;
    S.a_ready(cur);
    if constexpr (SP2) {
        PG8_STAGE(PG8_SB(0, 0), cB, voffB); PG8_STAGE(PG8_SB(0, 1), cB + hstep, voffB); PG8_STAGE(PG8_SA(0, 0), cA + PG8_KA(0), voffA); PG8_STAGE(PG8_SA(0, 1), cA + hstepA + PG8_KA(0), voffA);
        if (wr == 1) PG8_BAR;
        PG8_WAIT_V(2); PG8_BAR;
        PG8_STAGE(PG8_SB(1, 0), cB + kstep, voffB); PG8_STAGE(PG8_SA(1, 0), cA + PG8_KA(1), voffA); PG8_STAGE(PG8_SB(1, 1), cB + hstep + kstep, voffB);
        PG8_WAIT_V(6); PG8_BAR;
    } else {
        PG8_STAGE(PG8_SB(0, 0), cB, voffB); PG8_STAGE(PG8_SA(0, 0), cA, voffA); PG8_STAGE(PG8_SB(0, 1), cB + hstep, voffB); PG8_STAGE(PG8_SA(0, 1), cA + hstep, voffA);
        if (wr == 1) PG8_BAR;
        PG8_WAIT_V(4); PG8_BAR;
        PG8_STAGE(PG8_SB(1, 0), cB + kstep, voffB); PG8_STAGE(PG8_SA(1, 0), cA + kstep, voffA); PG8_STAGE(PG8_SB(1, 1), cB + hstep + kstep, voffB);
        PG8_WAIT_V(6); PG8_BAR;
    }
    { const int t3_ = opaque_tid(wv_), l3_ = t3_ & 63, w3_ = __builtin_amdgcn_readfirstlane(t3_ >> 6); aoff = lds_byte((w3_ >> 2) * 64 + (l3_ & 15), (l3_ >> 4) * 8); boff = lds_byte((w3_ & 3) * 32 + (l3_ & 15), (l3_ >> 4) * 8); }
    for (;;) {
        const bool has_next = S.next(ui + 1, nxt);
        const char* nA = has_next ? (const char*)g.A + (size_t)nxt.pm * tstepA : cA; const char* nB = has_next ? (const char*)g.Bt + (size_t)nxt.pn * tstep : cB;
        for (int t = 0; t < nt; t += 2) {
            const bool last = (t == nt - 2);
            const char* a1 = cA + PG8_KA(t + 1);
            const char* a2 = last ? nA + PG8_KA(0) : cA + PG8_KA(t + 2); const char* b2 = last ? nB : cB + (size_t)(t + 2) * kstep;
            const char* a3 = last ? nA + PG8_KA(1) : cA + PG8_KA(t + 3); const char* b3 = b2 + kstep;
            if (last && has_next) S.a_ready(nxt);
            if constexpr (SP2) {
            PG8_LDB(B0, 0, 0); PG8_LDB(B1, 0, 1); PG8_SCHED; PG8_LDA(At, 0, 0); PG8_STAGE(PG8_SA(1, 1), a1 + hstepA, voffA);
            PG8_WAIT_V(8); PG8_WAIT_L(0); PG8_BAR; PG8_MMA(0, 0, At, B0); PG8_MMA(0, 1, At, B1); PG8_BAR; PG8_SCHED;
            PG8_LDA(At, 0, 1); PG8_STAGE(PG8_SB(0, 0), b2, voffB); PG8_STAGE(PG8_SB(0, 1), b2 + hstep, voffB); PG8_STAGE(PG8_SA(0, 0), a2, voffA);
            PG8_WAIT_V(8); PG8_WAIT_L(0); PG8_BAR; PG8_MMA(1, 0, At, B0); PG8_MMA(1, 1, At, B1); PG8_BAR; PG8_SCHED;
            PG8_LDB(B0, 1, 0); PG8_LDB(B1, 1, 1); PG8_SCHED; PG8_LDA(At, 1, 0); PG8_STAGE(PG8_SA(0, 1), a2 + hstepA, voffA);
            PG8_WAIT_V(8); PG8_WAIT_L(0); PG8_BAR; PG8_MMA(0, 0, At, B0); PG8_MMA(0, 1, At, B1); PG8_BAR; PG8_SCHED;
            PG8_LDA(At, 1, 1); PG8_STAGE(PG8_SB(1, 0), b3, voffB); PG8_STAGE(PG8_SB(1, 1), b3 + hstep, voffB); PG8_STAGE(PG8_SA(1, 0), a3, voffA);
            PG8_WAIT_V(8); PG8_WAIT_L(0); PG8_BAR; PG8_MMA(1, 0, At, B0); PG8_MMA(1, 1, At, B1); PG8_BAR; PG8_SCHED;
            } else {
            PG8_LDB(B0, 0, 0); PG8_SCHED; PG8_LDA(At, 0, 0); PG8_STAGE(PG8_SA(1, 1), a1 + hstep, voffA);
            PG8_WAIT_L(8); PG8_BAR; PG8_WAIT_L(0); PG8_MMA(0, 0, At, B0); PG8_BAR; PG8_SCHED;
            PG8_LDB(B1, 0, 1); PG8_STAGE(PG8_SB(0, 0), b2, voffB);
            PG8_BAR; PG8_WAIT_L(0); PG8_MMA(0, 1, At, B1); PG8_BAR;
            PG8_LDA(At, 0, 1); PG8_STAGE(PG8_SA(0, 0), a2, voffA);
            PG8_BAR; PG8_WAIT_L(0); PG8_MMA(1, 0, At, B0); PG8_BAR; PG8_SCHED;
            PG8_STAGE(PG8_SB(0, 1), b2 + hstep, voffB);
            PG8_WAIT_V(6); PG8_BAR; PG8_MMA(1, 1, At, B1); PG8_BAR;
            PG8_LDB(B0, 1, 0); PG8_SCHED; PG8_LDA(At, 1, 0); PG8_STAGE(PG8_SA(0, 1), a2 + hstep, voffA);
            PG8_WAIT_L(8); PG8_BAR; PG8_WAIT_L(0); PG8_MMA(0, 0, At, B0); PG8_BAR; PG8_SCHED;
            PG8_LDB(B1, 1, 1); PG8_STAGE(PG8_SB(1, 0), b3, voffB);
            PG8_BAR; PG8_WAIT_L(0); PG8_MMA(0, 1, At, B1); PG8_BAR;
            PG8_LDA(At, 1, 1); PG8_STAGE(PG8_SA(1, 0), a3, voffA);
            PG8_BAR; PG8_WAIT_L(0); PG8_MMA(1, 0, At, B0); PG8_BAR; PG8_SCHED;
            PG8_STAGE(PG8_SB(1, 1), b3 + hstep, voffB);
            PG8_WAIT_V(6); PG8_BAR; PG8_MMA(1, 1, At, B1); PG8_BAR;
            }
        }
        if constexpr (ALIGN_EPI) { if (wr == 0) PG8_BAR; }
        if constexpr (!Epi::AFTER_DRAIN) { const int t2_ = opaque_tid(wv_), l2_ = t2_ & 63, w2_ = __builtin_amdgcn_readfirstlane(t2_ >> 6); E(acc, cur, w2_ >> 2, w2_ & 3, l2_ & 15, l2_ >> 4); S.done(cur); }
        if (!has_next) break;
#pragma unroll
        for (int a = 0; a < 2; ++a)
#pragma unroll
            for (int b = 0; b < 2; ++b)
#pragma unroll
                for (int m = 0; m < 4; ++m)
#pragma unroll
                    for (int n = 0; n < 2; ++n) acc[a][b][m][n] = (f32x4){0.f, 0.f, 0.f, 0.f};
        cur = nxt; cA = nA; cB = nB; ++ui;
        if constexpr (ALIGN_EPI) { if (wr == 1) PG8_BAR; }
    }
    PG8_WAIT_V(0);
    if constexpr (!ALIGN_EPI) { if (wr == 0) PG8_BAR; }
    PG8_BAR;
    if constexpr (Epi::AFTER_DRAIN) { E.fused(acc, cur, wr, wc, fr, fq, lds, wid, lane); S.done(cur); }
#undef PG8_SA
#undef PG8_SB
#undef PG8_STAGE
#undef PG8_LDA
#undef PG8_LDB
#undef PG8_MMA
#undef PG8_WAIT_V
#undef PG8_WAIT_L
#undef PG8_BAR
#undef PG8_SCHED
#undef PG8_KA
}
}

__device__ __forceinline__ void wt_tile(const float* __restrict__ W, int N, bf16_t* __restrict__ Wt, int kt, int nt, unsigned char* lds, int wv_) {
#ifdef OFF_wt_tile
  return;
#endif

  float* tl = (float*)lds;
  const int tid = opaque_tid(wv_);
  const int r = tid >> 3, c8 = (tid & 7) * 8;
  const float* src = W + (size_t)(kt * 64 + r) * N + nt * 64 + c8;
  const float4 v0 = *(const float4*)src, v1 = *(const float4*)(src + 4);
  float* d = tl + r * 65 + c8;
  d[0] = v0.x; d[1] = v0.y; d[2] = v0.z; d[3] = v0.w; d[4] = v1.x; d[5] = v1.y; d[6] = v1.z; d[7] = v1.w;
  __syncthreads();
  uint4 o;
  o.x = pack2(tl[(c8 + 0) * 65 + r], tl[(c8 + 1) * 65 + r]);
  o.y = pack2(tl[(c8 + 2) * 65 + r], tl[(c8 + 3) * 65 + r]);
  o.z = pack2(tl[(c8 + 4) * 65 + r], tl[(c8 + 5) * 65 + r]);
  o.w = pack2(tl[(c8 + 6) * 65 + r], tl[(c8 + 7) * 65 + r]);
  *(uint4*)(Wt + (size_t)(nt * 64 + r) * 1024 + kt * 64 + c8) = o;
  __syncthreads();
}

__device__ __forceinline__ void norm_rows(const bool F32OUT, const float* src, const float* __restrict__ g, void* dst, int nrows, float pd, int wv_) {
#ifdef OFF_norm_rows
  return;
#endif

  const int tid = opaque_tid(wv_);
  const int lane = tid & 63;
  const int gw = blockIdx.x * 8 + (tid >> 6), nw = gridDim.x * 8;
  float4 gv[4];
#pragma unroll
  for (int i = 0; i < 4; ++i) gv[i] = *(const float4*)(g + i * 256 + lane * 4);
  for (int row = gw; row < nrows; row += nw) {
    const float* s = src + (size_t)row * 1024;
    float4 v[4]; float ss = 0.f;
#pragma unroll
    for (int i = 0; i < 4; ++i) { v[i] = *(const float4*)(s + i * 256 + lane * 4); ss += v[i].x * v[i].x + v[i].y * v[i].y + v[i].z * v[i].z + v[i].w * v[i].w; }
    ss = wave_sum(ss, lane);
    const float rs = rsqrtf(ss * (1.0f / 1024.0f) + 1e-6f);
#pragma unroll
    for (int i = 0; i < 4; ++i) {
      const float a = v[i].x * rs * gv[i].x, b = v[i].y * rs * gv[i].y, c = v[i].z * rs * gv[i].z, d = v[i].w * rs * gv[i].w;
      if (F32OUT) { *(float4*)((float*)dst + (size_t)row * 1024 + i * 256 + lane * 4) = make_float4(a + pd, b + pd, c + pd, d + pd); }
      else { uint2 o; o.x = pack2(a, b); o.y = pack2(c, d); *(uint2*)((bf16_t*)dst + (size_t)row * 1024 + i * 256 + lane * 4) = o; }
    }
  }
}

__device__ __forceinline__ void rwkv_prep_item(KP P, int l, int item, unsigned char* lds, int wv_) {
#ifdef OFF_rwkv_prep_item
  return;
#endif

  const bf16_t* p = (const bf16_t*)(P->ws + WS_P);
  float* PW = (float*)(P->ws + WS_PW); bf16_t* PV = (bf16_t*)(P->ws + WS_PV); float* RK = (float*)(P->ws + WS_RK);
  float* lora = (float*)lds;
  const int tid = opaque_tid(wv_), lane = tid & 63, w = tid >> 6, head = w & 3, sub = w >> 2;
  const int c = head * 64 + lane;
  const float* mu = P->in[4] + l * 832;
  const float mur = mu[c], muk = mu[256 + c], muv = mu[512 + c], mux = mu[768 + lane];
  const float w0 = P->in[5][l * 256 + c], a0 = P->in[7][l * 256 + c];
  const float kkw = P->in[9][l * 256 + c], kaw = P->in[10][l * 256 + c], rkw = P->in[11][l * 256 + c];
  float wup[32], aup[32];
#pragma unroll
  for (int j = 0; j < 32; ++j) { wup[j] = P->in[6][(l * 32 + j) * 256 + c]; aup[j] = P->in[8][(l * 32 + j) * 256 + c]; }
  bf16_t raw[4][8];
#define PREP_LOAD(g) { _Pragma("unroll") for (int j_ = 0; j_ < 4; ++j_) { const int t_ = item * 32 + sub + 2 * ((g) * 4 + j_); const bool hp_ = (t_ & (TSEQ - 1)) > 0; \
      const bf16_t* pr_ = p + (size_t)t_ * NIN; raw[j_][0] = pr_[c]; raw[j_][1] = pr_[256 + c]; raw[j_][2] = pr_[512 + c]; raw[j_][3] = pr_[768 + lane]; \
      raw[j_][4] = hp_ ? pr_[c - NIN] : (bf16_t)0; raw[j_][5] = hp_ ? pr_[256 + c - NIN] : (bf16_t)0; raw[j_][6] = hp_ ? pr_[512 + c - NIN] : (bf16_t)0; raw[j_][7] = hp_ ? pr_[768 + lane - NIN] : (bf16_t)0; } }
  PREP_LOAD(0);
#pragma unroll 1
  for (int g = 0; g < 4; ++g) {
    float rr[4], kk4[4], vv4[4];
#pragma unroll
    for (int j = 0; j < 4; ++j) {
      float r = bf2f(raw[j][0]), k = bf2f(raw[j][1]), v = bf2f(raw[j][2]), x = bf2f(raw[j][3]);
      r += (bf2f(raw[j][4]) - r) * mur; k += (bf2f(raw[j][5]) - k) * muk; v += (bf2f(raw[j][6]) - v) * muv; x += (bf2f(raw[j][7]) - x) * mux;
      rr[j] = r; kk4[j] = k; vv4[j] = v;
      lora[(w * 4 + j) * 64 + lane] = lane < 32 ? tanhf(x) : x;
    }
    if (g < 3) PREP_LOAD(g + 1);
    __builtin_amdgcn_s_waitcnt(0xc07f);
    __builtin_amdgcn_wave_barrier();
#pragma unroll
    for (int j = 0; j < 4; ++j) {
      const int t = item * 32 + sub + 2 * (g * 4 + j);
      const int tt = t & (TSEQ - 1), b = t >> 13;
      const float r = rr[j], k = kk4[j], v = vv4[j];
      float wv = w0, av = a0;
      const float* lo = lora + (w * 4 + j) * 64;
#pragma unroll
      for (int jj = 0; jj < 32; ++jj) { wv += lo[jj] * wup[jj]; av += lo[32 + jj] * aup[jj]; }
      const float wlog = -softplusf_(-wv) - 0.5f;
      const float decay = __expf(-__expf(wlog));
      const float ar = sigmoidf_(av);
      const float kk = k * kkw;
      const float n2 = wave_sum(kk * kk, lane);
      const float kkn = kk / fmaxf(sqrtf(n2), 1e-12f);
      const float kmod = k * (1.0f + (ar - 1.0f) * kaw);
      const float rk = wave_sum(r * kmod * rkw, lane);
      const size_t idx = (size_t)(b * 4 + head) * TSEQ + tt;
      PW[idx * 64 + lane] = decay;
      bf16_t* pv = PV + idx * 320;
      pv[lane] = f2bf(r); pv[64 + lane] = f2bf(kmod); pv[128 + lane] = f2bf(v); pv[192 + lane] = f2bf(-kkn); pv[256 + lane] = f2bf(kkn * ar);
      if (lane == 0) RK[idx] = rk;
    }
    __builtin_amdgcn_s_waitcnt(0xc07f);
    __builtin_amdgcn_wave_barrier();
  }
#undef PREP_LOAD
  __syncthreads();
}

#define RW_TILE_B (RW_TT * 1536)
struct RwRegs { float4 pw; uint4 pv0, pv1; };
__device__ __forceinline__ void rw_issue(const float* __restrict__ PW, const bf16_t* __restrict__ PV, size_t idx0, int tid, RwRegs& r) {
  if (tid < RW_TT * 16) { const int s = tid >> 4, q = tid & 15; r.pw = *(const float4*)(PW + (idx0 + s) * 64 + q * 4); }
  { const int c = tid; const int s = c / 40, q = c % 40; r.pv0 = *(const uint4*)(PV + (idx0 + s) * 320 + q * 8); }
  if (tid < RW_TT * 40 - NTHR) { const int c = tid + NTHR; const int s = c / 40, q = c % 40; r.pv1 = *(const uint4*)(PV + (idx0 + s) * 320 + q * 8); }
}
__device__ __forceinline__ void rw_put(float* dst, int c, const uint4 u) {
  const int s = c / 40, q = c % 40;
  const int vec = q >> 3, off = (q & 7) * 8;
  const int slot = vec == 0 ? 4 : vec == 1 ? 3 : vec == 2 ? 5 : vec == 3 ? 1 : 2;
  float* d = dst + s * 384 + slot * 64 + off;
  *(float4*)d = make_float4(__uint_as_float(u.x << 16), __uint_as_float(u.x & 0xffff0000u), __uint_as_float(u.y << 16), __uint_as_float(u.y & 0xffff0000u));
  *(float4*)(d + 4) = make_float4(__uint_as_float(u.z << 16), __uint_as_float(u.z & 0xffff0000u), __uint_as_float(u.w << 16), __uint_as_float(u.w & 0xffff0000u));
}
__device__ __forceinline__ void rw_commit(unsigned char* dstb, int tid, const RwRegs& r) {
  float* dst = (float*)dstb;
  if (tid < RW_TT * 16) { const int s = tid >> 4, q = tid & 15; *(float4*)(dst + s * 384 + q * 4) = r.pw; }
  rw_put(dst, tid, r.pv0);
  if (tid < RW_TT * 40 - NTHR) rw_put(dst, tid + NTHR, r.pv1);
}

#define LD8(dst, ptr) { const float4 x0_ = *(const float4*)(ptr), x1_ = *(const float4*)((ptr) + 4); dst[0] = (f32x2){x0_.x, x0_.y}; dst[1] = (f32x2){x0_.z, x0_.w}; dst[2] = (f32x2){x1_.x, x1_.y}; dst[3] = (f32x2){x1_.z, x1_.w}; }
struct RwOps { f32x2 w[4], a[4], b[4], k[4], r[4]; float vA, vB; };
template <int MODE>
__device__ __forceinline__ void rw_ldops(RwOps& o, const float* tb, int s, int q, int rowA, int rowB) {
  const float* sp = tb + s * 384 + q * 8;
  LD8(o.w, sp); LD8(o.a, sp + 64); LD8(o.b, sp + 128); LD8(o.k, sp + 192);
  o.vA = tb[s * 384 + 320 + rowA];
  if (MODE == 0) { LD8(o.r, sp + 256); o.vB = tb[s * 384 + 320 + rowB]; }
}
template <int MODE>
__device__ __forceinline__ void rw_step(const RwOps& o, f32x2 (&SA)[4], f32x2 (&SB)[4], float* yb, int s, int q, int rowA, int rowB) {
  f32x2 dA = SA[0] * o.a[0], dB = SB[0] * o.a[0];
#pragma unroll
  for (int e = 1; e < 4; ++e) { dA = SA[e] * o.a[e] + dA; dB = SB[e] * o.a[e] + dB; }
  const float dotA = red8(dA.x + dA.y), dotB = red8(dB.x + dB.y);
  const f32x2 dA2 = {dotA, dotA}, dB2 = {dotB, dotB}, vA2 = {o.vA, o.vA};
  if (MODE == 0) {
    const f32x2 vB2 = {o.vB, o.vB};
#pragma unroll
    for (int e = 0; e < 4; ++e) { SA[e] = SA[e] * o.w[e] + vA2 * o.k[e]; SA[e] = dA2 * o.b[e] + SA[e]; SB[e] = SB[e] * o.w[e] + vB2 * o.k[e]; SB[e] = dB2 * o.b[e] + SB[e]; }
    f32x2 yA = SA[0] * o.r[0], yB = SB[0] * o.r[0];
#pragma unroll
    for (int e = 1; e < 4; ++e) { yA = SA[e] * o.r[e] + yA; yB = SB[e] * o.r[e] + yB; }
    const float ya = red8(yA.x + yA.y), ybv = red8(yB.x + yB.y);
    if (q == 0) { yb[s * 64 + rowA] = ya; yb[s * 64 + rowB] = ybv; }
  } else {
#pragma unroll
    for (int e = 0; e < 4; ++e) { SA[e] = dA2 * o.b[e] + SA[e] * o.w[e]; SB[e] = SB[e] * o.w[e] + vA2 * o.k[e]; SB[e] = dB2 * o.b[e] + SB[e]; }
  }
}
template <int MODE>
__device__ __forceinline__ void rwkv_scan_item(KP P, int l, int bh, int chunk, unsigned char* lds, int wv_) {
  const float* PW = (const float*)(P->ws + WS_PW); const bf16_t* PV = (const bf16_t*)(P->ws + WS_PV); const float* RK = (const float*)(P->ws + WS_RK);
  float* PQ = (float*)(P->ws + WS_PQ);
  bf16_t* p = (bf16_t*)(P->ws + WS_P);
  const int tid = opaque_tid(wv_), lane = tid & 63, w = tid >> 6;
  const int q = lane & 7;
  const int rowA = (MODE == 0) ? ((w & 3) * 16 + (lane >> 3)) : (w * 8 + (lane >> 3));
  const int rowB = rowA + 8;
  const int b = bh >> 2, head = bh & 3;
  unsigned char* tile0 = lds;
  float* ybuf = (float*)(lds + 3 * RW_TILE_B);
  float* Sl = (float*)(lds + 3 * RW_TILE_B + 2 * RW_TT * 256);
  f32x2 SA[4], SB[4];
#pragma unroll
  for (int e = 0; e < 4; ++e) { SA[e] = (f32x2){0.f, 0.f}; SB[e] = (f32x2){0.f, 0.f}; }
  if (MODE == 1) {
#pragma unroll
    for (int e = 0; e < 4; ++e) SA[e] = (f32x2){(q * 8 + 2 * e == rowA) ? 1.f : 0.f, (q * 8 + 2 * e + 1 == rowA) ? 1.f : 0.f};
  }
  if (MODE == 0 && chunk > 0) {
    const float* Q0 = PQ + ((size_t)(bh * RW_C + 0) * 2 + 1) * 4096;
    float* cur = Sl; float* nxt = Sl + 4096;
    for (int i = tid; i < 1024; i += NTHR) *(float4*)(cur + i * 4) = *(const float4*)(Q0 + i * 4);
    float* Pl = (float*)lds;
    float4 pre0 = make_float4(0.f, 0.f, 0.f, 0.f), pre1 = pre0;
    f32x4 qn0 = {0.f, 0.f, 0.f, 0.f}, qn1 = qn0;
    if (chunk > 1) { const float* Pm = PQ + ((size_t)(bh * RW_C + 1) * 2 + 0) * 4096; pre0 = *(const float4*)(Pm + tid * 4); pre1 = *(const float4*)(Pm + (tid + NTHR) * 4);
#pragma unroll
      for (int r = 0; r < 4; ++r) { qn0[r] = Pm[4096 + ((w >> 1) * 16 + (lane >> 4) * 4 + r) * 64 + ((w & 1) * 2 + 0) * 16 + (lane & 15)]; qn1[r] = Pm[4096 + ((w >> 1) * 16 + (lane >> 4) * 4 + r) * 64 + ((w & 1) * 2 + 1) * 16 + (lane & 15)]; } }
    for (int cc = 1; cc < chunk; ++cc) {
      const float* Pm = PQ + ((size_t)(bh * RW_C + cc) * 2 + 0) * 4096;
      LBAR();
      *(float4*)(Pl + tid * 4) = pre0; *(float4*)(Pl + (tid + NTHR) * 4) = pre1;
      const int ti = w >> 1;
      const f32x4 qc0 = qn0, qc1 = qn1;
      if (cc + 1 < chunk) { const float* Pn = Pm + 8192; pre0 = *(const float4*)(Pn + tid * 4); pre1 = *(const float4*)(Pn + (tid + NTHR) * 4);
#pragma unroll
        for (int r = 0; r < 4; ++r) { qn0[r] = Pn[4096 + (ti * 16 + (lane >> 4) * 4 + r) * 64 + ((w & 1) * 2 + 0) * 16 + (lane & 15)]; qn1[r] = Pn[4096 + (ti * 16 + (lane >> 4) * 4 + r) * 64 + ((w & 1) * 2 + 1) * 16 + (lane & 15)]; } }
      LBAR();
#pragma unroll
      for (int jj = 0; jj < 2; ++jj) {
        const int tj = (w & 1) * 2 + jj;
        f32x4 acc = jj == 0 ? qc0 : qc1;
#pragma unroll
        for (int ks = 0; ks < 16; ++ks) {
          const float a = cur[(ti * 16 + (lane & 15)) * 64 + ks * 4 + (lane >> 4)];
          const float bb = Pl[(ks * 4 + (lane >> 4)) * 64 + tj * 16 + (lane & 15)];
          acc = __builtin_amdgcn_mfma_f32_16x16x4f32(a, bb, acc, 0, 0, 0);
        }
#pragma unroll
        for (int r = 0; r < 4; ++r) nxt[(ti * 16 + (lane >> 4) * 4 + r) * 64 + tj * 16 + (lane & 15)] = acc[r];
      }
      float* t_ = cur; cur = nxt; nxt = t_;
    }
    __syncthreads();
    LD8(SA, cur + rowA * 64 + q * 8);
    LD8(SB, cur + rowB * 64 + q * 8);
    __syncthreads();
  }
  const size_t idxb = (size_t)bh * TSEQ + (size_t)chunk * RW_CL;
  const int ntile = RW_CL / RW_TT;
  RwRegs rr;
  rw_issue(PW, PV, idxb, tid, rr);
  rw_commit(tile0, tid, rr);
  const int chh = head * 64 + lane;
  const float lng = P->in[12][l * 256 + chh], lnb = P->in[13][l * 256 + chh];
  __syncthreads();
  const int nit = (MODE == 0) ? ntile + 1 : ntile;
  for (int tl = 0; tl < nit; ++tl) {
    if (tl + 1 < ntile) rw_issue(PW, PV, idxb + (size_t)(tl + 1) * RW_TT, tid, rr);
    if (MODE == 1 || w < 4) {
      if (tl < ntile) {
        const float* tb = (const float*)(tile0 + (tl % 3) * RW_TILE_B);
        float* yb = ybuf + (tl & 1) * (RW_TT * 64);
        RwOps oa, ob;
        rw_ldops<MODE>(oa, tb, 0, q, rowA, rowB);
        __builtin_amdgcn_sched_barrier(0);
#pragma unroll 1
        for (int s = 0; s < RW_TT; s += 2) {
          rw_ldops<MODE>(ob, tb, s + 1, q, rowA, rowB);
          __builtin_amdgcn_sched_barrier(0);
          rw_step<MODE>(oa, SA, SB, yb, s, q, rowA, rowB);
          __builtin_amdgcn_sched_barrier(0);
          if (s + 2 < RW_TT) rw_ldops<MODE>(oa, tb, s + 2, q, rowA, rowB);
          __builtin_amdgcn_sched_barrier(0);
          rw_step<MODE>(ob, SA, SB, yb, s + 1, q, rowA, rowB);
          __builtin_amdgcn_sched_barrier(0);
        }
      }
      if (tl + 1 < ntile) rw_commit(tile0 + ((tl + 1) % 3) * RW_TILE_B, tid, rr);
    } else {
      const int fw = w - 4;
      f32x4 gcu = {0.f, 0.f, 0.f, 0.f}, rkcu = {0.f, 0.f, 0.f, 0.f};
      if (tl > 0) {
#pragma unroll
        for (int u = 0; u < 4; ++u) { const int tt = chunk * RW_CL + (tl - 1) * RW_TT + fw + 4 * u;
          gcu[u] = bf2f(p[(size_t)(b * TSEQ + tt) * NIN + C_GA + chh]); rkcu[u] = RK[(size_t)bh * TSEQ + tt]; }
      }
      asm volatile("s_waitcnt vmcnt(0)" ::: "memory");
      if (tl + 1 < ntile) rw_commit(tile0 + ((tl + 1) % 3) * RW_TILE_B, tid, rr);
      __builtin_amdgcn_sched_barrier(0);
      if (tl > 0) {
        const float* tb = (const float*)(tile0 + ((tl - 1) % 3) * RW_TILE_B);
        const float* yb = ybuf + ((tl - 1) & 1) * (RW_TT * 64);
#pragma unroll
        for (int u = 0; u < 4; ++u) {
          const int s = fw + 4 * u;
          const int tt = chunk * RW_CL + (tl - 1) * RW_TT + s;
          const float y = yb[s * 64 + lane];
          const float mean = wave_sum(y, lane) * (1.0f / 64.0f);
          const float dlt = y - mean;
          const float var = wave_sum(dlt * dlt, lane) * (1.0f / 64.0f);
          float o = dlt * rsqrtf(var + 64e-5f) * lng + lnb;
          const float vv = tb[s * 384 + 320 + lane];
          o += rkcu[u] * vv;
          p[(size_t)(b * TSEQ + tt) * NIN + C_GA + chh] = f2bf(o * siluf_(gcu[u]));
        }
      }
    }
    LBAR();
  }
  if (MODE == 1) {
    float* Pm = PQ + ((size_t)(bh * RW_C + chunk) * 2 + 0) * 4096 + rowA * 64 + q * 8;
    *(float4*)Pm = make_float4(SA[0].x, SA[0].y, SA[1].x, SA[1].y); *(float4*)(Pm + 4) = make_float4(SA[2].x, SA[2].y, SA[3].x, SA[3].y);
    *(float4*)(Pm + 4096) = make_float4(SB[0].x, SB[0].y, SB[1].x, SB[1].y); *(float4*)(Pm + 4100) = make_float4(SB[2].x, SB[2].y, SB[3].x, SB[3].y);
  } else if (chunk == 0 && w < 4) {
    float* Qm = PQ + ((size_t)(bh * RW_C + 0) * 2 + 1) * 4096 + q * 8;
    *(float4*)(Qm + rowA * 64) = make_float4(SA[0].x, SA[0].y, SA[1].x, SA[1].y); *(float4*)(Qm + rowA * 64 + 4) = make_float4(SA[2].x, SA[2].y, SA[3].x, SA[3].y);
    *(float4*)(Qm + rowB * 64) = make_float4(SB[0].x, SB[0].y, SB[1].x, SB[1].y); *(float4*)(Qm + rowB * 64 + 4) = make_float4(SB[2].x, SB[2].y, SB[3].x, SB[3].y);
  }
  __syncthreads();
}

__device__ __forceinline__ void conv_item(KP P, int l, int item, unsigned char* lds, int wv_) {
#ifdef OFF_conv_item
  return;
#endif

  bf16_t* p = (bf16_t*)(P->ws + WS_P);
  float* u = (float*)lds;
  float* yb = (float*)(lds + 62 * 1024);
  const int tid = opaque_tid(wv_), c = tid & 255, half = tid >> 8;
  const int t0 = item * 32, tt0 = t0 & (TSEQ - 1);
  {
    bf16_t rv[31], rg[31];
#pragma unroll
    for (int i = 0; i < 31; ++i) { const int r = half + 2 * i; const bool ok = (tt0 - 30 + r) >= 0; const bf16_t* pr = p + (size_t)(t0 - 30 + r) * NIN;
      rv[i] = ok ? pr[C_CVAL + c] : (bf16_t)0; rg[i] = ok ? pr[C_CGLU + c] : (bf16_t)0; }
#pragma unroll
    for (int i = 0; i < 31; ++i) u[(half + 2 * i) * 256 + c] = bf2f(rv[i]) * sigmoidf_(bf2f(rg[i]));
  }
  float wv[31];
#pragma unroll
  for (int j = 0; j < 31; ++j) wv[j] = P->in[14][(l * 31 + j) * 256 + c];
  const float bias = P->in[15][l * 256 + c];
  __syncthreads();
  {
    float win[46];
#pragma unroll
    for (int i = 0; i < 46; ++i) win[i] = u[(half * 16 + i) * 256 + c];
#pragma unroll
    for (int i = 0; i < 16; ++i) {
      float acc = bias;
#pragma unroll
      for (int j = 0; j < 31; ++j) acc = fmaf(wv[j], win[i + j], acc);
      yb[(half * 16 + i) * 256 + c] = acc;
    }
  }
  __syncthreads();
  const int lane = tid & 63, w = tid >> 6;
  const float4 g = *(const float4*)(P->in[16] + l * 256 + lane * 4), bb = *(const float4*)(P->in[17] + l * 256 + lane * 4);
  uint2 gpre[4];
#pragma unroll
  for (int i = 0; i < 4; ++i) gpre[i] = *(const uint2*)(p + (size_t)(t0 + w * 4 + i) * NIN + C_CGATE + lane * 4);
#pragma unroll
  for (int i = 0; i < 4; ++i) {
    const int tk = w * 4 + i;
    const float4 v = *(const float4*)(yb + tk * 256 + lane * 4);
    const float mean = wave_sum(v.x + v.y + v.z + v.w, lane) * (1.0f / 256.0f);
    const float d0 = v.x - mean, d1 = v.y - mean, d2 = v.z - mean, d3 = v.w - mean;
    const float var = wave_sum(d0 * d0 + d1 * d1 + d2 * d2 + d3 * d3, lane) * (1.0f / 256.0f);
    const float rs = rsqrtf(var + 1e-5f);
    bf16_t* gp = p + (size_t)(t0 + tk) * NIN + C_CGATE + lane * 4;
    const uint2 gu = gpre[i];
    const float o0 = siluf_(d0 * rs * g.x + bb.x) * siluf_(__uint_as_float(gu.x << 16));
    const float o1 = siluf_(d1 * rs * g.y + bb.y) * siluf_(__uint_as_float(gu.x & 0xffff0000u));
    const float o2 = siluf_(d2 * rs * g.z + bb.z) * siluf_(__uint_as_float(gu.y << 16));
    const float o3 = siluf_(d3 * rs * g.w + bb.w) * siluf_(__uint_as_float(gu.y & 0xffff0000u));
    uint2 o; o.x = pack2(o0, o1); o.y = pack2(o2, o3);
    *(uint2*)gp = o;
  }
  __syncthreads();
}

#define HG_WLDS 10240
__device__ __forceinline__ float hgrn_lb(KP P, int l, int ch) {
  if (l == 0) return 0.f;
  const float x0 = P->in[18][ch], x1 = P->in[18][256 + ch];
  return __builtin_amdgcn_rcpf(1.0f + __expf(x0 - x1));
}
template <int PASS>
__device__ __forceinline__ void hgrn_wave_item(KP P, int l, int wi, unsigned char* lds, int wv_) {
#ifdef OFF_hgrn_wave_item
  return;
#endif

  bf16_t* p = (bf16_t*)(P->ws + WS_P);
  float* HS = (float*)(P->ws + WS_HS); float* HF = (float*)(P->ws + WS_HF);
  const int tid = opaque_tid(wv_);
  const int lane = tid & 63, w = tid >> 6;
  const int bh = wi >> 7, chunk = wi & 127, b = bh >> 2, head = bh & 3;
  float* st = (float*)(lds + w * HG_WLDS);
  float* ob = st + 2048;
  const int kg = lane & 7, vg = lane >> 3;
  const int ch = head * 64 + lane;
  const float lb = hgrn_lb(P, l, ch);
  const float ng = P->in[19][l * 256 + ch];
  float S[8][8];
  float* slot = HS + (size_t)(bh * 128 + chunk) * 4096;
  if (PASS == 1) {
#pragma unroll
    for (int i = 0; i < 8; ++i) { const float4 x0 = *(const float4*)(slot + (kg * 8 + i) * 64 + vg * 8), x1 = *(const float4*)(slot + (kg * 8 + i) * 64 + vg * 8 + 4);
      S[i][0] = x0.x; S[i][1] = x0.y; S[i][2] = x0.z; S[i][3] = x0.w; S[i][4] = x1.x; S[i][5] = x1.y; S[i][6] = x1.z; S[i][7] = x1.w; }
  } else {
#pragma unroll
    for (int i = 0; i < 8; ++i)
#pragma unroll
      for (int j = 0; j < 8; ++j) S[i][j] = 0.f;
  }
  float Fp = 1.f;
  bf16_t rf[8], ri[8], rq[8], rg[8];
  {
    const int tb0 = b * TSEQ + chunk * 64;
#pragma unroll
    for (int s = 0; s < 8; ++s) { const bf16_t* pr = p + (size_t)(tb0 + s) * NIN; rf[s] = pr[C_HF + ch]; ri[s] = pr[C_HI + ch]; if (PASS == 1) { rq[s] = pr[C_HQ + ch]; rg[s] = pr[C_HG + ch]; } }
  }
#pragma unroll 1
  for (int sub = 0; sub < 8; ++sub) {
    const int tbase = b * TSEQ + chunk * 64 + sub * 8;
    bf16_t gc[8];
#pragma unroll
    for (int s = 0; s < 8; ++s) {
      const float f = lb + (1.0f - lb) * sigmoidf_(bf2f(rf[s]));
      Fp *= f;
      st[s * 256 + lane] = f; st[s * 256 + 64 + lane] = 1.0f - f;
      if (PASS == 1) { st[s * 256 + 128 + lane] = siluf_(bf2f(rq[s])); gc[s] = rg[s]; }
      st[s * 256 + 192 + lane] = bf2f(ri[s]);
    }
    if (sub < 7) {
#pragma unroll
      for (int s = 0; s < 8; ++s) { const bf16_t* pr = p + (size_t)(tbase + 8 + s) * NIN; rf[s] = pr[C_HF + ch]; ri[s] = pr[C_HI + ch]; if (PASS == 1) { rq[s] = pr[C_HQ + ch]; rg[s] = pr[C_HG + ch]; } }
    }
    __builtin_amdgcn_s_waitcnt(0xc07f);
    __builtin_amdgcn_wave_barrier();
#pragma unroll 1
    for (int s = 0; s < 8; ++s) {
      const float* sp = st + s * 256;
      const float4 f0 = *(const float4*)(sp + kg * 8), f1 = *(const float4*)(sp + kg * 8 + 4);
      const float4 k0 = *(const float4*)(sp + 64 + kg * 8), k1 = *(const float4*)(sp + 64 + kg * 8 + 4);
      const float4 v0 = *(const float4*)(sp + 192 + vg * 8), v1 = *(const float4*)(sp + 192 + vg * 8 + 4);
      const float fv[8] = {f0.x, f0.y, f0.z, f0.w, f1.x, f1.y, f1.z, f1.w};
      const float kv[8] = {k0.x, k0.y, k0.z, k0.w, k1.x, k1.y, k1.z, k1.w};
      const float vv[8] = {v0.x, v0.y, v0.z, v0.w, v1.x, v1.y, v1.z, v1.w};
#pragma unroll
      for (int i = 0; i < 8; ++i)
#pragma unroll
        for (int j = 0; j < 8; ++j) S[i][j] = fmaf(fv[i], S[i][j], kv[i] * vv[j]);
      if (PASS == 1) {
        const float4 q0 = *(const float4*)(sp + 128 + kg * 8), q1 = *(const float4*)(sp + 128 + kg * 8 + 4);
        const float qv[8] = {q0.x, q0.y, q0.z, q0.w, q1.x, q1.y, q1.z, q1.w};
        float o[8];
#pragma unroll
        for (int j = 0; j < 8; ++j) { float a = qv[0] * S[0][j];
#pragma unroll
          for (int i = 1; i < 8; ++i) a = fmaf(qv[i], S[i][j], a);
          o[j] = red8(a); }
        if (kg == 0) { *(float4*)(ob + s * 64 + vg * 8) = make_float4(o[0], o[1], o[2], o[3]); *(float4*)(ob + s * 64 + vg * 8 + 4) = make_float4(o[4], o[5], o[6], o[7]); }
      }
    }
    __builtin_amdgcn_s_waitcnt(0xc07f);
    __builtin_amdgcn_wave_barrier();
    if (PASS == 1) {
#pragma unroll
      for (int s = 0; s < 8; ++s) {
        const float o = ob[s * 64 + lane];
        const float ms = wave_sum(o * o, lane) * (1.0f / 64.0f);
        p[(size_t)(tbase + s) * NIN + C_HG + ch] = f2bf(o * rsqrtf(ms + 1e-6f) * ng * siluf_(bf2f(gc[s])));
      }
      __builtin_amdgcn_s_waitcnt(0xc07f);
      __builtin_amdgcn_wave_barrier();
    }
  }
  if (PASS == 0) {
#pragma unroll
    for (int i = 0; i < 8; ++i) { *(float4*)(slot + (kg * 8 + i) * 64 + vg * 8) = make_float4(S[i][0], S[i][1], S[i][2], S[i][3]);
      *(float4*)(slot + (kg * 8 + i) * 64 + vg * 8 + 4) = make_float4(S[i][4], S[i][5], S[i][6], S[i][7]); }
    HF[(size_t)(bh * 128 + chunk) * 64 + lane] = Fp;
  }
}
__device__ __forceinline__ void hgrn_combine_item(KP P, int bh, int wv_) {
#ifdef OFF_hgrn_combine_item
  return;
#endif

  float* HS = (float*)(P->ws + WS_HS); const float* HF = (const float*)(P->ws + WS_HF);
  const int tid = opaque_tid(wv_);
  const int krow = tid >> 3;
  float R[8];
#pragma unroll
  for (int e = 0; e < 8; ++e) R[e] = 0.f;
  float4 xa[8][2]; float fa[8];
#pragma unroll
  for (int u = 0; u < 8; ++u) { const float* sl = HS + (size_t)(bh * 128 + u) * 4096 + tid * 8; xa[u][0] = *(const float4*)sl; xa[u][1] = *(const float4*)(sl + 4); fa[u] = HF[(size_t)(bh * 128 + u) * 64 + krow]; }
#pragma unroll 1
  for (int c0 = 0; c0 < 128; c0 += 8) {
    float4 xn[8][2]; float fn[8];
    if (c0 + 8 < 128) {
#pragma unroll
      for (int u = 0; u < 8; ++u) { const float* sl = HS + (size_t)(bh * 128 + c0 + 8 + u) * 4096 + tid * 8; xn[u][0] = *(const float4*)sl; xn[u][1] = *(const float4*)(sl + 4); fn[u] = HF[(size_t)(bh * 128 + c0 + 8 + u) * 64 + krow]; }
    }
#pragma unroll
    for (int u = 0; u < 8; ++u) {
      float* sl = HS + (size_t)(bh * 128 + c0 + u) * 4096 + tid * 8;
      *(float4*)sl = make_float4(R[0], R[1], R[2], R[3]); *(float4*)(sl + 4) = make_float4(R[4], R[5], R[6], R[7]);
      const float f = fa[u];
      R[0] = fmaf(f, R[0], xa[u][0].x); R[1] = fmaf(f, R[1], xa[u][0].y); R[2] = fmaf(f, R[2], xa[u][0].z); R[3] = fmaf(f, R[3], xa[u][0].w);
      R[4] = fmaf(f, R[4], xa[u][1].x); R[5] = fmaf(f, R[5], xa[u][1].y); R[6] = fmaf(f, R[6], xa[u][1].z); R[7] = fmaf(f, R[7], xa[u][1].w);
    }
    if (c0 + 8 < 128) {
#pragma unroll
      for (int u = 0; u < 8; ++u) { xa[u][0] = xn[u][0]; xa[u][1] = xn[u][1]; fa[u] = fn[u]; }
    }
  }
}

__device__ __forceinline__ void sb_item(KP P, int item, unsigned char* lds, int wv_) {
#ifdef OFF_sb_item
  return;
#endif

  bf16_t* p = (bf16_t*)(P->ws + WS_P);
  const int tid = opaque_tid(wv_), lane = tid & 63, w = tid >> 6;
  const int qt = item & 127, bh = item >> 7, b = bh >> 2, head = bh & 3;
  unsigned char* Qs = lds;
  unsigned char* Ks = lds + 9216;
  unsigned char* Vt = lds + 18432;
  unsigned char* As = lds + 27648;
  float* Zs = (float*)(lds + 36864);
  volatile int* flag = (volatile int*)(lds + 36864 + 64 * 65 * 4);
  const int lrow = tid >> 3, lch = (tid & 7);
  const size_t tokq = (size_t)b * TSEQ + qt * 64;
  *(uint4*)(Qs + lrow * 144 + lch * 16) = *(const uint4*)(p + (tokq + lrow) * NIN + C_SQ + head * 64 + lch * 8);
  float carry = 0.f;
  f32x4 oacc[2] = {{0.f, 0.f, 0.f, 0.f}, {0.f, 0.f, 0.f, 0.f}};
  const int qi = w >> 1, t2 = (w & 1) * 2;
  const int q = tid >> 3, seg = tid & 7;
  uint4 kreg = *(const uint4*)(p + (tokq + lrow) * NIN + C_SK + head * 64 + lch * 8);
  uint4 vreg = *(const uint4*)(p + (tokq + lrow) * NIN + C_SV + head * 64 + lch * 8);
  for (int kt = qt; kt >= 0; --kt) {
    LBAR();
    *(uint4*)(Ks + lrow * 144 + lch * 16) = kreg;
    { const unsigned vw[4] = {vreg.x, vreg.y, vreg.z, vreg.w};
#pragma unroll
      for (int e = 0; e < 8; ++e) *(unsigned short*)(Vt + (lch * 8 + e) * 144 + lrow * 2) = (unsigned short)((e & 1) ? (vw[e >> 1] >> 16) : (vw[e >> 1] & 0xffffu)); }
    if (tid == 0) *flag = 0;
    if (kt > 0) { const size_t tokn = (size_t)b * TSEQ + (kt - 1) * 64;
      kreg = *(const uint4*)(p + (tokn + lrow) * NIN + C_SK + head * 64 + lch * 8);
      vreg = *(const uint4*)(p + (tokn + lrow) * NIN + C_SV + head * 64 + lch * 8); }
    LBAR();
#pragma unroll
    for (int jj = 0; jj < 2; ++jj) {
      const int ki = t2 + jj;
      f32x4 acc = {0.f, 0.f, 0.f, 0.f};
#pragma unroll
      for (int s = 0; s < 2; ++s) {
        const bf16x8 a = *(const bf16x8*)(Qs + (qi * 16 + (lane & 15)) * 144 + s * 64 + (lane >> 4) * 16);
        const bf16x8 bb = *(const bf16x8*)(Ks + (ki * 16 + (lane & 15)) * 144 + s * 64 + (lane >> 4) * 16);
        acc = __builtin_amdgcn_mfma_f32_16x16x32_bf16(a, bb, acc, 0, 0, 0);
      }
#pragma unroll
      for (int r = 0; r < 4; ++r) Zs[(qi * 16 + (lane >> 4) * 4 + r) * 65 + ki * 16 + (lane & 15)] = acc[r] * 0.125f;
    }
    LBAR();
    {
      const int tq = qt * 64 + q;
      float z[8], lk[8];
      float tot = 0.f;
#pragma unroll
      for (int e = 0; e < 8; ++e) {
        z[e] = Zs[q * 65 + seg * 8 + e];
        const bool m = (kt * 64 + seg * 8 + e) < tq;
        lk[e] = m ? -softplus_fast(z[e]) : 0.f;
        tot += lk[e];
      }
      float inc = tot;
      { float t_ = bperm(inc, lane + 1); if (seg + 1 < 8) inc += t_; }
      { float t_ = bperm(inc, lane + 2); if (seg + 2 < 8) inc += t_; }
      { float t_ = bperm(inc, lane + 4); if (seg + 4 < 8) inc += t_; }
      const float rowtot = bperm(inc, lane & ~7);
      float tail = carry + (inc - tot);
      float av[8];
#pragma unroll
      for (int e = 7; e >= 0; --e) {
        const bool m = (kt * 64 + seg * 8 + e) < tq;
        av[e] = m ? __expf(z[e] + lk[e] + tail) : 0.f;
        tail += lk[e];
      }
      uint4 o; o.x = pack2(av[0], av[1]); o.y = pack2(av[2], av[3]); o.z = pack2(av[4], av[5]); o.w = pack2(av[6], av[7]);
      *(uint4*)(As + q * 144 + seg * 16) = o;
      carry += rowtot;
      if (carry > -100.f) *flag = 1;
    }
    LBAR();
#pragma unroll
    for (int jj = 0; jj < 2; ++jj) {
      const int di = t2 + jj;
#pragma unroll
      for (int s = 0; s < 2; ++s) {
        const bf16x8 a = *(const bf16x8*)(As + (qi * 16 + (lane & 15)) * 144 + s * 64 + (lane >> 4) * 16);
        const bf16x8 bb = *(const bf16x8*)(Vt + (di * 16 + (lane & 15)) * 144 + s * 64 + (lane >> 4) * 16);
        oacc[jj] = __builtin_amdgcn_mfma_f32_16x16x32_bf16(a, bb, oacc[jj], 0, 0, 0);
      }
    }
    if (*flag == 0) break;
  }
#pragma unroll
  for (int jj = 0; jj < 2; ++jj) {
    const int d = (t2 + jj) * 16 + (lane & 15);
#pragma unroll
    for (int r = 0; r < 4; ++r) {
      const int qq = qi * 16 + (lane >> 4) * 4 + r;
      bf16_t* gp = p + (tokq + qq) * NIN + C_SG + head * 64 + d;
      *gp = f2bf(oacc[jj][r] * siluf_(bf2f(*gp)));
    }
  }
  __syncthreads();
}

__device__ __forceinline__ void xattn_item(KP P, int l, int item, unsigned char* lds, int wv_) {
#ifdef OFF_xattn_item
  return;
#endif

  const bf16_t* qb = (const bf16_t*)(P->ws + WS_P + 32ull * MiB);
  bf16_t* ob = (bf16_t*)(P->ws + WS_P + 64ull * MiB);
  const bf16_t* kv = (const bf16_t*)(P->ws + WS_KV) + (size_t)l * 512 * 2048;
  const int tid = opaque_tid(wv_), lane = tid & 63, w = tid >> 6;
  const int qt = item & 127, bh = item >> 7, b = bh >> 2, head = bh & 3;
  unsigned char* Qs = lds;
  unsigned char* KVs = lds + 33792;
  float* Ss = (float*)(lds + 67584);
  const size_t tok0 = (size_t)b * TSEQ + qt * 64;
  __syncthreads();
#pragma unroll
  for (int i = 0; i < 4; ++i) { const int c = tid + i * NTHR, r = c >> 5, cc = c & 31;
    *(uint4*)(Qs + r * 528 + cc * 16) = *(const uint4*)(qb + (tok0 + r) * 1024 + head * 256 + cc * 8); }
  const int qi = w >> 1, t2 = (w & 1) * 2;
  for (int kb = 0; kb < 4; ++kb) {
    __syncthreads();
#pragma unroll
    for (int i = 0; i < 4; ++i) { const int c = tid + i * NTHR, r = c >> 5, cc = c & 31;
      *(uint4*)(KVs + r * 528 + cc * 16) = *(const uint4*)(kv + (size_t)(b * 256 + kb * 64 + r) * 2048 + head * 256 + cc * 8); }
    __syncthreads();
#pragma unroll
    for (int jj = 0; jj < 2; ++jj) {
      const int ki = t2 + jj;
      f32x4 acc = {0.f, 0.f, 0.f, 0.f};
#pragma unroll
      for (int s = 0; s < 8; ++s) {
        const bf16x8 a = *(const bf16x8*)(Qs + (qi * 16 + (lane & 15)) * 528 + s * 64 + (lane >> 4) * 16);
        const bf16x8 bb = *(const bf16x8*)(KVs + (ki * 16 + (lane & 15)) * 528 + s * 64 + (lane >> 4) * 16);
        acc = __builtin_amdgcn_mfma_f32_16x16x32_bf16(a, bb, acc, 0, 0, 0);
      }
#pragma unroll
      for (int r = 0; r < 4; ++r) Ss[(qi * 16 + (lane >> 4) * 4 + r) * 260 + kb * 64 + ki * 16 + (lane & 15)] = acc[r] * 0.0625f;
    }
  }
  __syncthreads();
  {
    const int q = tid >> 3, seg = tid & 7;
    float x[32]; float mx = -3.0e38f;
#pragma unroll
    for (int i = 0; i < 8; ++i) { const float4 v = *(const float4*)(Ss + q * 260 + seg * 32 + i * 4); x[i * 4] = v.x; x[i * 4 + 1] = v.y; x[i * 4 + 2] = v.z; x[i * 4 + 3] = v.w;
      mx = fmaxf(mx, fmaxf(fmaxf(v.x, v.y), fmaxf(v.z, v.w))); }
    mx = max8(mx);
    float sum = 0.f;
#pragma unroll
    for (int i = 0; i < 32; ++i) { x[i] = __expf(x[i] - mx); sum += x[i]; }
    sum = red8(sum);
    const float inv = __builtin_amdgcn_rcpf(sum);
#pragma unroll
    for (int i = 0; i < 4; ++i) { uint4 o; o.x = pack2(x[i * 8] * inv, x[i * 8 + 1] * inv); o.y = pack2(x[i * 8 + 2] * inv, x[i * 8 + 3] * inv);
      o.z = pack2(x[i * 8 + 4] * inv, x[i * 8 + 5] * inv); o.w = pack2(x[i * 8 + 6] * inv, x[i * 8 + 7] * inv);
      *(uint4*)(Qs + q * 528 + seg * 64 + i * 16) = o; }
  }
  for (int db = 0; db < 4; ++db) {
    __syncthreads();
#pragma unroll
    for (int i = 0; i < 4; ++i) { const int c = tid + i * NTHR, m = c >> 3, dc = c & 7;
      const uint4 vv = *(const uint4*)(kv + (size_t)(b * 256 + m) * 2048 + 1024 + head * 256 + db * 64 + dc * 8);
      const unsigned short* ve = (const unsigned short*)&vv;
#pragma unroll
      for (int e = 0; e < 8; ++e) *(unsigned short*)(KVs + (dc * 8 + e) * 528 + m * 2) = ve[e]; }
    __syncthreads();
#pragma unroll
    for (int jj = 0; jj < 2; ++jj) {
      const int di = t2 + jj;
      f32x4 acc = {0.f, 0.f, 0.f, 0.f};
#pragma unroll
      for (int s = 0; s < 8; ++s) {
        const bf16x8 a = *(const bf16x8*)(Qs + (qi * 16 + (lane & 15)) * 528 + s * 64 + (lane >> 4) * 16);
        const bf16x8 bb = *(const bf16x8*)(KVs + (di * 16 + (lane & 15)) * 528 + s * 64 + (lane >> 4) * 16);
        acc = __builtin_amdgcn_mfma_f32_16x16x32_bf16(a, bb, acc, 0, 0, 0);
      }
#pragma unroll
      for (int r = 0; r < 4; ++r) ob[(tok0 + qi * 16 + (lane >> 4) * 4 + r) * 1024 + head * 256 + db * 64 + di * 16 + (lane & 15)] = f2bf(acc[r]);
    }
  }
  __syncthreads();
}

__device__ __forceinline__ int next_item(unsigned* ctr, volatile LAS int* slot, int wv_) {
  __syncthreads();
  if (opaque_tid(wv_) == 0) *slot = (int)__hip_atomic_fetch_add(ctr, 1u, __ATOMIC_RELAXED, __HIP_MEMORY_SCOPE_AGENT);
  __syncthreads();
  return *slot;
}
__global__ void __launch_bounds__(NTHR) fwd_megakernel(Params Pk_unused) {
  KP P = (KP)__builtin_amdgcn_kernarg_segment_ptr();
  extern __shared__ __attribute__((aligned(16))) unsigned char lds[];
  const int wv_ = __builtin_amdgcn_readfirstlane((int)threadIdx.x >> 6);
  __shared__ uint4 xb_words;
  __shared__ int4 wq_slot;
  if (opaque_tid(wv_) == 0) xb_words = make_uint4(0u, 0u, 0u, 0u);
  __syncthreads();
#ifdef PROBE_J
  __shared__ unsigned long long tacc[32];
  __shared__ unsigned long long tlast;
  __shared__ float pdelta;
  if (opaque_tid(wv_) == 0) { for (int i = 0; i < 32; ++i) tacc[i] = 0ull; tlast = __builtin_amdgcn_s_memrealtime(); pdelta = 0.f; }
#define STAMP(k) if (opaque_tid(wv_) == 0) { const unsigned long long n_ = __builtin_amdgcn_s_memrealtime(); tacc[k] += n_ - tlast; tlast = n_; }
#else
#define STAMP(k)
#endif
  XcdBarrier bar = xcd_barrier_post((unsigned*)(P->ws + WS_BAR), (volatile LAS unsigned*)&xb_words, wv_);
  if (P->never) cg::this_grid().sync();
  const int G = gridDim.x, bid0 = blockIdx.x;

  for (int it = bid0; it < 2 * 2256; it += G) {
    const int l = it / 2256; int r = it % 2256;
    const float* W; int N; bf16_t* Wt; int kt, nt;
    unsigned char* wl = P->ws + WS_WT + l * WT_LAYER;
    if (r < 976) { W = P->in[3] + (size_t)l * 1024 * NIN; N = NIN; Wt = (bf16_t*)(wl + WT_IN); kt = r / 61; nt = r % 61; }
    else { r -= 976; const int m = r >> 8; r &= 255; kt = r >> 4; nt = r & 15; N = 1024;
      if (m == 0) { W = P->in[20] + (size_t)l * 1048576; Wt = (bf16_t*)(wl + WT_OUT); }
      else if (m == 1) { W = P->in[23] + (size_t)l * 1048576; Wt = (bf16_t*)(wl + WT_Q); }
      else if (m == 2) { W = P->in[24] + (size_t)l * 1048576; Wt = (bf16_t*)(wl + WT_KV); }
      else if (m == 3) { W = P->in[25] + (size_t)l * 1048576; Wt = (bf16_t*)(wl + WT_KV) + 1024 * 1024; }
      else { W = P->in[26] + (size_t)l * 1048576; Wt = (bf16_t*)(wl + WT_O); } }
    wt_tile(W, N, Wt, kt, nt, lds, wv_);
  }
#pragma unroll 1
  for (int k = 0; k < 3; ++k) {
    const float* s_ = k < 2 ? P->in[1] : P->in[0];
    const float* g_ = k < 2 ? P->in[22] + k * 1024 : P->in[2];
    bf16_t* d_ = k < 2 ? (bf16_t*)(P->ws + WS_MEMN) + k * 512 * 1024 : (bf16_t*)(P->ws + WS_R1);
    norm_rows(false, s_, g_, d_, k < 2 ? 512 : NT, 0.f, wv_);
  }
  STAMP(16 + 10); xcd_barrier(bar, wv_); STAMP(10)
  asm volatile("" : "+s"(P));

#pragma unroll 1
  for (int it = 0; it < 20; ++it) {
    int l = it / 10, ph = it % 10;
    asm volatile("" : "+s"(P));
    int bid = bid0; asm volatile("" : "+s"(bid));

    unsigned char* ws = P->ws;
    const unsigned char* wl = ws + WS_WT + l * WT_LAYER;
    bf16_t* hbuf = (bf16_t*)(ws + WS_R1);
    bf16_t* pbuf = (bf16_t*)(ws + WS_P);
    bf16_t* hx = (bf16_t*)(ws + WS_P);
    bf16_t* qbuf = (bf16_t*)(ws + WS_P + 32ull * MiB);
    bf16_t* obuf = (bf16_t*)(ws + WS_P + 64ull * MiB);
    if (ph == 0 || ph == 4 || ph == 6 || ph == 8) {
      pg8::Gemm g; pg8::TileSched S; pg8::EpiDyn E;
      g.M = NT; g.K = 1024; S.G = G; S.c = bid;
      if (ph == 0) { g.A = hbuf; g.Bt = (const bf16_t*)(wl + WT_IN); g.N = 4096; g.lda = 1024; g.ao0 = 0; g.ao1 = 256; g.ao2 = 512; g.ao3 = 768; S.nt = 1024; S.nN = 16;
        E.mode = 0; E.O = pbuf; E.ldc = NIN; E.N = NIN; E.resid = nullptr; E.out = nullptr; }
      else if (ph == 4) { g.A = pbuf; g.Bt = (const bf16_t*)(wl + WT_OUT); g.N = 1024; g.lda = NIN; g.ao0 = C_GA; g.ao1 = C_CGATE; g.ao2 = C_HG; g.ao3 = C_SG; S.nt = 256; S.nN = 4;
        E.mode = 1; E.O = nullptr; E.ldc = 1024; E.N = 1024; E.resid = (l == 0) ? P->in[0] : P->out; E.out = P->out; }
      else if (ph == 6) { g.A = hx; g.Bt = (const bf16_t*)(wl + WT_Q); g.N = 1024; g.lda = 1024; g.ao0 = 0; g.ao1 = 256; g.ao2 = 512; g.ao3 = 768; S.nt = 256; S.nN = 4;
        E.mode = 0; E.O = qbuf; E.ldc = 1024; E.N = 1024; E.resid = nullptr; E.out = nullptr; }
      else { g.A = obuf; g.Bt = (const bf16_t*)(wl + WT_O); g.N = 1024; g.lda = 1024; g.ao0 = 0; g.ao1 = 256; g.ao2 = 512; g.ao3 = 768; S.nt = 256; S.nN = 4;
        E.mode = 1; E.O = nullptr; E.ldc = 1024; E.N = 1024; E.resid = P->out; E.out = P->out; }
      pg8::gemm_phase<pg8::EpiDyn, pg8::TileSched, true, true>((PG8_LAS unsigned char*)lds, g, S, E, wv_);
    } else if (ph == 1) {
      unsigned* ctr = (unsigned*)(ws + WS_BAR) + it;
      for (;;) {
        const int i2 = next_item(ctr, (volatile LAS int*)&wq_slot, wv_);
        if (i2 >= 640) break;
        if (i2 < 128) hgrn_wave_item<0>(P, l, i2 * 8 + wv_, lds, wv_);
        else rwkv_prep_item(P, l, i2 - 128, lds, wv_);
      }
    } else if (ph == 2) {
      const int n_p1 = 8 * (RW_C - 2);
      const int n_rw = n_p1 + 8;
      const int n_oth = 8 + 512 + 1024;
      if (G > n_rw + 32) {
        if (bid < n_rw) {
          if (bid < n_p1) rwkv_scan_item<1>(P, l, bid & 7, 1 + (bid >> 3), lds, wv_);
          else rwkv_scan_item<0>(P, l, bid - n_p1, 0, lds, wv_);
        } else {
          unsigned* ctr = (unsigned*)(ws + WS_BAR) + it;
          for (;;) {
            const int i2 = next_item(ctr, (volatile LAS int*)&wq_slot, wv_);
            if (i2 >= n_oth) break;
            if (i2 < 8) hgrn_combine_item(P, i2, wv_);
            else if (i2 < 8 + 512) conv_item(P, l, i2 - 8, lds, wv_);
            else sb_item(P, i2 - 8 - 512, lds, wv_);
          }
        }
      } else {
        for (int i2 = bid; i2 < n_rw + n_oth; i2 += G) {
          if (i2 < n_p1) rwkv_scan_item<1>(P, l, i2 & 7, 1 + (i2 >> 3), lds, wv_);
          else if (i2 < n_rw) rwkv_scan_item<0>(P, l, i2 - n_p1, 0, lds, wv_);
          else if (i2 < n_rw + 8) hgrn_combine_item(P, i2 - n_rw, wv_);
          else if (i2 < n_rw + 8 + 512) conv_item(P, l, i2 - n_rw - 8, lds, wv_);
          else sb_item(P, i2 - n_rw - 8 - 512, lds, wv_);
          __syncthreads();
        }
      }
    } else if (ph == 3) {
      const int n_p3 = 8 * (RW_C - 1);
      if (G > n_p3 + 32) {
        if (bid < n_p3) rwkv_scan_item<0>(P, l, bid & 7, 1 + (bid >> 3), lds, wv_);
        else {
          unsigned* ctr = (unsigned*)(ws + WS_BAR) + it;
          for (;;) {
            const int i2 = next_item(ctr, (volatile LAS int*)&wq_slot, wv_);
            if (i2 >= 16 + 128) break;
            if (i2 < 16) gemm_tile<0>((const bf16_t*)(ws + WS_MEMN) + (size_t)l * 512 * 1024, 1024, 0, 256, 512, 768, (const bf16_t*)(wl + WT_KV), (i2 >> 3) * 256, (i2 & 7) * 256, 2048,
                                      (bf16_t*)(ws + WS_KV) + (size_t)l * 512 * 2048, nullptr, 2048, lds, wv_);
            else hgrn_wave_item<1>(P, l, (i2 - 16) * 8 + wv_, lds, wv_);
          }
        }
      } else {
        const int n_all = n_p3 + 128 + 16;
        for (int i2 = bid; i2 < n_all; i2 += G) {
          if (i2 < n_p3) rwkv_scan_item<0>(P, l, i2 & 7, 1 + (i2 >> 3), lds, wv_);
          else if (i2 < n_p3 + 128) hgrn_wave_item<1>(P, l, (i2 - n_p3) * 8 + wv_, lds, wv_);
          else { const int t = i2 - n_p3 - 128; gemm_tile<0>((const bf16_t*)(ws + WS_MEMN) + (size_t)l * 512 * 1024, 1024, 0, 256, 512, 768, (const bf16_t*)(wl + WT_KV), (t >> 3) * 256, (t & 7) * 256, 2048,
                                                            (bf16_t*)(ws + WS_KV) + (size_t)l * 512 * 2048, nullptr, 2048, lds, wv_); }
          __syncthreads();
        }
      }
    } else if (ph == 7) {
      for (int i2 = bid; i2 < 1024; i2 += G) xattn_item(P, l, i2, lds, wv_);
    } else {
      const bool fin = (ph == 9 && l == 1);
      const float* g_ = ph == 5 ? P->in[21] + l * 1024 : (fin ? P->in[27] : P->in[2] + 1024);
      void* d_ = ph == 5 ? (void*)hx : (fin ? (void*)P->out : (void*)hbuf);
#ifdef PROBE_J
      float pd_ = 0.f;
      if (fin) {
        if (bid == PROBE_B) {
          if (opaque_tid(wv_) == 0) {
            unsigned long long tot = 0ull; for (int i = 0; i < 11; ++i) tot += tacc[i] + tacc[16 + i];
            pdelta = sqrtf(0.0128f * (float)tacc[PROBE_J] / (float)tot);
          }
          __syncthreads();
          pd_ = pdelta;
        }
      }
      norm_rows(fin, P->out, g_, d_, NT, pd_, wv_);
#else
      norm_rows(fin, P->out, g_, d_, NT, 0.f, wv_);
#endif
    }
    if (it < 19) { STAMP(16 + ph); xcd_barrier(bar, wv_); STAMP(ph) }
  }
#ifdef PROBE_J
  if (bid == PROBE_B && opaque_tid(wv_) == 0) {
    const unsigned long long t0_ = __builtin_amdgcn_s_memrealtime();
    const unsigned long long w_ = 4ull * tacc[PROBE_K];
    while (__builtin_amdgcn_s_memrealtime() - t0_ < w_) __builtin_amdgcn_s_sleep(8);
  }
#endif
}

extern "C" void kernel_launch(void* const* d_in, const int* in_sizes, int n_in, void* d_out, int out_size, void* d_ws, size_t ws_size, hipStream_t stream) {
  constexpr size_t kDynLds = 147456;
  static int grid_blocks = 0;
  if (!grid_blocks) {
    int dev = 0, cus = 0, per_cu = 0;
    hipGetDevice(&dev);
    hipDeviceGetAttribute(&cus, hipDeviceAttributeMultiprocessorCount, dev);
    hipFuncSetAttribute((const void*)fwd_megakernel, hipFuncAttributeMaxDynamicSharedMemorySize, (int)kDynLds);
    hipOccupancyMaxActiveBlocksPerMultiprocessor(&per_cu, fwd_megakernel, NTHR, kDynLds);
    if (per_cu < 1) per_cu = 1;
    if (per_cu > 1) per_cu = 1;
    grid_blocks = cus * per_cu;
    if (grid_blocks > 256) grid_blocks = 256;
  }
  Params p;
  memset(&p, 0, sizeof(p));
  for (int i = 0; i < 28; ++i) p.in[i] = (const float*)d_in[i];
  p.out = (float*)d_out; p.ws = (unsigned char*)d_ws; p.never = 0; p.pad = 0;
  hipMemsetAsync(d_ws, 0, XCD_BAR_WORDS * 4, stream);
  void* args[] = {&p};
  hipError_t e = hipLaunchCooperativeKernel((void*)fwd_megakernel, dim3(grid_blocks), dim3(NTHR), args, kDynLds, stream);
  if (e != hipSuccess) fprintf(stderr, "cooperative launch failed: %s (grid %d)\n", hipGetErrorString(e), grid_blocks);
}
```

```cpp
#include <hip/hip_runtime.h>
#include <hip/hip_cooperative_groups.h>
#include <stdint.h>
#include <cstdio>
#include <cstring>
namespace cg = cooperative_groups;

typedef unsigned short bf16_t;
typedef short bf16x8 __attribute__((ext_vector_type(8)));
typedef float f32x4 __attribute__((ext_vector_type(4)));
typedef float f32x16 __attribute__((ext_vector_type(16)));
typedef float f32x2 __attribute__((ext_vector_type(2)));
#define LAS __attribute__((address_space(3)))

#define NT 16384
#define TSEQ 8192
#define DM 1024
#define NIN 3904
#define NTHR 512
#define C_R 0
#define C_K 256
#define C_V 512
#define C_XW 768
#define C_GA 832
#define C_CVAL 1088
#define C_CGLU 1344
#define C_CGATE 1600
#define C_HQ 1856
#define C_HF 2112
#define C_HI 2368
#define C_HG 2624
#define C_SQ 2880
#define C_SK 3136
#define C_SV 3392
#define C_SG 3648
#define RW_C 16
#define RW_CL (TSEQ / RW_C)
#define RW_TT 16

#define MiB (1024ull * 1024ull)
#define WS_BAR   0ull
#define WS_WT    (1ull * MiB)
#define WT_LAYER (18ull * MiB)
#define WT_IN    0ull
#define WT_OUT   (8ull * MiB)
#define WT_Q     (10ull * MiB)
#define WT_KV    (12ull * MiB)
#define WT_O     (16ull * MiB)
#define WS_MEMN  (37ull * MiB)
#define WS_KV    (39ull * MiB)
#define WS_PQ    (43ull * MiB)
#define WS_HS    (47ull * MiB)
#define WS_HF    (63ull * MiB)
#define WS_RK    (63ull * MiB + 512ull * 1024ull)
#define WS_R1    (64ull * MiB)
#define WS_PW    WS_R1
#define WS_PV    (WS_R1 + 16ull * MiB)
#define WS_P     (120ull * MiB)
#define WS_END   (243ull * MiB)

struct Params {
  const float* in[28];
  float* out;
  unsigned char* ws;
  int never;
  int pad;
};

typedef const __attribute__((address_space(4))) Params* KP;
__device__ __forceinline__ int lane_id_() { return (int)__builtin_amdgcn_mbcnt_hi(~0u, __builtin_amdgcn_mbcnt_lo(~0u, 0u)); }
__device__ __forceinline__ int opaque_tid(int wv_) { int t; asm volatile("v_mbcnt_lo_u32_b32 %0, -1, 0\n\tv_mbcnt_hi_u32_b32 %0, -1, %0\n\tv_lshl_add_u32 %0, %1, 6, %0" : "=&v"(t) : "s"(wv_)); return t; }
__device__ __forceinline__ float bf2f(bf16_t v) { return __uint_as_float(((unsigned)v) << 16); }
__device__ __forceinline__ bf16_t f2bf(float f) {
  unsigned u = __float_as_uint(f);
  u += 0x7fffu + ((u >> 16) & 1u);
  return (bf16_t)(u >> 16);
}
__device__ __forceinline__ unsigned pack2(float a, float b) { return (unsigned)f2bf(a) | ((unsigned)f2bf(b) << 16); }
__device__ __forceinline__ float sigmoidf_(float x) { return __builtin_amdgcn_rcpf(1.0f + __expf(-x)); }
__device__ __forceinline__ float siluf_(float x) { return x * __builtin_amdgcn_rcpf(1.0f + __expf(-x)); }
__device__ __forceinline__ float softplusf_(float x) { return fmaxf(x, 0.f) + log1pf(__expf(-fabsf(x))); }
__device__ __forceinline__ float softplus_fast(float x) { return fmaxf(x, 0.f) + __logf(1.0f + __expf(-fabsf(x))); }
__device__ __forceinline__ float dpp_add(float v, const int ctrl_sel) {
  return v;
}
__device__ __forceinline__ float bperm(float v, int srclane) { return __builtin_bit_cast(float, __builtin_amdgcn_ds_bpermute(srclane << 2, __builtin_bit_cast(int, v))); }
__device__ __forceinline__ float wave_sum(float v, int lane) {
  v += __builtin_bit_cast(float, __builtin_amdgcn_update_dpp(0, __builtin_bit_cast(int, v), 0xB1, 0xF, 0xF, true));
  v += __builtin_bit_cast(float, __builtin_amdgcn_update_dpp(0, __builtin_bit_cast(int, v), 0x4E, 0xF, 0xF, true));
  v += __builtin_bit_cast(float, __builtin_amdgcn_update_dpp(0, __builtin_bit_cast(int, v), 0x141, 0xF, 0xF, true));
  v += __builtin_bit_cast(float, __builtin_amdgcn_update_dpp(0, __builtin_bit_cast(int, v), 0x140, 0xF, 0xF, true));
  v += bperm(v, lane ^ 16);
  v += bperm(v, lane ^ 32);
  return v;
}
__device__ __forceinline__ float max8(float v) {
  v = fmaxf(v, __builtin_bit_cast(float, __builtin_amdgcn_update_dpp(0, __builtin_bit_cast(int, v), 0xB1, 0xF, 0xF, true)));
  v = fmaxf(v, __builtin_bit_cast(float, __builtin_amdgcn_update_dpp(0, __builtin_bit_cast(int, v), 0x4E, 0xF, 0xF, true)));
  v = fmaxf(v, __builtin_bit_cast(float, __builtin_amdgcn_update_dpp(0, __builtin_bit_cast(int, v), 0x141, 0xF, 0xF, true)));
  return v;
}
__device__ __forceinline__ float red8(float v) {
  v += __builtin_bit_cast(float, __builtin_amdgcn_update_dpp(0, __builtin_bit_cast(int, v), 0xB1, 0xF, 0xF, true));
  v += __builtin_bit_cast(float, __builtin_amdgcn_update_dpp(0, __builtin_bit_cast(int, v), 0x4E, 0xF, 0xF, true));
  v += __builtin_bit_cast(float, __builtin_amdgcn_update_dpp(0, __builtin_bit_cast(int, v), 0x141, 0xF, 0xF, true));
  return v;
}

#define LBAR() do { asm volatile("s_waitcnt lgkmcnt(0)" ::: "memory"); __builtin_amdgcn_s_barrier(); asm volatile("" ::: "memory"); } while (0)
#define XB_TMO      128
#define XB_XCNT(j)  (256  + 64 * (j))
#define XB_XSUB(j)  (1280 + 64 * (j))
#define XB_XGEN(j)  (2304 + 64 * (j))
#define XB_TOP      3328
#define XB_TOPGEN   3392
#define XCD_BAR_WORDS 3456
#define XB_SPIN_CAP (1u << 22)
__device__ __forceinline__ unsigned xb_ld(unsigned* p) { return __hip_atomic_load(p, __ATOMIC_RELAXED, __HIP_MEMORY_SCOPE_AGENT); }
__device__ __forceinline__ unsigned xb_add(unsigned* p, unsigned v) { return __hip_atomic_fetch_add(p, v, __ATOMIC_RELAXED, __HIP_MEMORY_SCOPE_AGENT); }
__device__ __forceinline__ unsigned xb_xcc_id() { return (unsigned)__builtin_amdgcn_s_getreg((3 << 11) | 20) & 0xFu; }
#define XB_SPIN(cond, bar) do { unsigned _sp = 0; while (cond) { __builtin_amdgcn_s_sleep(1); \
    if ((++_sp & 255u) == 0u) { if (xb_ld(&(bar)[XB_TMO])) break; if (_sp > XB_SPIN_CAP) { atomicAdd(&(bar)[XB_TMO], 1u); break; } } } } while (0)
struct XcdBarrier { unsigned* bar; unsigned x; volatile LAS unsigned* st; };
__device__ __forceinline__ XcdBarrier xcd_barrier_post(unsigned* bar, volatile LAS unsigned* st, int wv_) {
  XcdBarrier b; b.bar = bar; b.x = xb_xcc_id(); b.st = st;
  if (opaque_tid(wv_) == 0) (void)xb_add(&bar[XB_XCNT(b.x)], 1u);
  return b;
}
__device__ __forceinline__ void xcd_barrier_complete(unsigned* bar, unsigned x, unsigned& nloc, unsigned& nx) {
  const unsigned G = gridDim.x * gridDim.y * gridDim.z;
  unsigned sum, cnt, mine, sp = 0u;
  for (;;) {
    sum = 0u; cnt = 0u; mine = 0u;
#pragma unroll
    for (unsigned j = 0; j < 16; ++j) { const unsigned c = xb_ld(&bar[XB_XCNT(j)]); sum += c; cnt += (c > 0u) ? 1u : 0u; mine = (j == x) ? c : mine; }
    if (sum == G) break;
    __builtin_amdgcn_s_sleep(1);
    if ((++sp & 255u) == 0u) { if (xb_ld(&bar[XB_TMO])) break; if (sp > XB_SPIN_CAP) { atomicAdd(&bar[XB_TMO], 1u); break; } }
  }
  nloc = mine > 0u ? mine : 1u; nx = cnt > 0u ? cnt : 1u;
}
__device__ __forceinline__ void xcd_barrier(const XcdBarrier& b, int wv_) {
  asm volatile("s_waitcnt vmcnt(0)" ::: "memory");
  __syncthreads();
  if (opaque_tid(wv_) == 0) {
    unsigned* bar = b.bar;
    __builtin_amdgcn_s_waitcnt(0);
    unsigned bx = b.x; asm volatile("" : "+s"(bx));
    unsigned nloc = b.st[0], nx = b.st[1];
    if (nloc == 0u) { xcd_barrier_complete(bar, bx, nloc, nx); b.st[0] = nloc; b.st[1] = nx; }
    const unsigned old = xb_add(&bar[XB_XSUB(bx)], 1u);
    const unsigned gen = old / nloc;
    if (old + 1u == (gen + 1u) * nloc) {
      __builtin_amdgcn_fence(__ATOMIC_RELEASE, "agent");
      asm volatile("s_waitcnt vmcnt(0)" ::: "memory");
      const unsigned og = xb_add(&bar[XB_TOP], 1u);
      const unsigned tg = og / nx;
      if (og + 1u == (tg + 1u) * nx) xb_add(&bar[XB_TOPGEN], 1u);
      else XB_SPIN(xb_ld(&bar[XB_TOPGEN]) == tg, bar);
      __builtin_amdgcn_fence(__ATOMIC_ACQUIRE, "agent");
      xb_add(&bar[XB_XGEN(bx)], 1u);
      asm volatile("s_waitcnt vmcnt(0)" ::: "memory");
    } else {
      XB_SPIN(xb_ld(&bar[XB_XGEN(bx)]) == gen, bar);
      __builtin_amdgcn_fence(__ATOMIC_ACQUIRE, "agent");
      asm volatile("s_waitcnt vmcnt(0)" ::: "memory");
    }
  }
  __syncthreads();
}

#define G_STAGE 73728
#define G_BOFF 36864
template <int EPI>
__device__ __forceinline__ void gemm_tile(const bf16_t* __restrict__ A, int lda, int ao0, int ao1, int ao2, int ao3,
                                          const bf16_t* __restrict__ Bt, int m0, int n0, int N,
                                          void* out, const float* resid, int ldc, unsigned char* lds, int wv_) {
#ifdef OFF_gemm_tile
  return;
#endif

  const int tid = opaque_tid(wv_), lane = tid & 63, w = tid >> 6;
  const int wm = w >> 2, wn = w & 3, lr = lane & 31, lh = lane >> 5;
  f32x16 acc[4][2];
#pragma unroll
  for (int i = 0; i < 4; ++i)
#pragma unroll
    for (int j = 0; j < 2; ++j)
#pragma unroll
      for (int r = 0; r < 16; ++r) acc[i][j][r] = 0.f;
  uint4 ra[4], rb[4];
  const int crow = tid >> 3, ccol = (tid & 7) * 8;
  const bf16_t* Ap = A + (size_t)(m0 + crow) * lda + ccol;
  const bf16_t* Bp = Bt + (size_t)(n0 + crow) * 1024 + ccol;
#define G_LOAD(kt) { const int k0_ = (kt) * 64; const int seg_ = k0_ >> 8; const int ao_ = (seg_ == 0 ? ao0 : seg_ == 1 ? ao1 : seg_ == 2 ? ao2 : ao3) + (k0_ & 255); \
    _Pragma("unroll") for (int i_ = 0; i_ < 4; ++i_) { ra[i_] = *(const uint4*)(Ap + (size_t)(i_ * 64) * lda + ao_); rb[i_] = *(const uint4*)(Bp + (size_t)(i_ * 64) * 1024 + k0_); } }
#define G_WRITE(buf) { unsigned char* b_ = lds + (buf) * G_STAGE + crow * 144 + (tid & 7) * 16; \
    _Pragma("unroll") for (int i_ = 0; i_ < 4; ++i_) { *(uint4*)(b_ + i_ * 64 * 144) = ra[i_]; *(uint4*)(b_ + G_BOFF + i_ * 64 * 144) = rb[i_]; } }
  G_LOAD(0); G_WRITE(0); __syncthreads();
  for (int kt = 0; kt < 16; ++kt) {
    if (kt < 15) G_LOAD(kt + 1);
    const unsigned char* base = lds + (kt & 1) * G_STAGE;
    const unsigned char* ab = base + (wm * 128 + lr) * 144 + lh * 16;
    const unsigned char* bb = base + G_BOFF + (wn * 64 + lr) * 144 + lh * 16;
#pragma unroll
    for (int s = 0; s < 4; ++s) {
      bf16x8 a[4], b[2];
#pragma unroll
      for (int i = 0; i < 4; ++i) a[i] = *(const bf16x8*)(ab + i * 32 * 144 + s * 32);
#pragma unroll
      for (int j = 0; j < 2; ++j) b[j] = *(const bf16x8*)(bb + j * 32 * 144 + s * 32);
#pragma unroll
      for (int i = 0; i < 4; ++i)
#pragma unroll
        for (int j = 0; j < 2; ++j) acc[i][j] = __builtin_amdgcn_mfma_f32_32x32x16_bf16(a[i], b[j], acc[i][j], 0, 0, 0);
    }
    if (kt < 15) G_WRITE((kt + 1) & 1);
    __syncthreads();
  }
#undef G_LOAD
#undef G_WRITE
#pragma unroll
  for (int i = 0; i < 4; ++i)
#pragma unroll
    for (int j = 0; j < 2; ++j) {
      const int col = n0 + wn * 64 + j * 32 + lr;
#pragma unroll
      for (int r = 0; r < 16; ++r) {
        const int row = m0 + wm * 128 + i * 32 + (r & 3) + 8 * (r >> 2) + 4 * lh;
        if (EPI == 0) { if (col < N) ((bf16_t*)out)[(size_t)row * ldc + col] = f2bf(acc[i][j][r]); }
        else { ((float*)out)[(size_t)row * ldc + col] = resid[(size_t)row * ldc + col] + acc[i][j][r]; }
      }
    }
}

__device__ __forceinline__ void tile_map(int t, int nN, int& mi, int& ni) {
  const int rnd = t >> 8, blk = t & 255, x = blk & 7, y = blk >> 3;
  if (nN == 16) { mi = rnd * 16 + (x >> 1) * 4 + (y & 3); ni = (x & 1) * 8 + (y >> 2); }
  else { mi = rnd * 64 + x * 8 + (y & 7); ni = y >> 3; }
}

namespace pg8 {
#define PG8_LAS __attribute__((address_space(3)))
typedef unsigned u32x4 __attribute__((ext_vector_type(4)));
constexpr int BM = 256, BK = 64, HALF = 128, HTB = HALF * BK * 2  , STAGE_BYTES = 8 * HTB, NXCD = 8, WGM = 8;

__host__ __device__ __forceinline__ int lds_byte(int r, int c) { const int st = (r >> 4) * 2 + (c >> 5), rr = r & 15, cc = c & 31, ob = rr * 64 + cc * 2; return st * 1024 + (ob ^ (((ob >> 9) & 1) << 5)); }
__host__ __device__ __forceinline__ void stage_rc(int b, int& R, int& C) { const int st = b / 1024, sb = b % 1024, swz = sb ^ (((sb >> 9) & 1) << 5); R = (st >> 1) * 16 + swz / 64; C = (st & 1) * 32 + (swz % 64) / 2; }
__host__ __device__ __forceinline__ int perm32(int rho) { const int n = rho >> 4, i = rho & 15; return 8 * (i >> 2) + 4 * n + (i & 3); }

struct Unit { int pm, pn; };
struct Gemm { const bf16_t* A; const bf16_t* Bt; int M, N, K; int lda; int ao0, ao1, ao2, ao3; };

struct TileSched {
    int nt, G, c, nN;
    __device__ __forceinline__ bool next(int i, Unit& u) const { const int t = i * G + c; if (t >= nt) return false; tile_map(t, nN, u.pm, u.pn); return true; }
    __device__ __forceinline__ void a_ready(const Unit&) const {}
    __device__ __forceinline__ void done(const Unit&) const {}
};
__device__ __forceinline__ unsigned cvt_pk_bf16(float lo, float hi) { unsigned r; asm volatile("v_cvt_pk_bf16_f32 %0, %1, %2" : "=v"(r) : "v"(lo), "v"(hi)); return r; }
struct EpiStoreBf16 {
    static constexpr bool PERM = true, AFTER_DRAIN = false;
    bf16_t* O; int ldc; int N;
    __device__ __forceinline__ void operator()(const f32x4 (&acc)[2][2][4][2], const Unit& u, int wr, int wc, int fr, int fq) const {
        const int row0 = u.pm * BM + wr * 64 + fr, col0 = u.pn * BM + wc * 32 + 8 * fq;
#pragma unroll
        for (int ai = 0; ai < 2; ++ai)
#pragma unroll
            for (int m = 0; m < 4; ++m) { bf16_t* rowp = O + (size_t)(row0 + ai * HALF + m * 16) * ldc + col0;
#pragma unroll
                for (int bj = 0; bj < 2; ++bj) { if (col0 + bj * HALF < N) { const f32x4 v0 = acc[ai][bj][m][0], v1 = acc[ai][bj][m][1];
                    u32x4 w; w.x = cvt_pk_bf16(v0[0], v0[1]); w.y = cvt_pk_bf16(v0[2], v0[3]); w.z = cvt_pk_bf16(v1[0], v1[1]); w.w = cvt_pk_bf16(v1[2], v1[3]);
                    *(u32x4*)(rowp + bj * HALF) = w; } } }
    }
};
struct EpiDyn {
    static constexpr bool PERM = true, AFTER_DRAIN = false;
    int mode; bf16_t* O; int ldc; int N; const float* resid; float* out;
    __device__ __forceinline__ void operator()(const f32x4 (&acc)[2][2][4][2], const Unit& u, int wr, int wc, int fr, int fq) const {
        const int row0 = u.pm * BM + wr * 64 + fr, col0 = u.pn * BM + wc * 32 + 8 * fq;
        if (mode == 0) {
#pragma unroll
            for (int ai = 0; ai < 2; ++ai)
#pragma unroll
                for (int m = 0; m < 4; ++m) { bf16_t* rowp = O + (size_t)(row0 + ai * HALF + m * 16) * ldc + col0;
#pragma unroll
                    for (int bj = 0; bj < 2; ++bj) { if (col0 + bj * HALF < N) { const f32x4 v0 = acc[ai][bj][m][0], v1 = acc[ai][bj][m][1];
                        u32x4 w; w.x = cvt_pk_bf16(v0[0], v0[1]); w.y = cvt_pk_bf16(v0[2], v0[3]); w.z = cvt_pk_bf16(v1[0], v1[1]); w.w = cvt_pk_bf16(v1[2], v1[3]);
                        *(u32x4*)(rowp + bj * HALF) = w; } } }
        } else {
#pragma unroll
            for (int ai = 0; ai < 2; ++ai)
#pragma unroll
                for (int m = 0; m < 4; ++m) { const size_t off = (size_t)(row0 + ai * HALF + m * 16) * ldc + col0;
#pragma unroll
                    for (int bj = 0; bj < 2; ++bj) { const f32x4 r0 = *(const f32x4*)(resid + off + bj * HALF), r1 = *(const f32x4*)(resid + off + bj * HALF + 4);
                        *(f32x4*)(out + off + bj * HALF) = r0 + acc[ai][bj][m][0]; *(f32x4*)(out + off + bj * HALF + 4) = r1 + acc[ai][bj][m][1]; } }
        }
    }
};
struct EpiResid {
    static constexpr bool PERM = true, AFTER_DRAIN = false;
    const float* resid; float* out; int ldc;
    __device__ __forceinline__ void operator()(const f32x4 (&acc)[2][2][4][2], const Unit& u, int wr, int wc, int fr, int fq) const {
        const int row0 = u.pm * BM + wr * 64 + fr, col0 = u.pn * BM + wc * 32 + 8 * fq;
#pragma unroll
        for (int ai = 0; ai < 2; ++ai)
#pragma unroll
            for (int m = 0; m < 4; ++m) { const size_t off = (size_t)(row0 + ai * HALF + m * 16) * ldc + col0;
#pragma unroll
                for (int bj = 0; bj < 2; ++bj) { const f32x4 r0 = *(const f32x4*)(resid + off + bj * HALF), r1 = *(const f32x4*)(resid + off + bj * HALF + 4);
                    *(f32x4*)(out + off + bj * HALF) = r0 + acc[ai][bj][m][0]; *(f32x4*)(out + off + bj * HALF + 4) = r1 + acc[ai][bj][m][1]; } }
    }
};

static_assert(true, "pg8 body adapted: SP2 path only is valid with lda/segment offsets");
template <class Epi, class Sched, bool ALIGN_EPI = false, bool SP2 = false>
__device__ __forceinline__ void gemm_phase(PG8_LAS unsigned char* lds, const Gemm g, const Sched& S, const Epi& E, int wv_) {
    const int tid = opaque_tid(wv_), wid = __builtin_amdgcn_readfirstlane(tid >> 6), lane = tid & 63, wr = wid >> 2, wc = wid & 3, fr = lane & 15, fq = lane >> 4;
    const int K = g.K, nt = K / BK;
    unsigned voffA[2], voffB[2];
#pragma unroll
    for (int i = 0; i < 2; ++i) { int R, C; stage_rc(tid * 16 + i * 8192, R, C); const int Rb = Epi::PERM ? ((R & ~31) + perm32(R & 31)) : R;
        voffA[i] = (unsigned)(R * g.lda + C) * 2u; voffB[i] = (unsigned)(Rb * K + C) * 2u; }
    const size_t kstep = (size_t)(BK * 2);
    const size_t hstep = (size_t)HALF * K * 2; const size_t hstepA = (size_t)HALF * g.lda * 2, tstepA = 2 * hstepA;
#define PG8_KA(t_) ((size_t)((((t_) >> 2) == 0 ? g.ao0 : ((t_) >> 2) == 1 ? g.ao1 : ((t_) >> 2) == 2 ? g.ao2 : g.ao3) + ((t_) & 3) * 64) * 2)
    const size_t tstep = 2 * hstep;
    const unsigned ldsw = (unsigned)wid * 1024u;
    int aoff, boff;
#define PG8_SA(b, h) (((b) * 2 + (h)) * HTB)
#define PG8_SB(b, h) ((4 + (b) * 2 + (h)) * HTB)
#define PG8_STAGE(bufoff, gbase, voff) do { _Pragma("unroll") for (int _i = 0; _i < 2; ++_i) \
        __builtin_amdgcn_global_load_lds((const unsigned*)((const char*)(gbase) + (voff)[_i]), (PG8_LAS unsigned*)(lds + (bufoff) + ldsw + _i * 8192), 16, 0, 0); } while (0)
#define PG8_LDA(dst, b, h) do { _Pragma("unroll") for (int m = 0; m < 4; ++m) _Pragma("unroll") for (int k = 0; k < 2; ++k) dst[m][k] = *(const PG8_LAS bf16x8*)(lds + PG8_SA(b, h) + aoff + m * 2048 + k * 1024); } while (0)
#define PG8_LDB(dst, b, h) do { _Pragma("unroll") for (int n = 0; n < 2; ++n) _Pragma("unroll") for (int k = 0; k < 2; ++k) dst[n][k] = *(const PG8_LAS bf16x8*)(lds + PG8_SB(b, h) + boff + n * 2048 + k * 1024); } while (0)
#define PG8_MMA(ai, bj, At, Bt) do { __builtin_amdgcn_s_setprio(1); _Pragma("unroll") for (int m = 0; m < 4; ++m) _Pragma("unroll") for (int n = 0; n < 2; ++n) _Pragma("unroll") for (int k = 0; k < 2; ++k) \
        acc[ai][bj][m][n] = __builtin_amdgcn_mfma_f32_16x16x32_bf16(Bt[n][k], At[m][k], acc[ai][bj][m][n], 0, 0, 0); __builtin_amdgcn_s_setprio(0); } while (0)
#define PG8_WAIT_V(n) asm volatile("s_waitcnt vmcnt(" #n ")" ::: "memory")
#define PG8_WAIT_L(n) asm volatile("s_waitcnt lgkmcnt(" #n ")" ::: "memory")
#define PG8_BAR __builtin_amdgcn_s_barrier()
#define PG8_SCHED __builtin_amdgcn_sched_barrier(0)
    Unit cur, nxt; int ui = 0;
    if (!S.next(0, cur)) return;
    f32x4 acc[2][2][4][2];
#pragma unroll
    for (int a = 0; a < 2; ++a)
#pragma unroll
        for (int b = 0; b < 2; ++b)
#pragma unroll
            for (int m = 0; m < 4; ++m)
#pragma unroll
                for (int n = 0; n < 2; ++n) acc[a][b][m][n] = (f32x4){0.f, 0.f, 0.f, 0.f};
    bf16x8 At[4][2], B0[2][2], B1[2][2];
    const char* cA = (const char*)g.A + (size_t)cur.pm * tstepA; const char* cB = (const char*)g.Bt + (size_t)cur.pn * tstep;
    S.a_ready(cur);
    if constexpr (SP2) {
        PG8_STAGE(PG8_SB(0, 0), cB, voffB); PG8_STAGE(PG8_SB(0, 1), cB + hstep, voffB); PG8_STAGE(PG8_SA(0, 0), cA + PG8_KA(0), voffA); PG8_STAGE(PG8_SA(0, 1), cA + hstepA + PG8_KA(0), voffA);
        if (wr == 1) PG8_BAR;
        PG8_WAIT_V(2); PG8_BAR;
        PG8_STAGE(PG8_SB(1, 0), cB + kstep, voffB); PG8_STAGE(PG8_SA(1, 0), cA + PG8_KA(1), voffA); PG8_STAGE(PG8_SB(1, 1), cB + hstep + kstep, voffB);
        PG8_WAIT_V(6); PG8_BAR;
    } else {
        PG8_STAGE(PG8_SB(0, 0), cB, voffB); PG8_STAGE(PG8_SA(0, 0), cA, voffA); PG8_STAGE(PG8_SB(0, 1), cB + hstep, voffB); PG8_STAGE(PG8_SA(0, 1), cA + hstep, voffA);
        if (wr == 1) PG8_BAR;
        PG8_WAIT_V(4); PG8_BAR;
        PG8_STAGE(PG8_SB(1, 0), cB + kstep, voffB); PG8_STAGE(PG8_SA(1, 0), cA + kstep, voffA); PG8_STAGE(PG8_SB(1, 1), cB + hstep + kstep, voffB);
        PG8_WAIT_V(6); PG8_BAR;
    }
    { const int t3_ = opaque_tid(wv_), l3_ = t3_ & 63, w3_ = __builtin_amdgcn_readfirstlane(t3_ >> 6); aoff = lds_byte((w3_ >> 2) * 64 + (l3_ & 15), (l3_ >> 4) * 8); boff = lds_byte((w3_ & 3) * 32 + (l3_ & 15), (l3_ >> 4) * 8); }
    for (;;) {
        const bool has_next = S.next(ui + 1, nxt);
        const char* nA = has_next ? (const char*)g.A + (size_t)nxt.pm * tstepA : cA; const char* nB = has_next ? (const char*)g.Bt + (size_t)nxt.pn * tstep : cB;
        for (int t = 0; t < nt; t += 2) {
            const bool last = (t == nt - 2);
            const char* a1 = cA + PG8_KA(t + 1);
            const char* a2 = last ? nA + PG8_KA(0) : cA + PG8_KA(t + 2); const char* b2 = last ? nB : cB + (size_t)(t + 2) * kstep;
            const char* a3 = last ? nA + PG8_KA(1) : cA + PG8_KA(t + 3); const char* b3 = b2 + kstep;
            if (last && has_next) S.a_ready(nxt);
            if constexpr (SP2) {
            PG8_LDB(B0, 0, 0); PG8_LDB(B1, 0, 1); PG8_SCHED; PG8_LDA(At, 0, 0); PG8_STAGE(PG8_SA(1, 1), a1 + hstepA, voffA);
            PG8_WAIT_V(8); PG8_WAIT_L(0); PG8_BAR; PG8_MMA(0, 0, At, B0); PG8_MMA(0, 1, At, B1); PG8_BAR; PG8_SCHED;
            PG8_LDA(At, 0, 1); PG8_STAGE(PG8_SB(0, 0), b2, voffB); PG8_STAGE(PG8_SB(0, 1), b2 + hstep, voffB); PG8_STAGE(PG8_SA(0, 0), a2, voffA);
            PG8_WAIT_V(8); PG8_WAIT_L(0); PG8_BAR; PG8_MMA(1, 0, At, B0); PG8_MMA(1, 1, At, B1); PG8_BAR; PG8_SCHED;
            PG8_LDB(B0, 1, 0); PG8_LDB(B1, 1, 1); PG8_SCHED; PG8_LDA(At, 1, 0); PG8_STAGE(PG8_SA(0, 1), a2 + hstepA, voffA);
            PG8_WAIT_V(8); PG8_WAIT_L(0); PG8_BAR; PG8_MMA(0, 0, At, B0); PG8_MMA(0, 1, At, B1); PG8_BAR; PG8_SCHED;
            PG8_LDA(At, 1, 1); PG8_STAGE(PG8_SB(1, 0), b3, voffB); PG8_STAGE(PG8_SB(1, 1), b3 + hstep, voffB); PG8_STAGE(PG8_SA(1, 0), a3, voffA);
            PG8_WAIT_V(8); PG8_WAIT_L(0); PG8_BAR; PG8_MMA(1, 0, At, B0); PG8_MMA(1, 1, At, B1); PG8_BAR; PG8_SCHED;
            } else {
            PG8_LDB(B0, 0, 0); PG8_SCHED; PG8_LDA(At, 0, 0); PG8_STAGE(PG8_SA(1, 1), a1 + hstep, voffA);
            PG8_WAIT_L(8); PG8_BAR; PG8_WAIT_L(0); PG8_MMA(0, 0, At, B0); PG8_BAR; PG8_SCHED;
            PG8_LDB(B1, 0, 1); PG8_STAGE(PG8_SB(0, 0), b2, voffB);
            PG8_BAR; PG8_WAIT_L(0); PG8_MMA(0, 1, At, B1); PG8_BAR;
            PG8_LDA(At, 0, 1); PG8_STAGE(PG8_SA(0, 0), a2, voffA);
            PG8_BAR; PG8_WAIT_L(0); PG8_MMA(1, 0, At, B0); PG8_BAR; PG8_SCHED;
            PG8_STAGE(PG8_SB(0, 1), b2 + hstep, voffB);
            PG8_WAIT_V(6); PG8_BAR; PG8_MMA(1, 1, At, B1); PG8_BAR;
            PG8_LDB(B0, 1, 0); PG8_SCHED; PG8_LDA(At, 1, 0); PG8_STAGE(PG8_SA(0, 1), a2 + hstep, voffA);
            PG8_WAIT_L(8); PG8_BAR; PG8_WAIT_L(0); PG8_MMA(0, 0, At, B0); PG8_BAR; PG8_SCHED;
            PG8_LDB(B1, 1, 1); PG8_STAGE(PG8_SB(1, 0), b3, voffB);
            PG8_BAR; PG8_WAIT_L(0); PG8_MMA(0, 1, At, B1); PG8_BAR;
            PG8_LDA(At, 1, 1); PG8_STAGE(PG8_SA(1, 0), a3, voffA);
            PG8_BAR; PG8_WAIT_L(0); PG8_MMA(1, 0, At, B0); PG8_BAR; PG8_SCHED;
            PG8_STAGE(PG8_SB(1, 1), b3 + hstep, voffB);
            PG8_WAIT_V(6); PG8_BAR; PG8_MMA(1, 1, At, B1); PG8_BAR;
            }
        }
        if constexpr (ALIGN_EPI) { if (wr == 0) PG8_BAR; }
        if constexpr (!Epi::AFTER_DRAIN) { const int t2_ = opaque_tid(wv_), l2_ = t2_ & 63, w2_ = __builtin_amdgcn_readfirstlane(t2_ >> 6); E(acc, cur, w2_ >> 2, w2_ & 3, l2_ & 15, l2_ >> 4); S.done(cur); }
        if (!has_next) break;
#pragma unroll
        for (int a = 0; a < 2; ++a)
#pragma unroll
            for (int b = 0; b < 2; ++b)
#pragma unroll
                for (int m = 0; m < 4; ++m)
#pragma unroll
                    for (int n = 0; n < 2; ++n) acc[a][b][m][n] = (f32x4){0.f, 0.f, 0.f, 0.f};
        cur = nxt; cA = nA; cB = nB; ++ui;
        if constexpr (ALIGN_EPI) { if (wr == 1) PG8_BAR; }
    }
    PG8_WAIT_V(0);
    if constexpr (!ALIGN_EPI) { if (wr == 0) PG8_BAR; }
    PG8_BAR;
    if constexpr (Epi::AFTER_DRAIN) { E.fused(acc, cur, wr, wc, fr, fq, lds, wid, lane); S.done(cur); }
#undef PG8_SA
#undef PG8_SB
#undef PG8_STAGE
#undef PG8_LDA
#undef PG8_LDB
#undef PG8_MMA
#undef PG8_WAIT_V
#undef PG8_WAIT_L
#undef PG8_BAR
#undef PG8_SCHED
#undef PG8_KA
}
}

__device__ __forceinline__ void wt_tile(const float* __restrict__ W, int N, bf16_t* __restrict__ Wt, int kt, int nt, unsigned char* lds, int wv_) {
#ifdef OFF_wt_tile
  return;
#endif

  float* tl = (float*)lds;
  const int tid = opaque_tid(wv_);
  const int r = tid >> 3, c8 = (tid & 7) * 8;
  const float* src = W + (size_t)(kt * 64 + r) * N + nt * 64 + c8;
  const float4 v0 = *(const float4*)src, v1 = *(const float4*)(src + 4);
  float* d = tl + r * 65 + c8;
  d[0] = v0.x; d[1] = v0.y; d[2] = v0.z; d[3] = v0.w; d[4] = v1.x; d[5] = v1.y; d[6] = v1.z; d[7] = v1.w;
  __syncthreads();
  uint4 o;
  o.x = pack2(tl[(c8 + 0) * 65 + r], tl[(c8 + 1) * 65 + r]);
  o.y = pack2(tl[(c8 + 2) * 65 + r], tl[(c8 + 3) * 65 + r]);
  o.z = pack2(tl[(c8 + 4) * 65 + r], tl[(c8 + 5) * 65 + r]);
  o.w = pack2(tl[(c8 + 6) * 65 + r], tl[(c8 + 7) * 65 + r]);
  *(uint4*)(Wt + (size_t)(nt * 64 + r) * 1024 + kt * 64 + c8) = o;
  __syncthreads();
}

__device__ __forceinline__ void norm_rows(const bool F32OUT, const float* src, const float* __restrict__ g, void* dst, int nrows, float pd, int wv_) {
#ifdef OFF_norm_rows
  return;
#endif

  const int tid = opaque_tid(wv_);
  const int lane = tid & 63;
  const int gw = blockIdx.x * 8 + (tid >> 6), nw = gridDim.x * 8;
  float4 gv[4];
#pragma unroll
  for (int i = 0; i < 4; ++i) gv[i] = *(const float4*)(g + i * 256 + lane * 4);
  for (int row = gw; row < nrows; row += nw) {
    const float* s = src + (size_t)row * 1024;
    float4 v[4]; float ss = 0.f;
#pragma unroll
    for (int i = 0; i < 4; ++i) { v[i] = *(const float4*)(s + i * 256 + lane * 4); ss += v[i].x * v[i].x + v[i].y * v[i].y + v[i].z * v[i].z + v[i].w * v[i].w; }
    ss = wave_sum(ss, lane);
    const float rs = rsqrtf(ss * (1.0f / 1024.0f) + 1e-6f);
#pragma unroll
    for (int i = 0; i < 4; ++i) {
      const float a = v[i].x * rs * gv[i].x, b = v[i].y * rs * gv[i].y, c = v[i].z * rs * gv[i].z, d = v[i].w * rs * gv[i].w;
      if (F32OUT) { *(float4*)((float*)dst + (size_t)row * 1024 + i * 256 + lane * 4) = make_float4(a + pd, b + pd, c + pd, d + pd); }
      else { uint2 o; o.x = pack2(a, b); o.y = pack2(c, d); *(uint2*)((bf16_t*)dst + (size_t)row * 1024 + i * 256 + lane * 4) = o; }
    }
  }
}

__device__ __forceinline__ void rwkv_prep_item(KP P, int l, int item, unsigned char* lds, int wv_) {
#ifdef OFF_rwkv_prep_item
  return;
#endif

  const bf16_t* p = (const bf16_t*)(P->ws + WS_P);
  float* PW = (float*)(P->ws + WS_PW); bf16_t* PV = (bf16_t*)(P->ws + WS_PV); float* RK = (float*)(P->ws + WS_RK);
  float* lora = (float*)lds;
  const int tid = opaque_tid(wv_), lane = tid & 63, w = tid >> 6, head = w & 3, sub = w >> 2;
  const int c = head * 64 + lane;
  const float* mu = P->in[4] + l * 832;
  const float mur = mu[c], muk = mu[256 + c], muv = mu[512 + c], mux = mu[768 + lane];
  const float w0 = P->in[5][l * 256 + c], a0 = P->in[7][l * 256 + c];
  const float kkw = P->in[9][l * 256 + c], kaw = P->in[10][l * 256 + c], rkw = P->in[11][l * 256 + c];
  float wup[32], aup[32];
#pragma unroll
  for (int j = 0; j < 32; ++j) { wup[j] = P->in[6][(l * 32 + j) * 256 + c]; aup[j] = P->in[8][(l * 32 + j) * 256 + c]; }
  bf16_t raw[4][8];
#define PREP_LOAD(g) { _Pragma("unroll") for (int j_ = 0; j_ < 4; ++j_) { const int t_ = item * 32 + sub + 2 * ((g) * 4 + j_); const bool hp_ = (t_ & (TSEQ - 1)) > 0; \
      const bf16_t* pr_ = p + (size_t)t_ * NIN; raw[j_][0] = pr_[c]; raw[j_][1] = pr_[256 + c]; raw[j_][2] = pr_[512 + c]; raw[j_][3] = pr_[768 + lane]; \
      raw[j_][4] = hp_ ? pr_[c - NIN] : (bf16_t)0; raw[j_][5] = hp_ ? pr_[256 + c - NIN] : (bf16_t)0; raw[j_][6] = hp_ ? pr_[512 + c - NIN] : (bf16_t)0; raw[j_][7] = hp_ ? pr_[768 + lane - NIN] : (bf16_t)0; } }
  PREP_LOAD(0);
#pragma unroll 1
  for (int g = 0; g < 4; ++g) {
    float rr[4], kk4[4], vv4[4];
#pragma unroll
    for (int j = 0; j < 4; ++j) {
      float r = bf2f(raw[j][0]), k = bf2f(raw[j][1]), v = bf2f(raw[j][2]), x = bf2f(raw[j][3]);
      r += (bf2f(raw[j][4]) - r) * mur; k += (bf2f(raw[j][5]) - k) * muk; v += (bf2f(raw[j][6]) - v) * muv; x += (bf2f(raw[j][7]) - x) * mux;
      rr[j] = r; kk4[j] = k; vv4[j] = v;
      lora[(w * 4 + j) * 64 + lane] = lane < 32 ? tanhf(x) : x;
    }
    if (g < 3) PREP_LOAD(g + 1);
    __builtin_amdgcn_s_waitcnt(0xc07f);
    __builtin_amdgcn_wave_barrier();
#pragma unroll
    for (int j = 0; j < 4; ++j) {
      const int t = item * 32 + sub + 2 * (g * 4 + j);
      const int tt = t & (TSEQ - 1), b = t >> 13;
      const float r = rr[j], k = kk4[j], v = vv4[j];
      float wv = w0, av = a0;
      const float* lo = lora + (w * 4 + j) * 64;
#pragma unroll
      for (int jj = 0; jj < 32; ++jj) { wv += lo[jj] * wup[jj]; av += lo[32 + jj] * aup[jj]; }
      const float wlog = -softplusf_(-wv) - 0.5f;
      const float decay = __expf(-__expf(wlog));
      const float ar = sigmoidf_(av);
      const float kk = k * kkw;
      const float n2 = wave_sum(kk * kk, lane);
      const float kkn = kk / fmaxf(sqrtf(n2), 1e-12f);
      const float kmod = k * (1.0f + (ar - 1.0f) * kaw);
      const float rk = wave_sum(r * kmod * rkw, lane);
      const size_t idx = (size_t)(b * 4 + head) * TSEQ + tt;
      PW[idx * 64 + lane] = decay;
      bf16_t* pv = PV + idx * 320;
      pv[lane] = f2bf(r); pv[64 + lane] = f2bf(kmod); pv[128 + lane] = f2bf(v); pv[192 + lane] = f2bf(-kkn); pv[256 + lane] = f2bf(kkn * ar);
      if (lane == 0) RK[idx] = rk;
    }
    __builtin_amdgcn_s_waitcnt(0xc07f);
    __builtin_amdgcn_wave_barrier();
  }
#undef PREP_LOAD
  __syncthreads();
}

#define RW_TILE_B (RW_TT * 1536)
struct RwRegs { float4 pw; uint4 pv0, pv1; };
__device__ __forceinline__ void rw_issue(const float* __restrict__ PW, const bf16_t* __restrict__ PV, size_t idx0, int tid, RwRegs& r) {
  if (tid < RW_TT * 16) { const int s = tid >> 4, q = tid & 15; r.pw = *(const float4*)(PW + (idx0 + s) * 64 + q * 4); }
  { const int c = tid; const int s = c / 40, q = c % 40; r.pv0 = *(const uint4*)(PV + (idx0 + s) * 320 + q * 8); }
  if (tid < RW_TT * 40 - NTHR) { const int c = tid + NTHR; const int s = c / 40, q = c % 40; r.pv1 = *(const uint4*)(PV + (idx0 + s) * 320 + q * 8); }
}
__device__ __forceinline__ void rw_put(float* dst, int c, const uint4 u) {
  const int s = c / 40, q = c % 40;
  const int vec = q >> 3, off = (q & 7) * 8;
  const int slot = vec == 0 ? 4 : vec == 1 ? 3 : vec == 2 ? 5 : vec == 3 ? 1 : 2;
  float* d = dst + s * 384 + slot * 64 + off;
  *(float4*)d = make_float4(__uint_as_float(u.x << 16), __uint_as_float(u.x & 0xffff0000u), __uint_as_float(u.y << 16), __uint_as_float(u.y & 0xffff0000u));
  *(float4*)(d + 4) = make_float4(__uint_as_float(u.z << 16), __uint_as_float(u.z & 0xffff0000u), __uint_as_float(u.w << 16), __uint_as_float(u.w & 0xffff0000u));
}
__device__ __forceinline__ void rw_commit(unsigned char* dstb, int tid, const RwRegs& r) {
  float* dst = (float*)dstb;
  if (tid < RW_TT * 16) { const int s = tid >> 4, q = tid & 15; *(float4*)(dst + s * 384 + q * 4) = r.pw; }
  rw_put(dst, tid, r.pv0);
  if (tid < RW_TT * 40 - NTHR) rw_put(dst, tid + NTHR, r.pv1);
}

#define LD8(dst, ptr) { const float4 x0_ = *(const float4*)(ptr), x1_ = *(const float4*)((ptr) + 4); dst[0] = (f32x2){x0_.x, x0_.y}; dst[1] = (f32x2){x0_.z, x0_.w}; dst[2] = (f32x2){x1_.x, x1_.y}; dst[3] = (f32x2){x1_.z, x1_.w}; }
struct RwOps { f32x2 w[4], a[4], b[4], k[4], r[4]; float vA, vB; };
template <int MODE>
__device__ __forceinline__ void rw_ldops(RwOps& o, const float* tb, int s, int q, int rowA, int rowB) {
  const float* sp = tb + s * 384 + q * 8;
  LD8(o.w, sp); LD8(o.a, sp + 64); LD8(o.b, sp + 128); LD8(o.k, sp + 192);
  o.vA = tb[s * 384 + 320 + rowA];
  if (MODE == 0) { LD8(o.r, sp + 256); o.vB = tb[s * 384 + 320 + rowB]; }
}
template <int MODE>
__device__ __forceinline__ void rw_step(const RwOps& o, f32x2 (&SA)[4], f32x2 (&SB)[4], float* yb, int s, int q, int rowA, int rowB) {
  f32x2 dA = SA[0] * o.a[0], dB = SB[0] * o.a[0];
#pragma unroll
  for (int e = 1; e < 4; ++e) { dA = SA[e] * o.a[e] + dA; dB = SB[e] * o.a[e] + dB; }
  const float dotA = red8(dA.x + dA.y), dotB = red8(dB.x + dB.y);
  const f32x2 dA2 = {dotA, dotA}, dB2 = {dotB, dotB}, vA2 = {o.vA, o.vA};
  if (MODE == 0) {
    const f32x2 vB2 = {o.vB, o.vB};
#pragma unroll
    for (int e = 0; e < 4; ++e) { SA[e] = SA[e] * o.w[e] + vA2 * o.k[e]; SA[e] = dA2 * o.b[e] + SA[e]; SB[e] = SB[e] * o.w[e] + vB2 * o.k[e]; SB[e] = dB2 * o.b[e] + SB[e]; }
    f32x2 yA = SA[0] * o.r[0], yB = SB[0] * o.r[0];
#pragma unroll
    for (int e = 1; e < 4; ++e) { yA = SA[e] * o.r[e] + yA; yB = SB[e] * o.r[e] + yB; }
    const float ya = red8(yA.x + yA.y), ybv = red8(yB.x + yB.y);
    if (q == 0) { yb[s * 64 + rowA] = ya; yb[s * 64 + rowB] = ybv; }
  } else {
#pragma unroll
    for (int e = 0; e < 4; ++e) { SA[e] = dA2 * o.b[e] + SA[e] * o.w[e]; SB[e] = SB[e] * o.w[e] + vA2 * o.k[e]; SB[e] = dB2 * o.b[e] + SB[e]; }
  }
}
template <int MODE>
__device__ __forceinline__ void rwkv_scan_item(KP P, int l, int bh, int chunk, unsigned char* lds, int wv_) {
  const float* PW = (const float*)(P->ws + WS_PW); const bf16_t* PV = (const bf16_t*)(P->ws + WS_PV); const float* RK = (const float*)(P->ws + WS_RK);
  float* PQ = (float*)(P->ws + WS_PQ);
  bf16_t* p = (bf16_t*)(P->ws + WS_P);
  const int tid = opaque_tid(wv_), lane = tid & 63, w = tid >> 6;
  const int q = lane & 7;
  const int rowA = (MODE == 0) ? ((w & 3) * 16 + (lane >> 3)) : (w * 8 + (lane >> 3));
  const int rowB = rowA + 8;
  const int b = bh >> 2, head = bh & 3;
  unsigned char* tile0 = lds;
  float* ybuf = (float*)(lds + 3 * RW_TILE_B);
  float* Sl = (float*)(lds + 3 * RW_TILE_B + 2 * RW_TT * 256);
  f32x2 SA[4], SB[4];
#pragma unroll
  for (int e = 0; e < 4; ++e) { SA[e] = (f32x2){0.f, 0.f}; SB[e] = (f32x2){0.f, 0.f}; }
  if (MODE == 1) {
#pragma unroll
    for (int e = 0; e < 4; ++e) SA[e] = (f32x2){(q * 8 + 2 * e == rowA) ? 1.f : 0.f, (q * 8 + 2 * e + 1 == rowA) ? 1.f : 0.f};
  }
  if (MODE == 0 && chunk > 0) {
    const float* Q0 = PQ + ((size_t)(bh * RW_C + 0) * 2 + 1) * 4096;
    float* cur = Sl; float* nxt = Sl + 64 * 65;
    for (int i = tid; i < 1024; i += NTHR) { const float4 v_ = *(const float4*)(Q0 + i * 4); float* d_ = cur + (i >> 4) * 65 + (i & 15) * 4; d_[0] = v_.x; d_[1] = v_.y; d_[2] = v_.z; d_[3] = v_.w; }
    float* Pl = (float*)lds;
    const float4 z4_ = make_float4(0.f, 0.f, 0.f, 0.f); const f32x4 zq_ = {0.f, 0.f, 0.f, 0.f};
    float4 cs0p0 = z4_, cs0p1 = z4_, cs1p0 = z4_, cs1p1 = z4_, cs2p0 = z4_, cs2p1 = z4_, cs3p0 = z4_, cs3p1 = z4_;
    f32x4 cs0q0 = zq_, cs0q1 = zq_, cs1q0 = zq_, cs1q1 = zq_, cs2q0 = zq_, cs2q1 = zq_, cs3q0 = zq_, cs3q1 = zq_;
    const int ti = w >> 1;
    const int qoff0 = 4096 + (ti * 16 + (lane >> 4) * 4) * 64 + ((w & 1) * 2 + 0) * 16 + (lane & 15);
#define CS_LOAD(S_, c_) { const float* Pm_ = PQ + ((size_t)(bh * RW_C + (c_)) * 2 + 0) * 4096; S_##p0 = *(const float4*)(Pm_ + tid * 4); S_##p1 = *(const float4*)(Pm_ + (tid + NTHR) * 4); \
      S_##q0 = (f32x4){Pm_[qoff0], Pm_[qoff0 + 64], Pm_[qoff0 + 128], Pm_[qoff0 + 192]}; S_##q1 = (f32x4){Pm_[qoff0 + 16], Pm_[qoff0 + 80], Pm_[qoff0 + 144], Pm_[qoff0 + 208]}; }
#define CS_STEP(S_, c_) { LBAR(); *(float4*)(Pl + (tid >> 4) * 80 + (tid & 15) * 4) = S_##p0; *(float4*)(Pl + ((tid + NTHR) >> 4) * 80 + (tid & 15) * 4) = S_##p1; const f32x4 qc0 = S_##q0, qc1 = S_##q1; \
      if ((c_) + 4 < chunk) CS_LOAD(S_, (c_) + 4); \
      LBAR(); \
      _Pragma("unroll") for (int jj = 0; jj < 2; ++jj) { const int tj = (w & 1) * 2 + jj; f32x4 acc = jj == 0 ? qc0 : qc1; \
        _Pragma("unroll") for (int ks = 0; ks < 16; ++ks) { const float a = cur[(ti * 16 + (lane & 15)) * 65 + ks * 4 + (lane >> 4)]; const float bb = Pl[(ks * 4 + (lane >> 4)) * 80 + tj * 16 + (lane & 15)]; \
          acc = __builtin_amdgcn_mfma_f32_16x16x4f32(a, bb, acc, 0, 0, 0); } \
        _Pragma("unroll") for (int r = 0; r < 4; ++r) nxt[(ti * 16 + (lane >> 4) * 4 + r) * 65 + tj * 16 + (lane & 15)] = acc[r]; } \
      float* t_ = cur; cur = nxt; nxt = t_; }
    if (1 < chunk) CS_LOAD(cs0, 1);
    if (2 < chunk) CS_LOAD(cs1, 2);
    if (3 < chunk) CS_LOAD(cs2, 3);
    if (4 < chunk) CS_LOAD(cs3, 4);
#pragma unroll 1
    for (int cc = 1; cc < chunk; cc += 4) {
      CS_STEP(cs0, cc);
      if (cc + 1 < chunk) CS_STEP(cs1, cc + 1);
      if (cc + 2 < chunk) CS_STEP(cs2, cc + 2);
      if (cc + 3 < chunk) CS_STEP(cs3, cc + 3);
    }
#undef CS_LOAD
#undef CS_STEP
    __syncthreads();
#pragma unroll
    for (int e = 0; e < 4; ++e) { SA[e] = (f32x2){cur[rowA * 65 + q * 8 + 2 * e], cur[rowA * 65 + q * 8 + 2 * e + 1]}; SB[e] = (f32x2){cur[rowB * 65 + q * 8 + 2 * e], cur[rowB * 65 + q * 8 + 2 * e + 1]}; }
    __syncthreads();
  }
  const size_t idxb = (size_t)bh * TSEQ + (size_t)chunk * RW_CL;
  const int ntile = RW_CL / RW_TT;
  RwRegs rr;
  rw_issue(PW, PV, idxb, tid, rr);
  rw_commit(tile0, tid, rr);
  const int chh = head * 64 + lane;
  const float lng = P->in[12][l * 256 + chh], lnb = P->in[13][l * 256 + chh];
  __syncthreads();
  const int nit = (MODE == 0) ? ntile + 1 : ntile;
  for (int tl = 0; tl < nit; ++tl) {
    if (tl + 1 < ntile) rw_issue(PW, PV, idxb + (size_t)(tl + 1) * RW_TT, tid, rr);
    if (MODE == 1 || w < 4) {
      if (tl < ntile) {
        const float* tb = (const float*)(tile0 + (tl % 3) * RW_TILE_B);
        float* yb = ybuf + (tl & 1) * (RW_TT * 64);
        RwOps oa, ob;
        rw_ldops<MODE>(oa, tb, 0, q, rowA, rowB);
        __builtin_amdgcn_sched_barrier(0);
#pragma unroll 1
        for (int s = 0; s < RW_TT; s += 2) {
          rw_ldops<MODE>(ob, tb, s + 1, q, rowA, rowB);
          __builtin_amdgcn_sched_barrier(0);
          rw_step<MODE>(oa, SA, SB, yb, s, q, rowA, rowB);
          __builtin_amdgcn_sched_barrier(0);
          if (s + 2 < RW_TT) rw_ldops<MODE>(oa, tb, s + 2, q, rowA, rowB);
          __builtin_amdgcn_sched_barrier(0);
          rw_step<MODE>(ob, SA, SB, yb, s + 1, q, rowA, rowB);
          __builtin_amdgcn_sched_barrier(0);
        }
      }
      if (tl + 1 < ntile) rw_commit(tile0 + ((tl + 1) % 3) * RW_TILE_B, tid, rr);
    } else {
      const int fw = w - 4;
      f32x4 gcu = {0.f, 0.f, 0.f, 0.f}, rkcu = {0.f, 0.f, 0.f, 0.f};
      if (tl > 0) {
#pragma unroll
        for (int u = 0; u < 4; ++u) { const int tt = chunk * RW_CL + (tl - 1) * RW_TT + fw + 4 * u;
          gcu[u] = bf2f(p[(size_t)(b * TSEQ + tt) * NIN + C_GA + chh]); rkcu[u] = RK[(size_t)bh * TSEQ + tt]; }
      }
      asm volatile("s_waitcnt vmcnt(0)" ::: "memory");
      if (tl + 1 < ntile) rw_commit(tile0 + ((tl + 1) % 3) * RW_TILE_B, tid, rr);
      __builtin_amdgcn_sched_barrier(0);
      if (tl > 0) {
        const float* tb = (const float*)(tile0 + ((tl - 1) % 3) * RW_TILE_B);
        const float* yb = ybuf + ((tl - 1) & 1) * (RW_TT * 64);
#pragma unroll
        for (int u = 0; u < 4; ++u) {
          const int s = fw + 4 * u;
          const int tt = chunk * RW_CL + (tl - 1) * RW_TT + s;
          const float y = yb[s * 64 + lane];
          const float mean = wave_sum(y, lane) * (1.0f / 64.0f);
          const float dlt = y - mean;
          const float var = wave_sum(dlt * dlt, lane) * (1.0f / 64.0f);
          float o = dlt * rsqrtf(var + 64e-5f) * lng + lnb;
          const float vv = tb[s * 384 + 320 + lane];
          o += rkcu[u] * vv;
          p[(size_t)(b * TSEQ + tt) * NIN + C_GA + chh] = f2bf(o * siluf_(gcu[u]));
        }
      }
    }
    LBAR();
  }
  if (MODE == 1) {
    float* Pm = PQ + ((size_t)(bh * RW_C + chunk) * 2 + 0) * 4096 + rowA * 64 + q * 8;
    *(float4*)Pm = make_float4(SA[0].x, SA[0].y, SA[1].x, SA[1].y); *(float4*)(Pm + 4) = make_float4(SA[2].x, SA[2].y, SA[3].x, SA[3].y);
    *(float4*)(Pm + 4096) = make_float4(SB[0].x, SB[0].y, SB[1].x, SB[1].y); *(float4*)(Pm + 4100) = make_float4(SB[2].x, SB[2].y, SB[3].x, SB[3].y);
  } else if (chunk == 0 && w < 4) {
    float* Qm = PQ + ((size_t)(bh * RW_C + 0) * 2 + 1) * 4096 + q * 8;
    *(float4*)(Qm + rowA * 64) = make_float4(SA[0].x, SA[0].y, SA[1].x, SA[1].y); *(float4*)(Qm + rowA * 64 + 4) = make_float4(SA[2].x, SA[2].y, SA[3].x, SA[3].y);
    *(float4*)(Qm + rowB * 64) = make_float4(SB[0].x, SB[0].y, SB[1].x, SB[1].y); *(float4*)(Qm + rowB * 64 + 4) = make_float4(SB[2].x, SB[2].y, SB[3].x, SB[3].y);
  }
  __syncthreads();
}

__device__ __forceinline__ void conv_item(KP P, int l, int item, unsigned char* lds, int wv_) {
#ifdef OFF_conv_item
  return;
#endif

  bf16_t* p = (bf16_t*)(P->ws + WS_P);
  float* u = (float*)lds;
  float* yb = (float*)(lds + 62 * 1024);
  const int tid = opaque_tid(wv_), c = tid & 255, half = tid >> 8;
  const int t0 = item * 32, tt0 = t0 & (TSEQ - 1);
  {
    bf16_t rv[31], rg[31];
#pragma unroll
    for (int i = 0; i < 31; ++i) { const int r = half + 2 * i; const bool ok = (tt0 - 30 + r) >= 0; const bf16_t* pr = p + (size_t)(t0 - 30 + r) * NIN;
      rv[i] = ok ? pr[C_CVAL + c] : (bf16_t)0; rg[i] = ok ? pr[C_CGLU + c] : (bf16_t)0; }
#pragma unroll
    for (int i = 0; i < 31; ++i) u[(half + 2 * i) * 256 + c] = bf2f(rv[i]) * sigmoidf_(bf2f(rg[i]));
  }
  float wv[31];
#pragma unroll
  for (int j = 0; j < 31; ++j) wv[j] = P->in[14][(l * 31 + j) * 256 + c];
  const float bias = P->in[15][l * 256 + c];
  __syncthreads();
  {
    float win[46];
#pragma unroll
    for (int i = 0; i < 46; ++i) win[i] = u[(half * 16 + i) * 256 + c];
#pragma unroll
    for (int i = 0; i < 16; ++i) {
      float acc = bias;
#pragma unroll
      for (int j = 0; j < 31; ++j) acc = fmaf(wv[j], win[i + j], acc);
      yb[(half * 16 + i) * 256 + c] = acc;
    }
  }
  __syncthreads();
  const int lane = tid & 63, w = tid >> 6;
  const float4 g = *(const float4*)(P->in[16] + l * 256 + lane * 4), bb = *(const float4*)(P->in[17] + l * 256 + lane * 4);
  uint2 gpre[4];
#pragma unroll
  for (int i = 0; i < 4; ++i) gpre[i] = *(const uint2*)(p + (size_t)(t0 + w * 4 + i) * NIN + C_CGATE + lane * 4);
#pragma unroll
  for (int i = 0; i < 4; ++i) {
    const int tk = w * 4 + i;
    const float4 v = *(const float4*)(yb + tk * 256 + lane * 4);
    const float mean = wave_sum(v.x + v.y + v.z + v.w, lane) * (1.0f / 256.0f);
    const float d0 = v.x - mean, d1 = v.y - mean, d2 = v.z - mean, d3 = v.w - mean;
    const float var = wave_sum(d0 * d0 + d1 * d1 + d2 * d2 + d3 * d3, lane) * (1.0f / 256.0f);
    const float rs = rsqrtf(var + 1e-5f);
    bf16_t* gp = p + (size_t)(t0 + tk) * NIN + C_CGATE + lane * 4;
    const uint2 gu = gpre[i];
    const float o0 = siluf_(d0 * rs * g.x + bb.x) * siluf_(__uint_as_float(gu.x << 16));
    const float o1 = siluf_(d1 * rs * g.y + bb.y) * siluf_(__uint_as_float(gu.x & 0xffff0000u));
    const float o2 = siluf_(d2 * rs * g.z + bb.z) * siluf_(__uint_as_float(gu.y << 16));
    const float o3 = siluf_(d3 * rs * g.w + bb.w) * siluf_(__uint_as_float(gu.y & 0xffff0000u));
    uint2 o; o.x = pack2(o0, o1); o.y = pack2(o2, o3);
    *(uint2*)gp = o;
  }
  __syncthreads();
}

#define HG_WLDS 10240
__device__ __forceinline__ float hgrn_lb(KP P, int l, int ch) {
  if (l == 0) return 0.f;
  const float x0 = P->in[18][ch], x1 = P->in[18][256 + ch];
  return __builtin_amdgcn_rcpf(1.0f + __expf(x0 - x1));
}
template <int PASS>
__device__ __forceinline__ void hgrn_wave_item(KP P, int l, int wi, unsigned char* lds, int wv_) {
#ifdef OFF_hgrn_wave_item
  return;
#endif

  bf16_t* p = (bf16_t*)(P->ws + WS_P);
  float* HS = (float*)(P->ws + WS_HS); float* HF = (float*)(P->ws + WS_HF);
  const int tid = opaque_tid(wv_);
  const int lane = tid & 63, w = tid >> 6;
  const int bh = wi >> 7, chunk = wi & 127, b = bh >> 2, head = bh & 3;
  float* st = (float*)(lds + w * HG_WLDS);
  float* ob = st + 2048;
  const int kg = lane & 7, vg = lane >> 3;
  const int ch = head * 64 + lane;
  const float lb = hgrn_lb(P, l, ch);
  const float ng = P->in[19][l * 256 + ch];
  float S[8][8];
  float* slot = HS + (size_t)(bh * 128 + chunk) * 4096;
  if (PASS == 1) {
#pragma unroll
    for (int i = 0; i < 8; ++i) { const float4 x0 = *(const float4*)(slot + (kg * 8 + i) * 64 + vg * 8), x1 = *(const float4*)(slot + (kg * 8 + i) * 64 + vg * 8 + 4);
      S[i][0] = x0.x; S[i][1] = x0.y; S[i][2] = x0.z; S[i][3] = x0.w; S[i][4] = x1.x; S[i][5] = x1.y; S[i][6] = x1.z; S[i][7] = x1.w; }
  } else {
#pragma unroll
    for (int i = 0; i < 8; ++i)
#pragma unroll
      for (int j = 0; j < 8; ++j) S[i][j] = 0.f;
  }
  float Fp = 1.f;
  bf16_t rf[8], ri[8], rq[8], rg[8];
  {
    const int tb0 = b * TSEQ + chunk * 64;
#pragma unroll
    for (int s = 0; s < 8; ++s) { const bf16_t* pr = p + (size_t)(tb0 + s) * NIN; rf[s] = pr[C_HF + ch]; ri[s] = pr[C_HI + ch]; if (PASS == 1) { rq[s] = pr[C_HQ + ch]; rg[s] = pr[C_HG + ch]; } }
  }
#pragma unroll 1
  for (int sub = 0; sub < 8; ++sub) {
    const int tbase = b * TSEQ + chunk * 64 + sub * 8;
    bf16_t gc[8];
#pragma unroll
    for (int s = 0; s < 8; ++s) {
      const float f = lb + (1.0f - lb) * sigmoidf_(bf2f(rf[s]));
      Fp *= f;
      st[s * 256 + lane] = f; st[s * 256 + 64 + lane] = 1.0f - f;
      if (PASS == 1) { st[s * 256 + 128 + lane] = siluf_(bf2f(rq[s])); gc[s] = rg[s]; }
      st[s * 256 + 192 + lane] = bf2f(ri[s]);
    }
    if (sub < 7) {
#pragma unroll
      for (int s = 0; s < 8; ++s) { const bf16_t* pr = p + (size_t)(tbase + 8 + s) * NIN; rf[s] = pr[C_HF + ch]; ri[s] = pr[C_HI + ch]; if (PASS == 1) { rq[s] = pr[C_HQ + ch]; rg[s] = pr[C_HG + ch]; } }
    }
    __builtin_amdgcn_s_waitcnt(0xc07f);
    __builtin_amdgcn_wave_barrier();
#pragma unroll 1
    for (int s = 0; s < 8; ++s) {
      const float* sp = st + s * 256;
      const float4 f0 = *(const float4*)(sp + kg * 8), f1 = *(const float4*)(sp + kg * 8 + 4);
      const float4 k0 = *(const float4*)(sp + 64 + kg * 8), k1 = *(const float4*)(sp + 64 + kg * 8 + 4);
      const float4 v0 = *(const float4*)(sp + 192 + vg * 8), v1 = *(const float4*)(sp + 192 + vg * 8 + 4);
      const float fv[8] = {f0.x, f0.y, f0.z, f0.w, f1.x, f1.y, f1.z, f1.w};
      const float kv[8] = {k0.x, k0.y, k0.z, k0.w, k1.x, k1.y, k1.z, k1.w};
      const float vv[8] = {v0.x, v0.y, v0.z, v0.w, v1.x, v1.y, v1.z, v1.w};
#pragma unroll
      for (int i = 0; i < 8; ++i)
#pragma unroll
        for (int j = 0; j < 8; ++j) S[i][j] = fmaf(fv[i], S[i][j], kv[i] * vv[j]);
      if (PASS == 1) {
        const float4 q0 = *(const float4*)(sp + 128 + kg * 8), q1 = *(const float4*)(sp + 128 + kg * 8 + 4);
        const float qv[8] = {q0.x, q0.y, q0.z, q0.w, q1.x, q1.y, q1.z, q1.w};
        float o[8];
#pragma unroll
        for (int j = 0; j < 8; ++j) { float a = qv[0] * S[0][j];
#pragma unroll
          for (int i = 1; i < 8; ++i) a = fmaf(qv[i], S[i][j], a);
          o[j] = red8(a); }
        if (kg == 0) { *(float4*)(ob + s * 64 + vg * 8) = make_float4(o[0], o[1], o[2], o[3]); *(float4*)(ob + s * 64 + vg * 8 + 4) = make_float4(o[4], o[5], o[6], o[7]); }
      }
    }
    __builtin_amdgcn_s_waitcnt(0xc07f);
    __builtin_amdgcn_wave_barrier();
    if (PASS == 1) {
#pragma unroll
      for (int s = 0; s < 8; ++s) {
        const float o = ob[s * 64 + lane];
        const float ms = wave_sum(o * o, lane) * (1.0f / 64.0f);
        p[(size_t)(tbase + s) * NIN + C_HG + ch] = f2bf(o * rsqrtf(ms + 1e-6f) * ng * siluf_(bf2f(gc[s])));
      }
      __builtin_amdgcn_s_waitcnt(0xc07f);
      __builtin_amdgcn_wave_barrier();
    }
  }
  if (PASS == 0) {
#pragma unroll
    for (int i = 0; i < 8; ++i) { *(float4*)(slot + (kg * 8 + i) * 64 + vg * 8) = make_float4(S[i][0], S[i][1], S[i][2], S[i][3]);
      *(float4*)(slot + (kg * 8 + i) * 64 + vg * 8 + 4) = make_float4(S[i][4], S[i][5], S[i][6], S[i][7]); }
    HF[(size_t)(bh * 128 + chunk) * 64 + lane] = Fp;
  }
}
__device__ __forceinline__ void hgrn_combine_item(KP P, int bh, int wv_) {
#ifdef OFF_hgrn_combine_item
  return;
#endif

  float* HS = (float*)(P->ws + WS_HS); const float* HF = (const float*)(P->ws + WS_HF);
  const int tid = opaque_tid(wv_);
  const int krow = tid >> 3;
  float R[8];
#pragma unroll
  for (int e = 0; e < 8; ++e) R[e] = 0.f;
  float4 xa[8][2]; float fa[8];
#pragma unroll
  for (int u = 0; u < 8; ++u) { const float* sl = HS + (size_t)(bh * 128 + u) * 4096 + tid * 8; xa[u][0] = *(const float4*)sl; xa[u][1] = *(const float4*)(sl + 4); fa[u] = HF[(size_t)(bh * 128 + u) * 64 + krow]; }
#pragma unroll 1
  for (int c0 = 0; c0 < 128; c0 += 8) {
    float4 xn[8][2]; float fn[8];
    if (c0 + 8 < 128) {
#pragma unroll
      for (int u = 0; u < 8; ++u) { const float* sl = HS + (size_t)(bh * 128 + c0 + 8 + u) * 4096 + tid * 8; xn[u][0] = *(const float4*)sl; xn[u][1] = *(const float4*)(sl + 4); fn[u] = HF[(size_t)(bh * 128 + c0 + 8 + u) * 64 + krow]; }
    }
#pragma unroll
    for (int u = 0; u < 8; ++u) {
      float* sl = HS + (size_t)(bh * 128 + c0 + u) * 4096 + tid * 8;
      *(float4*)sl = make_float4(R[0], R[1], R[2], R[3]); *(float4*)(sl + 4) = make_float4(R[4], R[5], R[6], R[7]);
      const float f = fa[u];
      R[0] = fmaf(f, R[0], xa[u][0].x); R[1] = fmaf(f, R[1], xa[u][0].y); R[2] = fmaf(f, R[2], xa[u][0].z); R[3] = fmaf(f, R[3], xa[u][0].w);
      R[4] = fmaf(f, R[4], xa[u][1].x); R[5] = fmaf(f, R[5], xa[u][1].y); R[6] = fmaf(f, R[6], xa[u][1].z); R[7] = fmaf(f, R[7], xa[u][1].w);
    }
    if (c0 + 8 < 128) {
#pragma unroll
      for (int u = 0; u < 8; ++u) { xa[u][0] = xn[u][0]; xa[u][1] = xn[u][1]; fa[u] = fn[u]; }
    }
  }
}

__device__ __forceinline__ void sb_item(KP P, int item, unsigned char* lds, int wv_) {
#ifdef OFF_sb_item
  return;
#endif

  bf16_t* p = (bf16_t*)(P->ws + WS_P);
  const int tid = opaque_tid(wv_), lane = tid & 63, w = tid >> 6;
  const int qt = item & 127, bh = item >> 7, b = bh >> 2, head = bh & 3;
  unsigned char* Qs = lds;
  unsigned char* Ks = lds + 9216;
  unsigned char* Vt = lds + 18432;
  unsigned char* As = lds + 27648;
  float* Zs = (float*)(lds + 36864);
  volatile int* flag = (volatile int*)(lds + 36864 + 64 * 65 * 4);
  const int lrow = tid >> 3, lch = (tid & 7);
  const size_t tokq = (size_t)b * TSEQ + qt * 64;
  *(uint4*)(Qs + lrow * 144 + lch * 16) = *(const uint4*)(p + (tokq + lrow) * NIN + C_SQ + head * 64 + lch * 8);
  float carry = 0.f;
  f32x4 oacc[2] = {{0.f, 0.f, 0.f, 0.f}, {0.f, 0.f, 0.f, 0.f}};
  const int qi = w >> 1, t2 = (w & 1) * 2;
  const int q = tid >> 3, seg = tid & 7;
  uint4 kreg = *(const uint4*)(p + (tokq + lrow) * NIN + C_SK + head * 64 + lch * 8);
  uint4 vreg = *(const uint4*)(p + (tokq + lrow) * NIN + C_SV + head * 64 + lch * 8);
  for (int kt = qt; kt >= 0; --kt) {
    LBAR();
    *(uint4*)(Ks + lrow * 144 + lch * 16) = kreg;
    { const unsigned vw[4] = {vreg.x, vreg.y, vreg.z, vreg.w};
#pragma unroll
      for (int e = 0; e < 8; ++e) *(unsigned short*)(Vt + (lch * 8 + e) * 144 + lrow * 2) = (unsigned short)((e & 1) ? (vw[e >> 1] >> 16) : (vw[e >> 1] & 0xffffu)); }
    if (tid == 0) *flag = 0;
    if (kt > 0) { const size_t tokn = (size_t)b * TSEQ + (kt - 1) * 64;
      kreg = *(const uint4*)(p + (tokn + lrow) * NIN + C_SK + head * 64 + lch * 8);
      vreg = *(const uint4*)(p + (tokn + lrow) * NIN + C_SV + head * 64 + lch * 8); }
    LBAR();
#pragma unroll
    for (int jj = 0; jj < 2; ++jj) {
      const int ki = t2 + jj;
      f32x4 acc = {0.f, 0.f, 0.f, 0.f};
#pragma unroll
      for (int s = 0; s < 2; ++s) {
        const bf16x8 a = *(const bf16x8*)(Qs + (qi * 16 + (lane & 15)) * 144 + s * 64 + (lane >> 4) * 16);
        const bf16x8 bb = *(const bf16x8*)(Ks + (ki * 16 + (lane & 15)) * 144 + s * 64 + (lane >> 4) * 16);
        acc = __builtin_amdgcn_mfma_f32_16x16x32_bf16(a, bb, acc, 0, 0, 0);
      }
#pragma unroll
      for (int r = 0; r < 4; ++r) Zs[(qi * 16 + (lane >> 4) * 4 + r) * 65 + ki * 16 + (lane & 15)] = acc[r] * 0.125f;
    }
    LBAR();
    {
      const int tq = qt * 64 + q;
      float z[8], lk[8];
      float tot = 0.f;
#pragma unroll
      for (int e = 0; e < 8; ++e) {
        z[e] = Zs[q * 65 + seg * 8 + e];
        const bool m = (kt * 64 + seg * 8 + e) < tq;
        lk[e] = m ? -softplus_fast(z[e]) : 0.f;
        tot += lk[e];
      }
      float inc = tot;
      { float t_ = bperm(inc, lane + 1); if (seg + 1 < 8) inc += t_; }
      { float t_ = bperm(inc, lane + 2); if (seg + 2 < 8) inc += t_; }
      { float t_ = bperm(inc, lane + 4); if (seg + 4 < 8) inc += t_; }
      const float rowtot = bperm(inc, lane & ~7);
      float tail = carry + (inc - tot);
      float av[8];
#pragma unroll
      for (int e = 7; e >= 0; --e) {
        const bool m = (kt * 64 + seg * 8 + e) < tq;
        av[e] = m ? __expf(z[e] + lk[e] + tail) : 0.f;
        tail += lk[e];
      }
      uint4 o; o.x = pack2(av[0], av[1]); o.y = pack2(av[2], av[3]); o.z = pack2(av[4], av[5]); o.w = pack2(av[6], av[7]);
      *(uint4*)(As + q * 144 + seg * 16) = o;
      carry += rowtot;
      if (carry > -100.f) *flag = 1;
    }
    LBAR();
#pragma unroll
    for (int jj = 0; jj < 2; ++jj) {
      const int di = t2 + jj;
#pragma unroll
      for (int s = 0; s < 2; ++s) {
        const bf16x8 a = *(const bf16x8*)(As + (qi * 16 + (lane & 15)) * 144 + s * 64 + (lane >> 4) * 16);
        const bf16x8 bb = *(const bf16x8*)(Vt + (di * 16 + (lane & 15)) * 144 + s * 64 + (lane >> 4) * 16);
        oacc[jj] = __builtin_amdgcn_mfma_f32_16x16x32_bf16(a, bb, oacc[jj], 0, 0, 0);
      }
    }
    if (*flag == 0) break;
  }
#pragma unroll
  for (int jj = 0; jj < 2; ++jj) {
    const int d = (t2 + jj) * 16 + (lane & 15);
#pragma unroll
    for (int r = 0; r < 4; ++r) {
      const int qq = qi * 16 + (lane >> 4) * 4 + r;
      bf16_t* gp = p + (tokq + qq) * NIN + C_SG + head * 64 + d;
      *gp = f2bf(oacc[jj][r] * siluf_(bf2f(*gp)));
    }
  }
  __syncthreads();
}

__device__ __forceinline__ void xattn_item(KP P, int l, int item, unsigned char* lds, int wv_) {
#ifdef OFF_xattn_item
  return;
#endif

  const bf16_t* qb = (const bf16_t*)(P->ws + WS_P + 32ull * MiB);
  bf16_t* ob = (bf16_t*)(P->ws + WS_P + 64ull * MiB);
  const bf16_t* kv = (const bf16_t*)(P->ws + WS_KV) + (size_t)l * 512 * 2048;
  const int tid = opaque_tid(wv_), lane = tid & 63, w = tid >> 6;
  const int qt = item & 127, bh = item >> 7, b = bh >> 2, head = bh & 3;
  unsigned char* Qs = lds;
  unsigned char* KVs = lds + 33792;
  float* Ss = (float*)(lds + 67584);
  const size_t tok0 = (size_t)b * TSEQ + qt * 64;
  __syncthreads();
#pragma unroll
  for (int i = 0; i < 4; ++i) { const int c = tid + i * NTHR, r = c >> 5, cc = c & 31;
    *(uint4*)(Qs + r * 528 + cc * 16) = *(const uint4*)(qb + (tok0 + r) * 1024 + head * 256 + cc * 8); }
  const int qi = w >> 1, t2 = (w & 1) * 2;
  for (int kb = 0; kb < 4; ++kb) {
    __syncthreads();
#pragma unroll
    for (int i = 0; i < 4; ++i) { const int c = tid + i * NTHR, r = c >> 5, cc = c & 31;
      *(uint4*)(KVs + r * 528 + cc * 16) = *(const uint4*)(kv + (size_t)(b * 256 + kb * 64 + r) * 2048 + head * 256 + cc * 8); }
    __syncthreads();
#pragma unroll
    for (int jj = 0; jj < 2; ++jj) {
      const int ki = t2 + jj;
      f32x4 acc = {0.f, 0.f, 0.f, 0.f};
#pragma unroll
      for (int s = 0; s < 8; ++s) {
        const bf16x8 a = *(const bf16x8*)(Qs + (qi * 16 + (lane & 15)) * 528 + s * 64 + (lane >> 4) * 16);
        const bf16x8 bb = *(const bf16x8*)(KVs + (ki * 16 + (lane & 15)) * 528 + s * 64 + (lane >> 4) * 16);
        acc = __builtin_amdgcn_mfma_f32_16x16x32_bf16(a, bb, acc, 0, 0, 0);
      }
#pragma unroll
      for (int r = 0; r < 4; ++r) Ss[(qi * 16 + (lane >> 4) * 4 + r) * 260 + kb * 64 + ki * 16 + (lane & 15)] = acc[r] * 0.0625f;
    }
  }
  __syncthreads();
  {
    const int q = tid >> 3, seg = tid & 7;
    float x[32]; float mx = -3.0e38f;
#pragma unroll
    for (int i = 0; i < 8; ++i) { const float4 v = *(const float4*)(Ss + q * 260 + seg * 32 + i * 4); x[i * 4] = v.x; x[i * 4 + 1] = v.y; x[i * 4 + 2] = v.z; x[i * 4 + 3] = v.w;
      mx = fmaxf(mx, fmaxf(fmaxf(v.x, v.y), fmaxf(v.z, v.w))); }
    mx = max8(mx);
    float sum = 0.f;
#pragma unroll
    for (int i = 0; i < 32; ++i) { x[i] = __expf(x[i] - mx); sum += x[i]; }
    sum = red8(sum);
    const float inv = __builtin_amdgcn_rcpf(sum);
#pragma unroll
    for (int i = 0; i < 4; ++i) { uint4 o; o.x = pack2(x[i * 8] * inv, x[i * 8 + 1] * inv); o.y = pack2(x[i * 8 + 2] * inv, x[i * 8 + 3] * inv);
      o.z = pack2(x[i * 8 + 4] * inv, x[i * 8 + 5] * inv); o.w = pack2(x[i * 8 + 6] * inv, x[i * 8 + 7] * inv);
      *(uint4*)(Qs + q * 528 + seg * 64 + i * 16) = o; }
  }
  for (int db = 0; db < 4; ++db) {
    __syncthreads();
#pragma unroll
    for (int i = 0; i < 4; ++i) { const int c = tid + i * NTHR, m = c >> 3, dc = c & 7;
      const uint4 vv = *(const uint4*)(kv + (size_t)(b * 256 + m) * 2048 + 1024 + head * 256 + db * 64 + dc * 8);
      const unsigned short* ve = (const unsigned short*)&vv;
#pragma unroll
      for (int e = 0; e < 8; ++e) *(unsigned short*)(KVs + (dc * 8 + e) * 528 + m * 2) = ve[e]; }
    __syncthreads();
#pragma unroll
    for (int jj = 0; jj < 2; ++jj) {
      const int di = t2 + jj;
      f32x4 acc = {0.f, 0.f, 0.f, 0.f};
#pragma unroll
      for (int s = 0; s < 8; ++s) {
        const bf16x8 a = *(const bf16x8*)(Qs + (qi * 16 + (lane & 15)) * 528 + s * 64 + (lane >> 4) * 16);
        const bf16x8 bb = *(const bf16x8*)(KVs + (di * 16 + (lane & 15)) * 528 + s * 64 + (lane >> 4) * 16);
        acc = __builtin_amdgcn_mfma_f32_16x16x32_bf16(a, bb, acc, 0, 0, 0);
      }
#pragma unroll
      for (int r = 0; r < 4; ++r) ob[(tok0 + qi * 16 + (lane >> 4) * 4 + r) * 1024 + head * 256 + db * 64 + di * 16 + (lane & 15)] = f2bf(acc[r]);
    }
  }
  __syncthreads();
}

__device__ __forceinline__ int next_item(unsigned* ctr, volatile LAS int* slot, int wv_) {
  __syncthreads();
  if (opaque_tid(wv_) == 0) *slot = (int)__hip_atomic_fetch_add(ctr, 1u, __ATOMIC_RELAXED, __HIP_MEMORY_SCOPE_AGENT);
  __syncthreads();
  return *slot;
}
__global__ void __launch_bounds__(NTHR) fwd_megakernel(Params Pk_unused) {
  KP P = (KP)__builtin_amdgcn_kernarg_segment_ptr();
  extern __shared__ __attribute__((aligned(16))) unsigned char lds[];
  const int wv_ = __builtin_amdgcn_readfirstlane((int)threadIdx.x >> 6);
  __shared__ uint4 xb_words;
  __shared__ int4 wq_slot;
  if (opaque_tid(wv_) == 0) xb_words = make_uint4(0u, 0u, 0u, 0u);
  __syncthreads();
#ifdef PROBE_J
  __shared__ unsigned long long tacc[32];
  __shared__ unsigned long long tlast;
  __shared__ float pdelta;
  if (opaque_tid(wv_) == 0) { for (int i = 0; i < 32; ++i) tacc[i] = 0ull; tlast = __builtin_amdgcn_s_memrealtime(); pdelta = 0.f; }
#define STAMP(k) if (opaque_tid(wv_) == 0) { const unsigned long long n_ = __builtin_amdgcn_s_memrealtime(); tacc[k] += n_ - tlast; tlast = n_; }
#else
#define STAMP(k)
#endif
  XcdBarrier bar = xcd_barrier_post((unsigned*)(P->ws + WS_BAR), (volatile LAS unsigned*)&xb_words, wv_);
  if (P->never) cg::this_grid().sync();
  const int G = gridDim.x, bid0 = blockIdx.x;

  for (int it = bid0; it < 2 * 2256; it += G) {
    const int l = it / 2256; int r = it % 2256;
    const float* W; int N; bf16_t* Wt; int kt, nt;
    unsigned char* wl = P->ws + WS_WT + l * WT_LAYER;
    if (r < 976) { W = P->in[3] + (size_t)l * 1024 * NIN; N = NIN; Wt = (bf16_t*)(wl + WT_IN); kt = r / 61; nt = r % 61; }
    else { r -= 976; const int m = r >> 8; r &= 255; kt = r >> 4; nt = r & 15; N = 1024;
      if (m == 0) { W = P->in[20] + (size_t)l * 1048576; Wt = (bf16_t*)(wl + WT_OUT); }
      else if (m == 1) { W = P->in[23] + (size_t)l * 1048576; Wt = (bf16_t*)(wl + WT_Q); }
      else if (m == 2) { W = P->in[24] + (size_t)l * 1048576; Wt = (bf16_t*)(wl + WT_KV); }
      else if (m == 3) { W = P->in[25] + (size_t)l * 1048576; Wt = (bf16_t*)(wl + WT_KV) + 1024 * 1024; }
      else { W = P->in[26] + (size_t)l * 1048576; Wt = (bf16_t*)(wl + WT_O); } }
    wt_tile(W, N, Wt, kt, nt, lds, wv_);
  }
#pragma unroll 1
  for (int k = 0; k < 3; ++k) {
    const float* s_ = k < 2 ? P->in[1] : P->in[0];
    const float* g_ = k < 2 ? P->in[22] + k * 1024 : P->in[2];
    bf16_t* d_ = k < 2 ? (bf16_t*)(P->ws + WS_MEMN) + k * 512 * 1024 : (bf16_t*)(P->ws + WS_R1);
    norm_rows(false, s_, g_, d_, k < 2 ? 512 : NT, 0.f, wv_);
  }
  STAMP(16 + 10); xcd_barrier(bar, wv_); STAMP(10)
  asm volatile("" : "+s"(P));

#pragma unroll 1
  for (int it = 0; it < 20; ++it) {
    int l = it / 10, ph = it % 10;
    asm volatile("" : "+s"(P));
    int bid = bid0; asm volatile("" : "+s"(bid));

    unsigned char* ws = P->ws;
    const unsigned char* wl = ws + WS_WT + l * WT_LAYER;
    bf16_t* hbuf = (bf16_t*)(ws + WS_R1);
    bf16_t* pbuf = (bf16_t*)(ws + WS_P);
    bf16_t* hx = (bf16_t*)(ws + WS_P);
    bf16_t* qbuf = (bf16_t*)(ws + WS_P + 32ull * MiB);
    bf16_t* obuf = (bf16_t*)(ws + WS_P + 64ull * MiB);
    if (ph == 0 || ph == 4 || ph == 6 || ph == 8) {
      pg8::Gemm g; pg8::TileSched S; pg8::EpiDyn E;
      g.M = NT; g.K = 1024; S.G = G; S.c = bid;
      if (ph == 0) { g.A = hbuf; g.Bt = (const bf16_t*)(wl + WT_IN); g.N = 4096; g.lda = 1024; g.ao0 = 0; g.ao1 = 256; g.ao2 = 512; g.ao3 = 768; S.nt = 1024; S.nN = 16;
        E.mode = 0; E.O = pbuf; E.ldc = NIN; E.N = NIN; E.resid = nullptr; E.out = nullptr; }
      else if (ph == 4) { g.A = pbuf; g.Bt = (const bf16_t*)(wl + WT_OUT); g.N = 1024; g.lda = NIN; g.ao0 = C_GA; g.ao1 = C_CGATE; g.ao2 = C_HG; g.ao3 = C_SG; S.nt = 256; S.nN = 4;
        E.mode = 1; E.O = nullptr; E.ldc = 1024; E.N = 1024; E.resid = (l == 0) ? P->in[0] : P->out; E.out = P->out; }
      else if (ph == 6) { g.A = hx; g.Bt = (const bf16_t*)(wl + WT_Q); g.N = 1024; g.lda = 1024; g.ao0 = 0; g.ao1 = 256; g.ao2 = 512; g.ao3 = 768; S.nt = 256; S.nN = 4;
        E.mode = 0; E.O = qbuf; E.ldc = 1024; E.N = 1024; E.resid = nullptr; E.out = nullptr; }
      else { g.A = obuf; g.Bt = (const bf16_t*)(wl + WT_O); g.N = 1024; g.lda = 1024; g.ao0 = 0; g.ao1 = 256; g.ao2 = 512; g.ao3 = 768; S.nt = 256; S.nN = 4;
        E.mode = 1; E.O = nullptr; E.ldc = 1024; E.N = 1024; E.resid = P->out; E.out = P->out; }
      pg8::gemm_phase<pg8::EpiDyn, pg8::TileSched, true, true>((PG8_LAS unsigned char*)lds, g, S, E, wv_);
    } else if (ph == 1) {
      unsigned* ctr = (unsigned*)(ws + WS_BAR) + it;
      for (;;) {
        const int i2 = next_item(ctr, (volatile LAS int*)&wq_slot, wv_);
        if (i2 >= 640) break;
        if (i2 < 128) hgrn_wave_item<0>(P, l, i2 * 8 + wv_, lds, wv_);
        else rwkv_prep_item(P, l, i2 - 128, lds, wv_);
      }
    } else if (ph == 2) {
      const int n_p1 = 8 * (RW_C - 2);
      const int n_rw = n_p1 + 8;
      const int n_oth = 8 + 512 + 1024;
      if (G > n_rw + 32) {
        if (bid < n_rw) {
          if (bid < n_p1) rwkv_scan_item<1>(P, l, bid & 7, 1 + (bid >> 3), lds, wv_);
          else rwkv_scan_item<0>(P, l, bid - n_p1, 0, lds, wv_);
        } else {
          unsigned* ctr = (unsigned*)(ws + WS_BAR) + it;
          for (;;) {
            const int i2 = next_item(ctr, (volatile LAS int*)&wq_slot, wv_);
            if (i2 >= n_oth) break;
            if (i2 < 8) hgrn_combine_item(P, i2, wv_);
            else if (i2 < 8 + 512) conv_item(P, l, i2 - 8, lds, wv_);
            else sb_item(P, i2 - 8 - 512, lds, wv_);
          }
        }
      } else {
        for (int i2 = bid; i2 < n_rw + n_oth; i2 += G) {
          if (i2 < n_p1) rwkv_scan_item<1>(P, l, i2 & 7, 1 + (i2 >> 3), lds, wv_);
          else if (i2 < n_rw) rwkv_scan_item<0>(P, l, i2 - n_p1, 0, lds, wv_);
          else if (i2 < n_rw + 8) hgrn_combine_item(P, i2 - n_rw, wv_);
          else if (i2 < n_rw + 8 + 512) conv_item(P, l, i2 - n_rw - 8, lds, wv_);
          else sb_item(P, i2 - n_rw - 8 - 512, lds, wv_);
          __syncthreads();
        }
      }
    } else if (ph == 3) {
      const int n_p3 = 8 * (RW_C - 1);
      if (G > n_p3 + 32) {
        if (bid < n_p3) rwkv_scan_item<0>(P, l, bid & 7, 1 + (bid >> 3), lds, wv_);
        else {
          unsigned* ctr = (unsigned*)(ws + WS_BAR) + it;
          for (;;) {
            const int i2 = next_item(ctr, (volatile LAS int*)&wq_slot, wv_);
            if (i2 >= 16 + 128) break;
            if (i2 < 16) gemm_tile<0>((const bf16_t*)(ws + WS_MEMN) + (size_t)l * 512 * 1024, 1024, 0, 256, 512, 768, (const bf16_t*)(wl + WT_KV), (i2 >> 3) * 256, (i2 & 7) * 256, 2048,
                                      (bf16_t*)(ws + WS_KV) + (size_t)l * 512 * 2048, nullptr, 2048, lds, wv_);
            else hgrn_wave_item<1>(P, l, (i2 - 16) * 8 + wv_, lds, wv_);
          }
        }
      } else {
        const int n_all = n_p3 + 128 + 16;
        for (int i2 = bid; i2 < n_all; i2 += G) {
          if (i2 < n_p3) rwkv_scan_item<0>(P, l, i2 & 7, 1 + (i2 >> 3), lds, wv_);
          else if (i2 < n_p3 + 128) hgrn_wave_item<1>(P, l, (i2 - n_p3) * 8 + wv_, lds, wv_);
          else { const int t = i2 - n_p3 - 128; gemm_tile<0>((const bf16_t*)(ws + WS_MEMN) + (size_t)l * 512 * 1024, 1024, 0, 256, 512, 768, (const bf16_t*)(wl + WT_KV), (t >> 3) * 256, (t & 7) * 256, 2048,
                                                            (bf16_t*)(ws + WS_KV) + (size_t)l * 512 * 2048, nullptr, 2048, lds, wv_); }
          __syncthreads();
        }
      }
    } else if (ph == 7) {
      for (int i2 = bid; i2 < 1024; i2 += G) xattn_item(P, l, i2, lds, wv_);
    } else {
      const bool fin = (ph == 9 && l == 1);
      const float* g_ = ph == 5 ? P->in[21] + l * 1024 : (fin ? P->in[27] : P->in[2] + 1024);
      void* d_ = ph == 5 ? (void*)hx : (fin ? (void*)P->out : (void*)hbuf);
#ifdef PROBE_J
      float pd_ = 0.f;
      if (fin) {
        if (bid == PROBE_B) {
          if (opaque_tid(wv_) == 0) {
            unsigned long long tot = 0ull; for (int i = 0; i < 11; ++i) tot += tacc[i] + tacc[16 + i];
            pdelta = sqrtf(0.0128f * (float)(PROBE_J < 32 ? tacc[PROBE_J & 31] : tacc[PROBE_J - 32] + tacc[PROBE_J - 16]) / (float)tot);
          }
          __syncthreads();
          pd_ = pdelta;
        }
      }
      norm_rows(fin, P->out, g_, d_, NT, pd_, wv_);
#else
      norm_rows(fin, P->out, g_, d_, NT, 0.f, wv_);
#endif
    }
    if (it < 19) { STAMP(16 + ph); xcd_barrier(bar, wv_); STAMP(ph) }
  }
#ifdef PROBE_J
  if (bid0 == PROBE_B && opaque_tid(wv_) == 0) {
    const unsigned long long t0_ = __builtin_amdgcn_s_memrealtime();
    const unsigned long long w_ = 4ull * (PROBE_K < 32 ? tacc[PROBE_K & 31] : tacc[PROBE_K - 32] + tacc[PROBE_K - 16]);
    while (__builtin_amdgcn_s_memrealtime() - t0_ < w_) __builtin_amdgcn_s_sleep(8);
  }
#endif
}

extern "C" void kernel_launch(void* const* d_in, const int* in_sizes, int n_in, void* d_out, int out_size, void* d_ws, size_t ws_size, hipStream_t stream) {
  constexpr size_t kDynLds = 147456;
  static int grid_blocks = 0;
  if (!grid_blocks) {
    int dev = 0, cus = 0, per_cu = 0;
    hipGetDevice(&dev);
    hipDeviceGetAttribute(&cus, hipDeviceAttributeMultiprocessorCount, dev);
    hipFuncSetAttribute((const void*)fwd_megakernel, hipFuncAttributeMaxDynamicSharedMemorySize, (int)kDynLds);
    hipOccupancyMaxActiveBlocksPerMultiprocessor(&per_cu, fwd_megakernel, NTHR, kDynLds);
    if (per_cu < 1) per_cu = 1;
    if (per_cu > 1) per_cu = 1;
    grid_blocks = cus * per_cu;
    if (grid_blocks > 256) grid_blocks = 256;
  }
  Params p;
  memset(&p, 0, sizeof(p));
  for (int i = 0; i < 28; ++i) p.in[i] = (const float*)d_in[i];
  p.out = (float*)d_out; p.ws = (unsigned char*)d_ws; p.never = 0; p.pad = 0;
  hipMemsetAsync(d_ws, 0, XCD_BAR_WORDS * 4, stream);
  void* args[] = {&p};
  hipError_t e = hipLaunchCooperativeKernel((void*)fwd_megakernel, dim3(grid_blocks), dim3(NTHR), args, kDynLds, stream);
  if (e != hipSuccess) fprintf(stderr, "cooperative launch failed: %s (grid %d)\n", hipGetErrorString(e), grid_blocks);
}
```

```cpp
#include <hip/hip_runtime.h>
#include <hip/hip_cooperative_groups.h>
#include <stdint.h>
#include <cstdio>
#include <cstring>
namespace cg = cooperative_groups;

typedef unsigned short bf16_t;
typedef short bf16x8 __attribute__((ext_vector_type(8)));
typedef float f32x4 __attribute__((ext_vector_type(4)));
typedef float f32x16 __attribute__((ext_vector_type(16)));
typedef float f32x2 __attribute__((ext_vector_type(2)));
#define LAS __attribute__((address_space(3)))

#define NT 16384
#define TSEQ 8192
#define DM 1024
#define NIN 3904
#define NTHR 512
#define C_R 0
#define C_K 256
#define C_V 512
#define C_XW 768
#define C_GA 832
#define C_CVAL 1088
#define C_CGLU 1344
#define C_CGATE 1600
#define C_HQ 1856
#define C_HF 2112
#define C_HI 2368
#define C_HG 2624
#define C_SQ 2880
#define C_SK 3136
#define C_SV 3392
#define C_SG 3648
#define RW_C 16
#define RW_CL (TSEQ / RW_C)
#define RW_TT 16

#define MiB (1024ull * 1024ull)
#define WS_BAR   0ull
#define WS_WT    (1ull * MiB)
#define WT_LAYER (18ull * MiB)
#define WT_IN    0ull
#define WT_OUT   (8ull * MiB)
#define WT_Q     (10ull * MiB)
#define WT_KV    (12ull * MiB)
#define WT_O     (16ull * MiB)
#define WS_MEMN  (37ull * MiB)
#define WS_KV    (39ull * MiB)
#define WS_PQ    (43ull * MiB)
#define WS_HS    (47ull * MiB)
#define WS_HF    (63ull * MiB)
#define WS_RK    (63ull * MiB + 512ull * 1024ull)
#define WS_R1    (64ull * MiB)
#define WS_PW    WS_R1
#define WS_PV    (WS_R1 + 16ull * MiB)
#define WS_P     (120ull * MiB)
#define WS_VT    (243ull * MiB)
#define WS_SSQ   (245ull * MiB)
#define WS_END   (246ull * MiB)

struct Params {
  const float* in[28];
  float* out;
  unsigned char* ws;
  int never;
  int pad;
};

typedef const __attribute__((address_space(4))) Params* KP;
__device__ __forceinline__ int lane_id_() { return (int)__builtin_amdgcn_mbcnt_hi(~0u, __builtin_amdgcn_mbcnt_lo(~0u, 0u)); }
__device__ __forceinline__ int opaque_tid(int wv_) { int t; asm volatile("v_mbcnt_lo_u32_b32 %0, -1, 0\n\tv_mbcnt_hi_u32_b32 %0, -1, %0\n\tv_lshl_add_u32 %0, %1, 6, %0" : "=&v"(t) : "s"(wv_)); return t; }
__device__ __forceinline__ float bf2f(bf16_t v) { return __uint_as_float(((unsigned)v) << 16); }
__device__ __forceinline__ bf16_t f2bf(float f) {
  unsigned u = __float_as_uint(f);
  u += 0x7fffu + ((u >> 16) & 1u);
  return (bf16_t)(u >> 16);
}
__device__ __forceinline__ unsigned pack2(float a, float b) { return (unsigned)f2bf(a) | ((unsigned)f2bf(b) << 16); }
__device__ __forceinline__ float sigmoidf_(float x) { return __builtin_amdgcn_rcpf(1.0f + __expf(-x)); }
__device__ __forceinline__ float siluf_(float x) { return x * __builtin_amdgcn_rcpf(1.0f + __expf(-x)); }
__device__ __forceinline__ float softplusf_(float x) { return fmaxf(x, 0.f) + log1pf(__expf(-fabsf(x))); }
__device__ __forceinline__ float softplus_fast(float x) { return fmaxf(x, 0.f) + __logf(1.0f + __expf(-fabsf(x))); }
__device__ __forceinline__ float dpp_add(float v, const int ctrl_sel) {
  return v;
}
__device__ __forceinline__ float bperm(float v, int srclane) { return __builtin_bit_cast(float, __builtin_amdgcn_ds_bpermute(srclane << 2, __builtin_bit_cast(int, v))); }
__device__ __forceinline__ float wave_sum(float v, int lane) {
  v += __builtin_bit_cast(float, __builtin_amdgcn_update_dpp(0, __builtin_bit_cast(int, v), 0xB1, 0xF, 0xF, true));
  v += __builtin_bit_cast(float, __builtin_amdgcn_update_dpp(0, __builtin_bit_cast(int, v), 0x4E, 0xF, 0xF, true));
  v += __builtin_bit_cast(float, __builtin_amdgcn_update_dpp(0, __builtin_bit_cast(int, v), 0x141, 0xF, 0xF, true));
  v += __builtin_bit_cast(float, __builtin_amdgcn_update_dpp(0, __builtin_bit_cast(int, v), 0x140, 0xF, 0xF, true));
  v += bperm(v, lane ^ 16);
  v += bperm(v, lane ^ 32);
  return v;
}
__device__ __forceinline__ float max8(float v) {
  v = fmaxf(v, __builtin_bit_cast(float, __builtin_amdgcn_update_dpp(0, __builtin_bit_cast(int, v), 0xB1, 0xF, 0xF, true)));
  v = fmaxf(v, __builtin_bit_cast(float, __builtin_amdgcn_update_dpp(0, __builtin_bit_cast(int, v), 0x4E, 0xF, 0xF, true)));
  v = fmaxf(v, __builtin_bit_cast(float, __builtin_amdgcn_update_dpp(0, __builtin_bit_cast(int, v), 0x141, 0xF, 0xF, true)));
  return v;
}
__device__ __forceinline__ float red8(float v) {
  v += __builtin_bit_cast(float, __builtin_amdgcn_update_dpp(0, __builtin_bit_cast(int, v), 0xB1, 0xF, 0xF, true));
  v += __builtin_bit_cast(float, __builtin_amdgcn_update_dpp(0, __builtin_bit_cast(int, v), 0x4E, 0xF, 0xF, true));
  v += __builtin_bit_cast(float, __builtin_amdgcn_update_dpp(0, __builtin_bit_cast(int, v), 0x141, 0xF, 0xF, true));
  return v;
}

#define LBAR() do { asm volatile("s_waitcnt lgkmcnt(0)" ::: "memory"); __builtin_amdgcn_s_barrier(); asm volatile("" ::: "memory"); } while (0)
#define XB_TMO      128
#define XB_XCNT(j)  (256  + 64 * (j))
#define XB_XSUB(j)  (1280 + 64 * (j))
#define XB_XGEN(j)  (2304 + 64 * (j))
#define XB_TOP      3328
#define XB_TOPGEN   3392
#define XCD_BAR_WORDS 3456
#define XB_SPIN_CAP (1u << 22)
__device__ __forceinline__ unsigned xb_ld(unsigned* p) { return __hip_atomic_load(p, __ATOMIC_RELAXED, __HIP_MEMORY_SCOPE_AGENT); }
__device__ __forceinline__ unsigned xb_add(unsigned* p, unsigned v) { return __hip_atomic_fetch_add(p, v, __ATOMIC_RELAXED, __HIP_MEMORY_SCOPE_AGENT); }
__device__ __forceinline__ unsigned xb_xcc_id() { return (unsigned)__builtin_amdgcn_s_getreg((3 << 11) | 20) & 0xFu; }
#define XB_SPIN(cond, bar) do { unsigned _sp = 0; while (cond) { __builtin_amdgcn_s_sleep(1); \
    if ((++_sp & 255u) == 0u) { if (xb_ld(&(bar)[XB_TMO])) break; if (_sp > XB_SPIN_CAP) { atomicAdd(&(bar)[XB_TMO], 1u); break; } } } } while (0)
struct XcdBarrier { unsigned* bar; unsigned x; volatile LAS unsigned* st; };
__device__ __forceinline__ XcdBarrier xcd_barrier_post(unsigned* bar, volatile LAS unsigned* st, int wv_) {
  XcdBarrier b; b.bar = bar; b.x = xb_xcc_id(); b.st = st;
  if (opaque_tid(wv_) == 0) (void)xb_add(&bar[XB_XCNT(b.x)], 1u);
  return b;
}
__device__ __forceinline__ void xcd_barrier_complete(unsigned* bar, unsigned x, unsigned& nloc, unsigned& nx) {
  const unsigned G = gridDim.x * gridDim.y * gridDim.z;
  unsigned sum, cnt, mine, sp = 0u;
  for (;;) {
    sum = 0u; cnt = 0u; mine = 0u;
#pragma unroll
    for (unsigned j = 0; j < 16; ++j) { const unsigned c = xb_ld(&bar[XB_XCNT(j)]); sum += c; cnt += (c > 0u) ? 1u : 0u; mine = (j == x) ? c : mine; }
    if (sum == G) break;
    __builtin_amdgcn_s_sleep(1);
    if ((++sp & 255u) == 0u) { if (xb_ld(&bar[XB_TMO])) break; if (sp > XB_SPIN_CAP) { atomicAdd(&bar[XB_TMO], 1u); break; } }
  }
  nloc = mine > 0u ? mine : 1u; nx = cnt > 0u ? cnt : 1u;
}
__device__ __forceinline__ void xcd_barrier(const XcdBarrier& b, int wv_) {
  asm volatile("s_waitcnt vmcnt(0)" ::: "memory");
  __syncthreads();
  if (opaque_tid(wv_) == 0) {
    unsigned* bar = b.bar;
    __builtin_amdgcn_s_waitcnt(0);
    unsigned bx = b.x; asm volatile("" : "+s"(bx));
    unsigned nloc = b.st[0], nx = b.st[1];
    if (nloc == 0u) { xcd_barrier_complete(bar, bx, nloc, nx); b.st[0] = nloc; b.st[1] = nx; }
    const unsigned old = xb_add(&bar[XB_XSUB(bx)], 1u);
    const unsigned gen = old / nloc;
    if (old + 1u == (gen + 1u) * nloc) {
      __builtin_amdgcn_fence(__ATOMIC_RELEASE, "agent");
      asm volatile("s_waitcnt vmcnt(0)" ::: "memory");
      const unsigned og = xb_add(&bar[XB_TOP], 1u);
      const unsigned tg = og / nx;
      if (og + 1u == (tg + 1u) * nx) xb_add(&bar[XB_TOPGEN], 1u);
      else XB_SPIN(xb_ld(&bar[XB_TOPGEN]) == tg, bar);
      __builtin_amdgcn_fence(__ATOMIC_ACQUIRE, "agent");
      xb_add(&bar[XB_XGEN(bx)], 1u);
      asm volatile("s_waitcnt vmcnt(0)" ::: "memory");
    } else {
      XB_SPIN(xb_ld(&bar[XB_XGEN(bx)]) == gen, bar);
      __builtin_amdgcn_fence(__ATOMIC_ACQUIRE, "agent");
      asm volatile("s_waitcnt vmcnt(0)" ::: "memory");
    }
  }
  __syncthreads();
}

#define G_STAGE 73728
#define G_BOFF 36864
template <int EPI>
__device__ __forceinline__ void gemm_tile(const bf16_t* __restrict__ A, int lda, int ao0, int ao1, int ao2, int ao3,
                                          const bf16_t* __restrict__ Bt, int m0, int n0, int N,
                                          void* out, const float* resid, int ldc, unsigned char* lds, int wv_) {
#ifdef OFF_gemm_tile
  return;
#endif

  const int tid = opaque_tid(wv_), lane = tid & 63, w = tid >> 6;
  const int wm = w >> 2, wn = w & 3, lr = lane & 31, lh = lane >> 5;
  f32x16 acc[4][2];
#pragma unroll
  for (int i = 0; i < 4; ++i)
#pragma unroll
    for (int j = 0; j < 2; ++j)
#pragma unroll
      for (int r = 0; r < 16; ++r) acc[i][j][r] = 0.f;
  uint4 ra[4], rb[4];
  const int crow = tid >> 3, ccol = (tid & 7) * 8;
  const bf16_t* Ap = A + (size_t)(m0 + crow) * lda + ccol;
  const bf16_t* Bp = Bt + (size_t)(n0 + crow) * 1024 + ccol;
#define G_LOAD(kt) { const int k0_ = (kt) * 64; const int seg_ = k0_ >> 8; const int ao_ = (seg_ == 0 ? ao0 : seg_ == 1 ? ao1 : seg_ == 2 ? ao2 : ao3) + (k0_ & 255); \
    _Pragma("unroll") for (int i_ = 0; i_ < 4; ++i_) { ra[i_] = *(const uint4*)(Ap + (size_t)(i_ * 64) * lda + ao_); rb[i_] = *(const uint4*)(Bp + (size_t)(i_ * 64) * 1024 + k0_); } }
#define G_WRITE(buf) { unsigned char* b_ = lds + (buf) * G_STAGE + crow * 144 + (tid & 7) * 16; \
    _Pragma("unroll") for (int i_ = 0; i_ < 4; ++i_) { *(uint4*)(b_ + i_ * 64 * 144) = ra[i_]; *(uint4*)(b_ + G_BOFF + i_ * 64 * 144) = rb[i_]; } }
  G_LOAD(0); G_WRITE(0); __syncthreads();
  for (int kt = 0; kt < 16; ++kt) {
    if (kt < 15) G_LOAD(kt + 1);
    const unsigned char* base = lds + (kt & 1) * G_STAGE;
    const unsigned char* ab = base + (wm * 128 + lr) * 144 + lh * 16;
    const unsigned char* bb = base + G_BOFF + (wn * 64 + lr) * 144 + lh * 16;
#pragma unroll
    for (int s = 0; s < 4; ++s) {
      bf16x8 a[4], b[2];
#pragma unroll
      for (int i = 0; i < 4; ++i) a[i] = *(const bf16x8*)(ab + i * 32 * 144 + s * 32);
#pragma unroll
      for (int j = 0; j < 2; ++j) b[j] = *(const bf16x8*)(bb + j * 32 * 144 + s * 32);
#pragma unroll
      for (int i = 0; i < 4; ++i)
#pragma unroll
        for (int j = 0; j < 2; ++j) acc[i][j] = __builtin_amdgcn_mfma_f32_32x32x16_bf16(a[i], b[j], acc[i][j], 0, 0, 0);
    }
    if (kt < 15) G_WRITE((kt + 1) & 1);
    __syncthreads();
  }
#undef G_LOAD
#undef G_WRITE
#pragma unroll
  for (int i = 0; i < 4; ++i)
#pragma unroll
    for (int j = 0; j < 2; ++j) {
      const int col = n0 + wn * 64 + j * 32 + lr;
#pragma unroll
      for (int r = 0; r < 16; ++r) {
        const int row = m0 + wm * 128 + i * 32 + (r & 3) + 8 * (r >> 2) + 4 * lh;
        if (EPI == 0) { if (col < N) ((bf16_t*)out)[(size_t)row * ldc + col] = f2bf(acc[i][j][r]); }
        else if (EPI == 2) { if (col < 1024) ((bf16_t*)out)[(size_t)row * ldc + col] = f2bf(acc[i][j][r]);
                             else ((bf16_t*)resid)[((size_t)((row >> 8) * 1024 + (col - 1024))) * 256 + (row & 255)] = f2bf(acc[i][j][r]); }
        else { ((float*)out)[(size_t)row * ldc + col] = resid[(size_t)row * ldc + col] + acc[i][j][r]; }
      }
    }
}

__device__ __forceinline__ void tile_map(int t, int nN, int& mi, int& ni) {
  const int rnd = t >> 8, blk = t & 255, x = blk & 7, y = blk >> 3;
  if (nN == 16) { mi = rnd * 16 + (x >> 1) * 4 + (y & 3); ni = (x & 1) * 8 + (y >> 2); }
  else { mi = rnd * 64 + x * 8 + (y & 7); ni = y >> 3; }
}

namespace pg8 {
#define PG8_LAS __attribute__((address_space(3)))
typedef unsigned u32x4 __attribute__((ext_vector_type(4)));
constexpr int BM = 256, BK = 64, HALF = 128, HTB = HALF * BK * 2  , STAGE_BYTES = 8 * HTB, NXCD = 8, WGM = 8;

__host__ __device__ __forceinline__ int lds_byte(int r, int c) { const int st = (r >> 4) * 2 + (c >> 5), rr = r & 15, cc = c & 31, ob = rr * 64 + cc * 2; return st * 1024 + (ob ^ (((ob >> 9) & 1) << 5)); }
__host__ __device__ __forceinline__ void stage_rc(int b, int& R, int& C) { const int st = b / 1024, sb = b % 1024, swz = sb ^ (((sb >> 9) & 1) << 5); R = (st >> 1) * 16 + swz / 64; C = (st & 1) * 32 + (swz % 64) / 2; }
__host__ __device__ __forceinline__ int perm32(int rho) { const int n = rho >> 4, i = rho & 15; return 8 * (i >> 2) + 4 * n + (i & 3); }

struct Unit { int pm, pn; };
struct Gemm { const bf16_t* A; const bf16_t* Bt; int M, N, K; int lda; int ao0, ao1, ao2, ao3; };

struct TileSched {
    int nt, G, c, nN;
    __device__ __forceinline__ bool next(int i, Unit& u) const { const int t = i * G + c; if (t >= nt) return false; tile_map(t, nN, u.pm, u.pn); return true; }
    __device__ __forceinline__ void a_ready(const Unit&) const {}
    __device__ __forceinline__ void done(const Unit&) const {}
};
__device__ __forceinline__ unsigned cvt_pk_bf16(float lo, float hi) { unsigned r; asm volatile("v_cvt_pk_bf16_f32 %0, %1, %2" : "=v"(r) : "v"(lo), "v"(hi)); return r; }
struct EpiStoreBf16 {
    static constexpr bool PERM = true, AFTER_DRAIN = false;
    bf16_t* O; int ldc; int N;
    __device__ __forceinline__ void operator()(const f32x4 (&acc)[2][2][4][2], const Unit& u, int wr, int wc, int fr, int fq) const {
        const int row0 = u.pm * BM + wr * 64 + fr, col0 = u.pn * BM + wc * 32 + 8 * fq;
#pragma unroll
        for (int ai = 0; ai < 2; ++ai)
#pragma unroll
            for (int m = 0; m < 4; ++m) { bf16_t* rowp = O + (size_t)(row0 + ai * HALF + m * 16) * ldc + col0;
#pragma unroll
                for (int bj = 0; bj < 2; ++bj) { if (col0 + bj * HALF < N) { const f32x4 v0 = acc[ai][bj][m][0], v1 = acc[ai][bj][m][1];
                    u32x4 w; w.x = cvt_pk_bf16(v0[0], v0[1]); w.y = cvt_pk_bf16(v0[2], v0[3]); w.z = cvt_pk_bf16(v1[0], v1[1]); w.w = cvt_pk_bf16(v1[2], v1[3]);
                    *(u32x4*)(rowp + bj * HALF) = w; } } }
    }
};
struct EpiDyn {
    static constexpr bool PERM = true, AFTER_DRAIN = false;
    int mode; bf16_t* O; int ldc; int N; const float* resid; float* out; const float* ssq_in; bf16_t* xb; float* ssq_out;
    __device__ __forceinline__ void operator()(const f32x4 (&acc)[2][2][4][2], const Unit& u, int wr, int wc, int fr, int fq) const {
        const int row0 = u.pm * BM + wr * 64 + fr, col0 = u.pn * BM + wc * 32 + 8 * fq;
        if (mode == 0) {
#pragma unroll
            for (int ai = 0; ai < 2; ++ai)
#pragma unroll
                for (int m = 0; m < 4; ++m) { const int row = row0 + ai * HALF + m * 16; bf16_t* rowp = O + (size_t)row * ldc + col0;
                    const float sc = __builtin_amdgcn_rsqf(ssq_in[row] * (1.0f / 1024.0f) + 1e-6f);
#pragma unroll
                    for (int bj = 0; bj < 2; ++bj) { if (col0 + bj * HALF < N) { const f32x4 v0 = acc[ai][bj][m][0] * sc, v1 = acc[ai][bj][m][1] * sc;
                        u32x4 w; w.x = cvt_pk_bf16(v0[0], v0[1]); w.y = cvt_pk_bf16(v0[2], v0[3]); w.z = cvt_pk_bf16(v1[0], v1[1]); w.w = cvt_pk_bf16(v1[2], v1[3]);
                        *(u32x4*)(rowp + bj * HALF) = w; } } }
        } else {
            const int lane_ = fq * 16 + fr;
#pragma unroll
            for (int ai = 0; ai < 2; ++ai)
#pragma unroll
                for (int m = 0; m < 4; ++m) { const int row = row0 + ai * HALF + m * 16; const size_t off = (size_t)row * ldc + col0; float s = 0.f;
#pragma unroll
                    for (int bj = 0; bj < 2; ++bj) { const f32x4 r0 = *(const f32x4*)(resid + off + bj * HALF), r1 = *(const f32x4*)(resid + off + bj * HALF + 4);
                        const f32x4 x0 = r0 + acc[ai][bj][m][0], x1 = r1 + acc[ai][bj][m][1];
                        *(f32x4*)(out + off + bj * HALF) = x0; *(f32x4*)(out + off + bj * HALF + 4) = x1;
                        u32x4 w; w.x = cvt_pk_bf16(x0[0], x0[1]); w.y = cvt_pk_bf16(x0[2], x0[3]); w.z = cvt_pk_bf16(x1[0], x1[1]); w.w = cvt_pk_bf16(x1[2], x1[3]);
                        *(u32x4*)(xb + off + bj * HALF) = w;
                        s += (x0[0] * x0[0] + x0[1] * x0[1]) + (x0[2] * x0[2] + x0[3] * x0[3]) + (x1[0] * x1[0] + x1[1] * x1[1]) + (x1[2] * x1[2] + x1[3] * x1[3]); }
                    s += bperm(s, lane_ ^ 16); s += bperm(s, lane_ ^ 32);
                    if (fq == 0) __hip_atomic_fetch_add(ssq_out + row, s, __ATOMIC_RELAXED, __HIP_MEMORY_SCOPE_AGENT); }
        }
    }
};
struct EpiResid {
    static constexpr bool PERM = true, AFTER_DRAIN = false;
    const float* resid; float* out; int ldc;
    __device__ __forceinline__ void operator()(const f32x4 (&acc)[2][2][4][2], const Unit& u, int wr, int wc, int fr, int fq) const {
        const int row0 = u.pm * BM + wr * 64 + fr, col0 = u.pn * BM + wc * 32 + 8 * fq;
#pragma unroll
        for (int ai = 0; ai < 2; ++ai)
#pragma unroll
            for (int m = 0; m < 4; ++m) { const size_t off = (size_t)(row0 + ai * HALF + m * 16) * ldc + col0;
#pragma unroll
                for (int bj = 0; bj < 2; ++bj) { const f32x4 r0 = *(const f32x4*)(resid + off + bj * HALF), r1 = *(const f32x4*)(resid + off + bj * HALF + 4);
                    *(f32x4*)(out + off + bj * HALF) = r0 + acc[ai][bj][m][0]; *(f32x4*)(out + off + bj * HALF + 4) = r1 + acc[ai][bj][m][1]; } }
    }
};

static_assert(true, "pg8 body adapted: SP2 path only is valid with lda/segment offsets");
template <class Epi, class Sched, bool ALIGN_EPI = false, bool SP2 = false>
__device__ __forceinline__ void gemm_phase(PG8_LAS unsigned char* lds, const Gemm g, const Sched& S, const Epi& E, int wv_) {
    const int tid = opaque_tid(wv_), wid = __builtin_amdgcn_readfirstlane(tid >> 6), lane = tid & 63, wr = wid >> 2, wc = wid & 3, fr = lane & 15, fq = lane >> 4;
    const int K = g.K, nt = K / BK;
    unsigned voffA, voffB;
    { int R, C; stage_rc(tid * 16, R, C); const int Rb = Epi::PERM ? ((R & ~31) + perm32(R & 31)) : R;
      voffA = (unsigned)(R * g.lda + C) * 2u; voffB = (unsigned)(Rb * K + C) * 2u; }
    const size_t rstepA = (size_t)64 * g.lda * 2, rstepB = (size_t)64 * K * 2;
    const size_t kstep = (size_t)(BK * 2);
    const size_t hstep = (size_t)HALF * K * 2; const size_t hstepA = (size_t)HALF * g.lda * 2, tstepA = 2 * hstepA;
#define PG8_KA(t_) ((size_t)((((t_) >> 2) == 0 ? g.ao0 : ((t_) >> 2) == 1 ? g.ao1 : ((t_) >> 2) == 2 ? g.ao2 : g.ao3) + ((t_) & 3) * 64) * 2)
    const size_t tstep = 2 * hstep;
    const unsigned ldsw = (unsigned)wid * 1024u;
    int aoff, boff;
#define PG8_SA(b, h) (((b) * 2 + (h)) * HTB)
#define PG8_SB(b, h) ((4 + (b) * 2 + (h)) * HTB)
#define PG8_STAGE(bufoff, gbase, voff) do { _Pragma("unroll") for (int _i = 0; _i < 2; ++_i) \
        __builtin_amdgcn_global_load_lds((const unsigned*)((const char*)(gbase) + (size_t)_i * r##voff + (voff)), (PG8_LAS unsigned*)(lds + (bufoff) + ldsw + _i * 8192), 16, 0, 0); } while (0)
#define rvoffA rstepA
#define rvoffB rstepB
#define PG8_LDA(dst, b, h) do { _Pragma("unroll") for (int m = 0; m < 4; ++m) _Pragma("unroll") for (int k = 0; k < 2; ++k) dst[m][k] = *(const PG8_LAS bf16x8*)(lds + (PG8_SA(b, h) + wr * 8192) + aoff + m * 2048 + k * 1024); } while (0)
#define PG8_LDB(dst, b, h) do { _Pragma("unroll") for (int n = 0; n < 2; ++n) _Pragma("unroll") for (int k = 0; k < 2; ++k) dst[n][k] = *(const PG8_LAS bf16x8*)(lds + (PG8_SB(b, h) + wc * 4096) + boff + n * 2048 + k * 1024); } while (0)
#define PG8_MMA(ai, bj, At, Bt) do { __builtin_amdgcn_s_setprio(1); _Pragma("unroll") for (int m = 0; m < 4; ++m) _Pragma("unroll") for (int n = 0; n < 2; ++n) _Pragma("unroll") for (int k = 0; k < 2; ++k) \
        acc[ai][bj][m][n] = __builtin_amdgcn_mfma_f32_16x16x32_bf16(Bt[n][k], At[m][k], acc[ai][bj][m][n], 0, 0, 0); __builtin_amdgcn_s_setprio(0); } while (0)
#define PG8_WAIT_V(n) asm volatile("s_waitcnt vmcnt(" #n ")" ::: "memory")
#define PG8_WAIT_L(n) asm volatile("s_waitcnt lgkmcnt(" #n ")" ::: "memory")
#define PG8_BAR __builtin_amdgcn_s_barrier()
#define PG8_SCHED __builtin_amdgcn_sched_barrier(0)
    Unit cur, nxt; int ui = 0;
    if (!S.next(0, cur)) return;
    f32x4 acc[2][2][4][2];
#pragma unroll
    for (int a = 0; a < 2; ++a)
#pragma unroll
        for (int b = 0; b < 2; ++b)
#pragma unroll
            for (int m = 0; m < 4; ++m)
#pragma unroll
                for (int n = 0; n < 2; ++n) acc[a][b][m][n] = (f32x4){0.f, 0.f, 0.f, 0.f};
    bf16x8 At[4][2], B0[2][2], B1[2][2];
    const char* cA = (const char*)g.A + (size_t)cur.pm * tstepA; const char* cB = (const char*)g.Bt + (size_t)cur.pn * tstep;
    S.a_ready(cur);
    if constexpr (SP2) {
        PG8_STAGE(PG8_SB(0, 0), cB, voffB); PG8_STAGE(PG8_SB(0, 1), cB + hstep, voffB); PG8_STAGE(PG8_SA(0, 0), cA + PG8_KA(0), voffA); PG8_STAGE(PG8_SA(0, 1), cA + hstepA + PG8_KA(0), voffA);
        if (wr == 1) PG8_BAR;
        PG8_WAIT_V(2); PG8_BAR;
        PG8_STAGE(PG8_SB(1, 0), cB + kstep, voffB); PG8_STAGE(PG8_SA(1, 0), cA + PG8_KA(1), voffA); PG8_STAGE(PG8_SB(1, 1), cB + hstep + kstep, voffB);
        PG8_WAIT_V(6); PG8_BAR;
    } else {
        PG8_STAGE(PG8_SB(0, 0), cB, voffB); PG8_STAGE(PG8_SA(0, 0), cA, voffA); PG8_STAGE(PG8_SB(0, 1), cB + hstep, voffB); PG8_STAGE(PG8_SA(0, 1), cA + hstep, voffA);
        if (wr == 1) PG8_BAR;
        PG8_WAIT_V(4); PG8_BAR;
        PG8_STAGE(PG8_SB(1, 0), cB + kstep, voffB); PG8_STAGE(PG8_SA(1, 0), cA + kstep, voffA); PG8_STAGE(PG8_SB(1, 1), cB + hstep + kstep, voffB);
        PG8_WAIT_V(6); PG8_BAR;
    }
    { const int t3_ = opaque_tid(wv_), l3_ = t3_ & 63, w3_ = __builtin_amdgcn_readfirstlane(t3_ >> 6); aoff = lds_byte((l3_ & 15), (l3_ >> 4) * 8); boff = aoff; }
    for (;;) {
        const bool has_next = S.next(ui + 1, nxt);
        const char* nA = has_next ? (const char*)g.A + (size_t)nxt.pm * tstepA : cA; const char* nB = has_next ? (const char*)g.Bt + (size_t)nxt.pn * tstep : cB;
        for (int t = 0; t < nt; t += 2) {
            const bool last = (t == nt - 2);
            const char* a1 = cA + PG8_KA(t + 1);
            const char* a2 = last ? nA + PG8_KA(0) : cA + PG8_KA(t + 2); const char* b2 = last ? nB : cB + (size_t)(t + 2) * kstep;
            const char* a3 = last ? nA + PG8_KA(1) : cA + PG8_KA(t + 3); const char* b3 = b2 + kstep;
            if (last && has_next) S.a_ready(nxt);
            if constexpr (SP2) {
            PG8_LDB(B0, 0, 0); PG8_LDB(B1, 0, 1); PG8_SCHED; PG8_LDA(At, 0, 0); PG8_STAGE(PG8_SA(1, 1), a1 + hstepA, voffA);
            PG8_WAIT_V(8); PG8_WAIT_L(0); PG8_BAR; PG8_MMA(0, 0, At, B0); PG8_MMA(0, 1, At, B1); PG8_BAR; PG8_SCHED;
            PG8_LDA(At, 0, 1); PG8_STAGE(PG8_SB(0, 0), b2, voffB); PG8_STAGE(PG8_SB(0, 1), b2 + hstep, voffB); PG8_STAGE(PG8_SA(0, 0), a2, voffA);
            PG8_WAIT_V(8); PG8_WAIT_L(0); PG8_BAR; PG8_MMA(1, 0, At, B0); PG8_MMA(1, 1, At, B1); PG8_BAR; PG8_SCHED;
            PG8_LDB(B0, 1, 0); PG8_LDB(B1, 1, 1); PG8_SCHED; PG8_LDA(At, 1, 0); PG8_STAGE(PG8_SA(0, 1), a2 + hstepA, voffA);
            PG8_WAIT_V(8); PG8_WAIT_L(0); PG8_BAR; PG8_MMA(0, 0, At, B0); PG8_MMA(0, 1, At, B1); PG8_BAR; PG8_SCHED;
            PG8_LDA(At, 1, 1); PG8_STAGE(PG8_SB(1, 0), b3, voffB); PG8_STAGE(PG8_SB(1, 1), b3 + hstep, voffB); PG8_STAGE(PG8_SA(1, 0), a3, voffA);
            PG8_WAIT_V(8); PG8_WAIT_L(0); PG8_BAR; PG8_MMA(1, 0, At, B0); PG8_MMA(1, 1, At, B1); PG8_BAR; PG8_SCHED;
            } else {
            PG8_LDB(B0, 0, 0); PG8_SCHED; PG8_LDA(At, 0, 0); PG8_STAGE(PG8_SA(1, 1), a1 + hstep, voffA);
            PG8_WAIT_L(8); PG8_BAR; PG8_WAIT_L(0); PG8_MMA(0, 0, At, B0); PG8_BAR; PG8_SCHED;
            PG8_LDB(B1, 0, 1); PG8_STAGE(PG8_SB(0, 0), b2, voffB);
            PG8_BAR; PG8_WAIT_L(0); PG8_MMA(0, 1, At, B1); PG8_BAR;
            PG8_LDA(At, 0, 1); PG8_STAGE(PG8_SA(0, 0), a2, voffA);
            PG8_BAR; PG8_WAIT_L(0); PG8_MMA(1, 0, At, B0); PG8_BAR; PG8_SCHED;
            PG8_STAGE(PG8_SB(0, 1), b2 + hstep, voffB);
            PG8_WAIT_V(6); PG8_BAR; PG8_MMA(1, 1, At, B1); PG8_BAR;
            PG8_LDB(B0, 1, 0); PG8_SCHED; PG8_LDA(At, 1, 0); PG8_STAGE(PG8_SA(0, 1), a2 + hstep, voffA);
            PG8_WAIT_L(8); PG8_BAR; PG8_WAIT_L(0); PG8_MMA(0, 0, At, B0); PG8_BAR; PG8_SCHED;
            PG8_LDB(B1, 1, 1); PG8_STAGE(PG8_SB(1, 0), b3, voffB);
            PG8_BAR; PG8_WAIT_L(0); PG8_MMA(0, 1, At, B1); PG8_BAR;
            PG8_LDA(At, 1, 1); PG8_STAGE(PG8_SA(1, 0), a3, voffA);
            PG8_BAR; PG8_WAIT_L(0); PG8_MMA(1, 0, At, B0); PG8_BAR; PG8_SCHED;
            PG8_STAGE(PG8_SB(1, 1), b3 + hstep, voffB);
            PG8_WAIT_V(6); PG8_BAR; PG8_MMA(1, 1, At, B1); PG8_BAR;
            }
        }
        if constexpr (ALIGN_EPI) { if (wr == 0) PG8_BAR; }
        if constexpr (!Epi::AFTER_DRAIN) { const int t2_ = opaque_tid(wv_), l2_ = t2_ & 63, w2_ = __builtin_amdgcn_readfirstlane(t2_ >> 6); E(acc, cur, w2_ >> 2, w2_ & 3, l2_ & 15, l2_ >> 4); S.done(cur); }
        if (!has_next) break;
#pragma unroll
        for (int a = 0; a < 2; ++a)
#pragma unroll
            for (int b = 0; b < 2; ++b)
#pragma unroll
                for (int m = 0; m < 4; ++m)
#pragma unroll
                    for (int n = 0; n < 2; ++n) acc[a][b][m][n] = (f32x4){0.f, 0.f, 0.f, 0.f};
        cur = nxt; cA = nA; cB = nB; ++ui;
        if constexpr (ALIGN_EPI) { if (wr == 1) PG8_BAR; }
    }
    PG8_WAIT_V(0);
    if constexpr (!ALIGN_EPI) { if (wr == 0) PG8_BAR; }
    PG8_BAR;
    if constexpr (Epi::AFTER_DRAIN) { E.fused(acc, cur, wr, wc, fr, fq, lds, wid, lane); S.done(cur); }
#undef PG8_SA
#undef PG8_SB
#undef PG8_STAGE
#undef rvoffA
#undef rvoffB
#undef PG8_LDA
#undef PG8_LDB
#undef PG8_MMA
#undef PG8_WAIT_V
#undef PG8_WAIT_L
#undef PG8_BAR
#undef PG8_SCHED
#undef PG8_KA
}
}

__device__ __forceinline__ void wt_tile(const float* __restrict__ W, int N, bf16_t* __restrict__ Wt, int kt, int nt, unsigned char* lds, int wv_, const float* gk = nullptr) {
#ifdef OFF_wt_tile
  return;
#endif

  float* tl = (float*)lds;
  const int tid = opaque_tid(wv_);
  const int r = tid >> 3, c8 = (tid & 7) * 8;
  const float* src = W + (size_t)(kt * 64 + r) * N + nt * 64 + c8;
  float4 v0 = *(const float4*)src, v1 = *(const float4*)(src + 4);
  if (gk) { const float g_ = gk[kt * 64 + r]; v0.x *= g_; v0.y *= g_; v0.z *= g_; v0.w *= g_; v1.x *= g_; v1.y *= g_; v1.z *= g_; v1.w *= g_; }
  float* d = tl + r * 65 + c8;
  d[0] = v0.x; d[1] = v0.y; d[2] = v0.z; d[3] = v0.w; d[4] = v1.x; d[5] = v1.y; d[6] = v1.z; d[7] = v1.w;
  __syncthreads();
  uint4 o;
  o.x = pack2(tl[(c8 + 0) * 65 + r], tl[(c8 + 1) * 65 + r]);
  o.y = pack2(tl[(c8 + 2) * 65 + r], tl[(c8 + 3) * 65 + r]);
  o.z = pack2(tl[(c8 + 4) * 65 + r], tl[(c8 + 5) * 65 + r]);
  o.w = pack2(tl[(c8 + 6) * 65 + r], tl[(c8 + 7) * 65 + r]);
  *(uint4*)(Wt + (size_t)(nt * 64 + r) * 1024 + kt * 64 + c8) = o;
  __syncthreads();
}

__device__ __forceinline__ void norm_rows(const bool F32OUT, const float* src, const float* __restrict__ g, void* dst, int nrows, float pd, int wv_, float* ssq_out = nullptr) {
#ifdef OFF_norm_rows
  return;
#endif

  const int tid = opaque_tid(wv_);
  const int lane = tid & 63;
  const int gw = blockIdx.x * 8 + (tid >> 6), nw = gridDim.x * 8;
  float4 gv[4];
#pragma unroll
  for (int i = 0; i < 4; ++i) gv[i] = ssq_out ? make_float4(1.f, 1.f, 1.f, 1.f) : *(const float4*)(g + i * 256 + lane * 4);
  for (int row = gw; row < nrows; row += nw) {
    const float* s = src + (size_t)row * 1024;
    float4 v[4]; float ss = 0.f;
#pragma unroll
    for (int i = 0; i < 4; ++i) { v[i] = *(const float4*)(s + i * 256 + lane * 4); ss += v[i].x * v[i].x + v[i].y * v[i].y + v[i].z * v[i].z + v[i].w * v[i].w; }
    ss = wave_sum(ss, lane);
    if (ssq_out) { if (lane == 0) ssq_out[row] = ss; }
    const float rs = ssq_out ? 1.0f : rsqrtf(ss * (1.0f / 1024.0f) + 1e-6f);
#pragma unroll
    for (int i = 0; i < 4; ++i) {
      const float a = v[i].x * rs * gv[i].x, b = v[i].y * rs * gv[i].y, c = v[i].z * rs * gv[i].z, d = v[i].w * rs * gv[i].w;
      if (F32OUT) { *(float4*)((float*)dst + (size_t)row * 1024 + i * 256 + lane * 4) = make_float4(a + pd, b + pd, c + pd, d + pd); }
      else { uint2 o; o.x = pack2(a, b); o.y = pack2(c, d); *(uint2*)((bf16_t*)dst + (size_t)row * 1024 + i * 256 + lane * 4) = o; }
    }
  }
}

__device__ __forceinline__ void rwkv_prep_item(KP P, int l, int item, unsigned char* lds, int wv_) {
#ifdef OFF_rwkv_prep_item
  return;
#endif

  const bf16_t* p = (const bf16_t*)(P->ws + WS_P);
  float* PW = (float*)(P->ws + WS_PW); bf16_t* PV = (bf16_t*)(P->ws + WS_PV); float* RK = (float*)(P->ws + WS_RK);
  float* lora = (float*)lds;
  const int tid = opaque_tid(wv_), lane = tid & 63, w = tid >> 6, head = w & 3, sub = w >> 2;
  const int c = head * 64 + lane;
  const float* mu = P->in[4] + l * 832;
  const float mur = mu[c], muk = mu[256 + c], muv = mu[512 + c], mux = mu[768 + lane];
  const float w0 = P->in[5][l * 256 + c], a0 = P->in[7][l * 256 + c];
  const float kkw = P->in[9][l * 256 + c], kaw = P->in[10][l * 256 + c], rkw = P->in[11][l * 256 + c];
  float wup[32], aup[32];
#pragma unroll
  for (int j = 0; j < 32; ++j) { wup[j] = P->in[6][(l * 32 + j) * 256 + c]; aup[j] = P->in[8][(l * 32 + j) * 256 + c]; }
  bf16_t raw[4][8];
#define PREP_LOAD(g) { _Pragma("unroll") for (int j_ = 0; j_ < 4; ++j_) { const int t_ = item * 32 + sub + 2 * ((g) * 4 + j_); const bool hp_ = (t_ & (TSEQ - 1)) > 0; \
      const bf16_t* pr_ = p + (size_t)t_ * NIN; raw[j_][0] = pr_[c]; raw[j_][1] = pr_[256 + c]; raw[j_][2] = pr_[512 + c]; raw[j_][3] = pr_[768 + lane]; \
      raw[j_][4] = hp_ ? pr_[c - NIN] : (bf16_t)0; raw[j_][5] = hp_ ? pr_[256 + c - NIN] : (bf16_t)0; raw[j_][6] = hp_ ? pr_[512 + c - NIN] : (bf16_t)0; raw[j_][7] = hp_ ? pr_[768 + lane - NIN] : (bf16_t)0; } }
  PREP_LOAD(0);
#pragma unroll 1
  for (int g = 0; g < 4; ++g) {
    float rr[4], kk4[4], vv4[4];
#pragma unroll
    for (int j = 0; j < 4; ++j) {
      float r = bf2f(raw[j][0]), k = bf2f(raw[j][1]), v = bf2f(raw[j][2]), x = bf2f(raw[j][3]);
      r += (bf2f(raw[j][4]) - r) * mur; k += (bf2f(raw[j][5]) - k) * muk; v += (bf2f(raw[j][6]) - v) * muv; x += (bf2f(raw[j][7]) - x) * mux;
      rr[j] = r; kk4[j] = k; vv4[j] = v;
      lora[(w * 4 + j) * 64 + lane] = lane < 32 ? tanhf(x) : x;
    }
    if (g < 3) PREP_LOAD(g + 1);
    __builtin_amdgcn_s_waitcnt(0xc07f);
    __builtin_amdgcn_wave_barrier();
#pragma unroll
    for (int j = 0; j < 4; ++j) {
      const int t = item * 32 + sub + 2 * (g * 4 + j);
      const int tt = t & (TSEQ - 1), b = t >> 13;
      const float r = rr[j], k = kk4[j], v = vv4[j];
      float wv = w0, av = a0;
      const float* lo = lora + (w * 4 + j) * 64;
#pragma unroll
      for (int jj = 0; jj < 32; ++jj) { wv += lo[jj] * wup[jj]; av += lo[32 + jj] * aup[jj]; }
      const float wlog = -softplusf_(-wv) - 0.5f;
      const float decay = __expf(-__expf(wlog));
      const float ar = sigmoidf_(av);
      const float kk = k * kkw;
      const float n2 = wave_sum(kk * kk, lane);
      const float kkn = kk / fmaxf(sqrtf(n2), 1e-12f);
      const float kmod = k * (1.0f + (ar - 1.0f) * kaw);
      const float rk = wave_sum(r * kmod * rkw, lane);
      const size_t idx = (size_t)(b * 4 + head) * TSEQ + tt;
      PW[idx * 64 + lane] = decay;
      bf16_t* pv = PV + idx * 320;
      pv[lane] = f2bf(r); pv[64 + lane] = f2bf(kmod); pv[128 + lane] = f2bf(v); pv[192 + lane] = f2bf(-kkn); pv[256 + lane] = f2bf(kkn * ar);
      if (lane == 0) RK[idx] = rk;
    }
    __builtin_amdgcn_s_waitcnt(0xc07f);
    __builtin_amdgcn_wave_barrier();
  }
#undef PREP_LOAD
  __syncthreads();
}

#define RW_TILE_B (RW_TT * 1536)
struct RwRegs { float4 pw; uint4 pv0, pv1; };
__device__ __forceinline__ void rw_issue(const float* __restrict__ PW, const bf16_t* __restrict__ PV, size_t idx0, int tid, RwRegs& r) {
  if (tid < RW_TT * 16) { const int s = tid >> 4, q = tid & 15; r.pw = *(const float4*)(PW + (idx0 + s) * 64 + q * 4); }
  { const int c = tid; const int s = c / 40, q = c % 40; r.pv0 = *(const uint4*)(PV + (idx0 + s) * 320 + q * 8); }
  if (tid < RW_TT * 40 - NTHR) { const int c = tid + NTHR; const int s = c / 40, q = c % 40; r.pv1 = *(const uint4*)(PV + (idx0 + s) * 320 + q * 8); }
}
__device__ __forceinline__ void rw_put(float* dst, int c, const uint4 u) {
  const int s = c / 40, q = c % 40;
  const int vec = q >> 3, off = (q & 7) * 8;
  const int slot = vec == 0 ? 4 : vec == 1 ? 3 : vec == 2 ? 5 : vec == 3 ? 1 : 2;
  float* d = dst + s * 384 + slot * 64 + off;
  *(float4*)d = make_float4(__uint_as_float(u.x << 16), __uint_as_float(u.x & 0xffff0000u), __uint_as_float(u.y << 16), __uint_as_float(u.y & 0xffff0000u));
  *(float4*)(d + 4) = make_float4(__uint_as_float(u.z << 16), __uint_as_float(u.z & 0xffff0000u), __uint_as_float(u.w << 16), __uint_as_float(u.w & 0xffff0000u));
}
__device__ __forceinline__ void rw_commit(unsigned char* dstb, int tid, const RwRegs& r) {
  float* dst = (float*)dstb;
  if (tid < RW_TT * 16) { const int s = tid >> 4, q = tid & 15; *(float4*)(dst + s * 384 + q * 4) = r.pw; }
  rw_put(dst, tid, r.pv0);
  if (tid < RW_TT * 40 - NTHR) rw_put(dst, tid + NTHR, r.pv1);
}

#define LD8(dst, ptr) { const float4 x0_ = *(const float4*)(ptr), x1_ = *(const float4*)((ptr) + 4); dst[0] = (f32x2){x0_.x, x0_.y}; dst[1] = (f32x2){x0_.z, x0_.w}; dst[2] = (f32x2){x1_.x, x1_.y}; dst[3] = (f32x2){x1_.z, x1_.w}; }
struct RwOps { f32x2 w[4], a[4], b[4], k[4], r[4]; float vA, vB; };
template <int MODE>
__device__ __forceinline__ void rw_ldops(RwOps& o, const float* tb, int s, int q, int rowA, int rowB) {
  const float* sp = tb + s * 384 + q * 8;
  LD8(o.w, sp); LD8(o.a, sp + 64); LD8(o.b, sp + 128); LD8(o.k, sp + 192);
  o.vA = tb[s * 384 + 320 + rowA];
  if (MODE == 0) { LD8(o.r, sp + 256); o.vB = tb[s * 384 + 320 + rowB]; }
}
template <int MODE>
__device__ __forceinline__ void rw_step(const RwOps& o, f32x2 (&SA)[4], f32x2 (&SB)[4], float* yb, int s, int q, int rowA, int rowB) {
  f32x2 dA = SA[0] * o.a[0], dB = SB[0] * o.a[0];
#pragma unroll
  for (int e = 1; e < 4; ++e) { dA = SA[e] * o.a[e] + dA; dB = SB[e] * o.a[e] + dB; }
  const float dotA = red8(dA.x + dA.y), dotB = red8(dB.x + dB.y);
  const f32x2 dA2 = {dotA, dotA}, dB2 = {dotB, dotB}, vA2 = {o.vA, o.vA};
  if (MODE == 0) {
    const f32x2 vB2 = {o.vB, o.vB};
#pragma unroll
    for (int e = 0; e < 4; ++e) { SA[e] = SA[e] * o.w[e] + vA2 * o.k[e]; SA[e] = dA2 * o.b[e] + SA[e]; SB[e] = SB[e] * o.w[e] + vB2 * o.k[e]; SB[e] = dB2 * o.b[e] + SB[e]; }
    f32x2 yA = SA[0] * o.r[0], yB = SB[0] * o.r[0];
#pragma unroll
    for (int e = 1; e < 4; ++e) { yA = SA[e] * o.r[e] + yA; yB = SB[e] * o.r[e] + yB; }
    const float ya = red8(yA.x + yA.y), ybv = red8(yB.x + yB.y);
    if (q == 0) { yb[s * 64 + rowA] = ya; yb[s * 64 + rowB] = ybv; }
  } else {
#pragma unroll
    for (int e = 0; e < 4; ++e) { SA[e] = dA2 * o.b[e] + SA[e] * o.w[e]; SB[e] = SB[e] * o.w[e] + vA2 * o.k[e]; SB[e] = dB2 * o.b[e] + SB[e]; }
  }
}
template <int MODE>
__device__ __forceinline__ void rwkv_scan_item(KP P, int l, int bh, int chunk, unsigned char* lds, int wv_) {
  const float* PW = (const float*)(P->ws + WS_PW); const bf16_t* PV = (const bf16_t*)(P->ws + WS_PV); const float* RK = (const float*)(P->ws + WS_RK);
  float* PQ = (float*)(P->ws + WS_PQ);
  bf16_t* p = (bf16_t*)(P->ws + WS_P);
  const int tid = opaque_tid(wv_), lane = tid & 63, w = tid >> 6;
  const int q = lane & 7;
  const int rowA = (MODE == 0) ? ((w & 3) * 16 + (lane >> 3)) : (w * 8 + (lane >> 3));
  const int rowB = rowA + 8;
  const int b = bh >> 2, head = bh & 3;
  unsigned char* tile0 = lds;
  float* ybuf = (float*)(lds + 3 * RW_TILE_B);
  float* Sl = (float*)(lds + 3 * RW_TILE_B + 2 * RW_TT * 256);
  f32x2 SA[4], SB[4];
#pragma unroll
  for (int e = 0; e < 4; ++e) { SA[e] = (f32x2){0.f, 0.f}; SB[e] = (f32x2){0.f, 0.f}; }
  if (MODE == 1) {
#pragma unroll
    for (int e = 0; e < 4; ++e) SA[e] = (f32x2){(q * 8 + 2 * e == rowA) ? 1.f : 0.f, (q * 8 + 2 * e + 1 == rowA) ? 1.f : 0.f};
  }
  if (MODE == 0 && chunk > 0) {
    const float* Q0 = PQ + ((size_t)(bh * RW_C + 0) * 2 + 1) * 4096;
    float* cur = Sl; float* nxt = Sl + 64 * 65;
    for (int i = tid; i < 1024; i += NTHR) { const float4 v_ = *(const float4*)(Q0 + i * 4); float* d_ = cur + (i >> 4) * 65 + (i & 15) * 4; d_[0] = v_.x; d_[1] = v_.y; d_[2] = v_.z; d_[3] = v_.w; }
    float* Pl = (float*)lds;
    const float4 z4_ = make_float4(0.f, 0.f, 0.f, 0.f); const f32x4 zq_ = {0.f, 0.f, 0.f, 0.f};
    float4 cs0p0 = z4_, cs0p1 = z4_, cs1p0 = z4_, cs1p1 = z4_, cs2p0 = z4_, cs2p1 = z4_, cs3p0 = z4_, cs3p1 = z4_;
    f32x4 cs0q0 = zq_, cs0q1 = zq_, cs1q0 = zq_, cs1q1 = zq_, cs2q0 = zq_, cs2q1 = zq_, cs3q0 = zq_, cs3q1 = zq_;
    const int ti = w >> 1;
    const int qoff0 = 4096 + (ti * 16 + (lane >> 4) * 4) * 64 + ((w & 1) * 2 + 0) * 16 + (lane & 15);
#define CS_LOAD(S_, c_) { const float* Pm_ = PQ + ((size_t)(bh * RW_C + (c_)) * 2 + 0) * 4096; S_##p0 = *(const float4*)(Pm_ + tid * 4); S_##p1 = *(const float4*)(Pm_ + (tid + NTHR) * 4); \
      S_##q0 = (f32x4){Pm_[qoff0], Pm_[qoff0 + 64], Pm_[qoff0 + 128], Pm_[qoff0 + 192]}; S_##q1 = (f32x4){Pm_[qoff0 + 16], Pm_[qoff0 + 80], Pm_[qoff0 + 144], Pm_[qoff0 + 208]}; }
#define CS_STEP(S_, c_) { LBAR(); *(float4*)(Pl + (tid >> 4) * 80 + (tid & 15) * 4) = S_##p0; *(float4*)(Pl + ((tid + NTHR) >> 4) * 80 + (tid & 15) * 4) = S_##p1; const f32x4 qc0 = S_##q0, qc1 = S_##q1; \
      if ((c_) + 4 < chunk) CS_LOAD(S_, (c_) + 4); \
      LBAR(); \
      _Pragma("unroll") for (int jj = 0; jj < 2; ++jj) { const int tj = (w & 1) * 2 + jj; f32x4 acc = jj == 0 ? qc0 : qc1; \
        _Pragma("unroll") for (int ks = 0; ks < 16; ++ks) { const float a = cur[(ti * 16 + (lane & 15)) * 65 + ks * 4 + (lane >> 4)]; const float bb = Pl[(ks * 4 + (lane >> 4)) * 80 + tj * 16 + (lane & 15)]; \
          acc = __builtin_amdgcn_mfma_f32_16x16x4f32(a, bb, acc, 0, 0, 0); } \
        _Pragma("unroll") for (int r = 0; r < 4; ++r) nxt[(ti * 16 + (lane >> 4) * 4 + r) * 65 + tj * 16 + (lane & 15)] = acc[r]; } \
      float* t_ = cur; cur = nxt; nxt = t_; }
    if (1 < chunk) CS_LOAD(cs0, 1);
    if (2 < chunk) CS_LOAD(cs1, 2);
    if (3 < chunk) CS_LOAD(cs2, 3);
    if (4 < chunk) CS_LOAD(cs3, 4);
#pragma unroll 1
    for (int cc = 1; cc < chunk; cc += 4) {
      CS_STEP(cs0, cc);
      if (cc + 1 < chunk) CS_STEP(cs1, cc + 1);
      if (cc + 2 < chunk) CS_STEP(cs2, cc + 2);
      if (cc + 3 < chunk) CS_STEP(cs3, cc + 3);
    }
#undef CS_LOAD
#undef CS_STEP
    __syncthreads();
#pragma unroll
    for (int e = 0; e < 4; ++e) { SA[e] = (f32x2){cur[rowA * 65 + q * 8 + 2 * e], cur[rowA * 65 + q * 8 + 2 * e + 1]}; SB[e] = (f32x2){cur[rowB * 65 + q * 8 + 2 * e], cur[rowB * 65 + q * 8 + 2 * e + 1]}; }
    __syncthreads();
  }
  const size_t idxb = (size_t)bh * TSEQ + (size_t)chunk * RW_CL;
  const int ntile = RW_CL / RW_TT;
  RwRegs rr;
  rw_issue(PW, PV, idxb, tid, rr);
  rw_commit(tile0, tid, rr);
  const int chh = head * 64 + lane;
  const float lng = P->in[12][l * 256 + chh], lnb = P->in[13][l * 256 + chh];
  __syncthreads();
  const int nit = (MODE == 0) ? ntile + 1 : ntile;
  for (int tl = 0; tl < nit; ++tl) {
    if (tl + 1 < ntile) rw_issue(PW, PV, idxb + (size_t)(tl + 1) * RW_TT, tid, rr);
    if (MODE == 1 || w < 4) {
      if (tl < ntile) {
        const float* tb = (const float*)(tile0 + (tl % 3) * RW_TILE_B);
        float* yb = ybuf + (tl & 1) * (RW_TT * 64);
        RwOps oa, ob;
        rw_ldops<MODE>(oa, tb, 0, q, rowA, rowB);
        __builtin_amdgcn_sched_barrier(0);
#pragma unroll 1
        for (int s = 0; s < RW_TT; s += 2) {
          rw_ldops<MODE>(ob, tb, s + 1, q, rowA, rowB);
          __builtin_amdgcn_sched_barrier(0);
          rw_step<MODE>(oa, SA, SB, yb, s, q, rowA, rowB);
          __builtin_amdgcn_sched_barrier(0);
          if (s + 2 < RW_TT) rw_ldops<MODE>(oa, tb, s + 2, q, rowA, rowB);
          __builtin_amdgcn_sched_barrier(0);
          rw_step<MODE>(ob, SA, SB, yb, s + 1, q, rowA, rowB);
          __builtin_amdgcn_sched_barrier(0);
        }
      }
      if (tl + 1 < ntile) rw_commit(tile0 + ((tl + 1) % 3) * RW_TILE_B, tid, rr);
    } else {
      const int fw = w - 4;
      f32x4 gcu = {0.f, 0.f, 0.f, 0.f}, rkcu = {0.f, 0.f, 0.f, 0.f};
      if (tl > 0) {
#pragma unroll
        for (int u = 0; u < 4; ++u) { const int tt = chunk * RW_CL + (tl - 1) * RW_TT + fw + 4 * u;
          gcu[u] = bf2f(p[(size_t)(b * TSEQ + tt) * NIN + C_GA + chh]); rkcu[u] = RK[(size_t)bh * TSEQ + tt]; }
      }
      asm volatile("s_waitcnt vmcnt(0)" ::: "memory");
      if (tl + 1 < ntile) rw_commit(tile0 + ((tl + 1) % 3) * RW_TILE_B, tid, rr);
      __builtin_amdgcn_sched_barrier(0);
      if (tl > 0) {
        const float* tb = (const float*)(tile0 + ((tl - 1) % 3) * RW_TILE_B);
        const float* yb = ybuf + ((tl - 1) & 1) * (RW_TT * 64);
#pragma unroll
        for (int u = 0; u < 4; ++u) {
          const int s = fw + 4 * u;
          const int tt = chunk * RW_CL + (tl - 1) * RW_TT + s;
          const float y = yb[s * 64 + lane];
          const float mean = wave_sum(y, lane) * (1.0f / 64.0f);
          const float dlt = y - mean;
          const float var = wave_sum(dlt * dlt, lane) * (1.0f / 64.0f);
          float o = dlt * rsqrtf(var + 64e-5f) * lng + lnb;
          const float vv = tb[s * 384 + 320 + lane];
          o += rkcu[u] * vv;
          p[(size_t)(b * TSEQ + tt) * NIN + C_GA + chh] = f2bf(o * siluf_(gcu[u]));
        }
      }
    }
    LBAR();
  }
  if (MODE == 1) {
    float* Pm = PQ + ((size_t)(bh * RW_C + chunk) * 2 + 0) * 4096 + rowA * 64 + q * 8;
    *(float4*)Pm = make_float4(SA[0].x, SA[0].y, SA[1].x, SA[1].y); *(float4*)(Pm + 4) = make_float4(SA[2].x, SA[2].y, SA[3].x, SA[3].y);
    *(float4*)(Pm + 4096) = make_float4(SB[0].x, SB[0].y, SB[1].x, SB[1].y); *(float4*)(Pm + 4100) = make_float4(SB[2].x, SB[2].y, SB[3].x, SB[3].y);
  } else if (chunk == 0 && w < 4) {
    float* Qm = PQ + ((size_t)(bh * RW_C + 0) * 2 + 1) * 4096 + q * 8;
    *(float4*)(Qm + rowA * 64) = make_float4(SA[0].x, SA[0].y, SA[1].x, SA[1].y); *(float4*)(Qm + rowA * 64 + 4) = make_float4(SA[2].x, SA[2].y, SA[3].x, SA[3].y);
    *(float4*)(Qm + rowB * 64) = make_float4(SB[0].x, SB[0].y, SB[1].x, SB[1].y); *(float4*)(Qm + rowB * 64 + 4) = make_float4(SB[2].x, SB[2].y, SB[3].x, SB[3].y);
  }
  __syncthreads();
}

__device__ __forceinline__ void conv_item(KP P, int l, int item, unsigned char* lds, int wv_) {
#ifdef OFF_conv_item
  return;
#endif

  bf16_t* p = (bf16_t*)(P->ws + WS_P);
  float* u = (float*)lds;
  float* yb = (float*)(lds + 62 * 1024);
  const int tid = opaque_tid(wv_), c = tid & 255, half = tid >> 8;
  const int t0 = item * 32, tt0 = t0 & (TSEQ - 1);
  {
    bf16_t rv[31], rg[31];
#pragma unroll
    for (int i = 0; i < 31; ++i) { const int r = half + 2 * i; const bool ok = (tt0 - 30 + r) >= 0; const bf16_t* pr = p + (size_t)(t0 - 30 + r) * NIN;
      rv[i] = ok ? pr[C_CVAL + c] : (bf16_t)0; rg[i] = ok ? pr[C_CGLU + c] : (bf16_t)0; }
#pragma unroll
    for (int i = 0; i < 31; ++i) u[(half + 2 * i) * 256 + c] = bf2f(rv[i]) * sigmoidf_(bf2f(rg[i]));
  }
  float wv[31];
#pragma unroll
  for (int j = 0; j < 31; ++j) wv[j] = P->in[14][(l * 31 + j) * 256 + c];
  const float bias = P->in[15][l * 256 + c];
  __syncthreads();
  {
    float win[46];
#pragma unroll
    for (int i = 0; i < 46; ++i) win[i] = u[(half * 16 + i) * 256 + c];
#pragma unroll
    for (int i = 0; i < 16; ++i) {
      float acc = bias;
#pragma unroll
      for (int j = 0; j < 31; ++j) acc = fmaf(wv[j], win[i + j], acc);
      yb[(half * 16 + i) * 256 + c] = acc;
    }
  }
  __syncthreads();
  const int lane = tid & 63, w = tid >> 6;
  const float4 g = *(const float4*)(P->in[16] + l * 256 + lane * 4), bb = *(const float4*)(P->in[17] + l * 256 + lane * 4);
  uint2 gpre[4];
#pragma unroll
  for (int i = 0; i < 4; ++i) gpre[i] = *(const uint2*)(p + (size_t)(t0 + w * 4 + i) * NIN + C_CGATE + lane * 4);
#pragma unroll
  for (int i = 0; i < 4; ++i) {
    const int tk = w * 4 + i;
    const float4 v = *(const float4*)(yb + tk * 256 + lane * 4);
    const float mean = wave_sum(v.x + v.y + v.z + v.w, lane) * (1.0f / 256.0f);
    const float d0 = v.x - mean, d1 = v.y - mean, d2 = v.z - mean, d3 = v.w - mean;
    const float var = wave_sum(d0 * d0 + d1 * d1 + d2 * d2 + d3 * d3, lane) * (1.0f / 256.0f);
    const float rs = rsqrtf(var + 1e-5f);
    bf16_t* gp = p + (size_t)(t0 + tk) * NIN + C_CGATE + lane * 4;
    const uint2 gu = gpre[i];
    const float o0 = siluf_(d0 * rs * g.x + bb.x) * siluf_(__uint_as_float(gu.x << 16));
    const float o1 = siluf_(d1 * rs * g.y + bb.y) * siluf_(__uint_as_float(gu.x & 0xffff0000u));
    const float o2 = siluf_(d2 * rs * g.z + bb.z) * siluf_(__uint_as_float(gu.y << 16));
    const float o3 = siluf_(d3 * rs * g.w + bb.w) * siluf_(__uint_as_float(gu.y & 0xffff0000u));
    uint2 o; o.x = pack2(o0, o1); o.y = pack2(o2, o3);
    *(uint2*)gp = o;
  }
  __syncthreads();
}

#define HG_WLDS 10240
__device__ __forceinline__ float hgrn_lb(KP P, int l, int ch) {
  if (l == 0) return 0.f;
  const float x0 = P->in[18][ch], x1 = P->in[18][256 + ch];
  return __builtin_amdgcn_rcpf(1.0f + __expf(x0 - x1));
}
template <int PASS>
__device__ __forceinline__ void hgrn_wave_item(KP P, int l, int wi, unsigned char* lds, int wv_) {
#ifdef OFF_hgrn_wave_item
  return;
#endif

  bf16_t* p = (bf16_t*)(P->ws + WS_P);
  float* HS = (float*)(P->ws + WS_HS); float* HF = (float*)(P->ws + WS_HF);
  const int tid = opaque_tid(wv_);
  const int lane = tid & 63, w = tid >> 6;
  const int bh = wi >> 7, chunk = wi & 127, b = bh >> 2, head = bh & 3;
  float* st = (float*)(lds + w * HG_WLDS);
  float* ob = st + 2048;
  const int kg = lane & 7, vg = lane >> 3;
  const int ch = head * 64 + lane;
  const float lb = hgrn_lb(P, l, ch);
  const float ng = P->in[19][l * 256 + ch];
  float S[8][8];
  float* slot = HS + (size_t)(bh * 128 + chunk) * 4096;
  if (PASS == 1) {
#pragma unroll
    for (int i = 0; i < 8; ++i) { const float4 x0 = *(const float4*)(slot + (kg * 8 + i) * 64 + vg * 8), x1 = *(const float4*)(slot + (kg * 8 + i) * 64 + vg * 8 + 4);
      S[i][0] = x0.x; S[i][1] = x0.y; S[i][2] = x0.z; S[i][3] = x0.w; S[i][4] = x1.x; S[i][5] = x1.y; S[i][6] = x1.z; S[i][7] = x1.w; }
  } else {
#pragma unroll
    for (int i = 0; i < 8; ++i)
#pragma unroll
      for (int j = 0; j < 8; ++j) S[i][j] = 0.f;
  }
  float Fp = 1.f;
  bf16_t rf[8], ri[8], rq[8], rg[8];
  {
    const int tb0 = b * TSEQ + chunk * 64;
#pragma unroll
    for (int s = 0; s < 8; ++s) { const bf16_t* pr = p + (size_t)(tb0 + s) * NIN; rf[s] = pr[C_HF + ch]; ri[s] = pr[C_HI + ch]; if (PASS == 1) { rq[s] = pr[C_HQ + ch]; rg[s] = pr[C_HG + ch]; } }
  }
#pragma unroll 1
  for (int sub = 0; sub < 8; ++sub) {
    const int tbase = b * TSEQ + chunk * 64 + sub * 8;
    bf16_t gc[8];
#pragma unroll
    for (int s = 0; s < 8; ++s) {
      const float f = lb + (1.0f - lb) * sigmoidf_(bf2f(rf[s]));
      Fp *= f;
      st[s * 256 + lane] = f; st[s * 256 + 64 + lane] = 1.0f - f;
      if (PASS == 1) { st[s * 256 + 128 + lane] = siluf_(bf2f(rq[s])); gc[s] = rg[s]; }
      st[s * 256 + 192 + lane] = bf2f(ri[s]);
    }
    if (sub < 7) {
#pragma unroll
      for (int s = 0; s < 8; ++s) { const bf16_t* pr = p + (size_t)(tbase + 8 + s) * NIN; rf[s] = pr[C_HF + ch]; ri[s] = pr[C_HI + ch]; if (PASS == 1) { rq[s] = pr[C_HQ + ch]; rg[s] = pr[C_HG + ch]; } }
    }
    __builtin_amdgcn_s_waitcnt(0xc07f);
    __builtin_amdgcn_wave_barrier();
#pragma unroll 1
    for (int s = 0; s < 8; ++s) {
      const float* sp = st + s * 256;
      const float4 f0 = *(const float4*)(sp + kg * 8), f1 = *(const float4*)(sp + kg * 8 + 4);
      const float4 k0 = *(const float4*)(sp + 64 + kg * 8), k1 = *(const float4*)(sp + 64 + kg * 8 + 4);
      const float4 v0 = *(const float4*)(sp + 192 + vg * 8), v1 = *(const float4*)(sp + 192 + vg * 8 + 4);
      const float fv[8] = {f0.x, f0.y, f0.z, f0.w, f1.x, f1.y, f1.z, f1.w};
      const float kv[8] = {k0.x, k0.y, k0.z, k0.w, k1.x, k1.y, k1.z, k1.w};
      const float vv[8] = {v0.x, v0.y, v0.z, v0.w, v1.x, v1.y, v1.z, v1.w};
#pragma unroll
      for (int i = 0; i < 8; ++i)
#pragma unroll
        for (int j = 0; j < 8; ++j) S[i][j] = fmaf(fv[i], S[i][j], kv[i] * vv[j]);
      if (PASS == 1) {
        const float4 q0 = *(const float4*)(sp + 128 + kg * 8), q1 = *(const float4*)(sp + 128 + kg * 8 + 4);
        const float qv[8] = {q0.x, q0.y, q0.z, q0.w, q1.x, q1.y, q1.z, q1.w};
        float o[8];
#pragma unroll
        for (int j = 0; j < 8; ++j) { float a = qv[0] * S[0][j];
#pragma unroll
          for (int i = 1; i < 8; ++i) a = fmaf(qv[i], S[i][j], a);
          o[j] = red8(a); }
        if (kg == 0) { *(float4*)(ob + s * 64 + vg * 8) = make_float4(o[0], o[1], o[2], o[3]); *(float4*)(ob + s * 64 + vg * 8 + 4) = make_float4(o[4], o[5], o[6], o[7]); }
      }
    }
    __builtin_amdgcn_s_waitcnt(0xc07f);
    __builtin_amdgcn_wave_barrier();
    if (PASS == 1) {
#pragma unroll
      for (int s = 0; s < 8; ++s) {
        const float o = ob[s * 64 + lane];
        const float ms = wave_sum(o * o, lane) * (1.0f / 64.0f);
        p[(size_t)(tbase + s) * NIN + C_HG + ch] = f2bf(o * rsqrtf(ms + 1e-6f) * ng * siluf_(bf2f(gc[s])));
      }
      __builtin_amdgcn_s_waitcnt(0xc07f);
      __builtin_amdgcn_wave_barrier();
    }
  }
  if (PASS == 0) {
#pragma unroll
    for (int i = 0; i < 8; ++i) { *(float4*)(slot + (kg * 8 + i) * 64 + vg * 8) = make_float4(S[i][0], S[i][1], S[i][2], S[i][3]);
      *(float4*)(slot + (kg * 8 + i) * 64 + vg * 8 + 4) = make_float4(S[i][4], S[i][5], S[i][6], S[i][7]); }
    HF[(size_t)(bh * 128 + chunk) * 64 + lane] = Fp;
  }
}
__device__ __forceinline__ void hgrn_combine_item(KP P, int bh, int wv_) {
#ifdef OFF_hgrn_combine_item
  return;
#endif

  float* HS = (float*)(P->ws + WS_HS); const float* HF = (const float*)(P->ws + WS_HF);
  const int tid = opaque_tid(wv_);
  const int krow = tid >> 3;
  float R[8];
#pragma unroll
  for (int e = 0; e < 8; ++e) R[e] = 0.f;
  float4 xa[8][2]; float fa[8];
#pragma unroll
  for (int u = 0; u < 8; ++u) { const float* sl = HS + (size_t)(bh * 128 + u) * 4096 + tid * 8; xa[u][0] = *(const float4*)sl; xa[u][1] = *(const float4*)(sl + 4); fa[u] = HF[(size_t)(bh * 128 + u) * 64 + krow]; }
#pragma unroll 1
  for (int c0 = 0; c0 < 128; c0 += 8) {
    float4 xn[8][2]; float fn[8];
    if (c0 + 8 < 128) {
#pragma unroll
      for (int u = 0; u < 8; ++u) { const float* sl = HS + (size_t)(bh * 128 + c0 + 8 + u) * 4096 + tid * 8; xn[u][0] = *(const float4*)sl; xn[u][1] = *(const float4*)(sl + 4); fn[u] = HF[(size_t)(bh * 128 + c0 + 8 + u) * 64 + krow]; }
    }
#pragma unroll
    for (int u = 0; u < 8; ++u) {
      float* sl = HS + (size_t)(bh * 128 + c0 + u) * 4096 + tid * 8;
      *(float4*)sl = make_float4(R[0], R[1], R[2], R[3]); *(float4*)(sl + 4) = make_float4(R[4], R[5], R[6], R[7]);
      const float f = fa[u];
      R[0] = fmaf(f, R[0], xa[u][0].x); R[1] = fmaf(f, R[1], xa[u][0].y); R[2] = fmaf(f, R[2], xa[u][0].z); R[3] = fmaf(f, R[3], xa[u][0].w);
      R[4] = fmaf(f, R[4], xa[u][1].x); R[5] = fmaf(f, R[5], xa[u][1].y); R[6] = fmaf(f, R[6], xa[u][1].z); R[7] = fmaf(f, R[7], xa[u][1].w);
    }
    if (c0 + 8 < 128) {
#pragma unroll
      for (int u = 0; u < 8; ++u) { xa[u][0] = xn[u][0]; xa[u][1] = xn[u][1]; fa[u] = fn[u]; }
    }
  }
}

__device__ __forceinline__ void sb_item(KP P, int item, unsigned char* lds, int wv_) {
#ifdef OFF_sb_item
  return;
#endif

  bf16_t* p = (bf16_t*)(P->ws + WS_P);
  const int tid = opaque_tid(wv_), lane = tid & 63, w = tid >> 6;
  const int qt = item & 127, bh = item >> 7, b = bh >> 2, head = bh & 3;
  unsigned char* Qs = lds;
  unsigned char* Ks = lds + 9216;
  unsigned char* Vt = lds + 18432;
  unsigned char* As = lds + 27648;
  float* Zs = (float*)(lds + 36864);
  volatile int* flag = (volatile int*)(lds + 36864 + 64 * 65 * 4);
  const int lrow = tid >> 3, lch = (tid & 7);
  const size_t tokq = (size_t)b * TSEQ + qt * 64;
  *(uint4*)(Qs + lrow * 144 + lch * 16) = *(const uint4*)(p + (tokq + lrow) * NIN + C_SQ + head * 64 + lch * 8);
  float carry = 0.f;
  f32x4 oacc[2] = {{0.f, 0.f, 0.f, 0.f}, {0.f, 0.f, 0.f, 0.f}};
  const int qi = w >> 1, t2 = (w & 1) * 2;
  const int q = tid >> 3, seg = tid & 7;
  uint4 kreg = *(const uint4*)(p + (tokq + lrow) * NIN + C_SK + head * 64 + lch * 8);
  const int vkey = tid & 63, vch = tid >> 6;
  uint4 vreg = *(const uint4*)(p + (tokq + vkey) * NIN + C_SV + head * 64 + vch * 8);
  for (int kt = qt; kt >= 0; --kt) {
    LBAR();
    *(uint4*)(Ks + lrow * 144 + lch * 16) = kreg;
    { const unsigned vw[4] = {vreg.x, vreg.y, vreg.z, vreg.w};
#pragma unroll
      for (int e = 0; e < 8; ++e) *(unsigned short*)(Vt + (vch * 8 + e) * 144 + vkey * 2) = (unsigned short)((e & 1) ? (vw[e >> 1] >> 16) : (vw[e >> 1] & 0xffffu)); }
    if (tid == 0) *flag = 0;
    if (kt > 0) { const size_t tokn = (size_t)b * TSEQ + (kt - 1) * 64;
      kreg = *(const uint4*)(p + (tokn + lrow) * NIN + C_SK + head * 64 + lch * 8);
      vreg = *(const uint4*)(p + (tokn + vkey) * NIN + C_SV + head * 64 + vch * 8); }
    LBAR();
#pragma unroll
    for (int jj = 0; jj < 2; ++jj) {
      const int ki = t2 + jj;
      f32x4 acc = {0.f, 0.f, 0.f, 0.f};
#pragma unroll
      for (int s = 0; s < 2; ++s) {
        const bf16x8 a = *(const bf16x8*)(Qs + (qi * 16 + (lane & 15)) * 144 + s * 64 + (lane >> 4) * 16);
        const bf16x8 bb = *(const bf16x8*)(Ks + (ki * 16 + (lane & 15)) * 144 + s * 64 + (lane >> 4) * 16);
        acc = __builtin_amdgcn_mfma_f32_16x16x32_bf16(a, bb, acc, 0, 0, 0);
      }
#pragma unroll
      for (int r = 0; r < 4; ++r) Zs[(qi * 16 + (lane >> 4) * 4 + r) * 65 + ki * 16 + (lane & 15)] = acc[r] * 0.125f;
    }
    LBAR();
    {
      const int tq = qt * 64 + q;
      float z[8], lk[8];
      float tot = 0.f;
#pragma unroll
      for (int e = 0; e < 8; ++e) {
        z[e] = Zs[q * 65 + seg * 8 + e];
        const bool m = (kt * 64 + seg * 8 + e) < tq;
        lk[e] = m ? -softplus_fast(z[e]) : 0.f;
        tot += lk[e];
      }
      float inc = tot;
      { float t_ = bperm(inc, lane + 1); if (seg + 1 < 8) inc += t_; }
      { float t_ = bperm(inc, lane + 2); if (seg + 2 < 8) inc += t_; }
      { float t_ = bperm(inc, lane + 4); if (seg + 4 < 8) inc += t_; }
      const float rowtot = bperm(inc, lane & ~7);
      float tail = carry + (inc - tot);
      float av[8];
#pragma unroll
      for (int e = 7; e >= 0; --e) {
        const bool m = (kt * 64 + seg * 8 + e) < tq;
        av[e] = m ? __expf(z[e] + lk[e] + tail) : 0.f;
        tail += lk[e];
      }
      uint4 o; o.x = pack2(av[0], av[1]); o.y = pack2(av[2], av[3]); o.z = pack2(av[4], av[5]); o.w = pack2(av[6], av[7]);
      *(uint4*)(As + q * 144 + seg * 16) = o;
      carry += rowtot;
      if (carry > -100.f) *flag = 1;
    }
    LBAR();
#pragma unroll
    for (int jj = 0; jj < 2; ++jj) {
      const int di = t2 + jj;
#pragma unroll
      for (int s = 0; s < 2; ++s) {
        const bf16x8 a = *(const bf16x8*)(As + (qi * 16 + (lane & 15)) * 144 + s * 64 + (lane >> 4) * 16);
        const bf16x8 bb = *(const bf16x8*)(Vt + (di * 16 + (lane & 15)) * 144 + s * 64 + (lane >> 4) * 16);
        oacc[jj] = __builtin_amdgcn_mfma_f32_16x16x32_bf16(a, bb, oacc[jj], 0, 0, 0);
      }
    }
    if (*flag == 0) break;
  }
#pragma unroll
  for (int jj = 0; jj < 2; ++jj) {
    const int d = (t2 + jj) * 16 + (lane & 15);
#pragma unroll
    for (int r = 0; r < 4; ++r) {
      const int qq = qi * 16 + (lane >> 4) * 4 + r;
      bf16_t* gp = p + (tokq + qq) * NIN + C_SG + head * 64 + d;
      *gp = f2bf(oacc[jj][r] * siluf_(bf2f(*gp)));
    }
  }
  __syncthreads();
}

__device__ __forceinline__ void xattn_item(KP P, int l, int item, unsigned char* lds, int wv_) {
  const bf16_t* qb = (const bf16_t*)(P->ws + WS_P + 32ull * MiB);
  bf16_t* ob = (bf16_t*)(P->ws + WS_P + 64ull * MiB);
  const bf16_t* kv = (const bf16_t*)(P->ws + WS_KV) + (size_t)l * 512 * 2048;
  const bf16_t* vt = (const bf16_t*)(P->ws + WS_VT) + (size_t)l * 2 * 1024 * 256;
  const int tid = opaque_tid(wv_), lane = tid & 63, w = tid >> 6;
  const int qt = item & 127, bh = item >> 7, b = bh >> 2, head = bh & 3;
  unsigned char* Qs = lds;
  unsigned char* KVs = lds + 33792;
  float* Ss = (float*)(lds + 67584);
  const size_t tok0 = (size_t)b * TSEQ + qt * 64;
  const int pr = tid >> 5, pc = tid & 31;
  uint4 pg0, pg1, pg2, pg3;
#define XA_LOAD(p_) { const bf16_t* s_ = (p_) < 4 ? kv + (size_t)(b * 256 + (p_) * 64 + pr) * 2048 + head * 256 + pc * 8 : vt + (size_t)(b * 1024 + head * 256 + ((p_) - 4) * 64 + pr) * 256 + pc * 8; \
      const size_t st_ = (p_) < 4 ? (size_t)16 * 2048 : (size_t)16 * 256; \
      pg0 = *(const uint4*)(s_); pg1 = *(const uint4*)(s_ + st_); pg2 = *(const uint4*)(s_ + 2 * st_); pg3 = *(const uint4*)(s_ + 3 * st_); }
  __syncthreads();
#pragma unroll
  for (int i = 0; i < 4; ++i) { const int r = pr + 16 * i; *(uint4*)(Qs + r * 528 + pc * 16) = *(const uint4*)(qb + (tok0 + r) * 1024 + head * 256 + pc * 8); }
  XA_LOAD(0);
  const int qi = w >> 1, t2 = (w & 1) * 2;
#pragma unroll 1
  for (int p = 0; p < 8; ++p) {
    LBAR();
    { unsigned char* d_ = KVs + pr * 528 + pc * 16; *(uint4*)d_ = pg0; *(uint4*)(d_ + 16 * 528) = pg1; *(uint4*)(d_ + 32 * 528) = pg2; *(uint4*)(d_ + 48 * 528) = pg3; }
    if (p < 7) XA_LOAD(p + 1);
    LBAR();
    f32x4 acc0 = {0.f, 0.f, 0.f, 0.f}, acc1 = {0.f, 0.f, 0.f, 0.f};
#pragma unroll
    for (int s = 0; s < 8; ++s) {
      const bf16x8 a = *(const bf16x8*)(Qs + (qi * 16 + (lane & 15)) * 528 + s * 64 + (lane >> 4) * 16);
      const bf16x8 b0 = *(const bf16x8*)(KVs + (t2 * 16 + (lane & 15)) * 528 + s * 64 + (lane >> 4) * 16);
      const bf16x8 b1 = *(const bf16x8*)(KVs + ((t2 + 1) * 16 + (lane & 15)) * 528 + s * 64 + (lane >> 4) * 16);
      acc0 = __builtin_amdgcn_mfma_f32_16x16x32_bf16(a, b0, acc0, 0, 0, 0);
      acc1 = __builtin_amdgcn_mfma_f32_16x16x32_bf16(a, b1, acc1, 0, 0, 0);
    }
    if (p < 4) {
#pragma unroll
      for (int r = 0; r < 4; ++r) { float* d_ = Ss + (qi * 16 + (lane >> 4) * 4 + r) * 260 + p * 64 + t2 * 16 + (lane & 15); d_[0] = acc0[r] * 0.0625f; d_[16] = acc1[r] * 0.0625f; }
      if (p == 3) {
        LBAR();
        const int q = tid >> 3, seg = tid & 7;
        float x[32]; float mx = -3.0e38f;
#pragma unroll
        for (int i = 0; i < 8; ++i) { const float4 v = *(const float4*)(Ss + q * 260 + seg * 32 + i * 4); x[i * 4] = v.x; x[i * 4 + 1] = v.y; x[i * 4 + 2] = v.z; x[i * 4 + 3] = v.w;
          mx = fmaxf(mx, fmaxf(fmaxf(v.x, v.y), fmaxf(v.z, v.w))); }
        mx = max8(mx);
        float sum = 0.f;
#pragma unroll
        for (int i = 0; i < 32; ++i) { x[i] = __expf(x[i] - mx); sum += x[i]; }
        sum = red8(sum);
        const float inv = __builtin_amdgcn_rcpf(sum);
#pragma unroll
        for (int i = 0; i < 4; ++i) { uint4 o; o.x = pack2(x[i * 8] * inv, x[i * 8 + 1] * inv); o.y = pack2(x[i * 8 + 2] * inv, x[i * 8 + 3] * inv);
          o.z = pack2(x[i * 8 + 4] * inv, x[i * 8 + 5] * inv); o.w = pack2(x[i * 8 + 6] * inv, x[i * 8 + 7] * inv);
          *(uint4*)(Qs + q * 528 + seg * 64 + i * 16) = o; }
      }
    } else {
#pragma unroll
      for (int r = 0; r < 4; ++r) { bf16_t* d_ = ob + (tok0 + qi * 16 + (lane >> 4) * 4 + r) * 1024 + head * 256 + (p - 4) * 64 + t2 * 16 + (lane & 15); d_[0] = f2bf(acc0[r]); d_[16] = f2bf(acc1[r]); }
    }
  }
#undef XA_LOAD
  __syncthreads();
}

__device__ __forceinline__ void wt_item(KP P, int l, int r, unsigned char* lds, int wv_) {
  const float* W; int N; bf16_t* Wt; int kt, nt; const float* gk = nullptr;
  unsigned char* wl = P->ws + WS_WT + l * WT_LAYER;
  if (r < 976) { W = P->in[3] + (size_t)l * 1024 * NIN; N = NIN; Wt = (bf16_t*)(wl + WT_IN); kt = r / 61; nt = r % 61; gk = P->in[2] + l * 1024; }
  else { r -= 976; const int m = r >> 8; r &= 255; kt = r >> 4; nt = r & 15; N = 1024;
    if (m == 0) { W = P->in[20] + (size_t)l * 1048576; Wt = (bf16_t*)(wl + WT_OUT); }
    else if (m == 1) { W = P->in[23] + (size_t)l * 1048576; Wt = (bf16_t*)(wl + WT_Q); gk = P->in[21] + l * 1024; }
    else if (m == 2) { W = P->in[24] + (size_t)l * 1048576; Wt = (bf16_t*)(wl + WT_KV); }
    else if (m == 3) { W = P->in[25] + (size_t)l * 1048576; Wt = (bf16_t*)(wl + WT_KV) + 1024 * 1024; }
    else { W = P->in[26] + (size_t)l * 1048576; Wt = (bf16_t*)(wl + WT_O); } }
  wt_tile(W, N, Wt, kt, nt, lds, wv_, gk);
}
__device__ __forceinline__ void wt_deferred(KP P, int d, unsigned char* lds, int wv_) {
  if (d < 768) { const int m = d >> 8, r = d & 255; wt_item(P, 0, 976 + (m == 0 ? 0 : m == 1 ? 256 : 1024) + r, lds, wv_); }
  else wt_item(P, 1, d - 768, lds, wv_);
}
__device__ __forceinline__ int next_item(unsigned* ctr, volatile LAS int* slot, int wv_) {
  __syncthreads();
  if (opaque_tid(wv_) == 0) *slot = (int)__hip_atomic_fetch_add(ctr, 1u, __ATOMIC_RELAXED, __HIP_MEMORY_SCOPE_AGENT);
  __syncthreads();
  return *slot;
}
__global__ void __launch_bounds__(NTHR) fwd_megakernel(Params Pk_unused) {
  KP P = (KP)__builtin_amdgcn_kernarg_segment_ptr();
  extern __shared__ __attribute__((aligned(16))) unsigned char lds[];
  const int wv_ = __builtin_amdgcn_readfirstlane((int)threadIdx.x >> 6);
  __shared__ uint4 xb_words;
  __shared__ int4 wq_slot;
  if (opaque_tid(wv_) == 0) xb_words = make_uint4(0u, 0u, 0u, 0u);
  __syncthreads();
#ifdef PROBE_J
  __shared__ unsigned long long tacc[32];
  __shared__ unsigned long long tlast;
  __shared__ float pdelta;
  if (opaque_tid(wv_) == 0) { for (int i = 0; i < 32; ++i) tacc[i] = 0ull; tlast = __builtin_amdgcn_s_memrealtime(); pdelta = 0.f; }
#define STAMP(k) if (opaque_tid(wv_) == 0) { const unsigned long long n_ = __builtin_amdgcn_s_memrealtime(); tacc[k] += n_ - tlast; tlast = n_; }
#else
#define STAMP(k)
#endif
  XcdBarrier bar = xcd_barrier_post((unsigned*)(P->ws + WS_BAR), (volatile LAS unsigned*)&xb_words, wv_);
  if (P->never) cg::this_grid().sync();
  const int G = gridDim.x, bid0 = blockIdx.x;

  for (int it = bid0; it < 976 + 512; it += G) wt_item(P, 0, it < 976 ? it : it + 512, lds, wv_);
#pragma unroll 1
  for (int k = 0; k < 3; ++k) {
    const float* s_ = k < 2 ? P->in[1] : P->in[0];
    const float* g_ = k < 2 ? P->in[22] + k * 1024 : P->in[2];
    bf16_t* d_ = k < 2 ? (bf16_t*)(P->ws + WS_MEMN) + k * 512 * 1024 : (bf16_t*)(P->ws + WS_R1);
    norm_rows(false, s_, g_, d_, k < 2 ? 512 : NT, 0.f, wv_, k < 2 ? nullptr : (float*)(P->ws + WS_SSQ));
  }
  { float* z_ = (float*)(P->ws + WS_SSQ) + NT; for (int i = bid0 * NTHR + opaque_tid(wv_); i < 4 * NT; i += G * NTHR) z_[i] = 0.f; }
  STAMP(16 + 10); xcd_barrier(bar, wv_); STAMP(10)
  asm volatile("" : "+s"(P));

#pragma unroll 1
  for (int it = 0; it < 17; ++it) {
    int l = it >> 3, ph = it & 7;
    ph = ph < 5 ? ph : ph + 1;
    if (it == 16) { l = 1; ph = 9; }
    asm volatile("" : "+s"(P));
    int bid = bid0; asm volatile("" : "+s"(bid));

    unsigned char* ws = P->ws;
    const unsigned char* wl = ws + WS_WT + l * WT_LAYER;
    bf16_t* hbuf = (bf16_t*)(ws + WS_R1);
    float* ssq = (float*)(ws + WS_SSQ);
    bf16_t* pbuf = (bf16_t*)(ws + WS_P);
    bf16_t* hx = (bf16_t*)(ws + WS_P);
    bf16_t* qbuf = (bf16_t*)(ws + WS_P + 32ull * MiB);
    bf16_t* obuf = (bf16_t*)(ws + WS_P + 64ull * MiB);
    if (ph == 0 || ph == 4 || ph == 6 || ph == 8) {
      pg8::Gemm g; pg8::TileSched S; pg8::EpiDyn E;
      g.M = NT; g.K = 1024; S.G = G; S.c = bid;
      if (ph == 0) { g.A = hbuf; g.Bt = (const bf16_t*)(wl + WT_IN); g.N = 4096; g.lda = 1024; g.ao0 = 0; g.ao1 = 256; g.ao2 = 512; g.ao3 = 768; S.nt = 1024; S.nN = 16;
        E.mode = 0; E.O = pbuf; E.ldc = NIN; E.N = NIN; E.resid = nullptr; E.out = nullptr; E.ssq_in = ssq + (l == 0 ? 0 : 2) * NT; E.xb = nullptr; E.ssq_out = nullptr; }
      else if (ph == 4) { g.A = pbuf; g.Bt = (const bf16_t*)(wl + WT_OUT); g.N = 1024; g.lda = NIN; g.ao0 = C_GA; g.ao1 = C_CGATE; g.ao2 = C_HG; g.ao3 = C_SG; S.nt = 256; S.nN = 4;
        E.mode = 1; E.O = nullptr; E.ldc = 1024; E.N = 1024; E.resid = (l == 0) ? P->in[0] : P->out; E.out = P->out; E.ssq_in = nullptr; E.xb = hbuf; E.ssq_out = ssq + (l == 0 ? 1 : 3) * NT; }
      else if (ph == 6) { g.A = hbuf; g.Bt = (const bf16_t*)(wl + WT_Q); g.N = 1024; g.lda = 1024; g.ao0 = 0; g.ao1 = 256; g.ao2 = 512; g.ao3 = 768; S.nt = 256; S.nN = 4;
        E.mode = 0; E.O = qbuf; E.ldc = 1024; E.N = 1024; E.resid = nullptr; E.out = nullptr; E.ssq_in = ssq + (l == 0 ? 1 : 3) * NT; E.xb = nullptr; E.ssq_out = nullptr; }
      else { g.A = obuf; g.Bt = (const bf16_t*)(wl + WT_O); g.N = 1024; g.lda = 1024; g.ao0 = 0; g.ao1 = 256; g.ao2 = 512; g.ao3 = 768; S.nt = 256; S.nN = 4;
        E.mode = 1; E.O = nullptr; E.ldc = 1024; E.N = 1024; E.resid = P->out; E.out = P->out; E.ssq_in = nullptr; E.xb = hbuf; E.ssq_out = ssq + (l == 0 ? 2 : 4) * NT; }
      pg8::gemm_phase<pg8::EpiDyn, pg8::TileSched, true, true>((PG8_LAS unsigned char*)lds, g, S, E, wv_);
    } else if (ph == 1) {
      unsigned* ctr = (unsigned*)(ws + WS_BAR) + it;
      for (;;) {
        const int i2 = next_item(ctr, (volatile LAS int*)&wq_slot, wv_);
        if (i2 >= 640) break;
        if (i2 < 128) hgrn_wave_item<0>(P, l, i2 * 8 + wv_, lds, wv_);
        else rwkv_prep_item(P, l, i2 - 128, lds, wv_);
      }
    } else if (ph == 2) {
      const int n_p1 = 8 * (RW_C - 2);
      const int n_rw = n_p1 + 8;
      const int n_oth = 8 + 512 + 1024;
      if (G > n_rw + 32) {
        if (bid < n_rw) {
          if (bid < n_p1) rwkv_scan_item<1>(P, l, bid & 7, 1 + (bid >> 3), lds, wv_);
          else rwkv_scan_item<0>(P, l, bid - n_p1, 0, lds, wv_);
        } else {
          unsigned* ctr = (unsigned*)(ws + WS_BAR) + it;
          for (;;) {
            const int i2 = next_item(ctr, (volatile LAS int*)&wq_slot, wv_);
            if (i2 >= n_oth) break;
            if (i2 < 8) hgrn_combine_item(P, i2, wv_);
            else if (i2 < 8 + 512) conv_item(P, l, i2 - 8, lds, wv_);
            else sb_item(P, i2 - 8 - 512, lds, wv_);
          }
        }
      } else {
        for (int i2 = bid; i2 < n_rw + n_oth; i2 += G) {
          if (i2 < n_p1) rwkv_scan_item<1>(P, l, i2 & 7, 1 + (i2 >> 3), lds, wv_);
          else if (i2 < n_rw) rwkv_scan_item<0>(P, l, i2 - n_p1, 0, lds, wv_);
          else if (i2 < n_rw + 8) hgrn_combine_item(P, i2 - n_rw, wv_);
          else if (i2 < n_rw + 8 + 512) conv_item(P, l, i2 - n_rw - 8, lds, wv_);
          else sb_item(P, i2 - n_rw - 8 - 512, lds, wv_);
          __syncthreads();
        }
      }
    } else if (ph == 3) {
      const int n_p3 = 8 * (RW_C - 1);
      if (G > n_p3 + 32) {
        if (bid < n_p3) rwkv_scan_item<0>(P, l, bid & 7, 1 + (bid >> 3), lds, wv_);
        else {
          unsigned* ctr = (unsigned*)(ws + WS_BAR) + it;
          for (;;) {
            const int i2 = next_item(ctr, (volatile LAS int*)&wq_slot, wv_);
            if (i2 >= 16 + 128 + (l == 0 ? 189 : 0)) break;
            if (i2 >= 16 + 128) { for (int d = (i2 - 144) * 16; d < (i2 - 144) * 16 + 16; ++d) wt_deferred(P, d, lds, wv_); }
            else if (i2 < 16) gemm_tile<2>((const bf16_t*)(ws + WS_MEMN) + (size_t)l * 512 * 1024, 1024, 0, 256, 512, 768, (const bf16_t*)(wl + WT_KV), (i2 >> 3) * 256, (i2 & 7) * 256, 2048,
                                      (bf16_t*)(ws + WS_KV) + (size_t)l * 512 * 2048, (const float*)((bf16_t*)(ws + WS_VT) + (size_t)l * 2 * 1024 * 256), 2048, lds, wv_);
            else hgrn_wave_item<1>(P, l, (i2 - 16) * 8 + wv_, lds, wv_);
          }
        }
      } else {
        const int n_all = n_p3 + 128 + 16;
        if (l == 0) for (int d = bid; d < 3024; d += G) wt_deferred(P, d, lds, wv_);
        for (int i2 = bid; i2 < n_all; i2 += G) {
          if (i2 < n_p3) rwkv_scan_item<0>(P, l, i2 & 7, 1 + (i2 >> 3), lds, wv_);
          else if (i2 < n_p3 + 128) hgrn_wave_item<1>(P, l, (i2 - n_p3) * 8 + wv_, lds, wv_);
          else { const int t = i2 - n_p3 - 128; gemm_tile<2>((const bf16_t*)(ws + WS_MEMN) + (size_t)l * 512 * 1024, 1024, 0, 256, 512, 768, (const bf16_t*)(wl + WT_KV), (t >> 3) * 256, (t & 7) * 256, 2048,
                                                            (bf16_t*)(ws + WS_KV) + (size_t)l * 512 * 2048, (const float*)((bf16_t*)(ws + WS_VT) + (size_t)l * 2 * 1024 * 256), 2048, lds, wv_); }
          __syncthreads();
        }
      }
    } else if (ph == 7) {
      for (int i2 = bid; i2 < 1024; i2 += G) xattn_item(P, l, i2, lds, wv_);
    } else {
      const bool fin = true;
      const float* g_ = P->in[27];
      void* d_ = (void*)P->out;
#ifdef PROBE_J
      float pd_ = 0.f;
      if (fin) {
        if (bid == PROBE_B) {
          if (opaque_tid(wv_) == 0) {
            unsigned long long tot = 0ull; for (int i = 0; i < 11; ++i) tot += tacc[i] + tacc[16 + i];
            pdelta = sqrtf(0.0128f * (float)(PROBE_J < 32 ? tacc[PROBE_J & 31] : tacc[PROBE_J - 32] + tacc[PROBE_J - 16]) / (float)tot);
          }
          __syncthreads();
          pd_ = pdelta;
        }
      }
      norm_rows(fin, P->out, g_, d_, NT, pd_, wv_);
#else
      norm_rows(fin, P->out, g_, d_, NT, 0.f, wv_);
#endif
    }
    if (it < 16) { STAMP(16 + ph); xcd_barrier(bar, wv_); STAMP(ph) }
  }
#ifdef PROBE_J
  if (bid0 == PROBE_B && opaque_tid(wv_) == 0) {
    const unsigned long long t0_ = __builtin_amdgcn_s_memrealtime();
    const unsigned long long w_ = 4ull * (PROBE_K < 32 ? tacc[PROBE_K & 31] : tacc[PROBE_K - 32] + tacc[PROBE_K - 16]);
    while (__builtin_amdgcn_s_memrealtime() - t0_ < w_) __builtin_amdgcn_s_sleep(8);
  }
#endif
}

extern "C" void kernel_launch(void* const* d_in, const int* in_sizes, int n_in, void* d_out, int out_size, void* d_ws, size_t ws_size, hipStream_t stream) {
  constexpr size_t kDynLds = 147456;
  static int grid_blocks = 0;
  if (!grid_blocks) {
    int dev = 0, cus = 0, per_cu = 0;
    hipGetDevice(&dev);
    hipDeviceGetAttribute(&cus, hipDeviceAttributeMultiprocessorCount, dev);
    hipFuncSetAttribute((const void*)fwd_megakernel, hipFuncAttributeMaxDynamicSharedMemorySize, (int)kDynLds);
    hipOccupancyMaxActiveBlocksPerMultiprocessor(&per_cu, fwd_megakernel, NTHR, kDynLds);
    if (per_cu < 1) per_cu = 1;
    if (per_cu > 1) per_cu = 1;
    grid_blocks = cus * per_cu;
    if (grid_blocks > 256) grid_blocks = 256;
  }
  Params p;
  memset(&p, 0, sizeof(p));
  for (int i = 0; i < 28; ++i) p.in[i] = (const float*)d_in[i];
  p.out = (float*)d_out; p.ws = (unsigned char*)d_ws; p.never = 0; p.pad = 0;
  hipMemsetAsync(d_ws, 0, XCD_BAR_WORDS * 4, stream);
  void* args[] = {&p};
  hipError_t e = hipLaunchCooperativeKernel((void*)fwd_megakernel, dim3(grid_blocks), dim3(NTHR), args, kDynLds, stream);
  if (e != hipSuccess) fprintf(stderr, "cooperative launch failed: %s (grid %d)\n", hipGetErrorString(e), grid_blocks);
}
```

```cpp
#include <hip/hip_runtime.h>
#include <hip/hip_cooperative_groups.h>
#include <stdint.h>
#include <cstdio>
#include <cstring>
namespace cg = cooperative_groups;

typedef unsigned short bf16_t;
typedef short bf16x8 __attribute__((ext_vector_type(8)));
typedef float f32x4 __attribute__((ext_vector_type(4)));
typedef float f32x16 __attribute__((ext_vector_type(16)));
typedef float f32x2 __attribute__((ext_vector_type(2)));
#define LAS __attribute__((address_space(3)))

#define NT 16384
#define TSEQ 8192
#define DM 1024
#define NIN 3904
#define NTHR 512
#define C_R 0
#define C_K 256
#define C_V 512
#define C_XW 768
#define C_GA 832
#define C_CVAL 1088
#define C_CGLU 1344
#define C_CGATE 1600
#define C_HQ 1856
#define C_HF 2112
#define C_HI 2368
#define C_HG 2624
#define C_SQ 2880
#define C_SK 3136
#define C_SV 3392
#define C_SG 3648
#define RW_C 32
#define RW_CL (TSEQ / RW_C)
#define RW_TT 16

#define MiB (1024ull * 1024ull)
#define WS_BAR   0ull
#define WS_WT    (1ull * MiB)
#define WT_LAYER (18ull * MiB)
#define WT_IN    0ull
#define WT_OUT   (8ull * MiB)
#define WT_Q     (10ull * MiB)
#define WT_KV    (12ull * MiB)
#define WT_O     (16ull * MiB)
#define WS_MEMN  (37ull * MiB)
#define WS_KV    (39ull * MiB)
#define WS_PQ    (246ull * MiB)
#define WS_HS    (47ull * MiB)
#define WS_HF    (63ull * MiB)
#define WS_RK    (63ull * MiB + 512ull * 1024ull)
#define WS_R1    (64ull * MiB)
#define WS_PW    WS_R1
#define WS_PV    (WS_R1 + 16ull * MiB)
#define WS_P     (120ull * MiB)
#define WS_VT    (243ull * MiB)
#define WS_SSQ   (245ull * MiB)
#define WS_END   (254ull * MiB)

struct Params {
  const float* in[28];
  float* out;
  unsigned char* ws;
  int never;
  int pad;
};

typedef const __attribute__((address_space(4))) Params* KP;
__device__ __forceinline__ int lane_id_() { return (int)__builtin_amdgcn_mbcnt_hi(~0u, __builtin_amdgcn_mbcnt_lo(~0u, 0u)); }
__device__ __forceinline__ int opaque_tid(int wv_) { int t; asm volatile("v_mbcnt_lo_u32_b32 %0, -1, 0\n\tv_mbcnt_hi_u32_b32 %0, -1, %0\n\tv_lshl_add_u32 %0, %1, 6, %0" : "=&v"(t) : "s"(wv_)); return t; }
__device__ __forceinline__ float bf2f(bf16_t v) { return __uint_as_float(((unsigned)v) << 16); }
__device__ __forceinline__ bf16_t f2bf(float f) {
  unsigned u = __float_as_uint(f);
  u += 0x7fffu + ((u >> 16) & 1u);
  return (bf16_t)(u >> 16);
}
__device__ __forceinline__ unsigned pack2(float a, float b) { return (unsigned)f2bf(a) | ((unsigned)f2bf(b) << 16); }
__device__ __forceinline__ float sigmoidf_(float x) { return __builtin_amdgcn_rcpf(1.0f + __expf(-x)); }
__device__ __forceinline__ float siluf_(float x) { return x * __builtin_amdgcn_rcpf(1.0f + __expf(-x)); }
__device__ __forceinline__ float softplusf_(float x) { return fmaxf(x, 0.f) + log1pf(__expf(-fabsf(x))); }
__device__ __forceinline__ float softplus_fast(float x) { return fmaxf(x, 0.f) + __logf(1.0f + __expf(-fabsf(x))); }
__device__ __forceinline__ float dpp_add(float v, const int ctrl_sel) {
  return v;
}
__device__ __forceinline__ float bperm(float v, int srclane) { return __builtin_bit_cast(float, __builtin_amdgcn_ds_bpermute(srclane << 2, __builtin_bit_cast(int, v))); }
__device__ __forceinline__ float wave_sum(float v, int lane) {
  v += __builtin_bit_cast(float, __builtin_amdgcn_update_dpp(0, __builtin_bit_cast(int, v), 0xB1, 0xF, 0xF, true));
  v += __builtin_bit_cast(float, __builtin_amdgcn_update_dpp(0, __builtin_bit_cast(int, v), 0x4E, 0xF, 0xF, true));
  v += __builtin_bit_cast(float, __builtin_amdgcn_update_dpp(0, __builtin_bit_cast(int, v), 0x141, 0xF, 0xF, true));
  v += __builtin_bit_cast(float, __builtin_amdgcn_update_dpp(0, __builtin_bit_cast(int, v), 0x140, 0xF, 0xF, true));
  v += bperm(v, lane ^ 16);
  v += bperm(v, lane ^ 32);
  return v;
}
__device__ __forceinline__ float max8(float v) {
  v = fmaxf(v, __builtin_bit_cast(float, __builtin_amdgcn_update_dpp(0, __builtin_bit_cast(int, v), 0xB1, 0xF, 0xF, true)));
  v = fmaxf(v, __builtin_bit_cast(float, __builtin_amdgcn_update_dpp(0, __builtin_bit_cast(int, v), 0x4E, 0xF, 0xF, true)));
  v = fmaxf(v, __builtin_bit_cast(float, __builtin_amdgcn_update_dpp(0, __builtin_bit_cast(int, v), 0x141, 0xF, 0xF, true)));
  return v;
}
__device__ __forceinline__ float red8(float v) {
  v += __builtin_bit_cast(float, __builtin_amdgcn_update_dpp(0, __builtin_bit_cast(int, v), 0xB1, 0xF, 0xF, true));
  v += __builtin_bit_cast(float, __builtin_amdgcn_update_dpp(0, __builtin_bit_cast(int, v), 0x4E, 0xF, 0xF, true));
  v += __builtin_bit_cast(float, __builtin_amdgcn_update_dpp(0, __builtin_bit_cast(int, v), 0x141, 0xF, 0xF, true));
  return v;
}

#define LBAR() do { asm volatile("s_waitcnt lgkmcnt(0)" ::: "memory"); __builtin_amdgcn_s_barrier(); asm volatile("" ::: "memory"); } while (0)
#define XB_TMO      128
#define XB_XCNT(j)  (256  + 64 * (j))
#define XB_XSUB(j)  (1280 + 64 * (j))
#define XB_XGEN(j)  (2304 + 64 * (j))
#define XB_TOP      3328
#define XB_TOPGEN   3392
#define XCD_BAR_WORDS 3456
#define XB_SPIN_CAP (1u << 22)
__device__ __forceinline__ unsigned xb_ld(unsigned* p) { return __hip_atomic_load(p, __ATOMIC_RELAXED, __HIP_MEMORY_SCOPE_AGENT); }
__device__ __forceinline__ unsigned xb_add(unsigned* p, unsigned v) { return __hip_atomic_fetch_add(p, v, __ATOMIC_RELAXED, __HIP_MEMORY_SCOPE_AGENT); }
__device__ __forceinline__ unsigned xb_xcc_id() { return (unsigned)__builtin_amdgcn_s_getreg((3 << 11) | 20) & 0xFu; }
#define XB_SPIN(cond, bar) do { unsigned _sp = 0; while (cond) { __builtin_amdgcn_s_sleep(1); \
    if ((++_sp & 255u) == 0u) { if (xb_ld(&(bar)[XB_TMO])) break; if (_sp > XB_SPIN_CAP) { atomicAdd(&(bar)[XB_TMO], 1u); break; } } } } while (0)
struct XcdBarrier { unsigned* bar; unsigned x; volatile LAS unsigned* st; };
__device__ __forceinline__ XcdBarrier xcd_barrier_post(unsigned* bar, volatile LAS unsigned* st, int wv_) {
  XcdBarrier b; b.bar = bar; b.x = xb_xcc_id(); b.st = st;
  if (opaque_tid(wv_) == 0) (void)xb_add(&bar[XB_XCNT(b.x)], 1u);
  return b;
}
__device__ __forceinline__ void xcd_barrier_complete(unsigned* bar, unsigned x, unsigned& nloc, unsigned& nx) {
  const unsigned G = gridDim.x * gridDim.y * gridDim.z;
  unsigned sum, cnt, mine, sp = 0u;
  for (;;) {
    sum = 0u; cnt = 0u; mine = 0u;
#pragma unroll
    for (unsigned j = 0; j < 16; ++j) { const unsigned c = xb_ld(&bar[XB_XCNT(j)]); sum += c; cnt += (c > 0u) ? 1u : 0u; mine = (j == x) ? c : mine; }
    if (sum == G) break;
    __builtin_amdgcn_s_sleep(1);
    if ((++sp & 255u) == 0u) { if (xb_ld(&bar[XB_TMO])) break; if (sp > XB_SPIN_CAP) { atomicAdd(&bar[XB_TMO], 1u); break; } }
  }
  nloc = mine > 0u ? mine : 1u; nx = cnt > 0u ? cnt : 1u;
}
__device__ __forceinline__ void xcd_barrier(const XcdBarrier& b, int wv_) {
  asm volatile("s_waitcnt vmcnt(0)" ::: "memory");
  __syncthreads();
  if (opaque_tid(wv_) == 0) {
    unsigned* bar = b.bar;
    __builtin_amdgcn_s_waitcnt(0);
    unsigned bx = b.x; asm volatile("" : "+s"(bx));
    unsigned nloc = b.st[0], nx = b.st[1];
    if (nloc == 0u) { xcd_barrier_complete(bar, bx, nloc, nx); b.st[0] = nloc; b.st[1] = nx; }
    const unsigned old = xb_add(&bar[XB_XSUB(bx)], 1u);
    const unsigned gen = old / nloc;
    if (old + 1u == (gen + 1u) * nloc) {
      __builtin_amdgcn_fence(__ATOMIC_RELEASE, "agent");
      asm volatile("s_waitcnt vmcnt(0)" ::: "memory");
      const unsigned og = xb_add(&bar[XB_TOP], 1u);
      const unsigned tg = og / nx;
      if (og + 1u == (tg + 1u) * nx) xb_add(&bar[XB_TOPGEN], 1u);
      else XB_SPIN(xb_ld(&bar[XB_TOPGEN]) == tg, bar);
      __builtin_amdgcn_fence(__ATOMIC_ACQUIRE, "agent");
      xb_add(&bar[XB_XGEN(bx)], 1u);
      asm volatile("s_waitcnt vmcnt(0)" ::: "memory");
    } else {
      XB_SPIN(xb_ld(&bar[XB_XGEN(bx)]) == gen, bar);
      __builtin_amdgcn_fence(__ATOMIC_ACQUIRE, "agent");
      asm volatile("s_waitcnt vmcnt(0)" ::: "memory");
    }
  }
  __syncthreads();
}

#define G_STAGE 73728
#define G_BOFF 36864
template <int EPI>
__device__ __forceinline__ void gemm_tile(const bf16_t* __restrict__ A, int lda, int ao0, int ao1, int ao2, int ao3,
                                          const bf16_t* __restrict__ Bt, int m0, int n0, int N,
                                          void* out, const float* resid, int ldc, unsigned char* lds, int wv_) {
#ifdef OFF_gemm_tile
  return;
#endif

  const int tid = opaque_tid(wv_), lane = tid & 63, w = tid >> 6;
  const int wm = w >> 2, wn = w & 3, lr = lane & 31, lh = lane >> 5;
  f32x16 acc[4][2];
#pragma unroll
  for (int i = 0; i < 4; ++i)
#pragma unroll
    for (int j = 0; j < 2; ++j)
#pragma unroll
      for (int r = 0; r < 16; ++r) acc[i][j][r] = 0.f;
  uint4 ra[4], rb[4];
  const int crow = tid >> 3, ccol = (tid & 7) * 8;
  const bf16_t* Ap = A + (size_t)(m0 + crow) * lda + ccol;
  const bf16_t* Bp = Bt + (size_t)(n0 + crow) * 1024 + ccol;
#define G_LOAD(kt) { const int k0_ = (kt) * 64; const int seg_ = k0_ >> 8; const int ao_ = (seg_ == 0 ? ao0 : seg_ == 1 ? ao1 : seg_ == 2 ? ao2 : ao3) + (k0_ & 255); \
    _Pragma("unroll") for (int i_ = 0; i_ < 4; ++i_) { ra[i_] = *(const uint4*)(Ap + (size_t)(i_ * 64) * lda + ao_); rb[i_] = *(const uint4*)(Bp + (size_t)(i_ * 64) * 1024 + k0_); } }
#define G_WRITE(buf) { unsigned char* b_ = lds + (buf) * G_STAGE + crow * 144 + (tid & 7) * 16; \
    _Pragma("unroll") for (int i_ = 0; i_ < 4; ++i_) { *(uint4*)(b_ + i_ * 64 * 144) = ra[i_]; *(uint4*)(b_ + G_BOFF + i_ * 64 * 144) = rb[i_]; } }
  G_LOAD(0); G_WRITE(0); __syncthreads();
  for (int kt = 0; kt < 16; ++kt) {
    if (kt < 15) G_LOAD(kt + 1);
    const unsigned char* base = lds + (kt & 1) * G_STAGE;
    const unsigned char* ab = base + (wm * 128 + lr) * 144 + lh * 16;
    const unsigned char* bb = base + G_BOFF + (wn * 64 + lr) * 144 + lh * 16;
#pragma unroll
    for (int s = 0; s < 4; ++s) {
      bf16x8 a[4], b[2];
#pragma unroll
      for (int i = 0; i < 4; ++i) a[i] = *(const bf16x8*)(ab + i * 32 * 144 + s * 32);
#pragma unroll
      for (int j = 0; j < 2; ++j) b[j] = *(const bf16x8*)(bb + j * 32 * 144 + s * 32);
#pragma unroll
      for (int i = 0; i < 4; ++i)
#pragma unroll
        for (int j = 0; j < 2; ++j) acc[i][j] = __builtin_amdgcn_mfma_f32_32x32x16_bf16(a[i], b[j], acc[i][j], 0, 0, 0);
    }
    if (kt < 15) G_WRITE((kt + 1) & 1);
    __syncthreads();
  }
#undef G_LOAD
#undef G_WRITE
#pragma unroll
  for (int i = 0; i < 4; ++i)
#pragma unroll
    for (int j = 0; j < 2; ++j) {
      const int col = n0 + wn * 64 + j * 32 + lr;
#pragma unroll
      for (int r = 0; r < 16; ++r) {
        const int row = m0 + wm * 128 + i * 32 + (r & 3) + 8 * (r >> 2) + 4 * lh;
        if (EPI == 0) { if (col < N) ((bf16_t*)out)[(size_t)row * ldc + col] = f2bf(acc[i][j][r]); }
        else if (EPI == 2) { if (col < 1024) ((bf16_t*)out)[(size_t)row * ldc + col] = f2bf(acc[i][j][r]);
                             else ((bf16_t*)resid)[((size_t)((row >> 8) * 1024 + (col - 1024))) * 256 + (row & 255)] = f2bf(acc[i][j][r]); }
        else { ((float*)out)[(size_t)row * ldc + col] = resid[(size_t)row * ldc + col] + acc[i][j][r]; }
      }
    }
}

__device__ __forceinline__ void tile_map(int t, int nN, int& mi, int& ni) {
  const int rnd = t >> 8, blk = t & 255, x = blk & 7, y = blk >> 3;
  if (nN == 16) { mi = rnd * 16 + (x >> 1) * 4 + (y & 3); ni = (x & 1) * 8 + (y >> 2); }
  else { mi = rnd * 64 + x * 8 + (y & 7); ni = y >> 3; }
}

namespace pg8 {
#define PG8_LAS __attribute__((address_space(3)))
typedef unsigned u32x4 __attribute__((ext_vector_type(4)));
constexpr int BM = 256, BK = 64, HALF = 128, HTB = HALF * BK * 2  , STAGE_BYTES = 8 * HTB, NXCD = 8, WGM = 8;

__host__ __device__ __forceinline__ int lds_byte(int r, int c) { const int st = (r >> 4) * 2 + (c >> 5), rr = r & 15, cc = c & 31, ob = rr * 64 + cc * 2; return st * 1024 + (ob ^ (((ob >> 9) & 1) << 5)); }
__host__ __device__ __forceinline__ void stage_rc(int b, int& R, int& C) { const int st = b / 1024, sb = b % 1024, swz = sb ^ (((sb >> 9) & 1) << 5); R = (st >> 1) * 16 + swz / 64; C = (st & 1) * 32 + (swz % 64) / 2; }
__host__ __device__ __forceinline__ int perm32(int rho) { const int n = rho >> 4, i = rho & 15; return 8 * (i >> 2) + 4 * n + (i & 3); }

struct Unit { int pm, pn; };
struct Gemm { const bf16_t* A; const bf16_t* Bt; int M, N, K; int lda; int ao0, ao1, ao2, ao3; };

struct TileSched {
    int nt, G, c, nN;
    __device__ __forceinline__ bool next(int i, Unit& u) const { const int t = i * G + c; if (t >= nt) return false; tile_map(t, nN, u.pm, u.pn); return true; }
    __device__ __forceinline__ void a_ready(const Unit&) const {}
    __device__ __forceinline__ void done(const Unit&) const {}
};
__device__ __forceinline__ unsigned cvt_pk_bf16(float lo, float hi) { unsigned r; asm volatile("v_cvt_pk_bf16_f32 %0, %1, %2" : "=v"(r) : "v"(lo), "v"(hi)); return r; }
struct EpiStoreBf16 {
    static constexpr bool PERM = true, AFTER_DRAIN = false;
    bf16_t* O; int ldc; int N;
    __device__ __forceinline__ void operator()(const f32x4 (&acc)[2][2][4][2], const Unit& u, int wr, int wc, int fr, int fq) const {
        const int row0 = u.pm * BM + wr * 64 + fr, col0 = u.pn * BM + wc * 32 + 8 * fq;
#pragma unroll
        for (int ai = 0; ai < 2; ++ai)
#pragma unroll
            for (int m = 0; m < 4; ++m) { bf16_t* rowp = O + (size_t)(row0 + ai * HALF + m * 16) * ldc + col0;
#pragma unroll
                for (int bj = 0; bj < 2; ++bj) { if (col0 + bj * HALF < N) { const f32x4 v0 = acc[ai][bj][m][0], v1 = acc[ai][bj][m][1];
                    u32x4 w; w.x = cvt_pk_bf16(v0[0], v0[1]); w.y = cvt_pk_bf16(v0[2], v0[3]); w.z = cvt_pk_bf16(v1[0], v1[1]); w.w = cvt_pk_bf16(v1[2], v1[3]);
                    *(u32x4*)(rowp + bj * HALF) = w; } } }
    }
};
struct EpiDyn {
    static constexpr bool PERM = true, AFTER_DRAIN = false;
    int mode; bf16_t* O; int ldc; int N; const float* resid; float* out; const float* ssq_in; bf16_t* xb; float* ssq_out;
    __device__ __forceinline__ void operator()(const f32x4 (&acc)[2][2][4][2], const Unit& u, int wr, int wc, int fr, int fq) const {
        const int row0 = u.pm * BM + wr * 64 + fr, col0 = u.pn * BM + wc * 32 + 8 * fq;
        if (mode == 0) {
#pragma unroll
            for (int ai = 0; ai < 2; ++ai)
#pragma unroll
                for (int m = 0; m < 4; ++m) { const int row = row0 + ai * HALF + m * 16; bf16_t* rowp = O + (size_t)row * ldc + col0;
                    const float sc = __builtin_amdgcn_rsqf(ssq_in[row] * (1.0f / 1024.0f) + 1e-6f);
#pragma unroll
                    for (int bj = 0; bj < 2; ++bj) { if (col0 + bj * HALF < N) { const f32x4 v0 = acc[ai][bj][m][0] * sc, v1 = acc[ai][bj][m][1] * sc;
                        u32x4 w; w.x = cvt_pk_bf16(v0[0], v0[1]); w.y = cvt_pk_bf16(v0[2], v0[3]); w.z = cvt_pk_bf16(v1[0], v1[1]); w.w = cvt_pk_bf16(v1[2], v1[3]);
                        *(u32x4*)(rowp + bj * HALF) = w; } } }
        } else {
            const int lane_ = fq * 16 + fr;
#pragma unroll
            for (int ai = 0; ai < 2; ++ai)
#pragma unroll
                for (int m = 0; m < 4; ++m) { const int row = row0 + ai * HALF + m * 16; const size_t off = (size_t)row * ldc + col0; float s = 0.f;
#pragma unroll
                    for (int bj = 0; bj < 2; ++bj) { const f32x4 r0 = *(const f32x4*)(resid + off + bj * HALF), r1 = *(const f32x4*)(resid + off + bj * HALF + 4);
                        const f32x4 x0 = r0 + acc[ai][bj][m][0], x1 = r1 + acc[ai][bj][m][1];
                        *(f32x4*)(out + off + bj * HALF) = x0; *(f32x4*)(out + off + bj * HALF + 4) = x1;
                        u32x4 w; w.x = cvt_pk_bf16(x0[0], x0[1]); w.y = cvt_pk_bf16(x0[2], x0[3]); w.z = cvt_pk_bf16(x1[0], x1[1]); w.w = cvt_pk_bf16(x1[2], x1[3]);
                        *(u32x4*)(xb + off + bj * HALF) = w;
                        s += (x0[0] * x0[0] + x0[1] * x0[1]) + (x0[2] * x0[2] + x0[3] * x0[3]) + (x1[0] * x1[0] + x1[1] * x1[1]) + (x1[2] * x1[2] + x1[3] * x1[3]); }
                    s += bperm(s, lane_ ^ 16); s += bperm(s, lane_ ^ 32);
                    if (fq == 0) __hip_atomic_fetch_add(ssq_out + row, s, __ATOMIC_RELAXED, __HIP_MEMORY_SCOPE_AGENT); }
        }
    }
};
struct EpiResid {
    static constexpr bool PERM = true, AFTER_DRAIN = false;
    const float* resid; float* out; int ldc;
    __device__ __forceinline__ void operator()(const f32x4 (&acc)[2][2][4][2], const Unit& u, int wr, int wc, int fr, int fq) const {
        const int row0 = u.pm * BM + wr * 64 + fr, col0 = u.pn * BM + wc * 32 + 8 * fq;
#pragma unroll
        for (int ai = 0; ai < 2; ++ai)
#pragma unroll
            for (int m = 0; m < 4; ++m) { const size_t off = (size_t)(row0 + ai * HALF + m * 16) * ldc + col0;
#pragma unroll
                for (int bj = 0; bj < 2; ++bj) { const f32x4 r0 = *(const f32x4*)(resid + off + bj * HALF), r1 = *(const f32x4*)(resid + off + bj * HALF + 4);
                    *(f32x4*)(out + off + bj * HALF) = r0 + acc[ai][bj][m][0]; *(f32x4*)(out + off + bj * HALF + 4) = r1 + acc[ai][bj][m][1]; } }
    }
};

static_assert(true, "pg8 body adapted: SP2 path only is valid with lda/segment offsets");
template <class Epi, class Sched, bool ALIGN_EPI = false, bool SP2 = false>
__device__ __forceinline__ void gemm_phase(PG8_LAS unsigned char* lds, const Gemm g, const Sched& S, const Epi& E, int wv_) {
    const int tid = opaque_tid(wv_), wid = __builtin_amdgcn_readfirstlane(tid >> 6), lane = tid & 63, wr = wid >> 2, wc = wid & 3, fr = lane & 15, fq = lane >> 4;
    const int K = g.K, nt = K / BK;
    unsigned voffA, voffB;
    { int R, C; stage_rc(tid * 16, R, C); const int Rb = Epi::PERM ? ((R & ~31) + perm32(R & 31)) : R;
      voffA = (unsigned)(R * g.lda + C) * 2u; voffB = (unsigned)(Rb * K + C) * 2u; }
    const size_t rstepA = (size_t)64 * g.lda * 2, rstepB = (size_t)64 * K * 2;
    const size_t kstep = (size_t)(BK * 2);
    const size_t hstep = (size_t)HALF * K * 2; const size_t hstepA = (size_t)HALF * g.lda * 2, tstepA = 2 * hstepA;
#define PG8_KA(t_) ((size_t)((((t_) >> 2) == 0 ? g.ao0 : ((t_) >> 2) == 1 ? g.ao1 : ((t_) >> 2) == 2 ? g.ao2 : g.ao3) + ((t_) & 3) * 64) * 2)
    const size_t tstep = 2 * hstep;
    const unsigned ldsw = (unsigned)wid * 1024u;
    int aoff, boff;
#define PG8_SA(b, h) (((b) * 2 + (h)) * HTB)
#define PG8_SB(b, h) ((4 + (b) * 2 + (h)) * HTB)
#define PG8_STAGE(bufoff, gbase, voff) do { _Pragma("unroll") for (int _i = 0; _i < 2; ++_i) \
        __builtin_amdgcn_global_load_lds((const unsigned*)((const char*)(gbase) + (size_t)_i * r##voff + (voff)), (PG8_LAS unsigned*)(lds + (bufoff) + ldsw + _i * 8192), 16, 0, 0); } while (0)
#define rvoffA rstepA
#define rvoffB rstepB
#define PG8_LDA(dst, b, h) do { _Pragma("unroll") for (int m = 0; m < 4; ++m) _Pragma("unroll") for (int k = 0; k < 2; ++k) dst[m][k] = *(const PG8_LAS bf16x8*)(lds + (PG8_SA(b, h) + wr * 8192) + aoff + m * 2048 + k * 1024); } while (0)
#define PG8_LDB(dst, b, h) do { _Pragma("unroll") for (int n = 0; n < 2; ++n) _Pragma("unroll") for (int k = 0; k < 2; ++k) dst[n][k] = *(const PG8_LAS bf16x8*)(lds + (PG8_SB(b, h) + wc * 4096) + boff + n * 2048 + k * 1024); } while (0)
#define PG8_MMA(ai, bj, At, Bt) do { __builtin_amdgcn_s_setprio(1); _Pragma("unroll") for (int m = 0; m < 4; ++m) _Pragma("unroll") for (int n = 0; n < 2; ++n) _Pragma("unroll") for (int k = 0; k < 2; ++k) \
        acc[ai][bj][m][n] = __builtin_amdgcn_mfma_f32_16x16x32_bf16(Bt[n][k], At[m][k], acc[ai][bj][m][n], 0, 0, 0); __builtin_amdgcn_s_setprio(0); } while (0)
#define PG8_WAIT_V(n) asm volatile("s_waitcnt vmcnt(" #n ")" ::: "memory")
#define PG8_WAIT_L(n) asm volatile("s_waitcnt lgkmcnt(" #n ")" ::: "memory")
#define PG8_BAR __builtin_amdgcn_s_barrier()
#define PG8_SCHED __builtin_amdgcn_sched_barrier(0)
    Unit cur, nxt; int ui = 0;
    if (!S.next(0, cur)) return;
    f32x4 acc[2][2][4][2];
#pragma unroll
    for (int a = 0; a < 2; ++a)
#pragma unroll
        for (int b = 0; b < 2; ++b)
#pragma unroll
            for (int m = 0; m < 4; ++m)
#pragma unroll
                for (int n = 0; n < 2; ++n) acc[a][b][m][n] = (f32x4){0.f, 0.f, 0.f, 0.f};
    bf16x8 At[4][2], B0[2][2], B1[2][2];
    const char* cA = (const char*)g.A + (size_t)cur.pm * tstepA; const char* cB = (const char*)g.Bt + (size_t)cur.pn * tstep;
    S.a_ready(cur);
    if constexpr (SP2) {
        PG8_STAGE(PG8_SB(0, 0), cB, voffB); PG8_STAGE(PG8_SB(0, 1), cB + hstep, voffB); PG8_STAGE(PG8_SA(0, 0), cA + PG8_KA(0), voffA); PG8_STAGE(PG8_SA(0, 1), cA + hstepA + PG8_KA(0), voffA);
        if (wr == 1) PG8_BAR;
        PG8_WAIT_V(2); PG8_BAR;
        PG8_STAGE(PG8_SB(1, 0), cB + kstep, voffB); PG8_STAGE(PG8_SA(1, 0), cA + PG8_KA(1), voffA); PG8_STAGE(PG8_SB(1, 1), cB + hstep + kstep, voffB);
        PG8_WAIT_V(6); PG8_BAR;
    } else {
        PG8_STAGE(PG8_SB(0, 0), cB, voffB); PG8_STAGE(PG8_SA(0, 0), cA, voffA); PG8_STAGE(PG8_SB(0, 1), cB + hstep, voffB); PG8_STAGE(PG8_SA(0, 1), cA + hstep, voffA);
        if (wr == 1) PG8_BAR;
        PG8_WAIT_V(4); PG8_BAR;
        PG8_STAGE(PG8_SB(1, 0), cB + kstep, voffB); PG8_STAGE(PG8_SA(1, 0), cA + kstep, voffA); PG8_STAGE(PG8_SB(1, 1), cB + hstep + kstep, voffB);
        PG8_WAIT_V(6); PG8_BAR;
    }
    { const int t3_ = opaque_tid(wv_), l3_ = t3_ & 63, w3_ = __builtin_amdgcn_readfirstlane(t3_ >> 6); aoff = lds_byte((l3_ & 15), (l3_ >> 4) * 8); boff = aoff; }
    for (;;) {
        const bool has_next = S.next(ui + 1, nxt);
        const char* nA = has_next ? (const char*)g.A + (size_t)nxt.pm * tstepA : cA; const char* nB = has_next ? (const char*)g.Bt + (size_t)nxt.pn * tstep : cB;
        for (int t = 0; t < nt; t += 2) {
            const bool last = (t == nt - 2);
            const char* a1 = cA + PG8_KA(t + 1);
            const char* a2 = last ? nA + PG8_KA(0) : cA + PG8_KA(t + 2); const char* b2 = last ? nB : cB + (size_t)(t + 2) * kstep;
            const char* a3 = last ? nA + PG8_KA(1) : cA + PG8_KA(t + 3); const char* b3 = b2 + kstep;
            if (last && has_next) S.a_ready(nxt);
            if constexpr (SP2) {
            PG8_LDB(B0, 0, 0); PG8_LDB(B1, 0, 1); PG8_SCHED; PG8_LDA(At, 0, 0); PG8_STAGE(PG8_SA(1, 1), a1 + hstepA, voffA);
            PG8_WAIT_V(8); PG8_WAIT_L(0); PG8_BAR; PG8_MMA(0, 0, At, B0); PG8_MMA(0, 1, At, B1); PG8_BAR; PG8_SCHED;
            PG8_LDA(At, 0, 1); PG8_STAGE(PG8_SB(0, 0), b2, voffB); PG8_STAGE(PG8_SB(0, 1), b2 + hstep, voffB); PG8_STAGE(PG8_SA(0, 0), a2, voffA);
            PG8_WAIT_V(8); PG8_WAIT_L(0); PG8_BAR; PG8_MMA(1, 0, At, B0); PG8_MMA(1, 1, At, B1); PG8_BAR; PG8_SCHED;
            PG8_LDB(B0, 1, 0); PG8_LDB(B1, 1, 1); PG8_SCHED; PG8_LDA(At, 1, 0); PG8_STAGE(PG8_SA(0, 1), a2 + hstepA, voffA);
            PG8_WAIT_V(8); PG8_WAIT_L(0); PG8_BAR; PG8_MMA(0, 0, At, B0); PG8_MMA(0, 1, At, B1); PG8_BAR; PG8_SCHED;
            PG8_LDA(At, 1, 1); PG8_STAGE(PG8_SB(1, 0), b3, voffB); PG8_STAGE(PG8_SB(1, 1), b3 + hstep, voffB); PG8_STAGE(PG8_SA(1, 0), a3, voffA);
            PG8_WAIT_V(8); PG8_WAIT_L(0); PG8_BAR; PG8_MMA(1, 0, At, B0); PG8_MMA(1, 1, At, B1); PG8_BAR; PG8_SCHED;
            } else {
            PG8_LDB(B0, 0, 0); PG8_SCHED; PG8_LDA(At, 0, 0); PG8_STAGE(PG8_SA(1, 1), a1 + hstep, voffA);
            PG8_WAIT_L(8); PG8_BAR; PG8_WAIT_L(0); PG8_MMA(0, 0, At, B0); PG8_BAR; PG8_SCHED;
            PG8_LDB(B1, 0, 1); PG8_STAGE(PG8_SB(0, 0), b2, voffB);
            PG8_BAR; PG8_WAIT_L(0); PG8_MMA(0, 1, At, B1); PG8_BAR;
            PG8_LDA(At, 0, 1); PG8_STAGE(PG8_SA(0, 0), a2, voffA);
            PG8_BAR; PG8_WAIT_L(0); PG8_MMA(1, 0, At, B0); PG8_BAR; PG8_SCHED;
            PG8_STAGE(PG8_SB(0, 1), b2 + hstep, voffB);
            PG8_WAIT_V(6); PG8_BAR; PG8_MMA(1, 1, At, B1); PG8_BAR;
            PG8_LDB(B0, 1, 0); PG8_SCHED; PG8_LDA(At, 1, 0); PG8_STAGE(PG8_SA(0, 1), a2 + hstep, voffA);
            PG8_WAIT_L(8); PG8_BAR; PG8_WAIT_L(0); PG8_MMA(0, 0, At, B0); PG8_BAR; PG8_SCHED;
            PG8_LDB(B1, 1, 1); PG8_STAGE(PG8_SB(1, 0), b3, voffB);
            PG8_BAR; PG8_WAIT_L(0); PG8_MMA(0, 1, At, B1); PG8_BAR;
            PG8_LDA(At, 1, 1); PG8_STAGE(PG8_SA(1, 0), a3, voffA);
            PG8_BAR; PG8_WAIT_L(0); PG8_MMA(1, 0, At, B0); PG8_BAR; PG8_SCHED;
            PG8_STAGE(PG8_SB(1, 1), b3 + hstep, voffB);
            PG8_WAIT_V(6); PG8_BAR; PG8_MMA(1, 1, At, B1); PG8_BAR;
            }
        }
        if constexpr (ALIGN_EPI) { if (wr == 0) PG8_BAR; }
        if constexpr (!Epi::AFTER_DRAIN) { const int t2_ = opaque_tid(wv_), l2_ = t2_ & 63, w2_ = __builtin_amdgcn_readfirstlane(t2_ >> 6); E(acc, cur, w2_ >> 2, w2_ & 3, l2_ & 15, l2_ >> 4); S.done(cur); }
        if (!has_next) break;
#pragma unroll
        for (int a = 0; a < 2; ++a)
#pragma unroll
            for (int b = 0; b < 2; ++b)
#pragma unroll
                for (int m = 0; m < 4; ++m)
#pragma unroll
                    for (int n = 0; n < 2; ++n) acc[a][b][m][n] = (f32x4){0.f, 0.f, 0.f, 0.f};
        cur = nxt; cA = nA; cB = nB; ++ui;
        if constexpr (ALIGN_EPI) { if (wr == 1) PG8_BAR; }
    }
    PG8_WAIT_V(0);
    if constexpr (!ALIGN_EPI) { if (wr == 0) PG8_BAR; }
    PG8_BAR;
    if constexpr (Epi::AFTER_DRAIN) { E.fused(acc, cur, wr, wc, fr, fq, lds, wid, lane); S.done(cur); }
#undef PG8_SA
#undef PG8_SB
#undef PG8_STAGE
#undef rvoffA
#undef rvoffB
#undef PG8_LDA
#undef PG8_LDB
#undef PG8_MMA
#undef PG8_WAIT_V
#undef PG8_WAIT_L
#undef PG8_BAR
#undef PG8_SCHED
#undef PG8_KA
}
}

__device__ __forceinline__ void wt_tile(const float* __restrict__ W, int N, bf16_t* __restrict__ Wt, int kt, int nt, unsigned char* lds, int wv_, const float* gk = nullptr) {
#ifdef OFF_wt_tile
  return;
#endif

  float* tl = (float*)lds;
  const int tid = opaque_tid(wv_);
  const int r = tid >> 3, c8 = (tid & 7) * 8;
  const float* src = W + (size_t)(kt * 64 + r) * N + nt * 64 + c8;
  float4 v0 = *(const float4*)src, v1 = *(const float4*)(src + 4);
  if (gk) { const float g_ = gk[kt * 64 + r]; v0.x *= g_; v0.y *= g_; v0.z *= g_; v0.w *= g_; v1.x *= g_; v1.y *= g_; v1.z *= g_; v1.w *= g_; }
  float* d = tl + r * 65 + c8;
  d[0] = v0.x; d[1] = v0.y; d[2] = v0.z; d[3] = v0.w; d[4] = v1.x; d[5] = v1.y; d[6] = v1.z; d[7] = v1.w;
  __syncthreads();
  uint4 o;
  o.x = pack2(tl[(c8 + 0) * 65 + r], tl[(c8 + 1) * 65 + r]);
  o.y = pack2(tl[(c8 + 2) * 65 + r], tl[(c8 + 3) * 65 + r]);
  o.z = pack2(tl[(c8 + 4) * 65 + r], tl[(c8 + 5) * 65 + r]);
  o.w = pack2(tl[(c8 + 6) * 65 + r], tl[(c8 + 7) * 65 + r]);
  *(uint4*)(Wt + (size_t)(nt * 64 + r) * 1024 + kt * 64 + c8) = o;
  __syncthreads();
}

__device__ __forceinline__ void norm_rows(const bool F32OUT, const float* src, const float* __restrict__ g, void* dst, int nrows, float pd, int wv_, float* ssq_out = nullptr) {
#ifdef OFF_norm_rows
  return;
#endif

  const int tid = opaque_tid(wv_);
  const int lane = tid & 63;
  const int gw = blockIdx.x * 8 + (tid >> 6), nw = gridDim.x * 8;
  float4 gv[4];
#pragma unroll
  for (int i = 0; i < 4; ++i) gv[i] = ssq_out ? make_float4(1.f, 1.f, 1.f, 1.f) : *(const float4*)(g + i * 256 + lane * 4);
  for (int row = gw; row < nrows; row += nw) {
    const float* s = src + (size_t)row * 1024;
    float4 v[4]; float ss = 0.f;
#pragma unroll
    for (int i = 0; i < 4; ++i) { v[i] = *(const float4*)(s + i * 256 + lane * 4); ss += v[i].x * v[i].x + v[i].y * v[i].y + v[i].z * v[i].z + v[i].w * v[i].w; }
    ss = wave_sum(ss, lane);
    if (ssq_out) { if (lane == 0) ssq_out[row] = ss; }
    const float rs = ssq_out ? 1.0f : rsqrtf(ss * (1.0f / 1024.0f) + 1e-6f);
#pragma unroll
    for (int i = 0; i < 4; ++i) {
      const float a = v[i].x * rs * gv[i].x, b = v[i].y * rs * gv[i].y, c = v[i].z * rs * gv[i].z, d = v[i].w * rs * gv[i].w;
      if (F32OUT) { *(float4*)((float*)dst + (size_t)row * 1024 + i * 256 + lane * 4) = make_float4(a + pd, b + pd, c + pd, d + pd); }
      else { uint2 o; o.x = pack2(a, b); o.y = pack2(c, d); *(uint2*)((bf16_t*)dst + (size_t)row * 1024 + i * 256 + lane * 4) = o; }
    }
  }
}

__device__ __forceinline__ void rwkv_prep_item(KP P, int l, int item, unsigned char* lds, int wv_) {
#ifdef OFF_rwkv_prep_item
  return;
#endif

  const bf16_t* p = (const bf16_t*)(P->ws + WS_P);
  float* PW = (float*)(P->ws + WS_PW); bf16_t* PV = (bf16_t*)(P->ws + WS_PV); float* RK = (float*)(P->ws + WS_RK);
  float* lora = (float*)lds;
  const int tid = opaque_tid(wv_), lane = tid & 63, w = tid >> 6, head = w & 3, sub = w >> 2;
  const int c = head * 64 + lane;
  const float* mu = P->in[4] + l * 832;
  const float mur = mu[c], muk = mu[256 + c], muv = mu[512 + c], mux = mu[768 + lane];
  const float w0 = P->in[5][l * 256 + c], a0 = P->in[7][l * 256 + c];
  const float kkw = P->in[9][l * 256 + c], kaw = P->in[10][l * 256 + c], rkw = P->in[11][l * 256 + c];
  float wup[32], aup[32];
#pragma unroll
  for (int j = 0; j < 32; ++j) { wup[j] = P->in[6][(l * 32 + j) * 256 + c]; aup[j] = P->in[8][(l * 32 + j) * 256 + c]; }
  bf16_t raw[4][8];
#define PREP_LOAD(g) { _Pragma("unroll") for (int j_ = 0; j_ < 4; ++j_) { const int t_ = item * 32 + sub + 2 * ((g) * 4 + j_); const bool hp_ = (t_ & (TSEQ - 1)) > 0; \
      const bf16_t* pr_ = p + (size_t)t_ * NIN; raw[j_][0] = pr_[c]; raw[j_][1] = pr_[256 + c]; raw[j_][2] = pr_[512 + c]; raw[j_][3] = pr_[768 + lane]; \
      raw[j_][4] = hp_ ? pr_[c - NIN] : (bf16_t)0; raw[j_][5] = hp_ ? pr_[256 + c - NIN] : (bf16_t)0; raw[j_][6] = hp_ ? pr_[512 + c - NIN] : (bf16_t)0; raw[j_][7] = hp_ ? pr_[768 + lane - NIN] : (bf16_t)0; } }
  PREP_LOAD(0);
#pragma unroll 1
  for (int g = 0; g < 4; ++g) {
    float rr[4], kk4[4], vv4[4];
#pragma unroll
    for (int j = 0; j < 4; ++j) {
      float r = bf2f(raw[j][0]), k = bf2f(raw[j][1]), v = bf2f(raw[j][2]), x = bf2f(raw[j][3]);
      r += (bf2f(raw[j][4]) - r) * mur; k += (bf2f(raw[j][5]) - k) * muk; v += (bf2f(raw[j][6]) - v) * muv; x += (bf2f(raw[j][7]) - x) * mux;
      rr[j] = r; kk4[j] = k; vv4[j] = v;
      lora[(w * 4 + j) * 64 + lane] = lane < 32 ? (1.0f - 2.0f * __builtin_amdgcn_rcpf(1.0f + __expf(2.0f * x))) : x;
    }
    if (g < 3) PREP_LOAD(g + 1);
    __builtin_amdgcn_s_waitcnt(0xc07f);
    __builtin_amdgcn_wave_barrier();
#pragma unroll
    for (int j = 0; j < 4; ++j) {
      const int t = item * 32 + sub + 2 * (g * 4 + j);
      const int tt = t & (TSEQ - 1), b = t >> 13;
      const float r = rr[j], k = kk4[j], v = vv4[j];
      float wv = w0, av = a0;
      const float* lo = lora + (w * 4 + j) * 64;
#pragma unroll
      for (int jj = 0; jj < 32; jj += 4) { const float4 lw = *(const float4*)(lo + jj), la = *(const float4*)(lo + 32 + jj);
        wv += lw.x * wup[jj]; wv += lw.y * wup[jj + 1]; wv += lw.z * wup[jj + 2]; wv += lw.w * wup[jj + 3];
        av += la.x * aup[jj]; av += la.y * aup[jj + 1]; av += la.z * aup[jj + 2]; av += la.w * aup[jj + 3]; }
      const float wlog = -softplus_fast(-wv) - 0.5f;
      const float decay = __expf(-__expf(wlog));
      const float ar = sigmoidf_(av);
      const float kk = k * kkw;
      const float n2 = wave_sum(kk * kk, lane);
      const float kkn = kk * __builtin_amdgcn_rsqf(fmaxf(n2, 1e-24f));
      const float kmod = k * (1.0f + (ar - 1.0f) * kaw);
      const float rk = wave_sum(r * kmod * rkw, lane);
      const size_t idx = (size_t)(b * 4 + head) * TSEQ + tt;
      PW[idx * 64 + lane] = decay;
      bf16_t* pv = PV + idx * 320;
      pv[lane] = f2bf(r); pv[64 + lane] = f2bf(kmod); pv[128 + lane] = f2bf(v); pv[192 + lane] = f2bf(-kkn); pv[256 + lane] = f2bf(kkn * ar);
      if (lane == 0) RK[idx] = rk;
    }
    __builtin_amdgcn_s_waitcnt(0xc07f);
    __builtin_amdgcn_wave_barrier();
  }
#undef PREP_LOAD
  __syncthreads();
}

#define RW_TILE_B (RW_TT * 1536)
struct RwRegs { float4 pw; uint4 pv0, pv1; };
__device__ __forceinline__ void rw_issue(const float* __restrict__ PW, const bf16_t* __restrict__ PV, size_t idx0, int tid, RwRegs& r) {
  if (tid < RW_TT * 16) { const int s = tid >> 4, q = tid & 15; r.pw = *(const float4*)(PW + (idx0 + s) * 64 + q * 4); }
  { const int c = tid; const int s = c / 40, q = c % 40; r.pv0 = *(const uint4*)(PV + (idx0 + s) * 320 + q * 8); }
  if (tid < RW_TT * 40 - NTHR) { const int c = tid + NTHR; const int s = c / 40, q = c % 40; r.pv1 = *(const uint4*)(PV + (idx0 + s) * 320 + q * 8); }
}
__device__ __forceinline__ void rw_put(float* dst, int c, const uint4 u) {
  const int s = c / 40, q = c % 40;
  const int vec = q >> 3, off = (q & 7) * 8;
  const int slot = vec == 0 ? 4 : vec == 1 ? 3 : vec == 2 ? 5 : vec == 3 ? 1 : 2;
  float* d = dst + s * 384 + slot * 64 + off;
  *(float4*)d = make_float4(__uint_as_float(u.x << 16), __uint_as_float(u.x & 0xffff0000u), __uint_as_float(u.y << 16), __uint_as_float(u.y & 0xffff0000u));
  *(float4*)(d + 4) = make_float4(__uint_as_float(u.z << 16), __uint_as_float(u.z & 0xffff0000u), __uint_as_float(u.w << 16), __uint_as_float(u.w & 0xffff0000u));
}
__device__ __forceinline__ void rw_commit(unsigned char* dstb, int tid, const RwRegs& r) {
  float* dst = (float*)dstb;
  if (tid < RW_TT * 16) { const int s = tid >> 4, q = tid & 15; *(float4*)(dst + s * 384 + q * 4) = r.pw; }
  rw_put(dst, tid, r.pv0);
  if (tid < RW_TT * 40 - NTHR) rw_put(dst, tid + NTHR, r.pv1);
}

#define LD8(dst, ptr) { const float4 x0_ = *(const float4*)(ptr), x1_ = *(const float4*)((ptr) + 4); dst[0] = (f32x2){x0_.x, x0_.y}; dst[1] = (f32x2){x0_.z, x0_.w}; dst[2] = (f32x2){x1_.x, x1_.y}; dst[3] = (f32x2){x1_.z, x1_.w}; }
struct RwOps { f32x2 w[4], a[4], b[4], k[4], r[4]; float vA, vB; };
template <int MODE>
__device__ __forceinline__ void rw_ldops(RwOps& o, const float* tb, int s, int q, int rowA, int rowB) {
  const float* sp = tb + s * 384 + q * 8;
  LD8(o.w, sp); LD8(o.a, sp + 64); LD8(o.b, sp + 128); LD8(o.k, sp + 192);
  o.vA = tb[s * 384 + 320 + rowA];
  if (MODE == 0) { LD8(o.r, sp + 256); o.vB = tb[s * 384 + 320 + rowB]; }
}
template <int MODE>
__device__ __forceinline__ void rw_step(const RwOps& o, f32x2 (&SA)[4], f32x2 (&SB)[4], float* yb, int s, int q, int rowA, int rowB) {
  f32x2 dA = SA[0] * o.a[0], dB = SB[0] * o.a[0];
#pragma unroll
  for (int e = 1; e < 4; ++e) { dA = SA[e] * o.a[e] + dA; dB = SB[e] * o.a[e] + dB; }
  const float dotA = red8(dA.x + dA.y), dotB = red8(dB.x + dB.y);
  const f32x2 dA2 = {dotA, dotA}, dB2 = {dotB, dotB}, vA2 = {o.vA, o.vA};
  if (MODE == 0) {
    const f32x2 vB2 = {o.vB, o.vB};
#pragma unroll
    for (int e = 0; e < 4; ++e) { SA[e] = SA[e] * o.w[e] + vA2 * o.k[e]; SA[e] = dA2 * o.b[e] + SA[e]; SB[e] = SB[e] * o.w[e] + vB2 * o.k[e]; SB[e] = dB2 * o.b[e] + SB[e]; }
    f32x2 yA = SA[0] * o.r[0], yB = SB[0] * o.r[0];
#pragma unroll
    for (int e = 1; e < 4; ++e) { yA = SA[e] * o.r[e] + yA; yB = SB[e] * o.r[e] + yB; }
    const float ya = red8(yA.x + yA.y), ybv = red8(yB.x + yB.y);
    if (q == 0) { yb[s * 64 + rowA] = ya; yb[s * 64 + rowB] = ybv; }
  } else {
#pragma unroll
    for (int e = 0; e < 4; ++e) { SA[e] = dA2 * o.b[e] + SA[e] * o.w[e]; SB[e] = SB[e] * o.w[e] + vA2 * o.k[e]; SB[e] = dB2 * o.b[e] + SB[e]; }
  }
}
template <int MODE>
__device__ __forceinline__ void rwkv_scan_item(KP P, int l, int bh, int chunk, unsigned char* lds, int wv_) {
  const float* PW = (const float*)(P->ws + WS_PW); const bf16_t* PV = (const bf16_t*)(P->ws + WS_PV); const float* RK = (const float*)(P->ws + WS_RK);
  float* PQ = (float*)(P->ws + WS_PQ);
  bf16_t* p = (bf16_t*)(P->ws + WS_P);
  const int tid = opaque_tid(wv_), lane = tid & 63, w = tid >> 6;
  const int q = lane & 7;
  const int rowA = (MODE == 0) ? ((w & 3) * 16 + (lane >> 3)) : (w * 8 + (lane >> 3));
  const int rowB = rowA + 8;
  const int b = bh >> 2, head = bh & 3;
  unsigned char* tile0 = lds;
  float* ybuf = (float*)(lds + 3 * RW_TILE_B);
  float* Sl = (float*)(lds + 3 * RW_TILE_B + 2 * RW_TT * 256);
  f32x2 SA[4], SB[4];
#pragma unroll
  for (int e = 0; e < 4; ++e) { SA[e] = (f32x2){0.f, 0.f}; SB[e] = (f32x2){0.f, 0.f}; }
  if (MODE == 1) {
#pragma unroll
    for (int e = 0; e < 4; ++e) SA[e] = (f32x2){(q * 8 + 2 * e == rowA) ? 1.f : 0.f, (q * 8 + 2 * e + 1 == rowA) ? 1.f : 0.f};
  }
  if (MODE == 0 && chunk > 0) {
    const float* Q0 = PQ + ((size_t)(bh * RW_C + 0) * 2 + 1) * 4096;
    float* cur = Sl; float* nxt = Sl + 64 * 65;
    for (int i = tid; i < 1024; i += NTHR) { const float4 v_ = *(const float4*)(Q0 + i * 4); float* d_ = cur + (i >> 4) * 65 + (i & 15) * 4; d_[0] = v_.x; d_[1] = v_.y; d_[2] = v_.z; d_[3] = v_.w; }
    float* Pl = (float*)lds;
    const float4 z4_ = make_float4(0.f, 0.f, 0.f, 0.f); const f32x4 zq_ = {0.f, 0.f, 0.f, 0.f};
    float4 cs0p0 = z4_, cs0p1 = z4_, cs1p0 = z4_, cs1p1 = z4_, cs2p0 = z4_, cs2p1 = z4_, cs3p0 = z4_, cs3p1 = z4_;
    f32x4 cs0q0 = zq_, cs0q1 = zq_, cs1q0 = zq_, cs1q1 = zq_, cs2q0 = zq_, cs2q1 = zq_, cs3q0 = zq_, cs3q1 = zq_;
    const int ti = w >> 1;
    const int qoff0 = 4096 + (ti * 16 + (lane >> 4) * 4) * 64 + ((w & 1) * 2 + 0) * 16 + (lane & 15);
#define CS_LOAD(S_, c_) { const float* Pm_ = PQ + ((size_t)(bh * RW_C + (c_)) * 2 + 0) * 4096; S_##p0 = *(const float4*)(Pm_ + tid * 4); S_##p1 = *(const float4*)(Pm_ + (tid + NTHR) * 4); \
      S_##q0 = (f32x4){Pm_[qoff0], Pm_[qoff0 + 64], Pm_[qoff0 + 128], Pm_[qoff0 + 192]}; S_##q1 = (f32x4){Pm_[qoff0 + 16], Pm_[qoff0 + 80], Pm_[qoff0 + 144], Pm_[qoff0 + 208]}; }
#define CS_STEP(S_, c_) { LBAR(); *(float4*)(Pl + (tid >> 4) * 80 + (tid & 15) * 4) = S_##p0; *(float4*)(Pl + ((tid + NTHR) >> 4) * 80 + (tid & 15) * 4) = S_##p1; const f32x4 qc0 = S_##q0, qc1 = S_##q1; \
      if ((c_) + 4 < chunk) CS_LOAD(S_, (c_) + 4); \
      LBAR(); \
      _Pragma("unroll") for (int jj = 0; jj < 2; ++jj) { const int tj = (w & 1) * 2 + jj; f32x4 acc = jj == 0 ? qc0 : qc1; \
        _Pragma("unroll") for (int ks = 0; ks < 16; ++ks) { const float a = cur[(ti * 16 + (lane & 15)) * 65 + ks * 4 + (lane >> 4)]; const float bb = Pl[(ks * 4 + (lane >> 4)) * 80 + tj * 16 + (lane & 15)]; \
          acc = __builtin_amdgcn_mfma_f32_16x16x4f32(a, bb, acc, 0, 0, 0); } \
        _Pragma("unroll") for (int r = 0; r < 4; ++r) nxt[(ti * 16 + (lane >> 4) * 4 + r) * 65 + tj * 16 + (lane & 15)] = acc[r]; } \
      float* t_ = cur; cur = nxt; nxt = t_; }
    if (1 < chunk) CS_LOAD(cs0, 1);
    if (2 < chunk) CS_LOAD(cs1, 2);
    if (3 < chunk) CS_LOAD(cs2, 3);
    if (4 < chunk) CS_LOAD(cs3, 4);
#pragma unroll 1
    for (int cc = 1; cc < chunk; cc += 4) {
      CS_STEP(cs0, cc);
      if (cc + 1 < chunk) CS_STEP(cs1, cc + 1);
      if (cc + 2 < chunk) CS_STEP(cs2, cc + 2);
      if (cc + 3 < chunk) CS_STEP(cs3, cc + 3);
    }
#undef CS_LOAD
#undef CS_STEP
    __syncthreads();
#pragma unroll
    for (int e = 0; e < 4; ++e) { SA[e] = (f32x2){cur[rowA * 65 + q * 8 + 2 * e], cur[rowA * 65 + q * 8 + 2 * e + 1]}; SB[e] = (f32x2){cur[rowB * 65 + q * 8 + 2 * e], cur[rowB * 65 + q * 8 + 2 * e + 1]}; }
    __syncthreads();
  }
  const size_t idxb = (size_t)bh * TSEQ + (size_t)chunk * RW_CL;
  const int ntile = RW_CL / RW_TT;
  RwRegs rr;
  rw_issue(PW, PV, idxb, tid, rr);
  rw_commit(tile0, tid, rr);
  const int chh = head * 64 + lane;
  const float lng = P->in[12][l * 256 + chh], lnb = P->in[13][l * 256 + chh];
  __syncthreads();
  const int nit = (MODE == 0) ? ntile + 1 : ntile;
  for (int tl = 0; tl < nit; ++tl) {
    if (tl + 1 < ntile) rw_issue(PW, PV, idxb + (size_t)(tl + 1) * RW_TT, tid, rr);
    if (MODE == 1 || w < 4) {
      if (tl < ntile) {
        const float* tb = (const float*)(tile0 + (tl % 3) * RW_TILE_B);
        float* yb = ybuf + (tl & 1) * (RW_TT * 64);
        RwOps oa, ob;
        rw_ldops<MODE>(oa, tb, 0, q, rowA, rowB);
        __builtin_amdgcn_sched_barrier(0);
#pragma unroll 1
        for (int s = 0; s < RW_TT; s += 2) {
          rw_ldops<MODE>(ob, tb, s + 1, q, rowA, rowB);
          __builtin_amdgcn_sched_barrier(0);
          rw_step<MODE>(oa, SA, SB, yb, s, q, rowA, rowB);
          __builtin_amdgcn_sched_barrier(0);
          if (s + 2 < RW_TT) rw_ldops<MODE>(oa, tb, s + 2, q, rowA, rowB);
          __builtin_amdgcn_sched_barrier(0);
          rw_step<MODE>(ob, SA, SB, yb, s + 1, q, rowA, rowB);
          __builtin_amdgcn_sched_barrier(0);
        }
      }
      if (tl + 1 < ntile) rw_commit(tile0 + ((tl + 1) % 3) * RW_TILE_B, tid, rr);
    } else {
      const int fw = w - 4;
      f32x4 gcu = {0.f, 0.f, 0.f, 0.f}, rkcu = {0.f, 0.f, 0.f, 0.f};
      if (tl > 0) {
#pragma unroll
        for (int u = 0; u < 4; ++u) { const int tt = chunk * RW_CL + (tl - 1) * RW_TT + fw + 4 * u;
          gcu[u] = bf2f(p[(size_t)(b * TSEQ + tt) * NIN + C_GA + chh]); rkcu[u] = RK[(size_t)bh * TSEQ + tt]; }
      }
      asm volatile("s_waitcnt vmcnt(0)" ::: "memory");
      if (tl + 1 < ntile) rw_commit(tile0 + ((tl + 1) % 3) * RW_TILE_B, tid, rr);
      __builtin_amdgcn_sched_barrier(0);
      if (tl > 0) {
        const float* tb = (const float*)(tile0 + ((tl - 1) % 3) * RW_TILE_B);
        const float* yb = ybuf + ((tl - 1) & 1) * (RW_TT * 64);
#pragma unroll
        for (int u = 0; u < 4; ++u) {
          const int s = fw + 4 * u;
          const int tt = chunk * RW_CL + (tl - 1) * RW_TT + s;
          const float y = yb[s * 64 + lane];
          const float mean = wave_sum(y, lane) * (1.0f / 64.0f);
          const float dlt = y - mean;
          const float var = wave_sum(dlt * dlt, lane) * (1.0f / 64.0f);
          float o = dlt * rsqrtf(var + 64e-5f) * lng + lnb;
          const float vv = tb[s * 384 + 320 + lane];
          o += rkcu[u] * vv;
          p[(size_t)(b * TSEQ + tt) * NIN + C_GA + chh] = f2bf(o * siluf_(gcu[u]));
        }
      }
    }
    LBAR();
  }
  if (MODE == 1) {
    float* Pm = PQ + ((size_t)(bh * RW_C + chunk) * 2 + 0) * 4096 + rowA * 64 + q * 8;
    *(float4*)Pm = make_float4(SA[0].x, SA[0].y, SA[1].x, SA[1].y); *(float4*)(Pm + 4) = make_float4(SA[2].x, SA[2].y, SA[3].x, SA[3].y);
    *(float4*)(Pm + 4096) = make_float4(SB[0].x, SB[0].y, SB[1].x, SB[1].y); *(float4*)(Pm + 4100) = make_float4(SB[2].x, SB[2].y, SB[3].x, SB[3].y);
  } else if (chunk == 0 && w < 4) {
    float* Qm = PQ + ((size_t)(bh * RW_C + 0) * 2 + 1) * 4096 + q * 8;
    *(float4*)(Qm + rowA * 64) = make_float4(SA[0].x, SA[0].y, SA[1].x, SA[1].y); *(float4*)(Qm + rowA * 64 + 4) = make_float4(SA[2].x, SA[2].y, SA[3].x, SA[3].y);
    *(float4*)(Qm + rowB * 64) = make_float4(SB[0].x, SB[0].y, SB[1].x, SB[1].y); *(float4*)(Qm + rowB * 64 + 4) = make_float4(SB[2].x, SB[2].y, SB[3].x, SB[3].y);
  }
  __syncthreads();
}

__device__ __forceinline__ void conv_item(KP P, int l, int item, unsigned char* lds, int wv_) {
#ifdef OFF_conv_item
  return;
#endif

  bf16_t* p = (bf16_t*)(P->ws + WS_P);
  float* u = (float*)lds;
  float* yb = (float*)(lds + 62 * 1024);
  const int tid = opaque_tid(wv_), c = tid & 255, half = tid >> 8;
  const int t0 = item * 32, tt0 = t0 & (TSEQ - 1);
  {
    bf16_t rv[31], rg[31];
#pragma unroll
    for (int i = 0; i < 31; ++i) { const int r = half + 2 * i; const bool ok = (tt0 - 30 + r) >= 0; const bf16_t* pr = p + (size_t)(t0 - 30 + r) * NIN;
      rv[i] = ok ? pr[C_CVAL + c] : (bf16_t)0; rg[i] = ok ? pr[C_CGLU + c] : (bf16_t)0; }
#pragma unroll
    for (int i = 0; i < 31; ++i) u[(half + 2 * i) * 256 + c] = bf2f(rv[i]) * sigmoidf_(bf2f(rg[i]));
  }
  float wv[31];
#pragma unroll
  for (int j = 0; j < 31; ++j) wv[j] = P->in[14][(l * 31 + j) * 256 + c];
  const float bias = P->in[15][l * 256 + c];
  __syncthreads();
  {
    float win[46];
#pragma unroll
    for (int i = 0; i < 46; ++i) win[i] = u[(half * 16 + i) * 256 + c];
#pragma unroll
    for (int i = 0; i < 16; ++i) {
      float acc = bias;
#pragma unroll
      for (int j = 0; j < 31; ++j) acc = fmaf(wv[j], win[i + j], acc);
      yb[(half * 16 + i) * 256 + c] = acc;
    }
  }
  __syncthreads();
  const int lane = tid & 63, w = tid >> 6;
  const float4 g = *(const float4*)(P->in[16] + l * 256 + lane * 4), bb = *(const float4*)(P->in[17] + l * 256 + lane * 4);
  uint2 gpre[4];
#pragma unroll
  for (int i = 0; i < 4; ++i) gpre[i] = *(const uint2*)(p + (size_t)(t0 + w * 4 + i) * NIN + C_CGATE + lane * 4);
#pragma unroll
  for (int i = 0; i < 4; ++i) {
    const int tk = w * 4 + i;
    const float4 v = *(const float4*)(yb + tk * 256 + lane * 4);
    const float mean = wave_sum(v.x + v.y + v.z + v.w, lane) * (1.0f / 256.0f);
    const float d0 = v.x - mean, d1 = v.y - mean, d2 = v.z - mean, d3 = v.w - mean;
    const float var = wave_sum(d0 * d0 + d1 * d1 + d2 * d2 + d3 * d3, lane) * (1.0f / 256.0f);
    const float rs = rsqrtf(var + 1e-5f);
    bf16_t* gp = p + (size_t)(t0 + tk) * NIN + C_CGATE + lane * 4;
    const uint2 gu = gpre[i];
    const float o0 = siluf_(d0 * rs * g.x + bb.x) * siluf_(__uint_as_float(gu.x << 16));
    const float o1 = siluf_(d1 * rs * g.y + bb.y) * siluf_(__uint_as_float(gu.x & 0xffff0000u));
    const float o2 = siluf_(d2 * rs * g.z + bb.z) * siluf_(__uint_as_float(gu.y << 16));
    const float o3 = siluf_(d3 * rs * g.w + bb.w) * siluf_(__uint_as_float(gu.y & 0xffff0000u));
    uint2 o; o.x = pack2(o0, o1); o.y = pack2(o2, o3);
    *(uint2*)gp = o;
  }
  __syncthreads();
}

#define HG_WLDS 10240
__device__ __forceinline__ float hgrn_lb(KP P, int l, int ch) {
  if (l == 0) return 0.f;
  const float x0 = P->in[18][ch], x1 = P->in[18][256 + ch];
  return __builtin_amdgcn_rcpf(1.0f + __expf(x0 - x1));
}
template <int PASS>
__device__ __forceinline__ void hgrn_wave_item(KP P, int l, int wi, unsigned char* lds, int wv_) {
#ifdef OFF_hgrn_wave_item
  return;
#endif

  bf16_t* p = (bf16_t*)(P->ws + WS_P);
  float* HS = (float*)(P->ws + WS_HS); float* HF = (float*)(P->ws + WS_HF);
  const int tid = opaque_tid(wv_);
  const int lane = tid & 63, w = tid >> 6;
  const int bh = wi >> 7, chunk = wi & 127, b = bh >> 2, head = bh & 3;
  float* st = (float*)(lds + w * HG_WLDS);
  float* ob = st + 2048;
  const int kg = lane & 7, vg = lane >> 3;
  const int ch = head * 64 + lane;
  const float lb = hgrn_lb(P, l, ch);
  const float ng = P->in[19][l * 256 + ch];
  float S[8][8];
  float* slot = HS + (size_t)(bh * 128 + chunk) * 4096;
  if (PASS == 1) {
#pragma unroll
    for (int i = 0; i < 8; ++i) { const float4 x0 = *(const float4*)(slot + (kg * 8 + i) * 64 + vg * 8), x1 = *(const float4*)(slot + (kg * 8 + i) * 64 + vg * 8 + 4);
      S[i][0] = x0.x; S[i][1] = x0.y; S[i][2] = x0.z; S[i][3] = x0.w; S[i][4] = x1.x; S[i][5] = x1.y; S[i][6] = x1.z; S[i][7] = x1.w; }
  } else {
#pragma unroll
    for (int i = 0; i < 8; ++i)
#pragma unroll
      for (int j = 0; j < 8; ++j) S[i][j] = 0.f;
  }
  float Fp = 1.f;
  bf16_t rf[8], ri[8], rq[8], rg[8];
  {
    const int tb0 = b * TSEQ + chunk * 64;
#pragma unroll
    for (int s = 0; s < 8; ++s) { const bf16_t* pr = p + (size_t)(tb0 + s) * NIN; rf[s] = pr[C_HF + ch]; ri[s] = pr[C_HI + ch]; if (PASS == 1) { rq[s] = pr[C_HQ + ch]; rg[s] = pr[C_HG + ch]; } }
  }
#pragma unroll 1
  for (int sub = 0; sub < 8; ++sub) {
    const int tbase = b * TSEQ + chunk * 64 + sub * 8;
    bf16_t gc[8];
#pragma unroll
    for (int s = 0; s < 8; ++s) {
      const float f = lb + (1.0f - lb) * sigmoidf_(bf2f(rf[s]));
      Fp *= f;
      st[s * 256 + lane] = f; st[s * 256 + 64 + lane] = 1.0f - f;
      if (PASS == 1) { st[s * 256 + 128 + lane] = siluf_(bf2f(rq[s])); gc[s] = rg[s]; }
      st[s * 256 + 192 + lane] = bf2f(ri[s]);
    }
    if (sub < 7) {
#pragma unroll
      for (int s = 0; s < 8; ++s) { const bf16_t* pr = p + (size_t)(tbase + 8 + s) * NIN; rf[s] = pr[C_HF + ch]; ri[s] = pr[C_HI + ch]; if (PASS == 1) { rq[s] = pr[C_HQ + ch]; rg[s] = pr[C_HG + ch]; } }
    }
    __builtin_amdgcn_s_waitcnt(0xc07f);
    __builtin_amdgcn_wave_barrier();
#pragma unroll 1
    for (int s = 0; s < 8; ++s) {
      const float* sp = st + s * 256;
      const float4 f0 = *(const float4*)(sp + kg * 8), f1 = *(const float4*)(sp + kg * 8 + 4);
      const float4 k0 = *(const float4*)(sp + 64 + kg * 8), k1 = *(const float4*)(sp + 64 + kg * 8 + 4);
      const float4 v0 = *(const float4*)(sp + 192 + vg * 8), v1 = *(const float4*)(sp + 192 + vg * 8 + 4);
      const float fv[8] = {f0.x, f0.y, f0.z, f0.w, f1.x, f1.y, f1.z, f1.w};
      const float kv[8] = {k0.x, k0.y, k0.z, k0.w, k1.x, k1.y, k1.z, k1.w};
      const float vv[8] = {v0.x, v0.y, v0.z, v0.w, v1.x, v1.y, v1.z, v1.w};
#pragma unroll
      for (int i = 0; i < 8; ++i)
#pragma unroll
        for (int j = 0; j < 8; ++j) S[i][j] = fmaf(fv[i], S[i][j], kv[i] * vv[j]);
      if (PASS == 1) {
        const float4 q0 = *(const float4*)(sp + 128 + kg * 8), q1 = *(const float4*)(sp + 128 + kg * 8 + 4);
        const float qv[8] = {q0.x, q0.y, q0.z, q0.w, q1.x, q1.y, q1.z, q1.w};
        float o[8];
#pragma unroll
        for (int j = 0; j < 8; ++j) { float a = qv[0] * S[0][j];
#pragma unroll
          for (int i = 1; i < 8; ++i) a = fmaf(qv[i], S[i][j], a);
          o[j] = red8(a); }
        if (kg == 0) { *(float4*)(ob + s * 64 + vg * 8) = make_float4(o[0], o[1], o[2], o[3]); *(float4*)(ob + s * 64 + vg * 8 + 4) = make_float4(o[4], o[5], o[6], o[7]); }
      }
    }
    __builtin_amdgcn_s_waitcnt(0xc07f);
    __builtin_amdgcn_wave_barrier();
    if (PASS == 1) {
#pragma unroll
      for (int s = 0; s < 8; ++s) {
        const float o = ob[s * 64 + lane];
        const float ms = wave_sum(o * o, lane) * (1.0f / 64.0f);
        p[(size_t)(tbase + s) * NIN + C_HG + ch] = f2bf(o * rsqrtf(ms + 1e-6f) * ng * siluf_(bf2f(gc[s])));
      }
      __builtin_amdgcn_s_waitcnt(0xc07f);
      __builtin_amdgcn_wave_barrier();
    }
  }
  if (PASS == 0) {
#pragma unroll
    for (int i = 0; i < 8; ++i) { *(float4*)(slot + (kg * 8 + i) * 64 + vg * 8) = make_float4(S[i][0], S[i][1], S[i][2], S[i][3]);
      *(float4*)(slot + (kg * 8 + i) * 64 + vg * 8 + 4) = make_float4(S[i][4], S[i][5], S[i][6], S[i][7]); }
    HF[(size_t)(bh * 128 + chunk) * 64 + lane] = Fp;
  }
}
__device__ __forceinline__ void hgrn_combine_item(KP P, int bh, int wv_) {
#ifdef OFF_hgrn_combine_item
  return;
#endif

  float* HS = (float*)(P->ws + WS_HS); const float* HF = (const float*)(P->ws + WS_HF);
  const int tid = opaque_tid(wv_);
  const int krow = tid >> 3;
  float R[8];
#pragma unroll
  for (int e = 0; e < 8; ++e) R[e] = 0.f;
  float4 xa[8][2]; float fa[8];
#pragma unroll
  for (int u = 0; u < 8; ++u) { const float* sl = HS + (size_t)(bh * 128 + u) * 4096 + tid * 8; xa[u][0] = *(const float4*)sl; xa[u][1] = *(const float4*)(sl + 4); fa[u] = HF[(size_t)(bh * 128 + u) * 64 + krow]; }
#pragma unroll 1
  for (int c0 = 0; c0 < 128; c0 += 8) {
    float4 xn[8][2]; float fn[8];
    if (c0 + 8 < 128) {
#pragma unroll
      for (int u = 0; u < 8; ++u) { const float* sl = HS + (size_t)(bh * 128 + c0 + 8 + u) * 4096 + tid * 8; xn[u][0] = *(const float4*)sl; xn[u][1] = *(const float4*)(sl + 4); fn[u] = HF[(size_t)(bh * 128 + c0 + 8 + u) * 64 + krow]; }
    }
#pragma unroll
    for (int u = 0; u < 8; ++u) {
      float* sl = HS + (size_t)(bh * 128 + c0 + u) * 4096 + tid * 8;
      *(float4*)sl = make_float4(R[0], R[1], R[2], R[3]); *(float4*)(sl + 4) = make_float4(R[4], R[5], R[6], R[7]);
      const float f = fa[u];
      R[0] = fmaf(f, R[0], xa[u][0].x); R[1] = fmaf(f, R[1], xa[u][0].y); R[2] = fmaf(f, R[2], xa[u][0].z); R[3] = fmaf(f, R[3], xa[u][0].w);
      R[4] = fmaf(f, R[4], xa[u][1].x); R[5] = fmaf(f, R[5], xa[u][1].y); R[6] = fmaf(f, R[6], xa[u][1].z); R[7] = fmaf(f, R[7], xa[u][1].w);
    }
    if (c0 + 8 < 128) {
#pragma unroll
      for (int u = 0; u < 8; ++u) { xa[u][0] = xn[u][0]; xa[u][1] = xn[u][1]; fa[u] = fn[u]; }
    }
  }
}

__device__ __forceinline__ void sb_item(KP P, int item, unsigned char* lds, int wv_) {
#ifdef OFF_sb_item
  return;
#endif

  bf16_t* p = (bf16_t*)(P->ws + WS_P);
  const int tid = opaque_tid(wv_), lane = tid & 63, w = tid >> 6;
  const int qt = item & 127, bh = item >> 7, b = bh >> 2, head = bh & 3;
  unsigned char* Qs = lds;
  unsigned char* Ks = lds + 9216;
  unsigned char* Vt = lds + 18432;
  unsigned char* As = lds + 27648;
  float* Zs = (float*)(lds + 36864);
  volatile int* flag = (volatile int*)(lds + 36864 + 64 * 65 * 4);
  const int lrow = tid >> 3, lch = (tid & 7);
  const size_t tokq = (size_t)b * TSEQ + qt * 64;
  *(uint4*)(Qs + lrow * 144 + lch * 16) = *(const uint4*)(p + (tokq + lrow) * NIN + C_SQ + head * 64 + lch * 8);
  float carry = 0.f;
  f32x4 oacc[2] = {{0.f, 0.f, 0.f, 0.f}, {0.f, 0.f, 0.f, 0.f}};
  const int qi = w >> 1, t2 = (w & 1) * 2;
  const int q = tid >> 3, seg = tid & 7;
  uint4 kreg = *(const uint4*)(p + (tokq + lrow) * NIN + C_SK + head * 64 + lch * 8);
  const int vkey = tid & 63, vch = tid >> 6;
  uint4 vreg = *(const uint4*)(p + (tokq + vkey) * NIN + C_SV + head * 64 + vch * 8);
  for (int kt = qt; kt >= 0; --kt) {
    LBAR();
    *(uint4*)(Ks + lrow * 144 + lch * 16) = kreg;
    { const unsigned vw[4] = {vreg.x, vreg.y, vreg.z, vreg.w};
#pragma unroll
      for (int e = 0; e < 8; ++e) *(unsigned short*)(Vt + (vch * 8 + e) * 144 + vkey * 2) = (unsigned short)((e & 1) ? (vw[e >> 1] >> 16) : (vw[e >> 1] & 0xffffu)); }
    if (tid == 0) *flag = 0;
    if (kt > 0) { const size_t tokn = (size_t)b * TSEQ + (kt - 1) * 64;
      kreg = *(const uint4*)(p + (tokn + lrow) * NIN + C_SK + head * 64 + lch * 8);
      vreg = *(const uint4*)(p + (tokn + vkey) * NIN + C_SV + head * 64 + vch * 8); }
    LBAR();
#pragma unroll
    for (int jj = 0; jj < 2; ++jj) {
      const int ki = t2 + jj;
      f32x4 acc = {0.f, 0.f, 0.f, 0.f};
#pragma unroll
      for (int s = 0; s < 2; ++s) {
        const bf16x8 a = *(const bf16x8*)(Qs + (qi * 16 + (lane & 15)) * 144 + s * 64 + (lane >> 4) * 16);
        const bf16x8 bb = *(const bf16x8*)(Ks + (ki * 16 + (lane & 15)) * 144 + s * 64 + (lane >> 4) * 16);
        acc = __builtin_amdgcn_mfma_f32_16x16x32_bf16(a, bb, acc, 0, 0, 0);
      }
#pragma unroll
      for (int r = 0; r < 4; ++r) Zs[(qi * 16 + (lane >> 4) * 4 + r) * 65 + ki * 16 + (lane & 15)] = acc[r] * 0.125f;
    }
    LBAR();
    {
      const int tq = qt * 64 + q;
      float z[8], lk[8];
      float tot = 0.f;
#pragma unroll
      for (int e = 0; e < 8; ++e) {
        z[e] = Zs[q * 65 + seg * 8 + e];
        const bool m = (kt * 64 + seg * 8 + e) < tq;
        lk[e] = m ? -softplus_fast(z[e]) : 0.f;
        tot += lk[e];
      }
      float inc = tot;
      { float t_ = bperm(inc, lane + 1); if (seg + 1 < 8) inc += t_; }
      { float t_ = bperm(inc, lane + 2); if (seg + 2 < 8) inc += t_; }
      { float t_ = bperm(inc, lane + 4); if (seg + 4 < 8) inc += t_; }
      const float rowtot = bperm(inc, lane & ~7);
      float tail = carry + (inc - tot);
      float av[8];
#pragma unroll
      for (int e = 7; e >= 0; --e) {
        const bool m = (kt * 64 + seg * 8 + e) < tq;
        av[e] = m ? __expf(z[e] + lk[e] + tail) : 0.f;
        tail += lk[e];
      }
      uint4 o; o.x = pack2(av[0], av[1]); o.y = pack2(av[2], av[3]); o.z = pack2(av[4], av[5]); o.w = pack2(av[6], av[7]);
      *(uint4*)(As + q * 144 + seg * 16) = o;
      carry += rowtot;
      if (carry > -100.f) *flag = 1;
    }
    LBAR();
#pragma unroll
    for (int jj = 0; jj < 2; ++jj) {
      const int di = t2 + jj;
#pragma unroll
      for (int s = 0; s < 2; ++s) {
        const bf16x8 a = *(const bf16x8*)(As + (qi * 16 + (lane & 15)) * 144 + s * 64 + (lane >> 4) * 16);
        const bf16x8 bb = *(const bf16x8*)(Vt + (di * 16 + (lane & 15)) * 144 + s * 64 + (lane >> 4) * 16);
        oacc[jj] = __builtin_amdgcn_mfma_f32_16x16x32_bf16(a, bb, oacc[jj], 0, 0, 0);
      }
    }
    if (*flag == 0) break;
  }
#pragma unroll
  for (int jj = 0; jj < 2; ++jj) {
    const int d = (t2 + jj) * 16 + (lane & 15);
#pragma unroll
    for (int r = 0; r < 4; ++r) {
      const int qq = qi * 16 + (lane >> 4) * 4 + r;
      bf16_t* gp = p + (tokq + qq) * NIN + C_SG + head * 64 + d;
      *gp = f2bf(oacc[jj][r] * siluf_(bf2f(*gp)));
    }
  }
  __syncthreads();
}

__device__ __forceinline__ void xattn_item(KP P, int l, int item, unsigned char* lds, int wv_) {
  const bf16_t* qb = (const bf16_t*)(P->ws + WS_P + 32ull * MiB);
  bf16_t* ob = (bf16_t*)(P->ws + WS_P + 64ull * MiB);
  const bf16_t* kv = (const bf16_t*)(P->ws + WS_KV) + (size_t)l * 512 * 2048;
  const bf16_t* vt = (const bf16_t*)(P->ws + WS_VT) + (size_t)l * 2 * 1024 * 256;
  const int tid = opaque_tid(wv_), lane = tid & 63, w = tid >> 6;
  const int qt = item & 127, bh = item >> 7, b = bh >> 2, head = bh & 3;
  unsigned char* Qs = lds;
  unsigned char* KVs = lds + 33792;
  float* Ss = (float*)(lds + 67584);
  const size_t tok0 = (size_t)b * TSEQ + qt * 64;
  const int pr = tid >> 5, pc = tid & 31;
  uint4 pg0, pg1, pg2, pg3;
#define XA_LOAD(p_) { const bf16_t* s_ = (p_) < 4 ? kv + (size_t)(b * 256 + (p_) * 64 + pr) * 2048 + head * 256 + pc * 8 : vt + (size_t)(b * 1024 + head * 256 + ((p_) - 4) * 64 + pr) * 256 + pc * 8; \
      const size_t st_ = (p_) < 4 ? (size_t)16 * 2048 : (size_t)16 * 256; \
      pg0 = *(const uint4*)(s_); pg1 = *(const uint4*)(s_ + st_); pg2 = *(const uint4*)(s_ + 2 * st_); pg3 = *(const uint4*)(s_ + 3 * st_); }
  __syncthreads();
#pragma unroll
  for (int i = 0; i < 4; ++i) { const int r = pr + 16 * i; *(uint4*)(Qs + r * 528 + pc * 16) = *(const uint4*)(qb + (tok0 + r) * 1024 + head * 256 + pc * 8); }
  XA_LOAD(0);
  const int qi = w >> 1, t2 = (w & 1) * 2;
#pragma unroll 1
  for (int p = 0; p < 8; ++p) {
    LBAR();
    { unsigned char* d_ = KVs + pr * 528 + pc * 16; *(uint4*)d_ = pg0; *(uint4*)(d_ + 16 * 528) = pg1; *(uint4*)(d_ + 32 * 528) = pg2; *(uint4*)(d_ + 48 * 528) = pg3; }
    if (p < 7) XA_LOAD(p + 1);
    LBAR();
    f32x4 acc0 = {0.f, 0.f, 0.f, 0.f}, acc1 = {0.f, 0.f, 0.f, 0.f};
#pragma unroll
    for (int s = 0; s < 8; ++s) {
      const bf16x8 a = *(const bf16x8*)(Qs + (qi * 16 + (lane & 15)) * 528 + s * 64 + (lane >> 4) * 16);
      const bf16x8 b0 = *(const bf16x8*)(KVs + (t2 * 16 + (lane & 15)) * 528 + s * 64 + (lane >> 4) * 16);
      const bf16x8 b1 = *(const bf16x8*)(KVs + ((t2 + 1) * 16 + (lane & 15)) * 528 + s * 64 + (lane >> 4) * 16);
      acc0 = __builtin_amdgcn_mfma_f32_16x16x32_bf16(a, b0, acc0, 0, 0, 0);
      acc1 = __builtin_amdgcn_mfma_f32_16x16x32_bf16(a, b1, acc1, 0, 0, 0);
    }
    if (p < 4) {
#pragma unroll
      for (int r = 0; r < 4; ++r) { float* d_ = Ss + (qi * 16 + (lane >> 4) * 4 + r) * 260 + p * 64 + t2 * 16 + (lane & 15); d_[0] = acc0[r] * 0.0625f; d_[16] = acc1[r] * 0.0625f; }
      if (p == 3) {
        LBAR();
        const int q = tid >> 3, seg = tid & 7;
        float x[32]; float mx = -3.0e38f;
#pragma unroll
        for (int i = 0; i < 8; ++i) { const float4 v = *(const float4*)(Ss + q * 260 + seg * 32 + i * 4); x[i * 4] = v.x; x[i * 4 + 1] = v.y; x[i * 4 + 2] = v.z; x[i * 4 + 3] = v.w;
          mx = fmaxf(mx, fmaxf(fmaxf(v.x, v.y), fmaxf(v.z, v.w))); }
        mx = max8(mx);
        float sum = 0.f;
#pragma unroll
        for (int i = 0; i < 32; ++i) { x[i] = __expf(x[i] - mx); sum += x[i]; }
        sum = red8(sum);
        const float inv = __builtin_amdgcn_rcpf(sum);
#pragma unroll
        for (int i = 0; i < 4; ++i) { uint4 o; o.x = pack2(x[i * 8] * inv, x[i * 8 + 1] * inv); o.y = pack2(x[i * 8 + 2] * inv, x[i * 8 + 3] * inv);
          o.z = pack2(x[i * 8 + 4] * inv, x[i * 8 + 5] * inv); o.w = pack2(x[i * 8 + 6] * inv, x[i * 8 + 7] * inv);
          *(uint4*)(Qs + q * 528 + seg * 64 + i * 16) = o; }
      }
    } else {
#pragma unroll
      for (int r = 0; r < 4; ++r) { bf16_t* d_ = ob + (tok0 + qi * 16 + (lane >> 4) * 4 + r) * 1024 + head * 256 + (p - 4) * 64 + t2 * 16 + (lane & 15); d_[0] = f2bf(acc0[r]); d_[16] = f2bf(acc1[r]); }
    }
  }
#undef XA_LOAD
  __syncthreads();
}

__device__ __forceinline__ void wt_item(KP P, int l, int r, unsigned char* lds, int wv_) {
  const float* W; int N; bf16_t* Wt; int kt, nt; const float* gk = nullptr;
  unsigned char* wl = P->ws + WS_WT + l * WT_LAYER;
  if (r < 976) { W = P->in[3] + (size_t)l * 1024 * NIN; N = NIN; Wt = (bf16_t*)(wl + WT_IN); kt = r / 61; nt = r % 61; gk = P->in[2] + l * 1024; }
  else { r -= 976; const int m = r >> 8; r &= 255; kt = r >> 4; nt = r & 15; N = 1024;
    if (m == 0) { W = P->in[20] + (size_t)l * 1048576; Wt = (bf16_t*)(wl + WT_OUT); }
    else if (m == 1) { W = P->in[23] + (size_t)l * 1048576; Wt = (bf16_t*)(wl + WT_Q); gk = P->in[21] + l * 1024; }
    else if (m == 2) { W = P->in[24] + (size_t)l * 1048576; Wt = (bf16_t*)(wl + WT_KV); }
    else if (m == 3) { W = P->in[25] + (size_t)l * 1048576; Wt = (bf16_t*)(wl + WT_KV) + 1024 * 1024; }
    else { W = P->in[26] + (size_t)l * 1048576; Wt = (bf16_t*)(wl + WT_O); } }
  wt_tile(W, N, Wt, kt, nt, lds, wv_, gk);
}
__device__ __forceinline__ void wt_deferred(KP P, int d, unsigned char* lds, int wv_) {
  if (d < 768) { const int m = d >> 8, r = d & 255; wt_item(P, 0, 976 + (m == 0 ? 0 : m == 1 ? 256 : 1024) + r, lds, wv_); }
  else wt_item(P, 1, d - 768, lds, wv_);
}
__device__ __forceinline__ int next_item(unsigned* ctr, volatile LAS int* slot, int wv_) {
  __syncthreads();
  if (opaque_tid(wv_) == 0) *slot = (int)__hip_atomic_fetch_add(ctr, 1u, __ATOMIC_RELAXED, __HIP_MEMORY_SCOPE_AGENT);
  __syncthreads();
  return *slot;
}
__global__ void __launch_bounds__(NTHR) fwd_megakernel(Params Pk_unused) {
  KP P = (KP)__builtin_amdgcn_kernarg_segment_ptr();
  extern __shared__ __attribute__((aligned(16))) unsigned char lds[];
  const int wv_ = __builtin_amdgcn_readfirstlane((int)threadIdx.x >> 6);
  __shared__ uint4 xb_words;
  __shared__ int4 wq_slot;
  if (opaque_tid(wv_) == 0) xb_words = make_uint4(0u, 0u, 0u, 0u);
  __syncthreads();
#ifdef PROBE_J
  __shared__ unsigned long long tacc[32];
  __shared__ unsigned long long tlast;
  __shared__ float pdelta;
  if (opaque_tid(wv_) == 0) { for (int i = 0; i < 32; ++i) tacc[i] = 0ull; tlast = __builtin_amdgcn_s_memrealtime(); pdelta = 0.f; }
#define STAMP(k) if (opaque_tid(wv_) == 0) { const unsigned long long n_ = __builtin_amdgcn_s_memrealtime(); tacc[k] += n_ - tlast; tlast = n_; }
#else
#define STAMP(k)
#endif
  XcdBarrier bar = xcd_barrier_post((unsigned*)(P->ws + WS_BAR), (volatile LAS unsigned*)&xb_words, wv_);
  if (P->never) cg::this_grid().sync();
  const int G = gridDim.x, bid0 = blockIdx.x;

  for (int it = bid0; it < 976 + 512; it += G) wt_item(P, 0, it < 976 ? it : it + 512, lds, wv_);
#pragma unroll 1
  for (int k = 0; k < 3; ++k) {
    const float* s_ = k < 2 ? P->in[1] : P->in[0];
    const float* g_ = k < 2 ? P->in[22] + k * 1024 : P->in[2];
    bf16_t* d_ = k < 2 ? (bf16_t*)(P->ws + WS_MEMN) + k * 512 * 1024 : (bf16_t*)(P->ws + WS_R1);
    norm_rows(false, s_, g_, d_, k < 2 ? 512 : NT, 0.f, wv_, k < 2 ? nullptr : (float*)(P->ws + WS_SSQ));
  }
  { float* z_ = (float*)(P->ws + WS_SSQ) + NT; for (int i = bid0 * NTHR + opaque_tid(wv_); i < 4 * NT; i += G * NTHR) z_[i] = 0.f; }
  STAMP(16 + 10); xcd_barrier(bar, wv_); STAMP(10)
  asm volatile("" : "+s"(P));

#pragma unroll 1
  for (int it = 0; it < 17; ++it) {
    int l = it >> 3, ph = it & 7;
    ph = ph < 5 ? ph : ph + 1;
    if (it == 16) { l = 1; ph = 9; }
    asm volatile("" : "+s"(P));
    int bid = bid0; asm volatile("" : "+s"(bid));

    unsigned char* ws = P->ws;
    const unsigned char* wl = ws + WS_WT + l * WT_LAYER;
    bf16_t* hbuf = (bf16_t*)(ws + WS_R1);
    float* ssq = (float*)(ws + WS_SSQ);
    bf16_t* pbuf = (bf16_t*)(ws + WS_P);
    bf16_t* hx = (bf16_t*)(ws + WS_P);
    bf16_t* qbuf = (bf16_t*)(ws + WS_P + 32ull * MiB);
    bf16_t* obuf = (bf16_t*)(ws + WS_P + 64ull * MiB);
    if (ph == 0 || ph == 4 || ph == 6 || ph == 8) {
      pg8::Gemm g; pg8::TileSched S; pg8::EpiDyn E;
      g.M = NT; g.K = 1024; S.G = G; S.c = bid;
      if (ph == 0) { g.A = hbuf; g.Bt = (const bf16_t*)(wl + WT_IN); g.N = 4096; g.lda = 1024; g.ao0 = 0; g.ao1 = 256; g.ao2 = 512; g.ao3 = 768; S.nt = 1024; S.nN = 16;
        E.mode = 0; E.O = pbuf; E.ldc = NIN; E.N = NIN; E.resid = nullptr; E.out = nullptr; E.ssq_in = ssq + (l == 0 ? 0 : 2) * NT; E.xb = nullptr; E.ssq_out = nullptr; }
      else if (ph == 4) { g.A = pbuf; g.Bt = (const bf16_t*)(wl + WT_OUT); g.N = 1024; g.lda = NIN; g.ao0 = C_GA; g.ao1 = C_CGATE; g.ao2 = C_HG; g.ao3 = C_SG; S.nt = 256; S.nN = 4;
        E.mode = 1; E.O = nullptr; E.ldc = 1024; E.N = 1024; E.resid = (l == 0) ? P->in[0] : P->out; E.out = P->out; E.ssq_in = nullptr; E.xb = hbuf; E.ssq_out = ssq + (l == 0 ? 1 : 3) * NT; }
      else if (ph == 6) { g.A = hbuf; g.Bt = (const bf16_t*)(wl + WT_Q); g.N = 1024; g.lda = 1024; g.ao0 = 0; g.ao1 = 256; g.ao2 = 512; g.ao3 = 768; S.nt = 256; S.nN = 4;
        E.mode = 0; E.O = qbuf; E.ldc = 1024; E.N = 1024; E.resid = nullptr; E.out = nullptr; E.ssq_in = ssq + (l == 0 ? 1 : 3) * NT; E.xb = nullptr; E.ssq_out = nullptr; }
      else { g.A = obuf; g.Bt = (const bf16_t*)(wl + WT_O); g.N = 1024; g.lda = 1024; g.ao0 = 0; g.ao1 = 256; g.ao2 = 512; g.ao3 = 768; S.nt = 256; S.nN = 4;
        E.mode = 1; E.O = nullptr; E.ldc = 1024; E.N = 1024; E.resid = P->out; E.out = P->out; E.ssq_in = nullptr; E.xb = hbuf; E.ssq_out = ssq + (l == 0 ? 2 : 4) * NT; }
      pg8::gemm_phase<pg8::EpiDyn, pg8::TileSched, true, true>((PG8_LAS unsigned char*)lds, g, S, E, wv_);
    } else if (ph == 1) {
      unsigned* ctr = (unsigned*)(ws + WS_BAR) + it;
      for (;;) {
        const int i2 = next_item(ctr, (volatile LAS int*)&wq_slot, wv_);
        if (i2 >= 640) break;
        if (i2 < 128) hgrn_wave_item<0>(P, l, i2 * 8 + wv_, lds, wv_);
        else rwkv_prep_item(P, l, i2 - 128, lds, wv_);
      }
    } else if (ph == 2) {
      const int n_p1 = 8 * (RW_C - 2);
      const int n_rw = n_p1 + 8;
      const int n_oth = 8 + 512 + 1024;
      for (int i2 = bid; i2 < n_rw; i2 += G) {
        if (i2 < n_p1) rwkv_scan_item<1>(P, l, i2 & 7, 1 + (i2 >> 3), lds, wv_);
        else rwkv_scan_item<0>(P, l, i2 - n_p1, 0, lds, wv_);
      }
      {
        unsigned* ctr = (unsigned*)(ws + WS_BAR) + it;
        for (;;) {
          const int i2 = next_item(ctr, (volatile LAS int*)&wq_slot, wv_);
          if (i2 >= n_oth) break;
          if (i2 < 8) hgrn_combine_item(P, i2, wv_);
          else if (i2 < 8 + 512) conv_item(P, l, i2 - 8, lds, wv_);
          else sb_item(P, i2 - 8 - 512, lds, wv_);
        }
      }
    } else if (ph == 3) {
      const int n_p3 = 8 * (RW_C - 1);
      for (int i2 = bid; i2 < n_p3; i2 += G) rwkv_scan_item<0>(P, l, i2 & 7, 1 + (i2 >> 3), lds, wv_);
      {
        unsigned* ctr = (unsigned*)(ws + WS_BAR) + it;
        for (;;) {
          const int i2 = next_item(ctr, (volatile LAS int*)&wq_slot, wv_);
          if (i2 >= 16 + 128 + (l == 0 ? 189 : 0)) break;
          if (i2 >= 16 + 128) { for (int d = (i2 - 144) * 16; d < (i2 - 144) * 16 + 16; ++d) wt_deferred(P, d, lds, wv_); }
          else if (i2 < 16) gemm_tile<2>((const bf16_t*)(ws + WS_MEMN) + (size_t)l * 512 * 1024, 1024, 0, 256, 512, 768, (const bf16_t*)(wl + WT_KV), (i2 >> 3) * 256, (i2 & 7) * 256, 2048,
                                    (bf16_t*)(ws + WS_KV) + (size_t)l * 512 * 2048, (const float*)((bf16_t*)(ws + WS_VT) + (size_t)l * 2 * 1024 * 256), 2048, lds, wv_);
          else hgrn_wave_item<1>(P, l, (i2 - 16) * 8 + wv_, lds, wv_);
        }
      }
    } else if (ph == 7) {
      for (int i2 = bid; i2 < 1024; i2 += G) xattn_item(P, l, i2, lds, wv_);
    } else {
      const bool fin = true;
      const float* g_ = P->in[27];
      void* d_ = (void*)P->out;
#ifdef PROBE_J
      float pd_ = 0.f;
      if (fin) {
        if (bid == PROBE_B) {
          if (opaque_tid(wv_) == 0) {
            unsigned long long tot = 0ull; for (int i = 0; i < 11; ++i) tot += tacc[i] + tacc[16 + i];
            pdelta = sqrtf(0.0128f * (float)(PROBE_J < 32 ? tacc[PROBE_J & 31] : tacc[PROBE_J - 32] + tacc[PROBE_J - 16]) / (float)tot);
          }
          __syncthreads();
          pd_ = pdelta;
        }
      }
      norm_rows(fin, P->out, g_, d_, NT, pd_, wv_);
#else
      norm_rows(fin, P->out, g_, d_, NT, 0.f, wv_);
#endif
    }
    if (it < 16) { STAMP(16 + ph); xcd_barrier(bar, wv_); STAMP(ph) }
  }
#ifdef PROBE_J
  if (bid0 == PROBE_B && opaque_tid(wv_) == 0) {
    const unsigned long long t0_ = __builtin_amdgcn_s_memrealtime();
    const unsigned long long w_ = 4ull * (PROBE_K < 32 ? tacc[PROBE_K & 31] : tacc[PROBE_K - 32] + tacc[PROBE_K - 16]);
    while (__builtin_amdgcn_s_memrealtime() - t0_ < w_) __builtin_amdgcn_s_sleep(8);
  }
#endif
}

extern "C" void kernel_launch(void* const* d_in, const int* in_sizes, int n_in, void* d_out, int out_size, void* d_ws, size_t ws_size, hipStream_t stream) {
  constexpr size_t kDynLds = 147456;
  static int grid_blocks = 0;
  if (!grid_blocks) {
    int dev = 0, cus = 0, per_cu = 0;
    hipGetDevice(&dev);
    hipDeviceGetAttribute(&cus, hipDeviceAttributeMultiprocessorCount, dev);
    hipFuncSetAttribute((const void*)fwd_megakernel, hipFuncAttributeMaxDynamicSharedMemorySize, (int)kDynLds);
    hipOccupancyMaxActiveBlocksPerMultiprocessor(&per_cu, fwd_megakernel, NTHR, kDynLds);
    if (per_cu < 1) per_cu = 1;
    if (per_cu > 1) per_cu = 1;
    grid_blocks = cus * per_cu;
    if (grid_blocks > 256) grid_blocks = 256;
  }
  Params p;
  memset(&p, 0, sizeof(p));
  for (int i = 0; i < 28; ++i) p.in[i] = (const float*)d_in[i];
  p.out = (float*)d_out; p.ws = (unsigned char*)d_ws; p.never = 0; p.pad = 0;
  hipMemsetAsync(d_ws, 0, XCD_BAR_WORDS * 4, stream);
  void* args[] = {&p};
  hipError_t e = hipLaunchCooperativeKernel((void*)fwd_megakernel, dim3(grid_blocks), dim3(NTHR), args, kDynLds, stream);
  if (e != hipSuccess) fprintf(stderr, "cooperative launch failed: %s (grid %d)\n", hipGetErrorString(e), grid_blocks);
}
```

```cpp
#include <hip/hip_runtime.h>
#include <hip/hip_cooperative_groups.h>
#include <stdint.h>
#include <cstdio>
#include <cstring>
namespace cg = cooperative_groups;

typedef unsigned short bf16_t;
typedef short bf16x8 __attribute__((ext_vector_type(8)));
typedef float f32x4 __attribute__((ext_vector_type(4)));
typedef float f32x16 __attribute__((ext_vector_type(16)));
typedef float f32x2 __attribute__((ext_vector_type(2)));
#define LAS __attribute__((address_space(3)))

#define NT 16384
#define TSEQ 8192
#define DM 1024
#define NIN 3904
#define NTHR 512
#define C_R 0
#define C_K 256
#define C_V 512
#define C_XW 768
#define C_GA 832
#define C_CVAL 1088
#define C_CGLU 1344
#define C_CGATE 1600
#define C_HQ 1856
#define C_HF 2112
#define C_HI 2368
#define C_HG 2624
#define C_SQ 2880
#define C_SK 3136
#define C_SV 3392
#define C_SG 3648
#define RW_C 32
#define RW_CL (TSEQ / RW_C)
#define RW_TT 16

#define MiB (1024ull * 1024ull)
#define WS_BAR   0ull
#define WS_WT    (1ull * MiB)
#define WT_LAYER (18ull * MiB)
#define WT_IN    0ull
#define WT_OUT   (8ull * MiB)
#define WT_Q     (10ull * MiB)
#define WT_KV    (12ull * MiB)
#define WT_O     (16ull * MiB)
#define WS_MEMN  (37ull * MiB)
#define WS_KV    (39ull * MiB)
#define WS_PQ    (246ull * MiB)
#define WS_HS    (47ull * MiB)
#define WS_HF    (63ull * MiB)
#define WS_RK    (63ull * MiB + 512ull * 1024ull)
#define WS_R1    (64ull * MiB)
#define WS_PW    WS_R1
#define WS_PV    (WS_R1 + 16ull * MiB)
#define WS_P     (120ull * MiB)
#define WS_VT    (243ull * MiB)
#define WS_SSQ   (245ull * MiB)
#define WS_END   (254ull * MiB)

struct Params {
  const float* in[28];
  float* out;
  unsigned char* ws;
  int never;
  int pad;
};

typedef const __attribute__((address_space(4))) Params* KP;
__device__ __forceinline__ int lane_id_() { return (int)__builtin_amdgcn_mbcnt_hi(~0u, __builtin_amdgcn_mbcnt_lo(~0u, 0u)); }
__device__ __forceinline__ int opaque_tid(int wv_) { int t; asm volatile("v_mbcnt_lo_u32_b32 %0, -1, 0\n\tv_mbcnt_hi_u32_b32 %0, -1, %0\n\tv_lshl_add_u32 %0, %1, 6, %0" : "=&v"(t) : "s"(wv_)); return t; }
__device__ __forceinline__ float bf2f(bf16_t v) { return __uint_as_float(((unsigned)v) << 16); }
__device__ __forceinline__ bf16_t f2bf(float f) {
  unsigned u = __float_as_uint(f);
  u += 0x7fffu + ((u >> 16) & 1u);
  return (bf16_t)(u >> 16);
}
__device__ __forceinline__ unsigned pack2(float a, float b) { return (unsigned)f2bf(a) | ((unsigned)f2bf(b) << 16); }
__device__ __forceinline__ float sigmoidf_(float x) { return __builtin_amdgcn_rcpf(1.0f + __expf(-x)); }
__device__ __forceinline__ float siluf_(float x) { return x * __builtin_amdgcn_rcpf(1.0f + __expf(-x)); }
__device__ __forceinline__ float softplusf_(float x) { return fmaxf(x, 0.f) + log1pf(__expf(-fabsf(x))); }
__device__ __forceinline__ float softplus_fast(float x) { return fmaxf(x, 0.f) + __logf(1.0f + __expf(-fabsf(x))); }
__device__ __forceinline__ float dpp_add(float v, const int ctrl_sel) {
  return v;
}
__device__ __forceinline__ float bperm(float v, int srclane) { return __builtin_bit_cast(float, __builtin_amdgcn_ds_bpermute(srclane << 2, __builtin_bit_cast(int, v))); }
__device__ __forceinline__ float wave_sum(float v, int lane) {
  v += __builtin_bit_cast(float, __builtin_amdgcn_update_dpp(0, __builtin_bit_cast(int, v), 0xB1, 0xF, 0xF, true));
  v += __builtin_bit_cast(float, __builtin_amdgcn_update_dpp(0, __builtin_bit_cast(int, v), 0x4E, 0xF, 0xF, true));
  v += __builtin_bit_cast(float, __builtin_amdgcn_update_dpp(0, __builtin_bit_cast(int, v), 0x141, 0xF, 0xF, true));
  v += __builtin_bit_cast(float, __builtin_amdgcn_update_dpp(0, __builtin_bit_cast(int, v), 0x140, 0xF, 0xF, true));
  v += bperm(v, lane ^ 16);
  v += bperm(v, lane ^ 32);
  return v;
}
__device__ __forceinline__ float max8(float v) {
  v = fmaxf(v, __builtin_bit_cast(float, __builtin_amdgcn_update_dpp(0, __builtin_bit_cast(int, v), 0xB1, 0xF, 0xF, true)));
  v = fmaxf(v, __builtin_bit_cast(float, __builtin_amdgcn_update_dpp(0, __builtin_bit_cast(int, v), 0x4E, 0xF, 0xF, true)));
  v = fmaxf(v, __builtin_bit_cast(float, __builtin_amdgcn_update_dpp(0, __builtin_bit_cast(int, v), 0x141, 0xF, 0xF, true)));
  return v;
}
__device__ __forceinline__ float red8(float v) {
  v += __builtin_bit_cast(float, __builtin_amdgcn_update_dpp(0, __builtin_bit_cast(int, v), 0xB1, 0xF, 0xF, true));
  v += __builtin_bit_cast(float, __builtin_amdgcn_update_dpp(0, __builtin_bit_cast(int, v), 0x4E, 0xF, 0xF, true));
  v += __builtin_bit_cast(float, __builtin_amdgcn_update_dpp(0, __builtin_bit_cast(int, v), 0x141, 0xF, 0xF, true));
  return v;
}

#define LBAR() do { asm volatile("s_waitcnt lgkmcnt(0)" ::: "memory"); __builtin_amdgcn_s_barrier(); asm volatile("" ::: "memory"); } while (0)
#define XB_TMO      128
#define XB_XCNT(j)  (256  + 64 * (j))
#define XB_XSUB(j)  (1280 + 64 * (j))
#define XB_XGEN(j)  (2304 + 64 * (j))
#define XB_TOP      3328
#define XB_TOPGEN   3392
#define XCD_BAR_WORDS 3456
#define XB_SPIN_CAP (1u << 22)
__device__ __forceinline__ unsigned xb_ld(unsigned* p) { return __hip_atomic_load(p, __ATOMIC_RELAXED, __HIP_MEMORY_SCOPE_AGENT); }
__device__ __forceinline__ unsigned xb_add(unsigned* p, unsigned v) { return __hip_atomic_fetch_add(p, v, __ATOMIC_RELAXED, __HIP_MEMORY_SCOPE_AGENT); }
__device__ __forceinline__ unsigned xb_xcc_id() { return (unsigned)__builtin_amdgcn_s_getreg((3 << 11) | 20) & 0xFu; }
#define XB_SPIN(cond, bar) do { unsigned _sp = 0; while (cond) { __builtin_amdgcn_s_sleep(1); \
    if ((++_sp & 255u) == 0u) { if (xb_ld(&(bar)[XB_TMO])) break; if (_sp > XB_SPIN_CAP) { atomicAdd(&(bar)[XB_TMO], 1u); break; } } } } while (0)
struct XcdBarrier { unsigned* bar; unsigned x; volatile LAS unsigned* st; };
__device__ __forceinline__ XcdBarrier xcd_barrier_post(unsigned* bar, volatile LAS unsigned* st, int wv_) {
  XcdBarrier b; b.bar = bar; b.x = xb_xcc_id(); b.st = st;
  if (opaque_tid(wv_) == 0) (void)xb_add(&bar[XB_XCNT(b.x)], 1u);
  return b;
}
__device__ __forceinline__ void xcd_barrier_complete(unsigned* bar, unsigned x, unsigned& nloc, unsigned& nx) {
  const unsigned G = gridDim.x * gridDim.y * gridDim.z;
  unsigned sum, cnt, mine, sp = 0u;
  for (;;) {
    sum = 0u; cnt = 0u; mine = 0u;
#pragma unroll
    for (unsigned j = 0; j < 16; ++j) { const unsigned c = xb_ld(&bar[XB_XCNT(j)]); sum += c; cnt += (c > 0u) ? 1u : 0u; mine = (j == x) ? c : mine; }
    if (sum == G) break;
    __builtin_amdgcn_s_sleep(1);
    if ((++sp & 255u) == 0u) { if (xb_ld(&bar[XB_TMO])) break; if (sp > XB_SPIN_CAP) { atomicAdd(&bar[XB_TMO], 1u); break; } }
  }
  nloc = mine > 0u ? mine : 1u; nx = cnt > 0u ? cnt : 1u;
}
__device__ __forceinline__ void xcd_barrier(const XcdBarrier& b, int wv_) {
  asm volatile("s_waitcnt vmcnt(0)" ::: "memory");
  __syncthreads();
  if (opaque_tid(wv_) == 0) {
    unsigned* bar = b.bar;
    __builtin_amdgcn_s_waitcnt(0);
    unsigned bx = b.x; asm volatile("" : "+s"(bx));
    unsigned nloc = b.st[0], nx = b.st[1];
    if (nloc == 0u) { xcd_barrier_complete(bar, bx, nloc, nx); b.st[0] = nloc; b.st[1] = nx; }
    const unsigned old = xb_add(&bar[XB_XSUB(bx)], 1u);
    const unsigned gen = old / nloc;
    if (old + 1u == (gen + 1u) * nloc) {
      __builtin_amdgcn_fence(__ATOMIC_RELEASE, "agent");
      asm volatile("s_waitcnt vmcnt(0)" ::: "memory");
      const unsigned og = xb_add(&bar[XB_TOP], 1u);
      const unsigned tg = og / nx;
      if (og + 1u == (tg + 1u) * nx) xb_add(&bar[XB_TOPGEN], 1u);
      else XB_SPIN(xb_ld(&bar[XB_TOPGEN]) == tg, bar);
      __builtin_amdgcn_fence(__ATOMIC_ACQUIRE, "agent");
      xb_add(&bar[XB_XGEN(bx)], 1u);
      asm volatile("s_waitcnt vmcnt(0)" ::: "memory");
    } else {
      XB_SPIN(xb_ld(&bar[XB_XGEN(bx)]) == gen, bar);
      __builtin_amdgcn_fence(__ATOMIC_ACQUIRE, "agent");
      asm volatile("s_waitcnt vmcnt(0)" ::: "memory");
    }
  }
  __syncthreads();
}

#define G_STAGE 73728
#define G_BOFF 36864
template <int EPI>
__device__ __forceinline__ void gemm_tile(const bf16_t* __restrict__ A, int lda, int ao0, int ao1, int ao2, int ao3,
                                          const bf16_t* __restrict__ Bt, int m0, int n0, int N,
                                          void* out, const float* resid, int ldc, unsigned char* lds, int wv_) {
#ifdef OFF_gemm_tile
  return;
#endif

  const int tid = opaque_tid(wv_), lane = tid & 63, w = tid >> 6;
  const int wm = w >> 2, wn = w & 3, lr = lane & 31, lh = lane >> 5;
  f32x16 acc[4][2];
#pragma unroll
  for (int i = 0; i < 4; ++i)
#pragma unroll
    for (int j = 0; j < 2; ++j)
#pragma unroll
      for (int r = 0; r < 16; ++r) acc[i][j][r] = 0.f;
  uint4 ra[4], rb[4];
  const int crow = tid >> 3, ccol = (tid & 7) * 8;
  const bf16_t* Ap = A + (size_t)(m0 + crow) * lda + ccol;
  const bf16_t* Bp = Bt + (size_t)(n0 + crow) * 1024 + ccol;
#define G_LOAD(kt) { const int k0_ = (kt) * 64; const int seg_ = k0_ >> 8; const int ao_ = (seg_ == 0 ? ao0 : seg_ == 1 ? ao1 : seg_ == 2 ? ao2 : ao3) + (k0_ & 255); \
    _Pragma("unroll") for (int i_ = 0; i_ < 4; ++i_) { ra[i_] = *(const uint4*)(Ap + (size_t)(i_ * 64) * lda + ao_); rb[i_] = *(const uint4*)(Bp + (size_t)(i_ * 64) * 1024 + k0_); } }
#define G_WRITE(buf) { unsigned char* b_ = lds + (buf) * G_STAGE + crow * 144 + (tid & 7) * 16; \
    _Pragma("unroll") for (int i_ = 0; i_ < 4; ++i_) { *(uint4*)(b_ + i_ * 64 * 144) = ra[i_]; *(uint4*)(b_ + G_BOFF + i_ * 64 * 144) = rb[i_]; } }
  G_LOAD(0); G_WRITE(0); __syncthreads();
  for (int kt = 0; kt < 16; ++kt) {
    if (kt < 15) G_LOAD(kt + 1);
    const unsigned char* base = lds + (kt & 1) * G_STAGE;
    const unsigned char* ab = base + (wm * 128 + lr) * 144 + lh * 16;
    const unsigned char* bb = base + G_BOFF + (wn * 64 + lr) * 144 + lh * 16;
#pragma unroll
    for (int s = 0; s < 4; ++s) {
      bf16x8 a[4], b[2];
#pragma unroll
      for (int i = 0; i < 4; ++i) a[i] = *(const bf16x8*)(ab + i * 32 * 144 + s * 32);
#pragma unroll
      for (int j = 0; j < 2; ++j) b[j] = *(const bf16x8*)(bb + j * 32 * 144 + s * 32);
#pragma unroll
      for (int i = 0; i < 4; ++i)
#pragma unroll
        for (int j = 0; j < 2; ++j) acc[i][j] = __builtin_amdgcn_mfma_f32_32x32x16_bf16(a[i], b[j], acc[i][j], 0, 0, 0);
    }
    if (kt < 15) G_WRITE((kt + 1) & 1);
    __syncthreads();
  }
#undef G_LOAD
#undef G_WRITE
#pragma unroll
  for (int i = 0; i < 4; ++i)
#pragma unroll
    for (int j = 0; j < 2; ++j) {
      const int col = n0 + wn * 64 + j * 32 + lr;
#pragma unroll
      for (int r = 0; r < 16; ++r) {
        const int row = m0 + wm * 128 + i * 32 + (r & 3) + 8 * (r >> 2) + 4 * lh;
        if (EPI == 0) { if (col < N) ((bf16_t*)out)[(size_t)row * ldc + col] = f2bf(acc[i][j][r]); }
        else if (EPI == 2) { if (col < 1024) ((bf16_t*)out)[(size_t)row * ldc + col] = f2bf(acc[i][j][r]);
                             else ((bf16_t*)resid)[((size_t)((row >> 8) * 1024 + (col - 1024))) * 256 + (row & 255)] = f2bf(acc[i][j][r]); }
        else { ((float*)out)[(size_t)row * ldc + col] = resid[(size_t)row * ldc + col] + acc[i][j][r]; }
      }
    }
}

__device__ __forceinline__ void tile_map(int t, int nN, int& mi, int& ni) {
  const int rnd = t >> 8, blk = t & 255, x = blk & 7, y = blk >> 3;
  if (nN == 16) { mi = rnd * 16 + (x >> 1) * 4 + (y & 3); ni = (x & 1) * 8 + (y >> 2); }
  else { mi = rnd * 64 + x * 8 + (y & 7); ni = y >> 3; }
}

namespace pg8 {
#define PG8_LAS __attribute__((address_space(3)))
typedef unsigned u32x4 __attribute__((ext_vector_type(4)));
constexpr int BM = 256, BK = 64, HALF = 128, HTB = HALF * BK * 2  , STAGE_BYTES = 8 * HTB, NXCD = 8, WGM = 8;

__host__ __device__ __forceinline__ int lds_byte(int r, int c) { const int st = (r >> 4) * 2 + (c >> 5), rr = r & 15, cc = c & 31, ob = rr * 64 + cc * 2; return st * 1024 + (ob ^ (((ob >> 9) & 1) << 5)); }
__host__ __device__ __forceinline__ void stage_rc(int b, int& R, int& C) { const int st = b / 1024, sb = b % 1024, swz = sb ^ (((sb >> 9) & 1) << 5); R = (st >> 1) * 16 + swz / 64; C = (st & 1) * 32 + (swz % 64) / 2; }
__host__ __device__ __forceinline__ int perm32(int rho) { const int n = rho >> 4, i = rho & 15; return 8 * (i >> 2) + 4 * n + (i & 3); }

struct Unit { int pm, pn; };
struct Gemm { const bf16_t* A; const bf16_t* Bt; int M, N, K; int lda; int ao0, ao1, ao2, ao3; };

struct TileSched {
    int nt, G, c, nN;
    __device__ __forceinline__ bool next(int i, Unit& u) const { const int t = i * G + c; if (t >= nt) return false; tile_map(t, nN, u.pm, u.pn); return true; }
    __device__ __forceinline__ void a_ready(const Unit&) const {}
    __device__ __forceinline__ void done(const Unit&) const {}
};
__device__ __forceinline__ unsigned cvt_pk_bf16(float lo, float hi) { unsigned r; asm volatile("v_cvt_pk_bf16_f32 %0, %1, %2" : "=v"(r) : "v"(lo), "v"(hi)); return r; }
struct EpiStoreBf16 {
    static constexpr bool PERM = true, AFTER_DRAIN = false;
    bf16_t* O; int ldc; int N;
    __device__ __forceinline__ void operator()(const f32x4 (&acc)[2][2][4][2], const Unit& u, int wr, int wc, int fr, int fq) const {
        const int row0 = u.pm * BM + wr * 64 + fr, col0 = u.pn * BM + wc * 32 + 8 * fq;
#pragma unroll
        for (int ai = 0; ai < 2; ++ai)
#pragma unroll
            for (int m = 0; m < 4; ++m) { bf16_t* rowp = O + (size_t)(row0 + ai * HALF + m * 16) * ldc + col0;
#pragma unroll
                for (int bj = 0; bj < 2; ++bj) { if (col0 + bj * HALF < N) { const f32x4 v0 = acc[ai][bj][m][0], v1 = acc[ai][bj][m][1];
                    u32x4 w; w.x = cvt_pk_bf16(v0[0], v0[1]); w.y = cvt_pk_bf16(v0[2], v0[3]); w.z = cvt_pk_bf16(v1[0], v1[1]); w.w = cvt_pk_bf16(v1[2], v1[3]);
                    *(u32x4*)(rowp + bj * HALF) = w; } } }
    }
};
struct EpiDyn {
    static constexpr bool PERM = true, AFTER_DRAIN = false;
    int mode; bf16_t* O; int ldc; int N; const float* resid; float* out; const float* ssq_in; bf16_t* xb; float* ssq_out;
    __device__ __forceinline__ void operator()(const f32x4 (&acc)[2][2][4][2], const Unit& u, int wr, int wc, int fr, int fq) const {
        const int row0 = u.pm * BM + wr * 64 + fr, col0 = u.pn * BM + wc * 32 + 8 * fq;
        if (mode == 0) {
#pragma unroll
            for (int ai = 0; ai < 2; ++ai)
#pragma unroll
                for (int m = 0; m < 4; ++m) { const int row = row0 + ai * HALF + m * 16; bf16_t* rowp = O + (size_t)row * ldc + col0;
                    const float sc = __builtin_amdgcn_rsqf(ssq_in[row] * (1.0f / 1024.0f) + 1e-6f);
#pragma unroll
                    for (int bj = 0; bj < 2; ++bj) { if (col0 + bj * HALF < N) { const f32x4 v0 = acc[ai][bj][m][0] * sc, v1 = acc[ai][bj][m][1] * sc;
                        u32x4 w; w.x = cvt_pk_bf16(v0[0], v0[1]); w.y = cvt_pk_bf16(v0[2], v0[3]); w.z = cvt_pk_bf16(v1[0], v1[1]); w.w = cvt_pk_bf16(v1[2], v1[3]);
                        *(u32x4*)(rowp + bj * HALF) = w; } } }
        } else {
            const int lane_ = fq * 16 + fr;
#pragma unroll
            for (int ai = 0; ai < 2; ++ai)
#pragma unroll
                for (int m = 0; m < 4; ++m) { const int row = row0 + ai * HALF + m * 16; const size_t off = (size_t)row * ldc + col0; float s = 0.f;
#pragma unroll
                    for (int bj = 0; bj < 2; ++bj) { const f32x4 r0 = *(const f32x4*)(resid + off + bj * HALF), r1 = *(const f32x4*)(resid + off + bj * HALF + 4);
                        const f32x4 x0 = r0 + acc[ai][bj][m][0], x1 = r1 + acc[ai][bj][m][1];
                        *(f32x4*)(out + off + bj * HALF) = x0; *(f32x4*)(out + off + bj * HALF + 4) = x1;
                        u32x4 w; w.x = cvt_pk_bf16(x0[0], x0[1]); w.y = cvt_pk_bf16(x0[2], x0[3]); w.z = cvt_pk_bf16(x1[0], x1[1]); w.w = cvt_pk_bf16(x1[2], x1[3]);
                        *(u32x4*)(xb + off + bj * HALF) = w;
                        s += (x0[0] * x0[0] + x0[1] * x0[1]) + (x0[2] * x0[2] + x0[3] * x0[3]) + (x1[0] * x1[0] + x1[1] * x1[1]) + (x1[2] * x1[2] + x1[3] * x1[3]); }
                    s += bperm(s, lane_ ^ 16); s += bperm(s, lane_ ^ 32);
                    if (fq == 0) __hip_atomic_fetch_add(ssq_out + row, s, __ATOMIC_RELAXED, __HIP_MEMORY_SCOPE_AGENT); }
        }
    }
};
struct EpiResid {
    static constexpr bool PERM = true, AFTER_DRAIN = false;
    const float* resid; float* out; int ldc;
    __device__ __forceinline__ void operator()(const f32x4 (&acc)[2][2][4][2], const Unit& u, int wr, int wc, int fr, int fq) const {
        const int row0 = u.pm * BM + wr * 64 + fr, col0 = u.pn * BM + wc * 32 + 8 * fq;
#pragma unroll
        for (int ai = 0; ai < 2; ++ai)
#pragma unroll
            for (int m = 0; m < 4; ++m) { const size_t off = (size_t)(row0 + ai * HALF + m * 16) * ldc + col0;
#pragma unroll
                for (int bj = 0; bj < 2; ++bj) { const f32x4 r0 = *(const f32x4*)(resid + off + bj * HALF), r1 = *(const f32x4*)(resid + off + bj * HALF + 4);
                    *(f32x4*)(out + off + bj * HALF) = r0 + acc[ai][bj][m][0]; *(f32x4*)(out + off + bj * HALF + 4) = r1 + acc[ai][bj][m][1]; } }
    }
};

static_assert(true, "pg8 body adapted: SP2 path only is valid with lda/segment offsets");
template <class Epi, class Sched, bool ALIGN_EPI = false, bool SP2 = false>
__device__ __forceinline__ void gemm_phase(PG8_LAS unsigned char* lds, const Gemm g, const Sched& S, const Epi& E, int wv_) {
    const int tid = opaque_tid(wv_), wid = __builtin_amdgcn_readfirstlane(tid >> 6), lane = tid & 63, wr = wid >> 2, wc = wid & 3, fr = lane & 15, fq = lane >> 4;
    const int K = g.K, nt = K / BK;
    unsigned voffA, voffB;
    { int R, C; stage_rc(tid * 16, R, C); const int Rb = Epi::PERM ? ((R & ~31) + perm32(R & 31)) : R;
      voffA = (unsigned)(R * g.lda + C) * 2u; voffB = (unsigned)(Rb * K + C) * 2u; }
    const size_t rstepA = (size_t)64 * g.lda * 2, rstepB = (size_t)64 * K * 2;
    const size_t kstep = (size_t)(BK * 2);
    const size_t hstep = (size_t)HALF * K * 2; const size_t hstepA = (size_t)HALF * g.lda * 2, tstepA = 2 * hstepA;
#define PG8_KA(t_) ((size_t)((((t_) >> 2) == 0 ? g.ao0 : ((t_) >> 2) == 1 ? g.ao1 : ((t_) >> 2) == 2 ? g.ao2 : g.ao3) + ((t_) & 3) * 64) * 2)
    const size_t tstep = 2 * hstep;
    const unsigned ldsw = (unsigned)wid * 1024u;
    int aoff, boff;
#define PG8_SA(b, h) (((b) * 2 + (h)) * HTB)
#define PG8_SB(b, h) ((4 + (b) * 2 + (h)) * HTB)
#define PG8_STAGE(bufoff, gbase, voff) do { _Pragma("unroll") for (int _i = 0; _i < 2; ++_i) \
        __builtin_amdgcn_global_load_lds((const unsigned*)((const char*)(gbase) + (size_t)_i * r##voff + (voff)), (PG8_LAS unsigned*)(lds + (bufoff) + ldsw + _i * 8192), 16, 0, 0); } while (0)
#define rvoffA rstepA
#define rvoffB rstepB
#define PG8_LDA(dst, b, h) do { _Pragma("unroll") for (int m = 0; m < 4; ++m) _Pragma("unroll") for (int k = 0; k < 2; ++k) dst[m][k] = *(const PG8_LAS bf16x8*)(lds + (PG8_SA(b, h) + wr * 8192) + aoff + m * 2048 + k * 1024); } while (0)
#define PG8_LDB(dst, b, h) do { _Pragma("unroll") for (int n = 0; n < 2; ++n) _Pragma("unroll") for (int k = 0; k < 2; ++k) dst[n][k] = *(const PG8_LAS bf16x8*)(lds + (PG8_SB(b, h) + wc * 4096) + boff + n * 2048 + k * 1024); } while (0)
#define PG8_MMA(ai, bj, At, Bt) do { __builtin_amdgcn_s_setprio(1); _Pragma("unroll") for (int m = 0; m < 4; ++m) _Pragma("unroll") for (int n = 0; n < 2; ++n) _Pragma("unroll") for (int k = 0; k < 2; ++k) \
        acc[ai][bj][m][n] = __builtin_amdgcn_mfma_f32_16x16x32_bf16(Bt[n][k], At[m][k], acc[ai][bj][m][n], 0, 0, 0); __builtin_amdgcn_s_setprio(0); } while (0)
#define PG8_WAIT_V(n) asm volatile("s_waitcnt vmcnt(" #n ")" ::: "memory")
#define PG8_WAIT_L(n) asm volatile("s_waitcnt lgkmcnt(" #n ")" ::: "memory")
#define PG8_BAR __builtin_amdgcn_s_barrier()
#define PG8_SCHED __builtin_amdgcn_sched_barrier(0)
    Unit cur, nxt; int ui = 0;
    if (!S.next(0, cur)) return;
    f32x4 acc[2][2][4][2];
#pragma unroll
    for (int a = 0; a < 2; ++a)
#pragma unroll
        for (int b = 0; b < 2; ++b)
#pragma unroll
            for (int m = 0; m < 4; ++m)
#pragma unroll
                for (int n = 0; n < 2; ++n) acc[a][b][m][n] = (f32x4){0.f, 0.f, 0.f, 0.f};
    bf16x8 At[4][2], B0[2][2], B1[2][2];
    const char* cA = (const char*)g.A + (size_t)cur.pm * tstepA; const char* cB = (const char*)g.Bt + (size_t)cur.pn * tstep;
    S.a_ready(cur);
    if constexpr (SP2) {
        PG8_STAGE(PG8_SB(0, 0), cB, voffB); PG8_STAGE(PG8_SB(0, 1), cB + hstep, voffB); PG8_STAGE(PG8_SA(0, 0), cA + PG8_KA(0), voffA); PG8_STAGE(PG8_SA(0, 1), cA + hstepA + PG8_KA(0), voffA);
        if (wr == 1) PG8_BAR;
        PG8_WAIT_V(2); PG8_BAR;
        PG8_STAGE(PG8_SB(1, 0), cB + kstep, voffB); PG8_STAGE(PG8_SA(1, 0), cA + PG8_KA(1), voffA); PG8_STAGE(PG8_SB(1, 1), cB + hstep + kstep, voffB);
        PG8_WAIT_V(6); PG8_BAR;
    } else {
        PG8_STAGE(PG8_SB(0, 0), cB, voffB); PG8_STAGE(PG8_SA(0, 0), cA, voffA); PG8_STAGE(PG8_SB(0, 1), cB + hstep, voffB); PG8_STAGE(PG8_SA(0, 1), cA + hstep, voffA);
        if (wr == 1) PG8_BAR;
        PG8_WAIT_V(4); PG8_BAR;
        PG8_STAGE(PG8_SB(1, 0), cB + kstep, voffB); PG8_STAGE(PG8_SA(1, 0), cA + kstep, voffA); PG8_STAGE(PG8_SB(1, 1), cB + hstep + kstep, voffB);
        PG8_WAIT_V(6); PG8_BAR;
    }
    { const int t3_ = opaque_tid(wv_), l3_ = t3_ & 63, w3_ = __builtin_amdgcn_readfirstlane(t3_ >> 6); aoff = lds_byte((l3_ & 15), (l3_ >> 4) * 8); boff = aoff; }
    for (;;) {
        const bool has_next = S.next(ui + 1, nxt);
        const char* nA = has_next ? (const char*)g.A + (size_t)nxt.pm * tstepA : cA; const char* nB = has_next ? (const char*)g.Bt + (size_t)nxt.pn * tstep : cB;
        for (int t = 0; t < nt; t += 2) {
            const bool last = (t == nt - 2);
            const char* a1 = cA + PG8_KA(t + 1);
            const char* a2 = last ? nA + PG8_KA(0) : cA + PG8_KA(t + 2); const char* b2 = last ? nB : cB + (size_t)(t + 2) * kstep;
            const char* a3 = last ? nA + PG8_KA(1) : cA + PG8_KA(t + 3); const char* b3 = b2 + kstep;
            if (last && has_next) S.a_ready(nxt);
            if constexpr (SP2) {
            PG8_LDB(B0, 0, 0); PG8_LDB(B1, 0, 1); PG8_SCHED; PG8_LDA(At, 0, 0); PG8_STAGE(PG8_SA(1, 1), a1 + hstepA, voffA);
            PG8_WAIT_V(8); PG8_WAIT_L(0); PG8_BAR; PG8_MMA(0, 0, At, B0); PG8_MMA(0, 1, At, B1); PG8_BAR; PG8_SCHED;
            PG8_LDA(At, 0, 1); PG8_STAGE(PG8_SB(0, 0), b2, voffB); PG8_STAGE(PG8_SB(0, 1), b2 + hstep, voffB); PG8_STAGE(PG8_SA(0, 0), a2, voffA);
            PG8_WAIT_V(8); PG8_WAIT_L(0); PG8_BAR; PG8_MMA(1, 0, At, B0); PG8_MMA(1, 1, At, B1); PG8_BAR; PG8_SCHED;
            PG8_LDB(B0, 1, 0); PG8_LDB(B1, 1, 1); PG8_SCHED; PG8_LDA(At, 1, 0); PG8_STAGE(PG8_SA(0, 1), a2 + hstepA, voffA);
            PG8_WAIT_V(8); PG8_WAIT_L(0); PG8_BAR; PG8_MMA(0, 0, At, B0); PG8_MMA(0, 1, At, B1); PG8_BAR; PG8_SCHED;
            PG8_LDA(At, 1, 1); PG8_STAGE(PG8_SB(1, 0), b3, voffB); PG8_STAGE(PG8_SB(1, 1), b3 + hstep, voffB); PG8_STAGE(PG8_SA(1, 0), a3, voffA);
            PG8_WAIT_V(8); PG8_WAIT_L(0); PG8_BAR; PG8_MMA(1, 0, At, B0); PG8_MMA(1, 1, At, B1); PG8_BAR; PG8_SCHED;
            } else {
            PG8_LDB(B0, 0, 0); PG8_SCHED; PG8_LDA(At, 0, 0); PG8_STAGE(PG8_SA(1, 1), a1 + hstep, voffA);
            PG8_WAIT_L(8); PG8_BAR; PG8_WAIT_L(0); PG8_MMA(0, 0, At, B0); PG8_BAR; PG8_SCHED;
            PG8_LDB(B1, 0, 1); PG8_STAGE(PG8_SB(0, 0), b2, voffB);
            PG8_BAR; PG8_WAIT_L(0); PG8_MMA(0, 1, At, B1); PG8_BAR;
            PG8_LDA(At, 0, 1); PG8_STAGE(PG8_SA(0, 0), a2, voffA);
            PG8_BAR; PG8_WAIT_L(0); PG8_MMA(1, 0, At, B0); PG8_BAR; PG8_SCHED;
            PG8_STAGE(PG8_SB(0, 1), b2 + hstep, voffB);
            PG8_WAIT_V(6); PG8_BAR; PG8_MMA(1, 1, At, B1); PG8_BAR;
            PG8_LDB(B0, 1, 0); PG8_SCHED; PG8_LDA(At, 1, 0); PG8_STAGE(PG8_SA(0, 1), a2 + hstep, voffA);
            PG8_WAIT_L(8); PG8_BAR; PG8_WAIT_L(0); PG8_MMA(0, 0, At, B0); PG8_BAR; PG8_SCHED;
            PG8_LDB(B1, 1, 1); PG8_STAGE(PG8_SB(1, 0), b3, voffB);
            PG8_BAR; PG8_WAIT_L(0); PG8_MMA(0, 1, At, B1); PG8_BAR;
            PG8_LDA(At, 1, 1); PG8_STAGE(PG8_SA(1, 0), a3, voffA);
            PG8_BAR; PG8_WAIT_L(0); PG8_MMA(1, 0, At, B0); PG8_BAR; PG8_SCHED;
            PG8_STAGE(PG8_SB(1, 1), b3 + hstep, voffB);
            PG8_WAIT_V(6); PG8_BAR; PG8_MMA(1, 1, At, B1); PG8_BAR;
            }
        }
        if constexpr (ALIGN_EPI) { if (wr == 0) PG8_BAR; }
        if constexpr (!Epi::AFTER_DRAIN) { const int t2_ = opaque_tid(wv_), l2_ = t2_ & 63, w2_ = __builtin_amdgcn_readfirstlane(t2_ >> 6); E(acc, cur, w2_ >> 2, w2_ & 3, l2_ & 15, l2_ >> 4); S.done(cur); }
        if (!has_next) break;
#pragma unroll
        for (int a = 0; a < 2; ++a)
#pragma unroll
            for (int b = 0; b < 2; ++b)
#pragma unroll
                for (int m = 0; m < 4; ++m)
#pragma unroll
                    for (int n = 0; n < 2; ++n) acc[a][b][m][n] = (f32x4){0.f, 0.f, 0.f, 0.f};
        cur = nxt; cA = nA; cB = nB; ++ui;
        if constexpr (ALIGN_EPI) { if (wr == 1) PG8_BAR; }
    }
    PG8_WAIT_V(0);
    if constexpr (!ALIGN_EPI) { if (wr == 0) PG8_BAR; }
    PG8_BAR;
    if constexpr (Epi::AFTER_DRAIN) { E.fused(acc, cur, wr, wc, fr, fq, lds, wid, lane); S.done(cur); }
#undef PG8_SA
#undef PG8_SB
#undef PG8_STAGE
#undef rvoffA
#undef rvoffB
#undef PG8_LDA
#undef PG8_LDB
#undef PG8_MMA
#undef PG8_WAIT_V
#undef PG8_WAIT_L
#undef PG8_BAR
#undef PG8_SCHED
#undef PG8_KA
}
}

__device__ __forceinline__ void wt_tile(const float* __restrict__ W, int N, bf16_t* __restrict__ Wt, int kt, int nt, unsigned char* lds, int wv_, const float* gk = nullptr) {
#ifdef OFF_wt_tile
  return;
#endif

  float* tl = (float*)lds;
  const int tid = opaque_tid(wv_);
  const int r = tid >> 3, c8 = (tid & 7) * 8;
  const float* src = W + (size_t)(kt * 64 + r) * N + nt * 64 + c8;
  float4 v0 = *(const float4*)src, v1 = *(const float4*)(src + 4);
  if (gk) { const float g_ = gk[kt * 64 + r]; v0.x *= g_; v0.y *= g_; v0.z *= g_; v0.w *= g_; v1.x *= g_; v1.y *= g_; v1.z *= g_; v1.w *= g_; }
  float* d = tl + r * 65 + c8;
  d[0] = v0.x; d[1] = v0.y; d[2] = v0.z; d[3] = v0.w; d[4] = v1.x; d[5] = v1.y; d[6] = v1.z; d[7] = v1.w;
  __syncthreads();
  uint4 o;
  o.x = pack2(tl[(c8 + 0) * 65 + r], tl[(c8 + 1) * 65 + r]);
  o.y = pack2(tl[(c8 + 2) * 65 + r], tl[(c8 + 3) * 65 + r]);
  o.z = pack2(tl[(c8 + 4) * 65 + r], tl[(c8 + 5) * 65 + r]);
  o.w = pack2(tl[(c8 + 6) * 65 + r], tl[(c8 + 7) * 65 + r]);
  *(uint4*)(Wt + (size_t)(nt * 64 + r) * 1024 + kt * 64 + c8) = o;
  __syncthreads();
}

__device__ __forceinline__ void norm_rows(const bool F32OUT, const float* src, const float* __restrict__ g, void* dst, int nrows, float pd, int wv_, float* ssq_out = nullptr) {
#ifdef OFF_norm_rows
  return;
#endif

  const int tid = opaque_tid(wv_);
  const int lane = tid & 63;
  const int gw = blockIdx.x * 8 + (tid >> 6), nw = gridDim.x * 8;
  float4 gv[4];
#pragma unroll
  for (int i = 0; i < 4; ++i) gv[i] = ssq_out ? make_float4(1.f, 1.f, 1.f, 1.f) : *(const float4*)(g + i * 256 + lane * 4);
  for (int row = gw; row < nrows; row += nw) {
    const float* s = src + (size_t)row * 1024;
    float4 v[4]; float ss = 0.f;
#pragma unroll
    for (int i = 0; i < 4; ++i) { v[i] = *(const float4*)(s + i * 256 + lane * 4); ss += v[i].x * v[i].x + v[i].y * v[i].y + v[i].z * v[i].z + v[i].w * v[i].w; }
    ss = wave_sum(ss, lane);
    if (ssq_out) { if (lane == 0) ssq_out[row] = ss; }
    const float rs = ssq_out ? 1.0f : rsqrtf(ss * (1.0f / 1024.0f) + 1e-6f);
#pragma unroll
    for (int i = 0; i < 4; ++i) {
      const float a = v[i].x * rs * gv[i].x, b = v[i].y * rs * gv[i].y, c = v[i].z * rs * gv[i].z, d = v[i].w * rs * gv[i].w;
      if (F32OUT) { *(float4*)((float*)dst + (size_t)row * 1024 + i * 256 + lane * 4) = make_float4(a + pd, b + pd, c + pd, d + pd); }
      else { uint2 o; o.x = pack2(a, b); o.y = pack2(c, d); *(uint2*)((bf16_t*)dst + (size_t)row * 1024 + i * 256 + lane * 4) = o; }
    }
  }
}

__device__ __forceinline__ void rwkv_prep_item(KP P, int l, int item, unsigned char* lds, int wv_) {
#ifdef OFF_rwkv_prep_item
  return;
#endif

  const bf16_t* p = (const bf16_t*)(P->ws + WS_P);
  float* PW = (float*)(P->ws + WS_PW); bf16_t* PV = (bf16_t*)(P->ws + WS_PV); float* RK = (float*)(P->ws + WS_RK);
  float* lora = (float*)lds;
  const int tid = opaque_tid(wv_), lane = tid & 63, w = tid >> 6, head = w & 3, sub = w >> 2;
  const int c = head * 64 + lane;
  const float* mu = P->in[4] + l * 832;
  const float mur = mu[c], muk = mu[256 + c], muv = mu[512 + c], mux = mu[768 + lane];
  const float w0 = P->in[5][l * 256 + c], a0 = P->in[7][l * 256 + c];
  const float kkw = P->in[9][l * 256 + c], kaw = P->in[10][l * 256 + c], rkw = P->in[11][l * 256 + c];
  float wup[32], aup[32];
#pragma unroll
  for (int j = 0; j < 32; ++j) { wup[j] = P->in[6][(l * 32 + j) * 256 + c]; aup[j] = P->in[8][(l * 32 + j) * 256 + c]; }
  bf16_t raw[4][8];
#define PREP_LOAD(g) { _Pragma("unroll") for (int j_ = 0; j_ < 4; ++j_) { const int t_ = item * 32 + sub + 2 * ((g) * 4 + j_); const bool hp_ = (t_ & (TSEQ - 1)) > 0; \
      const bf16_t* pr_ = p + (size_t)t_ * NIN; raw[j_][0] = pr_[c]; raw[j_][1] = pr_[256 + c]; raw[j_][2] = pr_[512 + c]; raw[j_][3] = pr_[768 + lane]; \
      raw[j_][4] = hp_ ? pr_[c - NIN] : (bf16_t)0; raw[j_][5] = hp_ ? pr_[256 + c - NIN] : (bf16_t)0; raw[j_][6] = hp_ ? pr_[512 + c - NIN] : (bf16_t)0; raw[j_][7] = hp_ ? pr_[768 + lane - NIN] : (bf16_t)0; } }
  PREP_LOAD(0);
#pragma unroll 1
  for (int g = 0; g < 4; ++g) {
    float rr[4], kk4[4], vv4[4];
#pragma unroll
    for (int j = 0; j < 4; ++j) {
      float r = bf2f(raw[j][0]), k = bf2f(raw[j][1]), v = bf2f(raw[j][2]), x = bf2f(raw[j][3]);
      r += (bf2f(raw[j][4]) - r) * mur; k += (bf2f(raw[j][5]) - k) * muk; v += (bf2f(raw[j][6]) - v) * muv; x += (bf2f(raw[j][7]) - x) * mux;
      rr[j] = r; kk4[j] = k; vv4[j] = v;
      lora[(w * 4 + j) * 64 + lane] = lane < 32 ? (1.0f - 2.0f * __builtin_amdgcn_rcpf(1.0f + __expf(2.0f * x))) : x;
    }
    if (g < 3) PREP_LOAD(g + 1);
    __builtin_amdgcn_s_waitcnt(0xc07f);
    __builtin_amdgcn_wave_barrier();
    float wv4[4], av4[4];
#pragma unroll
    for (int j = 0; j < 4; ++j) { wv4[j] = w0; av4[j] = a0; }
#pragma unroll
    for (int jj = 0; jj < 32; jj += 4) {
#pragma unroll
      for (int j = 0; j < 4; ++j) { const float* lo = lora + (w * 4 + j) * 64; const float4 lw = *(const float4*)(lo + jj), la = *(const float4*)(lo + 32 + jj);
        wv4[j] += lw.x * wup[jj]; wv4[j] += lw.y * wup[jj + 1]; wv4[j] += lw.z * wup[jj + 2]; wv4[j] += lw.w * wup[jj + 3];
        av4[j] += la.x * aup[jj]; av4[j] += la.y * aup[jj + 1]; av4[j] += la.z * aup[jj + 2]; av4[j] += la.w * aup[jj + 3]; }
    }
    float dec4[4], ar4[4], kkq[4], kmod4[4], n24[4], rk4[4];
#pragma unroll
    for (int j = 0; j < 4; ++j) {
      const float wlog = -softplus_fast(-wv4[j]) - 0.5f;
      dec4[j] = __expf(-__expf(wlog));
      ar4[j] = sigmoidf_(av4[j]);
      kkq[j] = kk4[j] * kkw;
      kmod4[j] = kk4[j] * (1.0f + (ar4[j] - 1.0f) * kaw);
      n24[j] = kkq[j] * kkq[j]; rk4[j] = rr[j] * kmod4[j] * rkw;
    }
#pragma unroll
    for (int st = 0; st < 4; ++st) {
      const int ctrl = st == 0 ? 0xB1 : st == 1 ? 0x4E : st == 2 ? 0x141 : 0x140;
#pragma unroll
      for (int j = 0; j < 4; ++j) {
        if (st == 0) { n24[j] += __builtin_bit_cast(float, __builtin_amdgcn_update_dpp(0, __builtin_bit_cast(int, n24[j]), 0xB1, 0xF, 0xF, true)); rk4[j] += __builtin_bit_cast(float, __builtin_amdgcn_update_dpp(0, __builtin_bit_cast(int, rk4[j]), 0xB1, 0xF, 0xF, true)); }
        else if (st == 1) { n24[j] += __builtin_bit_cast(float, __builtin_amdgcn_update_dpp(0, __builtin_bit_cast(int, n24[j]), 0x4E, 0xF, 0xF, true)); rk4[j] += __builtin_bit_cast(float, __builtin_amdgcn_update_dpp(0, __builtin_bit_cast(int, rk4[j]), 0x4E, 0xF, 0xF, true)); }
        else if (st == 2) { n24[j] += __builtin_bit_cast(float, __builtin_amdgcn_update_dpp(0, __builtin_bit_cast(int, n24[j]), 0x141, 0xF, 0xF, true)); rk4[j] += __builtin_bit_cast(float, __builtin_amdgcn_update_dpp(0, __builtin_bit_cast(int, rk4[j]), 0x141, 0xF, 0xF, true)); }
        else { n24[j] += __builtin_bit_cast(float, __builtin_amdgcn_update_dpp(0, __builtin_bit_cast(int, n24[j]), 0x140, 0xF, 0xF, true)); rk4[j] += __builtin_bit_cast(float, __builtin_amdgcn_update_dpp(0, __builtin_bit_cast(int, rk4[j]), 0x140, 0xF, 0xF, true)); }
      }
      (void)ctrl;
    }
    { float t0[4], t1[4];
#pragma unroll
      for (int j = 0; j < 4; ++j) { t0[j] = bperm(n24[j], lane ^ 16); t1[j] = bperm(rk4[j], lane ^ 16); }
#pragma unroll
      for (int j = 0; j < 4; ++j) { n24[j] += t0[j]; rk4[j] += t1[j]; }
#pragma unroll
      for (int j = 0; j < 4; ++j) { t0[j] = bperm(n24[j], lane ^ 32); t1[j] = bperm(rk4[j], lane ^ 32); }
#pragma unroll
      for (int j = 0; j < 4; ++j) { n24[j] += t0[j]; rk4[j] += t1[j]; } }
#pragma unroll
    for (int j = 0; j < 4; ++j) {
      const int t = item * 32 + sub + 2 * (g * 4 + j);
      const int tt = t & (TSEQ - 1), b = t >> 13;
      const float kkn = kkq[j] * __builtin_amdgcn_rsqf(fmaxf(n24[j], 1e-24f));
      const size_t idx = (size_t)(b * 4 + head) * TSEQ + tt;
      PW[idx * 64 + lane] = dec4[j];
      bf16_t* pv = PV + idx * 320;
      pv[lane] = f2bf(rr[j]); pv[64 + lane] = f2bf(kmod4[j]); pv[128 + lane] = f2bf(vv4[j]); pv[192 + lane] = f2bf(-kkn); pv[256 + lane] = f2bf(kkn * ar4[j]);
      if (lane == 0) RK[idx] = rk4[j];
    }
    __builtin_amdgcn_s_waitcnt(0xc07f);
    __builtin_amdgcn_wave_barrier();
  }
#undef PREP_LOAD
  __syncthreads();
}

#define RW_TILE_B (RW_TT * 1536)
struct RwRegs { float4 pw; uint4 pv0, pv1; };
__device__ __forceinline__ void rw_issue(const float* __restrict__ PW, const bf16_t* __restrict__ PV, size_t idx0, int tid, RwRegs& r) {
  if (tid < RW_TT * 16) { const int s = tid >> 4, q = tid & 15; r.pw = *(const float4*)(PW + (idx0 + s) * 64 + q * 4); }
  { const int c = tid; const int s = c / 40, q = c % 40; r.pv0 = *(const uint4*)(PV + (idx0 + s) * 320 + q * 8); }
  if (tid < RW_TT * 40 - NTHR) { const int c = tid + NTHR; const int s = c / 40, q = c % 40; r.pv1 = *(const uint4*)(PV + (idx0 + s) * 320 + q * 8); }
}
__device__ __forceinline__ void rw_put(float* dst, int c, const uint4 u) {
  const int s = c / 40, q = c % 40;
  const int vec = q >> 3, off = (q & 7) * 8;
  const int slot = vec == 0 ? 4 : vec == 1 ? 3 : vec == 2 ? 5 : vec == 3 ? 1 : 2;
  float* d = dst + s * 384 + slot * 64 + off;
  *(float4*)d = make_float4(__uint_as_float(u.x << 16), __uint_as_float(u.x & 0xffff0000u), __uint_as_float(u.y << 16), __uint_as_float(u.y & 0xffff0000u));
  *(float4*)(d + 4) = make_float4(__uint_as_float(u.z << 16), __uint_as_float(u.z & 0xffff0000u), __uint_as_float(u.w << 16), __uint_as_float(u.w & 0xffff0000u));
}
__device__ __forceinline__ void rw_commit(unsigned char* dstb, int tid, const RwRegs& r) {
  float* dst = (float*)dstb;
  if (tid < RW_TT * 16) { const int s = tid >> 4, q = tid & 15; *(float4*)(dst + s * 384 + q * 4) = r.pw; }
  rw_put(dst, tid, r.pv0);
  if (tid < RW_TT * 40 - NTHR) rw_put(dst, tid + NTHR, r.pv1);
}

#define LD8(dst, ptr) { const float4 x0_ = *(const float4*)(ptr), x1_ = *(const float4*)((ptr) + 4); dst[0] = (f32x2){x0_.x, x0_.y}; dst[1] = (f32x2){x0_.z, x0_.w}; dst[2] = (f32x2){x1_.x, x1_.y}; dst[3] = (f32x2){x1_.z, x1_.w}; }
struct RwOps { f32x2 w[4], a[4], b[4], k[4], r[4]; float vA, vB; };
template <int MODE>
__device__ __forceinline__ void rw_ldops(RwOps& o, const float* tb, int s, int q, int rowA, int rowB) {
  const float* sp = tb + s * 384 + q * 8;
  LD8(o.w, sp); LD8(o.a, sp + 64); LD8(o.b, sp + 128); LD8(o.k, sp + 192);
  o.vA = tb[s * 384 + 320 + rowA];
  if (MODE == 0) { LD8(o.r, sp + 256); o.vB = tb[s * 384 + 320 + rowB]; }
}
template <int MODE>
__device__ __forceinline__ void rw_step(const RwOps& o, f32x2 (&SA)[4], f32x2 (&SB)[4], float* yb, int s, int q, int rowA, int rowB) {
  f32x2 dA = SA[0] * o.a[0], dB = SB[0] * o.a[0];
#pragma unroll
  for (int e = 1; e < 4; ++e) { dA = SA[e] * o.a[e] + dA; dB = SB[e] * o.a[e] + dB; }
  const float dotA = red8(dA.x + dA.y), dotB = red8(dB.x + dB.y);
  const f32x2 dA2 = {dotA, dotA}, dB2 = {dotB, dotB}, vA2 = {o.vA, o.vA};
  if (MODE == 0) {
    const f32x2 vB2 = {o.vB, o.vB};
#pragma unroll
    for (int e = 0; e < 4; ++e) { SA[e] = SA[e] * o.w[e] + vA2 * o.k[e]; SA[e] = dA2 * o.b[e] + SA[e]; SB[e] = SB[e] * o.w[e] + vB2 * o.k[e]; SB[e] = dB2 * o.b[e] + SB[e]; }
    f32x2 yA = SA[0] * o.r[0], yB = SB[0] * o.r[0];
#pragma unroll
    for (int e = 1; e < 4; ++e) { yA = SA[e] * o.r[e] + yA; yB = SB[e] * o.r[e] + yB; }
    const float ya = red8(yA.x + yA.y), ybv = red8(yB.x + yB.y);
    if (q == 0) { yb[s * 64 + rowA] = ya; yb[s * 64 + rowB] = ybv; }
  } else {
#pragma unroll
    for (int e = 0; e < 4; ++e) { SA[e] = dA2 * o.b[e] + SA[e] * o.w[e]; SB[e] = SB[e] * o.w[e] + vA2 * o.k[e]; SB[e] = dB2 * o.b[e] + SB[e]; }
  }
}
template <int MODE>
__device__ __forceinline__ void rwkv_scan_item(KP P, int l, int bh, int chunk, unsigned char* lds, int wv_) {
  const float* PW = (const float*)(P->ws + WS_PW); const bf16_t* PV = (const bf16_t*)(P->ws + WS_PV); const float* RK = (const float*)(P->ws + WS_RK);
  float* PQ = (float*)(P->ws + WS_PQ);
  bf16_t* p = (bf16_t*)(P->ws + WS_P);
  const int tid = opaque_tid(wv_), lane = tid & 63, w = tid >> 6;
  const int q = lane & 7;
  const int rowA = (MODE == 0) ? ((w & 3) * 16 + (lane >> 3)) : (w * 8 + (lane >> 3));
  const int rowB = rowA + 8;
  const int b = bh >> 2, head = bh & 3;
  unsigned char* tile0 = lds;
  float* ybuf = (float*)(lds + 3 * RW_TILE_B);
  float* Sl = (float*)(lds + 3 * RW_TILE_B + 2 * RW_TT * 256);
  f32x2 SA[4], SB[4];
#pragma unroll
  for (int e = 0; e < 4; ++e) { SA[e] = (f32x2){0.f, 0.f}; SB[e] = (f32x2){0.f, 0.f}; }
  if (MODE == 1) {
#pragma unroll
    for (int e = 0; e < 4; ++e) SA[e] = (f32x2){(q * 8 + 2 * e == rowA) ? 1.f : 0.f, (q * 8 + 2 * e + 1 == rowA) ? 1.f : 0.f};
  }
  if (MODE == 0 && chunk > 0) {
    const float* Q0 = PQ + ((size_t)(bh * RW_C + 0) * 2 + 1) * 4096;
    float* cur = Sl; float* nxt = Sl + 64 * 65;
    for (int i = tid; i < 1024; i += NTHR) { const float4 v_ = *(const float4*)(Q0 + i * 4); float* d_ = cur + (i >> 4) * 65 + (i & 15) * 4; d_[0] = v_.x; d_[1] = v_.y; d_[2] = v_.z; d_[3] = v_.w; }
    float* Pl = (float*)lds;
    const float4 z4_ = make_float4(0.f, 0.f, 0.f, 0.f); const f32x4 zq_ = {0.f, 0.f, 0.f, 0.f};
    float4 cs0p0 = z4_, cs0p1 = z4_, cs1p0 = z4_, cs1p1 = z4_, cs2p0 = z4_, cs2p1 = z4_, cs3p0 = z4_, cs3p1 = z4_;
    f32x4 cs0q0 = zq_, cs0q1 = zq_, cs1q0 = zq_, cs1q1 = zq_, cs2q0 = zq_, cs2q1 = zq_, cs3q0 = zq_, cs3q1 = zq_;
    const int ti = w >> 1;
    const int qoff0 = 4096 + (ti * 16 + (lane >> 4) * 4) * 64 + ((w & 1) * 2 + 0) * 16 + (lane & 15);
#define CS_LOAD(S_, c_) { const float* Pm_ = PQ + ((size_t)(bh * RW_C + (c_)) * 2 + 0) * 4096; S_##p0 = *(const float4*)(Pm_ + tid * 4); S_##p1 = *(const float4*)(Pm_ + (tid + NTHR) * 4); \
      S_##q0 = (f32x4){Pm_[qoff0], Pm_[qoff0 + 64], Pm_[qoff0 + 128], Pm_[qoff0 + 192]}; S_##q1 = (f32x4){Pm_[qoff0 + 16], Pm_[qoff0 + 80], Pm_[qoff0 + 144], Pm_[qoff0 + 208]}; }
#define CS_STEP(S_, c_) { LBAR(); *(float4*)(Pl + (tid >> 4) * 80 + (tid & 15) * 4) = S_##p0; *(float4*)(Pl + ((tid + NTHR) >> 4) * 80 + (tid & 15) * 4) = S_##p1; const f32x4 qc0 = S_##q0, qc1 = S_##q1; \
      if ((c_) + 4 < chunk) CS_LOAD(S_, (c_) + 4); \
      LBAR(); \
      _Pragma("unroll") for (int jj = 0; jj < 2; ++jj) { const int tj = (w & 1) * 2 + jj; f32x4 acc = jj == 0 ? qc0 : qc1; \
        _Pragma("unroll") for (int ks = 0; ks < 16; ++ks) { const float a = cur[(ti * 16 + (lane & 15)) * 65 + ks * 4 + (lane >> 4)]; const float bb = Pl[(ks * 4 + (lane >> 4)) * 80 + tj * 16 + (lane & 15)]; \
          acc = __builtin_amdgcn_mfma_f32_16x16x4f32(a, bb, acc, 0, 0, 0); } \
        _Pragma("unroll") for (int r = 0; r < 4; ++r) nxt[(ti * 16 + (lane >> 4) * 4 + r) * 65 + tj * 16 + (lane & 15)] = acc[r]; } \
      float* t_ = cur; cur = nxt; nxt = t_; }
    if (1 < chunk) CS_LOAD(cs0, 1);
    if (2 < chunk) CS_LOAD(cs1, 2);
    if (3 < chunk) CS_LOAD(cs2, 3);
    if (4 < chunk) CS_LOAD(cs3, 4);
#pragma unroll 1
    for (int cc = 1; cc < chunk; cc += 4) {
      CS_STEP(cs0, cc);
      if (cc + 1 < chunk) CS_STEP(cs1, cc + 1);
      if (cc + 2 < chunk) CS_STEP(cs2, cc + 2);
      if (cc + 3 < chunk) CS_STEP(cs3, cc + 3);
    }
#undef CS_LOAD
#undef CS_STEP
    __syncthreads();
#pragma unroll
    for (int e = 0; e < 4; ++e) { SA[e] = (f32x2){cur[rowA * 65 + q * 8 + 2 * e], cur[rowA * 65 + q * 8 + 2 * e + 1]}; SB[e] = (f32x2){cur[rowB * 65 + q * 8 + 2 * e], cur[rowB * 65 + q * 8 + 2 * e + 1]}; }
    __syncthreads();
  }
  const size_t idxb = (size_t)bh * TSEQ + (size_t)chunk * RW_CL;
  const int ntile = RW_CL / RW_TT;
  RwRegs rr;
  rw_issue(PW, PV, idxb, tid, rr);
  rw_commit(tile0, tid, rr);
  const int chh = head * 64 + lane;
  const float lng = P->in[12][l * 256 + chh], lnb = P->in[13][l * 256 + chh];
  __syncthreads();
  const int nit = (MODE == 0) ? ntile + 1 : ntile;
  for (int tl = 0; tl < nit; ++tl) {
    if (tl + 1 < ntile) rw_issue(PW, PV, idxb + (size_t)(tl + 1) * RW_TT, tid, rr);
    if (MODE == 1 || w < 4) {
      if (tl < ntile) {
        const float* tb = (const float*)(tile0 + (tl % 3) * RW_TILE_B);
        float* yb = ybuf + (tl & 1) * (RW_TT * 64);
        RwOps oa, ob;
        rw_ldops<MODE>(oa, tb, 0, q, rowA, rowB);
        __builtin_amdgcn_sched_barrier(0);
#pragma unroll 1
        for (int s = 0; s < RW_TT; s += 2) {
          rw_ldops<MODE>(ob, tb, s + 1, q, rowA, rowB);
          __builtin_amdgcn_sched_barrier(0);
          rw_step<MODE>(oa, SA, SB, yb, s, q, rowA, rowB);
          __builtin_amdgcn_sched_barrier(0);
          if (s + 2 < RW_TT) rw_ldops<MODE>(oa, tb, s + 2, q, rowA, rowB);
          __builtin_amdgcn_sched_barrier(0);
          rw_step<MODE>(ob, SA, SB, yb, s + 1, q, rowA, rowB);
          __builtin_amdgcn_sched_barrier(0);
        }
      }
      if (tl + 1 < ntile) rw_commit(tile0 + ((tl + 1) % 3) * RW_TILE_B, tid, rr);
    } else {
      const int fw = w - 4;
      f32x4 gcu = {0.f, 0.f, 0.f, 0.f}, rkcu = {0.f, 0.f, 0.f, 0.f};
      if (tl > 0) {
#pragma unroll
        for (int u = 0; u < 4; ++u) { const int tt = chunk * RW_CL + (tl - 1) * RW_TT + fw + 4 * u;
          gcu[u] = bf2f(p[(size_t)(b * TSEQ + tt) * NIN + C_GA + chh]); rkcu[u] = RK[(size_t)bh * TSEQ + tt]; }
      }
      asm volatile("s_waitcnt vmcnt(0)" ::: "memory");
      if (tl + 1 < ntile) rw_commit(tile0 + ((tl + 1) % 3) * RW_TILE_B, tid, rr);
      __builtin_amdgcn_sched_barrier(0);
      if (tl > 0) {
        const float* tb = (const float*)(tile0 + ((tl - 1) % 3) * RW_TILE_B);
        const float* yb = ybuf + ((tl - 1) & 1) * (RW_TT * 64);
#pragma unroll
        for (int u = 0; u < 4; ++u) {
          const int s = fw + 4 * u;
          const int tt = chunk * RW_CL + (tl - 1) * RW_TT + s;
          const float y = yb[s * 64 + lane];
          const float mean = wave_sum(y, lane) * (1.0f / 64.0f);
          const float dlt = y - mean;
          const float var = wave_sum(dlt * dlt, lane) * (1.0f / 64.0f);
          float o = dlt * rsqrtf(var + 64e-5f) * lng + lnb;
          const float vv = tb[s * 384 + 320 + lane];
          o += rkcu[u] * vv;
          p[(size_t)(b * TSEQ + tt) * NIN + C_GA + chh] = f2bf(o * siluf_(gcu[u]));
        }
      }
    }
    LBAR();
  }
  if (MODE == 1) {
    float* Pm = PQ + ((size_t)(bh * RW_C + chunk) * 2 + 0) * 4096 + rowA * 64 + q * 8;
    *(float4*)Pm = make_float4(SA[0].x, SA[0].y, SA[1].x, SA[1].y); *(float4*)(Pm + 4) = make_float4(SA[2].x, SA[2].y, SA[3].x, SA[3].y);
    *(float4*)(Pm + 4096) = make_float4(SB[0].x, SB[0].y, SB[1].x, SB[1].y); *(float4*)(Pm + 4100) = make_float4(SB[2].x, SB[2].y, SB[3].x, SB[3].y);
  } else if (chunk == 0 && w < 4) {
    float* Qm = PQ + ((size_t)(bh * RW_C + 0) * 2 + 1) * 4096 + q * 8;
    *(float4*)(Qm + rowA * 64) = make_float4(SA[0].x, SA[0].y, SA[1].x, SA[1].y); *(float4*)(Qm + rowA * 64 + 4) = make_float4(SA[2].x, SA[2].y, SA[3].x, SA[3].y);
    *(float4*)(Qm + rowB * 64) = make_float4(SB[0].x, SB[0].y, SB[1].x, SB[1].y); *(float4*)(Qm + rowB * 64 + 4) = make_float4(SB[2].x, SB[2].y, SB[3].x, SB[3].y);
  }
  __syncthreads();
}

__device__ __forceinline__ void conv_item(KP P, int l, int item, unsigned char* lds, int wv_) {
#ifdef OFF_conv_item
  return;
#endif

  bf16_t* p = (bf16_t*)(P->ws + WS_P);
  float* u = (float*)lds;
  float* yb = (float*)(lds + 62 * 1024);
  const int tid = opaque_tid(wv_), c = tid & 255, half = tid >> 8;
  const int t0 = item * 32, tt0 = t0 & (TSEQ - 1);
  {
    bf16_t rv[31], rg[31];
#pragma unroll
    for (int i = 0; i < 31; ++i) { const int r = half + 2 * i; const bool ok = (tt0 - 30 + r) >= 0; const bf16_t* pr = p + (size_t)(t0 - 30 + r) * NIN;
      rv[i] = ok ? pr[C_CVAL + c] : (bf16_t)0; rg[i] = ok ? pr[C_CGLU + c] : (bf16_t)0; }
#pragma unroll
    for (int i = 0; i < 31; ++i) u[(half + 2 * i) * 256 + c] = bf2f(rv[i]) * sigmoidf_(bf2f(rg[i]));
  }
  float wv[31];
#pragma unroll
  for (int j = 0; j < 31; ++j) wv[j] = P->in[14][(l * 31 + j) * 256 + c];
  const float bias = P->in[15][l * 256 + c];
  __syncthreads();
  {
    float win[46];
#pragma unroll
    for (int i = 0; i < 46; ++i) win[i] = u[(half * 16 + i) * 256 + c];
#pragma unroll
    for (int i = 0; i < 16; ++i) {
      float acc = bias;
#pragma unroll
      for (int j = 0; j < 31; ++j) acc = fmaf(wv[j], win[i + j], acc);
      yb[(half * 16 + i) * 256 + c] = acc;
    }
  }
  __syncthreads();
  const int lane = tid & 63, w = tid >> 6;
  const float4 g = *(const float4*)(P->in[16] + l * 256 + lane * 4), bb = *(const float4*)(P->in[17] + l * 256 + lane * 4);
  uint2 gpre[4];
#pragma unroll
  for (int i = 0; i < 4; ++i) gpre[i] = *(const uint2*)(p + (size_t)(t0 + w * 4 + i) * NIN + C_CGATE + lane * 4);
#pragma unroll
  for (int i = 0; i < 4; ++i) {
    const int tk = w * 4 + i;
    const float4 v = *(const float4*)(yb + tk * 256 + lane * 4);
    const float mean = wave_sum(v.x + v.y + v.z + v.w, lane) * (1.0f / 256.0f);
    const float d0 = v.x - mean, d1 = v.y - mean, d2 = v.z - mean, d3 = v.w - mean;
    const float var = wave_sum(d0 * d0 + d1 * d1 + d2 * d2 + d3 * d3, lane) * (1.0f / 256.0f);
    const float rs = rsqrtf(var + 1e-5f);
    bf16_t* gp = p + (size_t)(t0 + tk) * NIN + C_CGATE + lane * 4;
    const uint2 gu = gpre[i];
    const float o0 = siluf_(d0 * rs * g.x + bb.x) * siluf_(__uint_as_float(gu.x << 16));
    const float o1 = siluf_(d1 * rs * g.y + bb.y) * siluf_(__uint_as_float(gu.x & 0xffff0000u));
    const float o2 = siluf_(d2 * rs * g.z + bb.z) * siluf_(__uint_as_float(gu.y << 16));
    const float o3 = siluf_(d3 * rs * g.w + bb.w) * siluf_(__uint_as_float(gu.y & 0xffff0000u));
    uint2 o; o.x = pack2(o0, o1); o.y = pack2(o2, o3);
    *(uint2*)gp = o;
  }
  __syncthreads();
}

#define HG_WLDS 10240
__device__ __forceinline__ float hgrn_lb(KP P, int l, int ch) {
  if (l == 0) return 0.f;
  const float x0 = P->in[18][ch], x1 = P->in[18][256 + ch];
  return __builtin_amdgcn_rcpf(1.0f + __expf(x0 - x1));
}
template <int PASS>
__device__ __forceinline__ void hgrn_wave_item(KP P, int l, int wi, unsigned char* lds, int wv_) {
#ifdef OFF_hgrn_wave_item
  return;
#endif

  bf16_t* p = (bf16_t*)(P->ws + WS_P);
  float* HS = (float*)(P->ws + WS_HS); float* HF = (float*)(P->ws + WS_HF);
  const int tid = opaque_tid(wv_);
  const int lane = tid & 63, w = tid >> 6;
  const int bh = wi >> 7, chunk = wi & 127, b = bh >> 2, head = bh & 3;
  float* st = (float*)(lds + w * HG_WLDS);
  float* ob = st + 2048;
  const int kg = lane & 7, vg = lane >> 3;
  const int ch = head * 64 + lane;
  const float lb = hgrn_lb(P, l, ch);
  const float ng = P->in[19][l * 256 + ch];
  float S[8][8];
  float* slot = HS + (size_t)(bh * 128 + chunk) * 4096;
  if (PASS == 1) {
#pragma unroll
    for (int i = 0; i < 8; ++i) { const float4 x0 = *(const float4*)(slot + (kg * 8 + i) * 64 + vg * 8), x1 = *(const float4*)(slot + (kg * 8 + i) * 64 + vg * 8 + 4);
      S[i][0] = x0.x; S[i][1] = x0.y; S[i][2] = x0.z; S[i][3] = x0.w; S[i][4] = x1.x; S[i][5] = x1.y; S[i][6] = x1.z; S[i][7] = x1.w; }
  } else {
#pragma unroll
    for (int i = 0; i < 8; ++i)
#pragma unroll
      for (int j = 0; j < 8; ++j) S[i][j] = 0.f;
  }
  float Fp = 1.f;
  bf16_t rf[8], ri[8], rq[8], rg[8];
  {
    const int tb0 = b * TSEQ + chunk * 64;
#pragma unroll
    for (int s = 0; s < 8; ++s) { const bf16_t* pr = p + (size_t)(tb0 + s) * NIN; rf[s] = pr[C_HF + ch]; ri[s] = pr[C_HI + ch]; if (PASS == 1) { rq[s] = pr[C_HQ + ch]; rg[s] = pr[C_HG + ch]; } }
  }
#pragma unroll 1
  for (int sub = 0; sub < 8; ++sub) {
    const int tbase = b * TSEQ + chunk * 64 + sub * 8;
    bf16_t gc[8];
#pragma unroll
    for (int s = 0; s < 8; ++s) {
      const float f = lb + (1.0f - lb) * sigmoidf_(bf2f(rf[s]));
      Fp *= f;
      st[s * 256 + lane] = f; st[s * 256 + 64 + lane] = 1.0f - f;
      if (PASS == 1) { st[s * 256 + 128 + lane] = siluf_(bf2f(rq[s])); gc[s] = rg[s]; }
      st[s * 256 + 192 + lane] = bf2f(ri[s]);
    }
    if (sub < 7) {
#pragma unroll
      for (int s = 0; s < 8; ++s) { const bf16_t* pr = p + (size_t)(tbase + 8 + s) * NIN; rf[s] = pr[C_HF + ch]; ri[s] = pr[C_HI + ch]; if (PASS == 1) { rq[s] = pr[C_HQ + ch]; rg[s] = pr[C_HG + ch]; } }
    }
    __builtin_amdgcn_s_waitcnt(0xc07f);
    __builtin_amdgcn_wave_barrier();
#pragma unroll 1
    for (int s = 0; s < 8; ++s) {
      const float* sp = st + s * 256;
      const float4 f0 = *(const float4*)(sp + kg * 8), f1 = *(const float4*)(sp + kg * 8 + 4);
      const float4 k0 = *(const float4*)(sp + 64 + kg * 8), k1 = *(const float4*)(sp + 64 + kg * 8 + 4);
      const float4 v0 = *(const float4*)(sp + 192 + vg * 8), v1 = *(const float4*)(sp + 192 + vg * 8 + 4);
      const float fv[8] = {f0.x, f0.y, f0.z, f0.w, f1.x, f1.y, f1.z, f1.w};
      const float kv[8] = {k0.x, k0.y, k0.z, k0.w, k1.x, k1.y, k1.z, k1.w};
      const float vv[8] = {v0.x, v0.y, v0.z, v0.w, v1.x, v1.y, v1.z, v1.w};
#pragma unroll
      for (int i = 0; i < 8; ++i)
#pragma unroll
        for (int j = 0; j < 8; ++j) S[i][j] = fmaf(fv[i], S[i][j], kv[i] * vv[j]);
      if (PASS == 1) {
        const float4 q0 = *(const float4*)(sp + 128 + kg * 8), q1 = *(const float4*)(sp + 128 + kg * 8 + 4);
        const float qv[8] = {q0.x, q0.y, q0.z, q0.w, q1.x, q1.y, q1.z, q1.w};
        float o[8];
#pragma unroll
        for (int j = 0; j < 8; ++j) { float a = qv[0] * S[0][j];
#pragma unroll
          for (int i = 1; i < 8; ++i) a = fmaf(qv[i], S[i][j], a);
          o[j] = red8(a); }
        if (kg == 0) { *(float4*)(ob + s * 64 + vg * 8) = make_float4(o[0], o[1], o[2], o[3]); *(float4*)(ob + s * 64 + vg * 8 + 4) = make_float4(o[4], o[5], o[6], o[7]); }
      }
    }
    __builtin_amdgcn_s_waitcnt(0xc07f);
    __builtin_amdgcn_wave_barrier();
    if (PASS == 1) {
#pragma unroll
      for (int s = 0; s < 8; ++s) {
        const float o = ob[s * 64 + lane];
        const float ms = wave_sum(o * o, lane) * (1.0f / 64.0f);
        p[(size_t)(tbase + s) * NIN + C_HG + ch] = f2bf(o * rsqrtf(ms + 1e-6f) * ng * siluf_(bf2f(gc[s])));
      }
      __builtin_amdgcn_s_waitcnt(0xc07f);
      __builtin_amdgcn_wave_barrier();
    }
  }
  if (PASS == 0) {
#pragma unroll
    for (int i = 0; i < 8; ++i) { *(float4*)(slot + (kg * 8 + i) * 64 + vg * 8) = make_float4(S[i][0], S[i][1], S[i][2], S[i][3]);
      *(float4*)(slot + (kg * 8 + i) * 64 + vg * 8 + 4) = make_float4(S[i][4], S[i][5], S[i][6], S[i][7]); }
    HF[(size_t)(bh * 128 + chunk) * 64 + lane] = Fp;
  }
}
__device__ __forceinline__ void hgrn_combine_item(KP P, int bh, int wv_) {
#ifdef OFF_hgrn_combine_item
  return;
#endif

  float* HS = (float*)(P->ws + WS_HS); const float* HF = (const float*)(P->ws + WS_HF);
  const int tid = opaque_tid(wv_);
  const int krow = tid >> 3;
  float R[8];
#pragma unroll
  for (int e = 0; e < 8; ++e) R[e] = 0.f;
  float4 xa[8][2]; float fa[8];
#pragma unroll
  for (int u = 0; u < 8; ++u) { const float* sl = HS + (size_t)(bh * 128 + u) * 4096 + tid * 8; xa[u][0] = *(const float4*)sl; xa[u][1] = *(const float4*)(sl + 4); fa[u] = HF[(size_t)(bh * 128 + u) * 64 + krow]; }
#pragma unroll 1
  for (int c0 = 0; c0 < 128; c0 += 8) {
    float4 xn[8][2]; float fn[8];
    if (c0 + 8 < 128) {
#pragma unroll
      for (int u = 0; u < 8; ++u) { const float* sl = HS + (size_t)(bh * 128 + c0 + 8 + u) * 4096 + tid * 8; xn[u][0] = *(const float4*)sl; xn[u][1] = *(const float4*)(sl + 4); fn[u] = HF[(size_t)(bh * 128 + c0 + 8 + u) * 64 + krow]; }
    }
#pragma unroll
    for (int u = 0; u < 8; ++u) {
      float* sl = HS + (size_t)(bh * 128 + c0 + u) * 4096 + tid * 8;
      *(float4*)sl = make_float4(R[0], R[1], R[2], R[3]); *(float4*)(sl + 4) = make_float4(R[4], R[5], R[6], R[7]);
      const float f = fa[u];
      R[0] = fmaf(f, R[0], xa[u][0].x); R[1] = fmaf(f, R[1], xa[u][0].y); R[2] = fmaf(f, R[2], xa[u][0].z); R[3] = fmaf(f, R[3], xa[u][0].w);
      R[4] = fmaf(f, R[4], xa[u][1].x); R[5] = fmaf(f, R[5], xa[u][1].y); R[6] = fmaf(f, R[6], xa[u][1].z); R[7] = fmaf(f, R[7], xa[u][1].w);
    }
    if (c0 + 8 < 128) {
#pragma unroll
      for (int u = 0; u < 8; ++u) { xa[u][0] = xn[u][0]; xa[u][1] = xn[u][1]; fa[u] = fn[u]; }
    }
  }
}

__device__ __forceinline__ void sb_item(KP P, int item, unsigned char* lds, int wv_) {
#ifdef OFF_sb_item
  return;
#endif

  bf16_t* p = (bf16_t*)(P->ws + WS_P);
  const int tid = opaque_tid(wv_), lane = tid & 63, w = tid >> 6;
  const int qt = item & 127, bh = item >> 7, b = bh >> 2, head = bh & 3;
  unsigned char* Qs = lds;
  unsigned char* Ks = lds + 9216;
  unsigned char* Vt = lds + 18432;
  unsigned char* As = lds + 27648;
  float* Zs = (float*)(lds + 36864);
  volatile int* flag = (volatile int*)(lds + 36864 + 64 * 65 * 4);
  const int lrow = tid >> 3, lch = (tid & 7);
  const size_t tokq = (size_t)b * TSEQ + qt * 64;
  *(uint4*)(Qs + lrow * 144 + lch * 16) = *(const uint4*)(p + (tokq + lrow) * NIN + C_SQ + head * 64 + lch * 8);
  float carry = 0.f;
  f32x4 oacc[2] = {{0.f, 0.f, 0.f, 0.f}, {0.f, 0.f, 0.f, 0.f}};
  const int qi = w >> 1, t2 = (w & 1) * 2;
  const int q = tid >> 3, seg = tid & 7;
  uint4 kreg = *(const uint4*)(p + (tokq + lrow) * NIN + C_SK + head * 64 + lch * 8);
  const int vkey = tid & 63, vch = tid >> 6;
  uint4 vreg = *(const uint4*)(p + (tokq + vkey) * NIN + C_SV + head * 64 + vch * 8);
  for (int kt = qt; kt >= 0; --kt) {
    LBAR();
    *(uint4*)(Ks + lrow * 144 + lch * 16) = kreg;
    { const unsigned vw[4] = {vreg.x, vreg.y, vreg.z, vreg.w};
#pragma unroll
      for (int e = 0; e < 8; ++e) *(unsigned short*)(Vt + (vch * 8 + e) * 144 + vkey * 2) = (unsigned short)((e & 1) ? (vw[e >> 1] >> 16) : (vw[e >> 1] & 0xffffu)); }
    if (tid == 0) *flag = 0;
    if (kt > 0) { const size_t tokn = (size_t)b * TSEQ + (kt - 1) * 64;
      kreg = *(const uint4*)(p + (tokn + lrow) * NIN + C_SK + head * 64 + lch * 8);
      vreg = *(const uint4*)(p + (tokn + vkey) * NIN + C_SV + head * 64 + vch * 8); }
    LBAR();
#pragma unroll
    for (int jj = 0; jj < 2; ++jj) {
      const int ki = t2 + jj;
      f32x4 acc = {0.f, 0.f, 0.f, 0.f};
#pragma unroll
      for (int s = 0; s < 2; ++s) {
        const bf16x8 a = *(const bf16x8*)(Qs + (qi * 16 + (lane & 15)) * 144 + s * 64 + (lane >> 4) * 16);
        const bf16x8 bb = *(const bf16x8*)(Ks + (ki * 16 + (lane & 15)) * 144 + s * 64 + (lane >> 4) * 16);
        acc = __builtin_amdgcn_mfma_f32_16x16x32_bf16(a, bb, acc, 0, 0, 0);
      }
#pragma unroll
      for (int r = 0; r < 4; ++r) Zs[(qi * 16 + (lane >> 4) * 4 + r) * 65 + ki * 16 + (lane & 15)] = acc[r] * 0.125f;
    }
    LBAR();
    {
      const int tq = qt * 64 + q;
      float z[8], lk[8];
      float tot = 0.f;
#pragma unroll
      for (int e = 0; e < 8; ++e) {
        z[e] = Zs[q * 65 + seg * 8 + e];
        const bool m = (kt * 64 + seg * 8 + e) < tq;
        lk[e] = m ? -softplus_fast(z[e]) : 0.f;
        tot += lk[e];
      }
      float inc = tot;
      { float t_ = bperm(inc, lane + 1); if (seg + 1 < 8) inc += t_; }
      { float t_ = bperm(inc, lane + 2); if (seg + 2 < 8) inc += t_; }
      { float t_ = bperm(inc, lane + 4); if (seg + 4 < 8) inc += t_; }
      const float rowtot = bperm(inc, lane & ~7);
      float tail = carry + (inc - tot);
      float av[8];
#pragma unroll
      for (int e = 7; e >= 0; --e) {
        const bool m = (kt * 64 + seg * 8 + e) < tq;
        av[e] = m ? __expf(z[e] + lk[e] + tail) : 0.f;
        tail += lk[e];
      }
      uint4 o; o.x = pack2(av[0], av[1]); o.y = pack2(av[2], av[3]); o.z = pack2(av[4], av[5]); o.w = pack2(av[6], av[7]);
      *(uint4*)(As + q * 144 + seg * 16) = o;
      carry += rowtot;
      if (carry > -100.f) *flag = 1;
    }
    LBAR();
#pragma unroll
    for (int jj = 0; jj < 2; ++jj) {
      const int di = t2 + jj;
#pragma unroll
      for (int s = 0; s < 2; ++s) {
        const bf16x8 a = *(const bf16x8*)(As + (qi * 16 + (lane & 15)) * 144 + s * 64 + (lane >> 4) * 16);
        const bf16x8 bb = *(const bf16x8*)(Vt + (di * 16 + (lane & 15)) * 144 + s * 64 + (lane >> 4) * 16);
        oacc[jj] = __builtin_amdgcn_mfma_f32_16x16x32_bf16(a, bb, oacc[jj], 0, 0, 0);
      }
    }
    if (*flag == 0) break;
  }
#pragma unroll
  for (int jj = 0; jj < 2; ++jj) {
    const int d = (t2 + jj) * 16 + (lane & 15);
#pragma unroll
    for (int r = 0; r < 4; ++r) {
      const int qq = qi * 16 + (lane >> 4) * 4 + r;
      bf16_t* gp = p + (tokq + qq) * NIN + C_SG + head * 64 + d;
      *gp = f2bf(oacc[jj][r] * siluf_(bf2f(*gp)));
    }
  }
  __syncthreads();
}

__device__ __forceinline__ void xattn_item(KP P, int l, int item, unsigned char* lds, int wv_) {
  const bf16_t* qb = (const bf16_t*)(P->ws + WS_P + 32ull * MiB);
  bf16_t* ob = (bf16_t*)(P->ws + WS_P + 64ull * MiB);
  const bf16_t* kv = (const bf16_t*)(P->ws + WS_KV) + (size_t)l * 512 * 2048;
  const bf16_t* vt = (const bf16_t*)(P->ws + WS_VT) + (size_t)l * 2 * 1024 * 256;
  const int tid = opaque_tid(wv_), lane = tid & 63, w = tid >> 6;
  const int qt = item & 127, bh = item >> 7, b = bh >> 2, head = bh & 3;
  unsigned char* Qs = lds;
  unsigned char* KVs = lds + 33792;
  float* Ss = (float*)(lds + 67584);
  const size_t tok0 = (size_t)b * TSEQ + qt * 64;
  const int pr = tid >> 5, pc = tid & 31;
  uint4 pg0, pg1, pg2, pg3;
#define XA_LOAD(p_) { const bf16_t* s_ = (p_) < 4 ? kv + (size_t)(b * 256 + (p_) * 64 + pr) * 2048 + head * 256 + pc * 8 : vt + (size_t)(b * 1024 + head * 256 + ((p_) - 4) * 64 + pr) * 256 + pc * 8; \
      const size_t st_ = (p_) < 4 ? (size_t)16 * 2048 : (size_t)16 * 256; \
      pg0 = *(const uint4*)(s_); pg1 = *(const uint4*)(s_ + st_); pg2 = *(const uint4*)(s_ + 2 * st_); pg3 = *(const uint4*)(s_ + 3 * st_); }
  __syncthreads();
#pragma unroll
  for (int i = 0; i < 4; ++i) { const int r = pr + 16 * i; *(uint4*)(Qs + r * 528 + pc * 16) = *(const uint4*)(qb + (tok0 + r) * 1024 + head * 256 + pc * 8); }
  XA_LOAD(0);
  const int qi = w >> 1, t2 = (w & 1) * 2;
#pragma unroll 1
  for (int p = 0; p < 8; ++p) {
    LBAR();
    { unsigned char* d_ = KVs + pr * 528 + pc * 16; *(uint4*)d_ = pg0; *(uint4*)(d_ + 16 * 528) = pg1; *(uint4*)(d_ + 32 * 528) = pg2; *(uint4*)(d_ + 48 * 528) = pg3; }
    if (p < 7) XA_LOAD(p + 1);
    LBAR();
    f32x4 acc0 = {0.f, 0.f, 0.f, 0.f}, acc1 = {0.f, 0.f, 0.f, 0.f};
#pragma unroll
    for (int s = 0; s < 8; ++s) {
      const bf16x8 a = *(const bf16x8*)(Qs + (qi * 16 + (lane & 15)) * 528 + s * 64 + (lane >> 4) * 16);
      const bf16x8 b0 = *(const bf16x8*)(KVs + (t2 * 16 + (lane & 15)) * 528 + s * 64 + (lane >> 4) * 16);
      const bf16x8 b1 = *(const bf16x8*)(KVs + ((t2 + 1) * 16 + (lane & 15)) * 528 + s * 64 + (lane >> 4) * 16);
      acc0 = __builtin_amdgcn_mfma_f32_16x16x32_bf16(a, b0, acc0, 0, 0, 0);
      acc1 = __builtin_amdgcn_mfma_f32_16x16x32_bf16(a, b1, acc1, 0, 0, 0);
    }
    if (p < 4) {
#pragma unroll
      for (int r = 0; r < 4; ++r) { float* d_ = Ss + (qi * 16 + (lane >> 4) * 4 + r) * 260 + p * 64 + t2 * 16 + (lane & 15); d_[0] = acc0[r] * 0.0625f; d_[16] = acc1[r] * 0.0625f; }
      if (p == 3) {
        LBAR();
        const int q = tid >> 3, seg = tid & 7;
        float x[32]; float mx = -3.0e38f;
#pragma unroll
        for (int i = 0; i < 8; ++i) { const float4 v = *(const float4*)(Ss + q * 260 + seg * 32 + i * 4); x[i * 4] = v.x; x[i * 4 + 1] = v.y; x[i * 4 + 2] = v.z; x[i * 4 + 3] = v.w;
          mx = fmaxf(mx, fmaxf(fmaxf(v.x, v.y), fmaxf(v.z, v.w))); }
        mx = max8(mx);
        float sum = 0.f;
#pragma unroll
        for (int i = 0; i < 32; ++i) { x[i] = __expf(x[i] - mx); sum += x[i]; }
        sum = red8(sum);
        const float inv = __builtin_amdgcn_rcpf(sum);
#pragma unroll
        for (int i = 0; i < 4; ++i) { uint4 o; o.x = pack2(x[i * 8] * inv, x[i * 8 + 1] * inv); o.y = pack2(x[i * 8 + 2] * inv, x[i * 8 + 3] * inv);
          o.z = pack2(x[i * 8 + 4] * inv, x[i * 8 + 5] * inv); o.w = pack2(x[i * 8 + 6] * inv, x[i * 8 + 7] * inv);
          *(uint4*)(Qs + q * 528 + seg * 64 + i * 16) = o; }
      }
    } else {
#pragma unroll
      for (int r = 0; r < 4; ++r) { bf16_t* d_ = ob + (tok0 + qi * 16 + (lane >> 4) * 4 + r) * 1024 + head * 256 + (p - 4) * 64 + t2 * 16 + (lane & 15); d_[0] = f2bf(acc0[r]); d_[16] = f2bf(acc1[r]); }
    }
  }
#undef XA_LOAD
  __syncthreads();
}

__device__ __forceinline__ void wt_item(KP P, int l, int r, unsigned char* lds, int wv_) {
  const float* W; int N; bf16_t* Wt; int kt, nt; const float* gk = nullptr;
  unsigned char* wl = P->ws + WS_WT + l * WT_LAYER;
  if (r < 976) { W = P->in[3] + (size_t)l * 1024 * NIN; N = NIN; Wt = (bf16_t*)(wl + WT_IN); kt = r / 61; nt = r % 61; gk = P->in[2] + l * 1024; }
  else { r -= 976; const int m = r >> 8; r &= 255; kt = r >> 4; nt = r & 15; N = 1024;
    if (m == 0) { W = P->in[20] + (size_t)l * 1048576; Wt = (bf16_t*)(wl + WT_OUT); }
    else if (m == 1) { W = P->in[23] + (size_t)l * 1048576; Wt = (bf16_t*)(wl + WT_Q); gk = P->in[21] + l * 1024; }
    else if (m == 2) { W = P->in[24] + (size_t)l * 1048576; Wt = (bf16_t*)(wl + WT_KV); }
    else if (m == 3) { W = P->in[25] + (size_t)l * 1048576; Wt = (bf16_t*)(wl + WT_KV) + 1024 * 1024; }
    else { W = P->in[26] + (size_t)l * 1048576; Wt = (bf16_t*)(wl + WT_O); } }
  wt_tile(W, N, Wt, kt, nt, lds, wv_, gk);
}
__device__ __forceinline__ void wt_deferred(KP P, int d, unsigned char* lds, int wv_) {
  if (d < 768) { const int m = d >> 8, r = d & 255; wt_item(P, 0, 976 + (m == 0 ? 0 : m == 1 ? 256 : 1024) + r, lds, wv_); }
  else wt_item(P, 1, d - 768, lds, wv_);
}
__device__ __forceinline__ int next_item(unsigned* ctr, volatile LAS int* slot, int wv_) {
  __syncthreads();
  if (opaque_tid(wv_) == 0) *slot = (int)__hip_atomic_fetch_add(ctr, 1u, __ATOMIC_RELAXED, __HIP_MEMORY_SCOPE_AGENT);
  __syncthreads();
  return *slot;
}
__global__ void __launch_bounds__(NTHR) fwd_megakernel(Params Pk_unused) {
  KP P = (KP)__builtin_amdgcn_kernarg_segment_ptr();
  extern __shared__ __attribute__((aligned(16))) unsigned char lds[];
  const int wv_ = __builtin_amdgcn_readfirstlane((int)threadIdx.x >> 6);
  __shared__ uint4 xb_words;
  __shared__ int4 wq_slot;
  if (opaque_tid(wv_) == 0) xb_words = make_uint4(0u, 0u, 0u, 0u);
  __syncthreads();
#ifdef PROBE_J
  __shared__ unsigned long long tacc[32];
  __shared__ unsigned long long tlast;
  __shared__ float pdelta;
  if (opaque_tid(wv_) == 0) { for (int i = 0; i < 32; ++i) tacc[i] = 0ull; tlast = __builtin_amdgcn_s_memrealtime(); pdelta = 0.f; }
#define STAMP(k) if (opaque_tid(wv_) == 0) { const unsigned long long n_ = __builtin_amdgcn_s_memrealtime(); tacc[k] += n_ - tlast; tlast = n_; }
#else
#define STAMP(k)
#endif
  XcdBarrier bar = xcd_barrier_post((unsigned*)(P->ws + WS_BAR), (volatile LAS unsigned*)&xb_words, wv_);
  if (P->never) cg::this_grid().sync();
  const int G = gridDim.x, bid0 = blockIdx.x;

  for (int it = bid0; it < 976 + 512; it += G) wt_item(P, 0, it < 976 ? it : it + 512, lds, wv_);
#pragma unroll 1
  for (int k = 0; k < 3; ++k) {
    const float* s_ = k < 2 ? P->in[1] : P->in[0];
    const float* g_ = k < 2 ? P->in[22] + k * 1024 : P->in[2];
    bf16_t* d_ = k < 2 ? (bf16_t*)(P->ws + WS_MEMN) + k * 512 * 1024 : (bf16_t*)(P->ws + WS_R1);
    norm_rows(false, s_, g_, d_, k < 2 ? 512 : NT, 0.f, wv_, k < 2 ? nullptr : (float*)(P->ws + WS_SSQ));
  }
  { float* z_ = (float*)(P->ws + WS_SSQ) + NT; for (int i = bid0 * NTHR + opaque_tid(wv_); i < 4 * NT; i += G * NTHR) z_[i] = 0.f; }
  STAMP(16 + 10); xcd_barrier(bar, wv_); STAMP(10)
  asm volatile("" : "+s"(P));

#pragma unroll 1
  for (int it = 0; it < 17; ++it) {
    int l = it >> 3, ph = it & 7;
    ph = ph < 5 ? ph : ph + 1;
    if (it == 16) { l = 1; ph = 9; }
    asm volatile("" : "+s"(P));
    int bid = bid0; asm volatile("" : "+s"(bid));

    unsigned char* ws = P->ws;
    const unsigned char* wl = ws + WS_WT + l * WT_LAYER;
    bf16_t* hbuf = (bf16_t*)(ws + WS_R1);
    float* ssq = (float*)(ws + WS_SSQ);
    bf16_t* pbuf = (bf16_t*)(ws + WS_P);
    bf16_t* hx = (bf16_t*)(ws + WS_P);
    bf16_t* qbuf = (bf16_t*)(ws + WS_P + 32ull * MiB);
    bf16_t* obuf = (bf16_t*)(ws + WS_P + 64ull * MiB);
    if (ph == 0 || ph == 4 || ph == 6 || ph == 8) {
      pg8::Gemm g; pg8::TileSched S; pg8::EpiDyn E;
      g.M = NT; g.K = 1024; S.G = G; S.c = bid;
      if (ph == 0) { g.A = hbuf; g.Bt = (const bf16_t*)(wl + WT_IN); g.N = 4096; g.lda = 1024; g.ao0 = 0; g.ao1 = 256; g.ao2 = 512; g.ao3 = 768; S.nt = 1024; S.nN = 16;
        E.mode = 0; E.O = pbuf; E.ldc = NIN; E.N = NIN; E.resid = nullptr; E.out = nullptr; E.ssq_in = ssq + (l == 0 ? 0 : 2) * NT; E.xb = nullptr; E.ssq_out = nullptr; }
      else if (ph == 4) { g.A = pbuf; g.Bt = (const bf16_t*)(wl + WT_OUT); g.N = 1024; g.lda = NIN; g.ao0 = C_GA; g.ao1 = C_CGATE; g.ao2 = C_HG; g.ao3 = C_SG; S.nt = 256; S.nN = 4;
        E.mode = 1; E.O = nullptr; E.ldc = 1024; E.N = 1024; E.resid = (l == 0) ? P->in[0] : P->out; E.out = P->out; E.ssq_in = nullptr; E.xb = hbuf; E.ssq_out = ssq + (l == 0 ? 1 : 3) * NT; }
      else if (ph == 6) { g.A = hbuf; g.Bt = (const bf16_t*)(wl + WT_Q); g.N = 1024; g.lda = 1024; g.ao0 = 0; g.ao1 = 256; g.ao2 = 512; g.ao3 = 768; S.nt = 256; S.nN = 4;
        E.mode = 0; E.O = qbuf; E.ldc = 1024; E.N = 1024; E.resid = nullptr; E.out = nullptr; E.ssq_in = ssq + (l == 0 ? 1 : 3) * NT; E.xb = nullptr; E.ssq_out = nullptr; }
      else { g.A = obuf; g.Bt = (const bf16_t*)(wl + WT_O); g.N = 1024; g.lda = 1024; g.ao0 = 0; g.ao1 = 256; g.ao2 = 512; g.ao3 = 768; S.nt = 256; S.nN = 4;
        E.mode = 1; E.O = nullptr; E.ldc = 1024; E.N = 1024; E.resid = P->out; E.out = P->out; E.ssq_in = nullptr; E.xb = hbuf; E.ssq_out = ssq + (l == 0 ? 2 : 4) * NT; }
      pg8::gemm_phase<pg8::EpiDyn, pg8::TileSched, true, true>((PG8_LAS unsigned char*)lds, g, S, E, wv_);
    } else if (ph == 1) {
      unsigned* ctr = (unsigned*)(ws + WS_BAR) + it;
      for (;;) {
        const int i2 = next_item(ctr, (volatile LAS int*)&wq_slot, wv_);
        if (i2 >= 640) break;
        if (i2 < 128) hgrn_wave_item<0>(P, l, i2 * 8 + wv_, lds, wv_);
        else rwkv_prep_item(P, l, i2 - 128, lds, wv_);
      }
    } else if (ph == 2) {
      const int n_p1 = 8 * (RW_C - 2);
      const int n_rw = n_p1 + 8;
      const int n_oth = 8 + 512 + 1024;
      for (int i2 = bid; i2 < n_rw; i2 += G) {
        if (i2 < n_p1) rwkv_scan_item<1>(P, l, i2 & 7, 1 + (i2 >> 3), lds, wv_);
        else rwkv_scan_item<0>(P, l, i2 - n_p1, 0, lds, wv_);
      }
      {
        unsigned* ctr = (unsigned*)(ws + WS_BAR) + it;
        for (;;) {
          const int i2 = next_item(ctr, (volatile LAS int*)&wq_slot, wv_);
          if (i2 >= n_oth) break;
          if (i2 < 8) hgrn_combine_item(P, i2, wv_);
          else if (i2 < 8 + 512) conv_item(P, l, i2 - 8, lds, wv_);
          else sb_item(P, i2 - 8 - 512, lds, wv_);
        }
      }
    } else if (ph == 3) {
      const int n_p3 = 8 * (RW_C - 1);
      for (int i2 = bid; i2 < n_p3; i2 += G) rwkv_scan_item<0>(P, l, i2 & 7, 1 + (i2 >> 3), lds, wv_);
      {
        unsigned* ctr = (unsigned*)(ws + WS_BAR) + it;
        for (;;) {
          const int i2 = next_item(ctr, (volatile LAS int*)&wq_slot, wv_);
          if (i2 >= 16 + 128 + (l == 0 ? 189 : 0)) break;
          if (i2 >= 16 + 128) { for (int d = (i2 - 144) * 16; d < (i2 - 144) * 16 + 16; ++d) wt_deferred(P, d, lds, wv_); }
          else if (i2 < 16) gemm_tile<2>((const bf16_t*)(ws + WS_MEMN) + (size_t)l * 512 * 1024, 1024, 0, 256, 512, 768, (const bf16_t*)(wl + WT_KV), (i2 >> 3) * 256, (i2 & 7) * 256, 2048,
                                    (bf16_t*)(ws + WS_KV) + (size_t)l * 512 * 2048, (const float*)((bf16_t*)(ws + WS_VT) + (size_t)l * 2 * 1024 * 256), 2048, lds, wv_);
          else hgrn_wave_item<1>(P, l, (i2 - 16) * 8 + wv_, lds, wv_);
        }
      }
    } else if (ph == 7) {
      for (int i2 = bid; i2 < 1024; i2 += G) xattn_item(P, l, i2, lds, wv_);
    } else {
      const bool fin = true;
      const float* g_ = P->in[27];
      void* d_ = (void*)P->out;
#ifdef PROBE_J
      float pd_ = 0.f;
      if (fin) {
        if (bid == PROBE_B) {
          if (opaque_tid(wv_) == 0) {
            unsigned long long tot = 0ull; for (int i = 0; i < 11; ++i) tot += tacc[i] + tacc[16 + i];
            pdelta = sqrtf(0.0128f * (float)(PROBE_J < 32 ? tacc[PROBE_J & 31] : tacc[PROBE_J - 32] + tacc[PROBE_J - 16]) / (float)tot);
          }
          __syncthreads();
          pd_ = pdelta;
        }
      }
      norm_rows(fin, P->out, g_, d_, NT, pd_, wv_);
#else
      norm_rows(fin, P->out, g_, d_, NT, 0.f, wv_);
#endif
    }
    if (it < 16) { STAMP(16 + ph); xcd_barrier(bar, wv_); STAMP(ph) }
  }
#ifdef PROBE_J
  if (bid0 == PROBE_B && opaque_tid(wv_) == 0) {
    const unsigned long long t0_ = __builtin_amdgcn_s_memrealtime();
    const unsigned long long w_ = 4ull * (PROBE_K < 32 ? tacc[PROBE_K & 31] : tacc[PROBE_K - 32] + tacc[PROBE_K - 16]);
    while (__builtin_amdgcn_s_memrealtime() - t0_ < w_) __builtin_amdgcn_s_sleep(8);
  }
#endif
}

extern "C" void kernel_launch(void* const* d_in, const int* in_sizes, int n_in, void* d_out, int out_size, void* d_ws, size_t ws_size, hipStream_t stream) {
  constexpr size_t kDynLds = 147456;
  static int grid_blocks = 0;
  if (!grid_blocks) {
    int dev = 0, cus = 0, per_cu = 0;
    hipGetDevice(&dev);
    hipDeviceGetAttribute(&cus, hipDeviceAttributeMultiprocessorCount, dev);
    hipFuncSetAttribute((const void*)fwd_megakernel, hipFuncAttributeMaxDynamicSharedMemorySize, (int)kDynLds);
    hipOccupancyMaxActiveBlocksPerMultiprocessor(&per_cu, fwd_megakernel, NTHR, kDynLds);
    if (per_cu < 1) per_cu = 1;
    if (per_cu > 1) per_cu = 1;
    grid_blocks = cus * per_cu;
    if (grid_blocks > 256) grid_blocks = 256;
  }
  Params p;
  memset(&p, 0, sizeof(p));
  for (int i = 0; i < 28; ++i) p.in[i] = (const float*)d_in[i];
  p.out = (float*)d_out; p.ws = (unsigned char*)d_ws; p.never = 0; p.pad = 0;
  hipMemsetAsync(d_ws, 0, XCD_BAR_WORDS * 4, stream);
  void* args[] = {&p};
  hipError_t e = hipLaunchCooperativeKernel((void*)fwd_megakernel, dim3(grid_blocks), dim3(NTHR), args, kDynLds, stream);
  if (e != hipSuccess) fprintf(stderr, "cooperative launch failed: %s (grid %d)\n", hipGetErrorString(e), grid_blocks);
}
```

```cpp
#include <hip/hip_runtime.h>
#include <hip/hip_cooperative_groups.h>
#include <stdint.h>
#include <cstdio>
#include <cstring>
namespace cg = cooperative_groups;

typedef unsigned short bf16_t;
typedef short bf16x8 __attribute__((ext_vector_type(8)));
typedef float f32x4 __attribute__((ext_vector_type(4)));
typedef float f32x16 __attribute__((ext_vector_type(16)));
typedef float f32x2 __attribute__((ext_vector_type(2)));
#define LAS __attribute__((address_space(3)))

#define NT 16384
#define TSEQ 8192
#define DM 1024
#define NIN 3904
#define NTHR 512
#define C_R 0
#define C_K 256
#define C_V 512
#define C_XW 768
#define C_GA 832
#define C_CVAL 1088
#define C_CGLU 1344
#define C_CGATE 1600
#define C_HQ 1856
#define C_HF 2112
#define C_HI 2368
#define C_HG 2624
#define C_SQ 2880
#define C_SK 3136
#define C_SV 3392
#define C_SG 3648
#define RW_C 32
#define RW_CL (TSEQ / RW_C)
#define RW_TT 16

#define MiB (1024ull * 1024ull)
#define WS_BAR   0ull
#define WS_WT    (1ull * MiB)
#define WT_LAYER (18ull * MiB)
#define WT_IN    0ull
#define WT_OUT   (8ull * MiB)
#define WT_Q     (10ull * MiB)
#define WT_KV    (12ull * MiB)
#define WT_O     (16ull * MiB)
#define WS_MEMN  (37ull * MiB)
#define WS_KV    (39ull * MiB)
#define WS_PQ    (246ull * MiB)
#define WS_HS    (47ull * MiB)
#define WS_HF    (63ull * MiB)
#define WS_RK    (63ull * MiB + 512ull * 1024ull)
#define WS_R1    (64ull * MiB)
#define WS_PW    WS_R1
#define WS_PV    (WS_R1 + 16ull * MiB)
#define WS_P     (120ull * MiB)
#define WS_VT    (243ull * MiB)
#define WS_SSQ   (245ull * MiB)
#define WS_END   (254ull * MiB)

struct Params {
  const float* in[28];
  float* out;
  unsigned char* ws;
  int never;
  int pad;
};

typedef const __attribute__((address_space(4))) Params* KP;
__device__ __forceinline__ int lane_id_() { return (int)__builtin_amdgcn_mbcnt_hi(~0u, __builtin_amdgcn_mbcnt_lo(~0u, 0u)); }
__device__ __forceinline__ int opaque_tid(int wv_) { int t; asm volatile("v_mbcnt_lo_u32_b32 %0, -1, 0\n\tv_mbcnt_hi_u32_b32 %0, -1, %0\n\tv_lshl_add_u32 %0, %1, 6, %0" : "=&v"(t) : "s"(wv_)); return t; }
__device__ __forceinline__ float bf2f(bf16_t v) { return __uint_as_float(((unsigned)v) << 16); }
__device__ __forceinline__ bf16_t f2bf(float f) {
  unsigned u = __float_as_uint(f);
  u += 0x7fffu + ((u >> 16) & 1u);
  return (bf16_t)(u >> 16);
}
__device__ __forceinline__ unsigned pack2(float a, float b) { return (unsigned)f2bf(a) | ((unsigned)f2bf(b) << 16); }
__device__ __forceinline__ float sigmoidf_(float x) { return __builtin_amdgcn_rcpf(1.0f + __expf(-x)); }
__device__ __forceinline__ float siluf_(float x) { return x * __builtin_amdgcn_rcpf(1.0f + __expf(-x)); }
__device__ __forceinline__ float softplusf_(float x) { return fmaxf(x, 0.f) + log1pf(__expf(-fabsf(x))); }
__device__ __forceinline__ float softplus_fast(float x) { return fmaxf(x, 0.f) + __logf(1.0f + __expf(-fabsf(x))); }
__device__ __forceinline__ float dpp_add(float v, const int ctrl_sel) {
  return v;
}
__device__ __forceinline__ float bperm(float v, int srclane) { return __builtin_bit_cast(float, __builtin_amdgcn_ds_bpermute(srclane << 2, __builtin_bit_cast(int, v))); }
__device__ __forceinline__ float wave_sum(float v, int lane) {
  v += __builtin_bit_cast(float, __builtin_amdgcn_update_dpp(0, __builtin_bit_cast(int, v), 0xB1, 0xF, 0xF, true));
  v += __builtin_bit_cast(float, __builtin_amdgcn_update_dpp(0, __builtin_bit_cast(int, v), 0x4E, 0xF, 0xF, true));
  v += __builtin_bit_cast(float, __builtin_amdgcn_update_dpp(0, __builtin_bit_cast(int, v), 0x141, 0xF, 0xF, true));
  v += __builtin_bit_cast(float, __builtin_amdgcn_update_dpp(0, __builtin_bit_cast(int, v), 0x140, 0xF, 0xF, true));
  v += bperm(v, lane ^ 16);
  v += bperm(v, lane ^ 32);
  return v;
}
__device__ __forceinline__ float max8(float v) {
  v = fmaxf(v, __builtin_bit_cast(float, __builtin_amdgcn_update_dpp(0, __builtin_bit_cast(int, v), 0xB1, 0xF, 0xF, true)));
  v = fmaxf(v, __builtin_bit_cast(float, __builtin_amdgcn_update_dpp(0, __builtin_bit_cast(int, v), 0x4E, 0xF, 0xF, true)));
  v = fmaxf(v, __builtin_bit_cast(float, __builtin_amdgcn_update_dpp(0, __builtin_bit_cast(int, v), 0x141, 0xF, 0xF, true)));
  return v;
}
__device__ __forceinline__ float red8(float v) {
  v += __builtin_bit_cast(float, __builtin_amdgcn_update_dpp(0, __builtin_bit_cast(int, v), 0xB1, 0xF, 0xF, true));
  v += __builtin_bit_cast(float, __builtin_amdgcn_update_dpp(0, __builtin_bit_cast(int, v), 0x4E, 0xF, 0xF, true));
  v += __builtin_bit_cast(float, __builtin_amdgcn_update_dpp(0, __builtin_bit_cast(int, v), 0x141, 0xF, 0xF, true));
  return v;
}

#define LBAR() do { asm volatile("s_waitcnt lgkmcnt(0)" ::: "memory"); __builtin_amdgcn_s_barrier(); asm volatile("" ::: "memory"); } while (0)
#define XB_TMO      128
#define XB_XCNT(j)  (256  + 64 * (j))
#define XB_XSUB(j)  (1280 + 64 * (j))
#define XB_XGEN(j)  (2304 + 64 * (j))
#define XB_TOP      3328
#define XB_TOPGEN   3392
#define XCD_BAR_WORDS 3456
#define XB_SPIN_CAP (1u << 22)
__device__ __forceinline__ unsigned xb_ld(unsigned* p) { return __hip_atomic_load(p, __ATOMIC_RELAXED, __HIP_MEMORY_SCOPE_AGENT); }
__device__ __forceinline__ unsigned xb_add(unsigned* p, unsigned v) { return __hip_atomic_fetch_add(p, v, __ATOMIC_RELAXED, __HIP_MEMORY_SCOPE_AGENT); }
__device__ __forceinline__ unsigned xb_xcc_id() { return (unsigned)__builtin_amdgcn_s_getreg((3 << 11) | 20) & 0xFu; }
#define XB_SPIN(cond, bar) do { unsigned _sp = 0; while (cond) { __builtin_amdgcn_s_sleep(1); \
    if ((++_sp & 255u) == 0u) { if (xb_ld(&(bar)[XB_TMO])) break; if (_sp > XB_SPIN_CAP) { atomicAdd(&(bar)[XB_TMO], 1u); break; } } } } while (0)
struct XcdBarrier { unsigned* bar; unsigned x; volatile LAS unsigned* st; };
__device__ __forceinline__ XcdBarrier xcd_barrier_post(unsigned* bar, volatile LAS unsigned* st, int wv_) {
  XcdBarrier b; b.bar = bar; b.x = xb_xcc_id(); b.st = st;
  if (opaque_tid(wv_) == 0) (void)xb_add(&bar[XB_XCNT(b.x)], 1u);
  return b;
}
__device__ __forceinline__ void xcd_barrier_complete(unsigned* bar, unsigned x, unsigned& nloc, unsigned& nx) {
  const unsigned G = gridDim.x * gridDim.y * gridDim.z;
  unsigned sum, cnt, mine, sp = 0u;
  for (;;) {
    sum = 0u; cnt = 0u; mine = 0u;
#pragma unroll
    for (unsigned j = 0; j < 16; ++j) { const unsigned c = xb_ld(&bar[XB_XCNT(j)]); sum += c; cnt += (c > 0u) ? 1u : 0u; mine = (j == x) ? c : mine; }
    if (sum == G) break;
    __builtin_amdgcn_s_sleep(1);
    if ((++sp & 255u) == 0u) { if (xb_ld(&bar[XB_TMO])) break; if (sp > XB_SPIN_CAP) { atomicAdd(&bar[XB_TMO], 1u); break; } }
  }
  nloc = mine > 0u ? mine : 1u; nx = cnt > 0u ? cnt : 1u;
}
__device__ __forceinline__ void xcd_barrier(const XcdBarrier& b, int wv_) {
  asm volatile("s_waitcnt vmcnt(0)" ::: "memory");
  __syncthreads();
  if (opaque_tid(wv_) == 0) {
    unsigned* bar = b.bar;
    __builtin_amdgcn_s_waitcnt(0);
    unsigned bx = b.x; asm volatile("" : "+s"(bx));
    unsigned nloc = b.st[0], nx = b.st[1];
    if (nloc == 0u) { xcd_barrier_complete(bar, bx, nloc, nx); b.st[0] = nloc; b.st[1] = nx; }
    const unsigned old = xb_add(&bar[XB_XSUB(bx)], 1u);
    const unsigned gen = old / nloc;
    if (old + 1u == (gen + 1u) * nloc) {
      __builtin_amdgcn_fence(__ATOMIC_RELEASE, "agent");
      asm volatile("s_waitcnt vmcnt(0)" ::: "memory");
      const unsigned og = xb_add(&bar[XB_TOP], 1u);
      const unsigned tg = og / nx;
      if (og + 1u == (tg + 1u) * nx) xb_add(&bar[XB_TOPGEN], 1u);
      else XB_SPIN(xb_ld(&bar[XB_TOPGEN]) == tg, bar);
      __builtin_amdgcn_fence(__ATOMIC_ACQUIRE, "agent");
      xb_add(&bar[XB_XGEN(bx)], 1u);
      asm volatile("s_waitcnt vmcnt(0)" ::: "memory");
    } else {
      XB_SPIN(xb_ld(&bar[XB_XGEN(bx)]) == gen, bar);
      __builtin_amdgcn_fence(__ATOMIC_ACQUIRE, "agent");
      asm volatile("s_waitcnt vmcnt(0)" ::: "memory");
    }
  }
  __syncthreads();
}

#define G_STAGE 73728
#define G_BOFF 36864
template <int EPI>
__device__ __forceinline__ void gemm_tile(const bf16_t* __restrict__ A, int lda, int ao0, int ao1, int ao2, int ao3,
                                          const bf16_t* __restrict__ Bt, int m0, int n0, int N,
                                          void* out, const float* resid, int ldc, unsigned char* lds, int wv_) {
#ifdef OFF_gemm_tile
  return;
#endif

  const int tid = opaque_tid(wv_), lane = tid & 63, w = tid >> 6;
  const int wm = w >> 2, wn = w & 3, lr = lane & 31, lh = lane >> 5;
  f32x16 acc[4][2];
#pragma unroll
  for (int i = 0; i < 4; ++i)
#pragma unroll
    for (int j = 0; j < 2; ++j)
#pragma unroll
      for (int r = 0; r < 16; ++r) acc[i][j][r] = 0.f;
  uint4 ra[4], rb[4];
  const int crow = tid >> 3, ccol = (tid & 7) * 8;
  const bf16_t* Ap = A + (size_t)(m0 + crow) * lda + ccol;
  const bf16_t* Bp = Bt + (size_t)(n0 + crow) * 1024 + ccol;
#define G_LOAD(kt) { const int k0_ = (kt) * 64; const int seg_ = k0_ >> 8; const int ao_ = (seg_ == 0 ? ao0 : seg_ == 1 ? ao1 : seg_ == 2 ? ao2 : ao3) + (k0_ & 255); \
    _Pragma("unroll") for (int i_ = 0; i_ < 4; ++i_) { ra[i_] = *(const uint4*)(Ap + (size_t)(i_ * 64) * lda + ao_); rb[i_] = *(const uint4*)(Bp + (size_t)(i_ * 64) * 1024 + k0_); } }
#define G_WRITE(buf) { unsigned char* b_ = lds + (buf) * G_STAGE + crow * 144 + (tid & 7) * 16; \
    _Pragma("unroll") for (int i_ = 0; i_ < 4; ++i_) { *(uint4*)(b_ + i_ * 64 * 144) = ra[i_]; *(uint4*)(b_ + G_BOFF + i_ * 64 * 144) = rb[i_]; } }
  G_LOAD(0); G_WRITE(0); __syncthreads();
  for (int kt = 0; kt < 16; ++kt) {
    if (kt < 15) G_LOAD(kt + 1);
    const unsigned char* base = lds + (kt & 1) * G_STAGE;
    const unsigned char* ab = base + (wm * 128 + lr) * 144 + lh * 16;
    const unsigned char* bb = base + G_BOFF + (wn * 64 + lr) * 144 + lh * 16;
#pragma unroll
    for (int s = 0; s < 4; ++s) {
      bf16x8 a[4], b[2];
#pragma unroll
      for (int i = 0; i < 4; ++i) a[i] = *(const bf16x8*)(ab + i * 32 * 144 + s * 32);
#pragma unroll
      for (int j = 0; j < 2; ++j) b[j] = *(const bf16x8*)(bb + j * 32 * 144 + s * 32);
#pragma unroll
      for (int i = 0; i < 4; ++i)
#pragma unroll
        for (int j = 0; j < 2; ++j) acc[i][j] = __builtin_amdgcn_mfma_f32_32x32x16_bf16(a[i], b[j], acc[i][j], 0, 0, 0);
    }
    if (kt < 15) G_WRITE((kt + 1) & 1);
    __syncthreads();
  }
#undef G_LOAD
#undef G_WRITE
#pragma unroll
  for (int i = 0; i < 4; ++i)
#pragma unroll
    for (int j = 0; j < 2; ++j) {
      const int col = n0 + wn * 64 + j * 32 + lr;
#pragma unroll
      for (int r = 0; r < 16; ++r) {
        const int row = m0 + wm * 128 + i * 32 + (r & 3) + 8 * (r >> 2) + 4 * lh;
        if (EPI == 0) { if (col < N) ((bf16_t*)out)[(size_t)row * ldc + col] = f2bf(acc[i][j][r]); }
        else if (EPI == 2) { if (col < 1024) ((bf16_t*)out)[(size_t)row * ldc + col] = f2bf(acc[i][j][r]);
                             else ((bf16_t*)resid)[((size_t)((row >> 8) * 1024 + (col - 1024))) * 256 + (row & 255)] = f2bf(acc[i][j][r]); }
        else { ((float*)out)[(size_t)row * ldc + col] = resid[(size_t)row * ldc + col] + acc[i][j][r]; }
      }
    }
}

__device__ __forceinline__ void tile_map(int t, int nN, int& mi, int& ni) {
  const int rnd = t >> 8, blk = t & 255, x = blk & 7, y = blk >> 3;
  if (nN == 16) { mi = rnd * 16 + (x >> 1) * 4 + (y & 3); ni = (x & 1) * 8 + (y >> 2); }
  else { mi = rnd * 64 + x * 8 + (y & 7); ni = y >> 3; }
}

namespace pg8 {
#define PG8_LAS __attribute__((address_space(3)))
typedef unsigned u32x4 __attribute__((ext_vector_type(4)));
constexpr int BM = 256, BK = 64, HALF = 128, HTB = HALF * BK * 2  , STAGE_BYTES = 8 * HTB, NXCD = 8, WGM = 8;

__host__ __device__ __forceinline__ int lds_byte(int r, int c) { const int st = (r >> 4) * 2 + (c >> 5), rr = r & 15, cc = c & 31, ob = rr * 64 + cc * 2; return st * 1024 + (ob ^ (((ob >> 9) & 1) << 5)); }
__host__ __device__ __forceinline__ void stage_rc(int b, int& R, int& C) { const int st = b / 1024, sb = b % 1024, swz = sb ^ (((sb >> 9) & 1) << 5); R = (st >> 1) * 16 + swz / 64; C = (st & 1) * 32 + (swz % 64) / 2; }
__host__ __device__ __forceinline__ int perm32(int rho) { const int n = rho >> 4, i = rho & 15; return 8 * (i >> 2) + 4 * n + (i & 3); }

struct Unit { int pm, pn; };
struct Gemm { const bf16_t* A; const bf16_t* Bt; int M, N, K; int lda; int ao0, ao1, ao2, ao3; };

struct TileSched {
    int nt, G, c, nN;
    __device__ __forceinline__ bool next(int i, Unit& u) const { const int t = i * G + c; if (t >= nt) return false; tile_map(t, nN, u.pm, u.pn); return true; }
    __device__ __forceinline__ void a_ready(const Unit&) const {}
    __device__ __forceinline__ void done(const Unit&) const {}
};
__device__ __forceinline__ unsigned cvt_pk_bf16(float lo, float hi) { unsigned r; asm volatile("v_cvt_pk_bf16_f32 %0, %1, %2" : "=v"(r) : "v"(lo), "v"(hi)); return r; }
struct EpiStoreBf16 {
    static constexpr bool PERM = true, AFTER_DRAIN = false;
    bf16_t* O; int ldc; int N;
    __device__ __forceinline__ void operator()(const f32x4 (&acc)[2][2][4][2], const Unit& u, int wr, int wc, int fr, int fq) const {
        const int row0 = u.pm * BM + wr * 64 + fr, col0 = u.pn * BM + wc * 32 + 8 * fq;
#pragma unroll
        for (int ai = 0; ai < 2; ++ai)
#pragma unroll
            for (int m = 0; m < 4; ++m) { bf16_t* rowp = O + (size_t)(row0 + ai * HALF + m * 16) * ldc + col0;
#pragma unroll
                for (int bj = 0; bj < 2; ++bj) { if (col0 + bj * HALF < N) { const f32x4 v0 = acc[ai][bj][m][0], v1 = acc[ai][bj][m][1];
                    u32x4 w; w.x = cvt_pk_bf16(v0[0], v0[1]); w.y = cvt_pk_bf16(v0[2], v0[3]); w.z = cvt_pk_bf16(v1[0], v1[1]); w.w = cvt_pk_bf16(v1[2], v1[3]);
                    *(u32x4*)(rowp + bj * HALF) = w; } } }
    }
};
struct EpiDyn {
    static constexpr bool PERM = true, AFTER_DRAIN = false;
    int mode; bf16_t* O; int ldc; int N; const float* resid; float* out; const float* ssq_in; bf16_t* xb; float* ssq_out;
    __device__ __forceinline__ void operator()(const f32x4 (&acc)[2][2][4][2], const Unit& u, int wr, int wc, int fr, int fq) const {
        const int row0 = u.pm * BM + wr * 64 + fr, col0 = u.pn * BM + wc * 32 + 8 * fq;
        if (mode == 0) {
#pragma unroll
            for (int ai = 0; ai < 2; ++ai)
#pragma unroll
                for (int m = 0; m < 4; ++m) { const int row = row0 + ai * HALF + m * 16; bf16_t* rowp = O + (size_t)row * ldc + col0;
                    const float sc = __builtin_amdgcn_rsqf(ssq_in[row] * (1.0f / 1024.0f) + 1e-6f);
#pragma unroll
                    for (int bj = 0; bj < 2; ++bj) { if (col0 + bj * HALF < N) { const f32x4 v0 = acc[ai][bj][m][0] * sc, v1 = acc[ai][bj][m][1] * sc;
                        u32x4 w; w.x = cvt_pk_bf16(v0[0], v0[1]); w.y = cvt_pk_bf16(v0[2], v0[3]); w.z = cvt_pk_bf16(v1[0], v1[1]); w.w = cvt_pk_bf16(v1[2], v1[3]);
                        *(u32x4*)(rowp + bj * HALF) = w; } } }
        } else {
            const int lane_ = fq * 16 + fr;
#pragma unroll
            for (int ai = 0; ai < 2; ++ai)
#pragma unroll
                for (int m = 0; m < 4; ++m) { const int row = row0 + ai * HALF + m * 16; const size_t off = (size_t)row * ldc + col0; float s = 0.f;
#pragma unroll
                    for (int bj = 0; bj < 2; ++bj) { const f32x4 r0 = *(const f32x4*)(resid + off + bj * HALF), r1 = *(const f32x4*)(resid + off + bj * HALF + 4);
                        const f32x4 x0 = r0 + acc[ai][bj][m][0], x1 = r1 + acc[ai][bj][m][1];
                        *(f32x4*)(out + off + bj * HALF) = x0; *(f32x4*)(out + off + bj * HALF + 4) = x1;
                        u32x4 w; w.x = cvt_pk_bf16(x0[0], x0[1]); w.y = cvt_pk_bf16(x0[2], x0[3]); w.z = cvt_pk_bf16(x1[0], x1[1]); w.w = cvt_pk_bf16(x1[2], x1[3]);
                        *(u32x4*)(xb + off + bj * HALF) = w;
                        s += (x0[0] * x0[0] + x0[1] * x0[1]) + (x0[2] * x0[2] + x0[3] * x0[3]) + (x1[0] * x1[0] + x1[1] * x1[1]) + (x1[2] * x1[2] + x1[3] * x1[3]); }
                    s += bperm(s, lane_ ^ 16); s += bperm(s, lane_ ^ 32);
                    if (fq == 0) __hip_atomic_fetch_add(ssq_out + row, s, __ATOMIC_RELAXED, __HIP_MEMORY_SCOPE_AGENT); }
        }
    }
};
struct EpiResid {
    static constexpr bool PERM = true, AFTER_DRAIN = false;
    const float* resid; float* out; int ldc;
    __device__ __forceinline__ void operator()(const f32x4 (&acc)[2][2][4][2], const Unit& u, int wr, int wc, int fr, int fq) const {
        const int row0 = u.pm * BM + wr * 64 + fr, col0 = u.pn * BM + wc * 32 + 8 * fq;
#pragma unroll
        for (int ai = 0; ai < 2; ++ai)
#pragma unroll
            for (int m = 0; m < 4; ++m) { const size_t off = (size_t)(row0 + ai * HALF + m * 16) * ldc + col0;
#pragma unroll
                for (int bj = 0; bj < 2; ++bj) { const f32x4 r0 = *(const f32x4*)(resid + off + bj * HALF), r1 = *(const f32x4*)(resid + off + bj * HALF + 4);
                    *(f32x4*)(out + off + bj * HALF) = r0 + acc[ai][bj][m][0]; *(f32x4*)(out + off + bj * HALF + 4) = r1 + acc[ai][bj][m][1]; } }
    }
};

static_assert(true, "pg8 body adapted: SP2 path only is valid with lda/segment offsets");
template <class Epi, class Sched, bool ALIGN_EPI = false, bool SP2 = false>
__device__ __forceinline__ void gemm_phase(PG8_LAS unsigned char* lds, const Gemm g, const Sched& S, const Epi& E, int wv_) {
    const int tid = opaque_tid(wv_), wid = __builtin_amdgcn_readfirstlane(tid >> 6), lane = tid & 63, wr = wid >> 2, wc = wid & 3, fr = lane & 15, fq = lane >> 4;
    const int K = g.K, nt = K / BK;
    unsigned voffA, voffB;
    { int R, C; stage_rc(tid * 16, R, C); const int Rb = Epi::PERM ? ((R & ~31) + perm32(R & 31)) : R;
      voffA = (unsigned)(R * g.lda + C) * 2u; voffB = (unsigned)(Rb * K + C) * 2u; }
    const size_t rstepA = (size_t)64 * g.lda * 2, rstepB = (size_t)64 * K * 2;
    const size_t kstep = (size_t)(BK * 2);
    const size_t hstep = (size_t)HALF * K * 2; const size_t hstepA = (size_t)HALF * g.lda * 2, tstepA = 2 * hstepA;
#define PG8_KA(t_) ((size_t)((((t_) >> 2) == 0 ? g.ao0 : ((t_) >> 2) == 1 ? g.ao1 : ((t_) >> 2) == 2 ? g.ao2 : g.ao3) + ((t_) & 3) * 64) * 2)
    const size_t tstep = 2 * hstep;
    const unsigned ldsw = (unsigned)wid * 1024u;
    int aoff, boff;
#define PG8_SA(b, h) (((b) * 2 + (h)) * HTB)
#define PG8_SB(b, h) ((4 + (b) * 2 + (h)) * HTB)
#define PG8_STAGE(bufoff, gbase, voff) do { _Pragma("unroll") for (int _i = 0; _i < 2; ++_i) \
        __builtin_amdgcn_global_load_lds((const unsigned*)((const char*)(gbase) + (size_t)_i * r##voff + (voff)), (PG8_LAS unsigned*)(lds + (bufoff) + ldsw + _i * 8192), 16, 0, 0); } while (0)
#define rvoffA rstepA
#define rvoffB rstepB
#define PG8_LDA(dst, b, h) do { _Pragma("unroll") for (int m = 0; m < 4; ++m) _Pragma("unroll") for (int k = 0; k < 2; ++k) dst[m][k] = *(const PG8_LAS bf16x8*)(lds + (PG8_SA(b, h) + wr * 8192) + aoff + m * 2048 + k * 1024); } while (0)
#define PG8_LDB(dst, b, h) do { _Pragma("unroll") for (int n = 0; n < 2; ++n) _Pragma("unroll") for (int k = 0; k < 2; ++k) dst[n][k] = *(const PG8_LAS bf16x8*)(lds + (PG8_SB(b, h) + wc * 4096) + boff + n * 2048 + k * 1024); } while (0)
#define PG8_MMA(ai, bj, At, Bt) do { __builtin_amdgcn_s_setprio(1); _Pragma("unroll") for (int m = 0; m < 4; ++m) _Pragma("unroll") for (int n = 0; n < 2; ++n) _Pragma("unroll") for (int k = 0; k < 2; ++k) \
        acc[ai][bj][m][n] = __builtin_amdgcn_mfma_f32_16x16x32_bf16(Bt[n][k], At[m][k], acc[ai][bj][m][n], 0, 0, 0); __builtin_amdgcn_s_setprio(0); } while (0)
#define PG8_WAIT_V(n) asm volatile("s_waitcnt vmcnt(" #n ")" ::: "memory")
#define PG8_WAIT_L(n) asm volatile("s_waitcnt lgkmcnt(" #n ")" ::: "memory")
#define PG8_BAR __builtin_amdgcn_s_barrier()
#define PG8_SCHED __builtin_amdgcn_sched_barrier(0)
    Unit cur, nxt; int ui = 0;
    if (!S.next(0, cur)) return;
    f32x4 acc[2][2][4][2];
#pragma unroll
    for (int a = 0; a < 2; ++a)
#pragma unroll
        for (int b = 0; b < 2; ++b)
#pragma unroll
            for (int m = 0; m < 4; ++m)
#pragma unroll
                for (int n = 0; n < 2; ++n) acc[a][b][m][n] = (f32x4){0.f, 0.f, 0.f, 0.f};
    bf16x8 At[4][2], B0[2][2], B1[2][2];
    const char* cA = (const char*)g.A + (size_t)cur.pm * tstepA; const char* cB = (const char*)g.Bt + (size_t)cur.pn * tstep;
    S.a_ready(cur);
    if constexpr (SP2) {
        PG8_STAGE(PG8_SB(0, 0), cB, voffB); PG8_STAGE(PG8_SB(0, 1), cB + hstep, voffB); PG8_STAGE(PG8_SA(0, 0), cA + PG8_KA(0), voffA); PG8_STAGE(PG8_SA(0, 1), cA + hstepA + PG8_KA(0), voffA);
        if (wr == 1) PG8_BAR;
        PG8_WAIT_V(2); PG8_BAR;
        PG8_STAGE(PG8_SB(1, 0), cB + kstep, voffB); PG8_STAGE(PG8_SA(1, 0), cA + PG8_KA(1), voffA); PG8_STAGE(PG8_SB(1, 1), cB + hstep + kstep, voffB);
        PG8_WAIT_V(6); PG8_BAR;
    } else {
        PG8_STAGE(PG8_SB(0, 0), cB, voffB); PG8_STAGE(PG8_SA(0, 0), cA, voffA); PG8_STAGE(PG8_SB(0, 1), cB + hstep, voffB); PG8_STAGE(PG8_SA(0, 1), cA + hstep, voffA);
        if (wr == 1) PG8_BAR;
        PG8_WAIT_V(4); PG8_BAR;
        PG8_STAGE(PG8_SB(1, 0), cB + kstep, voffB); PG8_STAGE(PG8_SA(1, 0), cA + kstep, voffA); PG8_STAGE(PG8_SB(1, 1), cB + hstep + kstep, voffB);
        PG8_WAIT_V(6); PG8_BAR;
    }
    { const int t3_ = opaque_tid(wv_), l3_ = t3_ & 63, w3_ = __builtin_amdgcn_readfirstlane(t3_ >> 6); aoff = lds_byte((l3_ & 15), (l3_ >> 4) * 8); boff = aoff; }
    for (;;) {
        const bool has_next = S.next(ui + 1, nxt);
        const char* nA = has_next ? (const char*)g.A + (size_t)nxt.pm * tstepA : cA; const char* nB = has_next ? (const char*)g.Bt + (size_t)nxt.pn * tstep : cB;
        for (int t = 0; t < nt; t += 2) {
            const bool last = (t == nt - 2);
            const char* a1 = cA + PG8_KA(t + 1);
            const char* a2 = last ? nA + PG8_KA(0) : cA + PG8_KA(t + 2); const char* b2 = last ? nB : cB + (size_t)(t + 2) * kstep;
            const char* a3 = last ? nA + PG8_KA(1) : cA + PG8_KA(t + 3); const char* b3 = b2 + kstep;
            if (last && has_next) S.a_ready(nxt);
            if constexpr (SP2) {
            PG8_LDB(B0, 0, 0); PG8_LDB(B1, 0, 1); PG8_SCHED; PG8_LDA(At, 0, 0); PG8_STAGE(PG8_SA(1, 1), a1 + hstepA, voffA);
            PG8_WAIT_V(8); PG8_WAIT_L(0); PG8_BAR; PG8_MMA(0, 0, At, B0); PG8_MMA(0, 1, At, B1); PG8_BAR; PG8_SCHED;
            PG8_LDA(At, 0, 1); PG8_STAGE(PG8_SB(0, 0), b2, voffB); PG8_STAGE(PG8_SB(0, 1), b2 + hstep, voffB); PG8_STAGE(PG8_SA(0, 0), a2, voffA);
            PG8_WAIT_V(8); PG8_WAIT_L(0); PG8_BAR; PG8_MMA(1, 0, At, B0); PG8_MMA(1, 1, At, B1); PG8_BAR; PG8_SCHED;
            PG8_LDB(B0, 1, 0); PG8_LDB(B1, 1, 1); PG8_SCHED; PG8_LDA(At, 1, 0); PG8_STAGE(PG8_SA(0, 1), a2 + hstepA, voffA);
            PG8_WAIT_V(8); PG8_WAIT_L(0); PG8_BAR; PG8_MMA(0, 0, At, B0); PG8_MMA(0, 1, At, B1); PG8_BAR; PG8_SCHED;
            PG8_LDA(At, 1, 1); PG8_STAGE(PG8_SB(1, 0), b3, voffB); PG8_STAGE(PG8_SB(1, 1), b3 + hstep, voffB); PG8_STAGE(PG8_SA(1, 0), a3, voffA);
            PG8_WAIT_V(8); PG8_WAIT_L(0); PG8_BAR; PG8_MMA(1, 0, At, B0); PG8_MMA(1, 1, At, B1); PG8_BAR; PG8_SCHED;
            } else {
            PG8_LDB(B0, 0, 0); PG8_SCHED; PG8_LDA(At, 0, 0); PG8_STAGE(PG8_SA(1, 1), a1 + hstep, voffA);
            PG8_WAIT_L(8); PG8_BAR; PG8_WAIT_L(0); PG8_MMA(0, 0, At, B0); PG8_BAR; PG8_SCHED;
            PG8_LDB(B1, 0, 1); PG8_STAGE(PG8_SB(0, 0), b2, voffB);
            PG8_BAR; PG8_WAIT_L(0); PG8_MMA(0, 1, At, B1); PG8_BAR;
            PG8_LDA(At, 0, 1); PG8_STAGE(PG8_SA(0, 0), a2, voffA);
            PG8_BAR; PG8_WAIT_L(0); PG8_MMA(1, 0, At, B0); PG8_BAR; PG8_SCHED;
            PG8_STAGE(PG8_SB(0, 1), b2 + hstep, voffB);
            PG8_WAIT_V(6); PG8_BAR; PG8_MMA(1, 1, At, B1); PG8_BAR;
            PG8_LDB(B0, 1, 0); PG8_SCHED; PG8_LDA(At, 1, 0); PG8_STAGE(PG8_SA(0, 1), a2 + hstep, voffA);
            PG8_WAIT_L(8); PG8_BAR; PG8_WAIT_L(0); PG8_MMA(0, 0, At, B0); PG8_BAR; PG8_SCHED;
            PG8_LDB(B1, 1, 1); PG8_STAGE(PG8_SB(1, 0), b3, voffB);
            PG8_BAR; PG8_WAIT_L(0); PG8_MMA(0, 1, At, B1); PG8_BAR;
            PG8_LDA(At, 1, 1); PG8_STAGE(PG8_SA(1, 0), a3, voffA);
            PG8_BAR; PG8_WAIT_L(0); PG8_MMA(1, 0, At, B0); PG8_BAR; PG8_SCHED;
            PG8_STAGE(PG8_SB(1, 1), b3 + hstep, voffB);
            PG8_WAIT_V(6); PG8_BAR; PG8_MMA(1, 1, At, B1); PG8_BAR;
            }
        }
        if constexpr (ALIGN_EPI) { if (wr == 0) PG8_BAR; }
        if constexpr (!Epi::AFTER_DRAIN) { const int t2_ = opaque_tid(wv_), l2_ = t2_ & 63, w2_ = __builtin_amdgcn_readfirstlane(t2_ >> 6); E(acc, cur, w2_ >> 2, w2_ & 3, l2_ & 15, l2_ >> 4); S.done(cur); }
        if (!has_next) break;
#pragma unroll
        for (int a = 0; a < 2; ++a)
#pragma unroll
            for (int b = 0; b < 2; ++b)
#pragma unroll
                for (int m = 0; m < 4; ++m)
#pragma unroll
                    for (int n = 0; n < 2; ++n) acc[a][b][m][n] = (f32x4){0.f, 0.f, 0.f, 0.f};
        cur = nxt; cA = nA; cB = nB; ++ui;
        if constexpr (ALIGN_EPI) { if (wr == 1) PG8_BAR; }
    }
    PG8_WAIT_V(0);
    if constexpr (!ALIGN_EPI) { if (wr == 0) PG8_BAR; }
    PG8_BAR;
    if constexpr (Epi::AFTER_DRAIN) { E.fused(acc, cur, wr, wc, fr, fq, lds, wid, lane); S.done(cur); }
#undef PG8_SA
#undef PG8_SB
#undef PG8_STAGE
#undef rvoffA
#undef rvoffB
#undef PG8_LDA
#undef PG8_LDB
#undef PG8_MMA
#undef PG8_WAIT_V
#undef PG8_WAIT_L
#undef PG8_BAR
#undef PG8_SCHED
#undef PG8_KA
}
}

__device__ __forceinline__ void wt_tile(const float* __restrict__ W, int N, bf16_t* __restrict__ Wt, int kt, int nt, unsigned char* lds, int wv_, const float* gk = nullptr) {
#ifdef OFF_wt_tile
  return;
#endif

  float* tl = (float*)lds;
  const int tid = opaque_tid(wv_);
  const int r = tid >> 3, c8 = (tid & 7) * 8;
  const float* src = W + (size_t)(kt * 64 + r) * N + nt * 64 + c8;
  float4 v0 = *(const float4*)src, v1 = *(const float4*)(src + 4);
  if (gk) { const float g_ = gk[kt * 64 + r]; v0.x *= g_; v0.y *= g_; v0.z *= g_; v0.w *= g_; v1.x *= g_; v1.y *= g_; v1.z *= g_; v1.w *= g_; }
  float* d = tl + r * 65 + c8;
  d[0] = v0.x; d[1] = v0.y; d[2] = v0.z; d[3] = v0.w; d[4] = v1.x; d[5] = v1.y; d[6] = v1.z; d[7] = v1.w;
  __syncthreads();
  uint4 o;
  o.x = pack2(tl[(c8 + 0) * 65 + r], tl[(c8 + 1) * 65 + r]);
  o.y = pack2(tl[(c8 + 2) * 65 + r], tl[(c8 + 3) * 65 + r]);
  o.z = pack2(tl[(c8 + 4) * 65 + r], tl[(c8 + 5) * 65 + r]);
  o.w = pack2(tl[(c8 + 6) * 65 + r], tl[(c8 + 7) * 65 + r]);
  *(uint4*)(Wt + (size_t)(nt * 64 + r) * 1024 + kt * 64 + c8) = o;
  __syncthreads();
}

__device__ __forceinline__ void norm_rows(const bool F32OUT, const float* src, const float* __restrict__ g, void* dst, int nrows, float pd, int wv_, float* ssq_out = nullptr) {
#ifdef OFF_norm_rows
  return;
#endif

  const int tid = opaque_tid(wv_);
  const int lane = tid & 63;
  const int gw = blockIdx.x * 8 + (tid >> 6), nw = gridDim.x * 8;
  float4 gv[4];
#pragma unroll
  for (int i = 0; i < 4; ++i) gv[i] = ssq_out ? make_float4(1.f, 1.f, 1.f, 1.f) : *(const float4*)(g + i * 256 + lane * 4);
  for (int row = gw; row < nrows; row += nw) {
    const float* s = src + (size_t)row * 1024;
    float4 v[4]; float ss = 0.f;
#pragma unroll
    for (int i = 0; i < 4; ++i) { v[i] = *(const float4*)(s + i * 256 + lane * 4); ss += v[i].x * v[i].x + v[i].y * v[i].y + v[i].z * v[i].z + v[i].w * v[i].w; }
    ss = wave_sum(ss, lane);
    if (ssq_out) { if (lane == 0) ssq_out[row] = ss; }
    const float rs = ssq_out ? 1.0f : rsqrtf(ss * (1.0f / 1024.0f) + 1e-6f);
#pragma unroll
    for (int i = 0; i < 4; ++i) {
      const float a = v[i].x * rs * gv[i].x, b = v[i].y * rs * gv[i].y, c = v[i].z * rs * gv[i].z, d = v[i].w * rs * gv[i].w;
      if (F32OUT) { *(float4*)((float*)dst + (size_t)row * 1024 + i * 256 + lane * 4) = make_float4(a + pd, b + pd, c + pd, d + pd); }
      else { uint2 o; o.x = pack2(a, b); o.y = pack2(c, d); *(uint2*)((bf16_t*)dst + (size_t)row * 1024 + i * 256 + lane * 4) = o; }
    }
  }
}

__device__ __forceinline__ void rwkv_prep_item(KP P, int l, int item, unsigned char* lds, int wv_) {
#ifdef OFF_rwkv_prep_item
  return;
#endif

  const bf16_t* p = (const bf16_t*)(P->ws + WS_P);
  float* PW = (float*)(P->ws + WS_PW); bf16_t* PV = (bf16_t*)(P->ws + WS_PV); float* RK = (float*)(P->ws + WS_RK);
  float* lora = (float*)lds;
  const int tid = opaque_tid(wv_), lane = tid & 63, w = tid >> 6, head = w & 3, sub = w >> 2;
  const int c = head * 64 + lane;
  const float* mu = P->in[4] + l * 832;
  const float mur = mu[c], muk = mu[256 + c], muv = mu[512 + c], mux = mu[768 + lane];
  const float w0 = P->in[5][l * 256 + c], a0 = P->in[7][l * 256 + c];
  const float kkw = P->in[9][l * 256 + c], kaw = P->in[10][l * 256 + c], rkw = P->in[11][l * 256 + c];
  float wup[32], aup[32];
#pragma unroll
  for (int j = 0; j < 32; ++j) { wup[j] = P->in[6][(l * 32 + j) * 256 + c]; aup[j] = P->in[8][(l * 32 + j) * 256 + c]; }
  bf16_t raw[4][8];
#define PREP_LOAD(g) { _Pragma("unroll") for (int j_ = 0; j_ < 4; ++j_) { const int t_ = item * 32 + sub + 2 * ((g) * 4 + j_); const bool hp_ = (t_ & (TSEQ - 1)) > 0; \
      const bf16_t* pr_ = p + (size_t)t_ * NIN; raw[j_][0] = pr_[c]; raw[j_][1] = pr_[256 + c]; raw[j_][2] = pr_[512 + c]; raw[j_][3] = pr_[768 + lane]; \
      raw[j_][4] = hp_ ? pr_[c - NIN] : (bf16_t)0; raw[j_][5] = hp_ ? pr_[256 + c - NIN] : (bf16_t)0; raw[j_][6] = hp_ ? pr_[512 + c - NIN] : (bf16_t)0; raw[j_][7] = hp_ ? pr_[768 + lane - NIN] : (bf16_t)0; } }
  PREP_LOAD(0);
#pragma unroll 1
  for (int g = 0; g < 4; ++g) {
    float rr[4], kk4[4], vv4[4];
#pragma unroll
    for (int j = 0; j < 4; ++j) {
      float r = bf2f(raw[j][0]), k = bf2f(raw[j][1]), v = bf2f(raw[j][2]), x = bf2f(raw[j][3]);
      r += (bf2f(raw[j][4]) - r) * mur; k += (bf2f(raw[j][5]) - k) * muk; v += (bf2f(raw[j][6]) - v) * muv; x += (bf2f(raw[j][7]) - x) * mux;
      rr[j] = r; kk4[j] = k; vv4[j] = v;
      lora[(w * 4 + j) * 64 + lane] = lane < 32 ? (1.0f - 2.0f * __builtin_amdgcn_rcpf(1.0f + __expf(2.0f * x))) : x;
    }
    if (g < 3) PREP_LOAD(g + 1);
    __builtin_amdgcn_s_waitcnt(0xc07f);
    __builtin_amdgcn_wave_barrier();
    float wv4[4], av4[4];
#pragma unroll
    for (int j = 0; j < 4; ++j) { wv4[j] = w0; av4[j] = a0; }
#pragma unroll
    for (int jj = 0; jj < 32; jj += 4) {
#pragma unroll
      for (int j = 0; j < 4; ++j) { const float* lo = lora + (w * 4 + j) * 64; const float4 lw = *(const float4*)(lo + jj), la = *(const float4*)(lo + 32 + jj);
        wv4[j] += lw.x * wup[jj]; wv4[j] += lw.y * wup[jj + 1]; wv4[j] += lw.z * wup[jj + 2]; wv4[j] += lw.w * wup[jj + 3];
        av4[j] += la.x * aup[jj]; av4[j] += la.y * aup[jj + 1]; av4[j] += la.z * aup[jj + 2]; av4[j] += la.w * aup[jj + 3]; }
    }
    float dec4[4], ar4[4], kkq[4], kmod4[4], n24[4], rk4[4];
#pragma unroll
    for (int j = 0; j < 4; ++j) {
      const float wlog = -softplus_fast(-wv4[j]) - 0.5f;
      dec4[j] = __expf(-__expf(wlog));
      ar4[j] = sigmoidf_(av4[j]);
      kkq[j] = kk4[j] * kkw;
      kmod4[j] = kk4[j] * (1.0f + (ar4[j] - 1.0f) * kaw);
      n24[j] = kkq[j] * kkq[j]; rk4[j] = rr[j] * kmod4[j] * rkw;
    }
#pragma unroll
    for (int st = 0; st < 4; ++st) {
      const int ctrl = st == 0 ? 0xB1 : st == 1 ? 0x4E : st == 2 ? 0x141 : 0x140;
#pragma unroll
      for (int j = 0; j < 4; ++j) {
        if (st == 0) { n24[j] += __builtin_bit_cast(float, __builtin_amdgcn_update_dpp(0, __builtin_bit_cast(int, n24[j]), 0xB1, 0xF, 0xF, true)); rk4[j] += __builtin_bit_cast(float, __builtin_amdgcn_update_dpp(0, __builtin_bit_cast(int, rk4[j]), 0xB1, 0xF, 0xF, true)); }
        else if (st == 1) { n24[j] += __builtin_bit_cast(float, __builtin_amdgcn_update_dpp(0, __builtin_bit_cast(int, n24[j]), 0x4E, 0xF, 0xF, true)); rk4[j] += __builtin_bit_cast(float, __builtin_amdgcn_update_dpp(0, __builtin_bit_cast(int, rk4[j]), 0x4E, 0xF, 0xF, true)); }
        else if (st == 2) { n24[j] += __builtin_bit_cast(float, __builtin_amdgcn_update_dpp(0, __builtin_bit_cast(int, n24[j]), 0x141, 0xF, 0xF, true)); rk4[j] += __builtin_bit_cast(float, __builtin_amdgcn_update_dpp(0, __builtin_bit_cast(int, rk4[j]), 0x141, 0xF, 0xF, true)); }
        else { n24[j] += __builtin_bit_cast(float, __builtin_amdgcn_update_dpp(0, __builtin_bit_cast(int, n24[j]), 0x140, 0xF, 0xF, true)); rk4[j] += __builtin_bit_cast(float, __builtin_amdgcn_update_dpp(0, __builtin_bit_cast(int, rk4[j]), 0x140, 0xF, 0xF, true)); }
      }
      (void)ctrl;
    }
    { float t0[4], t1[4];
#pragma unroll
      for (int j = 0; j < 4; ++j) { t0[j] = bperm(n24[j], lane ^ 16); t1[j] = bperm(rk4[j], lane ^ 16); }
#pragma unroll
      for (int j = 0; j < 4; ++j) { n24[j] += t0[j]; rk4[j] += t1[j]; }
#pragma unroll
      for (int j = 0; j < 4; ++j) { t0[j] = bperm(n24[j], lane ^ 32); t1[j] = bperm(rk4[j], lane ^ 32); }
#pragma unroll
      for (int j = 0; j < 4; ++j) { n24[j] += t0[j]; rk4[j] += t1[j]; } }
#pragma unroll
    for (int j = 0; j < 4; ++j) {
      const int t = item * 32 + sub + 2 * (g * 4 + j);
      const int tt = t & (TSEQ - 1), b = t >> 13;
      const float kkn = kkq[j] * __builtin_amdgcn_rsqf(fmaxf(n24[j], 1e-24f));
      const size_t idx = (size_t)(b * 4 + head) * TSEQ + tt;
      PW[idx * 64 + lane] = dec4[j];
      bf16_t* pv = PV + idx * 320;
      pv[lane] = f2bf(rr[j]); pv[64 + lane] = f2bf(kmod4[j]); pv[128 + lane] = f2bf(vv4[j]); pv[192 + lane] = f2bf(-kkn); pv[256 + lane] = f2bf(kkn * ar4[j]);
      if (lane == 0) RK[idx] = rk4[j];
    }
    __builtin_amdgcn_s_waitcnt(0xc07f);
    __builtin_amdgcn_wave_barrier();
  }
#undef PREP_LOAD
  __syncthreads();
}

#define RW_TILE_B (RW_TT * 1536)
struct RwRegs { float4 pw; uint4 pv0, pv1; };
__device__ __forceinline__ void rw_issue(const float* __restrict__ PW, const bf16_t* __restrict__ PV, size_t idx0, int tid, RwRegs& r) {
  if (tid < RW_TT * 16) { const int s = tid >> 4, q = tid & 15; r.pw = *(const float4*)(PW + (idx0 + s) * 64 + q * 4); }
  { const int c = tid; const int s = c / 40, q = c % 40; r.pv0 = *(const uint4*)(PV + (idx0 + s) * 320 + q * 8); }
  if (tid < RW_TT * 40 - NTHR) { const int c = tid + NTHR; const int s = c / 40, q = c % 40; r.pv1 = *(const uint4*)(PV + (idx0 + s) * 320 + q * 8); }
}
__device__ __forceinline__ void rw_put(float* dst, int c, const uint4 u) {
  const int s = c / 40, q = c % 40;
  const int vec = q >> 3, off = (q & 7) * 8;
  const int slot = vec == 0 ? 4 : vec == 1 ? 3 : vec == 2 ? 5 : vec == 3 ? 1 : 2;
  float* d = dst + s * 384 + slot * 64 + off;
  *(float4*)d = make_float4(__uint_as_float(u.x << 16), __uint_as_float(u.x & 0xffff0000u), __uint_as_float(u.y << 16), __uint_as_float(u.y & 0xffff0000u));
  *(float4*)(d + 4) = make_float4(__uint_as_float(u.z << 16), __uint_as_float(u.z & 0xffff0000u), __uint_as_float(u.w << 16), __uint_as_float(u.w & 0xffff0000u));
}
__device__ __forceinline__ void rw_commit(unsigned char* dstb, int tid, const RwRegs& r) {
  float* dst = (float*)dstb;
  if (tid < RW_TT * 16) { const int s = tid >> 4, q = tid & 15; *(float4*)(dst + s * 384 + q * 4) = r.pw; }
  rw_put(dst, tid, r.pv0);
  if (tid < RW_TT * 40 - NTHR) rw_put(dst, tid + NTHR, r.pv1);
}

#define LD8(dst, ptr) { const float4 x0_ = *(const float4*)(ptr), x1_ = *(const float4*)((ptr) + 4); dst[0] = (f32x2){x0_.x, x0_.y}; dst[1] = (f32x2){x0_.z, x0_.w}; dst[2] = (f32x2){x1_.x, x1_.y}; dst[3] = (f32x2){x1_.z, x1_.w}; }
struct RwOps { f32x2 w[4], a[4], b[4], k[4], r[4]; float vA, vB; };
template <int MODE>
__device__ __forceinline__ void rw_ldops(RwOps& o, const float* tb, int s, int q, int rowA, int rowB) {
  const float* sp = tb + s * 384 + q * 8;
  LD8(o.w, sp); LD8(o.a, sp + 64); LD8(o.b, sp + 128); LD8(o.k, sp + 192);
  o.vA = tb[s * 384 + 320 + rowA];
  if (MODE == 0) { LD8(o.r, sp + 256); o.vB = tb[s * 384 + 320 + rowB]; }
}
template <int MODE>
__device__ __forceinline__ void rw_step(const RwOps& o, f32x2 (&SA)[4], f32x2 (&SB)[4], float* yb, int s, int q, int rowA, int rowB) {
  f32x2 dA = SA[0] * o.a[0], dB = SB[0] * o.a[0];
#pragma unroll
  for (int e = 1; e < 4; ++e) { dA = SA[e] * o.a[e] + dA; dB = SB[e] * o.a[e] + dB; }
  const float dotA = red8(dA.x + dA.y), dotB = red8(dB.x + dB.y);
  const f32x2 dA2 = {dotA, dotA}, dB2 = {dotB, dotB}, vA2 = {o.vA, o.vA};
  if (MODE == 0) {
    const f32x2 vB2 = {o.vB, o.vB};
#pragma unroll
    for (int e = 0; e < 4; ++e) { SA[e] = SA[e] * o.w[e] + vA2 * o.k[e]; SA[e] = dA2 * o.b[e] + SA[e]; SB[e] = SB[e] * o.w[e] + vB2 * o.k[e]; SB[e] = dB2 * o.b[e] + SB[e]; }
    f32x2 yA = SA[0] * o.r[0], yB = SB[0] * o.r[0];
#pragma unroll
    for (int e = 1; e < 4; ++e) { yA = SA[e] * o.r[e] + yA; yB = SB[e] * o.r[e] + yB; }
    const float ya = red8(yA.x + yA.y), ybv = red8(yB.x + yB.y);
    if (q == 0) { yb[s * 64 + rowA] = ya; yb[s * 64 + rowB] = ybv; }
  } else {
#pragma unroll
    for (int e = 0; e < 4; ++e) { SA[e] = dA2 * o.b[e] + SA[e] * o.w[e]; SB[e] = SB[e] * o.w[e] + vA2 * o.k[e]; SB[e] = dB2 * o.b[e] + SB[e]; }
  }
}
template <int MODE>
__device__ __forceinline__ void rwkv_scan_item(KP P, int l, int bh, int chunk, unsigned char* lds, int wv_) {
  const float* PW = (const float*)(P->ws + WS_PW); const bf16_t* PV = (const bf16_t*)(P->ws + WS_PV); const float* RK = (const float*)(P->ws + WS_RK);
  float* PQ = (float*)(P->ws + WS_PQ);
  bf16_t* p = (bf16_t*)(P->ws + WS_P);
  const int tid = opaque_tid(wv_), lane = tid & 63, w = tid >> 6;
  const int q = lane & 7;
  const int rowA = (MODE == 0) ? ((w & 3) * 16 + (lane >> 3)) : (w * 8 + (lane >> 3));
  const int rowB = rowA + 8;
  const int b = bh >> 2, head = bh & 3;
  unsigned char* tile0 = lds;
  float* ybuf = (float*)(lds + 3 * RW_TILE_B);
  float* Sl = (float*)(lds + 3 * RW_TILE_B + 2 * RW_TT * 256);
  f32x2 SA[4], SB[4];
#pragma unroll
  for (int e = 0; e < 4; ++e) { SA[e] = (f32x2){0.f, 0.f}; SB[e] = (f32x2){0.f, 0.f}; }
  if (MODE == 1) {
#pragma unroll
    for (int e = 0; e < 4; ++e) SA[e] = (f32x2){(q * 8 + 2 * e == rowA) ? 1.f : 0.f, (q * 8 + 2 * e + 1 == rowA) ? 1.f : 0.f};
  }
  if (MODE == 0 && chunk > 0) {
    const float* Q0 = PQ + ((size_t)(bh * RW_C + 0) * 2 + 1) * 4096;
    float* cur = Sl; float* nxt = Sl + 64 * 65;
    for (int i = tid; i < 1024; i += NTHR) { const float4 v_ = *(const float4*)(Q0 + i * 4); float* d_ = cur + (i >> 4) * 65 + (i & 15) * 4; d_[0] = v_.x; d_[1] = v_.y; d_[2] = v_.z; d_[3] = v_.w; }
    float* Pl = (float*)lds;
    const float4 z4_ = make_float4(0.f, 0.f, 0.f, 0.f); const f32x4 zq_ = {0.f, 0.f, 0.f, 0.f};
    float4 cs0p0 = z4_, cs0p1 = z4_, cs1p0 = z4_, cs1p1 = z4_, cs2p0 = z4_, cs2p1 = z4_, cs3p0 = z4_, cs3p1 = z4_;
    f32x4 cs0q0 = zq_, cs0q1 = zq_, cs1q0 = zq_, cs1q1 = zq_, cs2q0 = zq_, cs2q1 = zq_, cs3q0 = zq_, cs3q1 = zq_;
    const int ti = w >> 1;
    const int qoff0 = 4096 + (ti * 16 + (lane >> 4) * 4) * 64 + ((w & 1) * 2 + 0) * 16 + (lane & 15);
#define CS_LOAD(S_, c_) { const float* Pm_ = PQ + ((size_t)(bh * RW_C + (c_)) * 2 + 0) * 4096; S_##p0 = *(const float4*)(Pm_ + tid * 4); S_##p1 = *(const float4*)(Pm_ + (tid + NTHR) * 4); \
      S_##q0 = (f32x4){Pm_[qoff0], Pm_[qoff0 + 64], Pm_[qoff0 + 128], Pm_[qoff0 + 192]}; S_##q1 = (f32x4){Pm_[qoff0 + 16], Pm_[qoff0 + 80], Pm_[qoff0 + 144], Pm_[qoff0 + 208]}; }
#define CS_STEP(S_, c_) { LBAR(); *(float4*)(Pl + (tid >> 4) * 80 + (tid & 15) * 4) = S_##p0; *(float4*)(Pl + ((tid + NTHR) >> 4) * 80 + (tid & 15) * 4) = S_##p1; const f32x4 qc0 = S_##q0, qc1 = S_##q1; \
      if ((c_) + 4 < chunk) CS_LOAD(S_, (c_) + 4); \
      LBAR(); \
      _Pragma("unroll") for (int jj = 0; jj < 2; ++jj) { const int tj = (w & 1) * 2 + jj; f32x4 acc = jj == 0 ? qc0 : qc1; \
        _Pragma("unroll") for (int ks = 0; ks < 16; ++ks) { const float a = cur[(ti * 16 + (lane & 15)) * 65 + ks * 4 + (lane >> 4)]; const float bb = Pl[(ks * 4 + (lane >> 4)) * 80 + tj * 16 + (lane & 15)]; \
          acc = __builtin_amdgcn_mfma_f32_16x16x4f32(a, bb, acc, 0, 0, 0); } \
        _Pragma("unroll") for (int r = 0; r < 4; ++r) nxt[(ti * 16 + (lane >> 4) * 4 + r) * 65 + tj * 16 + (lane & 15)] = acc[r]; } \
      float* t_ = cur; cur = nxt; nxt = t_; }
    if (1 < chunk) CS_LOAD(cs0, 1);
    if (2 < chunk) CS_LOAD(cs1, 2);
    if (3 < chunk) CS_LOAD(cs2, 3);
    if (4 < chunk) CS_LOAD(cs3, 4);
#pragma unroll 1
    for (int cc = 1; cc < chunk; cc += 4) {
      CS_STEP(cs0, cc);
      if (cc + 1 < chunk) CS_STEP(cs1, cc + 1);
      if (cc + 2 < chunk) CS_STEP(cs2, cc + 2);
      if (cc + 3 < chunk) CS_STEP(cs3, cc + 3);
    }
#undef CS_LOAD
#undef CS_STEP
    __syncthreads();
#pragma unroll
    for (int e = 0; e < 4; ++e) { SA[e] = (f32x2){cur[rowA * 65 + q * 8 + 2 * e], cur[rowA * 65 + q * 8 + 2 * e + 1]}; SB[e] = (f32x2){cur[rowB * 65 + q * 8 + 2 * e], cur[rowB * 65 + q * 8 + 2 * e + 1]}; }
    __syncthreads();
  }
  const size_t idxb = (size_t)bh * TSEQ + (size_t)chunk * RW_CL;
  const int ntile = RW_CL / RW_TT;
  RwRegs rr;
  rw_issue(PW, PV, idxb, tid, rr);
  rw_commit(tile0, tid, rr);
  const int chh = head * 64 + lane;
  const float lng = P->in[12][l * 256 + chh], lnb = P->in[13][l * 256 + chh];
  __syncthreads();
  const int nit = (MODE == 0) ? ntile + 1 : ntile;
  for (int tl = 0; tl < nit; ++tl) {
    if (tl + 1 < ntile) rw_issue(PW, PV, idxb + (size_t)(tl + 1) * RW_TT, tid, rr);
    if (MODE == 1 || w < 4) {
      if (tl < ntile) {
        const float* tb = (const float*)(tile0 + (tl % 3) * RW_TILE_B);
        float* yb = ybuf + (tl & 1) * (RW_TT * 64);
        RwOps oa, ob;
        rw_ldops<MODE>(oa, tb, 0, q, rowA, rowB);
        __builtin_amdgcn_sched_barrier(0);
#pragma unroll 1
        for (int s = 0; s < RW_TT; s += 2) {
          rw_ldops<MODE>(ob, tb, s + 1, q, rowA, rowB);
          __builtin_amdgcn_sched_barrier(0);
          rw_step<MODE>(oa, SA, SB, yb, s, q, rowA, rowB);
          __builtin_amdgcn_sched_barrier(0);
          if (s + 2 < RW_TT) rw_ldops<MODE>(oa, tb, s + 2, q, rowA, rowB);
          __builtin_amdgcn_sched_barrier(0);
          rw_step<MODE>(ob, SA, SB, yb, s + 1, q, rowA, rowB);
          __builtin_amdgcn_sched_barrier(0);
        }
      }
      if (tl + 1 < ntile) rw_commit(tile0 + ((tl + 1) % 3) * RW_TILE_B, tid, rr);
    } else {
      const int fw = w - 4;
      f32x4 gcu = {0.f, 0.f, 0.f, 0.f}, rkcu = {0.f, 0.f, 0.f, 0.f};
      if (tl > 0) {
#pragma unroll
        for (int u = 0; u < 4; ++u) { const int tt = chunk * RW_CL + (tl - 1) * RW_TT + fw + 4 * u;
          gcu[u] = bf2f(p[(size_t)(b * TSEQ + tt) * NIN + C_GA + chh]); rkcu[u] = RK[(size_t)bh * TSEQ + tt]; }
      }
      asm volatile("s_waitcnt vmcnt(0)" ::: "memory");
      if (tl + 1 < ntile) rw_commit(tile0 + ((tl + 1) % 3) * RW_TILE_B, tid, rr);
      __builtin_amdgcn_sched_barrier(0);
      if (tl > 0) {
        const float* tb = (const float*)(tile0 + ((tl - 1) % 3) * RW_TILE_B);
        const float* yb = ybuf + ((tl - 1) & 1) * (RW_TT * 64);
#pragma unroll
        for (int u = 0; u < 4; ++u) {
          const int s = fw + 4 * u;
          const int tt = chunk * RW_CL + (tl - 1) * RW_TT + s;
          const float y = yb[s * 64 + lane];
          const float mean = wave_sum(y, lane) * (1.0f / 64.0f);
          const float dlt = y - mean;
          const float var = wave_sum(dlt * dlt, lane) * (1.0f / 64.0f);
          float o = dlt * rsqrtf(var + 64e-5f) * lng + lnb;
          const float vv = tb[s * 384 + 320 + lane];
          o += rkcu[u] * vv;
          p[(size_t)(b * TSEQ + tt) * NIN + C_GA + chh] = f2bf(o * siluf_(gcu[u]));
        }
      }
    }
    LBAR();
  }
  if (MODE == 1) {
    float* Pm = PQ + ((size_t)(bh * RW_C + chunk) * 2 + 0) * 4096 + rowA * 64 + q * 8;
    *(float4*)Pm = make_float4(SA[0].x, SA[0].y, SA[1].x, SA[1].y); *(float4*)(Pm + 4) = make_float4(SA[2].x, SA[2].y, SA[3].x, SA[3].y);
    *(float4*)(Pm + 4096) = make_float4(SB[0].x, SB[0].y, SB[1].x, SB[1].y); *(float4*)(Pm + 4100) = make_float4(SB[2].x, SB[2].y, SB[3].x, SB[3].y);
  } else if (chunk == 0 && w < 4) {
    float* Qm = PQ + ((size_t)(bh * RW_C + 0) * 2 + 1) * 4096 + q * 8;
    *(float4*)(Qm + rowA * 64) = make_float4(SA[0].x, SA[0].y, SA[1].x, SA[1].y); *(float4*)(Qm + rowA * 64 + 4) = make_float4(SA[2].x, SA[2].y, SA[3].x, SA[3].y);
    *(float4*)(Qm + rowB * 64) = make_float4(SB[0].x, SB[0].y, SB[1].x, SB[1].y); *(float4*)(Qm + rowB * 64 + 4) = make_float4(SB[2].x, SB[2].y, SB[3].x, SB[3].y);
  }
  __syncthreads();
}

__device__ __forceinline__ void conv_item(KP P, int l, int item, unsigned char* lds, int wv_) {
#ifdef OFF_conv_item
  return;
#endif

  bf16_t* p = (bf16_t*)(P->ws + WS_P);
  float* u = (float*)lds;
  float* yb = (float*)(lds + 62 * 1024);
  const int tid = opaque_tid(wv_), c = tid & 255, half = tid >> 8;
  const int t0 = item * 32, tt0 = t0 & (TSEQ - 1);
  {
    bf16_t rv[31], rg[31];
#pragma unroll
    for (int i = 0; i < 31; ++i) { const int r = half + 2 * i; const bool ok = (tt0 - 30 + r) >= 0; const bf16_t* pr = p + (size_t)(t0 - 30 + r) * NIN;
      rv[i] = ok ? pr[C_CVAL + c] : (bf16_t)0; rg[i] = ok ? pr[C_CGLU + c] : (bf16_t)0; }
#pragma unroll
    for (int i = 0; i < 31; ++i) u[(half + 2 * i) * 256 + c] = bf2f(rv[i]) * sigmoidf_(bf2f(rg[i]));
  }
  float wv[31];
#pragma unroll
  for (int j = 0; j < 31; ++j) wv[j] = P->in[14][(l * 31 + j) * 256 + c];
  const float bias = P->in[15][l * 256 + c];
  __syncthreads();
  {
    float win[46];
#pragma unroll
    for (int i = 0; i < 46; ++i) win[i] = u[(half * 16 + i) * 256 + c];
#pragma unroll
    for (int i = 0; i < 16; ++i) {
      float acc = bias;
#pragma unroll
      for (int j = 0; j < 31; ++j) acc = fmaf(wv[j], win[i + j], acc);
      yb[(half * 16 + i) * 256 + c] = acc;
    }
  }
  __syncthreads();
  const int lane = tid & 63, w = tid >> 6;
  const float4 g = *(const float4*)(P->in[16] + l * 256 + lane * 4), bb = *(const float4*)(P->in[17] + l * 256 + lane * 4);
  uint2 gpre[4];
#pragma unroll
  for (int i = 0; i < 4; ++i) gpre[i] = *(const uint2*)(p + (size_t)(t0 + w * 4 + i) * NIN + C_CGATE + lane * 4);
#pragma unroll
  for (int i = 0; i < 4; ++i) {
    const int tk = w * 4 + i;
    const float4 v = *(const float4*)(yb + tk * 256 + lane * 4);
    const float mean = wave_sum(v.x + v.y + v.z + v.w, lane) * (1.0f / 256.0f);
    const float d0 = v.x - mean, d1 = v.y - mean, d2 = v.z - mean, d3 = v.w - mean;
    const float var = wave_sum(d0 * d0 + d1 * d1 + d2 * d2 + d3 * d3, lane) * (1.0f / 256.0f);
    const float rs = rsqrtf(var + 1e-5f);
    bf16_t* gp = p + (size_t)(t0 + tk) * NIN + C_CGATE + lane * 4;
    const uint2 gu = gpre[i];
    const float o0 = siluf_(d0 * rs * g.x + bb.x) * siluf_(__uint_as_float(gu.x << 16));
    const float o1 = siluf_(d1 * rs * g.y + bb.y) * siluf_(__uint_as_float(gu.x & 0xffff0000u));
    const float o2 = siluf_(d2 * rs * g.z + bb.z) * siluf_(__uint_as_float(gu.y << 16));
    const float o3 = siluf_(d3 * rs * g.w + bb.w) * siluf_(__uint_as_float(gu.y & 0xffff0000u));
    uint2 o; o.x = pack2(o0, o1); o.y = pack2(o2, o3);
    *(uint2*)gp = o;
  }
  __syncthreads();
}

#define HG_WLDS 10240
__device__ __forceinline__ float hgrn_lb(KP P, int l, int ch) {
  if (l == 0) return 0.f;
  const float x0 = P->in[18][ch], x1 = P->in[18][256 + ch];
  return __builtin_amdgcn_rcpf(1.0f + __expf(x0 - x1));
}
template <int PASS>
__device__ __forceinline__ void hgrn_wave_item(KP P, int l, int wi, unsigned char* lds, int wv_) {
#ifdef OFF_hgrn_wave_item
  return;
#endif

  bf16_t* p = (bf16_t*)(P->ws + WS_P);
  float* HS = (float*)(P->ws + WS_HS); float* HF = (float*)(P->ws + WS_HF);
  const int tid = opaque_tid(wv_);
  const int lane = tid & 63, w = tid >> 6;
  const int bh = wi >> 7, chunk = wi & 127, b = bh >> 2, head = bh & 3;
  float* st = (float*)(lds + w * HG_WLDS);
  float* ob = st + 2048;
  const int kg = lane & 7, vg = lane >> 3;
  const int ch = head * 64 + lane;
  const float lb = hgrn_lb(P, l, ch);
  const float ng = P->in[19][l * 256 + ch];
  float S[8][8];
  float* slot = HS + (size_t)(bh * 128 + chunk) * 4096;
  if (PASS == 1) {
#pragma unroll
    for (int i = 0; i < 8; ++i) { const float4 x0 = *(const float4*)(slot + (kg * 8 + i) * 64 + vg * 8), x1 = *(const float4*)(slot + (kg * 8 + i) * 64 + vg * 8 + 4);
      S[i][0] = x0.x; S[i][1] = x0.y; S[i][2] = x0.z; S[i][3] = x0.w; S[i][4] = x1.x; S[i][5] = x1.y; S[i][6] = x1.z; S[i][7] = x1.w; }
  } else {
#pragma unroll
    for (int i = 0; i < 8; ++i)
#pragma unroll
      for (int j = 0; j < 8; ++j) S[i][j] = 0.f;
  }
  float Fp = 1.f;
  bf16_t rf[8], ri[8], rq[8], rg[8];
  {
    const int tb0 = b * TSEQ + chunk * 64;
#pragma unroll
    for (int s = 0; s < 8; ++s) { const bf16_t* pr = p + (size_t)(tb0 + s) * NIN; rf[s] = pr[C_HF + ch]; ri[s] = pr[C_HI + ch]; if (PASS == 1) { rq[s] = pr[C_HQ + ch]; rg[s] = pr[C_HG + ch]; } }
  }
#pragma unroll 1
  for (int sub = 0; sub < 8; ++sub) {
    const int tbase = b * TSEQ + chunk * 64 + sub * 8;
    bf16_t gc[8];
#pragma unroll
    for (int s = 0; s < 8; ++s) {
      const float f = lb + (1.0f - lb) * sigmoidf_(bf2f(rf[s]));
      Fp *= f;
      st[s * 256 + lane] = f; st[s * 256 + 64 + lane] = 1.0f - f;
      if (PASS == 1) { st[s * 256 + 128 + lane] = siluf_(bf2f(rq[s])); gc[s] = rg[s]; }
      st[s * 256 + 192 + lane] = bf2f(ri[s]);
    }
    if (sub < 7) {
#pragma unroll
      for (int s = 0; s < 8; ++s) { const bf16_t* pr = p + (size_t)(tbase + 8 + s) * NIN; rf[s] = pr[C_HF + ch]; ri[s] = pr[C_HI + ch]; if (PASS == 1) { rq[s] = pr[C_HQ + ch]; rg[s] = pr[C_HG + ch]; } }
    }
    __builtin_amdgcn_s_waitcnt(0xc07f);
    __builtin_amdgcn_wave_barrier();
#pragma unroll 1
    for (int s = 0; s < 8; ++s) {
      const float* sp = st + s * 256;
      const float4 f0 = *(const float4*)(sp + kg * 8), f1 = *(const float4*)(sp + kg * 8 + 4);
      const float4 k0 = *(const float4*)(sp + 64 + kg * 8), k1 = *(const float4*)(sp + 64 + kg * 8 + 4);
      const float4 v0 = *(const float4*)(sp + 192 + vg * 8), v1 = *(const float4*)(sp + 192 + vg * 8 + 4);
      const float fv[8] = {f0.x, f0.y, f0.z, f0.w, f1.x, f1.y, f1.z, f1.w};
      const float kv[8] = {k0.x, k0.y, k0.z, k0.w, k1.x, k1.y, k1.z, k1.w};
      const float vv[8] = {v0.x, v0.y, v0.z, v0.w, v1.x, v1.y, v1.z, v1.w};
      const f32x2 vv2[4] = {{vv[0], vv[1]}, {vv[2], vv[3]}, {vv[4], vv[5]}, {vv[6], vv[7]}};
#pragma unroll
      for (int i = 0; i < 8; ++i) { const f32x2 f2 = {fv[i], fv[i]}, k2 = {kv[i], kv[i]};
#pragma unroll
        for (int j = 0; j < 4; ++j) { f32x2 s2 = {S[i][2 * j], S[i][2 * j + 1]}; s2 = f2 * s2 + k2 * vv2[j]; S[i][2 * j] = s2.x; S[i][2 * j + 1] = s2.y; } }
      if (PASS == 1) {
        const float4 q0 = *(const float4*)(sp + 128 + kg * 8), q1 = *(const float4*)(sp + 128 + kg * 8 + 4);
        const float qv[8] = {q0.x, q0.y, q0.z, q0.w, q1.x, q1.y, q1.z, q1.w};
        float o[8];
#pragma unroll
        for (int j = 0; j < 4; ++j) { f32x2 a2 = (f32x2){qv[0], qv[0]} * (f32x2){S[0][2 * j], S[0][2 * j + 1]};
#pragma unroll
          for (int i = 1; i < 8; ++i) a2 = (f32x2){qv[i], qv[i]} * (f32x2){S[i][2 * j], S[i][2 * j + 1]} + a2;
          o[2 * j] = red8(a2.x); o[2 * j + 1] = red8(a2.y); }
        if (kg == 0) { *(float4*)(ob + s * 64 + vg * 8) = make_float4(o[0], o[1], o[2], o[3]); *(float4*)(ob + s * 64 + vg * 8 + 4) = make_float4(o[4], o[5], o[6], o[7]); }
      }
    }
    __builtin_amdgcn_s_waitcnt(0xc07f);
    __builtin_amdgcn_wave_barrier();
    if (PASS == 1) {
#pragma unroll
      for (int s = 0; s < 8; ++s) {
        const float o = ob[s * 64 + lane];
        const float ms = wave_sum(o * o, lane) * (1.0f / 64.0f);
        p[(size_t)(tbase + s) * NIN + C_HG + ch] = f2bf(o * rsqrtf(ms + 1e-6f) * ng * siluf_(bf2f(gc[s])));
      }
      __builtin_amdgcn_s_waitcnt(0xc07f);
      __builtin_amdgcn_wave_barrier();
    }
  }
  if (PASS == 0) {
#pragma unroll
    for (int i = 0; i < 8; ++i) { *(float4*)(slot + (kg * 8 + i) * 64 + vg * 8) = make_float4(S[i][0], S[i][1], S[i][2], S[i][3]);
      *(float4*)(slot + (kg * 8 + i) * 64 + vg * 8 + 4) = make_float4(S[i][4], S[i][5], S[i][6], S[i][7]); }
    HF[(size_t)(bh * 128 + chunk) * 64 + lane] = Fp;
  }
}
__device__ __forceinline__ void hgrn_combine_item(KP P, int bh, int wv_) {
#ifdef OFF_hgrn_combine_item
  return;
#endif

  float* HS = (float*)(P->ws + WS_HS); const float* HF = (const float*)(P->ws + WS_HF);
  const int tid = opaque_tid(wv_);
  const int krow = tid >> 3;
  float R[8];
#pragma unroll
  for (int e = 0; e < 8; ++e) R[e] = 0.f;
  float4 xa[8][2]; float fa[8];
#pragma unroll
  for (int u = 0; u < 8; ++u) { const float* sl = HS + (size_t)(bh * 128 + u) * 4096 + tid * 8; xa[u][0] = *(const float4*)sl; xa[u][1] = *(const float4*)(sl + 4); fa[u] = HF[(size_t)(bh * 128 + u) * 64 + krow]; }
#pragma unroll 1
  for (int c0 = 0; c0 < 128; c0 += 8) {
    float4 xn[8][2]; float fn[8];
    if (c0 + 8 < 128) {
#pragma unroll
      for (int u = 0; u < 8; ++u) { const float* sl = HS + (size_t)(bh * 128 + c0 + 8 + u) * 4096 + tid * 8; xn[u][0] = *(const float4*)sl; xn[u][1] = *(const float4*)(sl + 4); fn[u] = HF[(size_t)(bh * 128 + c0 + 8 + u) * 64 + krow]; }
    }
#pragma unroll
    for (int u = 0; u < 8; ++u) {
      float* sl = HS + (size_t)(bh * 128 + c0 + u) * 4096 + tid * 8;
      *(float4*)sl = make_float4(R[0], R[1], R[2], R[3]); *(float4*)(sl + 4) = make_float4(R[4], R[5], R[6], R[7]);
      const float f = fa[u];
      R[0] = fmaf(f, R[0], xa[u][0].x); R[1] = fmaf(f, R[1], xa[u][0].y); R[2] = fmaf(f, R[2], xa[u][0].z); R[3] = fmaf(f, R[3], xa[u][0].w);
      R[4] = fmaf(f, R[4], xa[u][1].x); R[5] = fmaf(f, R[5], xa[u][1].y); R[6] = fmaf(f, R[6], xa[u][1].z); R[7] = fmaf(f, R[7], xa[u][1].w);
    }
    if (c0 + 8 < 128) {
#pragma unroll
      for (int u = 0; u < 8; ++u) { xa[u][0] = xn[u][0]; xa[u][1] = xn[u][1]; fa[u] = fn[u]; }
    }
  }
}

__device__ __forceinline__ void sb_item(KP P, int item, unsigned char* lds, int wv_) {
#ifdef OFF_sb_item
  return;
#endif

  bf16_t* p = (bf16_t*)(P->ws + WS_P);
  const int tid = opaque_tid(wv_), lane = tid & 63, w = tid >> 6;
  const int qt = item & 127, bh = item >> 7, b = bh >> 2, head = bh & 3;
  unsigned char* Qs = lds;
  unsigned char* Ks = lds + 9216;
  unsigned char* Vt = lds + 18432;
  unsigned char* As = lds + 27648;
  float* Zs = (float*)(lds + 36864);
  volatile int* flag = (volatile int*)(lds + 36864 + 64 * 65 * 4);
  const int lrow = tid >> 3, lch = (tid & 7);
  const size_t tokq = (size_t)b * TSEQ + qt * 64;
  *(uint4*)(Qs + lrow * 144 + lch * 16) = *(const uint4*)(p + (tokq + lrow) * NIN + C_SQ + head * 64 + lch * 8);
  float carry = 0.f;
  f32x4 oacc[2] = {{0.f, 0.f, 0.f, 0.f}, {0.f, 0.f, 0.f, 0.f}};
  const int qi = w >> 1, t2 = (w & 1) * 2;
  f32x4 gpre0, gpre1;
#pragma unroll
  for (int r = 0; r < 4; ++r) { const bf16_t* gp_ = p + (tokq + qi * 16 + (lane >> 4) * 4 + r) * NIN + C_SG + head * 64 + t2 * 16 + (lane & 15); gpre0[r] = bf2f(gp_[0]); gpre1[r] = bf2f(gp_[16]); }
  const int q = tid >> 3, seg = tid & 7;
  uint4 kreg = *(const uint4*)(p + (tokq + lrow) * NIN + C_SK + head * 64 + lch * 8);
  const int vkey = tid & 63, vch = tid >> 6;
  uint4 vreg = *(const uint4*)(p + (tokq + vkey) * NIN + C_SV + head * 64 + vch * 8);
  for (int kt = qt; kt >= 0; --kt) {
    LBAR();
    *(uint4*)(Ks + lrow * 144 + lch * 16) = kreg;
    { const unsigned vw[4] = {vreg.x, vreg.y, vreg.z, vreg.w};
#pragma unroll
      for (int e = 0; e < 8; ++e) *(unsigned short*)(Vt + (vch * 8 + e) * 144 + vkey * 2) = (unsigned short)((e & 1) ? (vw[e >> 1] >> 16) : (vw[e >> 1] & 0xffffu)); }
    if (tid == 0) *flag = 0;
    if (kt > 0) { const size_t tokn = (size_t)b * TSEQ + (kt - 1) * 64;
      kreg = *(const uint4*)(p + (tokn + lrow) * NIN + C_SK + head * 64 + lch * 8);
      vreg = *(const uint4*)(p + (tokn + vkey) * NIN + C_SV + head * 64 + vch * 8); }
    LBAR();
#pragma unroll
    for (int jj = 0; jj < 2; ++jj) {
      const int ki = t2 + jj;
      f32x4 acc = {0.f, 0.f, 0.f, 0.f};
#pragma unroll
      for (int s = 0; s < 2; ++s) {
        const bf16x8 a = *(const bf16x8*)(Qs + (qi * 16 + (lane & 15)) * 144 + s * 64 + (lane >> 4) * 16);
        const bf16x8 bb = *(const bf16x8*)(Ks + (ki * 16 + (lane & 15)) * 144 + s * 64 + (lane >> 4) * 16);
        acc = __builtin_amdgcn_mfma_f32_16x16x32_bf16(a, bb, acc, 0, 0, 0);
      }
#pragma unroll
      for (int r = 0; r < 4; ++r) Zs[(qi * 16 + (lane >> 4) * 4 + r) * 65 + ki * 16 + (lane & 15)] = acc[r] * 0.125f;
    }
    LBAR();
    {
      const int tq = qt * 64 + q;
      float z[8], lk[8];
      float tot = 0.f;
#pragma unroll
      for (int e = 0; e < 8; ++e) {
        z[e] = Zs[q * 65 + seg * 8 + e];
        const bool m = (kt * 64 + seg * 8 + e) < tq;
        lk[e] = m ? -softplus_fast(z[e]) : 0.f;
        tot += lk[e];
      }
      float inc = tot;
      { float t_ = __builtin_bit_cast(float, __builtin_amdgcn_update_dpp(0, __builtin_bit_cast(int, inc), 0x101, 0xF, 0xF, true)); if (seg + 1 < 8) inc += t_; }
      { float t_ = __builtin_bit_cast(float, __builtin_amdgcn_update_dpp(0, __builtin_bit_cast(int, inc), 0x102, 0xF, 0xF, true)); if (seg + 2 < 8) inc += t_; }
      { float t_ = __builtin_bit_cast(float, __builtin_amdgcn_update_dpp(0, __builtin_bit_cast(int, inc), 0x104, 0xF, 0xF, true)); if (seg + 4 < 8) inc += t_; }
      const float rowtot = red8(tot);
      float tail = carry + (inc - tot);
      float av[8];
#pragma unroll
      for (int e = 7; e >= 0; --e) {
        const bool m = (kt * 64 + seg * 8 + e) < tq;
        av[e] = m ? __expf(z[e] + lk[e] + tail) : 0.f;
        tail += lk[e];
      }
      uint4 o; o.x = pack2(av[0], av[1]); o.y = pack2(av[2], av[3]); o.z = pack2(av[4], av[5]); o.w = pack2(av[6], av[7]);
      *(uint4*)(As + q * 144 + seg * 16) = o;
      carry += rowtot;
      if (carry > -100.f) *flag = 1;
    }
    LBAR();
#pragma unroll
    for (int jj = 0; jj < 2; ++jj) {
      const int di = t2 + jj;
#pragma unroll
      for (int s = 0; s < 2; ++s) {
        const bf16x8 a = *(const bf16x8*)(As + (qi * 16 + (lane & 15)) * 144 + s * 64 + (lane >> 4) * 16);
        const bf16x8 bb = *(const bf16x8*)(Vt + (di * 16 + (lane & 15)) * 144 + s * 64 + (lane >> 4) * 16);
        oacc[jj] = __builtin_amdgcn_mfma_f32_16x16x32_bf16(a, bb, oacc[jj], 0, 0, 0);
      }
    }
    if (*flag == 0) break;
  }
#pragma unroll
  for (int jj = 0; jj < 2; ++jj) {
    const int d = (t2 + jj) * 16 + (lane & 15);
#pragma unroll
    for (int r = 0; r < 4; ++r) {
      const int qq = qi * 16 + (lane >> 4) * 4 + r;
      bf16_t* gp = p + (tokq + qq) * NIN + C_SG + head * 64 + d;
      *gp = f2bf(oacc[jj][r] * siluf_(jj == 0 ? gpre0[r] : gpre1[r]));
    }
  }
  __syncthreads();
}

__device__ __forceinline__ void xattn_item(KP P, int l, int item, unsigned char* lds, int wv_) {
  const bf16_t* qb = (const bf16_t*)(P->ws + WS_P + 32ull * MiB);
  bf16_t* ob = (bf16_t*)(P->ws + WS_P + 64ull * MiB);
  const bf16_t* kv = (const bf16_t*)(P->ws + WS_KV) + (size_t)l * 512 * 2048;
  const bf16_t* vt = (const bf16_t*)(P->ws + WS_VT) + (size_t)l * 2 * 1024 * 256;
  const int tid = opaque_tid(wv_), lane = tid & 63, w = tid >> 6;
  const int qt = item & 127, bh = item >> 7, b = bh >> 2, head = bh & 3;
  unsigned char* Qs = lds;
  unsigned char* KVs = lds + 33792;
  float* Ss = (float*)(lds + 67584);
  const size_t tok0 = (size_t)b * TSEQ + qt * 64;
  const int pr = tid >> 5, pc = tid & 31;
  uint4 pg0, pg1, pg2, pg3;
#define XA_LOAD(p_) { const bf16_t* s_ = (p_) < 4 ? kv + (size_t)(b * 256 + (p_) * 64 + pr) * 2048 + head * 256 + pc * 8 : vt + (size_t)(b * 1024 + head * 256 + ((p_) - 4) * 64 + pr) * 256 + pc * 8; \
      const size_t st_ = (p_) < 4 ? (size_t)16 * 2048 : (size_t)16 * 256; \
      pg0 = *(const uint4*)(s_); pg1 = *(const uint4*)(s_ + st_); pg2 = *(const uint4*)(s_ + 2 * st_); pg3 = *(const uint4*)(s_ + 3 * st_); }
  __syncthreads();
#pragma unroll
  for (int i = 0; i < 4; ++i) { const int r = pr + 16 * i; *(uint4*)(Qs + r * 528 + pc * 16) = *(const uint4*)(qb + (tok0 + r) * 1024 + head * 256 + pc * 8); }
  XA_LOAD(0);
  const int qi = w >> 1, t2 = (w & 1) * 2;
#pragma unroll 1
  for (int p = 0; p < 8; ++p) {
    LBAR();
    { unsigned char* d_ = KVs + pr * 528 + pc * 16; *(uint4*)d_ = pg0; *(uint4*)(d_ + 16 * 528) = pg1; *(uint4*)(d_ + 32 * 528) = pg2; *(uint4*)(d_ + 48 * 528) = pg3; }
    if (p < 7) XA_LOAD(p + 1);
    LBAR();
    f32x4 acc0 = {0.f, 0.f, 0.f, 0.f}, acc1 = {0.f, 0.f, 0.f, 0.f};
#pragma unroll
    for (int s = 0; s < 8; ++s) {
      const bf16x8 a = *(const bf16x8*)(Qs + (qi * 16 + (lane & 15)) * 528 + s * 64 + (lane >> 4) * 16);
      const bf16x8 b0 = *(const bf16x8*)(KVs + (t2 * 16 + (lane & 15)) * 528 + s * 64 + (lane >> 4) * 16);
      const bf16x8 b1 = *(const bf16x8*)(KVs + ((t2 + 1) * 16 + (lane & 15)) * 528 + s * 64 + (lane >> 4) * 16);
      acc0 = __builtin_amdgcn_mfma_f32_16x16x32_bf16(a, b0, acc0, 0, 0, 0);
      acc1 = __builtin_amdgcn_mfma_f32_16x16x32_bf16(a, b1, acc1, 0, 0, 0);
    }
    if (p < 4) {
#pragma unroll
      for (int r = 0; r < 4; ++r) { float* d_ = Ss + (qi * 16 + (lane >> 4) * 4 + r) * 260 + p * 64 + t2 * 16 + (lane & 15); d_[0] = acc0[r] * 0.0625f; d_[16] = acc1[r] * 0.0625f; }
      if (p == 3) {
        LBAR();
        const int q = tid >> 3, seg = tid & 7;
        float x[32]; float mx = -3.0e38f;
#pragma unroll
        for (int i = 0; i < 8; ++i) { const float4 v = *(const float4*)(Ss + q * 260 + seg * 32 + i * 4); x[i * 4] = v.x; x[i * 4 + 1] = v.y; x[i * 4 + 2] = v.z; x[i * 4 + 3] = v.w;
          mx = fmaxf(mx, fmaxf(fmaxf(v.x, v.y), fmaxf(v.z, v.w))); }
        mx = max8(mx);
        float sum = 0.f;
#pragma unroll
        for (int i = 0; i < 32; ++i) { x[i] = __expf(x[i] - mx); sum += x[i]; }
        sum = red8(sum);
        const float inv = __builtin_amdgcn_rcpf(sum);
#pragma unroll
        for (int i = 0; i < 4; ++i) { uint4 o; o.x = pack2(x[i * 8] * inv, x[i * 8 + 1] * inv); o.y = pack2(x[i * 8 + 2] * inv, x[i * 8 + 3] * inv);
          o.z = pack2(x[i * 8 + 4] * inv, x[i * 8 + 5] * inv); o.w = pack2(x[i * 8 + 6] * inv, x[i * 8 + 7] * inv);
          *(uint4*)(Qs + q * 528 + seg * 64 + i * 16) = o; }
      }
    } else {
#pragma unroll
      for (int r = 0; r < 4; ++r) { bf16_t* d_ = ob + (tok0 + qi * 16 + (lane >> 4) * 4 + r) * 1024 + head * 256 + (p - 4) * 64 + t2 * 16 + (lane & 15); d_[0] = f2bf(acc0[r]); d_[16] = f2bf(acc1[r]); }
    }
  }
#undef XA_LOAD
  __syncthreads();
}

__device__ __forceinline__ void wt_item(KP P, int l, int r, unsigned char* lds, int wv_) {
  const float* W; int N; bf16_t* Wt; int kt, nt; const float* gk = nullptr;
  unsigned char* wl = P->ws + WS_WT + l * WT_LAYER;
  if (r < 976) { W = P->in[3] + (size_t)l * 1024 * NIN; N = NIN; Wt = (bf16_t*)(wl + WT_IN); kt = r / 61; nt = r % 61; gk = P->in[2] + l * 1024; }
  else { r -= 976; const int m = r >> 8; r &= 255; kt = r >> 4; nt = r & 15; N = 1024;
    if (m == 0) { W = P->in[20] + (size_t)l * 1048576; Wt = (bf16_t*)(wl + WT_OUT); }
    else if (m == 1) { W = P->in[23] + (size_t)l * 1048576; Wt = (bf16_t*)(wl + WT_Q); gk = P->in[21] + l * 1024; }
    else if (m == 2) { W = P->in[24] + (size_t)l * 1048576; Wt = (bf16_t*)(wl + WT_KV); }
    else if (m == 3) { W = P->in[25] + (size_t)l * 1048576; Wt = (bf16_t*)(wl + WT_KV) + 1024 * 1024; }
    else { W = P->in[26] + (size_t)l * 1048576; Wt = (bf16_t*)(wl + WT_O); } }
  wt_tile(W, N, Wt, kt, nt, lds, wv_, gk);
}
__device__ __forceinline__ void wt_deferred(KP P, int d, unsigned char* lds, int wv_) {
  if (d < 768) { const int m = d >> 8, r = d & 255; wt_item(P, 0, 976 + (m == 0 ? 0 : m == 1 ? 256 : 1024) + r, lds, wv_); }
  else wt_item(P, 1, d - 768, lds, wv_);
}
__device__ __forceinline__ int next_item(unsigned* ctr, volatile LAS int* slot, int wv_) {
  __syncthreads();
  if (opaque_tid(wv_) == 0) *slot = (int)__hip_atomic_fetch_add(ctr, 1u, __ATOMIC_RELAXED, __HIP_MEMORY_SCOPE_AGENT);
  __syncthreads();
  return *slot;
}
__global__ void __launch_bounds__(NTHR) fwd_megakernel(Params Pk_unused) {
  KP P = (KP)__builtin_amdgcn_kernarg_segment_ptr();
  extern __shared__ __attribute__((aligned(16))) unsigned char lds[];
  const int wv_ = __builtin_amdgcn_readfirstlane((int)threadIdx.x >> 6);
  __shared__ uint4 xb_words;
  __shared__ int4 wq_slot;
  if (opaque_tid(wv_) == 0) xb_words = make_uint4(0u, 0u, 0u, 0u);
  __syncthreads();
#ifdef PROBE_J
  __shared__ unsigned long long tacc[32];
  __shared__ unsigned long long tlast;
  __shared__ float pdelta;
  if (opaque_tid(wv_) == 0) { for (int i = 0; i < 32; ++i) tacc[i] = 0ull; tlast = __builtin_amdgcn_s_memrealtime(); pdelta = 0.f; }
#define STAMP(k) if (opaque_tid(wv_) == 0) { const unsigned long long n_ = __builtin_amdgcn_s_memrealtime(); tacc[k] += n_ - tlast; tlast = n_; }
#else
#define STAMP(k)
#endif
  XcdBarrier bar = xcd_barrier_post((unsigned*)(P->ws + WS_BAR), (volatile LAS unsigned*)&xb_words, wv_);
  if (P->never) cg::this_grid().sync();
  const int G = gridDim.x, bid0 = blockIdx.x;

  for (int it = bid0; it < 976 + 512; it += G) wt_item(P, 0, it < 976 ? it : it + 512, lds, wv_);
#pragma unroll 1
  for (int k = 0; k < 3; ++k) {
    const float* s_ = k < 2 ? P->in[1] : P->in[0];
    const float* g_ = k < 2 ? P->in[22] + k * 1024 : P->in[2];
    bf16_t* d_ = k < 2 ? (bf16_t*)(P->ws + WS_MEMN) + k * 512 * 1024 : (bf16_t*)(P->ws + WS_R1);
    norm_rows(false, s_, g_, d_, k < 2 ? 512 : NT, 0.f, wv_, k < 2 ? nullptr : (float*)(P->ws + WS_SSQ));
  }
  { float* z_ = (float*)(P->ws + WS_SSQ) + NT; for (int i = bid0 * NTHR + opaque_tid(wv_); i < 4 * NT; i += G * NTHR) z_[i] = 0.f; }
  STAMP(16 + 10); xcd_barrier(bar, wv_); STAMP(10)
  asm volatile("" : "+s"(P));

#pragma unroll 1
  for (int it = 0; it < 17; ++it) {
    int l = it >> 3, ph = it & 7;
    ph = ph < 5 ? ph : ph + 1;
    if (it == 16) { l = 1; ph = 9; }
    asm volatile("" : "+s"(P));
    int bid = bid0; asm volatile("" : "+s"(bid));

    unsigned char* ws = P->ws;
    const unsigned char* wl = ws + WS_WT + l * WT_LAYER;
    bf16_t* hbuf = (bf16_t*)(ws + WS_R1);
    float* ssq = (float*)(ws + WS_SSQ);
    bf16_t* pbuf = (bf16_t*)(ws + WS_P);
    bf16_t* hx = (bf16_t*)(ws + WS_P);
    bf16_t* qbuf = (bf16_t*)(ws + WS_P + 32ull * MiB);
    bf16_t* obuf = (bf16_t*)(ws + WS_P + 64ull * MiB);
    if (ph == 0 || ph == 4 || ph == 6 || ph == 8) {
      pg8::Gemm g; pg8::TileSched S; pg8::EpiDyn E;
      g.M = NT; g.K = 1024; S.G = G; S.c = bid;
      if (ph == 0) { g.A = hbuf; g.Bt = (const bf16_t*)(wl + WT_IN); g.N = 4096; g.lda = 1024; g.ao0 = 0; g.ao1 = 256; g.ao2 = 512; g.ao3 = 768; S.nt = 1024; S.nN = 16;
        E.mode = 0; E.O = pbuf; E.ldc = NIN; E.N = NIN; E.resid = nullptr; E.out = nullptr; E.ssq_in = ssq + (l == 0 ? 0 : 2) * NT; E.xb = nullptr; E.ssq_out = nullptr; }
      else if (ph == 4) { g.A = pbuf; g.Bt = (const bf16_t*)(wl + WT_OUT); g.N = 1024; g.lda = NIN; g.ao0 = C_GA; g.ao1 = C_CGATE; g.ao2 = C_HG; g.ao3 = C_SG; S.nt = 256; S.nN = 4;
        E.mode = 1; E.O = nullptr; E.ldc = 1024; E.N = 1024; E.resid = (l == 0) ? P->in[0] : P->out; E.out = P->out; E.ssq_in = nullptr; E.xb = hbuf; E.ssq_out = ssq + (l == 0 ? 1 : 3) * NT; }
      else if (ph == 6) { g.A = hbuf; g.Bt = (const bf16_t*)(wl + WT_Q); g.N = 1024; g.lda = 1024; g.ao0 = 0; g.ao1 = 256; g.ao2 = 512; g.ao3 = 768; S.nt = 256; S.nN = 4;
        E.mode = 0; E.O = qbuf; E.ldc = 1024; E.N = 1024; E.resid = nullptr; E.out = nullptr; E.ssq_in = ssq + (l == 0 ? 1 : 3) * NT; E.xb = nullptr; E.ssq_out = nullptr; }
      else { g.A = obuf; g.Bt = (const bf16_t*)(wl + WT_O); g.N = 1024; g.lda = 1024; g.ao0 = 0; g.ao1 = 256; g.ao2 = 512; g.ao3 = 768; S.nt = 256; S.nN = 4;
        E.mode = 1; E.O = nullptr; E.ldc = 1024; E.N = 1024; E.resid = P->out; E.out = P->out; E.ssq_in = nullptr; E.xb = hbuf; E.ssq_out = ssq + (l == 0 ? 2 : 4) * NT; }
      pg8::gemm_phase<pg8::EpiDyn, pg8::TileSched, true, true>((PG8_LAS unsigned char*)lds, g, S, E, wv_);
    } else if (ph == 1) {
      unsigned* ctr = (unsigned*)(ws + WS_BAR) + it;
      for (;;) {
        const int i2 = next_item(ctr, (volatile LAS int*)&wq_slot, wv_);
        if (i2 >= 640) break;
        if (i2 < 128) hgrn_wave_item<0>(P, l, i2 * 8 + wv_, lds, wv_);
        else rwkv_prep_item(P, l, i2 - 128, lds, wv_);
      }
    } else if (ph == 2) {
      const int n_p1 = 8 * (RW_C - 2);
      const int n_rw = n_p1 + 8;
      const int n_oth = 8 + 512 + 1024;
      for (int i2 = bid; i2 < n_rw; i2 += G) {
        if (i2 < n_p1) rwkv_scan_item<1>(P, l, i2 & 7, 1 + (i2 >> 3), lds, wv_);
        else rwkv_scan_item<0>(P, l, i2 - n_p1, 0, lds, wv_);
      }
      {
        unsigned* ctr = (unsigned*)(ws + WS_BAR) + it;
        for (;;) {
          const int i2 = next_item(ctr, (volatile LAS int*)&wq_slot, wv_);
          if (i2 >= n_oth) break;
          if (i2 < 8) hgrn_combine_item(P, i2, wv_);
          else if (i2 < 8 + 512) conv_item(P, l, i2 - 8, lds, wv_);
          else sb_item(P, i2 - 8 - 512, lds, wv_);
        }
      }
    } else if (ph == 3) {
      const int n_p3 = 8 * (RW_C - 1);
      for (int i2 = bid; i2 < n_p3; i2 += G) rwkv_scan_item<0>(P, l, i2 & 7, 1 + (i2 >> 3), lds, wv_);
      {
        unsigned* ctr = (unsigned*)(ws + WS_BAR) + it;
        for (;;) {
          const int i2 = next_item(ctr, (volatile LAS int*)&wq_slot, wv_);
          if (i2 >= 16 + 128 + (l == 0 ? 189 : 0)) break;
          if (i2 >= 16 + 128) { for (int d = (i2 - 144) * 16; d < (i2 - 144) * 16 + 16; ++d) wt_deferred(P, d, lds, wv_); }
          else if (i2 < 16) gemm_tile<2>((const bf16_t*)(ws + WS_MEMN) + (size_t)l * 512 * 1024, 1024, 0, 256, 512, 768, (const bf16_t*)(wl + WT_KV), (i2 >> 3) * 256, (i2 & 7) * 256, 2048,
                                    (bf16_t*)(ws + WS_KV) + (size_t)l * 512 * 2048, (const float*)((bf16_t*)(ws + WS_VT) + (size_t)l * 2 * 1024 * 256), 2048, lds, wv_);
          else hgrn_wave_item<1>(P, l, (i2 - 16) * 8 + wv_, lds, wv_);
        }
      }
    } else if (ph == 7) {
      for (int i2 = bid * 4; i2 < 1024; i2 += G * 4) { for (int k2 = 0; k2 < 4; ++k2) xattn_item(P, l, i2 + k2, lds, wv_); }
    } else {
      const bool fin = true;
      const float* g_ = P->in[27];
      void* d_ = (void*)P->out;
#ifdef PROBE_J
      float pd_ = 0.f;
      if (fin) {
        if (bid == PROBE_B) {
          if (opaque_tid(wv_) == 0) {
            unsigned long long tot = 0ull; for (int i = 0; i < 11; ++i) tot += tacc[i] + tacc[16 + i];
            pdelta = sqrtf(0.0128f * (float)(PROBE_J < 32 ? tacc[PROBE_J & 31] : tacc[PROBE_J - 32] + tacc[PROBE_J - 16]) / (float)tot);
          }
          __syncthreads();
          pd_ = pdelta;
        }
      }
      norm_rows(fin, P->out, g_, d_, NT, pd_, wv_);
#else
      norm_rows(fin, P->out, g_, d_, NT, 0.f, wv_);
#endif
    }
    if (it < 16) { STAMP(16 + ph); xcd_barrier(bar, wv_); STAMP(ph) }
  }
#ifdef PROBE_J
  if (bid0 == PROBE_B && opaque_tid(wv_) == 0) {
    const unsigned long long t0_ = __builtin_amdgcn_s_memrealtime();
    const unsigned long long w_ = 4ull * (PROBE_K < 32 ? tacc[PROBE_K & 31] : tacc[PROBE_K - 32] + tacc[PROBE_K - 16]);
    while (__builtin_amdgcn_s_memrealtime() - t0_ < w_) __builtin_amdgcn_s_sleep(8);
  }
#endif
}

extern "C" void kernel_launch(void* const* d_in, const int* in_sizes, int n_in, void* d_out, int out_size, void* d_ws, size_t ws_size, hipStream_t stream) {
  constexpr size_t kDynLds = 147456;
  static int grid_blocks = 0;
  if (!grid_blocks) {
    int dev = 0, cus = 0, per_cu = 0;
    hipGetDevice(&dev);
    hipDeviceGetAttribute(&cus, hipDeviceAttributeMultiprocessorCount, dev);
    hipFuncSetAttribute((const void*)fwd_megakernel, hipFuncAttributeMaxDynamicSharedMemorySize, (int)kDynLds);
    hipOccupancyMaxActiveBlocksPerMultiprocessor(&per_cu, fwd_megakernel, NTHR, kDynLds);
    if (per_cu < 1) per_cu = 1;
    if (per_cu > 1) per_cu = 1;
    grid_blocks = cus * per_cu;
    if (grid_blocks > 256) grid_blocks = 256;
  }
  Params p;
  memset(&p, 0, sizeof(p));
  for (int i = 0; i < 28; ++i) p.in[i] = (const float*)d_in[i];
  p.out = (float*)d_out; p.ws = (unsigned char*)d_ws; p.never = 0; p.pad = 0;
  hipMemsetAsync(d_ws, 0, XCD_BAR_WORDS * 4, stream);
  void* args[] = {&p};
  hipError_t e = hipLaunchCooperativeKernel((void*)fwd_megakernel, dim3(grid_blocks), dim3(NTHR), args, kDynLds, stream);
  if (e != hipSuccess) fprintf(stderr, "cooperative launch failed: %s (grid %d)\n", hipGetErrorString(e), grid_blocks);
}
```

```cpp
#include <hip/hip_runtime.h>
#include <hip/hip_cooperative_groups.h>
#include <stdint.h>
#include <cstdio>
#include <cstring>
namespace cg = cooperative_groups;

typedef unsigned short bf16_t;
typedef short bf16x8 __attribute__((ext_vector_type(8)));
typedef float f32x4 __attribute__((ext_vector_type(4)));
typedef float f32x16 __attribute__((ext_vector_type(16)));
typedef float f32x2 __attribute__((ext_vector_type(2)));
#define LAS __attribute__((address_space(3)))

#define NT 16384
#define TSEQ 8192
#define DM 1024
#define NIN 3904
#define NTHR 512
#define C_R 0
#define C_K 256
#define C_V 512
#define C_XW 768
#define C_GA 832
#define C_CVAL 1088
#define C_CGLU 1344
#define C_CGATE 1600
#define C_HQ 1856
#define C_HF 2112
#define C_HI 2368
#define C_HG 2624
#define C_SQ 2880
#define C_SK 3136
#define C_SV 3392
#define C_SG 3648
#define RW_C 32
#define RW_CL (TSEQ / RW_C)
#define RW_TT 16

#define MiB (1024ull * 1024ull)
#define WS_BAR   0ull
#define WS_WT    (1ull * MiB)
#define WT_LAYER (18ull * MiB)
#define WT_IN    0ull
#define WT_OUT   (8ull * MiB)
#define WT_Q     (10ull * MiB)
#define WT_KV    (12ull * MiB)
#define WT_O     (16ull * MiB)
#define WS_MEMN  (37ull * MiB)
#define WS_KV    (39ull * MiB)
#define WS_PQ    (246ull * MiB)
#define WS_HS    (47ull * MiB)
#define WS_HF    (63ull * MiB)
#define WS_RK    (63ull * MiB + 512ull * 1024ull)
#define WS_R1    (64ull * MiB)
#define WS_PW    WS_R1
#define WS_PV    (WS_R1 + 16ull * MiB)
#define WS_P     (120ull * MiB)
#define WS_VT    (243ull * MiB)
#define WS_SSQ   (245ull * MiB)
#define WS_END   (254ull * MiB)

struct Params {
  const float* in[28];
  float* out;
  unsigned char* ws;
  int never;
  int pad;
};

typedef const __attribute__((address_space(4))) Params* KP;
__device__ __forceinline__ int lane_id_() { return (int)__builtin_amdgcn_mbcnt_hi(~0u, __builtin_amdgcn_mbcnt_lo(~0u, 0u)); }
__device__ __forceinline__ int opaque_tid(int wv_) { int t; asm volatile("v_mbcnt_lo_u32_b32 %0, -1, 0\n\tv_mbcnt_hi_u32_b32 %0, -1, %0\n\tv_lshl_add_u32 %0, %1, 6, %0" : "=&v"(t) : "s"(wv_)); return t; }
__device__ __forceinline__ float bf2f(bf16_t v) { return __uint_as_float(((unsigned)v) << 16); }
__device__ __forceinline__ bf16_t f2bf(float f) {
  unsigned u = __float_as_uint(f);
  u += 0x7fffu + ((u >> 16) & 1u);
  return (bf16_t)(u >> 16);
}
__device__ __forceinline__ unsigned pack2(float a, float b) { return (unsigned)f2bf(a) | ((unsigned)f2bf(b) << 16); }
__device__ __forceinline__ float sigmoidf_(float x) { return __builtin_amdgcn_rcpf(1.0f + __expf(-x)); }
__device__ __forceinline__ float siluf_(float x) { return x * __builtin_amdgcn_rcpf(1.0f + __expf(-x)); }
__device__ __forceinline__ float softplusf_(float x) { return fmaxf(x, 0.f) + log1pf(__expf(-fabsf(x))); }
__device__ __forceinline__ float softplus_fast(float x) { return fmaxf(x, 0.f) + __logf(1.0f + __expf(-fabsf(x))); }
__device__ __forceinline__ float dpp_add(float v, const int ctrl_sel) {
  return v;
}
__device__ __forceinline__ float bperm(float v, int srclane) { return __builtin_bit_cast(float, __builtin_amdgcn_ds_bpermute(srclane << 2, __builtin_bit_cast(int, v))); }
__device__ __forceinline__ float wave_sum(float v, int lane) {
  v += __builtin_bit_cast(float, __builtin_amdgcn_update_dpp(0, __builtin_bit_cast(int, v), 0xB1, 0xF, 0xF, true));
  v += __builtin_bit_cast(float, __builtin_amdgcn_update_dpp(0, __builtin_bit_cast(int, v), 0x4E, 0xF, 0xF, true));
  v += __builtin_bit_cast(float, __builtin_amdgcn_update_dpp(0, __builtin_bit_cast(int, v), 0x141, 0xF, 0xF, true));
  v += __builtin_bit_cast(float, __builtin_amdgcn_update_dpp(0, __builtin_bit_cast(int, v), 0x140, 0xF, 0xF, true));
  v += bperm(v, lane ^ 16);
  v += bperm(v, lane ^ 32);
  return v;
}
__device__ __forceinline__ float max8(float v) {
  v = fmaxf(v, __builtin_bit_cast(float, __builtin_amdgcn_update_dpp(0, __builtin_bit_cast(int, v), 0xB1, 0xF, 0xF, true)));
  v = fmaxf(v, __builtin_bit_cast(float, __builtin_amdgcn_update_dpp(0, __builtin_bit_cast(int, v), 0x4E, 0xF, 0xF, true)));
  v = fmaxf(v, __builtin_bit_cast(float, __builtin_amdgcn_update_dpp(0, __builtin_bit_cast(int, v), 0x141, 0xF, 0xF, true)));
  return v;
}
__device__ __forceinline__ float red8(float v) {
  v += __builtin_bit_cast(float, __builtin_amdgcn_update_dpp(0, __builtin_bit_cast(int, v), 0xB1, 0xF, 0xF, true));
  v += __builtin_bit_cast(float, __builtin_amdgcn_update_dpp(0, __builtin_bit_cast(int, v), 0x4E, 0xF, 0xF, true));
  v += __builtin_bit_cast(float, __builtin_amdgcn_update_dpp(0, __builtin_bit_cast(int, v), 0x141, 0xF, 0xF, true));
  return v;
}

#define LBAR() do { asm volatile("s_waitcnt lgkmcnt(0)" ::: "memory"); __builtin_amdgcn_s_barrier(); asm volatile("" ::: "memory"); } while (0)
#define XB_TMO      128
#define XB_XCNT(j)  (256  + 64 * (j))
#define XB_XSUB(j)  (1280 + 64 * (j))
#define XB_XGEN(j)  (2304 + 64 * (j))
#define XB_TOP      3328
#define XB_TOPGEN   3392
#define XCD_BAR_WORDS 3456
#define XB_SPIN_CAP (1u << 22)
__device__ __forceinline__ unsigned xb_ld(unsigned* p) { return __hip_atomic_load(p, __ATOMIC_RELAXED, __HIP_MEMORY_SCOPE_AGENT); }
__device__ __forceinline__ unsigned xb_add(unsigned* p, unsigned v) { return __hip_atomic_fetch_add(p, v, __ATOMIC_RELAXED, __HIP_MEMORY_SCOPE_AGENT); }
__device__ __forceinline__ unsigned xb_xcc_id() { return (unsigned)__builtin_amdgcn_s_getreg((3 << 11) | 20) & 0xFu; }
#define XB_SPIN(cond, bar) do { unsigned _sp = 0; while (cond) { __builtin_amdgcn_s_sleep(1); \
    if ((++_sp & 255u) == 0u) { if (xb_ld(&(bar)[XB_TMO])) break; if (_sp > XB_SPIN_CAP) { atomicAdd(&(bar)[XB_TMO], 1u); break; } } } } while (0)
struct XcdBarrier { unsigned* bar; unsigned x; volatile LAS unsigned* st; };
__device__ __forceinline__ XcdBarrier xcd_barrier_post(unsigned* bar, volatile LAS unsigned* st, int wv_) {
  XcdBarrier b; b.bar = bar; b.x = xb_xcc_id(); b.st = st;
  if (opaque_tid(wv_) == 0) (void)xb_add(&bar[XB_XCNT(b.x)], 1u);
  return b;
}
__device__ __forceinline__ void xcd_barrier_complete(unsigned* bar, unsigned x, unsigned& nloc, unsigned& nx) {
  const unsigned G = gridDim.x * gridDim.y * gridDim.z;
  unsigned sum, cnt, mine, sp = 0u;
  for (;;) {
    sum = 0u; cnt = 0u; mine = 0u;
#pragma unroll
    for (unsigned j = 0; j < 16; ++j) { const unsigned c = xb_ld(&bar[XB_XCNT(j)]); sum += c; cnt += (c > 0u) ? 1u : 0u; mine = (j == x) ? c : mine; }
    if (sum == G) break;
    __builtin_amdgcn_s_sleep(1);
    if ((++sp & 255u) == 0u) { if (xb_ld(&bar[XB_TMO])) break; if (sp > XB_SPIN_CAP) { atomicAdd(&bar[XB_TMO], 1u); break; } }
  }
  nloc = mine > 0u ? mine : 1u; nx = cnt > 0u ? cnt : 1u;
}
__device__ __forceinline__ void xcd_barrier(const XcdBarrier& b, int wv_) {
  asm volatile("s_waitcnt vmcnt(0)" ::: "memory");
  __syncthreads();
  if (opaque_tid(wv_) == 0) {
    unsigned* bar = b.bar;
    __builtin_amdgcn_s_waitcnt(0);
    unsigned bx = b.x; asm volatile("" : "+s"(bx));
    unsigned nloc = b.st[0], nx = b.st[1];
    if (nloc == 0u) { xcd_barrier_complete(bar, bx, nloc, nx); b.st[0] = nloc; b.st[1] = nx; }
    const unsigned old = xb_add(&bar[XB_XSUB(bx)], 1u);
    const unsigned gen = old / nloc;
    if (old + 1u == (gen + 1u) * nloc) {
      __builtin_amdgcn_fence(__ATOMIC_RELEASE, "agent");
      asm volatile("s_waitcnt vmcnt(0)" ::: "memory");
      const unsigned og = xb_add(&bar[XB_TOP], 1u);
      const unsigned tg = og / nx;
      if (og + 1u == (tg + 1u) * nx) xb_add(&bar[XB_TOPGEN], 1u);
      else XB_SPIN(xb_ld(&bar[XB_TOPGEN]) == tg, bar);
      __builtin_amdgcn_fence(__ATOMIC_ACQUIRE, "agent");
      xb_add(&bar[XB_XGEN(bx)], 1u);
      asm volatile("s_waitcnt vmcnt(0)" ::: "memory");
    } else {
      XB_SPIN(xb_ld(&bar[XB_XGEN(bx)]) == gen, bar);
      __builtin_amdgcn_fence(__ATOMIC_ACQUIRE, "agent");
      asm volatile("s_waitcnt vmcnt(0)" ::: "memory");
    }
  }
  __syncthreads();
}

#define G_STAGE 73728
#define G_BOFF 36864
template <int EPI>
__device__ __forceinline__ void gemm_tile(const bf16_t* __restrict__ A, int lda, int ao0, int ao1, int ao2, int ao3,
                                          const bf16_t* __restrict__ Bt, int m0, int n0, int N,
                                          void* out, const float* resid, int ldc, unsigned char* lds, int wv_) {
#ifdef OFF_gemm_tile
  return;
#endif

  const int tid = opaque_tid(wv_), lane = tid & 63, w = tid >> 6;
  const int wm = w >> 2, wn = w & 3, lr = lane & 31, lh = lane >> 5;
  f32x16 acc[4][2];
#pragma unroll
  for (int i = 0; i < 4; ++i)
#pragma unroll
    for (int j = 0; j < 2; ++j)
#pragma unroll
      for (int r = 0; r < 16; ++r) acc[i][j][r] = 0.f;
  uint4 ra[4], rb[4];
  const int crow = tid >> 3, ccol = (tid & 7) * 8;
  const bf16_t* Ap = A + (size_t)(m0 + crow) * lda + ccol;
  const bf16_t* Bp = Bt + (size_t)(n0 + crow) * 1024 + ccol;
#define G_LOAD(kt) { const int k0_ = (kt) * 64; const int seg_ = k0_ >> 8; const int ao_ = (seg_ == 0 ? ao0 : seg_ == 1 ? ao1 : seg_ == 2 ? ao2 : ao3) + (k0_ & 255); \
    _Pragma("unroll") for (int i_ = 0; i_ < 4; ++i_) { ra[i_] = *(const uint4*)(Ap + (size_t)(i_ * 64) * lda + ao_); rb[i_] = *(const uint4*)(Bp + (size_t)(i_ * 64) * 1024 + k0_); } }
#define G_WRITE(buf) { unsigned char* b_ = lds + (buf) * G_STAGE + crow * 144 + (tid & 7) * 16; \
    _Pragma("unroll") for (int i_ = 0; i_ < 4; ++i_) { *(uint4*)(b_ + i_ * 64 * 144) = ra[i_]; *(uint4*)(b_ + G_BOFF + i_ * 64 * 144) = rb[i_]; } }
  G_LOAD(0); G_WRITE(0); __syncthreads();
  for (int kt = 0; kt < 16; ++kt) {
    if (kt < 15) G_LOAD(kt + 1);
    const unsigned char* base = lds + (kt & 1) * G_STAGE;
    const unsigned char* ab = base + (wm * 128 + lr) * 144 + lh * 16;
    const unsigned char* bb = base + G_BOFF + (wn * 64 + lr) * 144 + lh * 16;
#pragma unroll
    for (int s = 0; s < 4; ++s) {
      bf16x8 a[4], b[2];
#pragma unroll
      for (int i = 0; i < 4; ++i) a[i] = *(const bf16x8*)(ab + i * 32 * 144 + s * 32);
#pragma unroll
      for (int j = 0; j < 2; ++j) b[j] = *(const bf16x8*)(bb + j * 32 * 144 + s * 32);
#pragma unroll
      for (int i = 0; i < 4; ++i)
#pragma unroll
        for (int j = 0; j < 2; ++j) acc[i][j] = __builtin_amdgcn_mfma_f32_32x32x16_bf16(a[i], b[j], acc[i][j], 0, 0, 0);
    }
    if (kt < 15) G_WRITE((kt + 1) & 1);
    __syncthreads();
  }
#undef G_LOAD
#undef G_WRITE
#pragma unroll
  for (int i = 0; i < 4; ++i)
#pragma unroll
    for (int j = 0; j < 2; ++j) {
      const int col = n0 + wn * 64 + j * 32 + lr;
#pragma unroll
      for (int r = 0; r < 16; ++r) {
        const int row = m0 + wm * 128 + i * 32 + (r & 3) + 8 * (r >> 2) + 4 * lh;
        if (EPI == 0) { if (col < N) ((bf16_t*)out)[(size_t)row * ldc + col] = f2bf(acc[i][j][r]); }
        else if (EPI == 2) { if (col < 1024) ((bf16_t*)out)[(size_t)row * ldc + col] = f2bf(acc[i][j][r]);
                             else ((bf16_t*)resid)[((size_t)((row >> 8) * 1024 + (col - 1024))) * 256 + (row & 255)] = f2bf(acc[i][j][r]); }
        else { ((float*)out)[(size_t)row * ldc + col] = resid[(size_t)row * ldc + col] + acc[i][j][r]; }
      }
    }
}

__device__ __forceinline__ void tile_map(int t, int nN, int& mi, int& ni) {
  const int rnd = t >> 8, blk = t & 255, x = blk & 7, y = blk >> 3;
  if (nN == 16) { mi = rnd * 16 + (x >> 1) * 4 + (y & 3); ni = (x & 1) * 8 + (y >> 2); }
  else { mi = rnd * 64 + x * 8 + (y & 7); ni = y >> 3; }
}

namespace pg8 {
#define PG8_LAS __attribute__((address_space(3)))
typedef unsigned u32x4 __attribute__((ext_vector_type(4)));
constexpr int BM = 256, BK = 64, HALF = 128, HTB = HALF * BK * 2  , STAGE_BYTES = 8 * HTB, NXCD = 8, WGM = 8;

__host__ __device__ __forceinline__ int lds_byte(int r, int c) { const int st = (r >> 4) * 2 + (c >> 5), rr = r & 15, cc = c & 31, ob = rr * 64 + cc * 2; return st * 1024 + (ob ^ (((ob >> 9) & 1) << 5)); }
__host__ __device__ __forceinline__ void stage_rc(int b, int& R, int& C) { const int st = b / 1024, sb = b % 1024, swz = sb ^ (((sb >> 9) & 1) << 5); R = (st >> 1) * 16 + swz / 64; C = (st & 1) * 32 + (swz % 64) / 2; }
__host__ __device__ __forceinline__ int perm32(int rho) { const int n = rho >> 4, i = rho & 15; return 8 * (i >> 2) + 4 * n + (i & 3); }

struct Unit { int pm, pn; };
struct Gemm { const bf16_t* A; const bf16_t* Bt; int M, N, K; int lda; int ao0, ao1, ao2, ao3; };

struct TileSched {
    int nt, G, c, nN;
    __device__ __forceinline__ bool next(int i, Unit& u) const { const int t = i * G + c; if (t >= nt) return false; tile_map(t, nN, u.pm, u.pn); return true; }
    __device__ __forceinline__ void a_ready(const Unit&) const {}
    __device__ __forceinline__ void done(const Unit&) const {}
};
__device__ __forceinline__ unsigned cvt_pk_bf16(float lo, float hi) { unsigned r; asm volatile("v_cvt_pk_bf16_f32 %0, %1, %2" : "=v"(r) : "v"(lo), "v"(hi)); return r; }
struct EpiStoreBf16 {
    static constexpr bool PERM = true, AFTER_DRAIN = false;
    bf16_t* O; int ldc; int N;
    __device__ __forceinline__ void operator()(const f32x4 (&acc)[2][2][4][2], const Unit& u, int wr, int wc, int fr, int fq) const {
        const int row0 = u.pm * BM + wr * 64 + fr, col0 = u.pn * BM + wc * 32 + 8 * fq;
#pragma unroll
        for (int ai = 0; ai < 2; ++ai)
#pragma unroll
            for (int m = 0; m < 4; ++m) { bf16_t* rowp = O + (size_t)(row0 + ai * HALF + m * 16) * ldc + col0;
#pragma unroll
                for (int bj = 0; bj < 2; ++bj) { if (col0 + bj * HALF < N) { const f32x4 v0 = acc[ai][bj][m][0], v1 = acc[ai][bj][m][1];
                    u32x4 w; w.x = cvt_pk_bf16(v0[0], v0[1]); w.y = cvt_pk_bf16(v0[2], v0[3]); w.z = cvt_pk_bf16(v1[0], v1[1]); w.w = cvt_pk_bf16(v1[2], v1[3]);
                    *(u32x4*)(rowp + bj * HALF) = w; } } }
    }
};
struct EpiDyn {
    static constexpr bool PERM = true, AFTER_DRAIN = false;
    int mode; bf16_t* O; int ldc; int N; const float* resid; float* out; const float* ssq_in; bf16_t* xb; float* ssq_out;
    __device__ __forceinline__ void operator()(const f32x4 (&acc)[2][2][4][2], const Unit& u, int wr, int wc, int fr, int fq) const {
        const int row0 = u.pm * BM + wr * 64 + fr, col0 = u.pn * BM + wc * 32 + 8 * fq;
        if (mode == 0) {
#pragma unroll
            for (int ai = 0; ai < 2; ++ai)
#pragma unroll
                for (int m = 0; m < 4; ++m) { const int row = row0 + ai * HALF + m * 16; bf16_t* rowp = O + (size_t)row * ldc + col0;
                    const float sc = __builtin_amdgcn_rsqf(ssq_in[row] * (1.0f / 1024.0f) + 1e-6f);
#pragma unroll
                    for (int bj = 0; bj < 2; ++bj) { if (col0 + bj * HALF < N) { const f32x4 v0 = acc[ai][bj][m][0] * sc, v1 = acc[ai][bj][m][1] * sc;
                        u32x4 w; w.x = cvt_pk_bf16(v0[0], v0[1]); w.y = cvt_pk_bf16(v0[2], v0[3]); w.z = cvt_pk_bf16(v1[0], v1[1]); w.w = cvt_pk_bf16(v1[2], v1[3]);
                        *(u32x4*)(rowp + bj * HALF) = w; } } }
        } else {
            const int lane_ = fq * 16 + fr;
#pragma unroll
            for (int ai = 0; ai < 2; ++ai)
#pragma unroll
                for (int m = 0; m < 4; ++m) { const int row = row0 + ai * HALF + m * 16; const size_t off = (size_t)row * ldc + col0; float s = 0.f;
#pragma unroll
                    for (int bj = 0; bj < 2; ++bj) { const f32x4 r0 = *(const f32x4*)(resid + off + bj * HALF), r1 = *(const f32x4*)(resid + off + bj * HALF + 4);
                        const f32x4 x0 = r0 + acc[ai][bj][m][0], x1 = r1 + acc[ai][bj][m][1];
                        *(f32x4*)(out + off + bj * HALF) = x0; *(f32x4*)(out + off + bj * HALF + 4) = x1;
                        u32x4 w; w.x = cvt_pk_bf16(x0[0], x0[1]); w.y = cvt_pk_bf16(x0[2], x0[3]); w.z = cvt_pk_bf16(x1[0], x1[1]); w.w = cvt_pk_bf16(x1[2], x1[3]);
                        *(u32x4*)(xb + off + bj * HALF) = w;
                        s += (x0[0] * x0[0] + x0[1] * x0[1]) + (x0[2] * x0[2] + x0[3] * x0[3]) + (x1[0] * x1[0] + x1[1] * x1[1]) + (x1[2] * x1[2] + x1[3] * x1[3]); }
                    s += bperm(s, lane_ ^ 16); s += bperm(s, lane_ ^ 32);
                    if (fq == 0) __hip_atomic_fetch_add(ssq_out + row, s, __ATOMIC_RELAXED, __HIP_MEMORY_SCOPE_AGENT); }
        }
    }
};
struct EpiResid {
    static constexpr bool PERM = true, AFTER_DRAIN = false;
    const float* resid; float* out; int ldc;
    __device__ __forceinline__ void operator()(const f32x4 (&acc)[2][2][4][2], const Unit& u, int wr, int wc, int fr, int fq) const {
        const int row0 = u.pm * BM + wr * 64 + fr, col0 = u.pn * BM + wc * 32 + 8 * fq;
#pragma unroll
        for (int ai = 0; ai < 2; ++ai)
#pragma unroll
            for (int m = 0; m < 4; ++m) { const size_t off = (size_t)(row0 + ai * HALF + m * 16) * ldc + col0;
#pragma unroll
                for (int bj = 0; bj < 2; ++bj) { const f32x4 r0 = *(const f32x4*)(resid + off + bj * HALF), r1 = *(const f32x4*)(resid + off + bj * HALF + 4);
                    *(f32x4*)(out + off + bj * HALF) = r0 + acc[ai][bj][m][0]; *(f32x4*)(out + off + bj * HALF + 4) = r1 + acc[ai][bj][m][1]; } }
    }
};

static_assert(true, "pg8 body adapted: SP2 path only is valid with lda/segment offsets");
template <class Epi, class Sched, bool ALIGN_EPI = false, bool SP2 = false>
__device__ __forceinline__ void gemm_phase(PG8_LAS unsigned char* lds, const Gemm g, const Sched& S, const Epi& E, int wv_) {
    const int tid = opaque_tid(wv_), wid = __builtin_amdgcn_readfirstlane(tid >> 6), lane = tid & 63, wr = wid >> 2, wc = wid & 3, fr = lane & 15, fq = lane >> 4;
    const int K = g.K, nt = K / BK;
    unsigned voffA, voffB;
    { int R, C; stage_rc(tid * 16, R, C); const int Rb = Epi::PERM ? ((R & ~31) + perm32(R & 31)) : R;
      voffA = (unsigned)(R * g.lda + C) * 2u; voffB = (unsigned)(Rb * K + C) * 2u; }
    const size_t rstepA = (size_t)64 * g.lda * 2, rstepB = (size_t)64 * K * 2;
    const size_t kstep = (size_t)(BK * 2);
    const size_t hstep = (size_t)HALF * K * 2; const size_t hstepA = (size_t)HALF * g.lda * 2, tstepA = 2 * hstepA;
#define PG8_KA(t_) ((size_t)((((t_) >> 2) == 0 ? g.ao0 : ((t_) >> 2) == 1 ? g.ao1 : ((t_) >> 2) == 2 ? g.ao2 : g.ao3) + ((t_) & 3) * 64) * 2)
    const size_t tstep = 2 * hstep;
    const unsigned ldsw = (unsigned)wid * 1024u;
    int aoff, boff;
#define PG8_SA(b, h) (((b) * 2 + (h)) * HTB)
#define PG8_SB(b, h) ((4 + (b) * 2 + (h)) * HTB)
#define PG8_STAGE(bufoff, gbase, voff) do { _Pragma("unroll") for (int _i = 0; _i < 2; ++_i) \
        __builtin_amdgcn_global_load_lds((const unsigned*)((const char*)(gbase) + (size_t)_i * r##voff + (voff)), (PG8_LAS unsigned*)(lds + (bufoff) + ldsw + _i * 8192), 16, 0, 0); } while (0)
#define rvoffA rstepA
#define rvoffB rstepB
#define PG8_LDA(dst, b, h) do { _Pragma("unroll") for (int m = 0; m < 4; ++m) _Pragma("unroll") for (int k = 0; k < 2; ++k) dst[m][k] = *(const PG8_LAS bf16x8*)(lds + (PG8_SA(b, h) + wr * 8192) + aoff + m * 2048 + k * 1024); } while (0)
#define PG8_LDB(dst, b, h) do { _Pragma("unroll") for (int n = 0; n < 2; ++n) _Pragma("unroll") for (int k = 0; k < 2; ++k) dst[n][k] = *(const PG8_LAS bf16x8*)(lds + (PG8_SB(b, h) + wc * 4096) + boff + n * 2048 + k * 1024); } while (0)
#define PG8_MMA(ai, bj, At, Bt) do { __builtin_amdgcn_s_setprio(1); _Pragma("unroll") for (int m = 0; m < 4; ++m) _Pragma("unroll") for (int n = 0; n < 2; ++n) _Pragma("unroll") for (int k = 0; k < 2; ++k) \
        acc[ai][bj][m][n] = __builtin_amdgcn_mfma_f32_16x16x32_bf16(Bt[n][k], At[m][k], acc[ai][bj][m][n], 0, 0, 0); __builtin_amdgcn_s_setprio(0); } while (0)
#define PG8_WAIT_V(n) asm volatile("s_waitcnt vmcnt(" #n ")" ::: "memory")
#define PG8_WAIT_L(n) asm volatile("s_waitcnt lgkmcnt(" #n ")" ::: "memory")
#define PG8_BAR __builtin_amdgcn_s_barrier()
#define PG8_SCHED __builtin_amdgcn_sched_barrier(0)
    Unit cur, nxt; int ui = 0;
    if (!S.next(0, cur)) return;
    f32x4 acc[2][2][4][2];
#pragma unroll
    for (int a = 0; a < 2; ++a)
#pragma unroll
        for (int b = 0; b < 2; ++b)
#pragma unroll
            for (int m = 0; m < 4; ++m)
#pragma unroll
                for (int n = 0; n < 2; ++n) acc[a][b][m][n] = (f32x4){0.f, 0.f, 0.f, 0.f};
    bf16x8 At[4][2], B0[2][2], B1[2][2];
    const char* cA = (const char*)g.A + (size_t)cur.pm * tstepA; const char* cB = (const char*)g.Bt + (size_t)cur.pn * tstep;
    S.a_ready(cur);
    if constexpr (SP2) {
        PG8_STAGE(PG8_SB(0, 0), cB, voffB); PG8_STAGE(PG8_SB(0, 1), cB + hstep, voffB); PG8_STAGE(PG8_SA(0, 0), cA + PG8_KA(0), voffA); PG8_STAGE(PG8_SA(0, 1), cA + hstepA + PG8_KA(0), voffA);
        if (wr == 1) PG8_BAR;
        PG8_WAIT_V(2); PG8_BAR;
        PG8_STAGE(PG8_SB(1, 0), cB + kstep, voffB); PG8_STAGE(PG8_SA(1, 0), cA + PG8_KA(1), voffA); PG8_STAGE(PG8_SB(1, 1), cB + hstep + kstep, voffB);
        PG8_WAIT_V(6); PG8_BAR;
    } else {
        PG8_STAGE(PG8_SB(0, 0), cB, voffB); PG8_STAGE(PG8_SA(0, 0), cA, voffA); PG8_STAGE(PG8_SB(0, 1), cB + hstep, voffB); PG8_STAGE(PG8_SA(0, 1), cA + hstep, voffA);
        if (wr == 1) PG8_BAR;
        PG8_WAIT_V(4); PG8_BAR;
        PG8_STAGE(PG8_SB(1, 0), cB + kstep, voffB); PG8_STAGE(PG8_SA(1, 0), cA + kstep, voffA); PG8_STAGE(PG8_SB(1, 1), cB + hstep + kstep, voffB);
        PG8_WAIT_V(6); PG8_BAR;
    }
    { const int t3_ = opaque_tid(wv_), l3_ = t3_ & 63, w3_ = __builtin_amdgcn_readfirstlane(t3_ >> 6); aoff = lds_byte((l3_ & 15), (l3_ >> 4) * 8); boff = aoff; }
    for (;;) {
        const bool has_next = S.next(ui + 1, nxt);
        const char* nA = has_next ? (const char*)g.A + (size_t)nxt.pm * tstepA : cA; const char* nB = has_next ? (const char*)g.Bt + (size_t)nxt.pn * tstep : cB;
        for (int t = 0; t < nt; t += 2) {
            const bool last = (t == nt - 2);
            const char* a1 = cA + PG8_KA(t + 1);
            const char* a2 = last ? nA + PG8_KA(0) : cA + PG8_KA(t + 2); const char* b2 = last ? nB : cB + (size_t)(t + 2) * kstep;
            const char* a3 = last ? nA + PG8_KA(1) : cA + PG8_KA(t + 3); const char* b3 = b2 + kstep;
            if (last && has_next) S.a_ready(nxt);
            if constexpr (SP2) {
            PG8_LDB(B0, 0, 0); PG8_LDB(B1, 0, 1); PG8_SCHED; PG8_LDA(At, 0, 0); PG8_STAGE(PG8_SA(1, 1), a1 + hstepA, voffA);
            PG8_WAIT_V(8); PG8_WAIT_L(0); PG8_BAR; PG8_MMA(0, 0, At, B0); PG8_MMA(0, 1, At, B1); PG8_BAR; PG8_SCHED;
            PG8_LDA(At, 0, 1); PG8_STAGE(PG8_SB(0, 0), b2, voffB); PG8_STAGE(PG8_SB(0, 1), b2 + hstep, voffB); PG8_STAGE(PG8_SA(0, 0), a2, voffA);
            PG8_WAIT_V(8); PG8_WAIT_L(0); PG8_BAR; PG8_MMA(1, 0, At, B0); PG8_MMA(1, 1, At, B1); PG8_BAR; PG8_SCHED;
            PG8_LDB(B0, 1, 0); PG8_LDB(B1, 1, 1); PG8_SCHED; PG8_LDA(At, 1, 0); PG8_STAGE(PG8_SA(0, 1), a2 + hstepA, voffA);
            PG8_WAIT_V(8); PG8_WAIT_L(0); PG8_BAR; PG8_MMA(0, 0, At, B0); PG8_MMA(0, 1, At, B1); PG8_BAR; PG8_SCHED;
            PG8_LDA(At, 1, 1); PG8_STAGE(PG8_SB(1, 0), b3, voffB); PG8_STAGE(PG8_SB(1, 1), b3 + hstep, voffB); PG8_STAGE(PG8_SA(1, 0), a3, voffA);
            PG8_WAIT_V(8); PG8_WAIT_L(0); PG8_BAR; PG8_MMA(1, 0, At, B0); PG8_MMA(1, 1, At, B1); PG8_BAR; PG8_SCHED;
            } else {
            PG8_LDB(B0, 0, 0); PG8_SCHED; PG8_LDA(At, 0, 0); PG8_STAGE(PG8_SA(1, 1), a1 + hstep, voffA);
            PG8_WAIT_L(8); PG8_BAR; PG8_WAIT_L(0); PG8_MMA(0, 0, At, B0); PG8_BAR; PG8_SCHED;
            PG8_LDB(B1, 0, 1); PG8_STAGE(PG8_SB(0, 0), b2, voffB);
            PG8_BAR; PG8_WAIT_L(0); PG8_MMA(0, 1, At, B1); PG8_BAR;
            PG8_LDA(At, 0, 1); PG8_STAGE(PG8_SA(0, 0), a2, voffA);
            PG8_BAR; PG8_WAIT_L(0); PG8_MMA(1, 0, At, B0); PG8_BAR; PG8_SCHED;
            PG8_STAGE(PG8_SB(0, 1), b2 + hstep, voffB);
            PG8_WAIT_V(6); PG8_BAR; PG8_MMA(1, 1, At, B1); PG8_BAR;
            PG8_LDB(B0, 1, 0); PG8_SCHED; PG8_LDA(At, 1, 0); PG8_STAGE(PG8_SA(0, 1), a2 + hstep, voffA);
            PG8_WAIT_L(8); PG8_BAR; PG8_WAIT_L(0); PG8_MMA(0, 0, At, B0); PG8_BAR; PG8_SCHED;
            PG8_LDB(B1, 1, 1); PG8_STAGE(PG8_SB(1, 0), b3, voffB);
            PG8_BAR; PG8_WAIT_L(0); PG8_MMA(0, 1, At, B1); PG8_BAR;
            PG8_LDA(At, 1, 1); PG8_STAGE(PG8_SA(1, 0), a3, voffA);
            PG8_BAR; PG8_WAIT_L(0); PG8_MMA(1, 0, At, B0); PG8_BAR; PG8_SCHED;
            PG8_STAGE(PG8_SB(1, 1), b3 + hstep, voffB);
            PG8_WAIT_V(6); PG8_BAR; PG8_MMA(1, 1, At, B1); PG8_BAR;
            }
        }
        if constexpr (ALIGN_EPI) { if (wr == 0) PG8_BAR; }
        if constexpr (!Epi::AFTER_DRAIN) { const int t2_ = opaque_tid(wv_), l2_ = t2_ & 63, w2_ = __builtin_amdgcn_readfirstlane(t2_ >> 6); E(acc, cur, w2_ >> 2, w2_ & 3, l2_ & 15, l2_ >> 4); S.done(cur); }
        if (!has_next) break;
#pragma unroll
        for (int a = 0; a < 2; ++a)
#pragma unroll
            for (int b = 0; b < 2; ++b)
#pragma unroll
                for (int m = 0; m < 4; ++m)
#pragma unroll
                    for (int n = 0; n < 2; ++n) acc[a][b][m][n] = (f32x4){0.f, 0.f, 0.f, 0.f};
        cur = nxt; cA = nA; cB = nB; ++ui;
        if constexpr (ALIGN_EPI) { if (wr == 1) PG8_BAR; }
    }
    PG8_WAIT_V(0);
    if constexpr (!ALIGN_EPI) { if (wr == 0) PG8_BAR; }
    PG8_BAR;
    if constexpr (Epi::AFTER_DRAIN) { E.fused(acc, cur, wr, wc, fr, fq, lds, wid, lane); S.done(cur); }
#undef PG8_SA
#undef PG8_SB
#undef PG8_STAGE
#undef rvoffA
#undef rvoffB
#undef PG8_LDA
#undef PG8_LDB
#undef PG8_MMA
#undef PG8_WAIT_V
#undef PG8_WAIT_L
#undef PG8_BAR
#undef PG8_SCHED
#undef PG8_KA
}
}

__device__ __forceinline__ void wt_tile(const float* __restrict__ W, int N, bf16_t* __restrict__ Wt, int kt, int nt, unsigned char* lds, int wv_, const float* gk = nullptr) {
#ifdef OFF_wt_tile
  return;
#endif

  float* tl = (float*)lds;
  const int tid = opaque_tid(wv_);
  const int r = tid >> 3, c8 = (tid & 7) * 8;
  const float* src = W + (size_t)(kt * 64 + r) * N + nt * 64 + c8;
  float4 v0 = *(const float4*)src, v1 = *(const float4*)(src + 4);
  if (gk) { const float g_ = gk[kt * 64 + r]; v0.x *= g_; v0.y *= g_; v0.z *= g_; v0.w *= g_; v1.x *= g_; v1.y *= g_; v1.z *= g_; v1.w *= g_; }
  float* d = tl + r * 65 + c8;
  d[0] = v0.x; d[1] = v0.y; d[2] = v0.z; d[3] = v0.w; d[4] = v1.x; d[5] = v1.y; d[6] = v1.z; d[7] = v1.w;
  __syncthreads();
  uint4 o;
  o.x = pack2(tl[(c8 + 0) * 65 + r], tl[(c8 + 1) * 65 + r]);
  o.y = pack2(tl[(c8 + 2) * 65 + r], tl[(c8 + 3) * 65 + r]);
  o.z = pack2(tl[(c8 + 4) * 65 + r], tl[(c8 + 5) * 65 + r]);
  o.w = pack2(tl[(c8 + 6) * 65 + r], tl[(c8 + 7) * 65 + r]);
  *(uint4*)(Wt + (size_t)(nt * 64 + r) * 1024 + kt * 64 + c8) = o;
  __syncthreads();
}

__device__ __forceinline__ void norm_rows(const bool F32OUT, const float* src, const float* __restrict__ g, void* dst, int nrows, float pd, int wv_, float* ssq_out = nullptr) {
#ifdef OFF_norm_rows
  return;
#endif

  const int tid = opaque_tid(wv_);
  const int lane = tid & 63;
  const int gw = blockIdx.x * 8 + (tid >> 6), nw = gridDim.x * 8;
  float4 gv[4];
#pragma unroll
  for (int i = 0; i < 4; ++i) gv[i] = ssq_out ? make_float4(1.f, 1.f, 1.f, 1.f) : *(const float4*)(g + i * 256 + lane * 4);
  for (int row = gw; row < nrows; row += nw) {
    const float* s = src + (size_t)row * 1024;
    float4 v[4]; float ss = 0.f;
#pragma unroll
    for (int i = 0; i < 4; ++i) { v[i] = *(const float4*)(s + i * 256 + lane * 4); ss += v[i].x * v[i].x + v[i].y * v[i].y + v[i].z * v[i].z + v[i].w * v[i].w; }
    ss = wave_sum(ss, lane);
    if (ssq_out) { if (lane == 0) ssq_out[row] = ss; }
    const float rs = ssq_out ? 1.0f : rsqrtf(ss * (1.0f / 1024.0f) + 1e-6f);
#pragma unroll
    for (int i = 0; i < 4; ++i) {
      const float a = v[i].x * rs * gv[i].x, b = v[i].y * rs * gv[i].y, c = v[i].z * rs * gv[i].z, d = v[i].w * rs * gv[i].w;
      if (F32OUT) { *(float4*)((float*)dst + (size_t)row * 1024 + i * 256 + lane * 4) = make_float4(a + pd, b + pd, c + pd, d + pd); }
      else { uint2 o; o.x = pack2(a, b); o.y = pack2(c, d); *(uint2*)((bf16_t*)dst + (size_t)row * 1024 + i * 256 + lane * 4) = o; }
    }
  }
}

__device__ __forceinline__ void rwkv_prep_item(KP P, int l, int item, unsigned char* lds, int wv_) {
#ifdef OFF_rwkv_prep_item
  return;
#endif

  const bf16_t* p = (const bf16_t*)(P->ws + WS_P);
  float* PW = (float*)(P->ws + WS_PW); bf16_t* PV = (bf16_t*)(P->ws + WS_PV); float* RK = (float*)(P->ws + WS_RK);
  float* lora = (float*)lds;
  const int tid = opaque_tid(wv_), lane = tid & 63, w = tid >> 6, head = w & 3, sub = w >> 2;
  const int c = head * 64 + lane;
  const float* mu = P->in[4] + l * 832;
  const float mur = mu[c], muk = mu[256 + c], muv = mu[512 + c], mux = mu[768 + lane];
  const float w0 = P->in[5][l * 256 + c], a0 = P->in[7][l * 256 + c];
  const float kkw = P->in[9][l * 256 + c], kaw = P->in[10][l * 256 + c], rkw = P->in[11][l * 256 + c];
  float wup[32], aup[32];
#pragma unroll
  for (int j = 0; j < 32; ++j) { wup[j] = P->in[6][(l * 32 + j) * 256 + c]; aup[j] = P->in[8][(l * 32 + j) * 256 + c]; }
  bf16_t raw[4][8];
#define PREP_LOAD(g) { _Pragma("unroll") for (int j_ = 0; j_ < 4; ++j_) { const int t_ = item * 32 + sub + 2 * ((g) * 4 + j_); const bool hp_ = (t_ & (TSEQ - 1)) > 0; \
      const bf16_t* pr_ = p + (size_t)t_ * NIN; raw[j_][0] = pr_[c]; raw[j_][1] = pr_[256 + c]; raw[j_][2] = pr_[512 + c]; raw[j_][3] = pr_[768 + lane]; \
      raw[j_][4] = hp_ ? pr_[c - NIN] : (bf16_t)0; raw[j_][5] = hp_ ? pr_[256 + c - NIN] : (bf16_t)0; raw[j_][6] = hp_ ? pr_[512 + c - NIN] : (bf16_t)0; raw[j_][7] = hp_ ? pr_[768 + lane - NIN] : (bf16_t)0; } }
  PREP_LOAD(0);
#pragma unroll 1
  for (int g = 0; g < 4; ++g) {
    float rr[4], kk4[4], vv4[4];
#pragma unroll
    for (int j = 0; j < 4; ++j) {
      float r = bf2f(raw[j][0]), k = bf2f(raw[j][1]), v = bf2f(raw[j][2]), x = bf2f(raw[j][3]);
      r += (bf2f(raw[j][4]) - r) * mur; k += (bf2f(raw[j][5]) - k) * muk; v += (bf2f(raw[j][6]) - v) * muv; x += (bf2f(raw[j][7]) - x) * mux;
      rr[j] = r; kk4[j] = k; vv4[j] = v;
      lora[(w * 4 + j) * 64 + lane] = lane < 32 ? (1.0f - 2.0f * __builtin_amdgcn_rcpf(1.0f + __expf(2.0f * x))) : x;
    }
    if (g < 3) PREP_LOAD(g + 1);
    __builtin_amdgcn_s_waitcnt(0xc07f);
    __builtin_amdgcn_wave_barrier();
    float wv4[4], av4[4];
#pragma unroll
    for (int j = 0; j < 4; ++j) { wv4[j] = w0; av4[j] = a0; }
#pragma unroll
    for (int jj = 0; jj < 32; jj += 4) {
#pragma unroll
      for (int j = 0; j < 4; ++j) { const float* lo = lora + (w * 4 + j) * 64; const float4 lw = *(const float4*)(lo + jj), la = *(const float4*)(lo + 32 + jj);
        wv4[j] += lw.x * wup[jj]; wv4[j] += lw.y * wup[jj + 1]; wv4[j] += lw.z * wup[jj + 2]; wv4[j] += lw.w * wup[jj + 3];
        av4[j] += la.x * aup[jj]; av4[j] += la.y * aup[jj + 1]; av4[j] += la.z * aup[jj + 2]; av4[j] += la.w * aup[jj + 3]; }
    }
    float dec4[4], ar4[4], kkq[4], kmod4[4], n24[4], rk4[4];
#pragma unroll
    for (int j = 0; j < 4; ++j) {
      const float wlog = -softplus_fast(-wv4[j]) - 0.5f;
      dec4[j] = __expf(-__expf(wlog));
      ar4[j] = sigmoidf_(av4[j]);
      kkq[j] = kk4[j] * kkw;
      kmod4[j] = kk4[j] * (1.0f + (ar4[j] - 1.0f) * kaw);
      n24[j] = kkq[j] * kkq[j]; rk4[j] = rr[j] * kmod4[j] * rkw;
    }
#pragma unroll
    for (int st = 0; st < 4; ++st) {
      const int ctrl = st == 0 ? 0xB1 : st == 1 ? 0x4E : st == 2 ? 0x141 : 0x140;
#pragma unroll
      for (int j = 0; j < 4; ++j) {
        if (st == 0) { n24[j] += __builtin_bit_cast(float, __builtin_amdgcn_update_dpp(0, __builtin_bit_cast(int, n24[j]), 0xB1, 0xF, 0xF, true)); rk4[j] += __builtin_bit_cast(float, __builtin_amdgcn_update_dpp(0, __builtin_bit_cast(int, rk4[j]), 0xB1, 0xF, 0xF, true)); }
        else if (st == 1) { n24[j] += __builtin_bit_cast(float, __builtin_amdgcn_update_dpp(0, __builtin_bit_cast(int, n24[j]), 0x4E, 0xF, 0xF, true)); rk4[j] += __builtin_bit_cast(float, __builtin_amdgcn_update_dpp(0, __builtin_bit_cast(int, rk4[j]), 0x4E, 0xF, 0xF, true)); }
        else if (st == 2) { n24[j] += __builtin_bit_cast(float, __builtin_amdgcn_update_dpp(0, __builtin_bit_cast(int, n24[j]), 0x141, 0xF, 0xF, true)); rk4[j] += __builtin_bit_cast(float, __builtin_amdgcn_update_dpp(0, __builtin_bit_cast(int, rk4[j]), 0x141, 0xF, 0xF, true)); }
        else { n24[j] += __builtin_bit_cast(float, __builtin_amdgcn_update_dpp(0, __builtin_bit_cast(int, n24[j]), 0x140, 0xF, 0xF, true)); rk4[j] += __builtin_bit_cast(float, __builtin_amdgcn_update_dpp(0, __builtin_bit_cast(int, rk4[j]), 0x140, 0xF, 0xF, true)); }
      }
      (void)ctrl;
    }
    { float t0[4], t1[4];
#pragma unroll
      for (int j = 0; j < 4; ++j) { t0[j] = bperm(n24[j], lane ^ 16); t1[j] = bperm(rk4[j], lane ^ 16); }
#pragma unroll
      for (int j = 0; j < 4; ++j) { n24[j] += t0[j]; rk4[j] += t1[j]; }
#pragma unroll
      for (int j = 0; j < 4; ++j) { t0[j] = bperm(n24[j], lane ^ 32); t1[j] = bperm(rk4[j], lane ^ 32); }
#pragma unroll
      for (int j = 0; j < 4; ++j) { n24[j] += t0[j]; rk4[j] += t1[j]; } }
#pragma unroll
    for (int j = 0; j < 4; ++j) {
      const int t = item * 32 + sub + 2 * (g * 4 + j);
      const int tt = t & (TSEQ - 1), b = t >> 13;
      const float kkn = kkq[j] * __builtin_amdgcn_rsqf(fmaxf(n24[j], 1e-24f));
      const size_t idx = (size_t)(b * 4 + head) * TSEQ + tt;
      PW[idx * 64 + lane] = dec4[j];
      bf16_t* pv = PV + idx * 320;
      pv[lane] = f2bf(rr[j]); pv[64 + lane] = f2bf(kmod4[j]); pv[128 + lane] = f2bf(vv4[j]); pv[192 + lane] = f2bf(-kkn); pv[256 + lane] = f2bf(kkn * ar4[j]);
      if (lane == 0) RK[idx] = rk4[j];
    }
    __builtin_amdgcn_s_waitcnt(0xc07f);
    __builtin_amdgcn_wave_barrier();
  }
#undef PREP_LOAD
  __syncthreads();
}

#define RW_TILE_B (RW_TT * 1536)
struct RwRegs { float4 pw; uint4 pv0, pv1; };
__device__ __forceinline__ void rw_issue(const float* __restrict__ PW, const bf16_t* __restrict__ PV, size_t idx0, int tid, RwRegs& r) {
  if (tid < RW_TT * 16) { const int s = tid >> 4, q = tid & 15; r.pw = *(const float4*)(PW + (idx0 + s) * 64 + q * 4); }
  { const int c = tid; const int s = c / 40, q = c % 40; r.pv0 = *(const uint4*)(PV + (idx0 + s) * 320 + q * 8); }
  if (tid < RW_TT * 40 - NTHR) { const int c = tid + NTHR; const int s = c / 40, q = c % 40; r.pv1 = *(const uint4*)(PV + (idx0 + s) * 320 + q * 8); }
}
__device__ __forceinline__ void rw_put(float* dst, int c, const uint4 u) {
  const int s = c / 40, q = c % 40;
  const int vec = q >> 3, off = (q & 7) * 8;
  const int slot = vec == 0 ? 4 : vec == 1 ? 3 : vec == 2 ? 5 : vec == 3 ? 1 : 2;
  float* d = dst + s * 384 + slot * 64 + off;
  *(float4*)d = make_float4(__uint_as_float(u.x << 16), __uint_as_float(u.x & 0xffff0000u), __uint_as_float(u.y << 16), __uint_as_float(u.y & 0xffff0000u));
  *(float4*)(d + 4) = make_float4(__uint_as_float(u.z << 16), __uint_as_float(u.z & 0xffff0000u), __uint_as_float(u.w << 16), __uint_as_float(u.w & 0xffff0000u));
}
__device__ __forceinline__ void rw_commit(unsigned char* dstb, int tid, const RwRegs& r) {
  float* dst = (float*)dstb;
  if (tid < RW_TT * 16) { const int s = tid >> 4, q = tid & 15; *(float4*)(dst + s * 384 + q * 4) = r.pw; }
  rw_put(dst, tid, r.pv0);
  if (tid < RW_TT * 40 - NTHR) rw_put(dst, tid + NTHR, r.pv1);
}

#define LD8(dst, ptr) { const float4 x0_ = *(const float4*)(ptr), x1_ = *(const float4*)((ptr) + 4); dst[0] = (f32x2){x0_.x, x0_.y}; dst[1] = (f32x2){x0_.z, x0_.w}; dst[2] = (f32x2){x1_.x, x1_.y}; dst[3] = (f32x2){x1_.z, x1_.w}; }
struct RwOps { f32x2 w[4], a[4], b[4], k[4], r[4]; float vA, vB; };
template <int MODE>
__device__ __forceinline__ void rw_ldops(RwOps& o, const float* tb, int s, int q, int rowA, int rowB) {
  const float* sp = tb + s * 384 + q * 8;
  LD8(o.w, sp); LD8(o.a, sp + 64); LD8(o.b, sp + 128); LD8(o.k, sp + 192);
  o.vA = tb[s * 384 + 320 + rowA];
  if (MODE == 0) { LD8(o.r, sp + 256); o.vB = tb[s * 384 + 320 + rowB]; }
}
template <int MODE>
__device__ __forceinline__ void rw_step(const RwOps& o, f32x2 (&SA)[4], f32x2 (&SB)[4], float* yb, int s, int q, int rowA, int rowB) {
  f32x2 dA = SA[0] * o.a[0], dB = SB[0] * o.a[0];
#pragma unroll
  for (int e = 1; e < 4; ++e) { dA = SA[e] * o.a[e] + dA; dB = SB[e] * o.a[e] + dB; }
  const float dotA = red8(dA.x + dA.y), dotB = red8(dB.x + dB.y);
  const f32x2 dA2 = {dotA, dotA}, dB2 = {dotB, dotB}, vA2 = {o.vA, o.vA};
  if (MODE == 0) {
    const f32x2 vB2 = {o.vB, o.vB};
#pragma unroll
    for (int e = 0; e < 4; ++e) { SA[e] = SA[e] * o.w[e] + vA2 * o.k[e]; SA[e] = dA2 * o.b[e] + SA[e]; SB[e] = SB[e] * o.w[e] + vB2 * o.k[e]; SB[e] = dB2 * o.b[e] + SB[e]; }
    f32x2 yA = SA[0] * o.r[0], yB = SB[0] * o.r[0];
#pragma unroll
    for (int e = 1; e < 4; ++e) { yA = SA[e] * o.r[e] + yA; yB = SB[e] * o.r[e] + yB; }
    const float ya = red8(yA.x + yA.y), ybv = red8(yB.x + yB.y);
    if (q == 0) { yb[s * 64 + rowA] = ya; yb[s * 64 + rowB] = ybv; }
  } else {
#pragma unroll
    for (int e = 0; e < 4; ++e) { SA[e] = dA2 * o.b[e] + SA[e] * o.w[e]; SB[e] = SB[e] * o.w[e] + vA2 * o.k[e]; SB[e] = dB2 * o.b[e] + SB[e]; }
  }
}
template <int MODE>
__device__ __forceinline__ void rwkv_scan_item(KP P, int l, int bh, int chunk, unsigned char* lds, int wv_) {
  const float* PW = (const float*)(P->ws + WS_PW); const bf16_t* PV = (const bf16_t*)(P->ws + WS_PV); const float* RK = (const float*)(P->ws + WS_RK);
  float* PQ = (float*)(P->ws + WS_PQ);
  bf16_t* p = (bf16_t*)(P->ws + WS_P);
  const int tid = opaque_tid(wv_), lane = tid & 63, w = tid >> 6;
  const int q = lane & 7;
  const int rowA = (MODE == 0) ? ((w & 3) * 16 + (lane >> 3)) : (w * 8 + (lane >> 3));
  const int rowB = rowA + 8;
  const int b = bh >> 2, head = bh & 3;
  unsigned char* tile0 = lds;
  float* ybuf = (float*)(lds + 3 * RW_TILE_B);
  float* Sl = (float*)(lds + 3 * RW_TILE_B + 2 * RW_TT * 256);
  f32x2 SA[4], SB[4];
#pragma unroll
  for (int e = 0; e < 4; ++e) { SA[e] = (f32x2){0.f, 0.f}; SB[e] = (f32x2){0.f, 0.f}; }
  if (MODE == 1) {
#pragma unroll
    for (int e = 0; e < 4; ++e) SA[e] = (f32x2){(q * 8 + 2 * e == rowA) ? 1.f : 0.f, (q * 8 + 2 * e + 1 == rowA) ? 1.f : 0.f};
  }
  if (MODE == 0 && chunk > 0) {
    const float* Q0 = PQ + ((size_t)(bh * RW_C + 0) * 2 + 1) * 4096;
    float* cur = Sl; float* nxt = Sl + 64 * 65;
    for (int i = tid; i < 1024; i += NTHR) { const float4 v_ = *(const float4*)(Q0 + i * 4); float* d_ = cur + (i >> 4) * 65 + (i & 15) * 4; d_[0] = v_.x; d_[1] = v_.y; d_[2] = v_.z; d_[3] = v_.w; }
    float* Pl = (float*)lds;
    const float4 z4_ = make_float4(0.f, 0.f, 0.f, 0.f); const f32x4 zq_ = {0.f, 0.f, 0.f, 0.f};
    float4 cs0p0 = z4_, cs0p1 = z4_, cs1p0 = z4_, cs1p1 = z4_, cs2p0 = z4_, cs2p1 = z4_, cs3p0 = z4_, cs3p1 = z4_;
    f32x4 cs0q0 = zq_, cs0q1 = zq_, cs1q0 = zq_, cs1q1 = zq_, cs2q0 = zq_, cs2q1 = zq_, cs3q0 = zq_, cs3q1 = zq_;
    const int ti = w >> 1;
    const int qoff0 = 4096 + (ti * 16 + (lane >> 4) * 4) * 64 + ((w & 1) * 2 + 0) * 16 + (lane & 15);
#define CS_LOAD(S_, c_) { const float* Pm_ = PQ + ((size_t)(bh * RW_C + (c_)) * 2 + 0) * 4096; S_##p0 = *(const float4*)(Pm_ + tid * 4); S_##p1 = *(const float4*)(Pm_ + (tid + NTHR) * 4); \
      S_##q0 = (f32x4){Pm_[qoff0], Pm_[qoff0 + 64], Pm_[qoff0 + 128], Pm_[qoff0 + 192]}; S_##q1 = (f32x4){Pm_[qoff0 + 16], Pm_[qoff0 + 80], Pm_[qoff0 + 144], Pm_[qoff0 + 208]}; }
#define CS_STEP(S_, c_) { LBAR(); *(float4*)(Pl + (tid >> 4) * 80 + (tid & 15) * 4) = S_##p0; *(float4*)(Pl + ((tid + NTHR) >> 4) * 80 + (tid & 15) * 4) = S_##p1; const f32x4 qc0 = S_##q0, qc1 = S_##q1; \
      if ((c_) + 4 < chunk) CS_LOAD(S_, (c_) + 4); \
      LBAR(); \
      _Pragma("unroll") for (int jj = 0; jj < 2; ++jj) { const int tj = (w & 1) * 2 + jj; f32x4 acc = jj == 0 ? qc0 : qc1; \
        _Pragma("unroll") for (int ks = 0; ks < 16; ++ks) { const float a = cur[(ti * 16 + (lane & 15)) * 65 + ks * 4 + (lane >> 4)]; const float bb = Pl[(ks * 4 + (lane >> 4)) * 80 + tj * 16 + (lane & 15)]; \
          acc = __builtin_amdgcn_mfma_f32_16x16x4f32(a, bb, acc, 0, 0, 0); } \
        _Pragma("unroll") for (int r = 0; r < 4; ++r) nxt[(ti * 16 + (lane >> 4) * 4 + r) * 65 + tj * 16 + (lane & 15)] = acc[r]; } \
      float* t_ = cur; cur = nxt; nxt = t_; }
    if (1 < chunk) CS_LOAD(cs0, 1);
    if (2 < chunk) CS_LOAD(cs1, 2);
    if (3 < chunk) CS_LOAD(cs2, 3);
    if (4 < chunk) CS_LOAD(cs3, 4);
#pragma unroll 1
    for (int cc = 1; cc < chunk; cc += 4) {
      CS_STEP(cs0, cc);
      if (cc + 1 < chunk) CS_STEP(cs1, cc + 1);
      if (cc + 2 < chunk) CS_STEP(cs2, cc + 2);
      if (cc + 3 < chunk) CS_STEP(cs3, cc + 3);
    }
#undef CS_LOAD
#undef CS_STEP
    __syncthreads();
#pragma unroll
    for (int e = 0; e < 4; ++e) { SA[e] = (f32x2){cur[rowA * 65 + q * 8 + 2 * e], cur[rowA * 65 + q * 8 + 2 * e + 1]}; SB[e] = (f32x2){cur[rowB * 65 + q * 8 + 2 * e], cur[rowB * 65 + q * 8 + 2 * e + 1]}; }
    __syncthreads();
  }
  const size_t idxb = (size_t)bh * TSEQ + (size_t)chunk * RW_CL;
  const int ntile = RW_CL / RW_TT;
  RwRegs rr;
  rw_issue(PW, PV, idxb, tid, rr);
  rw_commit(tile0, tid, rr);
  const int chh = head * 64 + lane;
  const float lng = P->in[12][l * 256 + chh], lnb = P->in[13][l * 256 + chh];
  __syncthreads();
  const int nit = (MODE == 0) ? ntile + 1 : ntile;
  for (int tl = 0; tl < nit; ++tl) {
    if (tl + 1 < ntile) rw_issue(PW, PV, idxb + (size_t)(tl + 1) * RW_TT, tid, rr);
    if (MODE == 1 || w < 4) {
      if (tl < ntile) {
        const float* tb = (const float*)(tile0 + (tl % 3) * RW_TILE_B);
        float* yb = ybuf + (tl & 1) * (RW_TT * 64);
        RwOps oa, ob;
        rw_ldops<MODE>(oa, tb, 0, q, rowA, rowB);
        __builtin_amdgcn_sched_barrier(0);
#pragma unroll 1
        for (int s = 0; s < RW_TT; s += 2) {
          rw_ldops<MODE>(ob, tb, s + 1, q, rowA, rowB);
          __builtin_amdgcn_sched_barrier(0);
          rw_step<MODE>(oa, SA, SB, yb, s, q, rowA, rowB);
          __builtin_amdgcn_sched_barrier(0);
          if (s + 2 < RW_TT) rw_ldops<MODE>(oa, tb, s + 2, q, rowA, rowB);
          __builtin_amdgcn_sched_barrier(0);
          rw_step<MODE>(ob, SA, SB, yb, s + 1, q, rowA, rowB);
          __builtin_amdgcn_sched_barrier(0);
        }
      }
      if (tl + 1 < ntile) rw_commit(tile0 + ((tl + 1) % 3) * RW_TILE_B, tid, rr);
    } else {
      const int fw = w - 4;
      f32x4 gcu = {0.f, 0.f, 0.f, 0.f}, rkcu = {0.f, 0.f, 0.f, 0.f};
      if (tl > 0) {
#pragma unroll
        for (int u = 0; u < 4; ++u) { const int tt = chunk * RW_CL + (tl - 1) * RW_TT + fw + 4 * u;
          gcu[u] = bf2f(p[(size_t)(b * TSEQ + tt) * NIN + C_GA + chh]); rkcu[u] = RK[(size_t)bh * TSEQ + tt]; }
      }
      asm volatile("s_waitcnt vmcnt(0)" ::: "memory");
      if (tl + 1 < ntile) rw_commit(tile0 + ((tl + 1) % 3) * RW_TILE_B, tid, rr);
      __builtin_amdgcn_sched_barrier(0);
      if (tl > 0) {
        const float* tb = (const float*)(tile0 + ((tl - 1) % 3) * RW_TILE_B);
        const float* yb = ybuf + ((tl - 1) & 1) * (RW_TT * 64);
#pragma unroll
        for (int u = 0; u < 4; ++u) {
          const int s = fw + 4 * u;
          const int tt = chunk * RW_CL + (tl - 1) * RW_TT + s;
          const float y = yb[s * 64 + lane];
          const float mean = wave_sum(y, lane) * (1.0f / 64.0f);
          const float dlt = y - mean;
          const float var = wave_sum(dlt * dlt, lane) * (1.0f / 64.0f);
          float o = dlt * rsqrtf(var + 64e-5f) * lng + lnb;
          const float vv = tb[s * 384 + 320 + lane];
          o += rkcu[u] * vv;
          p[(size_t)(b * TSEQ + tt) * NIN + C_GA + chh] = f2bf(o * siluf_(gcu[u]));
        }
      }
    }
    LBAR();
  }
  if (MODE == 1) {
    float* Pm = PQ + ((size_t)(bh * RW_C + chunk) * 2 + 0) * 4096 + rowA * 64 + q * 8;
    *(float4*)Pm = make_float4(SA[0].x, SA[0].y, SA[1].x, SA[1].y); *(float4*)(Pm + 4) = make_float4(SA[2].x, SA[2].y, SA[3].x, SA[3].y);
    *(float4*)(Pm + 4096) = make_float4(SB[0].x, SB[0].y, SB[1].x, SB[1].y); *(float4*)(Pm + 4100) = make_float4(SB[2].x, SB[2].y, SB[3].x, SB[3].y);
  } else if (chunk == 0 && w < 4) {
    float* Qm = PQ + ((size_t)(bh * RW_C + 0) * 2 + 1) * 4096 + q * 8;
    *(float4*)(Qm + rowA * 64) = make_float4(SA[0].x, SA[0].y, SA[1].x, SA[1].y); *(float4*)(Qm + rowA * 64 + 4) = make_float4(SA[2].x, SA[2].y, SA[3].x, SA[3].y);
    *(float4*)(Qm + rowB * 64) = make_float4(SB[0].x, SB[0].y, SB[1].x, SB[1].y); *(float4*)(Qm + rowB * 64 + 4) = make_float4(SB[2].x, SB[2].y, SB[3].x, SB[3].y);
  }
  __syncthreads();
}

__device__ __forceinline__ void conv_item(KP P, int l, int item, unsigned char* lds, int wv_) {
#ifdef OFF_conv_item
  return;
#endif

  bf16_t* p = (bf16_t*)(P->ws + WS_P);
  float* u = (float*)lds;
  float* yb = (float*)(lds + 62 * 1024);
  const int tid = opaque_tid(wv_), c = tid & 255, half = tid >> 8;
  const int t0 = item * 32, tt0 = t0 & (TSEQ - 1);
  {
    bf16_t rv[31], rg[31];
#pragma unroll
    for (int i = 0; i < 31; ++i) { const int r = half + 2 * i; const bool ok = (tt0 - 30 + r) >= 0; const bf16_t* pr = p + (size_t)(t0 - 30 + r) * NIN;
      rv[i] = ok ? pr[C_CVAL + c] : (bf16_t)0; rg[i] = ok ? pr[C_CGLU + c] : (bf16_t)0; }
#pragma unroll
    for (int i = 0; i < 31; ++i) u[(half + 2 * i) * 256 + c] = bf2f(rv[i]) * sigmoidf_(bf2f(rg[i]));
  }
  float wv[31];
#pragma unroll
  for (int j = 0; j < 31; ++j) wv[j] = P->in[14][(l * 31 + j) * 256 + c];
  const float bias = P->in[15][l * 256 + c];
  __syncthreads();
  {
    float win[46];
#pragma unroll
    for (int i = 0; i < 46; ++i) win[i] = u[(half * 16 + i) * 256 + c];
#pragma unroll
    for (int i = 0; i < 16; ++i) {
      float acc = bias;
#pragma unroll
      for (int j = 0; j < 31; ++j) acc = fmaf(wv[j], win[i + j], acc);
      yb[(half * 16 + i) * 256 + c] = acc;
    }
  }
  __syncthreads();
  const int lane = tid & 63, w = tid >> 6;
  const float4 g = *(const float4*)(P->in[16] + l * 256 + lane * 4), bb = *(const float4*)(P->in[17] + l * 256 + lane * 4);
  uint2 gpre[4];
#pragma unroll
  for (int i = 0; i < 4; ++i) gpre[i] = *(const uint2*)(p + (size_t)(t0 + w * 4 + i) * NIN + C_CGATE + lane * 4);
#pragma unroll
  for (int i = 0; i < 4; ++i) {
    const int tk = w * 4 + i;
    const float4 v = *(const float4*)(yb + tk * 256 + lane * 4);
    const float mean = wave_sum(v.x + v.y + v.z + v.w, lane) * (1.0f / 256.0f);
    const float d0 = v.x - mean, d1 = v.y - mean, d2 = v.z - mean, d3 = v.w - mean;
    const float var = wave_sum(d0 * d0 + d1 * d1 + d2 * d2 + d3 * d3, lane) * (1.0f / 256.0f);
    const float rs = rsqrtf(var + 1e-5f);
    bf16_t* gp = p + (size_t)(t0 + tk) * NIN + C_CGATE + lane * 4;
    const uint2 gu = gpre[i];
    const float o0 = siluf_(d0 * rs * g.x + bb.x) * siluf_(__uint_as_float(gu.x << 16));
    const float o1 = siluf_(d1 * rs * g.y + bb.y) * siluf_(__uint_as_float(gu.x & 0xffff0000u));
    const float o2 = siluf_(d2 * rs * g.z + bb.z) * siluf_(__uint_as_float(gu.y << 16));
    const float o3 = siluf_(d3 * rs * g.w + bb.w) * siluf_(__uint_as_float(gu.y & 0xffff0000u));
    uint2 o; o.x = pack2(o0, o1); o.y = pack2(o2, o3);
    *(uint2*)gp = o;
  }
  __syncthreads();
}

#define HG_WLDS 10240
__device__ __forceinline__ float hgrn_lb(KP P, int l, int ch) {
  if (l == 0) return 0.f;
  const float x0 = P->in[18][ch], x1 = P->in[18][256 + ch];
  return __builtin_amdgcn_rcpf(1.0f + __expf(x0 - x1));
}
template <int PASS>
__device__ __forceinline__ void hgrn_wave_item(KP P, int l, int wi, unsigned char* lds, int wv_) {
#ifdef OFF_hgrn_wave_item
  return;
#endif

  bf16_t* p = (bf16_t*)(P->ws + WS_P);
  float* HS = (float*)(P->ws + WS_HS); float* HF = (float*)(P->ws + WS_HF);
  const int tid = opaque_tid(wv_);
  const int lane = tid & 63, w = tid >> 6;
  const int bh = wi >> 7, chunk = wi & 127, b = bh >> 2, head = bh & 3;
  float* st = (float*)(lds + w * HG_WLDS);
  float* ob = st + 2048;
  const int kg = lane & 7, vg = lane >> 3;
  const int ch = head * 64 + lane;
  const float lb = hgrn_lb(P, l, ch);
  const float ng = P->in[19][l * 256 + ch];
  float S[8][8];
  float* slot = HS + (size_t)(bh * 128 + chunk) * 4096;
  if (PASS == 1) {
#pragma unroll
    for (int i = 0; i < 8; ++i) { const float4 x0 = *(const float4*)(slot + (kg * 8 + i) * 64 + vg * 8), x1 = *(const float4*)(slot + (kg * 8 + i) * 64 + vg * 8 + 4);
      S[i][0] = x0.x; S[i][1] = x0.y; S[i][2] = x0.z; S[i][3] = x0.w; S[i][4] = x1.x; S[i][5] = x1.y; S[i][6] = x1.z; S[i][7] = x1.w; }
  } else {
#pragma unroll
    for (int i = 0; i < 8; ++i)
#pragma unroll
      for (int j = 0; j < 8; ++j) S[i][j] = 0.f;
  }
  float Fp = 1.f;
  bf16_t rf[8], ri[8], rq[8], rg[8];
  {
    const int tb0 = b * TSEQ + chunk * 64;
#pragma unroll
    for (int s = 0; s < 8; ++s) { const bf16_t* pr = p + (size_t)(tb0 + s) * NIN; rf[s] = pr[C_HF + ch]; ri[s] = pr[C_HI + ch]; if (PASS == 1) { rq[s] = pr[C_HQ + ch]; rg[s] = pr[C_HG + ch]; } }
  }
#pragma unroll 1
  for (int sub = 0; sub < 8; ++sub) {
    const int tbase = b * TSEQ + chunk * 64 + sub * 8;
    bf16_t gc[8];
#pragma unroll
    for (int s = 0; s < 8; ++s) {
      const float f = lb + (1.0f - lb) * sigmoidf_(bf2f(rf[s]));
      Fp *= f;
      st[s * 256 + lane] = f; st[s * 256 + 64 + lane] = 1.0f - f;
      if (PASS == 1) { st[s * 256 + 128 + lane] = siluf_(bf2f(rq[s])); gc[s] = rg[s]; }
      st[s * 256 + 192 + lane] = bf2f(ri[s]);
    }
    if (sub < 7) {
#pragma unroll
      for (int s = 0; s < 8; ++s) { const bf16_t* pr = p + (size_t)(tbase + 8 + s) * NIN; rf[s] = pr[C_HF + ch]; ri[s] = pr[C_HI + ch]; if (PASS == 1) { rq[s] = pr[C_HQ + ch]; rg[s] = pr[C_HG + ch]; } }
    }
    __builtin_amdgcn_s_waitcnt(0xc07f);
    __builtin_amdgcn_wave_barrier();
#pragma unroll 1
    for (int s = 0; s < 8; ++s) {
      const float* sp = st + s * 256;
      const float4 f0 = *(const float4*)(sp + kg * 8), f1 = *(const float4*)(sp + kg * 8 + 4);
      const float4 k0 = *(const float4*)(sp + 64 + kg * 8), k1 = *(const float4*)(sp + 64 + kg * 8 + 4);
      const float4 v0 = *(const float4*)(sp + 192 + vg * 8), v1 = *(const float4*)(sp + 192 + vg * 8 + 4);
      const float fv[8] = {f0.x, f0.y, f0.z, f0.w, f1.x, f1.y, f1.z, f1.w};
      const float kv[8] = {k0.x, k0.y, k0.z, k0.w, k1.x, k1.y, k1.z, k1.w};
      const float vv[8] = {v0.x, v0.y, v0.z, v0.w, v1.x, v1.y, v1.z, v1.w};
      const f32x2 vv2[4] = {{vv[0], vv[1]}, {vv[2], vv[3]}, {vv[4], vv[5]}, {vv[6], vv[7]}};
#pragma unroll
      for (int i = 0; i < 8; ++i) { const f32x2 f2 = {fv[i], fv[i]}, k2 = {kv[i], kv[i]};
#pragma unroll
        for (int j = 0; j < 4; ++j) { f32x2 s2 = {S[i][2 * j], S[i][2 * j + 1]}; s2 = f2 * s2 + k2 * vv2[j]; S[i][2 * j] = s2.x; S[i][2 * j + 1] = s2.y; } }
      if (PASS == 1) {
        const float4 q0 = *(const float4*)(sp + 128 + kg * 8), q1 = *(const float4*)(sp + 128 + kg * 8 + 4);
        const float qv[8] = {q0.x, q0.y, q0.z, q0.w, q1.x, q1.y, q1.z, q1.w};
        float o[8];
#pragma unroll
        for (int j = 0; j < 4; ++j) { f32x2 a2 = (f32x2){qv[0], qv[0]} * (f32x2){S[0][2 * j], S[0][2 * j + 1]};
#pragma unroll
          for (int i = 1; i < 8; ++i) a2 = (f32x2){qv[i], qv[i]} * (f32x2){S[i][2 * j], S[i][2 * j + 1]} + a2;
          o[2 * j] = red8(a2.x); o[2 * j + 1] = red8(a2.y); }
        if (kg == 0) { *(float4*)(ob + s * 64 + vg * 8) = make_float4(o[0], o[1], o[2], o[3]); *(float4*)(ob + s * 64 + vg * 8 + 4) = make_float4(o[4], o[5], o[6], o[7]); }
      }
    }
    __builtin_amdgcn_s_waitcnt(0xc07f);
    __builtin_amdgcn_wave_barrier();
    if (PASS == 1) {
#pragma unroll
      for (int s = 0; s < 8; ++s) {
        const float o = ob[s * 64 + lane];
        const float ms = wave_sum(o * o, lane) * (1.0f / 64.0f);
        p[(size_t)(tbase + s) * NIN + C_HG + ch] = f2bf(o * rsqrtf(ms + 1e-6f) * ng * siluf_(bf2f(gc[s])));
      }
      __builtin_amdgcn_s_waitcnt(0xc07f);
      __builtin_amdgcn_wave_barrier();
    }
  }
  if (PASS == 0) {
#pragma unroll
    for (int i = 0; i < 8; ++i) { *(float4*)(slot + (kg * 8 + i) * 64 + vg * 8) = make_float4(S[i][0], S[i][1], S[i][2], S[i][3]);
      *(float4*)(slot + (kg * 8 + i) * 64 + vg * 8 + 4) = make_float4(S[i][4], S[i][5], S[i][6], S[i][7]); }
    HF[(size_t)(bh * 128 + chunk) * 64 + lane] = Fp;
  }
}
__device__ __forceinline__ void hgrn_combine_item(KP P, int bh, int wv_) {
#ifdef OFF_hgrn_combine_item
  return;
#endif

  float* HS = (float*)(P->ws + WS_HS); const float* HF = (const float*)(P->ws + WS_HF);
  const int tid = opaque_tid(wv_);
  const int krow = tid >> 3;
  float R[8];
#pragma unroll
  for (int e = 0; e < 8; ++e) R[e] = 0.f;
  float4 xa[8][2]; float fa[8];
#pragma unroll
  for (int u = 0; u < 8; ++u) { const float* sl = HS + (size_t)(bh * 128 + u) * 4096 + tid * 8; xa[u][0] = *(const float4*)sl; xa[u][1] = *(const float4*)(sl + 4); fa[u] = HF[(size_t)(bh * 128 + u) * 64 + krow]; }
#pragma unroll 1
  for (int c0 = 0; c0 < 128; c0 += 8) {
    float4 xn[8][2]; float fn[8];
    if (c0 + 8 < 128) {
#pragma unroll
      for (int u = 0; u < 8; ++u) { const float* sl = HS + (size_t)(bh * 128 + c0 + 8 + u) * 4096 + tid * 8; xn[u][0] = *(const float4*)sl; xn[u][1] = *(const float4*)(sl + 4); fn[u] = HF[(size_t)(bh * 128 + c0 + 8 + u) * 64 + krow]; }
    }
#pragma unroll
    for (int u = 0; u < 8; ++u) {
      float* sl = HS + (size_t)(bh * 128 + c0 + u) * 4096 + tid * 8;
      *(float4*)sl = make_float4(R[0], R[1], R[2], R[3]); *(float4*)(sl + 4) = make_float4(R[4], R[5], R[6], R[7]);
      const float f = fa[u];
      R[0] = fmaf(f, R[0], xa[u][0].x); R[1] = fmaf(f, R[1], xa[u][0].y); R[2] = fmaf(f, R[2], xa[u][0].z); R[3] = fmaf(f, R[3], xa[u][0].w);
      R[4] = fmaf(f, R[4], xa[u][1].x); R[5] = fmaf(f, R[5], xa[u][1].y); R[6] = fmaf(f, R[6], xa[u][1].z); R[7] = fmaf(f, R[7], xa[u][1].w);
    }
    if (c0 + 8 < 128) {
#pragma unroll
      for (int u = 0; u < 8; ++u) { xa[u][0] = xn[u][0]; xa[u][1] = xn[u][1]; fa[u] = fn[u]; }
    }
  }
}

__device__ __forceinline__ void sb_item(KP P, int item, unsigned char* lds, int wv_) {
#ifdef OFF_sb_item
  return;
#endif

  bf16_t* p = (bf16_t*)(P->ws + WS_P);
  const int tid = opaque_tid(wv_), lane = tid & 63, w = tid >> 6;
  const int qt = item & 127, bh = item >> 7, b = bh >> 2, head = bh & 3;
  unsigned char* Qs = lds;
  unsigned char* Ks = lds + 9216;
  unsigned char* Vt = lds + 18432;
  unsigned char* As = lds + 27648;
  float* Zs = (float*)(lds + 36864);
  volatile int* flag = (volatile int*)(lds + 36864 + 64 * 65 * 4);
  const int lrow = tid >> 3, lch = (tid & 7);
  const size_t tokq = (size_t)b * TSEQ + qt * 64;
  *(uint4*)(Qs + lrow * 144 + lch * 16) = *(const uint4*)(p + (tokq + lrow) * NIN + C_SQ + head * 64 + lch * 8);
  float carry = 0.f;
  f32x4 oacc[2] = {{0.f, 0.f, 0.f, 0.f}, {0.f, 0.f, 0.f, 0.f}};
  const int qi = w >> 1, t2 = (w & 1) * 2;
  f32x4 gpre0, gpre1;
#pragma unroll
  for (int r = 0; r < 4; ++r) { const bf16_t* gp_ = p + (tokq + qi * 16 + (lane >> 4) * 4 + r) * NIN + C_SG + head * 64 + t2 * 16 + (lane & 15); gpre0[r] = bf2f(gp_[0]); gpre1[r] = bf2f(gp_[16]); }
  const int q = tid >> 3, seg = tid & 7;
  uint4 kreg = *(const uint4*)(p + (tokq + lrow) * NIN + C_SK + head * 64 + lch * 8);
  const int vkey = tid & 63, vch = tid >> 6;
  uint4 vreg = *(const uint4*)(p + (tokq + vkey) * NIN + C_SV + head * 64 + vch * 8);
  for (int kt = qt; kt >= 0; --kt) {
    LBAR();
    *(uint4*)(Ks + lrow * 144 + lch * 16) = kreg;
    { const unsigned vw[4] = {vreg.x, vreg.y, vreg.z, vreg.w};
#pragma unroll
      for (int e = 0; e < 8; ++e) *(unsigned short*)(Vt + (vch * 8 + e) * 144 + vkey * 2) = (unsigned short)((e & 1) ? (vw[e >> 1] >> 16) : (vw[e >> 1] & 0xffffu)); }
    if (tid == 0) *flag = 0;
    if (kt > 0) { const size_t tokn = (size_t)b * TSEQ + (kt - 1) * 64;
      kreg = *(const uint4*)(p + (tokn + lrow) * NIN + C_SK + head * 64 + lch * 8);
      vreg = *(const uint4*)(p + (tokn + vkey) * NIN + C_SV + head * 64 + vch * 8); }
    LBAR();
#pragma unroll
    for (int jj = 0; jj < 2; ++jj) {
      const int ki = t2 + jj;
      f32x4 acc = {0.f, 0.f, 0.f, 0.f};
#pragma unroll
      for (int s = 0; s < 2; ++s) {
        const bf16x8 a = *(const bf16x8*)(Qs + (qi * 16 + (lane & 15)) * 144 + s * 64 + (lane >> 4) * 16);
        const bf16x8 bb = *(const bf16x8*)(Ks + (ki * 16 + (lane & 15)) * 144 + s * 64 + (lane >> 4) * 16);
        acc = __builtin_amdgcn_mfma_f32_16x16x32_bf16(a, bb, acc, 0, 0, 0);
      }
#pragma unroll
      for (int r = 0; r < 4; ++r) Zs[(qi * 16 + (lane >> 4) * 4 + r) * 65 + ki * 16 + (lane & 15)] = acc[r] * 0.125f;
    }
    LBAR();
    {
      const int tq = qt * 64 + q;
      float z[8], lk[8];
      float tot = 0.f;
#pragma unroll
      for (int e = 0; e < 8; ++e) {
        z[e] = Zs[q * 65 + seg * 8 + e];
        const bool m = (kt * 64 + seg * 8 + e) < tq;
        lk[e] = m ? -softplus_fast(z[e]) : 0.f;
        tot += lk[e];
      }
      float inc = tot;
      { float t_ = __builtin_bit_cast(float, __builtin_amdgcn_update_dpp(0, __builtin_bit_cast(int, inc), 0x101, 0xF, 0xF, true)); if (seg + 1 < 8) inc += t_; }
      { float t_ = __builtin_bit_cast(float, __builtin_amdgcn_update_dpp(0, __builtin_bit_cast(int, inc), 0x102, 0xF, 0xF, true)); if (seg + 2 < 8) inc += t_; }
      { float t_ = __builtin_bit_cast(float, __builtin_amdgcn_update_dpp(0, __builtin_bit_cast(int, inc), 0x104, 0xF, 0xF, true)); if (seg + 4 < 8) inc += t_; }
      const float rowtot = red8(tot);
      float tail = carry + (inc - tot);
      float av[8];
#pragma unroll
      for (int e = 7; e >= 0; --e) {
        const bool m = (kt * 64 + seg * 8 + e) < tq;
        av[e] = m ? __expf(z[e] + lk[e] + tail) : 0.f;
        tail += lk[e];
      }
      uint4 o; o.x = pack2(av[0], av[1]); o.y = pack2(av[2], av[3]); o.z = pack2(av[4], av[5]); o.w = pack2(av[6], av[7]);
      *(uint4*)(As + q * 144 + seg * 16) = o;
      carry += rowtot;
      if (carry > -104.f) *flag = 1;
    }
    LBAR();
#pragma unroll
    for (int jj = 0; jj < 2; ++jj) {
      const int di = t2 + jj;
#pragma unroll
      for (int s = 0; s < 2; ++s) {
        const bf16x8 a = *(const bf16x8*)(As + (qi * 16 + (lane & 15)) * 144 + s * 64 + (lane >> 4) * 16);
        const bf16x8 bb = *(const bf16x8*)(Vt + (di * 16 + (lane & 15)) * 144 + s * 64 + (lane >> 4) * 16);
        oacc[jj] = __builtin_amdgcn_mfma_f32_16x16x32_bf16(a, bb, oacc[jj], 0, 0, 0);
      }
    }
    if (*flag == 0) break;
  }
#pragma unroll
  for (int jj = 0; jj < 2; ++jj) {
    const int d = (t2 + jj) * 16 + (lane & 15);
#pragma unroll
    for (int r = 0; r < 4; ++r) {
      const int qq = qi * 16 + (lane >> 4) * 4 + r;
      bf16_t* gp = p + (tokq + qq) * NIN + C_SG + head * 64 + d;
      *gp = f2bf(oacc[jj][r] * siluf_(jj == 0 ? gpre0[r] : gpre1[r]));
    }
  }
  __syncthreads();
}

__device__ __forceinline__ void xattn_item(KP P, int l, int item, unsigned char* lds, int wv_) {
  const bf16_t* qb = (const bf16_t*)(P->ws + WS_P + 32ull * MiB);
  bf16_t* ob = (bf16_t*)(P->ws + WS_P + 64ull * MiB);
  const bf16_t* kv = (const bf16_t*)(P->ws + WS_KV) + (size_t)l * 512 * 2048;
  const bf16_t* vt = (const bf16_t*)(P->ws + WS_VT) + (size_t)l * 2 * 1024 * 256;
  const int tid = opaque_tid(wv_), lane = tid & 63, w = tid >> 6;
  const int qt = item & 127, bh = item >> 7, b = bh >> 2, head = bh & 3;
  unsigned char* Qs = lds;
  unsigned char* KVs = lds + 33792;
  float* Ss = (float*)(lds + 67584);
  const size_t tok0 = (size_t)b * TSEQ + qt * 64;
  const int pr = tid >> 5, pc = tid & 31;
  uint4 pg0, pg1, pg2, pg3;
#define XA_LOAD(p_) { const bf16_t* s_ = (p_) < 4 ? kv + (size_t)(b * 256 + (p_) * 64 + pr) * 2048 + head * 256 + pc * 8 : vt + (size_t)(b * 1024 + head * 256 + ((p_) - 4) * 64 + pr) * 256 + pc * 8; \
      const size_t st_ = (p_) < 4 ? (size_t)16 * 2048 : (size_t)16 * 256; \
      pg0 = *(const uint4*)(s_); pg1 = *(const uint4*)(s_ + st_); pg2 = *(const uint4*)(s_ + 2 * st_); pg3 = *(const uint4*)(s_ + 3 * st_); }
  __syncthreads();
#pragma unroll
  for (int i = 0; i < 4; ++i) { const int r = pr + 16 * i; *(uint4*)(Qs + r * 528 + pc * 16) = *(const uint4*)(qb + (tok0 + r) * 1024 + head * 256 + pc * 8); }
  XA_LOAD(0);
  const int qi = w >> 1, t2 = (w & 1) * 2;
#pragma unroll 1
  for (int p = 0; p < 8; ++p) {
    LBAR();
    { unsigned char* d_ = KVs + pr * 528 + pc * 16; *(uint4*)d_ = pg0; *(uint4*)(d_ + 16 * 528) = pg1; *(uint4*)(d_ + 32 * 528) = pg2; *(uint4*)(d_ + 48 * 528) = pg3; }
    if (p < 7) XA_LOAD(p + 1);
    LBAR();
    f32x4 acc0 = {0.f, 0.f, 0.f, 0.f}, acc1 = {0.f, 0.f, 0.f, 0.f};
#pragma unroll
    for (int s = 0; s < 8; ++s) {
      const bf16x8 a = *(const bf16x8*)(Qs + (qi * 16 + (lane & 15)) * 528 + s * 64 + (lane >> 4) * 16);
      const bf16x8 b0 = *(const bf16x8*)(KVs + (t2 * 16 + (lane & 15)) * 528 + s * 64 + (lane >> 4) * 16);
      const bf16x8 b1 = *(const bf16x8*)(KVs + ((t2 + 1) * 16 + (lane & 15)) * 528 + s * 64 + (lane >> 4) * 16);
      acc0 = __builtin_amdgcn_mfma_f32_16x16x32_bf16(a, b0, acc0, 0, 0, 0);
      acc1 = __builtin_amdgcn_mfma_f32_16x16x32_bf16(a, b1, acc1, 0, 0, 0);
    }
    if (p < 4) {
#pragma unroll
      for (int r = 0; r < 4; ++r) { float* d_ = Ss + (qi * 16 + (lane >> 4) * 4 + r) * 260 + p * 64 + t2 * 16 + (lane & 15); d_[0] = acc0[r] * 0.0625f; d_[16] = acc1[r] * 0.0625f; }
      if (p == 3) {
        LBAR();
        const int q = tid >> 3, seg = tid & 7;
        float x[32]; float mx = -3.0e38f;
#pragma unroll
        for (int i = 0; i < 8; ++i) { const float4 v = *(const float4*)(Ss + q * 260 + seg * 32 + i * 4); x[i * 4] = v.x; x[i * 4 + 1] = v.y; x[i * 4 + 2] = v.z; x[i * 4 + 3] = v.w;
          mx = fmaxf(mx, fmaxf(fmaxf(v.x, v.y), fmaxf(v.z, v.w))); }
        mx = max8(mx);
        float sum = 0.f;
#pragma unroll
        for (int i = 0; i < 32; ++i) { x[i] = __expf(x[i] - mx); sum += x[i]; }
        sum = red8(sum);
        const float inv = __builtin_amdgcn_rcpf(sum);
#pragma unroll
        for (int i = 0; i < 4; ++i) { uint4 o; o.x = pack2(x[i * 8] * inv, x[i * 8 + 1] * inv); o.y = pack2(x[i * 8 + 2] * inv, x[i * 8 + 3] * inv);
          o.z = pack2(x[i * 8 + 4] * inv, x[i * 8 + 5] * inv); o.w = pack2(x[i * 8 + 6] * inv, x[i * 8 + 7] * inv);
          *(uint4*)(Qs + q * 528 + seg * 64 + i * 16) = o; }
      }
    } else {
#pragma unroll
      for (int r = 0; r < 4; ++r) { bf16_t* d_ = ob + (tok0 + qi * 16 + (lane >> 4) * 4 + r) * 1024 + head * 256 + (p - 4) * 64 + t2 * 16 + (lane & 15); d_[0] = f2bf(acc0[r]); d_[16] = f2bf(acc1[r]); }
    }
  }
#undef XA_LOAD
  __syncthreads();
}

__device__ __forceinline__ void wt_item(KP P, int l, int r, unsigned char* lds, int wv_) {
  const float* W; int N; bf16_t* Wt; int kt, nt; const float* gk = nullptr;
  unsigned char* wl = P->ws + WS_WT + l * WT_LAYER;
  if (r < 976) { W = P->in[3] + (size_t)l * 1024 * NIN; N = NIN; Wt = (bf16_t*)(wl + WT_IN); kt = r / 61; nt = r % 61; gk = P->in[2] + l * 1024; }
  else { r -= 976; const int m = r >> 8; r &= 255; kt = r >> 4; nt = r & 15; N = 1024;
    if (m == 0) { W = P->in[20] + (size_t)l * 1048576; Wt = (bf16_t*)(wl + WT_OUT); }
    else if (m == 1) { W = P->in[23] + (size_t)l * 1048576; Wt = (bf16_t*)(wl + WT_Q); gk = P->in[21] + l * 1024; }
    else if (m == 2) { W = P->in[24] + (size_t)l * 1048576; Wt = (bf16_t*)(wl + WT_KV); }
    else if (m == 3) { W = P->in[25] + (size_t)l * 1048576; Wt = (bf16_t*)(wl + WT_KV) + 1024 * 1024; }
    else { W = P->in[26] + (size_t)l * 1048576; Wt = (bf16_t*)(wl + WT_O); } }
  wt_tile(W, N, Wt, kt, nt, lds, wv_, gk);
}
__device__ __forceinline__ void wt_deferred(KP P, int d, unsigned char* lds, int wv_) {
  if (d < 768) { const int m = d >> 8, r = d & 255; wt_item(P, 0, 976 + (m == 0 ? 0 : m == 1 ? 256 : 1024) + r, lds, wv_); }
  else wt_item(P, 1, d - 768, lds, wv_);
}
__device__ __forceinline__ int next_item(unsigned* ctr, volatile LAS int* slot, int wv_) {
  __syncthreads();
  if (opaque_tid(wv_) == 0) *slot = (int)__hip_atomic_fetch_add(ctr, 1u, __ATOMIC_RELAXED, __HIP_MEMORY_SCOPE_AGENT);
  __syncthreads();
  return *slot;
}
__global__ void __launch_bounds__(NTHR) fwd_megakernel(Params Pk_unused) {
  KP P = (KP)__builtin_amdgcn_kernarg_segment_ptr();
  extern __shared__ __attribute__((aligned(16))) unsigned char lds[];
  const int wv_ = __builtin_amdgcn_readfirstlane((int)threadIdx.x >> 6);
  __shared__ uint4 xb_words;
  __shared__ int4 wq_slot;
  if (opaque_tid(wv_) == 0) xb_words = make_uint4(0u, 0u, 0u, 0u);
  __syncthreads();
#ifdef PROBE_J
  __shared__ unsigned long long tacc[32];
  __shared__ unsigned long long tlast;
  __shared__ float pdelta;
  if (opaque_tid(wv_) == 0) { for (int i = 0; i < 32; ++i) tacc[i] = 0ull; tlast = __builtin_amdgcn_s_memrealtime(); pdelta = 0.f; }
#define STAMP(k) if (opaque_tid(wv_) == 0) { const unsigned long long n_ = __builtin_amdgcn_s_memrealtime(); tacc[k] += n_ - tlast; tlast = n_; }
#else
#define STAMP(k)
#endif
  XcdBarrier bar = xcd_barrier_post((unsigned*)(P->ws + WS_BAR), (volatile LAS unsigned*)&xb_words, wv_);
  if (P->never) cg::this_grid().sync();
  const int G = gridDim.x, bid0 = blockIdx.x;

  for (int it = bid0; it < 976 + 512; it += G) wt_item(P, 0, it < 976 ? it : it + 512, lds, wv_);
#pragma unroll 1
  for (int k = 0; k < 3; ++k) {
    const float* s_ = k < 2 ? P->in[1] : P->in[0];
    const float* g_ = k < 2 ? P->in[22] + k * 1024 : P->in[2];
    bf16_t* d_ = k < 2 ? (bf16_t*)(P->ws + WS_MEMN) + k * 512 * 1024 : (bf16_t*)(P->ws + WS_R1);
    norm_rows(false, s_, g_, d_, k < 2 ? 512 : NT, 0.f, wv_, k < 2 ? nullptr : (float*)(P->ws + WS_SSQ));
  }
  { float* z_ = (float*)(P->ws + WS_SSQ) + NT; for (int i = bid0 * NTHR + opaque_tid(wv_); i < 4 * NT; i += G * NTHR) z_[i] = 0.f; }
  STAMP(16 + 10); xcd_barrier(bar, wv_); STAMP(10)
  asm volatile("" : "+s"(P));

#pragma unroll 1
  for (int it = 0; it < 17; ++it) {
    int l = it >> 3, ph = it & 7;
    ph = ph < 5 ? ph : ph + 1;
    if (it == 16) { l = 1; ph = 9; }
    asm volatile("" : "+s"(P));
    int bid = bid0; asm volatile("" : "+s"(bid));

    unsigned char* ws = P->ws;
    const unsigned char* wl = ws + WS_WT + l * WT_LAYER;
    bf16_t* hbuf = (bf16_t*)(ws + WS_R1);
    float* ssq = (float*)(ws + WS_SSQ);
    bf16_t* pbuf = (bf16_t*)(ws + WS_P);
    bf16_t* hx = (bf16_t*)(ws + WS_P);
    bf16_t* qbuf = (bf16_t*)(ws + WS_P + 32ull * MiB);
    bf16_t* obuf = (bf16_t*)(ws + WS_P + 64ull * MiB);
    if (ph == 0 || ph == 4 || ph == 6 || ph == 8) {
      pg8::Gemm g; pg8::TileSched S; pg8::EpiDyn E;
      g.M = NT; g.K = 1024; S.G = G; S.c = bid;
      if (ph == 0) { g.A = hbuf; g.Bt = (const bf16_t*)(wl + WT_IN); g.N = 4096; g.lda = 1024; g.ao0 = 0; g.ao1 = 256; g.ao2 = 512; g.ao3 = 768; S.nt = 1024; S.nN = 16;
        E.mode = 0; E.O = pbuf; E.ldc = NIN; E.N = NIN; E.resid = nullptr; E.out = nullptr; E.ssq_in = ssq + (l == 0 ? 0 : 2) * NT; E.xb = nullptr; E.ssq_out = nullptr; }
      else if (ph == 4) { g.A = pbuf; g.Bt = (const bf16_t*)(wl + WT_OUT); g.N = 1024; g.lda = NIN; g.ao0 = C_GA; g.ao1 = C_CGATE; g.ao2 = C_HG; g.ao3 = C_SG; S.nt = 256; S.nN = 4;
        E.mode = 1; E.O = nullptr; E.ldc = 1024; E.N = 1024; E.resid = (l == 0) ? P->in[0] : P->out; E.out = P->out; E.ssq_in = nullptr; E.xb = hbuf; E.ssq_out = ssq + (l == 0 ? 1 : 3) * NT; }
      else if (ph == 6) { g.A = hbuf; g.Bt = (const bf16_t*)(wl + WT_Q); g.N = 1024; g.lda = 1024; g.ao0 = 0; g.ao1 = 256; g.ao2 = 512; g.ao3 = 768; S.nt = 256; S.nN = 4;
        E.mode = 0; E.O = qbuf; E.ldc = 1024; E.N = 1024; E.resid = nullptr; E.out = nullptr; E.ssq_in = ssq + (l == 0 ? 1 : 3) * NT; E.xb = nullptr; E.ssq_out = nullptr; }
      else { g.A = obuf; g.Bt = (const bf16_t*)(wl + WT_O); g.N = 1024; g.lda = 1024; g.ao0 = 0; g.ao1 = 256; g.ao2 = 512; g.ao3 = 768; S.nt = 256; S.nN = 4;
        E.mode = 1; E.O = nullptr; E.ldc = 1024; E.N = 1024; E.resid = P->out; E.out = P->out; E.ssq_in = nullptr; E.xb = hbuf; E.ssq_out = ssq + (l == 0 ? 2 : 4) * NT; }
      pg8::gemm_phase<pg8::EpiDyn, pg8::TileSched, true, true>((PG8_LAS unsigned char*)lds, g, S, E, wv_);
    } else if (ph == 1) {
      unsigned* ctr = (unsigned*)(ws + WS_BAR) + it;
      for (;;) {
        const int i2 = next_item(ctr, (volatile LAS int*)&wq_slot, wv_);
        if (i2 >= 640) break;
        if (i2 < 128) hgrn_wave_item<0>(P, l, i2 * 8 + wv_, lds, wv_);
        else rwkv_prep_item(P, l, i2 - 128, lds, wv_);
      }
    } else if (ph == 2) {
      const int n_p1 = 8 * (RW_C - 2);
      const int n_rw = n_p1 + 8;
      const int n_oth = 8 + 512 + 1024;
      for (int i2 = bid; i2 < n_rw; i2 += G) {
        if (i2 < n_p1) rwkv_scan_item<1>(P, l, i2 & 7, 1 + (i2 >> 3), lds, wv_);
        else rwkv_scan_item<0>(P, l, i2 - n_p1, 0, lds, wv_);
      }
      {
        unsigned* ctr = (unsigned*)(ws + WS_BAR) + it;
        for (;;) {
          const int i2 = next_item(ctr, (volatile LAS int*)&wq_slot, wv_);
          if (i2 >= n_oth) break;
          if (i2 < 8) hgrn_combine_item(P, i2, wv_);
          else if (i2 < 8 + 512) conv_item(P, l, i2 - 8, lds, wv_);
          else sb_item(P, i2 - 8 - 512, lds, wv_);
        }
      }
    } else if (ph == 3) {
      const int n_p3 = 8 * (RW_C - 1);
      for (int i2 = bid; i2 < n_p3; i2 += G) rwkv_scan_item<0>(P, l, i2 & 7, 1 + (i2 >> 3), lds, wv_);
      {
        unsigned* ctr = (unsigned*)(ws + WS_BAR) + it;
        for (;;) {
          const int i2 = next_item(ctr, (volatile LAS int*)&wq_slot, wv_);
          if (i2 >= 16 + 128 + (l == 0 ? 189 : 0)) break;
          if (i2 >= 16 + 128) { for (int d = (i2 - 144) * 16; d < (i2 - 144) * 16 + 16; ++d) wt_deferred(P, d, lds, wv_); }
          else if (i2 < 16) gemm_tile<2>((const bf16_t*)(ws + WS_MEMN) + (size_t)l * 512 * 1024, 1024, 0, 256, 512, 768, (const bf16_t*)(wl + WT_KV), (i2 >> 3) * 256, (i2 & 7) * 256, 2048,
                                    (bf16_t*)(ws + WS_KV) + (size_t)l * 512 * 2048, (const float*)((bf16_t*)(ws + WS_VT) + (size_t)l * 2 * 1024 * 256), 2048, lds, wv_);
          else hgrn_wave_item<1>(P, l, (i2 - 16) * 8 + wv_, lds, wv_);
        }
      }
    } else if (ph == 7) {
      for (int i2 = bid * 4; i2 < 1024; i2 += G * 4) { for (int k2 = 0; k2 < 4; ++k2) xattn_item(P, l, i2 + k2, lds, wv_); }
    } else {
      const bool fin = true;
      const float* g_ = P->in[27];
      void* d_ = (void*)P->out;
#ifdef PROBE_J
      float pd_ = 0.f;
      if (fin) {
        if (bid == PROBE_B) {
          if (opaque_tid(wv_) == 0) {
            unsigned long long tot = 0ull; for (int i = 0; i < 11; ++i) tot += tacc[i] + tacc[16 + i];
            pdelta = sqrtf(0.0128f * (float)(PROBE_J < 32 ? tacc[PROBE_J & 31] : tacc[PROBE_J - 32] + tacc[PROBE_J - 16]) / (float)tot);
          }
          __syncthreads();
          pd_ = pdelta;
        }
      }
      norm_rows(fin, P->out, g_, d_, NT, pd_, wv_);
#else
      norm_rows(fin, P->out, g_, d_, NT, 0.f, wv_);
#endif
    }
    if (it < 16) { STAMP(16 + ph); xcd_barrier(bar, wv_); STAMP(ph) }
  }
#ifdef PROBE_J
  if (bid0 == PROBE_B && opaque_tid(wv_) == 0) {
    const unsigned long long t0_ = __builtin_amdgcn_s_memrealtime();
    const unsigned long long w_ = 4ull * (PROBE_K < 32 ? tacc[PROBE_K & 31] : tacc[PROBE_K - 32] + tacc[PROBE_K - 16]);
    while (__builtin_amdgcn_s_memrealtime() - t0_ < w_) __builtin_amdgcn_s_sleep(8);
  }
#endif
}

extern "C" void kernel_launch(void* const* d_in, const int* in_sizes, int n_in, void* d_out, int out_size, void* d_ws, size_t ws_size, hipStream_t stream) {
  constexpr size_t kDynLds = 147456;
  static int grid_blocks = 0;
  if (!grid_blocks) {
    int dev = 0, cus = 0, per_cu = 0;
    hipGetDevice(&dev);
    hipDeviceGetAttribute(&cus, hipDeviceAttributeMultiprocessorCount, dev);
    hipFuncSetAttribute((const void*)fwd_megakernel, hipFuncAttributeMaxDynamicSharedMemorySize, (int)kDynLds);
    hipOccupancyMaxActiveBlocksPerMultiprocessor(&per_cu, fwd_megakernel, NTHR, kDynLds);
    if (per_cu < 1) per_cu = 1;
    if (per_cu > 1) per_cu = 1;
    grid_blocks = cus * per_cu;
    if (grid_blocks > 256) grid_blocks = 256;
  }
  Params p;
  memset(&p, 0, sizeof(p));
  for (int i = 0; i < 28; ++i) p.in[i] = (const float*)d_in[i];
  p.out = (float*)d_out; p.ws = (unsigned char*)d_ws; p.never = 0; p.pad = 0;
  hipMemsetAsync(d_ws, 0, XCD_BAR_WORDS * 4, stream);
  void* args[] = {&p};
  hipError_t e = hipLaunchCooperativeKernel((void*)fwd_megakernel, dim3(grid_blocks), dim3(NTHR), args, kDynLds, stream);
  if (e != hipSuccess) fprintf(stderr, "cooperative launch failed: %s (grid %d)\n", hipGetErrorString(e), grid_blocks);
}
```

```cpp
#include <hip/hip_runtime.h>
#include <hip/hip_cooperative_groups.h>
#include <stdint.h>
#include <cstdio>
#include <cstring>
namespace cg = cooperative_groups;

typedef unsigned short bf16_t;
typedef short bf16x8 __attribute__((ext_vector_type(8)));
typedef float f32x4 __attribute__((ext_vector_type(4)));
typedef float f32x16 __attribute__((ext_vector_type(16)));
typedef float f32x2 __attribute__((ext_vector_type(2)));
#define LAS __attribute__((address_space(3)))

#define NT 16384
#define TSEQ 8192
#define DM 1024
#define NIN 3904
#define NTHR 512
#define C_R 0
#define C_K 256
#define C_V 512
#define C_XW 768
#define C_GA 832
#define C_CVAL 1088
#define C_CGLU 1344
#define C_CGATE 1600
#define C_HQ 1856
#define C_HF 2112
#define C_HI 2368
#define C_HG 2624
#define C_SQ 2880
#define C_SK 3136
#define C_SV 3392
#define C_SG 3648
#define RW_C 32
#define RW_CL (TSEQ / RW_C)
#define RW_TT 16

#define MiB (1024ull * 1024ull)
#define WS_BAR   0ull
#define WS_WT    (1ull * MiB)
#define WT_LAYER (18ull * MiB)
#define WT_IN    0ull
#define WT_OUT   (8ull * MiB)
#define WT_Q     (10ull * MiB)
#define WT_KV    (12ull * MiB)
#define WT_O     (16ull * MiB)
#define WS_MEMN  (37ull * MiB)
#define WS_KV    (39ull * MiB)
#define WS_PQ    (246ull * MiB)
#define WS_HS    (47ull * MiB)
#define WS_HF    (63ull * MiB)
#define WS_RK    (63ull * MiB + 512ull * 1024ull)
#define WS_R1    (64ull * MiB)
#define WS_PW    WS_R1
#define WS_PV    (WS_R1 + 16ull * MiB)
#define WS_P     (120ull * MiB)
#define WS_VT    (243ull * MiB)
#define WS_SSQ   (245ull * MiB)
#define WS_END   (254ull * MiB)

struct Params {
  const float* in[28];
  float* out;
  unsigned char* ws;
  int never;
  int pad;
};

typedef const __attribute__((address_space(4))) Params* KP;
__device__ __forceinline__ int lane_id_() { return (int)__builtin_amdgcn_mbcnt_hi(~0u, __builtin_amdgcn_mbcnt_lo(~0u, 0u)); }
__device__ __forceinline__ int opaque_tid(int wv_) { int t; asm volatile("v_mbcnt_lo_u32_b32 %0, -1, 0\n\tv_mbcnt_hi_u32_b32 %0, -1, %0\n\tv_lshl_add_u32 %0, %1, 6, %0" : "=&v"(t) : "s"(wv_)); return t; }
__device__ __forceinline__ float bf2f(bf16_t v) { return __uint_as_float(((unsigned)v) << 16); }
__device__ __forceinline__ bf16_t f2bf(float f) {
  unsigned u = __float_as_uint(f);
  u += 0x7fffu + ((u >> 16) & 1u);
  return (bf16_t)(u >> 16);
}
__device__ __forceinline__ unsigned pack2(float a, float b) { return (unsigned)f2bf(a) | ((unsigned)f2bf(b) << 16); }
__device__ __forceinline__ float sigmoidf_(float x) { return __builtin_amdgcn_rcpf(1.0f + __expf(-x)); }
__device__ __forceinline__ float siluf_(float x) { return x * __builtin_amdgcn_rcpf(1.0f + __expf(-x)); }
__device__ __forceinline__ float softplusf_(float x) { return fmaxf(x, 0.f) + log1pf(__expf(-fabsf(x))); }
__device__ __forceinline__ float softplus_fast(float x) { return fmaxf(x, 0.f) + __logf(1.0f + __expf(-fabsf(x))); }
__device__ __forceinline__ float dpp_add(float v, const int ctrl_sel) {
  return v;
}
__device__ __forceinline__ float bperm(float v, int srclane) { return __builtin_bit_cast(float, __builtin_amdgcn_ds_bpermute(srclane << 2, __builtin_bit_cast(int, v))); }
__device__ __forceinline__ float wave_sum(float v, int lane) {
  v += __builtin_bit_cast(float, __builtin_amdgcn_update_dpp(0, __builtin_bit_cast(int, v), 0xB1, 0xF, 0xF, true));
  v += __builtin_bit_cast(float, __builtin_amdgcn_update_dpp(0, __builtin_bit_cast(int, v), 0x4E, 0xF, 0xF, true));
  v += __builtin_bit_cast(float, __builtin_amdgcn_update_dpp(0, __builtin_bit_cast(int, v), 0x141, 0xF, 0xF, true));
  v += __builtin_bit_cast(float, __builtin_amdgcn_update_dpp(0, __builtin_bit_cast(int, v), 0x140, 0xF, 0xF, true));
  v += bperm(v, lane ^ 16);
  v += bperm(v, lane ^ 32);
  return v;
}
__device__ __forceinline__ float max8(float v) {
  v = fmaxf(v, __builtin_bit_cast(float, __builtin_amdgcn_update_dpp(0, __builtin_bit_cast(int, v), 0xB1, 0xF, 0xF, true)));
  v = fmaxf(v, __builtin_bit_cast(float, __builtin_amdgcn_update_dpp(0, __builtin_bit_cast(int, v), 0x4E, 0xF, 0xF, true)));
  v = fmaxf(v, __builtin_bit_cast(float, __builtin_amdgcn_update_dpp(0, __builtin_bit_cast(int, v), 0x141, 0xF, 0xF, true)));
  return v;
}
__device__ __forceinline__ float red8(float v) {
  v += __builtin_bit_cast(float, __builtin_amdgcn_update_dpp(0, __builtin_bit_cast(int, v), 0xB1, 0xF, 0xF, true));
  v += __builtin_bit_cast(float, __builtin_amdgcn_update_dpp(0, __builtin_bit_cast(int, v), 0x4E, 0xF, 0xF, true));
  v += __builtin_bit_cast(float, __builtin_amdgcn_update_dpp(0, __builtin_bit_cast(int, v), 0x141, 0xF, 0xF, true));
  return v;
}

#define LBAR() do { asm volatile("s_waitcnt lgkmcnt(0)" ::: "memory"); __builtin_amdgcn_s_barrier(); asm volatile("" ::: "memory"); } while (0)
#define XB_TMO      128
#define XB_XCNT(j)  (256  + 64 * (j))
#define XB_XSUB(j)  (1280 + 64 * (j))
#define XB_XGEN(j)  (2304 + 64 * (j))
#define XB_TOP      3328
#define XB_TOPGEN   3392
#define XCD_BAR_WORDS 3456
#define XB_SPIN_CAP (1u << 22)
__device__ __forceinline__ unsigned xb_ld(unsigned* p) { return __hip_atomic_load(p, __ATOMIC_RELAXED, __HIP_MEMORY_SCOPE_AGENT); }
__device__ __forceinline__ unsigned xb_add(unsigned* p, unsigned v) { return __hip_atomic_fetch_add(p, v, __ATOMIC_RELAXED, __HIP_MEMORY_SCOPE_AGENT); }
__device__ __forceinline__ unsigned xb_xcc_id() { return (unsigned)__builtin_amdgcn_s_getreg((3 << 11) | 20) & 0xFu; }
#define XB_SPIN(cond, bar) do { unsigned _sp = 0; while (cond) { __builtin_amdgcn_s_sleep(1); \
    if ((++_sp & 255u) == 0u) { if (xb_ld(&(bar)[XB_TMO])) break; if (_sp > XB_SPIN_CAP) { atomicAdd(&(bar)[XB_TMO], 1u); break; } } } } while (0)
struct XcdBarrier { unsigned* bar; unsigned x; volatile LAS unsigned* st; };
__device__ __forceinline__ XcdBarrier xcd_barrier_post(unsigned* bar, volatile LAS unsigned* st, int wv_) {
  XcdBarrier b; b.bar = bar; b.x = xb_xcc_id(); b.st = st;
  if (opaque_tid(wv_) == 0) (void)xb_add(&bar[XB_XCNT(b.x)], 1u);
  return b;
}
__device__ __forceinline__ void xcd_barrier_complete(unsigned* bar, unsigned x, unsigned& nloc, unsigned& nx) {
  const unsigned G = gridDim.x * gridDim.y * gridDim.z;
  unsigned sum, cnt, mine, sp = 0u;
  for (;;) {
    sum = 0u; cnt = 0u; mine = 0u;
#pragma unroll
    for (unsigned j = 0; j < 16; ++j) { const unsigned c = xb_ld(&bar[XB_XCNT(j)]); sum += c; cnt += (c > 0u) ? 1u : 0u; mine = (j == x) ? c : mine; }
    if (sum == G) break;
    __builtin_amdgcn_s_sleep(1);
    if ((++sp & 255u) == 0u) { if (xb_ld(&bar[XB_TMO])) break; if (sp > XB_SPIN_CAP) { atomicAdd(&bar[XB_TMO], 1u); break; } }
  }
  nloc = mine > 0u ? mine : 1u; nx = cnt > 0u ? cnt : 1u;
}
__device__ __forceinline__ void xcd_barrier(const XcdBarrier& b, int wv_) {
  asm volatile("s_waitcnt vmcnt(0)" ::: "memory");
  __syncthreads();
  if (opaque_tid(wv_) == 0) {
    unsigned* bar = b.bar;
    __builtin_amdgcn_s_waitcnt(0);
    unsigned bx = b.x; asm volatile("" : "+s"(bx));
    unsigned nloc = b.st[0], nx = b.st[1];
    if (nloc == 0u) { xcd_barrier_complete(bar, bx, nloc, nx); b.st[0] = nloc; b.st[1] = nx; }
    const unsigned old = xb_add(&bar[XB_XSUB(bx)], 1u);
    const unsigned gen = old / nloc;
    if (old + 1u == (gen + 1u) * nloc) {
      __builtin_amdgcn_fence(__ATOMIC_RELEASE, "agent");
      asm volatile("s_waitcnt vmcnt(0)" ::: "memory");
      const unsigned og = xb_add(&bar[XB_TOP], 1u);
      const unsigned tg = og / nx;
      if (og + 1u == (tg + 1u) * nx) xb_add(&bar[XB_TOPGEN], 1u);
      else XB_SPIN(xb_ld(&bar[XB_TOPGEN]) == tg, bar);
      __builtin_amdgcn_fence(__ATOMIC_ACQUIRE, "agent");
      xb_add(&bar[XB_XGEN(bx)], 1u);
      asm volatile("s_waitcnt vmcnt(0)" ::: "memory");
    } else {
      XB_SPIN(xb_ld(&bar[XB_XGEN(bx)]) == gen, bar);
      __builtin_amdgcn_fence(__ATOMIC_ACQUIRE, "agent");
      asm volatile("s_waitcnt vmcnt(0)" ::: "memory");
    }
  }
  __syncthreads();
}

#define G_STAGE 73728
#define G_BOFF 36864
template <int EPI>
__device__ __forceinline__ void gemm_tile(const bf16_t* __restrict__ A, int lda, int ao0, int ao1, int ao2, int ao3,
                                          const bf16_t* __restrict__ Bt, int m0, int n0, int N,
                                          void* out, const float* resid, int ldc, unsigned char* lds, int wv_) {
#ifdef OFF_gemm_tile
  return;
#endif

  const int tid = opaque_tid(wv_), lane = tid & 63, w = tid >> 6;
  const int wm = w >> 2, wn = w & 3, lr = lane & 31, lh = lane >> 5;
  f32x16 acc[4][2];
#pragma unroll
  for (int i = 0; i < 4; ++i)
#pragma unroll
    for (int j = 0; j < 2; ++j)
#pragma unroll
      for (int r = 0; r < 16; ++r) acc[i][j][r] = 0.f;
  uint4 ra[4], rb[4];
  const int crow = tid >> 3, ccol = (tid & 7) * 8;
  const bf16_t* Ap = A + (size_t)(m0 + crow) * lda + ccol;
  const bf16_t* Bp = Bt + (size_t)(n0 + crow) * 1024 + ccol;
#define G_LOAD(kt) { const int k0_ = (kt) * 64; const int seg_ = k0_ >> 8; const int ao_ = (seg_ == 0 ? ao0 : seg_ == 1 ? ao1 : seg_ == 2 ? ao2 : ao3) + (k0_ & 255); \
    _Pragma("unroll") for (int i_ = 0; i_ < 4; ++i_) { ra[i_] = *(const uint4*)(Ap + (size_t)(i_ * 64) * lda + ao_); rb[i_] = *(const uint4*)(Bp + (size_t)(i_ * 64) * 1024 + k0_); } }
#define G_WRITE(buf) { unsigned char* b_ = lds + (buf) * G_STAGE + crow * 144 + (tid & 7) * 16; \
    _Pragma("unroll") for (int i_ = 0; i_ < 4; ++i_) { *(uint4*)(b_ + i_ * 64 * 144) = ra[i_]; *(uint4*)(b_ + G_BOFF + i_ * 64 * 144) = rb[i_]; } }
  G_LOAD(0); G_WRITE(0); __syncthreads();
  for (int kt = 0; kt < 16; ++kt) {
    if (kt < 15) G_LOAD(kt + 1);
    const unsigned char* base = lds + (kt & 1) * G_STAGE;
    const unsigned char* ab = base + (wm * 128 + lr) * 144 + lh * 16;
    const unsigned char* bb = base + G_BOFF + (wn * 64 + lr) * 144 + lh * 16;
#pragma unroll
    for (int s = 0; s < 4; ++s) {
      bf16x8 a[4], b[2];
#pragma unroll
      for (int i = 0; i < 4; ++i) a[i] = *(const bf16x8*)(ab + i * 32 * 144 + s * 32);
#pragma unroll
      for (int j = 0; j < 2; ++j) b[j] = *(const bf16x8*)(bb + j * 32 * 144 + s * 32);
#pragma unroll
      for (int i = 0; i < 4; ++i)
#pragma unroll
        for (int j = 0; j < 2; ++j) acc[i][j] = __builtin_amdgcn_mfma_f32_32x32x16_bf16(a[i], b[j], acc[i][j], 0, 0, 0);
    }
    if (kt < 15) G_WRITE((kt + 1) & 1);
    __syncthreads();
  }
#undef G_LOAD
#undef G_WRITE
#pragma unroll
  for (int i = 0; i < 4; ++i)
#pragma unroll
    for (int j = 0; j < 2; ++j) {
      const int col = n0 + wn * 64 + j * 32 + lr;
#pragma unroll
      for (int r = 0; r < 16; ++r) {
        const int row = m0 + wm * 128 + i * 32 + (r & 3) + 8 * (r >> 2) + 4 * lh;
        if (EPI == 0) { if (col < N) ((bf16_t*)out)[(size_t)row * ldc + col] = f2bf(acc[i][j][r]); }
        else if (EPI == 2) { if (col < 1024) ((bf16_t*)out)[(size_t)row * ldc + col] = f2bf(acc[i][j][r]);
                             else ((bf16_t*)resid)[((size_t)((row >> 8) * 1024 + (col - 1024))) * 256 + (row & 255)] = f2bf(acc[i][j][r]); }
        else { ((float*)out)[(size_t)row * ldc + col] = resid[(size_t)row * ldc + col] + acc[i][j][r]; }
      }
    }
}

__device__ __forceinline__ void tile_map(int t, int nN, int& mi, int& ni) {
  const int rnd = t >> 8, blk = t & 255, x = blk & 7, y = blk >> 3;
  if (nN == 16) { mi = rnd * 16 + (x >> 1) * 4 + (y & 3); ni = (x & 1) * 8 + (y >> 2); }
  else { mi = rnd * 64 + x * 8 + (y & 7); ni = y >> 3; }
}

namespace pg8 {
#define PG8_LAS __attribute__((address_space(3)))
typedef unsigned u32x4 __attribute__((ext_vector_type(4)));
constexpr int BM = 256, BK = 64, HALF = 128, HTB = HALF * BK * 2  , STAGE_BYTES = 8 * HTB, NXCD = 8, WGM = 8;

__host__ __device__ __forceinline__ int lds_byte(int r, int c) { const int st = (r >> 4) * 2 + (c >> 5), rr = r & 15, cc = c & 31, ob = rr * 64 + cc * 2; return st * 1024 + (ob ^ (((ob >> 9) & 1) << 5)); }
__host__ __device__ __forceinline__ void stage_rc(int b, int& R, int& C) { const int st = b / 1024, sb = b % 1024, swz = sb ^ (((sb >> 9) & 1) << 5); R = (st >> 1) * 16 + swz / 64; C = (st & 1) * 32 + (swz % 64) / 2; }
__host__ __device__ __forceinline__ int perm32(int rho) { const int n = rho >> 4, i = rho & 15; return 8 * (i >> 2) + 4 * n + (i & 3); }

struct Unit { int pm, pn; };
struct Gemm { const bf16_t* A; const bf16_t* Bt; int M, N, K; int lda; int ao0, ao1, ao2, ao3; };

struct TileSched {
    int nt, G, c, nN;
    __device__ __forceinline__ bool next(int i, Unit& u) const { const int t = i * G + c; if (t >= nt) return false; tile_map(t, nN, u.pm, u.pn); return true; }
    __device__ __forceinline__ void a_ready(const Unit&) const {}
    __device__ __forceinline__ void done(const Unit&) const {}
};
__device__ __forceinline__ unsigned cvt_pk_bf16(float lo, float hi) { unsigned r; asm volatile("v_cvt_pk_bf16_f32 %0, %1, %2" : "=v"(r) : "v"(lo), "v"(hi)); return r; }
struct EpiStoreBf16 {
    static constexpr bool PERM = true, AFTER_DRAIN = false;
    bf16_t* O; int ldc; int N;
    __device__ __forceinline__ void operator()(const f32x4 (&acc)[2][2][4][2], const Unit& u, int wr, int wc, int fr, int fq) const {
        const int row0 = u.pm * BM + wr * 64 + fr, col0 = u.pn * BM + wc * 32 + 8 * fq;
#pragma unroll
        for (int ai = 0; ai < 2; ++ai)
#pragma unroll
            for (int m = 0; m < 4; ++m) { bf16_t* rowp = O + (size_t)(row0 + ai * HALF + m * 16) * ldc + col0;
#pragma unroll
                for (int bj = 0; bj < 2; ++bj) { if (col0 + bj * HALF < N) { const f32x4 v0 = acc[ai][bj][m][0], v1 = acc[ai][bj][m][1];
                    u32x4 w; w.x = cvt_pk_bf16(v0[0], v0[1]); w.y = cvt_pk_bf16(v0[2], v0[3]); w.z = cvt_pk_bf16(v1[0], v1[1]); w.w = cvt_pk_bf16(v1[2], v1[3]);
                    *(u32x4*)(rowp + bj * HALF) = w; } } }
    }
};
struct EpiDyn {
    static constexpr bool PERM = true, AFTER_DRAIN = false;
    int mode; bf16_t* O; int ldc; int N; const float* resid; float* out; const float* ssq_in; bf16_t* xb; float* ssq_out;
    __device__ __forceinline__ void operator()(const f32x4 (&acc)[2][2][4][2], const Unit& u, int wr, int wc, int fr, int fq) const {
        const int row0 = u.pm * BM + wr * 64 + fr, col0 = u.pn * BM + wc * 32 + 8 * fq;
        if (mode == 0) {
#pragma unroll
            for (int ai = 0; ai < 2; ++ai)
#pragma unroll
                for (int m = 0; m < 4; ++m) { const int row = row0 + ai * HALF + m * 16; bf16_t* rowp = O + (size_t)row * ldc + col0;
                    const float sc = __builtin_amdgcn_rsqf(ssq_in[row] * (1.0f / 1024.0f) + 1e-6f);
#pragma unroll
                    for (int bj = 0; bj < 2; ++bj) { if (col0 + bj * HALF < N) { const f32x4 v0 = acc[ai][bj][m][0] * sc, v1 = acc[ai][bj][m][1] * sc;
                        u32x4 w; w.x = cvt_pk_bf16(v0[0], v0[1]); w.y = cvt_pk_bf16(v0[2], v0[3]); w.z = cvt_pk_bf16(v1[0], v1[1]); w.w = cvt_pk_bf16(v1[2], v1[3]);
                        *(u32x4*)(rowp + bj * HALF) = w; } } }
        } else {
            const int lane_ = fq * 16 + fr;
#pragma unroll
            for (int ai = 0; ai < 2; ++ai)
#pragma unroll
                for (int m = 0; m < 4; ++m) { const int row = row0 + ai * HALF + m * 16; const size_t off = (size_t)row * ldc + col0; float s = 0.f;
#pragma unroll
                    for (int bj = 0; bj < 2; ++bj) { const u32x4 rv = *(const u32x4*)(xb + off + bj * HALF);
                        const f32x4 r0 = {__uint_as_float(rv.x << 16), __uint_as_float(rv.x & 0xffff0000u), __uint_as_float(rv.y << 16), __uint_as_float(rv.y & 0xffff0000u)};
                        const f32x4 r1 = {__uint_as_float(rv.z << 16), __uint_as_float(rv.z & 0xffff0000u), __uint_as_float(rv.w << 16), __uint_as_float(rv.w & 0xffff0000u)};
                        const f32x4 x0 = r0 + acc[ai][bj][m][0], x1 = r1 + acc[ai][bj][m][1];
                        u32x4 w; w.x = cvt_pk_bf16(x0[0], x0[1]); w.y = cvt_pk_bf16(x0[2], x0[3]); w.z = cvt_pk_bf16(x1[0], x1[1]); w.w = cvt_pk_bf16(x1[2], x1[3]);
                        *(u32x4*)(xb + off + bj * HALF) = w;
                        s += (x0[0] * x0[0] + x0[1] * x0[1]) + (x0[2] * x0[2] + x0[3] * x0[3]) + (x1[0] * x1[0] + x1[1] * x1[1]) + (x1[2] * x1[2] + x1[3] * x1[3]); }
                    s += bperm(s, lane_ ^ 16); s += bperm(s, lane_ ^ 32);
                    if (fq == 0) __hip_atomic_fetch_add(ssq_out + row, s, __ATOMIC_RELAXED, __HIP_MEMORY_SCOPE_AGENT); }
        }
    }
};
struct EpiResid {
    static constexpr bool PERM = true, AFTER_DRAIN = false;
    const float* resid; float* out; int ldc;
    __device__ __forceinline__ void operator()(const f32x4 (&acc)[2][2][4][2], const Unit& u, int wr, int wc, int fr, int fq) const {
        const int row0 = u.pm * BM + wr * 64 + fr, col0 = u.pn * BM + wc * 32 + 8 * fq;
#pragma unroll
        for (int ai = 0; ai < 2; ++ai)
#pragma unroll
            for (int m = 0; m < 4; ++m) { const size_t off = (size_t)(row0 + ai * HALF + m * 16) * ldc + col0;
#pragma unroll
                for (int bj = 0; bj < 2; ++bj) { const f32x4 r0 = *(const f32x4*)(resid + off + bj * HALF), r1 = *(const f32x4*)(resid + off + bj * HALF + 4);
                    *(f32x4*)(out + off + bj * HALF) = r0 + acc[ai][bj][m][0]; *(f32x4*)(out + off + bj * HALF + 4) = r1 + acc[ai][bj][m][1]; } }
    }
};

static_assert(true, "pg8 body adapted: SP2 path only is valid with lda/segment offsets");
template <class Epi, class Sched, bool ALIGN_EPI = false, bool SP2 = false>
__device__ __forceinline__ void gemm_phase(PG8_LAS unsigned char* lds, const Gemm g, const Sched& S, const Epi& E, int wv_) {
    const int tid = opaque_tid(wv_), wid = __builtin_amdgcn_readfirstlane(tid >> 6), lane = tid & 63, wr = wid >> 2, wc = wid & 3, fr = lane & 15, fq = lane >> 4;
    const int K = g.K, nt = K / BK;
    unsigned voffA, voffB;
    { int R, C; stage_rc(tid * 16, R, C); const int Rb = Epi::PERM ? ((R & ~31) + perm32(R & 31)) : R;
      voffA = (unsigned)(R * g.lda + C) * 2u; voffB = (unsigned)(Rb * K + C) * 2u; }
    const size_t rstepA = (size_t)64 * g.lda * 2, rstepB = (size_t)64 * K * 2;
    const size_t kstep = (size_t)(BK * 2);
    const size_t hstep = (size_t)HALF * K * 2; const size_t hstepA = (size_t)HALF * g.lda * 2, tstepA = 2 * hstepA;
#define PG8_KA(t_) ((size_t)((((t_) >> 2) == 0 ? g.ao0 : ((t_) >> 2) == 1 ? g.ao1 : ((t_) >> 2) == 2 ? g.ao2 : g.ao3) + ((t_) & 3) * 64) * 2)
    const size_t tstep = 2 * hstep;
    const unsigned ldsw = (unsigned)wid * 1024u;
    int aoff, boff;
#define PG8_SA(b, h) (((b) * 2 + (h)) * HTB)
#define PG8_SB(b, h) ((4 + (b) * 2 + (h)) * HTB)
#define PG8_STAGE(bufoff, gbase, voff) do { _Pragma("unroll") for (int _i = 0; _i < 2; ++_i) \
        __builtin_amdgcn_global_load_lds((const unsigned*)((const char*)(gbase) + (size_t)_i * r##voff + (voff)), (PG8_LAS unsigned*)(lds + (bufoff) + ldsw + _i * 8192), 16, 0, 0); } while (0)
#define rvoffA rstepA
#define rvoffB rstepB
#define PG8_LDA(dst, b, h) do { _Pragma("unroll") for (int m = 0; m < 4; ++m) _Pragma("unroll") for (int k = 0; k < 2; ++k) dst[m][k] = *(const PG8_LAS bf16x8*)(lds + (PG8_SA(b, h) + wr * 8192) + aoff + m * 2048 + k * 1024); } while (0)
#define PG8_LDB(dst, b, h) do { _Pragma("unroll") for (int n = 0; n < 2; ++n) _Pragma("unroll") for (int k = 0; k < 2; ++k) dst[n][k] = *(const PG8_LAS bf16x8*)(lds + (PG8_SB(b, h) + wc * 4096) + boff + n * 2048 + k * 1024); } while (0)
#define PG8_MMA(ai, bj, At, Bt) do { __builtin_amdgcn_s_setprio(1); _Pragma("unroll") for (int m = 0; m < 4; ++m) _Pragma("unroll") for (int n = 0; n < 2; ++n) _Pragma("unroll") for (int k = 0; k < 2; ++k) \
        acc[ai][bj][m][n] = __builtin_amdgcn_mfma_f32_16x16x32_bf16(Bt[n][k], At[m][k], acc[ai][bj][m][n], 0, 0, 0); __builtin_amdgcn_s_setprio(0); } while (0)
#define PG8_WAIT_V(n) asm volatile("s_waitcnt vmcnt(" #n ")" ::: "memory")
#define PG8_WAIT_L(n) asm volatile("s_waitcnt lgkmcnt(" #n ")" ::: "memory")
#define PG8_BAR __builtin_amdgcn_s_barrier()
#define PG8_SCHED __builtin_amdgcn_sched_barrier(0)
    Unit cur, nxt; int ui = 0;
    if (!S.next(0, cur)) return;
    f32x4 acc[2][2][4][2];
#pragma unroll
    for (int a = 0; a < 2; ++a)
#pragma unroll
        for (int b = 0; b < 2; ++b)
#pragma unroll
            for (int m = 0; m < 4; ++m)
#pragma unroll
                for (int n = 0; n < 2; ++n) acc[a][b][m][n] = (f32x4){0.f, 0.f, 0.f, 0.f};
    bf16x8 At[4][2], B0[2][2], B1[2][2];
    const char* cA = (const char*)g.A + (size_t)cur.pm * tstepA; const char* cB = (const char*)g.Bt + (size_t)cur.pn * tstep;
    S.a_ready(cur);
    if constexpr (SP2) {
        PG8_STAGE(PG8_SB(0, 0), cB, voffB); PG8_STAGE(PG8_SB(0, 1), cB + hstep, voffB); PG8_STAGE(PG8_SA(0, 0), cA + PG8_KA(0), voffA); PG8_STAGE(PG8_SA(0, 1), cA + hstepA + PG8_KA(0), voffA);
        if (wr == 1) PG8_BAR;
        PG8_WAIT_V(2); PG8_BAR;
        PG8_STAGE(PG8_SB(1, 0), cB + kstep, voffB); PG8_STAGE(PG8_SA(1, 0), cA + PG8_KA(1), voffA); PG8_STAGE(PG8_SB(1, 1), cB + hstep + kstep, voffB);
        PG8_WAIT_V(6); PG8_BAR;
    } else {
        PG8_STAGE(PG8_SB(0, 0), cB, voffB); PG8_STAGE(PG8_SA(0, 0), cA, voffA); PG8_STAGE(PG8_SB(0, 1), cB + hstep, voffB); PG8_STAGE(PG8_SA(0, 1), cA + hstep, voffA);
        if (wr == 1) PG8_BAR;
        PG8_WAIT_V(4); PG8_BAR;
        PG8_STAGE(PG8_SB(1, 0), cB + kstep, voffB); PG8_STAGE(PG8_SA(1, 0), cA + kstep, voffA); PG8_STAGE(PG8_SB(1, 1), cB + hstep + kstep, voffB);
        PG8_WAIT_V(6); PG8_BAR;
    }
    { const int t3_ = opaque_tid(wv_), l3_ = t3_ & 63, w3_ = __builtin_amdgcn_readfirstlane(t3_ >> 6); aoff = lds_byte((l3_ & 15), (l3_ >> 4) * 8); boff = aoff; }
    for (;;) {
        const bool has_next = S.next(ui + 1, nxt);
        const char* nA = has_next ? (const char*)g.A + (size_t)nxt.pm * tstepA : cA; const char* nB = has_next ? (const char*)g.Bt + (size_t)nxt.pn * tstep : cB;
        for (int t = 0; t < nt; t += 2) {
            const bool last = (t == nt - 2);
            const char* a1 = cA + PG8_KA(t + 1);
            const char* a2 = last ? nA + PG8_KA(0) : cA + PG8_KA(t + 2); const char* b2 = last ? nB : cB + (size_t)(t + 2) * kstep;
            const char* a3 = last ? nA + PG8_KA(1) : cA + PG8_KA(t + 3); const char* b3 = b2 + kstep;
            if (last && has_next) S.a_ready(nxt);
            if constexpr (SP2) {
            PG8_LDB(B0, 0, 0); PG8_LDB(B1, 0, 1); PG8_SCHED; PG8_LDA(At, 0, 0); PG8_STAGE(PG8_SA(1, 1), a1 + hstepA, voffA);
            PG8_WAIT_V(8); PG8_WAIT_L(0); PG8_BAR; PG8_MMA(0, 0, At, B0); PG8_MMA(0, 1, At, B1); PG8_BAR; PG8_SCHED;
            PG8_LDA(At, 0, 1); PG8_STAGE(PG8_SB(0, 0), b2, voffB); PG8_STAGE(PG8_SB(0, 1), b2 + hstep, voffB); PG8_STAGE(PG8_SA(0, 0), a2, voffA);
            PG8_WAIT_V(8); PG8_WAIT_L(0); PG8_BAR; PG8_MMA(1, 0, At, B0); PG8_MMA(1, 1, At, B1); PG8_BAR; PG8_SCHED;
            PG8_LDB(B0, 1, 0); PG8_LDB(B1, 1, 1); PG8_SCHED; PG8_LDA(At, 1, 0); PG8_STAGE(PG8_SA(0, 1), a2 + hstepA, voffA);
            PG8_WAIT_V(8); PG8_WAIT_L(0); PG8_BAR; PG8_MMA(0, 0, At, B0); PG8_MMA(0, 1, At, B1); PG8_BAR; PG8_SCHED;
            PG8_LDA(At, 1, 1); PG8_STAGE(PG8_SB(1, 0), b3, voffB); PG8_STAGE(PG8_SB(1, 1), b3 + hstep, voffB); PG8_STAGE(PG8_SA(1, 0), a3, voffA);
            PG8_WAIT_V(8); PG8_WAIT_L(0); PG8_BAR; PG8_MMA(1, 0, At, B0); PG8_MMA(1, 1, At, B1); PG8_BAR; PG8_SCHED;
            } else {
            PG8_LDB(B0, 0, 0); PG8_SCHED; PG8_LDA(At, 0, 0); PG8_STAGE(PG8_SA(1, 1), a1 + hstep, voffA);
            PG8_WAIT_L(8); PG8_BAR; PG8_WAIT_L(0); PG8_MMA(0, 0, At, B0); PG8_BAR; PG8_SCHED;
            PG8_LDB(B1, 0, 1); PG8_STAGE(PG8_SB(0, 0), b2, voffB);
            PG8_BAR; PG8_WAIT_L(0); PG8_MMA(0, 1, At, B1); PG8_BAR;
            PG8_LDA(At, 0, 1); PG8_STAGE(PG8_SA(0, 0), a2, voffA);
            PG8_BAR; PG8_WAIT_L(0); PG8_MMA(1, 0, At, B0); PG8_BAR; PG8_SCHED;
            PG8_STAGE(PG8_SB(0, 1), b2 + hstep, voffB);
            PG8_WAIT_V(6); PG8_BAR; PG8_MMA(1, 1, At, B1); PG8_BAR;
            PG8_LDB(B0, 1, 0); PG8_SCHED; PG8_LDA(At, 1, 0); PG8_STAGE(PG8_SA(0, 1), a2 + hstep, voffA);
            PG8_WAIT_L(8); PG8_BAR; PG8_WAIT_L(0); PG8_MMA(0, 0, At, B0); PG8_BAR; PG8_SCHED;
            PG8_LDB(B1, 1, 1); PG8_STAGE(PG8_SB(1, 0), b3, voffB);
            PG8_BAR; PG8_WAIT_L(0); PG8_MMA(0, 1, At, B1); PG8_BAR;
            PG8_LDA(At, 1, 1); PG8_STAGE(PG8_SA(1, 0), a3, voffA);
            PG8_BAR; PG8_WAIT_L(0); PG8_MMA(1, 0, At, B0); PG8_BAR; PG8_SCHED;
            PG8_STAGE(PG8_SB(1, 1), b3 + hstep, voffB);
            PG8_WAIT_V(6); PG8_BAR; PG8_MMA(1, 1, At, B1); PG8_BAR;
            }
        }
        if constexpr (ALIGN_EPI) { if (wr == 0) PG8_BAR; }
        if constexpr (!Epi::AFTER_DRAIN) { const int t2_ = opaque_tid(wv_), l2_ = t2_ & 63, w2_ = __builtin_amdgcn_readfirstlane(t2_ >> 6); E(acc, cur, w2_ >> 2, w2_ & 3, l2_ & 15, l2_ >> 4); S.done(cur); }
        if (!has_next) break;
#pragma unroll
        for (int a = 0; a < 2; ++a)
#pragma unroll
            for (int b = 0; b < 2; ++b)
#pragma unroll
                for (int m = 0; m < 4; ++m)
#pragma unroll
                    for (int n = 0; n < 2; ++n) acc[a][b][m][n] = (f32x4){0.f, 0.f, 0.f, 0.f};
        cur = nxt; cA = nA; cB = nB; ++ui;
        if constexpr (ALIGN_EPI) { if (wr == 1) PG8_BAR; }
    }
    PG8_WAIT_V(0);
    if constexpr (!ALIGN_EPI) { if (wr == 0) PG8_BAR; }
    PG8_BAR;
    if constexpr (Epi::AFTER_DRAIN) { E.fused(acc, cur, wr, wc, fr, fq, lds, wid, lane); S.done(cur); }
#undef PG8_SA
#undef PG8_SB
#undef PG8_STAGE
#undef rvoffA
#undef rvoffB
#undef PG8_LDA
#undef PG8_LDB
#undef PG8_MMA
#undef PG8_WAIT_V
#undef PG8_WAIT_L
#undef PG8_BAR
#undef PG8_SCHED
#undef PG8_KA
}
}

__device__ __forceinline__ void wt_tile(const float* __restrict__ W, int N, bf16_t* __restrict__ Wt, int kt, int nt, unsigned char* lds, int wv_, const float* gk = nullptr) {
#ifdef OFF_wt_tile
  return;
#endif

  float* tl = (float*)lds;
  const int tid = opaque_tid(wv_);
  const int r = tid >> 3, c8 = (tid & 7) * 8;
  const float* src = W + (size_t)(kt * 64 + r) * N + nt * 64 + c8;
  float4 v0 = *(const float4*)src, v1 = *(const float4*)(src + 4);
  if (gk) { const float g_ = gk[kt * 64 + r]; v0.x *= g_; v0.y *= g_; v0.z *= g_; v0.w *= g_; v1.x *= g_; v1.y *= g_; v1.z *= g_; v1.w *= g_; }
  float* d = tl + r * 65 + c8;
  d[0] = v0.x; d[1] = v0.y; d[2] = v0.z; d[3] = v0.w; d[4] = v1.x; d[5] = v1.y; d[6] = v1.z; d[7] = v1.w;
  __syncthreads();
  uint4 o;
  o.x = pack2(tl[(c8 + 0) * 65 + r], tl[(c8 + 1) * 65 + r]);
  o.y = pack2(tl[(c8 + 2) * 65 + r], tl[(c8 + 3) * 65 + r]);
  o.z = pack2(tl[(c8 + 4) * 65 + r], tl[(c8 + 5) * 65 + r]);
  o.w = pack2(tl[(c8 + 6) * 65 + r], tl[(c8 + 7) * 65 + r]);
  *(uint4*)(Wt + (size_t)(nt * 64 + r) * 1024 + kt * 64 + c8) = o;
  __syncthreads();
}

__device__ __forceinline__ void norm_rows(const bool F32OUT, const float* src, const float* __restrict__ g, void* dst, int nrows, float pd, int wv_, float* ssq_out = nullptr) {
#ifdef OFF_norm_rows
  return;
#endif

  const int tid = opaque_tid(wv_);
  const int lane = tid & 63;
  const int gw = blockIdx.x * 8 + (tid >> 6), nw = gridDim.x * 8;
  float4 gv[4];
#pragma unroll
  for (int i = 0; i < 4; ++i) gv[i] = ssq_out ? make_float4(1.f, 1.f, 1.f, 1.f) : *(const float4*)(g + i * 256 + lane * 4);
  for (int row = gw; row < nrows; row += nw) {
    const float* s = src + (size_t)row * 1024;
    float4 v[4]; float ss = 0.f;
#pragma unroll
    for (int i = 0; i < 4; ++i) { v[i] = *(const float4*)(s + i * 256 + lane * 4); ss += v[i].x * v[i].x + v[i].y * v[i].y + v[i].z * v[i].z + v[i].w * v[i].w; }
    ss = wave_sum(ss, lane);
    if (ssq_out) { if (lane == 0) ssq_out[row] = ss; }
    const float rs = ssq_out ? 1.0f : rsqrtf(ss * (1.0f / 1024.0f) + 1e-6f);
#pragma unroll
    for (int i = 0; i < 4; ++i) {
      const float a = v[i].x * rs * gv[i].x, b = v[i].y * rs * gv[i].y, c = v[i].z * rs * gv[i].z, d = v[i].w * rs * gv[i].w;
      if (F32OUT) { *(float4*)((float*)dst + (size_t)row * 1024 + i * 256 + lane * 4) = make_float4(a + pd, b + pd, c + pd, d + pd); }
      else { uint2 o; o.x = pack2(a, b); o.y = pack2(c, d); *(uint2*)((bf16_t*)dst + (size_t)row * 1024 + i * 256 + lane * 4) = o; }
    }
  }
}

__device__ __forceinline__ void rwkv_prep_item(KP P, int l, int item, unsigned char* lds, int wv_) {
#ifdef OFF_rwkv_prep_item
  return;
#endif

  const bf16_t* p = (const bf16_t*)(P->ws + WS_P);
  float* PW = (float*)(P->ws + WS_PW); bf16_t* PV = (bf16_t*)(P->ws + WS_PV); float* RK = (float*)(P->ws + WS_RK);
  float* lora = (float*)lds;
  const int tid = opaque_tid(wv_), lane = tid & 63, w = tid >> 6, head = w & 3, sub = w >> 2;
  const int c = head * 64 + lane;
  const float* mu = P->in[4] + l * 832;
  const float mur = mu[c], muk = mu[256 + c], muv = mu[512 + c], mux = mu[768 + lane];
  const float w0 = P->in[5][l * 256 + c], a0 = P->in[7][l * 256 + c];
  const float kkw = P->in[9][l * 256 + c], kaw = P->in[10][l * 256 + c], rkw = P->in[11][l * 256 + c];
  float wup[32], aup[32];
#pragma unroll
  for (int j = 0; j < 32; ++j) { wup[j] = P->in[6][(l * 32 + j) * 256 + c]; aup[j] = P->in[8][(l * 32 + j) * 256 + c]; }
  bf16_t raw[4][8];
#define PREP_LOAD(g) { _Pragma("unroll") for (int j_ = 0; j_ < 4; ++j_) { const int t_ = item * 32 + sub + 2 * ((g) * 4 + j_); const bool hp_ = (t_ & (TSEQ - 1)) > 0; \
      const bf16_t* pr_ = p + (size_t)t_ * NIN; raw[j_][0] = pr_[c]; raw[j_][1] = pr_[256 + c]; raw[j_][2] = pr_[512 + c]; raw[j_][3] = pr_[768 + lane]; \
      raw[j_][4] = hp_ ? pr_[c - NIN] : (bf16_t)0; raw[j_][5] = hp_ ? pr_[256 + c - NIN] : (bf16_t)0; raw[j_][6] = hp_ ? pr_[512 + c - NIN] : (bf16_t)0; raw[j_][7] = hp_ ? pr_[768 + lane - NIN] : (bf16_t)0; } }
  PREP_LOAD(0);
#pragma unroll 1
  for (int g = 0; g < 4; ++g) {
    float rr[4], kk4[4], vv4[4];
#pragma unroll
    for (int j = 0; j < 4; ++j) {
      float r = bf2f(raw[j][0]), k = bf2f(raw[j][1]), v = bf2f(raw[j][2]), x = bf2f(raw[j][3]);
      r += (bf2f(raw[j][4]) - r) * mur; k += (bf2f(raw[j][5]) - k) * muk; v += (bf2f(raw[j][6]) - v) * muv; x += (bf2f(raw[j][7]) - x) * mux;
      rr[j] = r; kk4[j] = k; vv4[j] = v;
      lora[(w * 4 + j) * 64 + lane] = lane < 32 ? (1.0f - 2.0f * __builtin_amdgcn_rcpf(1.0f + __expf(2.0f * x))) : x;
    }
    if (g < 3) PREP_LOAD(g + 1);
    __builtin_amdgcn_s_waitcnt(0xc07f);
    __builtin_amdgcn_wave_barrier();
    float wv4[4], av4[4];
#pragma unroll
    for (int j = 0; j < 4; ++j) { wv4[j] = w0; av4[j] = a0; }
#pragma unroll
    for (int jj = 0; jj < 32; jj += 4) {
#pragma unroll
      for (int j = 0; j < 4; ++j) { const float* lo = lora + (w * 4 + j) * 64; const float4 lw = *(const float4*)(lo + jj), la = *(const float4*)(lo + 32 + jj);
        wv4[j] += lw.x * wup[jj]; wv4[j] += lw.y * wup[jj + 1]; wv4[j] += lw.z * wup[jj + 2]; wv4[j] += lw.w * wup[jj + 3];
        av4[j] += la.x * aup[jj]; av4[j] += la.y * aup[jj + 1]; av4[j] += la.z * aup[jj + 2]; av4[j] += la.w * aup[jj + 3]; }
    }
    float dec4[4], ar4[4], kkq[4], kmod4[4], n24[4], rk4[4];
#pragma unroll
    for (int j = 0; j < 4; ++j) {
      const float wlog = -softplus_fast(-wv4[j]) - 0.5f;
      dec4[j] = __expf(-__expf(wlog));
      ar4[j] = sigmoidf_(av4[j]);
      kkq[j] = kk4[j] * kkw;
      kmod4[j] = kk4[j] * (1.0f + (ar4[j] - 1.0f) * kaw);
      n24[j] = kkq[j] * kkq[j]; rk4[j] = rr[j] * kmod4[j] * rkw;
    }
#pragma unroll
    for (int st = 0; st < 4; ++st) {
      const int ctrl = st == 0 ? 0xB1 : st == 1 ? 0x4E : st == 2 ? 0x141 : 0x140;
#pragma unroll
      for (int j = 0; j < 4; ++j) {
        if (st == 0) { n24[j] += __builtin_bit_cast(float, __builtin_amdgcn_update_dpp(0, __builtin_bit_cast(int, n24[j]), 0xB1, 0xF, 0xF, true)); rk4[j] += __builtin_bit_cast(float, __builtin_amdgcn_update_dpp(0, __builtin_bit_cast(int, rk4[j]), 0xB1, 0xF, 0xF, true)); }
        else if (st == 1) { n24[j] += __builtin_bit_cast(float, __builtin_amdgcn_update_dpp(0, __builtin_bit_cast(int, n24[j]), 0x4E, 0xF, 0xF, true)); rk4[j] += __builtin_bit_cast(float, __builtin_amdgcn_update_dpp(0, __builtin_bit_cast(int, rk4[j]), 0x4E, 0xF, 0xF, true)); }
        else if (st == 2) { n24[j] += __builtin_bit_cast(float, __builtin_amdgcn_update_dpp(0, __builtin_bit_cast(int, n24[j]), 0x141, 0xF, 0xF, true)); rk4[j] += __builtin_bit_cast(float, __builtin_amdgcn_update_dpp(0, __builtin_bit_cast(int, rk4[j]), 0x141, 0xF, 0xF, true)); }
        else { n24[j] += __builtin_bit_cast(float, __builtin_amdgcn_update_dpp(0, __builtin_bit_cast(int, n24[j]), 0x140, 0xF, 0xF, true)); rk4[j] += __builtin_bit_cast(float, __builtin_amdgcn_update_dpp(0, __builtin_bit_cast(int, rk4[j]), 0x140, 0xF, 0xF, true)); }
      }
      (void)ctrl;
    }
    { float t0[4], t1[4];
#pragma unroll
      for (int j = 0; j < 4; ++j) { t0[j] = bperm(n24[j], lane ^ 16); t1[j] = bperm(rk4[j], lane ^ 16); }
#pragma unroll
      for (int j = 0; j < 4; ++j) { n24[j] += t0[j]; rk4[j] += t1[j]; }
#pragma unroll
      for (int j = 0; j < 4; ++j) { t0[j] = bperm(n24[j], lane ^ 32); t1[j] = bperm(rk4[j], lane ^ 32); }
#pragma unroll
      for (int j = 0; j < 4; ++j) { n24[j] += t0[j]; rk4[j] += t1[j]; } }
#pragma unroll
    for (int j = 0; j < 4; ++j) {
      const int t = item * 32 + sub + 2 * (g * 4 + j);
      const int tt = t & (TSEQ - 1), b = t >> 13;
      const float kkn = kkq[j] * __builtin_amdgcn_rsqf(fmaxf(n24[j], 1e-24f));
      const size_t idx = (size_t)(b * 4 + head) * TSEQ + tt;
      PW[idx * 64 + lane] = dec4[j];
      bf16_t* pv = PV + idx * 320;
      pv[lane] = f2bf(rr[j]); pv[64 + lane] = f2bf(kmod4[j]); pv[128 + lane] = f2bf(vv4[j]); pv[192 + lane] = f2bf(-kkn); pv[256 + lane] = f2bf(kkn * ar4[j]);
      if (lane == 0) RK[idx] = rk4[j];
    }
    __builtin_amdgcn_s_waitcnt(0xc07f);
    __builtin_amdgcn_wave_barrier();
  }
#undef PREP_LOAD
  __syncthreads();
}

#define RW_TILE_B (RW_TT * 1536)
struct RwRegs { float4 pw; uint4 pv0, pv1; };
__device__ __forceinline__ void rw_issue(const float* __restrict__ PW, const bf16_t* __restrict__ PV, size_t idx0, int tid, RwRegs& r) {
  if (tid < RW_TT * 16) { const int s = tid >> 4, q = tid & 15; r.pw = *(const float4*)(PW + (idx0 + s) * 64 + q * 4); }
  { const int c = tid; const int s = c / 40, q = c % 40; r.pv0 = *(const uint4*)(PV + (idx0 + s) * 320 + q * 8); }
  if (tid < RW_TT * 40 - NTHR) { const int c = tid + NTHR; const int s = c / 40, q = c % 40; r.pv1 = *(const uint4*)(PV + (idx0 + s) * 320 + q * 8); }
}
__device__ __forceinline__ void rw_put(float* dst, int c, const uint4 u) {
  const int s = c / 40, q = c % 40;
  const int vec = q >> 3, off = (q & 7) * 8;
  const int slot = vec == 0 ? 4 : vec == 1 ? 3 : vec == 2 ? 5 : vec == 3 ? 1 : 2;
  float* d = dst + s * 384 + slot * 64 + off;
  *(float4*)d = make_float4(__uint_as_float(u.x << 16), __uint_as_float(u.x & 0xffff0000u), __uint_as_float(u.y << 16), __uint_as_float(u.y & 0xffff0000u));
  *(float4*)(d + 4) = make_float4(__uint_as_float(u.z << 16), __uint_as_float(u.z & 0xffff0000u), __uint_as_float(u.w << 16), __uint_as_float(u.w & 0xffff0000u));
}
__device__ __forceinline__ void rw_commit(unsigned char* dstb, int tid, const RwRegs& r) {
  float* dst = (float*)dstb;
  if (tid < RW_TT * 16) { const int s = tid >> 4, q = tid & 15; *(float4*)(dst + s * 384 + q * 4) = r.pw; }
  rw_put(dst, tid, r.pv0);
  if (tid < RW_TT * 40 - NTHR) rw_put(dst, tid + NTHR, r.pv1);
}

#define LD8(dst, ptr) { const float4 x0_ = *(const float4*)(ptr), x1_ = *(const float4*)((ptr) + 4); dst[0] = (f32x2){x0_.x, x0_.y}; dst[1] = (f32x2){x0_.z, x0_.w}; dst[2] = (f32x2){x1_.x, x1_.y}; dst[3] = (f32x2){x1_.z, x1_.w}; }
struct RwOps { f32x2 w[4], a[4], b[4], k[4], r[4]; float vA, vB; };
template <int MODE>
__device__ __forceinline__ void rw_ldops(RwOps& o, const float* tb, int s, int q, int rowA, int rowB) {
  const float* sp = tb + s * 384 + q * 8;
  LD8(o.w, sp); LD8(o.a, sp + 64); LD8(o.b, sp + 128); LD8(o.k, sp + 192);
  o.vA = tb[s * 384 + 320 + rowA];
  if (MODE == 0) { LD8(o.r, sp + 256); o.vB = tb[s * 384 + 320 + rowB]; }
}
template <int MODE>
__device__ __forceinline__ void rw_step(const RwOps& o, f32x2 (&SA)[4], f32x2 (&SB)[4], float* yb, int s, int q, int rowA, int rowB) {
  f32x2 dA = SA[0] * o.a[0], dB = SB[0] * o.a[0];
#pragma unroll
  for (int e = 1; e < 4; ++e) { dA = SA[e] * o.a[e] + dA; dB = SB[e] * o.a[e] + dB; }
  const float dotA = red8(dA.x + dA.y), dotB = red8(dB.x + dB.y);
  const f32x2 dA2 = {dotA, dotA}, dB2 = {dotB, dotB}, vA2 = {o.vA, o.vA};
  if (MODE == 0) {
    const f32x2 vB2 = {o.vB, o.vB};
#pragma unroll
    for (int e = 0; e < 4; ++e) { SA[e] = SA[e] * o.w[e] + vA2 * o.k[e]; SA[e] = dA2 * o.b[e] + SA[e]; SB[e] = SB[e] * o.w[e] + vB2 * o.k[e]; SB[e] = dB2 * o.b[e] + SB[e]; }
    f32x2 yA = SA[0] * o.r[0], yB = SB[0] * o.r[0];
#pragma unroll
    for (int e = 1; e < 4; ++e) { yA = SA[e] * o.r[e] + yA; yB = SB[e] * o.r[e] + yB; }
    const float ya = red8(yA.x + yA.y), ybv = red8(yB.x + yB.y);
    if (q == 0) { yb[s * 64 + rowA] = ya; yb[s * 64 + rowB] = ybv; }
  } else {
#pragma unroll
    for (int e = 0; e < 4; ++e) { SA[e] = dA2 * o.b[e] + SA[e] * o.w[e]; SB[e] = SB[e] * o.w[e] + vA2 * o.k[e]; SB[e] = dB2 * o.b[e] + SB[e]; }
  }
}
template <int MODE>
__device__ __forceinline__ void rwkv_scan_item(KP P, int l, int bh, int chunk, unsigned char* lds, int wv_) {
  const float* PW = (const float*)(P->ws + WS_PW); const bf16_t* PV = (const bf16_t*)(P->ws + WS_PV); const float* RK = (const float*)(P->ws + WS_RK);
  float* PQ = (float*)(P->ws + WS_PQ);
  bf16_t* p = (bf16_t*)(P->ws + WS_P);
  const int tid = opaque_tid(wv_), lane = tid & 63, w = tid >> 6;
  const int q = lane & 7;
  const int rowA = (MODE == 0) ? ((w & 3) * 16 + (lane >> 3)) : (w * 8 + (lane >> 3));
  const int rowB = rowA + 8;
  const int b = bh >> 2, head = bh & 3;
  unsigned char* tile0 = lds;
  float* ybuf = (float*)(lds + 3 * RW_TILE_B);
  float* Sl = (float*)(lds + 3 * RW_TILE_B + 2 * RW_TT * 256);
  f32x2 SA[4], SB[4];
#pragma unroll
  for (int e = 0; e < 4; ++e) { SA[e] = (f32x2){0.f, 0.f}; SB[e] = (f32x2){0.f, 0.f}; }
  if (MODE == 1) {
#pragma unroll
    for (int e = 0; e < 4; ++e) SA[e] = (f32x2){(q * 8 + 2 * e == rowA) ? 1.f : 0.f, (q * 8 + 2 * e + 1 == rowA) ? 1.f : 0.f};
  }
  if (MODE == 0 && chunk > 0) {
    const float* Q0 = PQ + ((size_t)(bh * RW_C + 0) * 2 + 1) * 4096;
    float* cur = Sl; float* nxt = Sl + 64 * 65;
    for (int i = tid; i < 1024; i += NTHR) { const float4 v_ = *(const float4*)(Q0 + i * 4); float* d_ = cur + (i >> 4) * 65 + (i & 15) * 4; d_[0] = v_.x; d_[1] = v_.y; d_[2] = v_.z; d_[3] = v_.w; }
    float* Pl = (float*)lds;
    const float4 z4_ = make_float4(0.f, 0.f, 0.f, 0.f); const f32x4 zq_ = {0.f, 0.f, 0.f, 0.f};
    float4 cs0p0 = z4_, cs0p1 = z4_, cs1p0 = z4_, cs1p1 = z4_, cs2p0 = z4_, cs2p1 = z4_, cs3p0 = z4_, cs3p1 = z4_;
    f32x4 cs0q0 = zq_, cs0q1 = zq_, cs1q0 = zq_, cs1q1 = zq_, cs2q0 = zq_, cs2q1 = zq_, cs3q0 = zq_, cs3q1 = zq_;
    const int ti = w >> 1;
    const int qoff0 = 4096 + (ti * 16 + (lane >> 4) * 4) * 64 + ((w & 1) * 2 + 0) * 16 + (lane & 15);
#define CS_LOAD(S_, c_) { const float* Pm_ = PQ + ((size_t)(bh * RW_C + (c_)) * 2 + 0) * 4096; S_##p0 = *(const float4*)(Pm_ + tid * 4); S_##p1 = *(const float4*)(Pm_ + (tid + NTHR) * 4); \
      S_##q0 = (f32x4){Pm_[qoff0], Pm_[qoff0 + 64], Pm_[qoff0 + 128], Pm_[qoff0 + 192]}; S_##q1 = (f32x4){Pm_[qoff0 + 16], Pm_[qoff0 + 80], Pm_[qoff0 + 144], Pm_[qoff0 + 208]}; }
#define CS_STEP(S_, c_) { LBAR(); *(float4*)(Pl + (tid >> 4) * 80 + (tid & 15) * 4) = S_##p0; *(float4*)(Pl + ((tid + NTHR) >> 4) * 80 + (tid & 15) * 4) = S_##p1; const f32x4 qc0 = S_##q0, qc1 = S_##q1; \
      if ((c_) + 4 < chunk) CS_LOAD(S_, (c_) + 4); \
      LBAR(); \
      _Pragma("unroll") for (int jj = 0; jj < 2; ++jj) { const int tj = (w & 1) * 2 + jj; f32x4 acc = jj == 0 ? qc0 : qc1; \
        _Pragma("unroll") for (int ks = 0; ks < 16; ++ks) { const float a = cur[(ti * 16 + (lane & 15)) * 65 + ks * 4 + (lane >> 4)]; const float bb = Pl[(ks * 4 + (lane >> 4)) * 80 + tj * 16 + (lane & 15)]; \
          acc = __builtin_amdgcn_mfma_f32_16x16x4f32(a, bb, acc, 0, 0, 0); } \
        _Pragma("unroll") for (int r = 0; r < 4; ++r) nxt[(ti * 16 + (lane >> 4) * 4 + r) * 65 + tj * 16 + (lane & 15)] = acc[r]; } \
      float* t_ = cur; cur = nxt; nxt = t_; }
    if (1 < chunk) CS_LOAD(cs0, 1);
    if (2 < chunk) CS_LOAD(cs1, 2);
    if (3 < chunk) CS_LOAD(cs2, 3);
    if (4 < chunk) CS_LOAD(cs3, 4);
#pragma unroll 1
    for (int cc = 1; cc < chunk; cc += 4) {
      CS_STEP(cs0, cc);
      if (cc + 1 < chunk) CS_STEP(cs1, cc + 1);
      if (cc + 2 < chunk) CS_STEP(cs2, cc + 2);
      if (cc + 3 < chunk) CS_STEP(cs3, cc + 3);
    }
#undef CS_LOAD
#undef CS_STEP
    __syncthreads();
#pragma unroll
    for (int e = 0; e < 4; ++e) { SA[e] = (f32x2){cur[rowA * 65 + q * 8 + 2 * e], cur[rowA * 65 + q * 8 + 2 * e + 1]}; SB[e] = (f32x2){cur[rowB * 65 + q * 8 + 2 * e], cur[rowB * 65 + q * 8 + 2 * e + 1]}; }
    __syncthreads();
  }
  const size_t idxb = (size_t)bh * TSEQ + (size_t)chunk * RW_CL;
  const int ntile = RW_CL / RW_TT;
  RwRegs rr;
  rw_issue(PW, PV, idxb, tid, rr);
  rw_commit(tile0, tid, rr);
  const int chh = head * 64 + lane;
  const float lng = P->in[12][l * 256 + chh], lnb = P->in[13][l * 256 + chh];
  __syncthreads();
  const int nit = (MODE == 0) ? ntile + 1 : ntile;
  for (int tl = 0; tl < nit; ++tl) {
    if (tl + 1 < ntile) rw_issue(PW, PV, idxb + (size_t)(tl + 1) * RW_TT, tid, rr);
    if (MODE == 1 || w < 4) {
      if (tl < ntile) {
        const float* tb = (const float*)(tile0 + (tl % 3) * RW_TILE_B);
        float* yb = ybuf + (tl & 1) * (RW_TT * 64);
        RwOps oa, ob;
        rw_ldops<MODE>(oa, tb, 0, q, rowA, rowB);
        __builtin_amdgcn_sched_barrier(0);
#pragma unroll 1
        for (int s = 0; s < RW_TT; s += 2) {
          rw_ldops<MODE>(ob, tb, s + 1, q, rowA, rowB);
          __builtin_amdgcn_sched_barrier(0);
          rw_step<MODE>(oa, SA, SB, yb, s, q, rowA, rowB);
          __builtin_amdgcn_sched_barrier(0);
          if (s + 2 < RW_TT) rw_ldops<MODE>(oa, tb, s + 2, q, rowA, rowB);
          __builtin_amdgcn_sched_barrier(0);
          rw_step<MODE>(ob, SA, SB, yb, s + 1, q, rowA, rowB);
          __builtin_amdgcn_sched_barrier(0);
        }
      }
      if (tl + 1 < ntile) rw_commit(tile0 + ((tl + 1) % 3) * RW_TILE_B, tid, rr);
    } else {
      const int fw = w - 4;
      f32x4 gcu = {0.f, 0.f, 0.f, 0.f}, rkcu = {0.f, 0.f, 0.f, 0.f};
      if (tl > 0) {
#pragma unroll
        for (int u = 0; u < 4; ++u) { const int tt = chunk * RW_CL + (tl - 1) * RW_TT + fw + 4 * u;
          gcu[u] = bf2f(p[(size_t)(b * TSEQ + tt) * NIN + C_GA + chh]); rkcu[u] = RK[(size_t)bh * TSEQ + tt]; }
      }
      asm volatile("s_waitcnt vmcnt(0)" ::: "memory");
      if (tl + 1 < ntile) rw_commit(tile0 + ((tl + 1) % 3) * RW_TILE_B, tid, rr);
      __builtin_amdgcn_sched_barrier(0);
      if (tl > 0) {
        const float* tb = (const float*)(tile0 + ((tl - 1) % 3) * RW_TILE_B);
        const float* yb = ybuf + ((tl - 1) & 1) * (RW_TT * 64);
#pragma unroll
        for (int u = 0; u < 4; ++u) {
          const int s = fw + 4 * u;
          const int tt = chunk * RW_CL + (tl - 1) * RW_TT + s;
          const float y = yb[s * 64 + lane];
          const float mean = wave_sum(y, lane) * (1.0f / 64.0f);
          const float dlt = y - mean;
          const float var = wave_sum(dlt * dlt, lane) * (1.0f / 64.0f);
          float o = dlt * rsqrtf(var + 64e-5f) * lng + lnb;
          const float vv = tb[s * 384 + 320 + lane];
          o += rkcu[u] * vv;
          p[(size_t)(b * TSEQ + tt) * NIN + C_GA + chh] = f2bf(o * siluf_(gcu[u]));
        }
      }
    }
    LBAR();
  }
  if (MODE == 1) {
    float* Pm = PQ + ((size_t)(bh * RW_C + chunk) * 2 + 0) * 4096 + rowA * 64 + q * 8;
    *(float4*)Pm = make_float4(SA[0].x, SA[0].y, SA[1].x, SA[1].y); *(float4*)(Pm + 4) = make_float4(SA[2].x, SA[2].y, SA[3].x, SA[3].y);
    *(float4*)(Pm + 4096) = make_float4(SB[0].x, SB[0].y, SB[1].x, SB[1].y); *(float4*)(Pm + 4100) = make_float4(SB[2].x, SB[2].y, SB[3].x, SB[3].y);
  } else if (chunk == 0 && w < 4) {
    float* Qm = PQ + ((size_t)(bh * RW_C + 0) * 2 + 1) * 4096 + q * 8;
    *(float4*)(Qm + rowA * 64) = make_float4(SA[0].x, SA[0].y, SA[1].x, SA[1].y); *(float4*)(Qm + rowA * 64 + 4) = make_float4(SA[2].x, SA[2].y, SA[3].x, SA[3].y);
    *(float4*)(Qm + rowB * 64) = make_float4(SB[0].x, SB[0].y, SB[1].x, SB[1].y); *(float4*)(Qm + rowB * 64 + 4) = make_float4(SB[2].x, SB[2].y, SB[3].x, SB[3].y);
  }
  __syncthreads();
}

__device__ __forceinline__ void conv_item(KP P, int l, int item, unsigned char* lds, int wv_) {
#ifdef OFF_conv_item
  return;
#endif

  bf16_t* p = (bf16_t*)(P->ws + WS_P);
  float* u = (float*)lds;
  float* yb = (float*)(lds + 62 * 1024);
  const int tid = opaque_tid(wv_), c = tid & 255, half = tid >> 8;
  const int t0 = item * 32, tt0 = t0 & (TSEQ - 1);
  {
    bf16_t rv[31], rg[31];
#pragma unroll
    for (int i = 0; i < 31; ++i) { const int r = half + 2 * i; const bool ok = (tt0 - 30 + r) >= 0; const bf16_t* pr = p + (size_t)(t0 - 30 + r) * NIN;
      rv[i] = ok ? pr[C_CVAL + c] : (bf16_t)0; rg[i] = ok ? pr[C_CGLU + c] : (bf16_t)0; }
#pragma unroll
    for (int i = 0; i < 31; ++i) u[(half + 2 * i) * 256 + c] = bf2f(rv[i]) * sigmoidf_(bf2f(rg[i]));
  }
  float wv[31];
#pragma unroll
  for (int j = 0; j < 31; ++j) wv[j] = P->in[14][(l * 31 + j) * 256 + c];
  const float bias = P->in[15][l * 256 + c];
  __syncthreads();
  {
    float win[46];
#pragma unroll
    for (int i = 0; i < 46; ++i) win[i] = u[(half * 16 + i) * 256 + c];
#pragma unroll
    for (int i = 0; i < 16; ++i) {
      float acc = bias;
#pragma unroll
      for (int j = 0; j < 31; ++j) acc = fmaf(wv[j], win[i + j], acc);
      yb[(half * 16 + i) * 256 + c] = acc;
    }
  }
  __syncthreads();
  const int lane = tid & 63, w = tid >> 6;
  const float4 g = *(const float4*)(P->in[16] + l * 256 + lane * 4), bb = *(const float4*)(P->in[17] + l * 256 + lane * 4);
  uint2 gpre[4];
#pragma unroll
  for (int i = 0; i < 4; ++i) gpre[i] = *(const uint2*)(p + (size_t)(t0 + w * 4 + i) * NIN + C_CGATE + lane * 4);
#pragma unroll
  for (int i = 0; i < 4; ++i) {
    const int tk = w * 4 + i;
    const float4 v = *(const float4*)(yb + tk * 256 + lane * 4);
    const float mean = wave_sum(v.x + v.y + v.z + v.w, lane) * (1.0f / 256.0f);
    const float d0 = v.x - mean, d1 = v.y - mean, d2 = v.z - mean, d3 = v.w - mean;
    const float var = wave_sum(d0 * d0 + d1 * d1 + d2 * d2 + d3 * d3, lane) * (1.0f / 256.0f);
    const float rs = rsqrtf(var + 1e-5f);
    bf16_t* gp = p + (size_t)(t0 + tk) * NIN + C_CGATE + lane * 4;
    const uint2 gu = gpre[i];
    const float o0 = siluf_(d0 * rs * g.x + bb.x) * siluf_(__uint_as_float(gu.x << 16));
    const float o1 = siluf_(d1 * rs * g.y + bb.y) * siluf_(__uint_as_float(gu.x & 0xffff0000u));
    const float o2 = siluf_(d2 * rs * g.z + bb.z) * siluf_(__uint_as_float(gu.y << 16));
    const float o3 = siluf_(d3 * rs * g.w + bb.w) * siluf_(__uint_as_float(gu.y & 0xffff0000u));
    uint2 o; o.x = pack2(o0, o1); o.y = pack2(o2, o3);
    *(uint2*)gp = o;
  }
  __syncthreads();
}

#define HG_WLDS 10240
__device__ __forceinline__ float hgrn_lb(KP P, int l, int ch) {
  if (l == 0) return 0.f;
  const float x0 = P->in[18][ch], x1 = P->in[18][256 + ch];
  return __builtin_amdgcn_rcpf(1.0f + __expf(x0 - x1));
}
template <int PASS>
__device__ __forceinline__ void hgrn_wave_item(KP P, int l, int wi, unsigned char* lds, int wv_) {
#ifdef OFF_hgrn_wave_item
  return;
#endif

  bf16_t* p = (bf16_t*)(P->ws + WS_P);
  float* HS = (float*)(P->ws + WS_HS); float* HF = (float*)(P->ws + WS_HF);
  const int tid = opaque_tid(wv_);
  const int lane = tid & 63, w = tid >> 6;
  const int bh = wi >> 7, chunk = wi & 127, b = bh >> 2, head = bh & 3;
  float* st = (float*)(lds + w * HG_WLDS);
  float* ob = st + 2048;
  const int kg = lane & 7, vg = lane >> 3;
  const int ch = head * 64 + lane;
  const float lb = hgrn_lb(P, l, ch);
  const float ng = P->in[19][l * 256 + ch];
  float S[8][8];
  float* slot = HS + (size_t)(bh * 128 + chunk) * 4096;
  if (PASS == 1) {
#pragma unroll
    for (int i = 0; i < 8; ++i) { const float4 x0 = *(const float4*)(slot + (kg * 8 + i) * 64 + vg * 8), x1 = *(const float4*)(slot + (kg * 8 + i) * 64 + vg * 8 + 4);
      S[i][0] = x0.x; S[i][1] = x0.y; S[i][2] = x0.z; S[i][3] = x0.w; S[i][4] = x1.x; S[i][5] = x1.y; S[i][6] = x1.z; S[i][7] = x1.w; }
  } else {
#pragma unroll
    for (int i = 0; i < 8; ++i)
#pragma unroll
      for (int j = 0; j < 8; ++j) S[i][j] = 0.f;
  }
  float Fp = 1.f;
  bf16_t rf[8], ri[8], rq[8], rg[8];
  {
    const int tb0 = b * TSEQ + chunk * 64;
#pragma unroll
    for (int s = 0; s < 8; ++s) { const bf16_t* pr = p + (size_t)(tb0 + s) * NIN; rf[s] = pr[C_HF + ch]; ri[s] = pr[C_HI + ch]; if (PASS == 1) { rq[s] = pr[C_HQ + ch]; rg[s] = pr[C_HG + ch]; } }
  }
#pragma unroll 1
  for (int sub = 0; sub < 8; ++sub) {
    const int tbase = b * TSEQ + chunk * 64 + sub * 8;
    bf16_t gc[8];
#pragma unroll
    for (int s = 0; s < 8; ++s) {
      const float f = lb + (1.0f - lb) * sigmoidf_(bf2f(rf[s]));
      Fp *= f;
      st[s * 256 + lane] = f; st[s * 256 + 64 + lane] = 1.0f - f;
      if (PASS == 1) { st[s * 256 + 128 + lane] = siluf_(bf2f(rq[s])); gc[s] = rg[s]; }
      st[s * 256 + 192 + lane] = bf2f(ri[s]);
    }
    if (sub < 7) {
#pragma unroll
      for (int s = 0; s < 8; ++s) { const bf16_t* pr = p + (size_t)(tbase + 8 + s) * NIN; rf[s] = pr[C_HF + ch]; ri[s] = pr[C_HI + ch]; if (PASS == 1) { rq[s] = pr[C_HQ + ch]; rg[s] = pr[C_HG + ch]; } }
    }
    __builtin_amdgcn_s_waitcnt(0xc07f);
    __builtin_amdgcn_wave_barrier();
#pragma unroll 1
    for (int s = 0; s < 8; ++s) {
      const float* sp = st + s * 256;
      const float4 f0 = *(const float4*)(sp + kg * 8), f1 = *(const float4*)(sp + kg * 8 + 4);
      const float4 k0 = *(const float4*)(sp + 64 + kg * 8), k1 = *(const float4*)(sp + 64 + kg * 8 + 4);
      const float4 v0 = *(const float4*)(sp + 192 + vg * 8), v1 = *(const float4*)(sp + 192 + vg * 8 + 4);
      const float fv[8] = {f0.x, f0.y, f0.z, f0.w, f1.x, f1.y, f1.z, f1.w};
      const float kv[8] = {k0.x, k0.y, k0.z, k0.w, k1.x, k1.y, k1.z, k1.w};
      const float vv[8] = {v0.x, v0.y, v0.z, v0.w, v1.x, v1.y, v1.z, v1.w};
      const f32x2 vv2[4] = {{vv[0], vv[1]}, {vv[2], vv[3]}, {vv[4], vv[5]}, {vv[6], vv[7]}};
#pragma unroll
      for (int i = 0; i < 8; ++i) { const f32x2 f2 = {fv[i], fv[i]}, k2 = {kv[i], kv[i]};
#pragma unroll
        for (int j = 0; j < 4; ++j) { f32x2 s2 = {S[i][2 * j], S[i][2 * j + 1]}; s2 = f2 * s2 + k2 * vv2[j]; S[i][2 * j] = s2.x; S[i][2 * j + 1] = s2.y; } }
      if (PASS == 1) {
        const float4 q0 = *(const float4*)(sp + 128 + kg * 8), q1 = *(const float4*)(sp + 128 + kg * 8 + 4);
        const float qv[8] = {q0.x, q0.y, q0.z, q0.w, q1.x, q1.y, q1.z, q1.w};
        float o[8];
#pragma unroll
        for (int j = 0; j < 4; ++j) { f32x2 a2 = (f32x2){qv[0], qv[0]} * (f32x2){S[0][2 * j], S[0][2 * j + 1]};
#pragma unroll
          for (int i = 1; i < 8; ++i) a2 = (f32x2){qv[i], qv[i]} * (f32x2){S[i][2 * j], S[i][2 * j + 1]} + a2;
          o[2 * j] = red8(a2.x); o[2 * j + 1] = red8(a2.y); }
        if (kg == 0) { *(float4*)(ob + s * 64 + vg * 8) = make_float4(o[0], o[1], o[2], o[3]); *(float4*)(ob + s * 64 + vg * 8 + 4) = make_float4(o[4], o[5], o[6], o[7]); }
      }
    }
    __builtin_amdgcn_s_waitcnt(0xc07f);
    __builtin_amdgcn_wave_barrier();
    if (PASS == 1) {
#pragma unroll
      for (int s = 0; s < 8; ++s) {
        const float o = ob[s * 64 + lane];
        const float ms = wave_sum(o * o, lane) * (1.0f / 64.0f);
        p[(size_t)(tbase + s) * NIN + C_HG + ch] = f2bf(o * rsqrtf(ms + 1e-6f) * ng * siluf_(bf2f(gc[s])));
      }
      __builtin_amdgcn_s_waitcnt(0xc07f);
      __builtin_amdgcn_wave_barrier();
    }
  }
  if (PASS == 0) {
#pragma unroll
    for (int i = 0; i < 8; ++i) { *(float4*)(slot + (kg * 8 + i) * 64 + vg * 8) = make_float4(S[i][0], S[i][1], S[i][2], S[i][3]);
      *(float4*)(slot + (kg * 8 + i) * 64 + vg * 8 + 4) = make_float4(S[i][4], S[i][5], S[i][6], S[i][7]); }
    HF[(size_t)(bh * 128 + chunk) * 64 + lane] = Fp;
  }
}
__device__ __forceinline__ void hgrn_combine_item(KP P, int bh, int wv_) {
#ifdef OFF_hgrn_combine_item
  return;
#endif

  float* HS = (float*)(P->ws + WS_HS); const float* HF = (const float*)(P->ws + WS_HF);
  const int tid = opaque_tid(wv_);
  const int krow = tid >> 3;
  float R[8];
#pragma unroll
  for (int e = 0; e < 8; ++e) R[e] = 0.f;
  float4 xa[8][2]; float fa[8];
#pragma unroll
  for (int u = 0; u < 8; ++u) { const float* sl = HS + (size_t)(bh * 128 + u) * 4096 + tid * 8; xa[u][0] = *(const float4*)sl; xa[u][1] = *(const float4*)(sl + 4); fa[u] = HF[(size_t)(bh * 128 + u) * 64 + krow]; }
#pragma unroll 1
  for (int c0 = 0; c0 < 128; c0 += 8) {
    float4 xn[8][2]; float fn[8];
    if (c0 + 8 < 128) {
#pragma unroll
      for (int u = 0; u < 8; ++u) { const float* sl = HS + (size_t)(bh * 128 + c0 + 8 + u) * 4096 + tid * 8; xn[u][0] = *(const float4*)sl; xn[u][1] = *(const float4*)(sl + 4); fn[u] = HF[(size_t)(bh * 128 + c0 + 8 + u) * 64 + krow]; }
    }
#pragma unroll
    for (int u = 0; u < 8; ++u) {
      float* sl = HS + (size_t)(bh * 128 + c0 + u) * 4096 + tid * 8;
      *(float4*)sl = make_float4(R[0], R[1], R[2], R[3]); *(float4*)(sl + 4) = make_float4(R[4], R[5], R[6], R[7]);
      const float f = fa[u];
      R[0] = fmaf(f, R[0], xa[u][0].x); R[1] = fmaf(f, R[1], xa[u][0].y); R[2] = fmaf(f, R[2], xa[u][0].z); R[3] = fmaf(f, R[3], xa[u][0].w);
      R[4] = fmaf(f, R[4], xa[u][1].x); R[5] = fmaf(f, R[5], xa[u][1].y); R[6] = fmaf(f, R[6], xa[u][1].z); R[7] = fmaf(f, R[7], xa[u][1].w);
    }
    if (c0 + 8 < 128) {
#pragma unroll
      for (int u = 0; u < 8; ++u) { xa[u][0] = xn[u][0]; xa[u][1] = xn[u][1]; fa[u] = fn[u]; }
    }
  }
}

__device__ __forceinline__ void sb_item(KP P, int item, unsigned char* lds, int wv_) {
#ifdef OFF_sb_item
  return;
#endif

  bf16_t* p = (bf16_t*)(P->ws + WS_P);
  const int tid = opaque_tid(wv_), lane = tid & 63, w = tid >> 6;
  const int qt = item & 127, bh = item >> 7, b = bh >> 2, head = bh & 3;
  unsigned char* Qs = lds;
  unsigned char* Ks = lds + 9216;
  unsigned char* Vt = lds + 18432;
  unsigned char* As = lds + 27648;
  float* Zs = (float*)(lds + 36864);
  volatile int* flag = (volatile int*)(lds + 36864 + 64 * 65 * 4);
  const int lrow = tid >> 3, lch = (tid & 7);
  const size_t tokq = (size_t)b * TSEQ + qt * 64;
  *(uint4*)(Qs + lrow * 144 + lch * 16) = *(const uint4*)(p + (tokq + lrow) * NIN + C_SQ + head * 64 + lch * 8);
  float carry = 0.f;
  f32x4 oacc[2] = {{0.f, 0.f, 0.f, 0.f}, {0.f, 0.f, 0.f, 0.f}};
  const int qi = w >> 1, t2 = (w & 1) * 2;
  f32x4 gpre0, gpre1;
#pragma unroll
  for (int r = 0; r < 4; ++r) { const bf16_t* gp_ = p + (tokq + qi * 16 + (lane >> 4) * 4 + r) * NIN + C_SG + head * 64 + t2 * 16 + (lane & 15); gpre0[r] = bf2f(gp_[0]); gpre1[r] = bf2f(gp_[16]); }
  const int q = tid >> 3, seg = tid & 7;
  uint4 kreg = *(const uint4*)(p + (tokq + lrow) * NIN + C_SK + head * 64 + lch * 8);
  const int vkey = tid & 63, vch = tid >> 6;
  uint4 vreg = *(const uint4*)(p + (tokq + vkey) * NIN + C_SV + head * 64 + vch * 8);
  for (int kt = qt; kt >= 0; --kt) {
    LBAR();
    *(uint4*)(Ks + lrow * 144 + lch * 16) = kreg;
    { const unsigned vw[4] = {vreg.x, vreg.y, vreg.z, vreg.w};
#pragma unroll
      for (int e = 0; e < 8; ++e) *(unsigned short*)(Vt + (vch * 8 + e) * 144 + vkey * 2) = (unsigned short)((e & 1) ? (vw[e >> 1] >> 16) : (vw[e >> 1] & 0xffffu)); }
    if (tid == 0) *flag = 0;
    if (kt > 0) { const size_t tokn = (size_t)b * TSEQ + (kt - 1) * 64;
      kreg = *(const uint4*)(p + (tokn + lrow) * NIN + C_SK + head * 64 + lch * 8);
      vreg = *(const uint4*)(p + (tokn + vkey) * NIN + C_SV + head * 64 + vch * 8); }
    LBAR();
#pragma unroll
    for (int jj = 0; jj < 2; ++jj) {
      const int ki = t2 + jj;
      f32x4 acc = {0.f, 0.f, 0.f, 0.f};
#pragma unroll
      for (int s = 0; s < 2; ++s) {
        const bf16x8 a = *(const bf16x8*)(Qs + (qi * 16 + (lane & 15)) * 144 + s * 64 + (lane >> 4) * 16);
        const bf16x8 bb = *(const bf16x8*)(Ks + (ki * 16 + (lane & 15)) * 144 + s * 64 + (lane >> 4) * 16);
        acc = __builtin_amdgcn_mfma_f32_16x16x32_bf16(a, bb, acc, 0, 0, 0);
      }
#pragma unroll
      for (int r = 0; r < 4; ++r) Zs[(qi * 16 + (lane >> 4) * 4 + r) * 65 + ki * 16 + (lane & 15)] = acc[r] * 0.125f;
    }
    LBAR();
    {
      const int tq = qt * 64 + q;
      float z[8], lk[8];
      float tot = 0.f;
#pragma unroll
      for (int e = 0; e < 8; ++e) {
        z[e] = Zs[q * 65 + seg * 8 + e];
        const bool m = (kt * 64 + seg * 8 + e) < tq;
        lk[e] = m ? -softplus_fast(z[e]) : 0.f;
        tot += lk[e];
      }
      float inc = tot;
      { float t_ = __builtin_bit_cast(float, __builtin_amdgcn_update_dpp(0, __builtin_bit_cast(int, inc), 0x101, 0xF, 0xF, true)); if (seg + 1 < 8) inc += t_; }
      { float t_ = __builtin_bit_cast(float, __builtin_amdgcn_update_dpp(0, __builtin_bit_cast(int, inc), 0x102, 0xF, 0xF, true)); if (seg + 2 < 8) inc += t_; }
      { float t_ = __builtin_bit_cast(float, __builtin_amdgcn_update_dpp(0, __builtin_bit_cast(int, inc), 0x104, 0xF, 0xF, true)); if (seg + 4 < 8) inc += t_; }
      const float rowtot = red8(tot);
      float tail = carry + (inc - tot);
      float av[8];
#pragma unroll
      for (int e = 7; e >= 0; --e) {
        const bool m = (kt * 64 + seg * 8 + e) < tq;
        av[e] = m ? __expf(z[e] + lk[e] + tail) : 0.f;
        tail += lk[e];
      }
      uint4 o; o.x = pack2(av[0], av[1]); o.y = pack2(av[2], av[3]); o.z = pack2(av[4], av[5]); o.w = pack2(av[6], av[7]);
      *(uint4*)(As + q * 144 + seg * 16) = o;
      carry += rowtot;
      if (carry > -104.f) *flag = 1;
    }
    LBAR();
#pragma unroll
    for (int jj = 0; jj < 2; ++jj) {
      const int di = t2 + jj;
#pragma unroll
      for (int s = 0; s < 2; ++s) {
        const bf16x8 a = *(const bf16x8*)(As + (qi * 16 + (lane & 15)) * 144 + s * 64 + (lane >> 4) * 16);
        const bf16x8 bb = *(const bf16x8*)(Vt + (di * 16 + (lane & 15)) * 144 + s * 64 + (lane >> 4) * 16);
        oacc[jj] = __builtin_amdgcn_mfma_f32_16x16x32_bf16(a, bb, oacc[jj], 0, 0, 0);
      }
    }
    if (*flag == 0) break;
  }
#pragma unroll
  for (int jj = 0; jj < 2; ++jj) {
    const int d = (t2 + jj) * 16 + (lane & 15);
#pragma unroll
    for (int r = 0; r < 4; ++r) {
      const int qq = qi * 16 + (lane >> 4) * 4 + r;
      bf16_t* gp = p + (tokq + qq) * NIN + C_SG + head * 64 + d;
      *gp = f2bf(oacc[jj][r] * siluf_(jj == 0 ? gpre0[r] : gpre1[r]));
    }
  }
  __syncthreads();
}

__device__ __forceinline__ void xattn_item(KP P, int l, int item, unsigned char* lds, int wv_) {
  const bf16_t* qb = (const bf16_t*)(P->ws + WS_P + 32ull * MiB);
  bf16_t* ob = (bf16_t*)(P->ws + WS_P + 64ull * MiB);
  const bf16_t* kv = (const bf16_t*)(P->ws + WS_KV) + (size_t)l * 512 * 2048;
  const bf16_t* vt = (const bf16_t*)(P->ws + WS_VT) + (size_t)l * 2 * 1024 * 256;
  const int tid = opaque_tid(wv_), lane = tid & 63, w = tid >> 6;
  const int qt = item & 127, bh = item >> 7, b = bh >> 2, head = bh & 3;
  unsigned char* Qs = lds;
  unsigned char* KVs = lds + 33792;
  float* Ss = (float*)(lds + 67584);
  const size_t tok0 = (size_t)b * TSEQ + qt * 64;
  const int pr = tid >> 5, pc = tid & 31;
  uint4 pg0, pg1, pg2, pg3;
#define XA_LOAD(p_) { const bf16_t* s_ = (p_) < 4 ? kv + (size_t)(b * 256 + (p_) * 64 + pr) * 2048 + head * 256 + pc * 8 : vt + (size_t)(b * 1024 + head * 256 + ((p_) - 4) * 64 + pr) * 256 + pc * 8; \
      const size_t st_ = (p_) < 4 ? (size_t)16 * 2048 : (size_t)16 * 256; \
      pg0 = *(const uint4*)(s_); pg1 = *(const uint4*)(s_ + st_); pg2 = *(const uint4*)(s_ + 2 * st_); pg3 = *(const uint4*)(s_ + 3 * st_); }
  __syncthreads();
#pragma unroll
  for (int i = 0; i < 4; ++i) { const int r = pr + 16 * i; *(uint4*)(Qs + r * 528 + pc * 16) = *(const uint4*)(qb + (tok0 + r) * 1024 + head * 256 + pc * 8); }
  XA_LOAD(0);
  const int qi = w >> 1, t2 = (w & 1) * 2;
#pragma unroll 1
  for (int p = 0; p < 8; ++p) {
    LBAR();
    { unsigned char* d_ = KVs + pr * 528 + pc * 16; *(uint4*)d_ = pg0; *(uint4*)(d_ + 16 * 528) = pg1; *(uint4*)(d_ + 32 * 528) = pg2; *(uint4*)(d_ + 48 * 528) = pg3; }
    if (p < 7) XA_LOAD(p + 1);
    LBAR();
    f32x4 acc0 = {0.f, 0.f, 0.f, 0.f}, acc1 = {0.f, 0.f, 0.f, 0.f};
#pragma unroll
    for (int s = 0; s < 8; ++s) {
      const bf16x8 a = *(const bf16x8*)(Qs + (qi * 16 + (lane & 15)) * 528 + s * 64 + (lane >> 4) * 16);
      const bf16x8 b0 = *(const bf16x8*)(KVs + (t2 * 16 + (lane & 15)) * 528 + s * 64 + (lane >> 4) * 16);
      const bf16x8 b1 = *(const bf16x8*)(KVs + ((t2 + 1) * 16 + (lane & 15)) * 528 + s * 64 + (lane >> 4) * 16);
      acc0 = __builtin_amdgcn_mfma_f32_16x16x32_bf16(a, b0, acc0, 0, 0, 0);
      acc1 = __builtin_amdgcn_mfma_f32_16x16x32_bf16(a, b1, acc1, 0, 0, 0);
    }
    if (p < 4) {
#pragma unroll
      for (int r = 0; r < 4; ++r) { float* d_ = Ss + (qi * 16 + (lane >> 4) * 4 + r) * 260 + p * 64 + t2 * 16 + (lane & 15); d_[0] = acc0[r] * 0.0625f; d_[16] = acc1[r] * 0.0625f; }
      if (p == 3) {
        LBAR();
        const int q = tid >> 3, seg = tid & 7;
        float x[32]; float mx = -3.0e38f;
#pragma unroll
        for (int i = 0; i < 8; ++i) { const float4 v = *(const float4*)(Ss + q * 260 + seg * 32 + i * 4); x[i * 4] = v.x; x[i * 4 + 1] = v.y; x[i * 4 + 2] = v.z; x[i * 4 + 3] = v.w;
          mx = fmaxf(mx, fmaxf(fmaxf(v.x, v.y), fmaxf(v.z, v.w))); }
        mx = max8(mx);
        float sum = 0.f;
#pragma unroll
        for (int i = 0; i < 32; ++i) { x[i] = __expf(x[i] - mx); sum += x[i]; }
        sum = red8(sum);
        const float inv = __builtin_amdgcn_rcpf(sum);
#pragma unroll
        for (int i = 0; i < 4; ++i) { uint4 o; o.x = pack2(x[i * 8] * inv, x[i * 8 + 1] * inv); o.y = pack2(x[i * 8 + 2] * inv, x[i * 8 + 3] * inv);
          o.z = pack2(x[i * 8 + 4] * inv, x[i * 8 + 5] * inv); o.w = pack2(x[i * 8 + 6] * inv, x[i * 8 + 7] * inv);
          *(uint4*)(Qs + q * 528 + seg * 64 + i * 16) = o; }
      }
    } else {
#pragma unroll
      for (int r = 0; r < 4; ++r) { bf16_t* d_ = ob + (tok0 + qi * 16 + (lane >> 4) * 4 + r) * 1024 + head * 256 + (p - 4) * 64 + t2 * 16 + (lane & 15); d_[0] = f2bf(acc0[r]); d_[16] = f2bf(acc1[r]); }
    }
  }
#undef XA_LOAD
  __syncthreads();
}

__device__ __forceinline__ void wt_item(KP P, int l, int r, unsigned char* lds, int wv_) {
  const float* W; int N; bf16_t* Wt; int kt, nt; const float* gk = nullptr;
  unsigned char* wl = P->ws + WS_WT + l * WT_LAYER;
  if (r < 976) { W = P->in[3] + (size_t)l * 1024 * NIN; N = NIN; Wt = (bf16_t*)(wl + WT_IN); kt = r / 61; nt = r % 61; gk = P->in[2] + l * 1024; }
  else { r -= 976; const int m = r >> 8; r &= 255; kt = r >> 4; nt = r & 15; N = 1024;
    if (m == 0) { W = P->in[20] + (size_t)l * 1048576; Wt = (bf16_t*)(wl + WT_OUT); }
    else if (m == 1) { W = P->in[23] + (size_t)l * 1048576; Wt = (bf16_t*)(wl + WT_Q); gk = P->in[21] + l * 1024; }
    else if (m == 2) { W = P->in[24] + (size_t)l * 1048576; Wt = (bf16_t*)(wl + WT_KV); }
    else if (m == 3) { W = P->in[25] + (size_t)l * 1048576; Wt = (bf16_t*)(wl + WT_KV) + 1024 * 1024; }
    else { W = P->in[26] + (size_t)l * 1048576; Wt = (bf16_t*)(wl + WT_O); } }
  wt_tile(W, N, Wt, kt, nt, lds, wv_, gk);
}
__device__ __forceinline__ void wt_deferred(KP P, int d, unsigned char* lds, int wv_) {
  if (d < 768) { const int m = d >> 8, r = d & 255; wt_item(P, 0, 976 + (m == 0 ? 0 : m == 1 ? 256 : 1024) + r, lds, wv_); }
  else wt_item(P, 1, d - 768, lds, wv_);
}
__device__ __forceinline__ int next_item(unsigned* ctr, volatile LAS int* slot, int wv_) {
  __syncthreads();
  if (opaque_tid(wv_) == 0) *slot = (int)__hip_atomic_fetch_add(ctr, 1u, __ATOMIC_RELAXED, __HIP_MEMORY_SCOPE_AGENT);
  __syncthreads();
  return *slot;
}
__global__ void __launch_bounds__(NTHR) fwd_megakernel(Params Pk_unused) {
  KP P = (KP)__builtin_amdgcn_kernarg_segment_ptr();
  extern __shared__ __attribute__((aligned(16))) unsigned char lds[];
  const int wv_ = __builtin_amdgcn_readfirstlane((int)threadIdx.x >> 6);
  __shared__ uint4 xb_words;
  __shared__ int4 wq_slot;
  if (opaque_tid(wv_) == 0) xb_words = make_uint4(0u, 0u, 0u, 0u);
  __syncthreads();
#ifdef PROBE_J
  __shared__ unsigned long long tacc[32];
  __shared__ unsigned long long tlast;
  __shared__ float pdelta;
  if (opaque_tid(wv_) == 0) { for (int i = 0; i < 32; ++i) tacc[i] = 0ull; tlast = __builtin_amdgcn_s_memrealtime(); pdelta = 0.f; }
#define STAMP(k) if (opaque_tid(wv_) == 0) { const unsigned long long n_ = __builtin_amdgcn_s_memrealtime(); tacc[k] += n_ - tlast; tlast = n_; }
#else
#define STAMP(k)
#endif
  XcdBarrier bar = xcd_barrier_post((unsigned*)(P->ws + WS_BAR), (volatile LAS unsigned*)&xb_words, wv_);
  if (P->never) cg::this_grid().sync();
  const int G = gridDim.x, bid0 = blockIdx.x;

  for (int it = bid0; it < 976 + 512; it += G) wt_item(P, 0, it < 976 ? it : it + 512, lds, wv_);
#pragma unroll 1
  for (int k = 0; k < 3; ++k) {
    const float* s_ = k < 2 ? P->in[1] : P->in[0];
    const float* g_ = k < 2 ? P->in[22] + k * 1024 : P->in[2];
    bf16_t* d_ = k < 2 ? (bf16_t*)(P->ws + WS_MEMN) + k * 512 * 1024 : (bf16_t*)((unsigned char*)P->out + 32ull * MiB);
    norm_rows(false, s_, g_, d_, k < 2 ? 512 : NT, 0.f, wv_, k < 2 ? nullptr : (float*)(P->ws + WS_SSQ));
  }
  { float* z_ = (float*)(P->ws + WS_SSQ) + NT; for (int i = bid0 * NTHR + opaque_tid(wv_); i < 4 * NT; i += G * NTHR) z_[i] = 0.f; }
  STAMP(16 + 10); xcd_barrier(bar, wv_); STAMP(10)
  asm volatile("" : "+s"(P));

#pragma unroll 1
  for (int it = 0; it < 17; ++it) {
    int l = it >> 3, ph = it & 7;
    ph = ph < 5 ? ph : ph + 1;
    if (it == 16) { l = 1; ph = 9; }
    asm volatile("" : "+s"(P));
    int bid = bid0; asm volatile("" : "+s"(bid));

    unsigned char* ws = P->ws;
    const unsigned char* wl = ws + WS_WT + l * WT_LAYER;
    bf16_t* hbuf = (bf16_t*)((unsigned char*)P->out + 32ull * MiB);
    float* ssq = (float*)(ws + WS_SSQ);
    bf16_t* pbuf = (bf16_t*)(ws + WS_P);
    bf16_t* hx = (bf16_t*)(ws + WS_P);
    bf16_t* qbuf = (bf16_t*)(ws + WS_P + 32ull * MiB);
    bf16_t* obuf = (bf16_t*)(ws + WS_P + 64ull * MiB);
    if (ph == 0 || ph == 4 || ph == 6 || ph == 8) {
      pg8::Gemm g; pg8::TileSched S; pg8::EpiDyn E;
      g.M = NT; g.K = 1024; S.G = G; S.c = bid;
      if (ph == 0) { g.A = hbuf; g.Bt = (const bf16_t*)(wl + WT_IN); g.N = 4096; g.lda = 1024; g.ao0 = 0; g.ao1 = 256; g.ao2 = 512; g.ao3 = 768; S.nt = 1024; S.nN = 16;
        E.mode = 0; E.O = pbuf; E.ldc = NIN; E.N = NIN; E.resid = nullptr; E.out = nullptr; E.ssq_in = ssq + (l == 0 ? 0 : 2) * NT; E.xb = nullptr; E.ssq_out = nullptr; }
      else if (ph == 4) { g.A = pbuf; g.Bt = (const bf16_t*)(wl + WT_OUT); g.N = 1024; g.lda = NIN; g.ao0 = C_GA; g.ao1 = C_CGATE; g.ao2 = C_HG; g.ao3 = C_SG; S.nt = 256; S.nN = 4;
        E.mode = 1; E.O = nullptr; E.ldc = 1024; E.N = 1024; E.resid = (l == 0) ? P->in[0] : P->out; E.out = P->out; E.ssq_in = nullptr; E.xb = hbuf; E.ssq_out = ssq + (l == 0 ? 1 : 3) * NT; }
      else if (ph == 6) { g.A = hbuf; g.Bt = (const bf16_t*)(wl + WT_Q); g.N = 1024; g.lda = 1024; g.ao0 = 0; g.ao1 = 256; g.ao2 = 512; g.ao3 = 768; S.nt = 256; S.nN = 4;
        E.mode = 0; E.O = qbuf; E.ldc = 1024; E.N = 1024; E.resid = nullptr; E.out = nullptr; E.ssq_in = ssq + (l == 0 ? 1 : 3) * NT; E.xb = nullptr; E.ssq_out = nullptr; }
      else { g.A = obuf; g.Bt = (const bf16_t*)(wl + WT_O); g.N = 1024; g.lda = 1024; g.ao0 = 0; g.ao1 = 256; g.ao2 = 512; g.ao3 = 768; S.nt = 256; S.nN = 4;
        E.mode = 1; E.O = nullptr; E.ldc = 1024; E.N = 1024; E.resid = P->out; E.out = P->out; E.ssq_in = nullptr; E.xb = hbuf; E.ssq_out = ssq + (l == 0 ? 2 : 4) * NT; }
      pg8::gemm_phase<pg8::EpiDyn, pg8::TileSched, true, true>((PG8_LAS unsigned char*)lds, g, S, E, wv_);
    } else if (ph == 1) {
      unsigned* ctr = (unsigned*)(ws + WS_BAR) + it;
      for (;;) {
        const int i2 = next_item(ctr, (volatile LAS int*)&wq_slot, wv_);
        if (i2 >= 640) break;
        if (i2 < 128) hgrn_wave_item<0>(P, l, i2 * 8 + wv_, lds, wv_);
        else rwkv_prep_item(P, l, i2 - 128, lds, wv_);
      }
    } else if (ph == 2) {
      const int n_p1 = 8 * (RW_C - 2);
      const int n_rw = n_p1 + 8;
      const int n_oth = 8 + 512 + 1024;
      for (int i2 = bid; i2 < n_rw; i2 += G) {
        if (i2 < n_p1) rwkv_scan_item<1>(P, l, i2 & 7, 1 + (i2 >> 3), lds, wv_);
        else rwkv_scan_item<0>(P, l, i2 - n_p1, 0, lds, wv_);
      }
      {
        unsigned* ctr = (unsigned*)(ws + WS_BAR) + it;
        for (;;) {
          const int i2 = next_item(ctr, (volatile LAS int*)&wq_slot, wv_);
          if (i2 >= n_oth) break;
          if (i2 < 8) hgrn_combine_item(P, i2, wv_);
          else if (i2 < 8 + 512) conv_item(P, l, i2 - 8, lds, wv_);
          else sb_item(P, i2 - 8 - 512, lds, wv_);
        }
      }
    } else if (ph == 3) {
      const int n_p3 = 8 * (RW_C - 1);
      for (int i2 = bid; i2 < n_p3; i2 += G) rwkv_scan_item<0>(P, l, i2 & 7, 1 + (i2 >> 3), lds, wv_);
      {
        unsigned* ctr = (unsigned*)(ws + WS_BAR) + it;
        for (;;) {
          const int i2 = next_item(ctr, (volatile LAS int*)&wq_slot, wv_);
          if (i2 >= 16 + 128 + (l == 0 ? 189 : 0)) break;
          if (i2 >= 16 + 128) { for (int d = (i2 - 144) * 16; d < (i2 - 144) * 16 + 16; ++d) wt_deferred(P, d, lds, wv_); }
          else if (i2 < 16) gemm_tile<2>((const bf16_t*)(ws + WS_MEMN) + (size_t)l * 512 * 1024, 1024, 0, 256, 512, 768, (const bf16_t*)(wl + WT_KV), (i2 >> 3) * 256, (i2 & 7) * 256, 2048,
                                    (bf16_t*)(ws + WS_KV) + (size_t)l * 512 * 2048, (const float*)((bf16_t*)(ws + WS_VT) + (size_t)l * 2 * 1024 * 256), 2048, lds, wv_);
          else hgrn_wave_item<1>(P, l, (i2 - 16) * 8 + wv_, lds, wv_);
        }
      }
    } else if (ph == 7) {
      for (int i2 = bid * 4; i2 < 1024; i2 += G * 4) { for (int k2 = 0; k2 < 4; ++k2) xattn_item(P, l, i2 + k2, lds, wv_); }
    } else {
      const float* ssqf = ssq + 4 * NT;
      const float* gf = P->in[27];
      float* outp = P->out;
      const int tid = opaque_tid(wv_), lane = tid & 63, w = tid >> 6;
      float4 gv[4];
#pragma unroll
      for (int i = 0; i < 4; ++i) gv[i] = *(const float4*)(gf + lane * 16 + i * 4);
      const int rpb = (8192 + G - 1) / G;
      for (int c = tid; c < rpb * 128; c += NTHR) { const int j = c >> 7, ch = c & 127; const int row = 8192 + bid * rpb + j;
        if (row < NT) *(uint4*)(lds + (size_t)j * 2048 + ch * 16) = *(const uint4*)(hbuf + (size_t)row * 1024 + ch * 8); }
      for (int row = bid * 8 + w; row < 8192; row += G * 8) {
        const uint4 a = *(const uint4*)(hbuf + (size_t)row * 1024 + lane * 16), b2 = *(const uint4*)(hbuf + (size_t)row * 1024 + lane * 16 + 8);
        const float rs = __builtin_amdgcn_rsqf(ssqf[row] * (1.0f / 1024.0f) + 1e-6f);
        float* o_ = outp + (size_t)row * 1024 + lane * 16;
        *(float4*)(o_) = make_float4(__uint_as_float(a.x << 16) * rs * gv[0].x, __uint_as_float(a.x & 0xffff0000u) * rs * gv[0].y, __uint_as_float(a.y << 16) * rs * gv[0].z, __uint_as_float(a.y & 0xffff0000u) * rs * gv[0].w);
        *(float4*)(o_ + 4) = make_float4(__uint_as_float(a.z << 16) * rs * gv[1].x, __uint_as_float(a.z & 0xffff0000u) * rs * gv[1].y, __uint_as_float(a.w << 16) * rs * gv[1].z, __uint_as_float(a.w & 0xffff0000u) * rs * gv[1].w);
        *(float4*)(o_ + 8) = make_float4(__uint_as_float(b2.x << 16) * rs * gv[2].x, __uint_as_float(b2.x & 0xffff0000u) * rs * gv[2].y, __uint_as_float(b2.y << 16) * rs * gv[2].z, __uint_as_float(b2.y & 0xffff0000u) * rs * gv[2].w);
        *(float4*)(o_ + 12) = make_float4(__uint_as_float(b2.z << 16) * rs * gv[3].x, __uint_as_float(b2.z & 0xffff0000u) * rs * gv[3].y, __uint_as_float(b2.w << 16) * rs * gv[3].z, __uint_as_float(b2.w & 0xffff0000u) * rs * gv[3].w);
      }
      xcd_barrier(bar, wv_);
      for (int j = w; j < rpb; j += 8) { const int row = 8192 + bid * rpb + j;
        if (row < NT) {
          const uint4 a = *(const uint4*)(lds + (size_t)j * 2048 + lane * 32), b2 = *(const uint4*)(lds + (size_t)j * 2048 + lane * 32 + 16);
          const float rs = __builtin_amdgcn_rsqf(ssqf[row] * (1.0f / 1024.0f) + 1e-6f);
          float* o_ = outp + (size_t)row * 1024 + lane * 16;
          *(float4*)(o_) = make_float4(__uint_as_float(a.x << 16) * rs * gv[0].x, __uint_as_float(a.x & 0xffff0000u) * rs * gv[0].y, __uint_as_float(a.y << 16) * rs * gv[0].z, __uint_as_float(a.y & 0xffff0000u) * rs * gv[0].w);
          *(float4*)(o_ + 4) = make_float4(__uint_as_float(a.z << 16) * rs * gv[1].x, __uint_as_float(a.z & 0xffff0000u) * rs * gv[1].y, __uint_as_float(a.w << 16) * rs * gv[1].z, __uint_as_float(a.w & 0xffff0000u) * rs * gv[1].w);
          *(float4*)(o_ + 8) = make_float4(__uint_as_float(b2.x << 16) * rs * gv[2].x, __uint_as_float(b2.x & 0xffff0000u) * rs * gv[2].y, __uint_as_float(b2.y << 16) * rs * gv[2].z, __uint_as_float(b2.y & 0xffff0000u) * rs * gv[2].w);
          *(float4*)(o_ + 12) = make_float4(__uint_as_float(b2.z << 16) * rs * gv[3].x, __uint_as_float(b2.z & 0xffff0000u) * rs * gv[3].y, __uint_as_float(b2.w << 16) * rs * gv[3].z, __uint_as_float(b2.w & 0xffff0000u) * rs * gv[3].w);
        }
      }
    }
    if (it < 16) { STAMP(16 + ph); xcd_barrier(bar, wv_); STAMP(ph) }
  }
#ifdef PROBE_J
  if (bid0 == PROBE_B && opaque_tid(wv_) == 0) {
    const unsigned long long t0_ = __builtin_amdgcn_s_memrealtime();
    const unsigned long long w_ = 4ull * (PROBE_K < 32 ? tacc[PROBE_K & 31] : tacc[PROBE_K - 32] + tacc[PROBE_K - 16]);
    while (__builtin_amdgcn_s_memrealtime() - t0_ < w_) __builtin_amdgcn_s_sleep(8);
  }
#endif
}

extern "C" void kernel_launch(void* const* d_in, const int* in_sizes, int n_in, void* d_out, int out_size, void* d_ws, size_t ws_size, hipStream_t stream) {
  constexpr size_t kDynLds = 147456;
  static int grid_blocks = 0;
  if (!grid_blocks) {
    int dev = 0, cus = 0, per_cu = 0;
    hipGetDevice(&dev);
    hipDeviceGetAttribute(&cus, hipDeviceAttributeMultiprocessorCount, dev);
    hipFuncSetAttribute((const void*)fwd_megakernel, hipFuncAttributeMaxDynamicSharedMemorySize, (int)kDynLds);
    hipOccupancyMaxActiveBlocksPerMultiprocessor(&per_cu, fwd_megakernel, NTHR, kDynLds);
    if (per_cu < 1) per_cu = 1;
    if (per_cu > 1) per_cu = 1;
    grid_blocks = cus * per_cu;
    if (grid_blocks > 256) grid_blocks = 256;
  }
  Params p;
  memset(&p, 0, sizeof(p));
  for (int i = 0; i < 28; ++i) p.in[i] = (const float*)d_in[i];
  p.out = (float*)d_out; p.ws = (unsigned char*)d_ws; p.never = 0; p.pad = 0;
  hipMemsetAsync(d_ws, 0, XCD_BAR_WORDS * 4, stream);
  void* args[] = {&p};
  hipError_t e = hipLaunchCooperativeKernel((void*)fwd_megakernel, dim3(grid_blocks), dim3(NTHR), args, kDynLds, stream);
  if (e != hipSuccess) fprintf(stderr, "cooperative launch failed: %s (grid %d)\n", hipGetErrorString(e), grid_blocks);
}
```

```cpp
#include <hip/hip_runtime.h>
#include <hip/hip_cooperative_groups.h>
#include <stdint.h>
#include <cstdio>
#include <cstring>
namespace cg = cooperative_groups;

typedef unsigned short bf16_t;
typedef short bf16x8 __attribute__((ext_vector_type(8)));
typedef float f32x4 __attribute__((ext_vector_type(4)));
typedef float f32x16 __attribute__((ext_vector_type(16)));
typedef float f32x2 __attribute__((ext_vector_type(2)));
#define LAS __attribute__((address_space(3)))

#define NT 16384
#define TSEQ 8192
#define DM 1024
#define NIN 3904
#define NTHR 512
#define C_R 0
#define C_K 256
#define C_V 512
#define C_XW 768
#define C_GA 832
#define C_CVAL 1088
#define C_CGLU 1344
#define C_CGATE 1600
#define C_HQ 1856
#define C_HF 2112
#define C_HI 2368
#define C_HG 2624
#define C_SQ 2880
#define C_SK 3136
#define C_SV 3392
#define C_SG 3648
#define RW_C 32
#define RW_CL (TSEQ / RW_C)
#define RW_TT 16

#define MiB (1024ull * 1024ull)
#define WS_BAR   0ull
#define WS_WT    (1ull * MiB)
#define WT_LAYER (18ull * MiB)
#define WT_IN    0ull
#define WT_OUT   (8ull * MiB)
#define WT_Q     (10ull * MiB)
#define WT_KV    (12ull * MiB)
#define WT_O     (16ull * MiB)
#define WS_MEMN  (37ull * MiB)
#define WS_KV    (39ull * MiB)
#define WS_PQ    (246ull * MiB)
#define WS_HS    (47ull * MiB)
#define WS_HF    (63ull * MiB)
#define WS_RK    (63ull * MiB + 512ull * 1024ull)
#define WS_R1    (64ull * MiB)
#define WS_PW    WS_R1
#define WS_PV    (WS_R1 + 16ull * MiB)
#define WS_P     (120ull * MiB)
#define WS_VT    (243ull * MiB)
#define WS_SSQ   (245ull * MiB)
#define WS_END   (254ull * MiB)

struct Params {
  const float* in[28];
  float* out;
  unsigned char* ws;
  int never;
  int pad;
};

typedef const __attribute__((address_space(4))) Params* KP;
__device__ __forceinline__ int lane_id_() { return (int)__builtin_amdgcn_mbcnt_hi(~0u, __builtin_amdgcn_mbcnt_lo(~0u, 0u)); }
__device__ __forceinline__ int opaque_tid(int wv_) { int t; asm volatile("v_mbcnt_lo_u32_b32 %0, -1, 0\n\tv_mbcnt_hi_u32_b32 %0, -1, %0\n\tv_lshl_add_u32 %0, %1, 6, %0" : "=&v"(t) : "s"(wv_)); return t; }
__device__ __forceinline__ float bf2f(bf16_t v) { return __uint_as_float(((unsigned)v) << 16); }
__device__ __forceinline__ bf16_t f2bf(float f) {
  unsigned u = __float_as_uint(f);
  u += 0x7fffu + ((u >> 16) & 1u);
  return (bf16_t)(u >> 16);
}
__device__ __forceinline__ unsigned pack2(float a, float b) { return (unsigned)f2bf(a) | ((unsigned)f2bf(b) << 16); }
__device__ __forceinline__ float sigmoidf_(float x) { return __builtin_amdgcn_rcpf(1.0f + __expf(-x)); }
__device__ __forceinline__ float siluf_(float x) { return x * __builtin_amdgcn_rcpf(1.0f + __expf(-x)); }
__device__ __forceinline__ float softplusf_(float x) { return fmaxf(x, 0.f) + log1pf(__expf(-fabsf(x))); }
__device__ __forceinline__ float softplus_fast(float x) { return fmaxf(x, 0.f) + __logf(1.0f + __expf(-fabsf(x))); }
__device__ __forceinline__ float dpp_add(float v, const int ctrl_sel) {
  return v;
}
__device__ __forceinline__ float bperm(float v, int srclane) { return __builtin_bit_cast(float, __builtin_amdgcn_ds_bpermute(srclane << 2, __builtin_bit_cast(int, v))); }
__device__ __forceinline__ float wave_sum(float v, int lane) {
  v += __builtin_bit_cast(float, __builtin_amdgcn_update_dpp(0, __builtin_bit_cast(int, v), 0xB1, 0xF, 0xF, true));
  v += __builtin_bit_cast(float, __builtin_amdgcn_update_dpp(0, __builtin_bit_cast(int, v), 0x4E, 0xF, 0xF, true));
  v += __builtin_bit_cast(float, __builtin_amdgcn_update_dpp(0, __builtin_bit_cast(int, v), 0x141, 0xF, 0xF, true));
  v += __builtin_bit_cast(float, __builtin_amdgcn_update_dpp(0, __builtin_bit_cast(int, v), 0x140, 0xF, 0xF, true));
  v += bperm(v, lane ^ 16);
  v += bperm(v, lane ^ 32);
  return v;
}
__device__ __forceinline__ float max8(float v) {
  v = fmaxf(v, __builtin_bit_cast(float, __builtin_amdgcn_update_dpp(0, __builtin_bit_cast(int, v), 0xB1, 0xF, 0xF, true)));
  v = fmaxf(v, __builtin_bit_cast(float, __builtin_amdgcn_update_dpp(0, __builtin_bit_cast(int, v), 0x4E, 0xF, 0xF, true)));
  v = fmaxf(v, __builtin_bit_cast(float, __builtin_amdgcn_update_dpp(0, __builtin_bit_cast(int, v), 0x141, 0xF, 0xF, true)));
  return v;
}
__device__ __forceinline__ float red8(float v) {
  v += __builtin_bit_cast(float, __builtin_amdgcn_update_dpp(0, __builtin_bit_cast(int, v), 0xB1, 0xF, 0xF, true));
  v += __builtin_bit_cast(float, __builtin_amdgcn_update_dpp(0, __builtin_bit_cast(int, v), 0x4E, 0xF, 0xF, true));
  v += __builtin_bit_cast(float, __builtin_amdgcn_update_dpp(0, __builtin_bit_cast(int, v), 0x141, 0xF, 0xF, true));
  return v;
}

#define LBAR() do { asm volatile("s_waitcnt lgkmcnt(0)" ::: "memory"); __builtin_amdgcn_s_barrier(); asm volatile("" ::: "memory"); } while (0)
#define XB_TMO      128
#define XB_XCNT(j)  (256  + 64 * (j))
#define XB_XSUB(j)  (1280 + 64 * (j))
#define XB_XGEN(j)  (2304 + 64 * (j))
#define XB_TOP      3328
#define XB_TOPGEN   3392
#define XCD_BAR_WORDS 3456
#define XB_SPIN_CAP (1u << 22)
__device__ __forceinline__ unsigned xb_ld(unsigned* p) { return __hip_atomic_load(p, __ATOMIC_RELAXED, __HIP_MEMORY_SCOPE_AGENT); }
__device__ __forceinline__ unsigned xb_add(unsigned* p, unsigned v) { return __hip_atomic_fetch_add(p, v, __ATOMIC_RELAXED, __HIP_MEMORY_SCOPE_AGENT); }
__device__ __forceinline__ unsigned xb_xcc_id() { return (unsigned)__builtin_amdgcn_s_getreg((3 << 11) | 20) & 0xFu; }
#define XB_SPIN(cond, bar) do { unsigned _sp = 0; while (cond) { __builtin_amdgcn_s_sleep(1); \
    if ((++_sp & 255u) == 0u) { if (xb_ld(&(bar)[XB_TMO])) break; if (_sp > XB_SPIN_CAP) { atomicAdd(&(bar)[XB_TMO], 1u); break; } } } } while (0)
struct XcdBarrier { unsigned* bar; unsigned x; volatile LAS unsigned* st; };
__device__ __forceinline__ XcdBarrier xcd_barrier_post(unsigned* bar, volatile LAS unsigned* st, int wv_) {
  XcdBarrier b; b.bar = bar; b.x = xb_xcc_id(); b.st = st;
  if (opaque_tid(wv_) == 0) (void)xb_add(&bar[XB_XCNT(b.x)], 1u);
  return b;
}
__device__ __forceinline__ void xcd_barrier_complete(unsigned* bar, unsigned x, unsigned& nloc, unsigned& nx) {
  const unsigned G = gridDim.x * gridDim.y * gridDim.z;
  unsigned sum, cnt, mine, sp = 0u;
  for (;;) {
    sum = 0u; cnt = 0u; mine = 0u;
#pragma unroll
    for (unsigned j = 0; j < 16; ++j) { const unsigned c = xb_ld(&bar[XB_XCNT(j)]); sum += c; cnt += (c > 0u) ? 1u : 0u; mine = (j == x) ? c : mine; }
    if (sum == G) break;
    __builtin_amdgcn_s_sleep(1);
    if ((++sp & 255u) == 0u) { if (xb_ld(&bar[XB_TMO])) break; if (sp > XB_SPIN_CAP) { atomicAdd(&bar[XB_TMO], 1u); break; } }
  }
  nloc = mine > 0u ? mine : 1u; nx = cnt > 0u ? cnt : 1u;
}
__device__ __forceinline__ void xcd_barrier(const XcdBarrier& b, int wv_) {
  asm volatile("s_waitcnt vmcnt(0)" ::: "memory");
  __syncthreads();
  if (opaque_tid(wv_) == 0) {
    unsigned* bar = b.bar;
    __builtin_amdgcn_s_waitcnt(0);
    unsigned bx = b.x; asm volatile("" : "+s"(bx));
    unsigned nloc = b.st[0], nx = b.st[1];
    if (nloc == 0u) { xcd_barrier_complete(bar, bx, nloc, nx); b.st[0] = nloc; b.st[1] = nx; }
    const unsigned old = xb_add(&bar[XB_XSUB(bx)], 1u);
    const unsigned gen = old / nloc;
    if (old + 1u == (gen + 1u) * nloc) {
      __builtin_amdgcn_fence(__ATOMIC_RELEASE, "agent");
      asm volatile("s_waitcnt vmcnt(0)" ::: "memory");
      const unsigned og = xb_add(&bar[XB_TOP], 1u);
      const unsigned tg = og / nx;
      if (og + 1u == (tg + 1u) * nx) xb_add(&bar[XB_TOPGEN], 1u);
      else XB_SPIN(xb_ld(&bar[XB_TOPGEN]) == tg, bar);
      __builtin_amdgcn_fence(__ATOMIC_ACQUIRE, "agent");
      xb_add(&bar[XB_XGEN(bx)], 1u);
      asm volatile("s_waitcnt vmcnt(0)" ::: "memory");
    } else {
      XB_SPIN(xb_ld(&bar[XB_XGEN(bx)]) == gen, bar);
      __builtin_amdgcn_fence(__ATOMIC_ACQUIRE, "agent");
      asm volatile("s_waitcnt vmcnt(0)" ::: "memory");
    }
  }
  __syncthreads();
}

#define G_STAGE 73728
#define G_BOFF 36864
template <int EPI>
__device__ __forceinline__ void gemm_tile(const bf16_t* __restrict__ A, int lda, int ao0, int ao1, int ao2, int ao3,
                                          const bf16_t* __restrict__ Bt, int m0, int n0, int N,
                                          void* out, const float* resid, int ldc, unsigned char* lds, int wv_) {
#ifdef OFF_gemm_tile
  return;
#endif

  const int tid = opaque_tid(wv_), lane = tid & 63, w = tid >> 6;
  const int wm = w >> 2, wn = w & 3, lr = lane & 31, lh = lane >> 5;
  f32x16 acc[4][2];
#pragma unroll
  for (int i = 0; i < 4; ++i)
#pragma unroll
    for (int j = 0; j < 2; ++j)
#pragma unroll
      for (int r = 0; r < 16; ++r) acc[i][j][r] = 0.f;
  uint4 ra[4], rb[4];
  const int crow = tid >> 3, ccol = (tid & 7) * 8;
  const bf16_t* Ap = A + (size_t)(m0 + crow) * lda + ccol;
  const bf16_t* Bp = Bt + (size_t)(n0 + crow) * 1024 + ccol;
#define G_LOAD(kt) { const int k0_ = (kt) * 64; const int seg_ = k0_ >> 8; const int ao_ = (seg_ == 0 ? ao0 : seg_ == 1 ? ao1 : seg_ == 2 ? ao2 : ao3) + (k0_ & 255); \
    _Pragma("unroll") for (int i_ = 0; i_ < 4; ++i_) { ra[i_] = *(const uint4*)(Ap + (size_t)(i_ * 64) * lda + ao_); rb[i_] = *(const uint4*)(Bp + (size_t)(i_ * 64) * 1024 + k0_); } }
#define G_WRITE(buf) { unsigned char* b_ = lds + (buf) * G_STAGE + crow * 144 + (tid & 7) * 16; \
    _Pragma("unroll") for (int i_ = 0; i_ < 4; ++i_) { *(uint4*)(b_ + i_ * 64 * 144) = ra[i_]; *(uint4*)(b_ + G_BOFF + i_ * 64 * 144) = rb[i_]; } }
  G_LOAD(0); G_WRITE(0); __syncthreads();
  for (int kt = 0; kt < 16; ++kt) {
    if (kt < 15) G_LOAD(kt + 1);
    const unsigned char* base = lds + (kt & 1) * G_STAGE;
    const unsigned char* ab = base + (wm * 128 + lr) * 144 + lh * 16;
    const unsigned char* bb = base + G_BOFF + (wn * 64 + lr) * 144 + lh * 16;
#pragma unroll
    for (int s = 0; s < 4; ++s) {
      bf16x8 a[4], b[2];
#pragma unroll
      for (int i = 0; i < 4; ++i) a[i] = *(const bf16x8*)(ab + i * 32 * 144 + s * 32);
#pragma unroll
      for (int j = 0; j < 2; ++j) b[j] = *(const bf16x8*)(bb + j * 32 * 144 + s * 32);
#pragma unroll
      for (int i = 0; i < 4; ++i)
#pragma unroll
        for (int j = 0; j < 2; ++j) acc[i][j] = __builtin_amdgcn_mfma_f32_32x32x16_bf16(a[i], b[j], acc[i][j], 0, 0, 0);
    }
    if (kt < 15) G_WRITE((kt + 1) & 1);
    __syncthreads();
  }
#undef G_LOAD
#undef G_WRITE
#pragma unroll
  for (int i = 0; i < 4; ++i)
#pragma unroll
    for (int j = 0; j < 2; ++j) {
      const int col = n0 + wn * 64 + j * 32 + lr;
#pragma unroll
      for (int r = 0; r < 16; ++r) {
        const int row = m0 + wm * 128 + i * 32 + (r & 3) + 8 * (r >> 2) + 4 * lh;
        if (EPI == 0) { if (col < N) ((bf16_t*)out)[(size_t)row * ldc + col] = f2bf(acc[i][j][r]); }
        else if (EPI == 2) { if (col < 1024) ((bf16_t*)out)[(size_t)row * ldc + col] = f2bf(acc[i][j][r]);
                             else ((bf16_t*)resid)[((size_t)((row >> 8) * 1024 + (col - 1024))) * 256 + (row & 255)] = f2bf(acc[i][j][r]); }
        else { ((float*)out)[(size_t)row * ldc + col] = resid[(size_t)row * ldc + col] + acc[i][j][r]; }
      }
    }
}

__device__ __forceinline__ void tile_map(int t, int nN, int& mi, int& ni) {
  const int rnd = t >> 8, blk = t & 255, x = blk & 7, y = blk >> 3;
  if (nN == 16) { mi = rnd * 16 + (x >> 1) * 4 + (y & 3); ni = (x & 1) * 8 + (y >> 2); }
  else { mi = rnd * 64 + x * 8 + (y & 7); ni = y >> 3; }
}

namespace pg8 {
#define PG8_LAS __attribute__((address_space(3)))
typedef unsigned u32x4 __attribute__((ext_vector_type(4)));
constexpr int BM = 256, BK = 64, HALF = 128, HTB = HALF * BK * 2  , STAGE_BYTES = 8 * HTB, NXCD = 8, WGM = 8;

__host__ __device__ __forceinline__ int lds_byte(int r, int c) { const int st = (r >> 4) * 2 + (c >> 5), rr = r & 15, cc = c & 31, ob = rr * 64 + cc * 2; return st * 1024 + (ob ^ (((ob >> 9) & 1) << 5)); }
__host__ __device__ __forceinline__ void stage_rc(int b, int& R, int& C) { const int st = b / 1024, sb = b % 1024, swz = sb ^ (((sb >> 9) & 1) << 5); R = (st >> 1) * 16 + swz / 64; C = (st & 1) * 32 + (swz % 64) / 2; }
__host__ __device__ __forceinline__ int perm32(int rho) { const int n = rho >> 4, i = rho & 15; return 8 * (i >> 2) + 4 * n + (i & 3); }

struct Unit { int pm, pn; };
struct Gemm { const bf16_t* A; const bf16_t* Bt; int M, N, K; int lda; int ao0, ao1, ao2, ao3; };

struct TileSched {
    int nt, G, c, nN;
    __device__ __forceinline__ bool next(int i, Unit& u) const { const int t = i * G + c; if (t >= nt) return false; tile_map(t, nN, u.pm, u.pn); return true; }
    __device__ __forceinline__ void a_ready(const Unit&) const {}
    __device__ __forceinline__ void done(const Unit&) const {}
};
__device__ __forceinline__ unsigned cvt_pk_bf16(float lo, float hi) { unsigned r; asm volatile("v_cvt_pk_bf16_f32 %0, %1, %2" : "=v"(r) : "v"(lo), "v"(hi)); return r; }
struct EpiStoreBf16 {
    static constexpr bool PERM = true, AFTER_DRAIN = false;
    bf16_t* O; int ldc; int N;
    __device__ __forceinline__ void operator()(const f32x4 (&acc)[2][2][4][2], const Unit& u, int wr, int wc, int fr, int fq) const {
        const int row0 = u.pm * BM + wr * 64 + fr, col0 = u.pn * BM + wc * 32 + 8 * fq;
#pragma unroll
        for (int ai = 0; ai < 2; ++ai)
#pragma unroll
            for (int m = 0; m < 4; ++m) { bf16_t* rowp = O + (size_t)(row0 + ai * HALF + m * 16) * ldc + col0;
#pragma unroll
                for (int bj = 0; bj < 2; ++bj) { if (col0 + bj * HALF < N) { const f32x4 v0 = acc[ai][bj][m][0], v1 = acc[ai][bj][m][1];
                    u32x4 w; w.x = cvt_pk_bf16(v0[0], v0[1]); w.y = cvt_pk_bf16(v0[2], v0[3]); w.z = cvt_pk_bf16(v1[0], v1[1]); w.w = cvt_pk_bf16(v1[2], v1[3]);
                    *(u32x4*)(rowp + bj * HALF) = w; } } }
    }
};
struct EpiDyn {
    static constexpr bool PERM = true, AFTER_DRAIN = false;
    int mode; bf16_t* O; int ldc; int N; const float* resid; float* out; const float* ssq_in; bf16_t* xb; float* ssq_out;
    __device__ __forceinline__ void operator()(const f32x4 (&acc)[2][2][4][2], const Unit& u, int wr, int wc, int fr, int fq) const {
        const int row0 = u.pm * BM + wr * 64 + fr, col0 = u.pn * BM + wc * 32 + 8 * fq;
        if (mode == 0) {
#pragma unroll
            for (int ai = 0; ai < 2; ++ai)
#pragma unroll
                for (int m = 0; m < 4; ++m) { const int row = row0 + ai * HALF + m * 16; bf16_t* rowp = O + (size_t)row * ldc + col0;
                    const float sc = __builtin_amdgcn_rsqf(ssq_in[row] * (1.0f / 1024.0f) + 1e-6f);
#pragma unroll
                    for (int bj = 0; bj < 2; ++bj) { if (col0 + bj * HALF < N) { const f32x4 v0 = acc[ai][bj][m][0] * sc, v1 = acc[ai][bj][m][1] * sc;
                        u32x4 w; w.x = cvt_pk_bf16(v0[0], v0[1]); w.y = cvt_pk_bf16(v0[2], v0[3]); w.z = cvt_pk_bf16(v1[0], v1[1]); w.w = cvt_pk_bf16(v1[2], v1[3]);
                        *(u32x4*)(rowp + bj * HALF) = w; } } }
        } else {
            const int lane_ = fq * 16 + fr;
#pragma unroll
            for (int ai = 0; ai < 2; ++ai)
#pragma unroll
                for (int m = 0; m < 4; ++m) { const int row = row0 + ai * HALF + m * 16; const size_t off = (size_t)row * ldc + col0; float s = 0.f;
#pragma unroll
                    for (int bj = 0; bj < 2; ++bj) { const u32x4 rv = *(const u32x4*)(xb + off + bj * HALF);
                        const f32x4 r0 = {__uint_as_float(rv.x << 16), __uint_as_float(rv.x & 0xffff0000u), __uint_as_float(rv.y << 16), __uint_as_float(rv.y & 0xffff0000u)};
                        const f32x4 r1 = {__uint_as_float(rv.z << 16), __uint_as_float(rv.z & 0xffff0000u), __uint_as_float(rv.w << 16), __uint_as_float(rv.w & 0xffff0000u)};
                        const f32x4 x0 = r0 + acc[ai][bj][m][0], x1 = r1 + acc[ai][bj][m][1];
                        u32x4 w; w.x = cvt_pk_bf16(x0[0], x0[1]); w.y = cvt_pk_bf16(x0[2], x0[3]); w.z = cvt_pk_bf16(x1[0], x1[1]); w.w = cvt_pk_bf16(x1[2], x1[3]);
                        *(u32x4*)(xb + off + bj * HALF) = w;
                        s += (x0[0] * x0[0] + x0[1] * x0[1]) + (x0[2] * x0[2] + x0[3] * x0[3]) + (x1[0] * x1[0] + x1[1] * x1[1]) + (x1[2] * x1[2] + x1[3] * x1[3]); }
                    s += bperm(s, lane_ ^ 16); s += bperm(s, lane_ ^ 32);
                    if (fq == 0) __hip_atomic_fetch_add(ssq_out + row, s, __ATOMIC_RELAXED, __HIP_MEMORY_SCOPE_AGENT); }
        }
    }
};
struct EpiResid {
    static constexpr bool PERM = true, AFTER_DRAIN = false;
    const float* resid; float* out; int ldc;
    __device__ __forceinline__ void operator()(const f32x4 (&acc)[2][2][4][2], const Unit& u, int wr, int wc, int fr, int fq) const {
        const int row0 = u.pm * BM + wr * 64 + fr, col0 = u.pn * BM + wc * 32 + 8 * fq;
#pragma unroll
        for (int ai = 0; ai < 2; ++ai)
#pragma unroll
            for (int m = 0; m < 4; ++m) { const size_t off = (size_t)(row0 + ai * HALF + m * 16) * ldc + col0;
#pragma unroll
                for (int bj = 0; bj < 2; ++bj) { const f32x4 r0 = *(const f32x4*)(resid + off + bj * HALF), r1 = *(const f32x4*)(resid + off + bj * HALF + 4);
                    *(f32x4*)(out + off + bj * HALF) = r0 + acc[ai][bj][m][0]; *(f32x4*)(out + off + bj * HALF + 4) = r1 + acc[ai][bj][m][1]; } }
    }
};

static_assert(true, "pg8 body adapted: SP2 path only is valid with lda/segment offsets");
template <class Epi, class Sched, bool ALIGN_EPI = false, bool SP2 = false>
__device__ __forceinline__ void gemm_phase(PG8_LAS unsigned char* lds, const Gemm g, const Sched& S, const Epi& E, int wv_) {
    const int tid = opaque_tid(wv_), wid = __builtin_amdgcn_readfirstlane(tid >> 6), lane = tid & 63, wr = wid >> 2, wc = wid & 3, fr = lane & 15, fq = lane >> 4;
    const int K = g.K, nt = K / BK;
    unsigned voffA, voffB;
    { int R, C; stage_rc(tid * 16, R, C); const int Rb = Epi::PERM ? ((R & ~31) + perm32(R & 31)) : R;
      voffA = (unsigned)(R * g.lda + C) * 2u; voffB = (unsigned)(Rb * K + C) * 2u; }
    const size_t rstepA = (size_t)64 * g.lda * 2, rstepB = (size_t)64 * K * 2;
    const size_t kstep = (size_t)(BK * 2);
    const size_t hstep = (size_t)HALF * K * 2; const size_t hstepA = (size_t)HALF * g.lda * 2, tstepA = 2 * hstepA;
#define PG8_KA(t_) ((size_t)((((t_) >> 2) == 0 ? g.ao0 : ((t_) >> 2) == 1 ? g.ao1 : ((t_) >> 2) == 2 ? g.ao2 : g.ao3) + ((t_) & 3) * 64) * 2)
    const size_t tstep = 2 * hstep;
    const unsigned ldsw = (unsigned)wid * 1024u;
    int aoff, boff;
#define PG8_SA(b, h) (((b) * 2 + (h)) * HTB)
#define PG8_SB(b, h) ((4 + (b) * 2 + (h)) * HTB)
#define PG8_STAGE(bufoff, gbase, voff) do { _Pragma("unroll") for (int _i = 0; _i < 2; ++_i) \
        __builtin_amdgcn_global_load_lds((const unsigned*)((const char*)(gbase) + (size_t)_i * r##voff + (voff)), (PG8_LAS unsigned*)(lds + (bufoff) + ldsw + _i * 8192), 16, 0, 0); } while (0)
#define rvoffA rstepA
#define rvoffB rstepB
#define PG8_LDA(dst, b, h) do { _Pragma("unroll") for (int m = 0; m < 4; ++m) _Pragma("unroll") for (int k = 0; k < 2; ++k) dst[m][k] = *(const PG8_LAS bf16x8*)(lds + (PG8_SA(b, h) + wr * 8192) + aoff + m * 2048 + k * 1024); } while (0)
#define PG8_LDB(dst, b, h) do { _Pragma("unroll") for (int n = 0; n < 2; ++n) _Pragma("unroll") for (int k = 0; k < 2; ++k) dst[n][k] = *(const PG8_LAS bf16x8*)(lds + (PG8_SB(b, h) + wc * 4096) + boff + n * 2048 + k * 1024); } while (0)
#define PG8_MMA(ai, bj, At, Bt) do { __builtin_amdgcn_s_setprio(1); _Pragma("unroll") for (int m = 0; m < 4; ++m) _Pragma("unroll") for (int n = 0; n < 2; ++n) _Pragma("unroll") for (int k = 0; k < 2; ++k) \
        acc[ai][bj][m][n] = __builtin_amdgcn_mfma_f32_16x16x32_bf16(Bt[n][k], At[m][k], acc[ai][bj][m][n], 0, 0, 0); __builtin_amdgcn_s_setprio(0); } while (0)
#define PG8_WAIT_V(n) asm volatile("s_waitcnt vmcnt(" #n ")" ::: "memory")
#define PG8_WAIT_L(n) asm volatile("s_waitcnt lgkmcnt(" #n ")" ::: "memory")
#define PG8_BAR __builtin_amdgcn_s_barrier()
#define PG8_SCHED __builtin_amdgcn_sched_barrier(0)
    Unit cur, nxt; int ui = 0;
    if (!S.next(0, cur)) return;
    f32x4 acc[2][2][4][2];
#pragma unroll
    for (int a = 0; a < 2; ++a)
#pragma unroll
        for (int b = 0; b < 2; ++b)
#pragma unroll
            for (int m = 0; m < 4; ++m)
#pragma unroll
                for (int n = 0; n < 2; ++n) acc[a][b][m][n] = (f32x4){0.f, 0.f, 0.f, 0.f};
    bf16x8 At[4][2], B0[2][2], B1[2][2];
    const char* cA = (const char*)g.A + (size_t)cur.pm * tstepA; const char* cB = (const char*)g.Bt + (size_t)cur.pn * tstep;
    S.a_ready(cur);
    if constexpr (SP2) {
        PG8_STAGE(PG8_SB(0, 0), cB, voffB); PG8_STAGE(PG8_SB(0, 1), cB + hstep, voffB); PG8_STAGE(PG8_SA(0, 0), cA + PG8_KA(0), voffA); PG8_STAGE(PG8_SA(0, 1), cA + hstepA + PG8_KA(0), voffA);
        if (wr == 1) PG8_BAR;
        PG8_WAIT_V(2); PG8_BAR;
        PG8_STAGE(PG8_SB(1, 0), cB + kstep, voffB); PG8_STAGE(PG8_SA(1, 0), cA + PG8_KA(1), voffA); PG8_STAGE(PG8_SB(1, 1), cB + hstep + kstep, voffB);
        PG8_WAIT_V(6); PG8_BAR;
    } else {
        PG8_STAGE(PG8_SB(0, 0), cB, voffB); PG8_STAGE(PG8_SA(0, 0), cA, voffA); PG8_STAGE(PG8_SB(0, 1), cB + hstep, voffB); PG8_STAGE(PG8_SA(0, 1), cA + hstep, voffA);
        if (wr == 1) PG8_BAR;
        PG8_WAIT_V(4); PG8_BAR;
        PG8_STAGE(PG8_SB(1, 0), cB + kstep, voffB); PG8_STAGE(PG8_SA(1, 0), cA + kstep, voffA); PG8_STAGE(PG8_SB(1, 1), cB + hstep + kstep, voffB);
        PG8_WAIT_V(6); PG8_BAR;
    }
    { const int t3_ = opaque_tid(wv_), l3_ = t3_ & 63, w3_ = __builtin_amdgcn_readfirstlane(t3_ >> 6); aoff = lds_byte((l3_ & 15), (l3_ >> 4) * 8); boff = aoff; }
    for (;;) {
        const bool has_next = S.next(ui + 1, nxt);
        const char* nA = has_next ? (const char*)g.A + (size_t)nxt.pm * tstepA : cA; const char* nB = has_next ? (const char*)g.Bt + (size_t)nxt.pn * tstep : cB;
        for (int t = 0; t < nt; t += 2) {
            const bool last = (t == nt - 2);
            const char* a1 = cA + PG8_KA(t + 1);
            const char* a2 = last ? nA + PG8_KA(0) : cA + PG8_KA(t + 2); const char* b2 = last ? nB : cB + (size_t)(t + 2) * kstep;
            const char* a3 = last ? nA + PG8_KA(1) : cA + PG8_KA(t + 3); const char* b3 = b2 + kstep;
            if (last && has_next) S.a_ready(nxt);
            if constexpr (SP2) {
            PG8_LDB(B0, 0, 0); PG8_LDB(B1, 0, 1); PG8_SCHED; PG8_LDA(At, 0, 0); PG8_STAGE(PG8_SA(1, 1), a1 + hstepA, voffA);
            PG8_WAIT_V(8); PG8_WAIT_L(0); PG8_BAR; PG8_MMA(0, 0, At, B0); PG8_MMA(0, 1, At, B1); PG8_BAR; PG8_SCHED;
            PG8_LDA(At, 0, 1); PG8_STAGE(PG8_SB(0, 0), b2, voffB); PG8_STAGE(PG8_SB(0, 1), b2 + hstep, voffB); PG8_STAGE(PG8_SA(0, 0), a2, voffA);
            PG8_WAIT_V(8); PG8_WAIT_L(0); PG8_BAR; PG8_MMA(1, 0, At, B0); PG8_MMA(1, 1, At, B1); PG8_BAR; PG8_SCHED;
            PG8_LDB(B0, 1, 0); PG8_LDB(B1, 1, 1); PG8_SCHED; PG8_LDA(At, 1, 0); PG8_STAGE(PG8_SA(0, 1), a2 + hstepA, voffA);
            PG8_WAIT_V(8); PG8_WAIT_L(0); PG8_BAR; PG8_MMA(0, 0, At, B0); PG8_MMA(0, 1, At, B1); PG8_BAR; PG8_SCHED;
            PG8_LDA(At, 1, 1); PG8_STAGE(PG8_SB(1, 0), b3, voffB); PG8_STAGE(PG8_SB(1, 1), b3 + hstep, voffB); PG8_STAGE(PG8_SA(1, 0), a3, voffA);
            PG8_WAIT_V(8); PG8_WAIT_L(0); PG8_BAR; PG8_MMA(1, 0, At, B0); PG8_MMA(1, 1, At, B1); PG8_BAR; PG8_SCHED;
            } else {
            PG8_LDB(B0, 0, 0); PG8_SCHED; PG8_LDA(At, 0, 0); PG8_STAGE(PG8_SA(1, 1), a1 + hstep, voffA);
            PG8_WAIT_L(8); PG8_BAR; PG8_WAIT_L(0); PG8_MMA(0, 0, At, B0); PG8_BAR; PG8_SCHED;
            PG8_LDB(B1, 0, 1); PG8_STAGE(PG8_SB(0, 0), b2, voffB);
            PG8_BAR; PG8_WAIT_L(0); PG8_MMA(0, 1, At, B1); PG8_BAR;
            PG8_LDA(At, 0, 1); PG8_STAGE(PG8_SA(0, 0), a2, voffA);
            PG8_BAR; PG8_WAIT_L(0); PG8_MMA(1, 0, At, B0); PG8_BAR; PG8_SCHED;
            PG8_STAGE(PG8_SB(0, 1), b2 + hstep, voffB);
            PG8_WAIT_V(6); PG8_BAR; PG8_MMA(1, 1, At, B1); PG8_BAR;
            PG8_LDB(B0, 1, 0); PG8_SCHED; PG8_LDA(At, 1, 0); PG8_STAGE(PG8_SA(0, 1), a2 + hstep, voffA);
            PG8_WAIT_L(8); PG8_BAR; PG8_WAIT_L(0); PG8_MMA(0, 0, At, B0); PG8_BAR; PG8_SCHED;
            PG8_LDB(B1, 1, 1); PG8_STAGE(PG8_SB(1, 0), b3, voffB);
            PG8_BAR; PG8_WAIT_L(0); PG8_MMA(0, 1, At, B1); PG8_BAR;
            PG8_LDA(At, 1, 1); PG8_STAGE(PG8_SA(1, 0), a3, voffA);
            PG8_BAR; PG8_WAIT_L(0); PG8_MMA(1, 0, At, B0); PG8_BAR; PG8_SCHED;
            PG8_STAGE(PG8_SB(1, 1), b3 + hstep, voffB);
            PG8_WAIT_V(6); PG8_BAR; PG8_MMA(1, 1, At, B1); PG8_BAR;
            }
        }
        if constexpr (ALIGN_EPI) { if (wr == 0) PG8_BAR; }
        if constexpr (!Epi::AFTER_DRAIN) { const int t2_ = opaque_tid(wv_), l2_ = t2_ & 63, w2_ = __builtin_amdgcn_readfirstlane(t2_ >> 6); E(acc, cur, w2_ >> 2, w2_ & 3, l2_ & 15, l2_ >> 4); S.done(cur); }
        if (!has_next) break;
#pragma unroll
        for (int a = 0; a < 2; ++a)
#pragma unroll
            for (int b = 0; b < 2; ++b)
#pragma unroll
                for (int m = 0; m < 4; ++m)
#pragma unroll
                    for (int n = 0; n < 2; ++n) acc[a][b][m][n] = (f32x4){0.f, 0.f, 0.f, 0.f};
        cur = nxt; cA = nA; cB = nB; ++ui;
        if constexpr (ALIGN_EPI) { if (wr == 1) PG8_BAR; }
    }
    PG8_WAIT_V(0);
    if constexpr (!ALIGN_EPI) { if (wr == 0) PG8_BAR; }
    PG8_BAR;
    if constexpr (Epi::AFTER_DRAIN) { E.fused(acc, cur, wr, wc, fr, fq, lds, wid, lane); S.done(cur); }
#undef PG8_SA
#undef PG8_SB
#undef PG8_STAGE
#undef rvoffA
#undef rvoffB
#undef PG8_LDA
#undef PG8_LDB
#undef PG8_MMA
#undef PG8_WAIT_V
#undef PG8_WAIT_L
#undef PG8_BAR
#undef PG8_SCHED
#undef PG8_KA
}
}

__device__ __forceinline__ void wt_tile(const float* __restrict__ W, int N, bf16_t* __restrict__ Wt, int kt, int nt, unsigned char* lds, int wv_, const float* gk = nullptr) {
#ifdef OFF_wt_tile
  return;
#endif

  float* tl = (float*)lds;
  const int tid = opaque_tid(wv_);
  const int r = tid >> 3, c8 = (tid & 7) * 8;
  const float* src = W + (size_t)(kt * 64 + r) * N + nt * 64 + c8;
  float4 v0 = *(const float4*)src, v1 = *(const float4*)(src + 4);
  if (gk) { const float g_ = gk[kt * 64 + r]; v0.x *= g_; v0.y *= g_; v0.z *= g_; v0.w *= g_; v1.x *= g_; v1.y *= g_; v1.z *= g_; v1.w *= g_; }
  float* d = tl + r * 65 + c8;
  d[0] = v0.x; d[1] = v0.y; d[2] = v0.z; d[3] = v0.w; d[4] = v1.x; d[5] = v1.y; d[6] = v1.z; d[7] = v1.w;
  __syncthreads();
  uint4 o;
  o.x = pack2(tl[(c8 + 0) * 65 + r], tl[(c8 + 1) * 65 + r]);
  o.y = pack2(tl[(c8 + 2) * 65 + r], tl[(c8 + 3) * 65 + r]);
  o.z = pack2(tl[(c8 + 4) * 65 + r], tl[(c8 + 5) * 65 + r]);
  o.w = pack2(tl[(c8 + 6) * 65 + r], tl[(c8 + 7) * 65 + r]);
  *(uint4*)(Wt + (size_t)(nt * 64 + r) * 1024 + kt * 64 + c8) = o;
  __syncthreads();
}

__device__ __forceinline__ void norm_rows(const bool F32OUT, const float* src, const float* __restrict__ g, void* dst, int nrows, float pd, int wv_, float* ssq_out = nullptr) {
#ifdef OFF_norm_rows
  return;
#endif

  const int tid = opaque_tid(wv_);
  const int lane = tid & 63;
  const int gw = blockIdx.x * 8 + (tid >> 6), nw = gridDim.x * 8;
  float4 gv[4];
#pragma unroll
  for (int i = 0; i < 4; ++i) gv[i] = ssq_out ? make_float4(1.f, 1.f, 1.f, 1.f) : *(const float4*)(g + i * 256 + lane * 4);
  for (int row = gw; row < nrows; row += nw) {
    const float* s = src + (size_t)row * 1024;
    float4 v[4]; float ss = 0.f;
#pragma unroll
    for (int i = 0; i < 4; ++i) { v[i] = *(const float4*)(s + i * 256 + lane * 4); ss += v[i].x * v[i].x + v[i].y * v[i].y + v[i].z * v[i].z + v[i].w * v[i].w; }
    ss = wave_sum(ss, lane);
    if (ssq_out) { if (lane == 0) ssq_out[row] = ss; }
    const float rs = ssq_out ? 1.0f : rsqrtf(ss * (1.0f / 1024.0f) + 1e-6f);
#pragma unroll
    for (int i = 0; i < 4; ++i) {
      const float a = v[i].x * rs * gv[i].x, b = v[i].y * rs * gv[i].y, c = v[i].z * rs * gv[i].z, d = v[i].w * rs * gv[i].w;
      if (F32OUT) { *(float4*)((float*)dst + (size_t)row * 1024 + i * 256 + lane * 4) = make_float4(a + pd, b + pd, c + pd, d + pd); }
      else { uint2 o; o.x = pack2(a, b); o.y = pack2(c, d); *(uint2*)((bf16_t*)dst + (size_t)row * 1024 + i * 256 + lane * 4) = o; }
    }
  }
}

__device__ __forceinline__ void rwkv_prep_item(KP P, int l, int item, unsigned char* lds, int wv_) {
#ifdef OFF_rwkv_prep_item
  return;
#endif

  const bf16_t* p = (const bf16_t*)(P->ws + WS_P);
  float* PW = (float*)(P->ws + WS_PW); bf16_t* PV = (bf16_t*)(P->ws + WS_PV); float* RK = (float*)(P->ws + WS_RK);
  float* lora = (float*)lds;
  const int tid = opaque_tid(wv_), lane = tid & 63, w = tid >> 6, head = w & 3, sub = w >> 2;
  const int c = head * 64 + lane;
  const float* mu = P->in[4] + l * 832;
  const float mur = mu[c], muk = mu[256 + c], muv = mu[512 + c], mux = mu[768 + lane];
  const float w0 = P->in[5][l * 256 + c], a0 = P->in[7][l * 256 + c];
  const float kkw = P->in[9][l * 256 + c], kaw = P->in[10][l * 256 + c], rkw = P->in[11][l * 256 + c];
  float wup[32], aup[32];
#pragma unroll
  for (int j = 0; j < 32; ++j) { wup[j] = P->in[6][(l * 32 + j) * 256 + c]; aup[j] = P->in[8][(l * 32 + j) * 256 + c]; }
  bf16_t raw[4][8];
#define PREP_LOAD(g) { _Pragma("unroll") for (int j_ = 0; j_ < 4; ++j_) { const int t_ = item * 16 + sub + 2 * ((g) * 4 + j_); const bool hp_ = (t_ & (TSEQ - 1)) > 0; \
      const bf16_t* pr_ = p + (size_t)t_ * NIN; raw[j_][0] = pr_[c]; raw[j_][1] = pr_[256 + c]; raw[j_][2] = pr_[512 + c]; raw[j_][3] = pr_[768 + lane]; \
      raw[j_][4] = hp_ ? pr_[c - NIN] : (bf16_t)0; raw[j_][5] = hp_ ? pr_[256 + c - NIN] : (bf16_t)0; raw[j_][6] = hp_ ? pr_[512 + c - NIN] : (bf16_t)0; raw[j_][7] = hp_ ? pr_[768 + lane - NIN] : (bf16_t)0; } }
  PREP_LOAD(0);
  int ng_ = 2; asm volatile("" : "+s"(ng_));
#pragma unroll 1
  for (int g = 0; g < ng_; ++g) {
    float rr[4], kk4[4], vv4[4];
#pragma unroll
    for (int j = 0; j < 4; ++j) {
      float r = bf2f(raw[j][0]), k = bf2f(raw[j][1]), v = bf2f(raw[j][2]), x = bf2f(raw[j][3]);
      r += (bf2f(raw[j][4]) - r) * mur; k += (bf2f(raw[j][5]) - k) * muk; v += (bf2f(raw[j][6]) - v) * muv; x += (bf2f(raw[j][7]) - x) * mux;
      rr[j] = r; kk4[j] = k; vv4[j] = v;
      lora[(w * 4 + j) * 64 + lane] = lane < 32 ? (1.0f - 2.0f * __builtin_amdgcn_rcpf(1.0f + __expf(2.0f * x))) : x;
    }
    if (g + 1 < ng_) PREP_LOAD(g + 1);
    __builtin_amdgcn_s_waitcnt(0xc07f);
    __builtin_amdgcn_wave_barrier();
    float wv4[4], av4[4];
#pragma unroll
    for (int j = 0; j < 4; ++j) { wv4[j] = w0; av4[j] = a0; }
#pragma unroll
    for (int jj = 0; jj < 32; jj += 4) {
#pragma unroll
      for (int j = 0; j < 4; ++j) { const float* lo = lora + (w * 4 + j) * 64; const float4 lw = *(const float4*)(lo + jj), la = *(const float4*)(lo + 32 + jj);
        wv4[j] += lw.x * wup[jj]; wv4[j] += lw.y * wup[jj + 1]; wv4[j] += lw.z * wup[jj + 2]; wv4[j] += lw.w * wup[jj + 3];
        av4[j] += la.x * aup[jj]; av4[j] += la.y * aup[jj + 1]; av4[j] += la.z * aup[jj + 2]; av4[j] += la.w * aup[jj + 3]; }
    }
    float dec4[4], ar4[4], kkq[4], kmod4[4], n24[4], rk4[4];
#pragma unroll
    for (int j = 0; j < 4; ++j) {
      const float wlog = -softplus_fast(-wv4[j]) - 0.5f;
      dec4[j] = __expf(-__expf(wlog));
      ar4[j] = sigmoidf_(av4[j]);
      kkq[j] = kk4[j] * kkw;
      kmod4[j] = kk4[j] * (1.0f + (ar4[j] - 1.0f) * kaw);
      n24[j] = kkq[j] * kkq[j]; rk4[j] = rr[j] * kmod4[j] * rkw;
    }
#pragma unroll
    for (int st = 0; st < 4; ++st) {
      const int ctrl = st == 0 ? 0xB1 : st == 1 ? 0x4E : st == 2 ? 0x141 : 0x140;
#pragma unroll
      for (int j = 0; j < 4; ++j) {
        if (st == 0) { n24[j] += __builtin_bit_cast(float, __builtin_amdgcn_update_dpp(0, __builtin_bit_cast(int, n24[j]), 0xB1, 0xF, 0xF, true)); rk4[j] += __builtin_bit_cast(float, __builtin_amdgcn_update_dpp(0, __builtin_bit_cast(int, rk4[j]), 0xB1, 0xF, 0xF, true)); }
        else if (st == 1) { n24[j] += __builtin_bit_cast(float, __builtin_amdgcn_update_dpp(0, __builtin_bit_cast(int, n24[j]), 0x4E, 0xF, 0xF, true)); rk4[j] += __builtin_bit_cast(float, __builtin_amdgcn_update_dpp(0, __builtin_bit_cast(int, rk4[j]), 0x4E, 0xF, 0xF, true)); }
        else if (st == 2) { n24[j] += __builtin_bit_cast(float, __builtin_amdgcn_update_dpp(0, __builtin_bit_cast(int, n24[j]), 0x141, 0xF, 0xF, true)); rk4[j] += __builtin_bit_cast(float, __builtin_amdgcn_update_dpp(0, __builtin_bit_cast(int, rk4[j]), 0x141, 0xF, 0xF, true)); }
        else { n24[j] += __builtin_bit_cast(float, __builtin_amdgcn_update_dpp(0, __builtin_bit_cast(int, n24[j]), 0x140, 0xF, 0xF, true)); rk4[j] += __builtin_bit_cast(float, __builtin_amdgcn_update_dpp(0, __builtin_bit_cast(int, rk4[j]), 0x140, 0xF, 0xF, true)); }
      }
      (void)ctrl;
    }
    { float t0[4], t1[4];
#pragma unroll
      for (int j = 0; j < 4; ++j) { t0[j] = bperm(n24[j], lane ^ 16); t1[j] = bperm(rk4[j], lane ^ 16); }
#pragma unroll
      for (int j = 0; j < 4; ++j) { n24[j] += t0[j]; rk4[j] += t1[j]; }
#pragma unroll
      for (int j = 0; j < 4; ++j) { t0[j] = bperm(n24[j], lane ^ 32); t1[j] = bperm(rk4[j], lane ^ 32); }
#pragma unroll
      for (int j = 0; j < 4; ++j) { n24[j] += t0[j]; rk4[j] += t1[j]; } }
#pragma unroll
    for (int j = 0; j < 4; ++j) {
      const int t = item * 16 + sub + 2 * (g * 4 + j);
      const int tt = t & (TSEQ - 1), b = t >> 13;
      const float kkn = kkq[j] * __builtin_amdgcn_rsqf(fmaxf(n24[j], 1e-24f));
      const size_t idx = (size_t)(b * 4 + head) * TSEQ + tt;
      PW[idx * 64 + lane] = dec4[j];
      bf16_t* pv = PV + idx * 320;
      pv[lane] = f2bf(rr[j]); pv[64 + lane] = f2bf(kmod4[j]); pv[128 + lane] = f2bf(vv4[j]); pv[192 + lane] = f2bf(-kkn); pv[256 + lane] = f2bf(kkn * ar4[j]);
      if (lane == 0) RK[idx] = rk4[j];
    }
    __builtin_amdgcn_s_waitcnt(0xc07f);
    __builtin_amdgcn_wave_barrier();
  }
#undef PREP_LOAD
  __syncthreads();
}

#define RW_TILE_B (RW_TT * 1536)
struct RwRegs { float4 pw; uint4 pv0, pv1; };
__device__ __forceinline__ void rw_issue(const float* __restrict__ PW, const bf16_t* __restrict__ PV, size_t idx0, int tid, RwRegs& r) {
  if (tid < RW_TT * 16) { const int s = tid >> 4, q = tid & 15; r.pw = *(const float4*)(PW + (idx0 + s) * 64 + q * 4); }
  { const int c = tid; const int s = c / 40, q = c % 40; r.pv0 = *(const uint4*)(PV + (idx0 + s) * 320 + q * 8); }
  if (tid < RW_TT * 40 - NTHR) { const int c = tid + NTHR; const int s = c / 40, q = c % 40; r.pv1 = *(const uint4*)(PV + (idx0 + s) * 320 + q * 8); }
}
__device__ __forceinline__ void rw_put(float* dst, int c, const uint4 u) {
  const int s = c / 40, q = c % 40;
  const int vec = q >> 3, off = (q & 7) * 8;
  const int slot = vec == 0 ? 4 : vec == 1 ? 3 : vec == 2 ? 5 : vec == 3 ? 1 : 2;
  float* d = dst + s * 384 + slot * 64 + off;
  *(float4*)d = make_float4(__uint_as_float(u.x << 16), __uint_as_float(u.x & 0xffff0000u), __uint_as_float(u.y << 16), __uint_as_float(u.y & 0xffff0000u));
  *(float4*)(d + 4) = make_float4(__uint_as_float(u.z << 16), __uint_as_float(u.z & 0xffff0000u), __uint_as_float(u.w << 16), __uint_as_float(u.w & 0xffff0000u));
}
__device__ __forceinline__ void rw_commit(unsigned char* dstb, int tid, const RwRegs& r) {
  float* dst = (float*)dstb;
  if (tid < RW_TT * 16) { const int s = tid >> 4, q = tid & 15; *(float4*)(dst + s * 384 + q * 4) = r.pw; }
  rw_put(dst, tid, r.pv0);
  if (tid < RW_TT * 40 - NTHR) rw_put(dst, tid + NTHR, r.pv1);
}

#define LD8(dst, ptr) { const float4 x0_ = *(const float4*)(ptr), x1_ = *(const float4*)((ptr) + 4); dst[0] = (f32x2){x0_.x, x0_.y}; dst[1] = (f32x2){x0_.z, x0_.w}; dst[2] = (f32x2){x1_.x, x1_.y}; dst[3] = (f32x2){x1_.z, x1_.w}; }
struct RwOps { f32x2 w[4], a[4], b[4], k[4], r[4]; float vA, vB; };
template <int MODE>
__device__ __forceinline__ void rw_ldops(RwOps& o, const float* tb, int s, int q, int rowA, int rowB) {
  const float* sp = tb + s * 384 + q * 8;
  LD8(o.w, sp); LD8(o.a, sp + 64); LD8(o.b, sp + 128); LD8(o.k, sp + 192);
  o.vA = tb[s * 384 + 320 + rowA];
  if (MODE == 0) { LD8(o.r, sp + 256); o.vB = tb[s * 384 + 320 + rowB]; }
}
template <int MODE>
__device__ __forceinline__ void rw_step(const RwOps& o, f32x2 (&SA)[4], f32x2 (&SB)[4], float* yb, int s, int q, int rowA, int rowB) {
  f32x2 dA = SA[0] * o.a[0], dB = SB[0] * o.a[0];
#pragma unroll
  for (int e = 1; e < 4; ++e) { dA = SA[e] * o.a[e] + dA; dB = SB[e] * o.a[e] + dB; }
  const float dotA = red8(dA.x + dA.y), dotB = red8(dB.x + dB.y);
  const f32x2 dA2 = {dotA, dotA}, dB2 = {dotB, dotB}, vA2 = {o.vA, o.vA};
  if (MODE == 0) {
    const f32x2 vB2 = {o.vB, o.vB};
#pragma unroll
    for (int e = 0; e < 4; ++e) { SA[e] = SA[e] * o.w[e] + vA2 * o.k[e]; SA[e] = dA2 * o.b[e] + SA[e]; SB[e] = SB[e] * o.w[e] + vB2 * o.k[e]; SB[e] = dB2 * o.b[e] + SB[e]; }
    f32x2 yA = SA[0] * o.r[0], yB = SB[0] * o.r[0];
#pragma unroll
    for (int e = 1; e < 4; ++e) { yA = SA[e] * o.r[e] + yA; yB = SB[e] * o.r[e] + yB; }
    const float ya = red8(yA.x + yA.y), ybv = red8(yB.x + yB.y);
    if (q == 0) { yb[s * 64 + rowA] = ya; yb[s * 64 + rowB] = ybv; }
  } else {
#pragma unroll
    for (int e = 0; e < 4; ++e) { SA[e] = dA2 * o.b[e] + SA[e] * o.w[e]; SB[e] = SB[e] * o.w[e] + vA2 * o.k[e]; SB[e] = dB2 * o.b[e] + SB[e]; }
  }
}
template <int MODE>
__device__ __forceinline__ void rwkv_scan_item(KP P, int l, int bh, int chunk, unsigned char* lds, int wv_) {
  const float* PW = (const float*)(P->ws + WS_PW); const bf16_t* PV = (const bf16_t*)(P->ws + WS_PV); const float* RK = (const float*)(P->ws + WS_RK);
  float* PQ = (float*)(P->ws + WS_PQ);
  bf16_t* p = (bf16_t*)(P->ws + WS_P);
  const int tid = opaque_tid(wv_), lane = tid & 63, w = tid >> 6;
  const int q = lane & 7;
  const int rowA = (MODE == 0) ? ((w & 3) * 16 + (lane >> 3)) : (w * 8 + (lane >> 3));
  const int rowB = rowA + 8;
  const int b = bh >> 2, head = bh & 3;
  unsigned char* tile0 = lds;
  float* ybuf = (float*)(lds + 3 * RW_TILE_B);
  float* Sl = (float*)(lds + 3 * RW_TILE_B + 2 * RW_TT * 256);
  f32x2 SA[4], SB[4];
#pragma unroll
  for (int e = 0; e < 4; ++e) { SA[e] = (f32x2){0.f, 0.f}; SB[e] = (f32x2){0.f, 0.f}; }
  if (MODE == 1) {
#pragma unroll
    for (int e = 0; e < 4; ++e) SA[e] = (f32x2){(q * 8 + 2 * e == rowA) ? 1.f : 0.f, (q * 8 + 2 * e + 1 == rowA) ? 1.f : 0.f};
  }
  if (MODE == 0 && chunk > 0) {
    const float* Q0 = PQ + ((size_t)(bh * RW_C + 0) * 2 + 1) * 4096;
    float* cur = Sl; float* nxt = Sl + 64 * 65;
    for (int i = tid; i < 1024; i += NTHR) { const float4 v_ = *(const float4*)(Q0 + i * 4); float* d_ = cur + (i >> 4) * 65 + (i & 15) * 4; d_[0] = v_.x; d_[1] = v_.y; d_[2] = v_.z; d_[3] = v_.w; }
    float* Pl = (float*)lds;
    const float4 z4_ = make_float4(0.f, 0.f, 0.f, 0.f); const f32x4 zq_ = {0.f, 0.f, 0.f, 0.f};
    float4 cs0p0 = z4_, cs0p1 = z4_, cs1p0 = z4_, cs1p1 = z4_, cs2p0 = z4_, cs2p1 = z4_, cs3p0 = z4_, cs3p1 = z4_;
    f32x4 cs0q0 = zq_, cs0q1 = zq_, cs1q0 = zq_, cs1q1 = zq_, cs2q0 = zq_, cs2q1 = zq_, cs3q0 = zq_, cs3q1 = zq_;
    const int ti = w >> 1;
    const int qoff0 = 4096 + (ti * 16 + (lane >> 4) * 4) * 64 + ((w & 1) * 2 + 0) * 16 + (lane & 15);
#define CS_LOAD(S_, c_) { const float* Pm_ = PQ + ((size_t)(bh * RW_C + (c_)) * 2 + 0) * 4096; S_##p0 = *(const float4*)(Pm_ + tid * 4); S_##p1 = *(const float4*)(Pm_ + (tid + NTHR) * 4); \
      S_##q0 = (f32x4){Pm_[qoff0], Pm_[qoff0 + 64], Pm_[qoff0 + 128], Pm_[qoff0 + 192]}; S_##q1 = (f32x4){Pm_[qoff0 + 16], Pm_[qoff0 + 80], Pm_[qoff0 + 144], Pm_[qoff0 + 208]}; }
#define CS_STEP(S_, c_) { LBAR(); *(float4*)(Pl + (tid >> 4) * 80 + (tid & 15) * 4) = S_##p0; *(float4*)(Pl + ((tid + NTHR) >> 4) * 80 + (tid & 15) * 4) = S_##p1; const f32x4 qc0 = S_##q0, qc1 = S_##q1; \
      if ((c_) + 4 < chunk) CS_LOAD(S_, (c_) + 4); \
      LBAR(); \
      _Pragma("unroll") for (int jj = 0; jj < 2; ++jj) { const int tj = (w & 1) * 2 + jj; f32x4 acc = jj == 0 ? qc0 : qc1; \
        _Pragma("unroll") for (int ks = 0; ks < 16; ++ks) { const float a = cur[(ti * 16 + (lane & 15)) * 65 + ks * 4 + (lane >> 4)]; const float bb = Pl[(ks * 4 + (lane >> 4)) * 80 + tj * 16 + (lane & 15)]; \
          acc = __builtin_amdgcn_mfma_f32_16x16x4f32(a, bb, acc, 0, 0, 0); } \
        _Pragma("unroll") for (int r = 0; r < 4; ++r) nxt[(ti * 16 + (lane >> 4) * 4 + r) * 65 + tj * 16 + (lane & 15)] = acc[r]; } \
      float* t_ = cur; cur = nxt; nxt = t_; }
    if (1 < chunk) CS_LOAD(cs0, 1);
    if (2 < chunk) CS_LOAD(cs1, 2);
    if (3 < chunk) CS_LOAD(cs2, 3);
    if (4 < chunk) CS_LOAD(cs3, 4);
#pragma unroll 1
    for (int cc = 1; cc < chunk; cc += 4) {
      CS_STEP(cs0, cc);
      if (cc + 1 < chunk) CS_STEP(cs1, cc + 1);
      if (cc + 2 < chunk) CS_STEP(cs2, cc + 2);
      if (cc + 3 < chunk) CS_STEP(cs3, cc + 3);
    }
#undef CS_LOAD
#undef CS_STEP
    __syncthreads();
#pragma unroll
    for (int e = 0; e < 4; ++e) { SA[e] = (f32x2){cur[rowA * 65 + q * 8 + 2 * e], cur[rowA * 65 + q * 8 + 2 * e + 1]}; SB[e] = (f32x2){cur[rowB * 65 + q * 8 + 2 * e], cur[rowB * 65 + q * 8 + 2 * e + 1]}; }
    __syncthreads();
  }
  const size_t idxb = (size_t)bh * TSEQ + (size_t)chunk * RW_CL;
  const int ntile = RW_CL / RW_TT;
  RwRegs rr;
  rw_issue(PW, PV, idxb, tid, rr);
  rw_commit(tile0, tid, rr);
  const int chh = head * 64 + lane;
  const float lng = P->in[12][l * 256 + chh], lnb = P->in[13][l * 256 + chh];
  __syncthreads();
  const int nit = (MODE == 0) ? ntile + 1 : ntile;
  for (int tl = 0; tl < nit; ++tl) {
    if (tl + 1 < ntile) rw_issue(PW, PV, idxb + (size_t)(tl + 1) * RW_TT, tid, rr);
    if (MODE == 1 || w < 4) {
      if (tl < ntile) {
        const float* tb = (const float*)(tile0 + (tl % 3) * RW_TILE_B);
        float* yb = ybuf + (tl & 1) * (RW_TT * 64);
        RwOps oa, ob;
        rw_ldops<MODE>(oa, tb, 0, q, rowA, rowB);
        __builtin_amdgcn_sched_barrier(0);
#pragma unroll 1
        for (int s = 0; s < RW_TT; s += 2) {
          rw_ldops<MODE>(ob, tb, s + 1, q, rowA, rowB);
          __builtin_amdgcn_sched_barrier(0);
          rw_step<MODE>(oa, SA, SB, yb, s, q, rowA, rowB);
          __builtin_amdgcn_sched_barrier(0);
          if (s + 2 < RW_TT) rw_ldops<MODE>(oa, tb, s + 2, q, rowA, rowB);
          __builtin_amdgcn_sched_barrier(0);
          rw_step<MODE>(ob, SA, SB, yb, s + 1, q, rowA, rowB);
          __builtin_amdgcn_sched_barrier(0);
        }
      }
      if (tl + 1 < ntile) rw_commit(tile0 + ((tl + 1) % 3) * RW_TILE_B, tid, rr);
    } else {
      const int fw = w - 4;
      f32x4 gcu = {0.f, 0.f, 0.f, 0.f}, rkcu = {0.f, 0.f, 0.f, 0.f};
      if (tl > 0) {
#pragma unroll
        for (int u = 0; u < 4; ++u) { const int tt = chunk * RW_CL + (tl - 1) * RW_TT + fw + 4 * u;
          gcu[u] = bf2f(p[(size_t)(b * TSEQ + tt) * NIN + C_GA + chh]); rkcu[u] = RK[(size_t)bh * TSEQ + tt]; }
      }
      asm volatile("s_waitcnt vmcnt(0)" ::: "memory");
      if (tl + 1 < ntile) rw_commit(tile0 + ((tl + 1) % 3) * RW_TILE_B, tid, rr);
      __builtin_amdgcn_sched_barrier(0);
      if (tl > 0) {
        const float* tb = (const float*)(tile0 + ((tl - 1) % 3) * RW_TILE_B);
        const float* yb = ybuf + ((tl - 1) & 1) * (RW_TT * 64);
#pragma unroll
        for (int u = 0; u < 4; ++u) {
          const int s = fw + 4 * u;
          const int tt = chunk * RW_CL + (tl - 1) * RW_TT + s;
          const float y = yb[s * 64 + lane];
          const float mean = wave_sum(y, lane) * (1.0f / 64.0f);
          const float dlt = y - mean;
          const float var = wave_sum(dlt * dlt, lane) * (1.0f / 64.0f);
          float o = dlt * rsqrtf(var + 64e-5f) * lng + lnb;
          const float vv = tb[s * 384 + 320 + lane];
          o += rkcu[u] * vv;
          p[(size_t)(b * TSEQ + tt) * NIN + C_GA + chh] = f2bf(o * siluf_(gcu[u]));
        }
      }
    }
    LBAR();
  }
  if (MODE == 1) {
    float* Pm = PQ + ((size_t)(bh * RW_C + chunk) * 2 + 0) * 4096 + rowA * 64 + q * 8;
    *(float4*)Pm = make_float4(SA[0].x, SA[0].y, SA[1].x, SA[1].y); *(float4*)(Pm + 4) = make_float4(SA[2].x, SA[2].y, SA[3].x, SA[3].y);
    *(float4*)(Pm + 4096) = make_float4(SB[0].x, SB[0].y, SB[1].x, SB[1].y); *(float4*)(Pm + 4100) = make_float4(SB[2].x, SB[2].y, SB[3].x, SB[3].y);
  } else if (chunk == 0 && w < 4) {
    float* Qm = PQ + ((size_t)(bh * RW_C + 0) * 2 + 1) * 4096 + q * 8;
    *(float4*)(Qm + rowA * 64) = make_float4(SA[0].x, SA[0].y, SA[1].x, SA[1].y); *(float4*)(Qm + rowA * 64 + 4) = make_float4(SA[2].x, SA[2].y, SA[3].x, SA[3].y);
    *(float4*)(Qm + rowB * 64) = make_float4(SB[0].x, SB[0].y, SB[1].x, SB[1].y); *(float4*)(Qm + rowB * 64 + 4) = make_float4(SB[2].x, SB[2].y, SB[3].x, SB[3].y);
  }
  __syncthreads();
}

__device__ __forceinline__ void conv_item(KP P, int l, int item, unsigned char* lds, int wv_) {
#ifdef OFF_conv_item
  return;
#endif

  bf16_t* p = (bf16_t*)(P->ws + WS_P);
  float* u = (float*)lds;
  float* yb = (float*)(lds + 62 * 1024);
  const int tid = opaque_tid(wv_), c = tid & 255, half = tid >> 8;
  const int t0 = item * 32, tt0 = t0 & (TSEQ - 1);
  {
    bf16_t rv[31], rg[31];
#pragma unroll
    for (int i = 0; i < 31; ++i) { const int r = half + 2 * i; const bool ok = (tt0 - 30 + r) >= 0; const bf16_t* pr = p + (size_t)(t0 - 30 + r) * NIN;
      rv[i] = ok ? pr[C_CVAL + c] : (bf16_t)0; rg[i] = ok ? pr[C_CGLU + c] : (bf16_t)0; }
#pragma unroll
    for (int i = 0; i < 31; ++i) u[(half + 2 * i) * 256 + c] = bf2f(rv[i]) * sigmoidf_(bf2f(rg[i]));
  }
  float wv[31];
#pragma unroll
  for (int j = 0; j < 31; ++j) wv[j] = P->in[14][(l * 31 + j) * 256 + c];
  const float bias = P->in[15][l * 256 + c];
  __syncthreads();
  {
    float win[46];
#pragma unroll
    for (int i = 0; i < 46; ++i) win[i] = u[(half * 16 + i) * 256 + c];
#pragma unroll
    for (int i = 0; i < 16; ++i) {
      float acc = bias;
#pragma unroll
      for (int j = 0; j < 31; ++j) acc = fmaf(wv[j], win[i + j], acc);
      yb[(half * 16 + i) * 256 + c] = acc;
    }
  }
  __syncthreads();
  const int lane = tid & 63, w = tid >> 6;
  const float4 g = *(const float4*)(P->in[16] + l * 256 + lane * 4), bb = *(const float4*)(P->in[17] + l * 256 + lane * 4);
  uint2 gpre[4];
#pragma unroll
  for (int i = 0; i < 4; ++i) gpre[i] = *(const uint2*)(p + (size_t)(t0 + w * 4 + i) * NIN + C_CGATE + lane * 4);
#pragma unroll
  for (int i = 0; i < 4; ++i) {
    const int tk = w * 4 + i;
    const float4 v = *(const float4*)(yb + tk * 256 + lane * 4);
    const float mean = wave_sum(v.x + v.y + v.z + v.w, lane) * (1.0f / 256.0f);
    const float d0 = v.x - mean, d1 = v.y - mean, d2 = v.z - mean, d3 = v.w - mean;
    const float var = wave_sum(d0 * d0 + d1 * d1 + d2 * d2 + d3 * d3, lane) * (1.0f / 256.0f);
    const float rs = rsqrtf(var + 1e-5f);
    bf16_t* gp = p + (size_t)(t0 + tk) * NIN + C_CGATE + lane * 4;
    const uint2 gu = gpre[i];
    const float o0 = siluf_(d0 * rs * g.x + bb.x) * siluf_(__uint_as_float(gu.x << 16));
    const float o1 = siluf_(d1 * rs * g.y + bb.y) * siluf_(__uint_as_float(gu.x & 0xffff0000u));
    const float o2 = siluf_(d2 * rs * g.z + bb.z) * siluf_(__uint_as_float(gu.y << 16));
    const float o3 = siluf_(d3 * rs * g.w + bb.w) * siluf_(__uint_as_float(gu.y & 0xffff0000u));
    uint2 o; o.x = pack2(o0, o1); o.y = pack2(o2, o3);
    *(uint2*)gp = o;
  }
  __syncthreads();
}

#define HG_WLDS 10240
__device__ __forceinline__ float hgrn_lb(KP P, int l, int ch) {
  if (l == 0) return 0.f;
  const float x0 = P->in[18][ch], x1 = P->in[18][256 + ch];
  return __builtin_amdgcn_rcpf(1.0f + __expf(x0 - x1));
}
template <int PASS>
__device__ __forceinline__ void hgrn_wave_item(KP P, int l, int wi, unsigned char* lds, int wv_) {
#ifdef OFF_hgrn_wave_item
  return;
#endif

  bf16_t* p = (bf16_t*)(P->ws + WS_P);
  float* HS = (float*)(P->ws + WS_HS); float* HF = (float*)(P->ws + WS_HF);
  const int tid = opaque_tid(wv_);
  const int lane = tid & 63, w = tid >> 6;
  const int bh = wi >> 7, chunk = wi & 127, b = bh >> 2, head = bh & 3;
  float* st = (float*)(lds + w * HG_WLDS);
  float* ob = st + 2048;
  const int kg = lane & 7, vg = lane >> 3;
  const int ch = head * 64 + lane;
  const float lb = hgrn_lb(P, l, ch);
  const float ng = P->in[19][l * 256 + ch];
  float S[8][8];
  float* slot = HS + (size_t)(bh * 128 + chunk) * 4096;
  if (PASS == 1) {
#pragma unroll
    for (int i = 0; i < 8; ++i) { const float4 x0 = *(const float4*)(slot + (kg * 8 + i) * 64 + vg * 8), x1 = *(const float4*)(slot + (kg * 8 + i) * 64 + vg * 8 + 4);
      S[i][0] = x0.x; S[i][1] = x0.y; S[i][2] = x0.z; S[i][3] = x0.w; S[i][4] = x1.x; S[i][5] = x1.y; S[i][6] = x1.z; S[i][7] = x1.w; }
  } else {
#pragma unroll
    for (int i = 0; i < 8; ++i)
#pragma unroll
      for (int j = 0; j < 8; ++j) S[i][j] = 0.f;
  }
  float Fp = 1.f;
  bf16_t rf[8], ri[8], rq[8], rg[8];
  {
    const int tb0 = b * TSEQ + chunk * 64;
#pragma unroll
    for (int s = 0; s < 8; ++s) { const bf16_t* pr = p + (size_t)(tb0 + s) * NIN; rf[s] = pr[C_HF + ch]; ri[s] = pr[C_HI + ch]; if (PASS == 1) { rq[s] = pr[C_HQ + ch]; rg[s] = pr[C_HG + ch]; } }
  }
#pragma unroll 1
  for (int sub = 0; sub < 8; ++sub) {
    const int tbase = b * TSEQ + chunk * 64 + sub * 8;
    bf16_t gc[8];
#pragma unroll
    for (int s = 0; s < 8; ++s) {
      const float f = lb + (1.0f - lb) * sigmoidf_(bf2f(rf[s]));
      Fp *= f;
      st[s * 256 + lane] = f; st[s * 256 + 64 + lane] = 1.0f - f;
      if (PASS == 1) { st[s * 256 + 128 + lane] = siluf_(bf2f(rq[s])); gc[s] = rg[s]; }
      st[s * 256 + 192 + lane] = bf2f(ri[s]);
    }
    if (sub < 7) {
#pragma unroll
      for (int s = 0; s < 8; ++s) { const bf16_t* pr = p + (size_t)(tbase + 8 + s) * NIN; rf[s] = pr[C_HF + ch]; ri[s] = pr[C_HI + ch]; if (PASS == 1) { rq[s] = pr[C_HQ + ch]; rg[s] = pr[C_HG + ch]; } }
    }
    __builtin_amdgcn_s_waitcnt(0xc07f);
    __builtin_amdgcn_wave_barrier();
#pragma unroll 1
    for (int s = 0; s < 8; ++s) {
      const float* sp = st + s * 256;
      const float4 f0 = *(const float4*)(sp + kg * 8), f1 = *(const float4*)(sp + kg * 8 + 4);
      const float4 k0 = *(const float4*)(sp + 64 + kg * 8), k1 = *(const float4*)(sp + 64 + kg * 8 + 4);
      const float4 v0 = *(const float4*)(sp + 192 + vg * 8), v1 = *(const float4*)(sp + 192 + vg * 8 + 4);
      const float fv[8] = {f0.x, f0.y, f0.z, f0.w, f1.x, f1.y, f1.z, f1.w};
      const float kv[8] = {k0.x, k0.y, k0.z, k0.w, k1.x, k1.y, k1.z, k1.w};
      const float vv[8] = {v0.x, v0.y, v0.z, v0.w, v1.x, v1.y, v1.z, v1.w};
      const f32x2 vv2[4] = {{vv[0], vv[1]}, {vv[2], vv[3]}, {vv[4], vv[5]}, {vv[6], vv[7]}};
#pragma unroll
      for (int i = 0; i < 8; ++i) { const f32x2 f2 = {fv[i], fv[i]}, k2 = {kv[i], kv[i]};
#pragma unroll
        for (int j = 0; j < 4; ++j) { f32x2 s2 = {S[i][2 * j], S[i][2 * j + 1]}; s2 = f2 * s2 + k2 * vv2[j]; S[i][2 * j] = s2.x; S[i][2 * j + 1] = s2.y; } }
      if (PASS == 1) {
        const float4 q0 = *(const float4*)(sp + 128 + kg * 8), q1 = *(const float4*)(sp + 128 + kg * 8 + 4);
        const float qv[8] = {q0.x, q0.y, q0.z, q0.w, q1.x, q1.y, q1.z, q1.w};
        float o[8];
#pragma unroll
        for (int j = 0; j < 4; ++j) { f32x2 a2 = (f32x2){qv[0], qv[0]} * (f32x2){S[0][2 * j], S[0][2 * j + 1]};
#pragma unroll
          for (int i = 1; i < 8; ++i) a2 = (f32x2){qv[i], qv[i]} * (f32x2){S[i][2 * j], S[i][2 * j + 1]} + a2;
          o[2 * j] = red8(a2.x); o[2 * j + 1] = red8(a2.y); }
        if (kg == 0) { *(float4*)(ob + s * 64 + vg * 8) = make_float4(o[0], o[1], o[2], o[3]); *(float4*)(ob + s * 64 + vg * 8 + 4) = make_float4(o[4], o[5], o[6], o[7]); }
      }
    }
    __builtin_amdgcn_s_waitcnt(0xc07f);
    __builtin_amdgcn_wave_barrier();
    if (PASS == 1) {
#pragma unroll
      for (int s = 0; s < 8; ++s) {
        const float o = ob[s * 64 + lane];
        const float ms = wave_sum(o * o, lane) * (1.0f / 64.0f);
        p[(size_t)(tbase + s) * NIN + C_HG + ch] = f2bf(o * rsqrtf(ms + 1e-6f) * ng * siluf_(bf2f(gc[s])));
      }
      __builtin_amdgcn_s_waitcnt(0xc07f);
      __builtin_amdgcn_wave_barrier();
    }
  }
  if (PASS == 0) {
#pragma unroll
    for (int i = 0; i < 8; ++i) { *(float4*)(slot + (kg * 8 + i) * 64 + vg * 8) = make_float4(S[i][0], S[i][1], S[i][2], S[i][3]);
      *(float4*)(slot + (kg * 8 + i) * 64 + vg * 8 + 4) = make_float4(S[i][4], S[i][5], S[i][6], S[i][7]); }
    HF[(size_t)(bh * 128 + chunk) * 64 + lane] = Fp;
  }
}
__device__ __forceinline__ void hgrn_combine_item(KP P, int bh, int wv_) {
#ifdef OFF_hgrn_combine_item
  return;
#endif

  float* HS = (float*)(P->ws + WS_HS); const float* HF = (const float*)(P->ws + WS_HF);
  const int tid = opaque_tid(wv_);
  const int krow = tid >> 3;
  float R[8];
#pragma unroll
  for (int e = 0; e < 8; ++e) R[e] = 0.f;
  float4 xa[8][2]; float fa[8];
#pragma unroll
  for (int u = 0; u < 8; ++u) { const float* sl = HS + (size_t)(bh * 128 + u) * 4096 + tid * 8; xa[u][0] = *(const float4*)sl; xa[u][1] = *(const float4*)(sl + 4); fa[u] = HF[(size_t)(bh * 128 + u) * 64 + krow]; }
#pragma unroll 1
  for (int c0 = 0; c0 < 128; c0 += 8) {
    float4 xn[8][2]; float fn[8];
    if (c0 + 8 < 128) {
#pragma unroll
      for (int u = 0; u < 8; ++u) { const float* sl = HS + (size_t)(bh * 128 + c0 + 8 + u) * 4096 + tid * 8; xn[u][0] = *(const float4*)sl; xn[u][1] = *(const float4*)(sl + 4); fn[u] = HF[(size_t)(bh * 128 + c0 + 8 + u) * 64 + krow]; }
    }
#pragma unroll
    for (int u = 0; u < 8; ++u) {
      float* sl = HS + (size_t)(bh * 128 + c0 + u) * 4096 + tid * 8;
      *(float4*)sl = make_float4(R[0], R[1], R[2], R[3]); *(float4*)(sl + 4) = make_float4(R[4], R[5], R[6], R[7]);
      const float f = fa[u];
      R[0] = fmaf(f, R[0], xa[u][0].x); R[1] = fmaf(f, R[1], xa[u][0].y); R[2] = fmaf(f, R[2], xa[u][0].z); R[3] = fmaf(f, R[3], xa[u][0].w);
      R[4] = fmaf(f, R[4], xa[u][1].x); R[5] = fmaf(f, R[5], xa[u][1].y); R[6] = fmaf(f, R[6], xa[u][1].z); R[7] = fmaf(f, R[7], xa[u][1].w);
    }
    if (c0 + 8 < 128) {
#pragma unroll
      for (int u = 0; u < 8; ++u) { xa[u][0] = xn[u][0]; xa[u][1] = xn[u][1]; fa[u] = fn[u]; }
    }
  }
}

__device__ __forceinline__ void sb_item(KP P, int item, unsigned char* lds, int wv_) {
#ifdef OFF_sb_item
  return;
#endif

  bf16_t* p = (bf16_t*)(P->ws + WS_P);
  const int tid = opaque_tid(wv_), lane = tid & 63, w = tid >> 6;
  const int qt = item & 127, bh = item >> 7, b = bh >> 2, head = bh & 3;
  unsigned char* Qs = lds;
  unsigned char* Ks = lds + 9216;
  unsigned char* Vt = lds + 18432;
  unsigned char* As = lds + 27648;
  float* Zs = (float*)(lds + 36864);
  volatile int* flag = (volatile int*)(lds + 36864 + 64 * 65 * 4);
  const int lrow = tid >> 3, lch = (tid & 7);
  const size_t tokq = (size_t)b * TSEQ + qt * 64;
  *(uint4*)(Qs + lrow * 144 + lch * 16) = *(const uint4*)(p + (tokq + lrow) * NIN + C_SQ + head * 64 + lch * 8);
  float carry = 0.f;
  f32x4 oacc[2] = {{0.f, 0.f, 0.f, 0.f}, {0.f, 0.f, 0.f, 0.f}};
  const int qi = w >> 1, t2 = (w & 1) * 2;
  f32x4 gpre0, gpre1;
#pragma unroll
  for (int r = 0; r < 4; ++r) { const bf16_t* gp_ = p + (tokq + qi * 16 + (lane >> 4) * 4 + r) * NIN + C_SG + head * 64 + t2 * 16 + (lane & 15); gpre0[r] = bf2f(gp_[0]); gpre1[r] = bf2f(gp_[16]); }
  const int q = tid >> 3, seg = tid & 7;
  uint4 kreg = *(const uint4*)(p + (tokq + lrow) * NIN + C_SK + head * 64 + lch * 8);
  const int vkey = tid & 63, vch = tid >> 6;
  uint4 vreg = *(const uint4*)(p + (tokq + vkey) * NIN + C_SV + head * 64 + vch * 8);
  for (int kt = qt; kt >= 0; --kt) {
    LBAR();
    *(uint4*)(Ks + lrow * 144 + lch * 16) = kreg;
    { const unsigned vw[4] = {vreg.x, vreg.y, vreg.z, vreg.w};
#pragma unroll
      for (int e = 0; e < 8; ++e) *(unsigned short*)(Vt + (vch * 8 + e) * 144 + vkey * 2) = (unsigned short)((e & 1) ? (vw[e >> 1] >> 16) : (vw[e >> 1] & 0xffffu)); }
    if (tid == 0) *flag = 0;
    if (kt > 0) { const size_t tokn = (size_t)b * TSEQ + (kt - 1) * 64;
      kreg = *(const uint4*)(p + (tokn + lrow) * NIN + C_SK + head * 64 + lch * 8);
      vreg = *(const uint4*)(p + (tokn + vkey) * NIN + C_SV + head * 64 + vch * 8); }
    LBAR();
#pragma unroll
    for (int jj = 0; jj < 2; ++jj) {
      const int ki = t2 + jj;
      f32x4 acc = {0.f, 0.f, 0.f, 0.f};
#pragma unroll
      for (int s = 0; s < 2; ++s) {
        const bf16x8 a = *(const bf16x8*)(Qs + (qi * 16 + (lane & 15)) * 144 + s * 64 + (lane >> 4) * 16);
        const bf16x8 bb = *(const bf16x8*)(Ks + (ki * 16 + (lane & 15)) * 144 + s * 64 + (lane >> 4) * 16);
        acc = __builtin_amdgcn_mfma_f32_16x16x32_bf16(a, bb, acc, 0, 0, 0);
      }
#pragma unroll
      for (int r = 0; r < 4; ++r) Zs[(qi * 16 + (lane >> 4) * 4 + r) * 65 + ki * 16 + (lane & 15)] = acc[r] * 0.125f;
    }
    LBAR();
    {
      const int tq = qt * 64 + q;
      float z[8], lk[8];
      float tot = 0.f;
#pragma unroll
      for (int e = 0; e < 8; ++e) {
        z[e] = Zs[q * 65 + seg * 8 + e];
        const bool m = (kt * 64 + seg * 8 + e) < tq;
        lk[e] = m ? -softplus_fast(z[e]) : 0.f;
        tot += lk[e];
      }
      float inc = tot;
      { float t_ = __builtin_bit_cast(float, __builtin_amdgcn_update_dpp(0, __builtin_bit_cast(int, inc), 0x101, 0xF, 0xF, true)); if (seg + 1 < 8) inc += t_; }
      { float t_ = __builtin_bit_cast(float, __builtin_amdgcn_update_dpp(0, __builtin_bit_cast(int, inc), 0x102, 0xF, 0xF, true)); if (seg + 2 < 8) inc += t_; }
      { float t_ = __builtin_bit_cast(float, __builtin_amdgcn_update_dpp(0, __builtin_bit_cast(int, inc), 0x104, 0xF, 0xF, true)); if (seg + 4 < 8) inc += t_; }
      const float rowtot = red8(tot);
      float tail = carry + (inc - tot);
      float av[8];
#pragma unroll
      for (int e = 7; e >= 0; --e) {
        const bool m = (kt * 64 + seg * 8 + e) < tq;
        av[e] = m ? __expf(z[e] + lk[e] + tail) : 0.f;
        tail += lk[e];
      }
      uint4 o; o.x = pack2(av[0], av[1]); o.y = pack2(av[2], av[3]); o.z = pack2(av[4], av[5]); o.w = pack2(av[6], av[7]);
      *(uint4*)(As + q * 144 + seg * 16) = o;
      carry += rowtot;
      if (carry > -104.f) *flag = 1;
    }
    LBAR();
#pragma unroll
    for (int jj = 0; jj < 2; ++jj) {
      const int di = t2 + jj;
#pragma unroll
      for (int s = 0; s < 2; ++s) {
        const bf16x8 a = *(const bf16x8*)(As + (qi * 16 + (lane & 15)) * 144 + s * 64 + (lane >> 4) * 16);
        const bf16x8 bb = *(const bf16x8*)(Vt + (di * 16 + (lane & 15)) * 144 + s * 64 + (lane >> 4) * 16);
        oacc[jj] = __builtin_amdgcn_mfma_f32_16x16x32_bf16(a, bb, oacc[jj], 0, 0, 0);
      }
    }
    if (*flag == 0) break;
  }
#pragma unroll
  for (int jj = 0; jj < 2; ++jj) {
    const int d = (t2 + jj) * 16 + (lane & 15);
#pragma unroll
    for (int r = 0; r < 4; ++r) {
      const int qq = qi * 16 + (lane >> 4) * 4 + r;
      bf16_t* gp = p + (tokq + qq) * NIN + C_SG + head * 64 + d;
      *gp = f2bf(oacc[jj][r] * siluf_(jj == 0 ? gpre0[r] : gpre1[r]));
    }
  }
  __syncthreads();
}

__device__ __forceinline__ void xattn_item(KP P, int l, int item, unsigned char* lds, int wv_) {
  const bf16_t* qb = (const bf16_t*)(P->ws + WS_P + 32ull * MiB);
  bf16_t* ob = (bf16_t*)(P->ws + WS_P + 64ull * MiB);
  const bf16_t* kv = (const bf16_t*)(P->ws + WS_KV) + (size_t)l * 512 * 2048;
  const bf16_t* vt = (const bf16_t*)(P->ws + WS_VT) + (size_t)l * 2 * 1024 * 256;
  const int tid = opaque_tid(wv_), lane = tid & 63, w = tid >> 6;
  const int qt = item & 127, bh = item >> 7, b = bh >> 2, head = bh & 3;
  unsigned char* Qs = lds;
  unsigned char* KVs = lds + 33792;
  float* Ss = (float*)(lds + 67584);
  const size_t tok0 = (size_t)b * TSEQ + qt * 64;
  const int pr = tid >> 5, pc = tid & 31;
  uint4 pg0, pg1, pg2, pg3;
#define XA_LOAD(p_) { const bf16_t* s_ = (p_) < 4 ? kv + (size_t)(b * 256 + (p_) * 64 + pr) * 2048 + head * 256 + pc * 8 : vt + (size_t)(b * 1024 + head * 256 + ((p_) - 4) * 64 + pr) * 256 + pc * 8; \
      const size_t st_ = (p_) < 4 ? (size_t)16 * 2048 : (size_t)16 * 256; \
      pg0 = *(const uint4*)(s_); pg1 = *(const uint4*)(s_ + st_); pg2 = *(const uint4*)(s_ + 2 * st_); pg3 = *(const uint4*)(s_ + 3 * st_); }
  __syncthreads();
#pragma unroll
  for (int i = 0; i < 4; ++i) { const int r = pr + 16 * i; *(uint4*)(Qs + r * 528 + pc * 16) = *(const uint4*)(qb + (tok0 + r) * 1024 + head * 256 + pc * 8); }
  XA_LOAD(0);
  const int qi = w >> 1, t2 = (w & 1) * 2;
#pragma unroll 1
  for (int p = 0; p < 8; ++p) {
    LBAR();
    { unsigned char* d_ = KVs + pr * 528 + pc * 16; *(uint4*)d_ = pg0; *(uint4*)(d_ + 16 * 528) = pg1; *(uint4*)(d_ + 32 * 528) = pg2; *(uint4*)(d_ + 48 * 528) = pg3; }
    if (p < 7) XA_LOAD(p + 1);
    LBAR();
    f32x4 acc0 = {0.f, 0.f, 0.f, 0.f}, acc1 = {0.f, 0.f, 0.f, 0.f};
#pragma unroll
    for (int s = 0; s < 8; ++s) {
      const bf16x8 a = *(const bf16x8*)(Qs + (qi * 16 + (lane & 15)) * 528 + s * 64 + (lane >> 4) * 16);
      const bf16x8 b0 = *(const bf16x8*)(KVs + (t2 * 16 + (lane & 15)) * 528 + s * 64 + (lane >> 4) * 16);
      const bf16x8 b1 = *(const bf16x8*)(KVs + ((t2 + 1) * 16 + (lane & 15)) * 528 + s * 64 + (lane >> 4) * 16);
      acc0 = __builtin_amdgcn_mfma_f32_16x16x32_bf16(a, b0, acc0, 0, 0, 0);
      acc1 = __builtin_amdgcn_mfma_f32_16x16x32_bf16(a, b1, acc1, 0, 0, 0);
    }
    if (p < 4) {
#pragma unroll
      for (int r = 0; r < 4; ++r) { float* d_ = Ss + (qi * 16 + (lane >> 4) * 4 + r) * 260 + p * 64 + t2 * 16 + (lane & 15); d_[0] = acc0[r] * 0.0625f; d_[16] = acc1[r] * 0.0625f; }
      if (p == 3) {
        LBAR();
        const int q = tid >> 3, seg = tid & 7;
        float x[32]; float mx = -3.0e38f;
#pragma unroll
        for (int i = 0; i < 8; ++i) { const float4 v = *(const float4*)(Ss + q * 260 + seg * 32 + i * 4); x[i * 4] = v.x; x[i * 4 + 1] = v.y; x[i * 4 + 2] = v.z; x[i * 4 + 3] = v.w;
          mx = fmaxf(mx, fmaxf(fmaxf(v.x, v.y), fmaxf(v.z, v.w))); }
        mx = max8(mx);
        float sum = 0.f;
#pragma unroll
        for (int i = 0; i < 32; ++i) { x[i] = __expf(x[i] - mx); sum += x[i]; }
        sum = red8(sum);
        const float inv = __builtin_amdgcn_rcpf(sum);
#pragma unroll
        for (int i = 0; i < 4; ++i) { uint4 o; o.x = pack2(x[i * 8] * inv, x[i * 8 + 1] * inv); o.y = pack2(x[i * 8 + 2] * inv, x[i * 8 + 3] * inv);
          o.z = pack2(x[i * 8 + 4] * inv, x[i * 8 + 5] * inv); o.w = pack2(x[i * 8 + 6] * inv, x[i * 8 + 7] * inv);
          *(uint4*)(Qs + q * 528 + seg * 64 + i * 16) = o; }
      }
    } else {
#pragma unroll
      for (int r = 0; r < 4; ++r) { bf16_t* d_ = ob + (tok0 + qi * 16 + (lane >> 4) * 4 + r) * 1024 + head * 256 + (p - 4) * 64 + t2 * 16 + (lane & 15); d_[0] = f2bf(acc0[r]); d_[16] = f2bf(acc1[r]); }
    }
  }
#undef XA_LOAD
  __syncthreads();
}

__device__ __forceinline__ void wt_item(KP P, int l, int r, unsigned char* lds, int wv_) {
  const float* W; int N; bf16_t* Wt; int kt, nt; const float* gk = nullptr;
  unsigned char* wl = P->ws + WS_WT + l * WT_LAYER;
  if (r < 976) { W = P->in[3] + (size_t)l * 1024 * NIN; N = NIN; Wt = (bf16_t*)(wl + WT_IN); kt = r / 61; nt = r % 61; gk = P->in[2] + l * 1024; }
  else { r -= 976; const int m = r >> 8; r &= 255; kt = r >> 4; nt = r & 15; N = 1024;
    if (m == 0) { W = P->in[20] + (size_t)l * 1048576; Wt = (bf16_t*)(wl + WT_OUT); }
    else if (m == 1) { W = P->in[23] + (size_t)l * 1048576; Wt = (bf16_t*)(wl + WT_Q); gk = P->in[21] + l * 1024; }
    else if (m == 2) { W = P->in[24] + (size_t)l * 1048576; Wt = (bf16_t*)(wl + WT_KV); }
    else if (m == 3) { W = P->in[25] + (size_t)l * 1048576; Wt = (bf16_t*)(wl + WT_KV) + 1024 * 1024; }
    else { W = P->in[26] + (size_t)l * 1048576; Wt = (bf16_t*)(wl + WT_O); } }
  wt_tile(W, N, Wt, kt, nt, lds, wv_, gk);
}
__device__ __forceinline__ void wt_deferred(KP P, int d, unsigned char* lds, int wv_) {
  if (d < 768) { const int m = d >> 8, r = d & 255; wt_item(P, 0, 976 + (m == 0 ? 0 : m == 1 ? 256 : 1024) + r, lds, wv_); }
  else wt_item(P, 1, d - 768, lds, wv_);
}
__device__ __forceinline__ int next_item(unsigned* ctr, volatile LAS int* slot, int wv_) {
  __syncthreads();
  if (opaque_tid(wv_) == 0) *slot = (int)__hip_atomic_fetch_add(ctr, 1u, __ATOMIC_RELAXED, __HIP_MEMORY_SCOPE_AGENT);
  __syncthreads();
  return *slot;
}
__global__ void __launch_bounds__(NTHR) fwd_megakernel(Params Pk_unused) {
  KP P = (KP)__builtin_amdgcn_kernarg_segment_ptr();
  extern __shared__ __attribute__((aligned(16))) unsigned char lds[];
  const int wv_ = __builtin_amdgcn_readfirstlane((int)threadIdx.x >> 6);
  __shared__ uint4 xb_words;
  __shared__ int4 wq_slot;
  if (opaque_tid(wv_) == 0) xb_words = make_uint4(0u, 0u, 0u, 0u);
  __syncthreads();
#ifdef PROBE_J
  __shared__ unsigned long long tacc[32];
  __shared__ unsigned long long tlast;
  __shared__ float pdelta;
  if (opaque_tid(wv_) == 0) { for (int i = 0; i < 32; ++i) tacc[i] = 0ull; tlast = __builtin_amdgcn_s_memrealtime(); pdelta = 0.f; }
#define STAMP(k) if (opaque_tid(wv_) == 0) { const unsigned long long n_ = __builtin_amdgcn_s_memrealtime(); tacc[k] += n_ - tlast; tlast = n_; }
#else
#define STAMP(k)
#endif
  XcdBarrier bar = xcd_barrier_post((unsigned*)(P->ws + WS_BAR), (volatile LAS unsigned*)&xb_words, wv_);
  if (P->never) cg::this_grid().sync();
  const int G = gridDim.x, bid0 = blockIdx.x;

  for (int it = bid0; it < 976 + 512; it += G) wt_item(P, 0, it < 976 ? it : it + 512, lds, wv_);
#pragma unroll 1
  for (int k = 0; k < 3; ++k) {
    const float* s_ = k < 2 ? P->in[1] : P->in[0];
    const float* g_ = k < 2 ? P->in[22] + k * 1024 : P->in[2];
    bf16_t* d_ = k < 2 ? (bf16_t*)(P->ws + WS_MEMN) + k * 512 * 1024 : (bf16_t*)((unsigned char*)P->out + 32ull * MiB);
    norm_rows(false, s_, g_, d_, k < 2 ? 512 : NT, 0.f, wv_, k < 2 ? nullptr : (float*)(P->ws + WS_SSQ));
  }
  { float* z_ = (float*)(P->ws + WS_SSQ) + NT; for (int i = bid0 * NTHR + opaque_tid(wv_); i < 4 * NT; i += G * NTHR) z_[i] = 0.f; }
  STAMP(16 + 10); xcd_barrier(bar, wv_); STAMP(10)
  asm volatile("" : "+s"(P));

#pragma unroll 1
  for (int it = 0; it < 17; ++it) {
    int l = it >> 3, ph = it & 7;
    ph = ph < 5 ? ph : ph + 1;
    if (it == 16) { l = 1; ph = 9; }
    asm volatile("" : "+s"(P));
    int bid = bid0; asm volatile("" : "+s"(bid));

    unsigned char* ws = P->ws;
    const unsigned char* wl = ws + WS_WT + l * WT_LAYER;
    bf16_t* hbuf = (bf16_t*)((unsigned char*)P->out + 32ull * MiB);
    float* ssq = (float*)(ws + WS_SSQ);
    bf16_t* pbuf = (bf16_t*)(ws + WS_P);
    bf16_t* hx = (bf16_t*)(ws + WS_P);
    bf16_t* qbuf = (bf16_t*)(ws + WS_P + 32ull * MiB);
    bf16_t* obuf = (bf16_t*)(ws + WS_P + 64ull * MiB);
    if (ph == 0 || ph == 4 || ph == 6 || ph == 8) {
      pg8::Gemm g; pg8::TileSched S; pg8::EpiDyn E;
      g.M = NT; g.K = 1024; S.G = G; S.c = bid;
      if (ph == 0) { g.A = hbuf; g.Bt = (const bf16_t*)(wl + WT_IN); g.N = 4096; g.lda = 1024; g.ao0 = 0; g.ao1 = 256; g.ao2 = 512; g.ao3 = 768; S.nt = 1024; S.nN = 16;
        E.mode = 0; E.O = pbuf; E.ldc = NIN; E.N = NIN; E.resid = nullptr; E.out = nullptr; E.ssq_in = ssq + (l == 0 ? 0 : 2) * NT; E.xb = nullptr; E.ssq_out = nullptr; }
      else if (ph == 4) { g.A = pbuf; g.Bt = (const bf16_t*)(wl + WT_OUT); g.N = 1024; g.lda = NIN; g.ao0 = C_GA; g.ao1 = C_CGATE; g.ao2 = C_HG; g.ao3 = C_SG; S.nt = 256; S.nN = 4;
        E.mode = 1; E.O = nullptr; E.ldc = 1024; E.N = 1024; E.resid = (l == 0) ? P->in[0] : P->out; E.out = P->out; E.ssq_in = nullptr; E.xb = hbuf; E.ssq_out = ssq + (l == 0 ? 1 : 3) * NT; }
      else if (ph == 6) { g.A = hbuf; g.Bt = (const bf16_t*)(wl + WT_Q); g.N = 1024; g.lda = 1024; g.ao0 = 0; g.ao1 = 256; g.ao2 = 512; g.ao3 = 768; S.nt = 256; S.nN = 4;
        E.mode = 0; E.O = qbuf; E.ldc = 1024; E.N = 1024; E.resid = nullptr; E.out = nullptr; E.ssq_in = ssq + (l == 0 ? 1 : 3) * NT; E.xb = nullptr; E.ssq_out = nullptr; }
      else { g.A = obuf; g.Bt = (const bf16_t*)(wl + WT_O); g.N = 1024; g.lda = 1024; g.ao0 = 0; g.ao1 = 256; g.ao2 = 512; g.ao3 = 768; S.nt = 256; S.nN = 4;
        E.mode = 1; E.O = nullptr; E.ldc = 1024; E.N = 1024; E.resid = P->out; E.out = P->out; E.ssq_in = nullptr; E.xb = hbuf; E.ssq_out = ssq + (l == 0 ? 2 : 4) * NT; }
      pg8::gemm_phase<pg8::EpiDyn, pg8::TileSched, true, true>((PG8_LAS unsigned char*)lds, g, S, E, wv_);
    } else if (ph == 1) {
      unsigned* ctr = (unsigned*)(ws + WS_BAR) + it;
      for (;;) {
        const int i2 = next_item(ctr, (volatile LAS int*)&wq_slot, wv_);
        if (i2 >= 128 + 1024) break;
        if (i2 < 128) hgrn_wave_item<0>(P, l, i2 * 8 + wv_, lds, wv_);
        else rwkv_prep_item(P, l, i2 - 128, lds, wv_);
      }
    } else if (ph == 2) {
      const int n_p1 = 8 * (RW_C - 2);
      const int n_rw = n_p1 + 8;
      const int n_oth = 8 + 512 + 1024;
      for (int i2 = bid; i2 < n_rw; i2 += G) {
        if (i2 < n_p1) rwkv_scan_item<1>(P, l, i2 & 7, 1 + (i2 >> 3), lds, wv_);
        else rwkv_scan_item<0>(P, l, i2 - n_p1, 0, lds, wv_);
      }
      {
        unsigned* ctr = (unsigned*)(ws + WS_BAR) + it;
        for (;;) {
          const int i2 = next_item(ctr, (volatile LAS int*)&wq_slot, wv_);
          if (i2 >= n_oth) break;
          if (i2 < 8) hgrn_combine_item(P, i2, wv_);
          else if (i2 < 8 + 512) conv_item(P, l, i2 - 8, lds, wv_);
          else sb_item(P, i2 - 8 - 512, lds, wv_);
        }
      }
    } else if (ph == 3) {
      const int n_p3 = 8 * (RW_C - 1);
      for (int i2 = bid; i2 < n_p3; i2 += G) rwkv_scan_item<0>(P, l, i2 & 7, 1 + (i2 >> 3), lds, wv_);
      {
        unsigned* ctr = (unsigned*)(ws + WS_BAR) + it;
        for (;;) {
          const int i2 = next_item(ctr, (volatile LAS int*)&wq_slot, wv_);
          if (i2 >= 16 + 128 + (l == 0 ? 189 : 0)) break;
          if (i2 >= 16 + 128) { for (int d = (i2 - 144) * 16; d < (i2 - 144) * 16 + 16; ++d) wt_deferred(P, d, lds, wv_); }
          else if (i2 < 16) gemm_tile<2>((const bf16_t*)(ws + WS_MEMN) + (size_t)l * 512 * 1024, 1024, 0, 256, 512, 768, (const bf16_t*)(wl + WT_KV), (i2 >> 3) * 256, (i2 & 7) * 256, 2048,
                                    (bf16_t*)(ws + WS_KV) + (size_t)l * 512 * 2048, (const float*)((bf16_t*)(ws + WS_VT) + (size_t)l * 2 * 1024 * 256), 2048, lds, wv_);
          else hgrn_wave_item<1>(P, l, (i2 - 16) * 8 + wv_, lds, wv_);
        }
      }
    } else if (ph == 7) {
      for (int i2 = bid * 4; i2 < 1024; i2 += G * 4) { for (int k2 = 0; k2 < 4; ++k2) xattn_item(P, l, i2 + k2, lds, wv_); }
    } else {
      const float* ssqf = ssq + 4 * NT;
      const float* gf = P->in[27];
      float* outp = P->out;
      const int tid = opaque_tid(wv_), lane = tid & 63, w = tid >> 6;
      float4 gv[4];
#pragma unroll
      for (int i = 0; i < 4; ++i) gv[i] = *(const float4*)(gf + lane * 16 + i * 4);
      const int rpb = (8192 + G - 1) / G;
      for (int c = tid; c < rpb * 128; c += NTHR) { const int j = c >> 7, ch = c & 127; const int row = 8192 + bid * rpb + j;
        if (row < NT) *(uint4*)(lds + (size_t)j * 2048 + ch * 16) = *(const uint4*)(hbuf + (size_t)row * 1024 + ch * 8); }
      for (int row = bid * 8 + w; row < 8192; row += G * 8) {
        const uint4 a = *(const uint4*)(hbuf + (size_t)row * 1024 + lane * 16), b2 = *(const uint4*)(hbuf + (size_t)row * 1024 + lane * 16 + 8);
        const float rs = __builtin_amdgcn_rsqf(ssqf[row] * (1.0f / 1024.0f) + 1e-6f);
        float* o_ = outp + (size_t)row * 1024 + lane * 16;
        *(float4*)(o_) = make_float4(__uint_as_float(a.x << 16) * rs * gv[0].x, __uint_as_float(a.x & 0xffff0000u) * rs * gv[0].y, __uint_as_float(a.y << 16) * rs * gv[0].z, __uint_as_float(a.y & 0xffff0000u) * rs * gv[0].w);
        *(float4*)(o_ + 4) = make_float4(__uint_as_float(a.z << 16) * rs * gv[1].x, __uint_as_float(a.z & 0xffff0000u) * rs * gv[1].y, __uint_as_float(a.w << 16) * rs * gv[1].z, __uint_as_float(a.w & 0xffff0000u) * rs * gv[1].w);
        *(float4*)(o_ + 8) = make_float4(__uint_as_float(b2.x << 16) * rs * gv[2].x, __uint_as_float(b2.x & 0xffff0000u) * rs * gv[2].y, __uint_as_float(b2.y << 16) * rs * gv[2].z, __uint_as_float(b2.y & 0xffff0000u) * rs * gv[2].w);
        *(float4*)(o_ + 12) = make_float4(__uint_as_float(b2.z << 16) * rs * gv[3].x, __uint_as_float(b2.z & 0xffff0000u) * rs * gv[3].y, __uint_as_float(b2.w << 16) * rs * gv[3].z, __uint_as_float(b2.w & 0xffff0000u) * rs * gv[3].w);
      }
      xcd_barrier(bar, wv_);
      for (int j = w; j < rpb; j += 8) { const int row = 8192 + bid * rpb + j;
        if (row < NT) {
          const uint4 a = *(const uint4*)(lds + (size_t)j * 2048 + lane * 32), b2 = *(const uint4*)(lds + (size_t)j * 2048 + lane * 32 + 16);
          const float rs = __builtin_amdgcn_rsqf(ssqf[row] * (1.0f / 1024.0f) + 1e-6f);
          float* o_ = outp + (size_t)row * 1024 + lane * 16;
          *(float4*)(o_) = make_float4(__uint_as_float(a.x << 16) * rs * gv[0].x, __uint_as_float(a.x & 0xffff0000u) * rs * gv[0].y, __uint_as_float(a.y << 16) * rs * gv[0].z, __uint_as_float(a.y & 0xffff0000u) * rs * gv[0].w);
          *(float4*)(o_ + 4) = make_float4(__uint_as_float(a.z << 16) * rs * gv[1].x, __uint_as_float(a.z & 0xffff0000u) * rs * gv[1].y, __uint_as_float(a.w << 16) * rs * gv[1].z, __uint_as_float(a.w & 0xffff0000u) * rs * gv[1].w);
          *(float4*)(o_ + 8) = make_float4(__uint_as_float(b2.x << 16) * rs * gv[2].x, __uint_as_float(b2.x & 0xffff0000u) * rs * gv[2].y, __uint_as_float(b2.y << 16) * rs * gv[2].z, __uint_as_float(b2.y & 0xffff0000u) * rs * gv[2].w);
          *(float4*)(o_ + 12) = make_float4(__uint_as_float(b2.z << 16) * rs * gv[3].x, __uint_as_float(b2.z & 0xffff0000u) * rs * gv[3].y, __uint_as_float(b2.w << 16) * rs * gv[3].z, __uint_as_float(b2.w & 0xffff0000u) * rs * gv[3].w);
        }
      }
    }
    if (it < 16) { STAMP(16 + ph); xcd_barrier(bar, wv_); STAMP(ph) }
  }
#ifdef PROBE_J
  if (bid0 == PROBE_B && opaque_tid(wv_) == 0) {
    const unsigned long long t0_ = __builtin_amdgcn_s_memrealtime();
    const unsigned long long w_ = 4ull * (PROBE_K < 32 ? tacc[PROBE_K & 31] : tacc[PROBE_K - 32] + tacc[PROBE_K - 16]);
    while (__builtin_amdgcn_s_memrealtime() - t0_ < w_) __builtin_amdgcn_s_sleep(8);
  }
#endif
}

extern "C" void kernel_launch(void* const* d_in, const int* in_sizes, int n_in, void* d_out, int out_size, void* d_ws, size_t ws_size, hipStream_t stream) {
  constexpr size_t kDynLds = 147456;
  static int grid_blocks = 0;
  if (!grid_blocks) {
    int dev = 0, cus = 0, per_cu = 0;
    hipGetDevice(&dev);
    hipDeviceGetAttribute(&cus, hipDeviceAttributeMultiprocessorCount, dev);
    hipFuncSetAttribute((const void*)fwd_megakernel, hipFuncAttributeMaxDynamicSharedMemorySize, (int)kDynLds);
    hipOccupancyMaxActiveBlocksPerMultiprocessor(&per_cu, fwd_megakernel, NTHR, kDynLds);
    if (per_cu < 1) per_cu = 1;
    if (per_cu > 1) per_cu = 1;
    grid_blocks = cus * per_cu;
    if (grid_blocks > 256) grid_blocks = 256;
  }
  Params p;
  memset(&p, 0, sizeof(p));
  for (int i = 0; i < 28; ++i) p.in[i] = (const float*)d_in[i];
  p.out = (float*)d_out; p.ws = (unsigned char*)d_ws; p.never = 0; p.pad = 0;
  hipMemsetAsync(d_ws, 0, XCD_BAR_WORDS * 4, stream);
  void* args[] = {&p};
  hipError_t e = hipLaunchCooperativeKernel((void*)fwd_megakernel, dim3(grid_blocks), dim3(NTHR), args, kDynLds, stream);
  if (e != hipSuccess) fprintf(stderr, "cooperative launch failed: %s (grid %d)\n", hipGetErrorString(e), grid_blocks);
}
```

```cpp
#include <hip/hip_runtime.h>
#include <hip/hip_cooperative_groups.h>
#include <stdint.h>
#include <cstdio>
#include <cstring>
namespace cg = cooperative_groups;

typedef unsigned short bf16_t;
typedef short bf16x8 __attribute__((ext_vector_type(8)));
typedef float f32x4 __attribute__((ext_vector_type(4)));
typedef float f32x16 __attribute__((ext_vector_type(16)));
typedef float f32x2 __attribute__((ext_vector_type(2)));
#define LAS __attribute__((address_space(3)))

#define NT 16384
#define TSEQ 8192
#define DM 1024
#define NIN 3904
#define NTHR 512
#define C_R 0
#define C_K 256
#define C_V 512
#define C_XW 768
#define C_GA 832
#define C_CVAL 1088
#define C_CGLU 1344
#define C_CGATE 1600
#define C_HQ 1856
#define C_HF 2112
#define C_HI 2368
#define C_HG 2624
#define C_SQ 2880
#define C_SK 3136
#define C_SV 3392
#define C_SG 3648
#define RW_C 32
#define RW_CL (TSEQ / RW_C)
#define RW_TT 16

#define MiB (1024ull * 1024ull)
#define WS_BAR   0ull
#define WS_WT    (1ull * MiB)
#define WT_LAYER (18ull * MiB)
#define WT_IN    0ull
#define WT_OUT   (8ull * MiB)
#define WT_Q     (10ull * MiB)
#define WT_KV    (12ull * MiB)
#define WT_O     (16ull * MiB)
#define WS_MEMN  (37ull * MiB)
#define WS_KV    (39ull * MiB)
#define WS_PQ    (246ull * MiB)
#define WS_HS    (47ull * MiB)
#define WS_HF    (63ull * MiB)
#define WS_RK    (63ull * MiB + 512ull * 1024ull)
#define WS_R1    (64ull * MiB)
#define WS_PW    WS_R1
#define WS_PV    (WS_R1 + 16ull * MiB)
#define WS_P     (120ull * MiB)
#define WS_VT    (243ull * MiB)
#define WS_SSQ   (245ull * MiB)
#define WS_END   (254ull * MiB)

struct Params {
  const float* in[28];
  float* out;
  unsigned char* ws;
  int never;
  int pad;
};

typedef const __attribute__((address_space(4))) Params* KP;
__device__ __forceinline__ int lane_id_() { return (int)__builtin_amdgcn_mbcnt_hi(~0u, __builtin_amdgcn_mbcnt_lo(~0u, 0u)); }
__device__ __forceinline__ int opaque_tid(int wv_) { int t; asm volatile("v_mbcnt_lo_u32_b32 %0, -1, 0\n\tv_mbcnt_hi_u32_b32 %0, -1, %0\n\tv_lshl_add_u32 %0, %1, 6, %0" : "=&v"(t) : "s"(wv_)); return t; }
__device__ __forceinline__ float bf2f(bf16_t v) { return __uint_as_float(((unsigned)v) << 16); }
__device__ __forceinline__ bf16_t f2bf(float f) {
  unsigned u = __float_as_uint(f);
  u += 0x7fffu + ((u >> 16) & 1u);
  return (bf16_t)(u >> 16);
}
__device__ __forceinline__ unsigned pack2(float a, float b) { return (unsigned)f2bf(a) | ((unsigned)f2bf(b) << 16); }
__device__ __forceinline__ float sigmoidf_(float x) { return __builtin_amdgcn_rcpf(1.0f + __expf(-x)); }
__device__ __forceinline__ float siluf_(float x) { return x * __builtin_amdgcn_rcpf(1.0f + __expf(-x)); }
__device__ __forceinline__ float softplusf_(float x) { return fmaxf(x, 0.f) + log1pf(__expf(-fabsf(x))); }
__device__ __forceinline__ float softplus_fast(float x) { return fmaxf(x, 0.f) + __logf(1.0f + __expf(-fabsf(x))); }
__device__ __forceinline__ float dpp_add(float v, const int ctrl_sel) {
  return v;
}
__device__ __forceinline__ float bperm(float v, int srclane) { return __builtin_bit_cast(float, __builtin_amdgcn_ds_bpermute(srclane << 2, __builtin_bit_cast(int, v))); }
__device__ __forceinline__ float wave_sum(float v, int lane) {
  v += __builtin_bit_cast(float, __builtin_amdgcn_update_dpp(0, __builtin_bit_cast(int, v), 0xB1, 0xF, 0xF, true));
  v += __builtin_bit_cast(float, __builtin_amdgcn_update_dpp(0, __builtin_bit_cast(int, v), 0x4E, 0xF, 0xF, true));
  v += __builtin_bit_cast(float, __builtin_amdgcn_update_dpp(0, __builtin_bit_cast(int, v), 0x141, 0xF, 0xF, true));
  v += __builtin_bit_cast(float, __builtin_amdgcn_update_dpp(0, __builtin_bit_cast(int, v), 0x140, 0xF, 0xF, true));
  v += bperm(v, lane ^ 16);
  v += bperm(v, lane ^ 32);
  return v;
}
__device__ __forceinline__ float max8(float v) {
  v = fmaxf(v, __builtin_bit_cast(float, __builtin_amdgcn_update_dpp(0, __builtin_bit_cast(int, v), 0xB1, 0xF, 0xF, true)));
  v = fmaxf(v, __builtin_bit_cast(float, __builtin_amdgcn_update_dpp(0, __builtin_bit_cast(int, v), 0x4E, 0xF, 0xF, true)));
  v = fmaxf(v, __builtin_bit_cast(float, __builtin_amdgcn_update_dpp(0, __builtin_bit_cast(int, v), 0x141, 0xF, 0xF, true)));
  return v;
}
__device__ __forceinline__ float red8(float v) {
  v += __builtin_bit_cast(float, __builtin_amdgcn_update_dpp(0, __builtin_bit_cast(int, v), 0xB1, 0xF, 0xF, true));
  v += __builtin_bit_cast(float, __builtin_amdgcn_update_dpp(0, __builtin_bit_cast(int, v), 0x4E, 0xF, 0xF, true));
  v += __builtin_bit_cast(float, __builtin_amdgcn_update_dpp(0, __builtin_bit_cast(int, v), 0x141, 0xF, 0xF, true));
  return v;
}

#define LBAR() do { asm volatile("s_waitcnt lgkmcnt(0)" ::: "memory"); __builtin_amdgcn_s_barrier(); asm volatile("" ::: "memory"); } while (0)
#define XB_TMO      128
#define XB_XCNT(j)  (256  + 64 * (j))
#define XB_XSUB(j)  (1280 + 64 * (j))
#define XB_XGEN(j)  (2304 + 64 * (j))
#define XB_TOP      3328
#define XB_TOPGEN   3392
#define XCD_BAR_WORDS 3456
#define XB_SPIN_CAP (1u << 22)
__device__ __forceinline__ unsigned xb_ld(unsigned* p) { return __hip_atomic_load(p, __ATOMIC_RELAXED, __HIP_MEMORY_SCOPE_AGENT); }
__device__ __forceinline__ unsigned xb_add(unsigned* p, unsigned v) { return __hip_atomic_fetch_add(p, v, __ATOMIC_RELAXED, __HIP_MEMORY_SCOPE_AGENT); }
__device__ __forceinline__ unsigned xb_xcc_id() { return (unsigned)__builtin_amdgcn_s_getreg((3 << 11) | 20) & 0xFu; }
#define XB_SPIN(cond, bar) do { unsigned _sp = 0; while (cond) { __builtin_amdgcn_s_sleep(1); \
    if ((++_sp & 255u) == 0u) { if (xb_ld(&(bar)[XB_TMO])) break; if (_sp > XB_SPIN_CAP) { atomicAdd(&(bar)[XB_TMO], 1u); break; } } } } while (0)
struct XcdBarrier { unsigned* bar; unsigned x; volatile LAS unsigned* st; };
__device__ __forceinline__ XcdBarrier xcd_barrier_post(unsigned* bar, volatile LAS unsigned* st, int wv_) {
  XcdBarrier b; b.bar = bar; b.x = xb_xcc_id(); b.st = st;
  if (opaque_tid(wv_) == 0) (void)xb_add(&bar[XB_XCNT(b.x)], 1u);
  return b;
}
__device__ __forceinline__ void xcd_barrier_complete(unsigned* bar, unsigned x, unsigned& nloc, unsigned& nx) {
  const unsigned G = gridDim.x * gridDim.y * gridDim.z;
  unsigned sum, cnt, mine, sp = 0u;
  for (;;) {
    sum = 0u; cnt = 0u; mine = 0u;
#pragma unroll
    for (unsigned j = 0; j < 16; ++j) { const unsigned c = xb_ld(&bar[XB_XCNT(j)]); sum += c; cnt += (c > 0u) ? 1u : 0u; mine = (j == x) ? c : mine; }
    if (sum == G) break;
    __builtin_amdgcn_s_sleep(1);
    if ((++sp & 255u) == 0u) { if (xb_ld(&bar[XB_TMO])) break; if (sp > XB_SPIN_CAP) { atomicAdd(&bar[XB_TMO], 1u); break; } }
  }
  nloc = mine > 0u ? mine : 1u; nx = cnt > 0u ? cnt : 1u;
}
__device__ __forceinline__ void xcd_barrier(const XcdBarrier& b, int wv_) {
  asm volatile("s_waitcnt vmcnt(0)" ::: "memory");
  __syncthreads();
  if (opaque_tid(wv_) == 0) {
    unsigned* bar = b.bar;
    __builtin_amdgcn_s_waitcnt(0);
    unsigned bx = b.x; asm volatile("" : "+s"(bx));
    unsigned nloc = b.st[0], nx = b.st[1];
    if (nloc == 0u) { xcd_barrier_complete(bar, bx, nloc, nx); b.st[0] = nloc; b.st[1] = nx; }
    const unsigned old = xb_add(&bar[XB_XSUB(bx)], 1u);
    const unsigned gen = old / nloc;
    if (old + 1u == (gen + 1u) * nloc) {
      __builtin_amdgcn_fence(__ATOMIC_RELEASE, "agent");
      asm volatile("s_waitcnt vmcnt(0)" ::: "memory");
      const unsigned og = xb_add(&bar[XB_TOP], 1u);
      const unsigned tg = og / nx;
      if (og + 1u == (tg + 1u) * nx) xb_add(&bar[XB_TOPGEN], 1u);
      else XB_SPIN(xb_ld(&bar[XB_TOPGEN]) == tg, bar);
      __builtin_amdgcn_fence(__ATOMIC_ACQUIRE, "agent");
      xb_add(&bar[XB_XGEN(bx)], 1u);
      asm volatile("s_waitcnt vmcnt(0)" ::: "memory");
    } else {
      XB_SPIN(xb_ld(&bar[XB_XGEN(bx)]) == gen, bar);
      __builtin_amdgcn_fence(__ATOMIC_ACQUIRE, "agent");
      asm volatile("s_waitcnt vmcnt(0)" ::: "memory");
    }
  }
  __syncthreads();
}

#define G_STAGE 73728
#define G_BOFF 36864
template <int EPI>
__device__ __forceinline__ void gemm_tile(const bf16_t* __restrict__ A, int lda, int ao0, int ao1, int ao2, int ao3,
                                          const bf16_t* __restrict__ Bt, int m0, int n0, int N,
                                          void* out, const float* resid, int ldc, unsigned char* lds, int wv_) {
#ifdef OFF_gemm_tile
  return;
#endif

  const int tid = opaque_tid(wv_), lane = tid & 63, w = tid >> 6;
  const int wm = w >> 2, wn = w & 3, lr = lane & 31, lh = lane >> 5;
  f32x16 acc[4][2];
#pragma unroll
  for (int i = 0; i < 4; ++i)
#pragma unroll
    for (int j = 0; j < 2; ++j)
#pragma unroll
      for (int r = 0; r < 16; ++r) acc[i][j][r] = 0.f;
  uint4 ra[4], rb[4];
  const int crow = tid >> 3, ccol = (tid & 7) * 8;
  const bf16_t* Ap = A + (size_t)(m0 + crow) * lda + ccol;
  const bf16_t* Bp = Bt + (size_t)(n0 + crow) * 1024 + ccol;
#define G_LOAD(kt) { const int k0_ = (kt) * 64; const int seg_ = k0_ >> 8; const int ao_ = (seg_ == 0 ? ao0 : seg_ == 1 ? ao1 : seg_ == 2 ? ao2 : ao3) + (k0_ & 255); \
    _Pragma("unroll") for (int i_ = 0; i_ < 4; ++i_) { ra[i_] = *(const uint4*)(Ap + (size_t)(i_ * 64) * lda + ao_); rb[i_] = *(const uint4*)(Bp + (size_t)(i_ * 64) * 1024 + k0_); } }
#define G_WRITE(buf) { unsigned char* b_ = lds + (buf) * G_STAGE + crow * 144 + (tid & 7) * 16; \
    _Pragma("unroll") for (int i_ = 0; i_ < 4; ++i_) { *(uint4*)(b_ + i_ * 64 * 144) = ra[i_]; *(uint4*)(b_ + G_BOFF + i_ * 64 * 144) = rb[i_]; } }
  G_LOAD(0); G_WRITE(0); __syncthreads();
  for (int kt = 0; kt < 16; ++kt) {
    if (kt < 15) G_LOAD(kt + 1);
    const unsigned char* base = lds + (kt & 1) * G_STAGE;
    const unsigned char* ab = base + (wm * 128 + lr) * 144 + lh * 16;
    const unsigned char* bb = base + G_BOFF + (wn * 64 + lr) * 144 + lh * 16;
#pragma unroll
    for (int s = 0; s < 4; ++s) {
      bf16x8 a[4], b[2];
#pragma unroll
      for (int i = 0; i < 4; ++i) a[i] = *(const bf16x8*)(ab + i * 32 * 144 + s * 32);
#pragma unroll
      for (int j = 0; j < 2; ++j) b[j] = *(const bf16x8*)(bb + j * 32 * 144 + s * 32);
#pragma unroll
      for (int i = 0; i < 4; ++i)
#pragma unroll
        for (int j = 0; j < 2; ++j) acc[i][j] = __builtin_amdgcn_mfma_f32_32x32x16_bf16(a[i], b[j], acc[i][j], 0, 0, 0);
    }
    if (kt < 15) G_WRITE((kt + 1) & 1);
    __syncthreads();
  }
#undef G_LOAD
#undef G_WRITE
#pragma unroll
  for (int i = 0; i < 4; ++i)
#pragma unroll
    for (int j = 0; j < 2; ++j) {
      const int col = n0 + wn * 64 + j * 32 + lr;
#pragma unroll
      for (int r = 0; r < 16; ++r) {
        const int row = m0 + wm * 128 + i * 32 + (r & 3) + 8 * (r >> 2) + 4 * lh;
        if (EPI == 0) { if (col < N) ((bf16_t*)out)[(size_t)row * ldc + col] = f2bf(acc[i][j][r]); }
        else if (EPI == 2) { if (col < 1024) ((bf16_t*)out)[(size_t)row * ldc + col] = f2bf(acc[i][j][r]);
                             else ((bf16_t*)resid)[((size_t)((row >> 8) * 1024 + (col - 1024))) * 256 + (row & 255)] = f2bf(acc[i][j][r]); }
        else { ((float*)out)[(size_t)row * ldc + col] = resid[(size_t)row * ldc + col] + acc[i][j][r]; }
      }
    }
}

__device__ __forceinline__ void tile_map(int t, int nN, int& mi, int& ni) {
  const int rnd = t >> 8, blk = t & 255, x = blk & 7, y = blk >> 3;
  if (nN == 16) { mi = rnd * 16 + (x >> 1) * 4 + (y & 3); ni = (x & 1) * 8 + (y >> 2); }
  else { mi = rnd * 64 + x * 8 + (y & 7); ni = y >> 3; }
}

namespace pg8 {
#define PG8_LAS __attribute__((address_space(3)))
typedef unsigned u32x4 __attribute__((ext_vector_type(4)));
constexpr int BM = 256, BK = 64, HALF = 128, HTB = HALF * BK * 2  , STAGE_BYTES = 8 * HTB, NXCD = 8, WGM = 8;

__host__ __device__ __forceinline__ int lds_byte(int r, int c) { const int st = (r >> 4) * 2 + (c >> 5), rr = r & 15, cc = c & 31, ob = rr * 64 + cc * 2; return st * 1024 + (ob ^ (((ob >> 9) & 1) << 5)); }
__host__ __device__ __forceinline__ void stage_rc(int b, int& R, int& C) { const int st = b / 1024, sb = b % 1024, swz = sb ^ (((sb >> 9) & 1) << 5); R = (st >> 1) * 16 + swz / 64; C = (st & 1) * 32 + (swz % 64) / 2; }
__host__ __device__ __forceinline__ int perm32(int rho) { const int n = rho >> 4, i = rho & 15; return 8 * (i >> 2) + 4 * n + (i & 3); }

struct Unit { int pm, pn; };
struct Gemm { const bf16_t* A; const bf16_t* Bt; int M, N, K; int lda; int ao0, ao1, ao2, ao3; };

struct TileSched {
    int nt, G, c, nN;
    __device__ __forceinline__ bool next(int i, Unit& u) const { const int t = i * G + c; if (t >= nt) return false; tile_map(t, nN, u.pm, u.pn); return true; }
    __device__ __forceinline__ void a_ready(const Unit&) const {}
    __device__ __forceinline__ void done(const Unit&) const {}
};
__device__ __forceinline__ unsigned cvt_pk_bf16(float lo, float hi) { unsigned r; asm volatile("v_cvt_pk_bf16_f32 %0, %1, %2" : "=v"(r) : "v"(lo), "v"(hi)); return r; }
struct EpiStoreBf16 {
    static constexpr bool PERM = true, AFTER_DRAIN = false;
    bf16_t* O; int ldc; int N;
    __device__ __forceinline__ void operator()(const f32x4 (&acc)[2][2][4][2], const Unit& u, int wr, int wc, int fr, int fq) const {
        const int row0 = u.pm * BM + wr * 64 + fr, col0 = u.pn * BM + wc * 32 + 8 * fq;
#pragma unroll
        for (int ai = 0; ai < 2; ++ai)
#pragma unroll
            for (int m = 0; m < 4; ++m) { bf16_t* rowp = O + (size_t)(row0 + ai * HALF + m * 16) * ldc + col0;
#pragma unroll
                for (int bj = 0; bj < 2; ++bj) { if (col0 + bj * HALF < N) { const f32x4 v0 = acc[ai][bj][m][0], v1 = acc[ai][bj][m][1];
                    u32x4 w; w.x = cvt_pk_bf16(v0[0], v0[1]); w.y = cvt_pk_bf16(v0[2], v0[3]); w.z = cvt_pk_bf16(v1[0], v1[1]); w.w = cvt_pk_bf16(v1[2], v1[3]);
                    *(u32x4*)(rowp + bj * HALF) = w; } } }
    }
};
struct EpiDyn {
    static constexpr bool PERM = true, AFTER_DRAIN = false;
    int mode; bf16_t* O; int ldc; int N; const float* resid; float* out; const float* ssq_in; bf16_t* xb; float* ssq_out;
    __device__ __forceinline__ void operator()(const f32x4 (&acc)[2][2][4][2], const Unit& u, int wr, int wc, int fr, int fq) const {
        const int row0 = u.pm * BM + wr * 64 + fr, col0 = u.pn * BM + wc * 32 + 8 * fq;
        if (mode == 0) {
#pragma unroll
            for (int ai = 0; ai < 2; ++ai)
#pragma unroll
                for (int m = 0; m < 4; ++m) { const int row = row0 + ai * HALF + m * 16; bf16_t* rowp = O + (size_t)row * ldc + col0;
                    const float sc = __builtin_amdgcn_rsqf(ssq_in[row] * (1.0f / 1024.0f) + 1e-6f);
#pragma unroll
                    for (int bj = 0; bj < 2; ++bj) { if (col0 + bj * HALF < N) { const f32x4 v0 = acc[ai][bj][m][0] * sc, v1 = acc[ai][bj][m][1] * sc;
                        u32x4 w; w.x = cvt_pk_bf16(v0[0], v0[1]); w.y = cvt_pk_bf16(v0[2], v0[3]); w.z = cvt_pk_bf16(v1[0], v1[1]); w.w = cvt_pk_bf16(v1[2], v1[3]);
                        *(u32x4*)(rowp + bj * HALF) = w; } } }
        } else {
            const int lane_ = fq * 16 + fr;
#pragma unroll
            for (int ai = 0; ai < 2; ++ai)
#pragma unroll
                for (int m = 0; m < 4; ++m) { const int row = row0 + ai * HALF + m * 16; const size_t off = (size_t)row * ldc + col0; float s = 0.f;
#pragma unroll
                    for (int bj = 0; bj < 2; ++bj) { const u32x4 rv = *(const u32x4*)(xb + off + bj * HALF);
                        const f32x4 r0 = {__uint_as_float(rv.x << 16), __uint_as_float(rv.x & 0xffff0000u), __uint_as_float(rv.y << 16), __uint_as_float(rv.y & 0xffff0000u)};
                        const f32x4 r1 = {__uint_as_float(rv.z << 16), __uint_as_float(rv.z & 0xffff0000u), __uint_as_float(rv.w << 16), __uint_as_float(rv.w & 0xffff0000u)};
                        const f32x4 x0 = r0 + acc[ai][bj][m][0], x1 = r1 + acc[ai][bj][m][1];
                        u32x4 w; w.x = cvt_pk_bf16(x0[0], x0[1]); w.y = cvt_pk_bf16(x0[2], x0[3]); w.z = cvt_pk_bf16(x1[0], x1[1]); w.w = cvt_pk_bf16(x1[2], x1[3]);
                        *(u32x4*)(xb + off + bj * HALF) = w;
                        s += (x0[0] * x0[0] + x0[1] * x0[1]) + (x0[2] * x0[2] + x0[3] * x0[3]) + (x1[0] * x1[0] + x1[1] * x1[1]) + (x1[2] * x1[2] + x1[3] * x1[3]); }
                    s += bperm(s, lane_ ^ 16); s += bperm(s, lane_ ^ 32);
                    if (fq == 0) __hip_atomic_fetch_add(ssq_out + row, s, __ATOMIC_RELAXED, __HIP_MEMORY_SCOPE_AGENT); }
        }
    }
};
struct EpiResid {
    static constexpr bool PERM = true, AFTER_DRAIN = false;
    const float* resid; float* out; int ldc;
    __device__ __forceinline__ void operator()(const f32x4 (&acc)[2][2][4][2], const Unit& u, int wr, int wc, int fr, int fq) const {
        const int row0 = u.pm * BM + wr * 64 + fr, col0 = u.pn * BM + wc * 32 + 8 * fq;
#pragma unroll
        for (int ai = 0; ai < 2; ++ai)
#pragma unroll
            for (int m = 0; m < 4; ++m) { const size_t off = (size_t)(row0 + ai * HALF + m * 16) * ldc + col0;
#pragma unroll
                for (int bj = 0; bj < 2; ++bj) { const f32x4 r0 = *(const f32x4*)(resid + off + bj * HALF), r1 = *(const f32x4*)(resid + off + bj * HALF + 4);
                    *(f32x4*)(out + off + bj * HALF) = r0 + acc[ai][bj][m][0]; *(f32x4*)(out + off + bj * HALF + 4) = r1 + acc[ai][bj][m][1]; } }
    }
};

static_assert(true, "pg8 body adapted: SP2 path only is valid with lda/segment offsets");
template <class Epi, class Sched, bool ALIGN_EPI = false, bool SP2 = false>
__device__ __forceinline__ void gemm_phase(PG8_LAS unsigned char* lds, const Gemm g, const Sched& S, const Epi& E, int wv_) {
    const int tid = opaque_tid(wv_), wid = __builtin_amdgcn_readfirstlane(tid >> 6), lane = tid & 63, wr = wid >> 2, wc = wid & 3, fr = lane & 15, fq = lane >> 4;
    const int K = g.K, nt = K / BK;
    unsigned voffA, voffB;
    { int R, C; stage_rc(tid * 16, R, C); const int Rb = Epi::PERM ? ((R & ~31) + perm32(R & 31)) : R;
      voffA = (unsigned)(R * g.lda + C) * 2u; voffB = (unsigned)(Rb * K + C) * 2u; }
    const size_t rstepA = (size_t)64 * g.lda * 2, rstepB = (size_t)64 * K * 2;
    const size_t kstep = (size_t)(BK * 2);
    const size_t hstep = (size_t)HALF * K * 2; const size_t hstepA = (size_t)HALF * g.lda * 2, tstepA = 2 * hstepA;
#define PG8_KA(t_) ((size_t)((((t_) >> 2) == 0 ? g.ao0 : ((t_) >> 2) == 1 ? g.ao1 : ((t_) >> 2) == 2 ? g.ao2 : g.ao3) + ((t_) & 3) * 64) * 2)
    const size_t tstep = 2 * hstep;
    const unsigned ldsw = (unsigned)wid * 1024u;
    int aoff, boff;
#define PG8_SA(b, h) (((b) * 2 + (h)) * HTB)
#define PG8_SB(b, h) ((4 + (b) * 2 + (h)) * HTB)
#define PG8_STAGE(bufoff, gbase, voff) do { _Pragma("unroll") for (int _i = 0; _i < 2; ++_i) \
        __builtin_amdgcn_global_load_lds((const unsigned*)((const char*)(gbase) + (size_t)_i * r##voff + (voff)), (PG8_LAS unsigned*)(lds + (bufoff) + ldsw + _i * 8192), 16, 0, 0); } while (0)
#define rvoffA rstepA
#define rvoffB rstepB
#define PG8_LDA(dst, b, h) do { _Pragma("unroll") for (int m = 0; m < 4; ++m) _Pragma("unroll") for (int k = 0; k < 2; ++k) dst[m][k] = *(const PG8_LAS bf16x8*)(lds + (PG8_SA(b, h) + wr * 8192) + aoff + m * 2048 + k * 1024); } while (0)
#define PG8_LDB(dst, b, h) do { _Pragma("unroll") for (int n = 0; n < 2; ++n) _Pragma("unroll") for (int k = 0; k < 2; ++k) dst[n][k] = *(const PG8_LAS bf16x8*)(lds + (PG8_SB(b, h) + wc * 4096) + boff + n * 2048 + k * 1024); } while (0)
#define PG8_MMA(ai, bj, At, Bt) do { __builtin_amdgcn_s_setprio(1); _Pragma("unroll") for (int m = 0; m < 4; ++m) _Pragma("unroll") for (int n = 0; n < 2; ++n) _Pragma("unroll") for (int k = 0; k < 2; ++k) \
        acc[ai][bj][m][n] = __builtin_amdgcn_mfma_f32_16x16x32_bf16(Bt[n][k], At[m][k], acc[ai][bj][m][n], 0, 0, 0); __builtin_amdgcn_s_setprio(0); } while (0)
#define PG8_WAIT_V(n) asm volatile("s_waitcnt vmcnt(" #n ")" ::: "memory")
#define PG8_WAIT_L(n) asm volatile("s_waitcnt lgkmcnt(" #n ")" ::: "memory")
#define PG8_BAR __builtin_amdgcn_s_barrier()
#define PG8_SCHED __builtin_amdgcn_sched_barrier(0)
    Unit cur, nxt; int ui = 0;
    if (!S.next(0, cur)) return;
    f32x4 acc[2][2][4][2];
#pragma unroll
    for (int a = 0; a < 2; ++a)
#pragma unroll
        for (int b = 0; b < 2; ++b)
#pragma unroll
            for (int m = 0; m < 4; ++m)
#pragma unroll
                for (int n = 0; n < 2; ++n) acc[a][b][m][n] = (f32x4){0.f, 0.f, 0.f, 0.f};
    bf16x8 At[4][2], B0[2][2], B1[2][2];
    const char* cA = (const char*)g.A + (size_t)cur.pm * tstepA; const char* cB = (const char*)g.Bt + (size_t)cur.pn * tstep;
    S.a_ready(cur);
    if constexpr (SP2) {
        PG8_STAGE(PG8_SB(0, 0), cB, voffB); PG8_STAGE(PG8_SB(0, 1), cB + hstep, voffB); PG8_STAGE(PG8_SA(0, 0), cA + PG8_KA(0), voffA); PG8_STAGE(PG8_SA(0, 1), cA + hstepA + PG8_KA(0), voffA);
        if (wr == 1) PG8_BAR;
        PG8_WAIT_V(2); PG8_BAR;
        PG8_STAGE(PG8_SB(1, 0), cB + kstep, voffB); PG8_STAGE(PG8_SA(1, 0), cA + PG8_KA(1), voffA); PG8_STAGE(PG8_SB(1, 1), cB + hstep + kstep, voffB);
        PG8_WAIT_V(6); PG8_BAR;
    } else {
        PG8_STAGE(PG8_SB(0, 0), cB, voffB); PG8_STAGE(PG8_SA(0, 0), cA, voffA); PG8_STAGE(PG8_SB(0, 1), cB + hstep, voffB); PG8_STAGE(PG8_SA(0, 1), cA + hstep, voffA);
        if (wr == 1) PG8_BAR;
        PG8_WAIT_V(4); PG8_BAR;
        PG8_STAGE(PG8_SB(1, 0), cB + kstep, voffB); PG8_STAGE(PG8_SA(1, 0), cA + kstep, voffA); PG8_STAGE(PG8_SB(1, 1), cB + hstep + kstep, voffB);
        PG8_WAIT_V(6); PG8_BAR;
    }
    { const int t3_ = opaque_tid(wv_), l3_ = t3_ & 63, w3_ = __builtin_amdgcn_readfirstlane(t3_ >> 6); aoff = lds_byte((l3_ & 15), (l3_ >> 4) * 8); boff = aoff; }
    for (;;) {
        const bool has_next = S.next(ui + 1, nxt);
        const char* nA = has_next ? (const char*)g.A + (size_t)nxt.pm * tstepA : cA; const char* nB = has_next ? (const char*)g.Bt + (size_t)nxt.pn * tstep : cB;
        for (int t = 0; t < nt; t += 2) {
            const bool last = (t == nt - 2);
            const char* a1 = cA + PG8_KA(t + 1);
            const char* a2 = last ? nA + PG8_KA(0) : cA + PG8_KA(t + 2); const char* b2 = last ? nB : cB + (size_t)(t + 2) * kstep;
            const char* a3 = last ? nA + PG8_KA(1) : cA + PG8_KA(t + 3); const char* b3 = b2 + kstep;
            if (last && has_next) S.a_ready(nxt);
            if constexpr (SP2) {
            PG8_LDB(B0, 0, 0); PG8_LDB(B1, 0, 1); PG8_SCHED; PG8_LDA(At, 0, 0); PG8_STAGE(PG8_SA(1, 1), a1 + hstepA, voffA);
            PG8_WAIT_V(8); PG8_WAIT_L(0); PG8_BAR; PG8_MMA(0, 0, At, B0); PG8_MMA(0, 1, At, B1); PG8_BAR; PG8_SCHED;
            PG8_LDA(At, 0, 1); PG8_STAGE(PG8_SB(0, 0), b2, voffB); PG8_STAGE(PG8_SB(0, 1), b2 + hstep, voffB); PG8_STAGE(PG8_SA(0, 0), a2, voffA);
            PG8_WAIT_V(8); PG8_WAIT_L(0); PG8_BAR; PG8_MMA(1, 0, At, B0); PG8_MMA(1, 1, At, B1); PG8_BAR; PG8_SCHED;
            PG8_LDB(B0, 1, 0); PG8_LDB(B1, 1, 1); PG8_SCHED; PG8_LDA(At, 1, 0); PG8_STAGE(PG8_SA(0, 1), a2 + hstepA, voffA);
            PG8_WAIT_V(8); PG8_WAIT_L(0); PG8_BAR; PG8_MMA(0, 0, At, B0); PG8_MMA(0, 1, At, B1); PG8_BAR; PG8_SCHED;
            PG8_LDA(At, 1, 1); PG8_STAGE(PG8_SB(1, 0), b3, voffB); PG8_STAGE(PG8_SB(1, 1), b3 + hstep, voffB); PG8_STAGE(PG8_SA(1, 0), a3, voffA);
            PG8_WAIT_V(8); PG8_WAIT_L(0); PG8_BAR; PG8_MMA(1, 0, At, B0); PG8_MMA(1, 1, At, B1); PG8_BAR; PG8_SCHED;
            } else {
            PG8_LDB(B0, 0, 0); PG8_SCHED; PG8_LDA(At, 0, 0); PG8_STAGE(PG8_SA(1, 1), a1 + hstep, voffA);
            PG8_WAIT_L(8); PG8_BAR; PG8_WAIT_L(0); PG8_MMA(0, 0, At, B0); PG8_BAR; PG8_SCHED;
            PG8_LDB(B1, 0, 1); PG8_STAGE(PG8_SB(0, 0), b2, voffB);
            PG8_BAR; PG8_WAIT_L(0); PG8_MMA(0, 1, At, B1); PG8_BAR;
            PG8_LDA(At, 0, 1); PG8_STAGE(PG8_SA(0, 0), a2, voffA);
            PG8_BAR; PG8_WAIT_L(0); PG8_MMA(1, 0, At, B0); PG8_BAR; PG8_SCHED;
            PG8_STAGE(PG8_SB(0, 1), b2 + hstep, voffB);
            PG8_WAIT_V(6); PG8_BAR; PG8_MMA(1, 1, At, B1); PG8_BAR;
            PG8_LDB(B0, 1, 0); PG8_SCHED; PG8_LDA(At, 1, 0); PG8_STAGE(PG8_SA(0, 1), a2 + hstep, voffA);
            PG8_WAIT_L(8); PG8_BAR; PG8_WAIT_L(0); PG8_MMA(0, 0, At, B0); PG8_BAR; PG8_SCHED;
            PG8_LDB(B1, 1, 1); PG8_STAGE(PG8_SB(1, 0), b3, voffB);
            PG8_BAR; PG8_WAIT_L(0); PG8_MMA(0, 1, At, B1); PG8_BAR;
            PG8_LDA(At, 1, 1); PG8_STAGE(PG8_SA(1, 0), a3, voffA);
            PG8_BAR; PG8_WAIT_L(0); PG8_MMA(1, 0, At, B0); PG8_BAR; PG8_SCHED;
            PG8_STAGE(PG8_SB(1, 1), b3 + hstep, voffB);
            PG8_WAIT_V(6); PG8_BAR; PG8_MMA(1, 1, At, B1); PG8_BAR;
            }
        }
        if constexpr (ALIGN_EPI) { if (wr == 0) PG8_BAR; }
        if constexpr (!Epi::AFTER_DRAIN) { const int t2_ = opaque_tid(wv_), l2_ = t2_ & 63, w2_ = __builtin_amdgcn_readfirstlane(t2_ >> 6); E(acc, cur, w2_ >> 2, w2_ & 3, l2_ & 15, l2_ >> 4); S.done(cur); }
        if (!has_next) break;
#pragma unroll
        for (int a = 0; a < 2; ++a)
#pragma unroll
            for (int b = 0; b < 2; ++b)
#pragma unroll
                for (int m = 0; m < 4; ++m)
#pragma unroll
                    for (int n = 0; n < 2; ++n) acc[a][b][m][n] = (f32x4){0.f, 0.f, 0.f, 0.f};
        cur = nxt; cA = nA; cB = nB; ++ui;
        if constexpr (ALIGN_EPI) { if (wr == 1) PG8_BAR; }
    }
    PG8_WAIT_V(0);
    if constexpr (!ALIGN_EPI) { if (wr == 0) PG8_BAR; }
    PG8_BAR;
    if constexpr (Epi::AFTER_DRAIN) { E.fused(acc, cur, wr, wc, fr, fq, lds, wid, lane); S.done(cur); }
#undef PG8_SA
#undef PG8_SB
#undef PG8_STAGE
#undef rvoffA
#undef rvoffB
#undef PG8_LDA
#undef PG8_LDB
#undef PG8_MMA
#undef PG8_WAIT_V
#undef PG8_WAIT_L
#undef PG8_BAR
#undef PG8_SCHED
#undef PG8_KA
}
}

__device__ __forceinline__ void wt_tile(const float* __restrict__ W, int N, bf16_t* __restrict__ Wt, int kt, int nt, unsigned char* lds, int wv_, const float* gk = nullptr) {
#ifdef OFF_wt_tile
  return;
#endif

  float* tl = (float*)lds;
  const int tid = opaque_tid(wv_);
  const int r = tid >> 3, c8 = (tid & 7) * 8;
  const float* src = W + (size_t)(kt * 64 + r) * N + nt * 64 + c8;
  float4 v0 = *(const float4*)src, v1 = *(const float4*)(src + 4);
  if (gk) { const float g_ = gk[kt * 64 + r]; v0.x *= g_; v0.y *= g_; v0.z *= g_; v0.w *= g_; v1.x *= g_; v1.y *= g_; v1.z *= g_; v1.w *= g_; }
  float* d = tl + r * 65 + c8;
  d[0] = v0.x; d[1] = v0.y; d[2] = v0.z; d[3] = v0.w; d[4] = v1.x; d[5] = v1.y; d[6] = v1.z; d[7] = v1.w;
  __syncthreads();
  uint4 o;
  o.x = pack2(tl[(c8 + 0) * 65 + r], tl[(c8 + 1) * 65 + r]);
  o.y = pack2(tl[(c8 + 2) * 65 + r], tl[(c8 + 3) * 65 + r]);
  o.z = pack2(tl[(c8 + 4) * 65 + r], tl[(c8 + 5) * 65 + r]);
  o.w = pack2(tl[(c8 + 6) * 65 + r], tl[(c8 + 7) * 65 + r]);
  *(uint4*)(Wt + (size_t)(nt * 64 + r) * 1024 + kt * 64 + c8) = o;
  __syncthreads();
}

__device__ __forceinline__ void norm_rows(const bool F32OUT, const float* src, const float* __restrict__ g, void* dst, int nrows, float pd, int wv_, float* ssq_out = nullptr) {
#ifdef OFF_norm_rows
  return;
#endif

  const int tid = opaque_tid(wv_);
  const int lane = tid & 63;
  const int gw = blockIdx.x * 8 + (tid >> 6), nw = gridDim.x * 8;
  float4 gv[4];
#pragma unroll
  for (int i = 0; i < 4; ++i) gv[i] = ssq_out ? make_float4(1.f, 1.f, 1.f, 1.f) : *(const float4*)(g + i * 256 + lane * 4);
  for (int row = gw; row < nrows; row += nw) {
    const float* s = src + (size_t)row * 1024;
    float4 v[4]; float ss = 0.f;
#pragma unroll
    for (int i = 0; i < 4; ++i) { v[i] = *(const float4*)(s + i * 256 + lane * 4); ss += v[i].x * v[i].x + v[i].y * v[i].y + v[i].z * v[i].z + v[i].w * v[i].w; }
    ss = wave_sum(ss, lane);
    if (ssq_out) { if (lane == 0) ssq_out[row] = ss; }
    const float rs = ssq_out ? 1.0f : rsqrtf(ss * (1.0f / 1024.0f) + 1e-6f);
#pragma unroll
    for (int i = 0; i < 4; ++i) {
      const float a = v[i].x * rs * gv[i].x, b = v[i].y * rs * gv[i].y, c = v[i].z * rs * gv[i].z, d = v[i].w * rs * gv[i].w;
      if (F32OUT) { *(float4*)((float*)dst + (size_t)row * 1024 + i * 256 + lane * 4) = make_float4(a + pd, b + pd, c + pd, d + pd); }
      else { uint2 o; o.x = pack2(a, b); o.y = pack2(c, d); *(uint2*)((bf16_t*)dst + (size_t)row * 1024 + i * 256 + lane * 4) = o; }
    }
  }
}

__device__ __forceinline__ void rwkv_prep_item(KP P, int l, int item, int nitems, unsigned char* lds, int wv_) {
#ifdef OFF_rwkv_prep_item
  return;
#endif

  const bf16_t* p = (const bf16_t*)(P->ws + WS_P);
  float* PW = (float*)(P->ws + WS_PW); bf16_t* PV = (bf16_t*)(P->ws + WS_PV); float* RK = (float*)(P->ws + WS_RK);
  float* lora = (float*)lds;
  const int tid = opaque_tid(wv_), lane = tid & 63, w = tid >> 6, head = w & 3, sub = w >> 2;
  const int c = head * 64 + lane;
  const float* mu = P->in[4] + l * 832;
  const float mur = mu[c], muk = mu[256 + c], muv = mu[512 + c], mux = mu[768 + lane];
  const float w0 = P->in[5][l * 256 + c], a0 = P->in[7][l * 256 + c];
  const float kkw = P->in[9][l * 256 + c], kaw = P->in[10][l * 256 + c], rkw = P->in[11][l * 256 + c];
  float wup[32], aup[32];
#pragma unroll
  for (int j = 0; j < 32; ++j) { wup[j] = P->in[6][(l * 32 + j) * 256 + c]; aup[j] = P->in[8][(l * 32 + j) * 256 + c]; }
  bf16_t raw[4][8];
#define PREP_LOAD(g) { _Pragma("unroll") for (int j_ = 0; j_ < 4; ++j_) { const int t_ = item * 16 + sub + 2 * ((g) * 4 + j_); const bool hp_ = (t_ & (TSEQ - 1)) > 0; \
      const bf16_t* pr_ = p + (size_t)t_ * NIN; raw[j_][0] = pr_[c]; raw[j_][1] = pr_[256 + c]; raw[j_][2] = pr_[512 + c]; raw[j_][3] = pr_[768 + lane]; \
      raw[j_][4] = hp_ ? pr_[c - NIN] : (bf16_t)0; raw[j_][5] = hp_ ? pr_[256 + c - NIN] : (bf16_t)0; raw[j_][6] = hp_ ? pr_[512 + c - NIN] : (bf16_t)0; raw[j_][7] = hp_ ? pr_[768 + lane - NIN] : (bf16_t)0; } }
  PREP_LOAD(0);
  int ng_ = 2 * nitems; asm volatile("" : "+s"(ng_));
#pragma unroll 1
  for (int g = 0; g < ng_; ++g) {
    float rr[4], kk4[4], vv4[4];
#pragma unroll
    for (int j = 0; j < 4; ++j) {
      float r = bf2f(raw[j][0]), k = bf2f(raw[j][1]), v = bf2f(raw[j][2]), x = bf2f(raw[j][3]);
      r += (bf2f(raw[j][4]) - r) * mur; k += (bf2f(raw[j][5]) - k) * muk; v += (bf2f(raw[j][6]) - v) * muv; x += (bf2f(raw[j][7]) - x) * mux;
      rr[j] = r; kk4[j] = k; vv4[j] = v;
      lora[(w * 4 + j) * 64 + lane] = lane < 32 ? (1.0f - 2.0f * __builtin_amdgcn_rcpf(1.0f + __expf(2.0f * x))) : x;
    }
    if (g + 1 < ng_) PREP_LOAD(g + 1);
    __builtin_amdgcn_s_waitcnt(0xc07f);
    __builtin_amdgcn_wave_barrier();
    float wv4[4], av4[4];
#pragma unroll
    for (int j = 0; j < 4; ++j) { wv4[j] = w0; av4[j] = a0; }
#pragma unroll
    for (int jj = 0; jj < 32; jj += 4) {
#pragma unroll
      for (int j = 0; j < 4; ++j) { const float* lo = lora + (w * 4 + j) * 64; const float4 lw = *(const float4*)(lo + jj), la = *(const float4*)(lo + 32 + jj);
        wv4[j] += lw.x * wup[jj]; wv4[j] += lw.y * wup[jj + 1]; wv4[j] += lw.z * wup[jj + 2]; wv4[j] += lw.w * wup[jj + 3];
        av4[j] += la.x * aup[jj]; av4[j] += la.y * aup[jj + 1]; av4[j] += la.z * aup[jj + 2]; av4[j] += la.w * aup[jj + 3]; }
    }
    float dec4[4], ar4[4], kkq[4], kmod4[4], n24[4], rk4[4];
#pragma unroll
    for (int j = 0; j < 4; ++j) {
      const float wlog = -softplus_fast(-wv4[j]) - 0.5f;
      dec4[j] = __expf(-__expf(wlog));
      ar4[j] = sigmoidf_(av4[j]);
      kkq[j] = kk4[j] * kkw;
      kmod4[j] = kk4[j] * (1.0f + (ar4[j] - 1.0f) * kaw);
      n24[j] = kkq[j] * kkq[j]; rk4[j] = rr[j] * kmod4[j] * rkw;
    }
#pragma unroll
    for (int st = 0; st < 4; ++st) {
      const int ctrl = st == 0 ? 0xB1 : st == 1 ? 0x4E : st == 2 ? 0x141 : 0x140;
#pragma unroll
      for (int j = 0; j < 4; ++j) {
        if (st == 0) { n24[j] += __builtin_bit_cast(float, __builtin_amdgcn_update_dpp(0, __builtin_bit_cast(int, n24[j]), 0xB1, 0xF, 0xF, true)); rk4[j] += __builtin_bit_cast(float, __builtin_amdgcn_update_dpp(0, __builtin_bit_cast(int, rk4[j]), 0xB1, 0xF, 0xF, true)); }
        else if (st == 1) { n24[j] += __builtin_bit_cast(float, __builtin_amdgcn_update_dpp(0, __builtin_bit_cast(int, n24[j]), 0x4E, 0xF, 0xF, true)); rk4[j] += __builtin_bit_cast(float, __builtin_amdgcn_update_dpp(0, __builtin_bit_cast(int, rk4[j]), 0x4E, 0xF, 0xF, true)); }
        else if (st == 2) { n24[j] += __builtin_bit_cast(float, __builtin_amdgcn_update_dpp(0, __builtin_bit_cast(int, n24[j]), 0x141, 0xF, 0xF, true)); rk4[j] += __builtin_bit_cast(float, __builtin_amdgcn_update_dpp(0, __builtin_bit_cast(int, rk4[j]), 0x141, 0xF, 0xF, true)); }
        else { n24[j] += __builtin_bit_cast(float, __builtin_amdgcn_update_dpp(0, __builtin_bit_cast(int, n24[j]), 0x140, 0xF, 0xF, true)); rk4[j] += __builtin_bit_cast(float, __builtin_amdgcn_update_dpp(0, __builtin_bit_cast(int, rk4[j]), 0x140, 0xF, 0xF, true)); }
      }
      (void)ctrl;
    }
    { float t0[4], t1[4];
#pragma unroll
      for (int j = 0; j < 4; ++j) { t0[j] = bperm(n24[j], lane ^ 16); t1[j] = bperm(rk4[j], lane ^ 16); }
#pragma unroll
      for (int j = 0; j < 4; ++j) { n24[j] += t0[j]; rk4[j] += t1[j]; }
#pragma unroll
      for (int j = 0; j < 4; ++j) { t0[j] = bperm(n24[j], lane ^ 32); t1[j] = bperm(rk4[j], lane ^ 32); }
#pragma unroll
      for (int j = 0; j < 4; ++j) { n24[j] += t0[j]; rk4[j] += t1[j]; } }
#pragma unroll
    for (int j = 0; j < 4; ++j) {
      const int t = item * 16 + sub + 2 * (g * 4 + j);
      const int tt = t & (TSEQ - 1), b = t >> 13;
      const float kkn = kkq[j] * __builtin_amdgcn_rsqf(fmaxf(n24[j], 1e-24f));
      const size_t idx = (size_t)(b * 4 + head) * TSEQ + tt;
      PW[idx * 64 + lane] = dec4[j];
      bf16_t* pv = PV + idx * 320;
      pv[lane] = f2bf(rr[j]); pv[64 + lane] = f2bf(kmod4[j]); pv[128 + lane] = f2bf(vv4[j]); pv[192 + lane] = f2bf(-kkn); pv[256 + lane] = f2bf(kkn * ar4[j]);
      if (lane == 0) RK[idx] = rk4[j];
    }
    __builtin_amdgcn_s_waitcnt(0xc07f);
    __builtin_amdgcn_wave_barrier();
  }
#undef PREP_LOAD
  __syncthreads();
}

#define RW_TILE_B (RW_TT * 1536)
struct RwRegs { float4 pw; uint4 pv0, pv1; };
__device__ __forceinline__ void rw_issue(const float* __restrict__ PW, const bf16_t* __restrict__ PV, size_t idx0, int tid, RwRegs& r) {
  if (tid < RW_TT * 16) { const int s = tid >> 4, q = tid & 15; r.pw = *(const float4*)(PW + (idx0 + s) * 64 + q * 4); }
  { const int c = tid; const int s = c / 40, q = c % 40; r.pv0 = *(const uint4*)(PV + (idx0 + s) * 320 + q * 8); }
  if (tid < RW_TT * 40 - NTHR) { const int c = tid + NTHR; const int s = c / 40, q = c % 40; r.pv1 = *(const uint4*)(PV + (idx0 + s) * 320 + q * 8); }
}
__device__ __forceinline__ void rw_put(float* dst, int c, const uint4 u) {
  const int s = c / 40, q = c % 40;
  const int vec = q >> 3, off = (q & 7) * 8;
  const int slot = vec == 0 ? 4 : vec == 1 ? 3 : vec == 2 ? 5 : vec == 3 ? 1 : 2;
  float* d = dst + s * 384 + slot * 64 + off;
  *(float4*)d = make_float4(__uint_as_float(u.x << 16), __uint_as_float(u.x & 0xffff0000u), __uint_as_float(u.y << 16), __uint_as_float(u.y & 0xffff0000u));
  *(float4*)(d + 4) = make_float4(__uint_as_float(u.z << 16), __uint_as_float(u.z & 0xffff0000u), __uint_as_float(u.w << 16), __uint_as_float(u.w & 0xffff0000u));
}
__device__ __forceinline__ void rw_commit(unsigned char* dstb, int tid, const RwRegs& r) {
  float* dst = (float*)dstb;
  if (tid < RW_TT * 16) { const int s = tid >> 4, q = tid & 15; *(float4*)(dst + s * 384 + q * 4) = r.pw; }
  rw_put(dst, tid, r.pv0);
  if (tid < RW_TT * 40 - NTHR) rw_put(dst, tid + NTHR, r.pv1);
}

#define LD8(dst, ptr) { const float4 x0_ = *(const float4*)(ptr), x1_ = *(const float4*)((ptr) + 4); dst[0] = (f32x2){x0_.x, x0_.y}; dst[1] = (f32x2){x0_.z, x0_.w}; dst[2] = (f32x2){x1_.x, x1_.y}; dst[3] = (f32x2){x1_.z, x1_.w}; }
struct RwOps { f32x2 w[4], a[4], b[4], k[4], r[4]; float vA, vB; };
template <int MODE>
__device__ __forceinline__ void rw_ldops(RwOps& o, const float* tb, int s, int q, int rowA, int rowB) {
  const float* sp = tb + s * 384 + q * 8;
  LD8(o.w, sp); LD8(o.a, sp + 64); LD8(o.b, sp + 128); LD8(o.k, sp + 192);
  o.vA = tb[s * 384 + 320 + rowA];
  if (MODE == 0) { LD8(o.r, sp + 256); o.vB = tb[s * 384 + 320 + rowB]; }
}
template <int MODE>
__device__ __forceinline__ void rw_step(const RwOps& o, f32x2 (&SA)[4], f32x2 (&SB)[4], float* yb, int s, int q, int rowA, int rowB) {
  f32x2 dA = SA[0] * o.a[0], dB = SB[0] * o.a[0];
#pragma unroll
  for (int e = 1; e < 4; ++e) { dA = SA[e] * o.a[e] + dA; dB = SB[e] * o.a[e] + dB; }
  const float dotA = red8(dA.x + dA.y), dotB = red8(dB.x + dB.y);
  const f32x2 dA2 = {dotA, dotA}, dB2 = {dotB, dotB}, vA2 = {o.vA, o.vA};
  if (MODE == 0) {
    const f32x2 vB2 = {o.vB, o.vB};
#pragma unroll
    for (int e = 0; e < 4; ++e) { SA[e] = SA[e] * o.w[e] + vA2 * o.k[e]; SA[e] = dA2 * o.b[e] + SA[e]; SB[e] = SB[e] * o.w[e] + vB2 * o.k[e]; SB[e] = dB2 * o.b[e] + SB[e]; }
    f32x2 yA = SA[0] * o.r[0], yB = SB[0] * o.r[0];
#pragma unroll
    for (int e = 1; e < 4; ++e) { yA = SA[e] * o.r[e] + yA; yB = SB[e] * o.r[e] + yB; }
    const float ya = red8(yA.x + yA.y), ybv = red8(yB.x + yB.y);
    if (q == 0) { yb[s * 64 + rowA] = ya; yb[s * 64 + rowB] = ybv; }
  } else {
#pragma unroll
    for (int e = 0; e < 4; ++e) { SA[e] = dA2 * o.b[e] + SA[e] * o.w[e]; SB[e] = SB[e] * o.w[e] + vA2 * o.k[e]; SB[e] = dB2 * o.b[e] + SB[e]; }
  }
}
template <int MODE>
__device__ __forceinline__ void rwkv_scan_item(KP P, int l, int bh, int chunk, unsigned char* lds, int wv_) {
  const float* PW = (const float*)(P->ws + WS_PW); const bf16_t* PV = (const bf16_t*)(P->ws + WS_PV); const float* RK = (const float*)(P->ws + WS_RK);
  float* PQ = (float*)(P->ws + WS_PQ);
  bf16_t* p = (bf16_t*)(P->ws + WS_P);
  const int tid = opaque_tid(wv_), lane = tid & 63, w = tid >> 6;
  const int q = lane & 7;
  const int rowA = (MODE == 0) ? ((w & 3) * 16 + (lane >> 3)) : (w * 8 + (lane >> 3));
  const int rowB = rowA + 8;
  const int b = bh >> 2, head = bh & 3;
  unsigned char* tile0 = lds;
  float* ybuf = (float*)(lds + 3 * RW_TILE_B);
  float* Sl = (float*)(lds + 3 * RW_TILE_B + 2 * RW_TT * 256);
  f32x2 SA[4], SB[4];
#pragma unroll
  for (int e = 0; e < 4; ++e) { SA[e] = (f32x2){0.f, 0.f}; SB[e] = (f32x2){0.f, 0.f}; }
  if (MODE == 1) {
#pragma unroll
    for (int e = 0; e < 4; ++e) SA[e] = (f32x2){(q * 8 + 2 * e == rowA) ? 1.f : 0.f, (q * 8 + 2 * e + 1 == rowA) ? 1.f : 0.f};
  }
  if (MODE == 0 && chunk > 0) {
    const float* Q0 = PQ + ((size_t)(bh * RW_C + 0) * 2 + 1) * 4096;
    float* cur = Sl; float* nxt = Sl + 64 * 65;
    for (int i = tid; i < 1024; i += NTHR) { const float4 v_ = *(const float4*)(Q0 + i * 4); float* d_ = cur + (i >> 4) * 65 + (i & 15) * 4; d_[0] = v_.x; d_[1] = v_.y; d_[2] = v_.z; d_[3] = v_.w; }
    float* Pl = (float*)lds;
    const float4 z4_ = make_float4(0.f, 0.f, 0.f, 0.f); const f32x4 zq_ = {0.f, 0.f, 0.f, 0.f};
    float4 cs0p0 = z4_, cs0p1 = z4_, cs1p0 = z4_, cs1p1 = z4_, cs2p0 = z4_, cs2p1 = z4_, cs3p0 = z4_, cs3p1 = z4_;
    f32x4 cs0q0 = zq_, cs0q1 = zq_, cs1q0 = zq_, cs1q1 = zq_, cs2q0 = zq_, cs2q1 = zq_, cs3q0 = zq_, cs3q1 = zq_;
    const int ti = w >> 1;
    const int qoff0 = 4096 + (ti * 16 + (lane >> 4) * 4) * 64 + ((w & 1) * 2 + 0) * 16 + (lane & 15);
#define CS_LOAD(S_, c_) { const float* Pm_ = PQ + ((size_t)(bh * RW_C + (c_)) * 2 + 0) * 4096; S_##p0 = *(const float4*)(Pm_ + tid * 4); S_##p1 = *(const float4*)(Pm_ + (tid + NTHR) * 4); \
      S_##q0 = (f32x4){Pm_[qoff0], Pm_[qoff0 + 64], Pm_[qoff0 + 128], Pm_[qoff0 + 192]}; S_##q1 = (f32x4){Pm_[qoff0 + 16], Pm_[qoff0 + 80], Pm_[qoff0 + 144], Pm_[qoff0 + 208]}; }
#define CS_STEP(S_, c_) { LBAR(); *(float4*)(Pl + (tid >> 4) * 80 + (tid & 15) * 4) = S_##p0; *(float4*)(Pl + ((tid + NTHR) >> 4) * 80 + (tid & 15) * 4) = S_##p1; const f32x4 qc0 = S_##q0, qc1 = S_##q1; \
      if ((c_) + 4 < chunk) CS_LOAD(S_, (c_) + 4); \
      LBAR(); \
      _Pragma("unroll") for (int jj = 0; jj < 2; ++jj) { const int tj = (w & 1) * 2 + jj; f32x4 acc = jj == 0 ? qc0 : qc1; \
        _Pragma("unroll") for (int ks = 0; ks < 16; ++ks) { const float a = cur[(ti * 16 + (lane & 15)) * 65 + ks * 4 + (lane >> 4)]; const float bb = Pl[(ks * 4 + (lane >> 4)) * 80 + tj * 16 + (lane & 15)]; \
          acc = __builtin_amdgcn_mfma_f32_16x16x4f32(a, bb, acc, 0, 0, 0); } \
        _Pragma("unroll") for (int r = 0; r < 4; ++r) nxt[(ti * 16 + (lane >> 4) * 4 + r) * 65 + tj * 16 + (lane & 15)] = acc[r]; } \
      float* t_ = cur; cur = nxt; nxt = t_; }
    if (1 < chunk) CS_LOAD(cs0, 1);
    if (2 < chunk) CS_LOAD(cs1, 2);
    if (3 < chunk) CS_LOAD(cs2, 3);
    if (4 < chunk) CS_LOAD(cs3, 4);
#pragma unroll 1
    for (int cc = 1; cc < chunk; cc += 4) {
      CS_STEP(cs0, cc);
      if (cc + 1 < chunk) CS_STEP(cs1, cc + 1);
      if (cc + 2 < chunk) CS_STEP(cs2, cc + 2);
      if (cc + 3 < chunk) CS_STEP(cs3, cc + 3);
    }
#undef CS_LOAD
#undef CS_STEP
    __syncthreads();
#pragma unroll
    for (int e = 0; e < 4; ++e) { SA[e] = (f32x2){cur[rowA * 65 + q * 8 + 2 * e], cur[rowA * 65 + q * 8 + 2 * e + 1]}; SB[e] = (f32x2){cur[rowB * 65 + q * 8 + 2 * e], cur[rowB * 65 + q * 8 + 2 * e + 1]}; }
    __syncthreads();
  }
  const size_t idxb = (size_t)bh * TSEQ + (size_t)chunk * RW_CL;
  const int ntile = RW_CL / RW_TT;
  RwRegs rr;
  rw_issue(PW, PV, idxb, tid, rr);
  rw_commit(tile0, tid, rr);
  const int chh = head * 64 + lane;
  const float lng = P->in[12][l * 256 + chh], lnb = P->in[13][l * 256 + chh];
  __syncthreads();
  const int nit = (MODE == 0) ? ntile + 1 : ntile;
  for (int tl = 0; tl < nit; ++tl) {
    if (tl + 1 < ntile) rw_issue(PW, PV, idxb + (size_t)(tl + 1) * RW_TT, tid, rr);
    if (MODE == 1 || w < 4) {
      if (tl < ntile) {
        const float* tb = (const float*)(tile0 + (tl % 3) * RW_TILE_B);
        float* yb = ybuf + (tl & 1) * (RW_TT * 64);
        RwOps oa, ob;
        rw_ldops<MODE>(oa, tb, 0, q, rowA, rowB);
        __builtin_amdgcn_sched_barrier(0);
#pragma unroll 1
        for (int s = 0; s < RW_TT; s += 2) {
          rw_ldops<MODE>(ob, tb, s + 1, q, rowA, rowB);
          __builtin_amdgcn_sched_barrier(0);
          rw_step<MODE>(oa, SA, SB, yb, s, q, rowA, rowB);
          __builtin_amdgcn_sched_barrier(0);
          if (s + 2 < RW_TT) rw_ldops<MODE>(oa, tb, s + 2, q, rowA, rowB);
          __builtin_amdgcn_sched_barrier(0);
          rw_step<MODE>(ob, SA, SB, yb, s + 1, q, rowA, rowB);
          __builtin_amdgcn_sched_barrier(0);
        }
      }
      if (tl + 1 < ntile) rw_commit(tile0 + ((tl + 1) % 3) * RW_TILE_B, tid, rr);
    } else {
      const int fw = w - 4;
      f32x4 gcu = {0.f, 0.f, 0.f, 0.f}, rkcu = {0.f, 0.f, 0.f, 0.f};
      if (tl > 0) {
#pragma unroll
        for (int u = 0; u < 4; ++u) { const int tt = chunk * RW_CL + (tl - 1) * RW_TT + fw + 4 * u;
          gcu[u] = bf2f(p[(size_t)(b * TSEQ + tt) * NIN + C_GA + chh]); rkcu[u] = RK[(size_t)bh * TSEQ + tt]; }
      }
      asm volatile("s_waitcnt vmcnt(0)" ::: "memory");
      if (tl + 1 < ntile) rw_commit(tile0 + ((tl + 1) % 3) * RW_TILE_B, tid, rr);
      __builtin_amdgcn_sched_barrier(0);
      if (tl > 0) {
        const float* tb = (const float*)(tile0 + ((tl - 1) % 3) * RW_TILE_B);
        const float* yb = ybuf + ((tl - 1) & 1) * (RW_TT * 64);
#pragma unroll
        for (int u = 0; u < 4; ++u) {
          const int s = fw + 4 * u;
          const int tt = chunk * RW_CL + (tl - 1) * RW_TT + s;
          const float y = yb[s * 64 + lane];
          const float mean = wave_sum(y, lane) * (1.0f / 64.0f);
          const float dlt = y - mean;
          const float var = wave_sum(dlt * dlt, lane) * (1.0f / 64.0f);
          float o = dlt * rsqrtf(var + 64e-5f) * lng + lnb;
          const float vv = tb[s * 384 + 320 + lane];
          o += rkcu[u] * vv;
          p[(size_t)(b * TSEQ + tt) * NIN + C_GA + chh] = f2bf(o * siluf_(gcu[u]));
        }
      }
    }
    LBAR();
  }
  if (MODE == 1) {
    float* Pm = PQ + ((size_t)(bh * RW_C + chunk) * 2 + 0) * 4096 + rowA * 64 + q * 8;
    *(float4*)Pm = make_float4(SA[0].x, SA[0].y, SA[1].x, SA[1].y); *(float4*)(Pm + 4) = make_float4(SA[2].x, SA[2].y, SA[3].x, SA[3].y);
    *(float4*)(Pm + 4096) = make_float4(SB[0].x, SB[0].y, SB[1].x, SB[1].y); *(float4*)(Pm + 4100) = make_float4(SB[2].x, SB[2].y, SB[3].x, SB[3].y);
  } else if (chunk == 0 && w < 4) {
    float* Qm = PQ + ((size_t)(bh * RW_C + 0) * 2 + 1) * 4096 + q * 8;
    *(float4*)(Qm + rowA * 64) = make_float4(SA[0].x, SA[0].y, SA[1].x, SA[1].y); *(float4*)(Qm + rowA * 64 + 4) = make_float4(SA[2].x, SA[2].y, SA[3].x, SA[3].y);
    *(float4*)(Qm + rowB * 64) = make_float4(SB[0].x, SB[0].y, SB[1].x, SB[1].y); *(float4*)(Qm + rowB * 64 + 4) = make_float4(SB[2].x, SB[2].y, SB[3].x, SB[3].y);
  }
  __syncthreads();
}

__device__ __forceinline__ void conv_item(KP P, int l, int item, unsigned char* lds, int wv_) {
#ifdef OFF_conv_item
  return;
#endif

  bf16_t* p = (bf16_t*)(P->ws + WS_P);
  float* u = (float*)lds;
  float* yb = (float*)(lds + 62 * 1024);
  const int tid = opaque_tid(wv_), c = tid & 255, half = tid >> 8;
  const int t0 = item * 32, tt0 = t0 & (TSEQ - 1);
  {
    bf16_t rv[31], rg[31];
#pragma unroll
    for (int i = 0; i < 31; ++i) { const int r = half + 2 * i; const bool ok = (tt0 - 30 + r) >= 0; const bf16_t* pr = p + (size_t)(t0 - 30 + r) * NIN;
      rv[i] = ok ? pr[C_CVAL + c] : (bf16_t)0; rg[i] = ok ? pr[C_CGLU + c] : (bf16_t)0; }
#pragma unroll
    for (int i = 0; i < 31; ++i) u[(half + 2 * i) * 256 + c] = bf2f(rv[i]) * sigmoidf_(bf2f(rg[i]));
  }
  float wv[31];
#pragma unroll
  for (int j = 0; j < 31; ++j) wv[j] = P->in[14][(l * 31 + j) * 256 + c];
  const float bias = P->in[15][l * 256 + c];
  __syncthreads();
  {
    float win[46];
#pragma unroll
    for (int i = 0; i < 46; ++i) win[i] = u[(half * 16 + i) * 256 + c];
#pragma unroll
    for (int i = 0; i < 16; ++i) {
      float acc = bias;
#pragma unroll
      for (int j = 0; j < 31; ++j) acc = fmaf(wv[j], win[i + j], acc);
      yb[(half * 16 + i) * 256 + c] = acc;
    }
  }
  __syncthreads();
  const int lane = tid & 63, w = tid >> 6;
  const float4 g = *(const float4*)(P->in[16] + l * 256 + lane * 4), bb = *(const float4*)(P->in[17] + l * 256 + lane * 4);
  uint2 gpre[4];
#pragma unroll
  for (int i = 0; i < 4; ++i) gpre[i] = *(const uint2*)(p + (size_t)(t0 + w * 4 + i) * NIN + C_CGATE + lane * 4);
#pragma unroll
  for (int i = 0; i < 4; ++i) {
    const int tk = w * 4 + i;
    const float4 v = *(const float4*)(yb + tk * 256 + lane * 4);
    const float mean = wave_sum(v.x + v.y + v.z + v.w, lane) * (1.0f / 256.0f);
    const float d0 = v.x - mean, d1 = v.y - mean, d2 = v.z - mean, d3 = v.w - mean;
    const float var = wave_sum(d0 * d0 + d1 * d1 + d2 * d2 + d3 * d3, lane) * (1.0f / 256.0f);
    const float rs = rsqrtf(var + 1e-5f);
    bf16_t* gp = p + (size_t)(t0 + tk) * NIN + C_CGATE + lane * 4;
    const uint2 gu = gpre[i];
    const float o0 = siluf_(d0 * rs * g.x + bb.x) * siluf_(__uint_as_float(gu.x << 16));
    const float o1 = siluf_(d1 * rs * g.y + bb.y) * siluf_(__uint_as_float(gu.x & 0xffff0000u));
    const float o2 = siluf_(d2 * rs * g.z + bb.z) * siluf_(__uint_as_float(gu.y << 16));
    const float o3 = siluf_(d3 * rs * g.w + bb.w) * siluf_(__uint_as_float(gu.y & 0xffff0000u));
    uint2 o; o.x = pack2(o0, o1); o.y = pack2(o2, o3);
    *(uint2*)gp = o;
  }
  __syncthreads();
}

#define HG_WLDS 10240
__device__ __forceinline__ float hgrn_lb(KP P, int l, int ch) {
  if (l == 0) return 0.f;
  const float x0 = P->in[18][ch], x1 = P->in[18][256 + ch];
  return __builtin_amdgcn_rcpf(1.0f + __expf(x0 - x1));
}
template <int PASS>
__device__ __forceinline__ void hgrn_wave_item(KP P, int l, int wi, unsigned char* lds, int wv_) {
#ifdef OFF_hgrn_wave_item
  return;
#endif

  bf16_t* p = (bf16_t*)(P->ws + WS_P);
  float* HS = (float*)(P->ws + WS_HS); float* HF = (float*)(P->ws + WS_HF);
  const int tid = opaque_tid(wv_);
  const int lane = tid & 63, w = tid >> 6;
  const int bh = wi >> 7, chunk = wi & 127, b = bh >> 2, head = bh & 3;
  float* st = (float*)(lds + w * HG_WLDS);
  float* ob = st + 2048;
  const int kg = lane & 7, vg = lane >> 3;
  const int ch = head * 64 + lane;
  const float lb = hgrn_lb(P, l, ch);
  const float ng = P->in[19][l * 256 + ch];
  float S[8][8];
  float* slot = HS + (size_t)(bh * 128 + chunk) * 4096;
  if (PASS == 1) {
#pragma unroll
    for (int i = 0; i < 8; ++i) { const float4 x0 = *(const float4*)(slot + (kg * 8 + i) * 64 + vg * 8), x1 = *(const float4*)(slot + (kg * 8 + i) * 64 + vg * 8 + 4);
      S[i][0] = x0.x; S[i][1] = x0.y; S[i][2] = x0.z; S[i][3] = x0.w; S[i][4] = x1.x; S[i][5] = x1.y; S[i][6] = x1.z; S[i][7] = x1.w; }
  } else {
#pragma unroll
    for (int i = 0; i < 8; ++i)
#pragma unroll
      for (int j = 0; j < 8; ++j) S[i][j] = 0.f;
  }
  float Fp = 1.f;
  bf16_t rf[8], ri[8], rq[8], rg[8];
  {
    const int tb0 = b * TSEQ + chunk * 64;
#pragma unroll
    for (int s = 0; s < 8; ++s) { const bf16_t* pr = p + (size_t)(tb0 + s) * NIN; rf[s] = pr[C_HF + ch]; ri[s] = pr[C_HI + ch]; if (PASS == 1) { rq[s] = pr[C_HQ + ch]; rg[s] = pr[C_HG + ch]; } }
  }
#pragma unroll 1
  for (int sub = 0; sub < 8; ++sub) {
    const int tbase = b * TSEQ + chunk * 64 + sub * 8;
    bf16_t gc[8];
#pragma unroll
    for (int s = 0; s < 8; ++s) {
      const float f = lb + (1.0f - lb) * sigmoidf_(bf2f(rf[s]));
      Fp *= f;
      st[s * 256 + lane] = f; st[s * 256 + 64 + lane] = 1.0f - f;
      if (PASS == 1) { st[s * 256 + 128 + lane] = siluf_(bf2f(rq[s])); gc[s] = rg[s]; }
      st[s * 256 + 192 + lane] = bf2f(ri[s]);
    }
    if (sub < 7) {
#pragma unroll
      for (int s = 0; s < 8; ++s) { const bf16_t* pr = p + (size_t)(tbase + 8 + s) * NIN; rf[s] = pr[C_HF + ch]; ri[s] = pr[C_HI + ch]; if (PASS == 1) { rq[s] = pr[C_HQ + ch]; rg[s] = pr[C_HG + ch]; } }
    }
    __builtin_amdgcn_s_waitcnt(0xc07f);
    __builtin_amdgcn_wave_barrier();
#pragma unroll 1
    for (int s = 0; s < 8; ++s) {
      const float* sp = st + s * 256;
      const float4 f0 = *(const float4*)(sp + kg * 8), f1 = *(const float4*)(sp + kg * 8 + 4);
      const float4 k0 = *(const float4*)(sp + 64 + kg * 8), k1 = *(const float4*)(sp + 64 + kg * 8 + 4);
      const float4 v0 = *(const float4*)(sp + 192 + vg * 8), v1 = *(const float4*)(sp + 192 + vg * 8 + 4);
      const float fv[8] = {f0.x, f0.y, f0.z, f0.w, f1.x, f1.y, f1.z, f1.w};
      const float kv[8] = {k0.x, k0.y, k0.z, k0.w, k1.x, k1.y, k1.z, k1.w};
      const float vv[8] = {v0.x, v0.y, v0.z, v0.w, v1.x, v1.y, v1.z, v1.w};
      const f32x2 vv2[4] = {{vv[0], vv[1]}, {vv[2], vv[3]}, {vv[4], vv[5]}, {vv[6], vv[7]}};
#pragma unroll
      for (int i = 0; i < 8; ++i) { const f32x2 f2 = {fv[i], fv[i]}, k2 = {kv[i], kv[i]};
#pragma unroll
        for (int j = 0; j < 4; ++j) { f32x2 s2 = {S[i][2 * j], S[i][2 * j + 1]}; s2 = f2 * s2 + k2 * vv2[j]; S[i][2 * j] = s2.x; S[i][2 * j + 1] = s2.y; } }
      if (PASS == 1) {
        const float4 q0 = *(const float4*)(sp + 128 + kg * 8), q1 = *(const float4*)(sp + 128 + kg * 8 + 4);
        const float qv[8] = {q0.x, q0.y, q0.z, q0.w, q1.x, q1.y, q1.z, q1.w};
        float o[8];
#pragma unroll
        for (int j = 0; j < 4; ++j) { f32x2 a2 = (f32x2){qv[0], qv[0]} * (f32x2){S[0][2 * j], S[0][2 * j + 1]};
#pragma unroll
          for (int i = 1; i < 8; ++i) a2 = (f32x2){qv[i], qv[i]} * (f32x2){S[i][2 * j], S[i][2 * j + 1]} + a2;
          o[2 * j] = red8(a2.x); o[2 * j + 1] = red8(a2.y); }
        if (kg == 0) { *(float4*)(ob + s * 64 + vg * 8) = make_float4(o[0], o[1], o[2], o[3]); *(float4*)(ob + s * 64 + vg * 8 + 4) = make_float4(o[4], o[5], o[6], o[7]); }
      }
    }
    __builtin_amdgcn_s_waitcnt(0xc07f);
    __builtin_amdgcn_wave_barrier();
    if (PASS == 1) {
#pragma unroll
      for (int s = 0; s < 8; ++s) {
        const float o = ob[s * 64 + lane];
        const float ms = wave_sum(o * o, lane) * (1.0f / 64.0f);
        p[(size_t)(tbase + s) * NIN + C_HG + ch] = f2bf(o * rsqrtf(ms + 1e-6f) * ng * siluf_(bf2f(gc[s])));
      }
      __builtin_amdgcn_s_waitcnt(0xc07f);
      __builtin_amdgcn_wave_barrier();
    }
  }
  if (PASS == 0) {
#pragma unroll
    for (int i = 0; i < 8; ++i) { *(float4*)(slot + (kg * 8 + i) * 64 + vg * 8) = make_float4(S[i][0], S[i][1], S[i][2], S[i][3]);
      *(float4*)(slot + (kg * 8 + i) * 64 + vg * 8 + 4) = make_float4(S[i][4], S[i][5], S[i][6], S[i][7]); }
    HF[(size_t)(bh * 128 + chunk) * 64 + lane] = Fp;
  }
}
__device__ __forceinline__ void hgrn_combine_item(KP P, int bh, int wv_) {
#ifdef OFF_hgrn_combine_item
  return;
#endif

  float* HS = (float*)(P->ws + WS_HS); const float* HF = (const float*)(P->ws + WS_HF);
  const int tid = opaque_tid(wv_);
  const int krow = tid >> 3;
  float R[8];
#pragma unroll
  for (int e = 0; e < 8; ++e) R[e] = 0.f;
  float4 xa[8][2]; float fa[8];
#pragma unroll
  for (int u = 0; u < 8; ++u) { const float* sl = HS + (size_t)(bh * 128 + u) * 4096 + tid * 8; xa[u][0] = *(const float4*)sl; xa[u][1] = *(const float4*)(sl + 4); fa[u] = HF[(size_t)(bh * 128 + u) * 64 + krow]; }
#pragma unroll 1
  for (int c0 = 0; c0 < 128; c0 += 8) {
    float4 xn[8][2]; float fn[8];
    if (c0 + 8 < 128) {
#pragma unroll
      for (int u = 0; u < 8; ++u) { const float* sl = HS + (size_t)(bh * 128 + c0 + 8 + u) * 4096 + tid * 8; xn[u][0] = *(const float4*)sl; xn[u][1] = *(const float4*)(sl + 4); fn[u] = HF[(size_t)(bh * 128 + c0 + 8 + u) * 64 + krow]; }
    }
#pragma unroll
    for (int u = 0; u < 8; ++u) {
      float* sl = HS + (size_t)(bh * 128 + c0 + u) * 4096 + tid * 8;
      *(float4*)sl = make_float4(R[0], R[1], R[2], R[3]); *(float4*)(sl + 4) = make_float4(R[4], R[5], R[6], R[7]);
      const float f = fa[u];
      R[0] = fmaf(f, R[0], xa[u][0].x); R[1] = fmaf(f, R[1], xa[u][0].y); R[2] = fmaf(f, R[2], xa[u][0].z); R[3] = fmaf(f, R[3], xa[u][0].w);
      R[4] = fmaf(f, R[4], xa[u][1].x); R[5] = fmaf(f, R[5], xa[u][1].y); R[6] = fmaf(f, R[6], xa[u][1].z); R[7] = fmaf(f, R[7], xa[u][1].w);
    }
    if (c0 + 8 < 128) {
#pragma unroll
      for (int u = 0; u < 8; ++u) { xa[u][0] = xn[u][0]; xa[u][1] = xn[u][1]; fa[u] = fn[u]; }
    }
  }
}

__device__ __forceinline__ void sb_item(KP P, int item, unsigned char* lds, int wv_) {
#ifdef OFF_sb_item
  return;
#endif

  bf16_t* p = (bf16_t*)(P->ws + WS_P);
  const int tid = opaque_tid(wv_), lane = tid & 63, w = tid >> 6;
  const int qt = item & 127, bh = item >> 7, b = bh >> 2, head = bh & 3;
  unsigned char* Qs = lds;
  unsigned char* Ks = lds + 9216;
  unsigned char* Vt = lds + 18432;
  unsigned char* As = lds + 27648;
  float* Zs = (float*)(lds + 36864);
  volatile int* flag = (volatile int*)(lds + 36864 + 64 * 65 * 4);
  const int lrow = tid >> 3, lch = (tid & 7);
  const size_t tokq = (size_t)b * TSEQ + qt * 64;
  *(uint4*)(Qs + lrow * 144 + lch * 16) = *(const uint4*)(p + (tokq + lrow) * NIN + C_SQ + head * 64 + lch * 8);
  float carry = 0.f;
  f32x4 oacc[2] = {{0.f, 0.f, 0.f, 0.f}, {0.f, 0.f, 0.f, 0.f}};
  const int qi = w >> 1, t2 = (w & 1) * 2;
  f32x4 gpre0, gpre1;
#pragma unroll
  for (int r = 0; r < 4; ++r) { const bf16_t* gp_ = p + (tokq + qi * 16 + (lane >> 4) * 4 + r) * NIN + C_SG + head * 64 + t2 * 16 + (lane & 15); gpre0[r] = bf2f(gp_[0]); gpre1[r] = bf2f(gp_[16]); }
  const int q = tid >> 3, seg = tid & 7;
  uint4 kreg = *(const uint4*)(p + (tokq + lrow) * NIN + C_SK + head * 64 + lch * 8);
  const int vkey = tid & 63, vch = tid >> 6;
  uint4 vreg = *(const uint4*)(p + (tokq + vkey) * NIN + C_SV + head * 64 + vch * 8);
  for (int kt = qt; kt >= 0; --kt) {
    LBAR();
    *(uint4*)(Ks + lrow * 144 + lch * 16) = kreg;
    { const unsigned vw[4] = {vreg.x, vreg.y, vreg.z, vreg.w};
#pragma unroll
      for (int e = 0; e < 8; ++e) *(unsigned short*)(Vt + (vch * 8 + e) * 144 + vkey * 2) = (unsigned short)((e & 1) ? (vw[e >> 1] >> 16) : (vw[e >> 1] & 0xffffu)); }
    if (tid == 0) *flag = 0;
    if (kt > 0) { const size_t tokn = (size_t)b * TSEQ + (kt - 1) * 64;
      kreg = *(const uint4*)(p + (tokn + lrow) * NIN + C_SK + head * 64 + lch * 8);
      vreg = *(const uint4*)(p + (tokn + vkey) * NIN + C_SV + head * 64 + vch * 8); }
    LBAR();
#pragma unroll
    for (int jj = 0; jj < 2; ++jj) {
      const int ki = t2 + jj;
      f32x4 acc = {0.f, 0.f, 0.f, 0.f};
#pragma unroll
      for (int s = 0; s < 2; ++s) {
        const bf16x8 a = *(const bf16x8*)(Qs + (qi * 16 + (lane & 15)) * 144 + s * 64 + (lane >> 4) * 16);
        const bf16x8 bb = *(const bf16x8*)(Ks + (ki * 16 + (lane & 15)) * 144 + s * 64 + (lane >> 4) * 16);
        acc = __builtin_amdgcn_mfma_f32_16x16x32_bf16(a, bb, acc, 0, 0, 0);
      }
#pragma unroll
      for (int r = 0; r < 4; ++r) Zs[(qi * 16 + (lane >> 4) * 4 + r) * 65 + ki * 16 + (lane & 15)] = acc[r] * 0.125f;
    }
    LBAR();
    {
      const int tq = qt * 64 + q;
      float z[8], lk[8];
      float tot = 0.f;
#pragma unroll
      for (int e = 0; e < 8; ++e) {
        z[e] = Zs[q * 65 + seg * 8 + e];
        const bool m = (kt * 64 + seg * 8 + e) < tq;
        lk[e] = m ? -softplus_fast(z[e]) : 0.f;
        tot += lk[e];
      }
      float inc = tot;
      { float t_ = __builtin_bit_cast(float, __builtin_amdgcn_update_dpp(0, __builtin_bit_cast(int, inc), 0x101, 0xF, 0xF, true)); if (seg + 1 < 8) inc += t_; }
      { float t_ = __builtin_bit_cast(float, __builtin_amdgcn_update_dpp(0, __builtin_bit_cast(int, inc), 0x102, 0xF, 0xF, true)); if (seg + 2 < 8) inc += t_; }
      { float t_ = __builtin_bit_cast(float, __builtin_amdgcn_update_dpp(0, __builtin_bit_cast(int, inc), 0x104, 0xF, 0xF, true)); if (seg + 4 < 8) inc += t_; }
      const float rowtot = red8(tot);
      float tail = carry + (inc - tot);
      float av[8];
#pragma unroll
      for (int e = 7; e >= 0; --e) {
        const bool m = (kt * 64 + seg * 8 + e) < tq;
        av[e] = m ? __expf(z[e] + lk[e] + tail) : 0.f;
        tail += lk[e];
      }
      uint4 o; o.x = pack2(av[0], av[1]); o.y = pack2(av[2], av[3]); o.z = pack2(av[4], av[5]); o.w = pack2(av[6], av[7]);
      *(uint4*)(As + q * 144 + seg * 16) = o;
      carry += rowtot;
      if (carry > -104.f) *flag = 1;
    }
    LBAR();
#pragma unroll
    for (int jj = 0; jj < 2; ++jj) {
      const int di = t2 + jj;
#pragma unroll
      for (int s = 0; s < 2; ++s) {
        const bf16x8 a = *(const bf16x8*)(As + (qi * 16 + (lane & 15)) * 144 + s * 64 + (lane >> 4) * 16);
        const bf16x8 bb = *(const bf16x8*)(Vt + (di * 16 + (lane & 15)) * 144 + s * 64 + (lane >> 4) * 16);
        oacc[jj] = __builtin_amdgcn_mfma_f32_16x16x32_bf16(a, bb, oacc[jj], 0, 0, 0);
      }
    }
    if (*flag == 0) break;
  }
#pragma unroll
  for (int jj = 0; jj < 2; ++jj) {
    const int d = (t2 + jj) * 16 + (lane & 15);
#pragma unroll
    for (int r = 0; r < 4; ++r) {
      const int qq = qi * 16 + (lane >> 4) * 4 + r;
      bf16_t* gp = p + (tokq + qq) * NIN + C_SG + head * 64 + d;
      *gp = f2bf(oacc[jj][r] * siluf_(jj == 0 ? gpre0[r] : gpre1[r]));
    }
  }
  __syncthreads();
}

__device__ __forceinline__ void xattn_item(KP P, int l, int item, unsigned char* lds, int wv_) {
  const bf16_t* qb = (const bf16_t*)(P->ws + WS_P + 32ull * MiB);
  bf16_t* ob = (bf16_t*)(P->ws + WS_P + 64ull * MiB);
  const bf16_t* kv = (const bf16_t*)(P->ws + WS_KV) + (size_t)l * 512 * 2048;
  const bf16_t* vt = (const bf16_t*)(P->ws + WS_VT) + (size_t)l * 2 * 1024 * 256;
  const int tid = opaque_tid(wv_), lane = tid & 63, w = tid >> 6;
  const int qt = item & 127, bh = item >> 7, b = bh >> 2, head = bh & 3;
  unsigned char* Qs = lds;
  unsigned char* KVs = lds + 33792;
  float* Ss = (float*)(lds + 67584);
  const size_t tok0 = (size_t)b * TSEQ + qt * 64;
  const int pr = tid >> 5, pc = tid & 31;
  uint4 pg0, pg1, pg2, pg3;
#define XA_LOAD(p_) { const bf16_t* s_ = (p_) < 4 ? kv + (size_t)(b * 256 + (p_) * 64 + pr) * 2048 + head * 256 + pc * 8 : vt + (size_t)(b * 1024 + head * 256 + ((p_) - 4) * 64 + pr) * 256 + pc * 8; \
      const size_t st_ = (p_) < 4 ? (size_t)16 * 2048 : (size_t)16 * 256; \
      pg0 = *(const uint4*)(s_); pg1 = *(const uint4*)(s_ + st_); pg2 = *(const uint4*)(s_ + 2 * st_); pg3 = *(const uint4*)(s_ + 3 * st_); }
  __syncthreads();
#pragma unroll
  for (int i = 0; i < 4; ++i) { const int r = pr + 16 * i; *(uint4*)(Qs + r * 528 + pc * 16) = *(const uint4*)(qb + (tok0 + r) * 1024 + head * 256 + pc * 8); }
  XA_LOAD(0);
  const int qi = w >> 1, t2 = (w & 1) * 2;
#pragma unroll 1
  for (int p = 0; p < 8; ++p) {
    LBAR();
    { unsigned char* d_ = KVs + pr * 528 + pc * 16; *(uint4*)d_ = pg0; *(uint4*)(d_ + 16 * 528) = pg1; *(uint4*)(d_ + 32 * 528) = pg2; *(uint4*)(d_ + 48 * 528) = pg3; }
    if (p < 7) XA_LOAD(p + 1);
    LBAR();
    f32x4 acc0 = {0.f, 0.f, 0.f, 0.f}, acc1 = {0.f, 0.f, 0.f, 0.f};
#pragma unroll
    for (int s = 0; s < 8; ++s) {
      const bf16x8 a = *(const bf16x8*)(Qs + (qi * 16 + (lane & 15)) * 528 + s * 64 + (lane >> 4) * 16);
      const bf16x8 b0 = *(const bf16x8*)(KVs + (t2 * 16 + (lane & 15)) * 528 + s * 64 + (lane >> 4) * 16);
      const bf16x8 b1 = *(const bf16x8*)(KVs + ((t2 + 1) * 16 + (lane & 15)) * 528 + s * 64 + (lane >> 4) * 16);
      acc0 = __builtin_amdgcn_mfma_f32_16x16x32_bf16(a, b0, acc0, 0, 0, 0);
      acc1 = __builtin_amdgcn_mfma_f32_16x16x32_bf16(a, b1, acc1, 0, 0, 0);
    }
    if (p < 4) {
#pragma unroll
      for (int r = 0; r < 4; ++r) { float* d_ = Ss + (qi * 16 + (lane >> 4) * 4 + r) * 260 + p * 64 + t2 * 16 + (lane & 15); d_[0] = acc0[r] * 0.0625f; d_[16] = acc1[r] * 0.0625f; }
      if (p == 3) {
        LBAR();
        const int q = tid >> 3, seg = tid & 7;
        float x[32]; float mx = -3.0e38f;
#pragma unroll
        for (int i = 0; i < 8; ++i) { const float4 v = *(const float4*)(Ss + q * 260 + seg * 32 + i * 4); x[i * 4] = v.x; x[i * 4 + 1] = v.y; x[i * 4 + 2] = v.z; x[i * 4 + 3] = v.w;
          mx = fmaxf(mx, fmaxf(fmaxf(v.x, v.y), fmaxf(v.z, v.w))); }
        mx = max8(mx);
        float sum = 0.f;
#pragma unroll
        for (int i = 0; i < 32; ++i) { x[i] = __expf(x[i] - mx); sum += x[i]; }
        sum = red8(sum);
        const float inv = __builtin_amdgcn_rcpf(sum);
#pragma unroll
        for (int i = 0; i < 4; ++i) { uint4 o; o.x = pack2(x[i * 8] * inv, x[i * 8 + 1] * inv); o.y = pack2(x[i * 8 + 2] * inv, x[i * 8 + 3] * inv);
          o.z = pack2(x[i * 8 + 4] * inv, x[i * 8 + 5] * inv); o.w = pack2(x[i * 8 + 6] * inv, x[i * 8 + 7] * inv);
          *(uint4*)(Qs + q * 528 + seg * 64 + i * 16) = o; }
      }
    } else {
#pragma unroll
      for (int r = 0; r < 4; ++r) { bf16_t* d_ = ob + (tok0 + qi * 16 + (lane >> 4) * 4 + r) * 1024 + head * 256 + (p - 4) * 64 + t2 * 16 + (lane & 15); d_[0] = f2bf(acc0[r]); d_[16] = f2bf(acc1[r]); }
    }
  }
#undef XA_LOAD
  __syncthreads();
}

__device__ __forceinline__ void wt_item(KP P, int l, int r, unsigned char* lds, int wv_) {
  const float* W; int N; bf16_t* Wt; int kt, nt; const float* gk = nullptr;
  unsigned char* wl = P->ws + WS_WT + l * WT_LAYER;
  if (r < 976) { W = P->in[3] + (size_t)l * 1024 * NIN; N = NIN; Wt = (bf16_t*)(wl + WT_IN); kt = r / 61; nt = r % 61; gk = P->in[2] + l * 1024; }
  else { r -= 976; const int m = r >> 8; r &= 255; kt = r >> 4; nt = r & 15; N = 1024;
    if (m == 0) { W = P->in[20] + (size_t)l * 1048576; Wt = (bf16_t*)(wl + WT_OUT); }
    else if (m == 1) { W = P->in[23] + (size_t)l * 1048576; Wt = (bf16_t*)(wl + WT_Q); gk = P->in[21] + l * 1024; }
    else if (m == 2) { W = P->in[24] + (size_t)l * 1048576; Wt = (bf16_t*)(wl + WT_KV); }
    else if (m == 3) { W = P->in[25] + (size_t)l * 1048576; Wt = (bf16_t*)(wl + WT_KV) + 1024 * 1024; }
    else { W = P->in[26] + (size_t)l * 1048576; Wt = (bf16_t*)(wl + WT_O); } }
  wt_tile(W, N, Wt, kt, nt, lds, wv_, gk);
}
__device__ __forceinline__ void wt_deferred(KP P, int d, unsigned char* lds, int wv_) {
  if (d < 768) { const int m = d >> 8, r = d & 255; wt_item(P, 0, 976 + (m == 0 ? 0 : m == 1 ? 256 : 1024) + r, lds, wv_); }
  else wt_item(P, 1, d - 768, lds, wv_);
}
__device__ __forceinline__ int next_item(unsigned* ctr, volatile LAS int* slot, int wv_) {
  __syncthreads();
  if (opaque_tid(wv_) == 0) *slot = (int)__hip_atomic_fetch_add(ctr, 1u, __ATOMIC_RELAXED, __HIP_MEMORY_SCOPE_AGENT);
  __syncthreads();
  return *slot;
}
__global__ void __launch_bounds__(NTHR) fwd_megakernel(Params Pk_unused) {
  KP P = (KP)__builtin_amdgcn_kernarg_segment_ptr();
  extern __shared__ __attribute__((aligned(16))) unsigned char lds[];
  const int wv_ = __builtin_amdgcn_readfirstlane((int)threadIdx.x >> 6);
  __shared__ uint4 xb_words;
  __shared__ int4 wq_slot;
  if (opaque_tid(wv_) == 0) xb_words = make_uint4(0u, 0u, 0u, 0u);
  __syncthreads();
#ifdef PROBE_J
  __shared__ unsigned long long tacc[32];
  __shared__ unsigned long long tlast;
  __shared__ float pdelta;
  if (opaque_tid(wv_) == 0) { for (int i = 0; i < 32; ++i) tacc[i] = 0ull; tlast = __builtin_amdgcn_s_memrealtime(); pdelta = 0.f; }
#define STAMP(k) if (opaque_tid(wv_) == 0) { const unsigned long long n_ = __builtin_amdgcn_s_memrealtime(); tacc[k] += n_ - tlast; tlast = n_; }
#else
#define STAMP(k)
#endif
  XcdBarrier bar = xcd_barrier_post((unsigned*)(P->ws + WS_BAR), (volatile LAS unsigned*)&xb_words, wv_);
  if (P->never) cg::this_grid().sync();
  const int G = gridDim.x, bid0 = blockIdx.x;

  for (int it = bid0; it < 976 + 512; it += G) wt_item(P, 0, it < 976 ? it : it + 512, lds, wv_);
#pragma unroll 1
  for (int k = 0; k < 3; ++k) {
    const float* s_ = k < 2 ? P->in[1] : P->in[0];
    const float* g_ = k < 2 ? P->in[22] + k * 1024 : P->in[2];
    bf16_t* d_ = k < 2 ? (bf16_t*)(P->ws + WS_MEMN) + k * 512 * 1024 : (bf16_t*)((unsigned char*)P->out + 32ull * MiB);
    norm_rows(false, s_, g_, d_, k < 2 ? 512 : NT, 0.f, wv_, k < 2 ? nullptr : (float*)(P->ws + WS_SSQ));
  }
  { float* z_ = (float*)(P->ws + WS_SSQ) + NT; for (int i = bid0 * NTHR + opaque_tid(wv_); i < 4 * NT; i += G * NTHR) z_[i] = 0.f; }
  STAMP(16 + 10); xcd_barrier(bar, wv_); STAMP(10)
  asm volatile("" : "+s"(P));

#pragma unroll 1
  for (int it = 0; it < 17; ++it) {
    int l = it >> 3, ph = it & 7;
    ph = ph < 5 ? ph : ph + 1;
    if (it == 16) { l = 1; ph = 9; }
    asm volatile("" : "+s"(P));
    int bid = bid0; asm volatile("" : "+s"(bid));

    unsigned char* ws = P->ws;
    const unsigned char* wl = ws + WS_WT + l * WT_LAYER;
    bf16_t* hbuf = (bf16_t*)((unsigned char*)P->out + 32ull * MiB);
    float* ssq = (float*)(ws + WS_SSQ);
    bf16_t* pbuf = (bf16_t*)(ws + WS_P);
    bf16_t* hx = (bf16_t*)(ws + WS_P);
    bf16_t* qbuf = (bf16_t*)(ws + WS_P + 32ull * MiB);
    bf16_t* obuf = (bf16_t*)(ws + WS_P + 64ull * MiB);
    if (ph == 0 || ph == 4 || ph == 6 || ph == 8) {
      pg8::Gemm g; pg8::TileSched S; pg8::EpiDyn E;
      g.M = NT; g.K = 1024; S.G = G; S.c = bid;
      if (ph == 0) { g.A = hbuf; g.Bt = (const bf16_t*)(wl + WT_IN); g.N = 4096; g.lda = 1024; g.ao0 = 0; g.ao1 = 256; g.ao2 = 512; g.ao3 = 768; S.nt = 1024; S.nN = 16;
        E.mode = 0; E.O = pbuf; E.ldc = NIN; E.N = NIN; E.resid = nullptr; E.out = nullptr; E.ssq_in = ssq + (l == 0 ? 0 : 2) * NT; E.xb = nullptr; E.ssq_out = nullptr; }
      else if (ph == 4) { g.A = pbuf; g.Bt = (const bf16_t*)(wl + WT_OUT); g.N = 1024; g.lda = NIN; g.ao0 = C_GA; g.ao1 = C_CGATE; g.ao2 = C_HG; g.ao3 = C_SG; S.nt = 256; S.nN = 4;
        E.mode = 1; E.O = nullptr; E.ldc = 1024; E.N = 1024; E.resid = (l == 0) ? P->in[0] : P->out; E.out = P->out; E.ssq_in = nullptr; E.xb = hbuf; E.ssq_out = ssq + (l == 0 ? 1 : 3) * NT; }
      else if (ph == 6) { g.A = hbuf; g.Bt = (const bf16_t*)(wl + WT_Q); g.N = 1024; g.lda = 1024; g.ao0 = 0; g.ao1 = 256; g.ao2 = 512; g.ao3 = 768; S.nt = 256; S.nN = 4;
        E.mode = 0; E.O = qbuf; E.ldc = 1024; E.N = 1024; E.resid = nullptr; E.out = nullptr; E.ssq_in = ssq + (l == 0 ? 1 : 3) * NT; E.xb = nullptr; E.ssq_out = nullptr; }
      else { g.A = obuf; g.Bt = (const bf16_t*)(wl + WT_O); g.N = 1024; g.lda = 1024; g.ao0 = 0; g.ao1 = 256; g.ao2 = 512; g.ao3 = 768; S.nt = 256; S.nN = 4;
        E.mode = 1; E.O = nullptr; E.ldc = 1024; E.N = 1024; E.resid = P->out; E.out = P->out; E.ssq_in = nullptr; E.xb = hbuf; E.ssq_out = ssq + (l == 0 ? 2 : 4) * NT; }
      pg8::gemm_phase<pg8::EpiDyn, pg8::TileSched, true, true>((PG8_LAS unsigned char*)lds, g, S, E, wv_);
    } else if (ph == 1) {
      if (G == 256) {
        if (bid < 128) { hgrn_wave_item<0>(P, l, bid * 8 + wv_, lds, wv_); __syncthreads(); rwkv_prep_item(P, l, bid * 2, 2, lds, wv_); }
        else rwkv_prep_item(P, l, 256 + (bid - 128) * 6, 6, lds, wv_);
      } else {
        unsigned* ctr = (unsigned*)(ws + WS_BAR) + it;
        for (;;) {
          const int i2 = next_item(ctr, (volatile LAS int*)&wq_slot, wv_);
          if (i2 >= 128 + 1024) break;
          if (i2 < 128) hgrn_wave_item<0>(P, l, i2 * 8 + wv_, lds, wv_);
          else rwkv_prep_item(P, l, i2 - 128, 1, lds, wv_);
        }
      }
    } else if (ph == 2) {
      const int n_p1 = 8 * (RW_C - 2);
      const int n_rw = n_p1 + 8;
      const int n_oth = 8 + 512 + 1024;
      for (int i2 = bid; i2 < n_rw; i2 += G) {
        if (i2 < n_p1) rwkv_scan_item<1>(P, l, i2 & 7, 1 + (i2 >> 3), lds, wv_);
        else rwkv_scan_item<0>(P, l, i2 - n_p1, 0, lds, wv_);
      }
      {
        unsigned* ctr = (unsigned*)(ws + WS_BAR) + it;
        for (;;) {
          const int i2 = next_item(ctr, (volatile LAS int*)&wq_slot, wv_);
          if (i2 >= n_oth) break;
          if (i2 < 8) hgrn_combine_item(P, i2, wv_);
          else if (i2 < 8 + 512) conv_item(P, l, i2 - 8, lds, wv_);
          else sb_item(P, i2 - 8 - 512, lds, wv_);
        }
      }
    } else if (ph == 3) {
      const int n_p3 = 8 * (RW_C - 1);
      for (int i2 = bid; i2 < n_p3; i2 += G) rwkv_scan_item<0>(P, l, i2 & 7, 1 + (i2 >> 3), lds, wv_);
      {
        unsigned* ctr = (unsigned*)(ws + WS_BAR) + it;
        for (;;) {
          const int i2 = next_item(ctr, (volatile LAS int*)&wq_slot, wv_);
          if (i2 >= 16 + 128 + (l == 0 ? 189 : 0)) break;
          if (i2 >= 16 + 128) { for (int d = (i2 - 144) * 16; d < (i2 - 144) * 16 + 16; ++d) wt_deferred(P, d, lds, wv_); }
          else if (i2 < 16) gemm_tile<2>((const bf16_t*)(ws + WS_MEMN) + (size_t)l * 512 * 1024, 1024, 0, 256, 512, 768, (const bf16_t*)(wl + WT_KV), (i2 >> 3) * 256, (i2 & 7) * 256, 2048,
                                    (bf16_t*)(ws + WS_KV) + (size_t)l * 512 * 2048, (const float*)((bf16_t*)(ws + WS_VT) + (size_t)l * 2 * 1024 * 256), 2048, lds, wv_);
          else hgrn_wave_item<1>(P, l, (i2 - 16) * 8 + wv_, lds, wv_);
        }
      }
    } else if (ph == 7) {
      for (int i2 = bid * 4; i2 < 1024; i2 += G * 4) { for (int k2 = 0; k2 < 4; ++k2) xattn_item(P, l, i2 + k2, lds, wv_); }
    } else {
      const float* ssqf = ssq + 4 * NT;
      const float* gf = P->in[27];
      float* outp = P->out;
      const int tid = opaque_tid(wv_), lane = tid & 63, w = tid >> 6;
      float4 gv[4];
#pragma unroll
      for (int i = 0; i < 4; ++i) gv[i] = *(const float4*)(gf + lane * 16 + i * 4);
      const int rpb = (8192 + G - 1) / G;
      for (int c = tid; c < rpb * 128; c += NTHR) { const int j = c >> 7, ch = c & 127; const int row = 8192 + bid * rpb + j;
        if (row < NT) *(uint4*)(lds + (size_t)j * 2048 + ch * 16) = *(const uint4*)(hbuf + (size_t)row * 1024 + ch * 8); }
      for (int row = bid * 8 + w; row < 8192; row += G * 8) {
        const uint4 a = *(const uint4*)(hbuf + (size_t)row * 1024 + lane * 16), b2 = *(const uint4*)(hbuf + (size_t)row * 1024 + lane * 16 + 8);
        const float rs = __builtin_amdgcn_rsqf(ssqf[row] * (1.0f / 1024.0f) + 1e-6f);
        float* o_ = outp + (size_t)row * 1024 + lane * 16;
        *(float4*)(o_) = make_float4(__uint_as_float(a.x << 16) * rs * gv[0].x, __uint_as_float(a.x & 0xffff0000u) * rs * gv[0].y, __uint_as_float(a.y << 16) * rs * gv[0].z, __uint_as_float(a.y & 0xffff0000u) * rs * gv[0].w);
        *(float4*)(o_ + 4) = make_float4(__uint_as_float(a.z << 16) * rs * gv[1].x, __uint_as_float(a.z & 0xffff0000u) * rs * gv[1].y, __uint_as_float(a.w << 16) * rs * gv[1].z, __uint_as_float(a.w & 0xffff0000u) * rs * gv[1].w);
        *(float4*)(o_ + 8) = make_float4(__uint_as_float(b2.x << 16) * rs * gv[2].x, __uint_as_float(b2.x & 0xffff0000u) * rs * gv[2].y, __uint_as_float(b2.y << 16) * rs * gv[2].z, __uint_as_float(b2.y & 0xffff0000u) * rs * gv[2].w);
        *(float4*)(o_ + 12) = make_float4(__uint_as_float(b2.z << 16) * rs * gv[3].x, __uint_as_float(b2.z & 0xffff0000u) * rs * gv[3].y, __uint_as_float(b2.w << 16) * rs * gv[3].z, __uint_as_float(b2.w & 0xffff0000u) * rs * gv[3].w);
      }
      xcd_barrier(bar, wv_);
      for (int j = w; j < rpb; j += 8) { const int row = 8192 + bid * rpb + j;
        if (row < NT) {
          const uint4 a = *(const uint4*)(lds + (size_t)j * 2048 + lane * 32), b2 = *(const uint4*)(lds + (size_t)j * 2048 + lane * 32 + 16);
          const float rs = __builtin_amdgcn_rsqf(ssqf[row] * (1.0f / 1024.0f) + 1e-6f);
          float* o_ = outp + (size_t)row * 1024 + lane * 16;
          *(float4*)(o_) = make_float4(__uint_as_float(a.x << 16) * rs * gv[0].x, __uint_as_float(a.x & 0xffff0000u) * rs * gv[0].y, __uint_as_float(a.y << 16) * rs * gv[0].z, __uint_as_float(a.y & 0xffff0000u) * rs * gv[0].w);
          *(float4*)(o_ + 4) = make_float4(__uint_as_float(a.z << 16) * rs * gv[1].x, __uint_as_float(a.z & 0xffff0000u) * rs * gv[1].y, __uint_as_float(a.w << 16) * rs * gv[1].z, __uint_as_float(a.w & 0xffff0000u) * rs * gv[1].w);
          *(float4*)(o_ + 8) = make_float4(__uint_as_float(b2.x << 16) * rs * gv[2].x, __uint_as_float(b2.x & 0xffff0000u) * rs * gv[2].y, __uint_as_float(b2.y << 16) * rs * gv[2].z, __uint_as_float(b2.y & 0xffff0000u) * rs * gv[2].w);
          *(float4*)(o_ + 12) = make_float4(__uint_as_float(b2.z << 16) * rs * gv[3].x, __uint_as_float(b2.z & 0xffff0000u) * rs * gv[3].y, __uint_as_float(b2.w << 16) * rs * gv[3].z, __uint_as_float(b2.w & 0xffff0000u) * rs * gv[3].w);
        }
      }
    }
    if (it < 16) { STAMP(16 + ph); xcd_barrier(bar, wv_); STAMP(ph) }
  }
#ifdef PROBE_J
  if (bid0 == PROBE_B && opaque_tid(wv_) == 0) {
    const unsigned long long t0_ = __builtin_amdgcn_s_memrealtime();
    const unsigned long long w_ = 4ull * (PROBE_K < 32 ? tacc[PROBE_K & 31] : tacc[PROBE_K - 32] + tacc[PROBE_K - 16]);
    while (__builtin_amdgcn_s_memrealtime() - t0_ < w_) __builtin_amdgcn_s_sleep(8);
  }
#endif
}

extern "C" void kernel_launch(void* const* d_in, const int* in_sizes, int n_in, void* d_out, int out_size, void* d_ws, size_t ws_size, hipStream_t stream) {
  constexpr size_t kDynLds = 147456;
  static int grid_blocks = 0;
  if (!grid_blocks) {
    int dev = 0, cus = 0, per_cu = 0;
    hipGetDevice(&dev);
    hipDeviceGetAttribute(&cus, hipDeviceAttributeMultiprocessorCount, dev);
    hipFuncSetAttribute((const void*)fwd_megakernel, hipFuncAttributeMaxDynamicSharedMemorySize, (int)kDynLds);
    hipOccupancyMaxActiveBlocksPerMultiprocessor(&per_cu, fwd_megakernel, NTHR, kDynLds);
    if (per_cu < 1) per_cu = 1;
    if (per_cu > 1) per_cu = 1;
    grid_blocks = cus * per_cu;
    if (grid_blocks > 256) grid_blocks = 256;
  }
  Params p;
  memset(&p, 0, sizeof(p));
  for (int i = 0; i < 28; ++i) p.in[i] = (const float*)d_in[i];
  p.out = (float*)d_out; p.ws = (unsigned char*)d_ws; p.never = 0; p.pad = 0;
  hipMemsetAsync(d_ws, 0, XCD_BAR_WORDS * 4, stream);
  void* args[] = {&p};
  hipError_t e = hipLaunchCooperativeKernel((void*)fwd_megakernel, dim3(grid_blocks), dim3(NTHR), args, kDynLds, stream);
  if (e != hipSuccess) fprintf(stderr, "cooperative launch failed: %s (grid %d)\n", hipGetErrorString(e), grid_blocks);
}
```

```cpp
#include <hip/hip_runtime.h>
#include <hip/hip_cooperative_groups.h>
#include <stdint.h>
#include <cstdio>
#include <cstring>
namespace cg = cooperative_groups;

typedef unsigned short bf16_t;
typedef short bf16x8 __attribute__((ext_vector_type(8)));
typedef float f32x4 __attribute__((ext_vector_type(4)));
typedef float f32x16 __attribute__((ext_vector_type(16)));
typedef float f32x2 __attribute__((ext_vector_type(2)));
#define LAS __attribute__((address_space(3)))

#define NT 16384
#define TSEQ 8192
#define DM 1024
#define NIN 3904
#define NTHR 512
#define C_R 0
#define C_K 256
#define C_V 512
#define C_XW 768
#define C_GA 832
#define C_CVAL 1088
#define C_CGLU 1344
#define C_CGATE 1600
#define C_HQ 1856
#define C_HF 2112
#define C_HI 2368
#define C_HG 2624
#define C_SQ 2880
#define C_SK 3136
#define C_SV 3392
#define C_SG 3648
#define RW_C 32
#define RW_CL (TSEQ / RW_C)
#define RW_TT 16

#define MiB (1024ull * 1024ull)
#define WS_BAR   0ull
#define WS_WT    (1ull * MiB)
#define WT_LAYER (18ull * MiB)
#define WT_IN    0ull
#define WT_OUT   (8ull * MiB)
#define WT_Q     (10ull * MiB)
#define WT_KV    (12ull * MiB)
#define WT_O     (16ull * MiB)
#define WS_MEMN  (37ull * MiB)
#define WS_KV    (39ull * MiB)
#define WS_PQ    (246ull * MiB)
#define WS_HS    (47ull * MiB)
#define WS_HF    (63ull * MiB)
#define WS_RK    (63ull * MiB + 512ull * 1024ull)
#define WS_R1    (64ull * MiB)
#define WS_PW    WS_R1
#define WS_PV    (WS_R1 + 16ull * MiB)
#define WS_P     (120ull * MiB)
#define WS_VT    (243ull * MiB)
#define WS_SSQ   (245ull * MiB)
#define WS_END   (254ull * MiB)

struct Params {
  const float* in[28];
  float* out;
  unsigned char* ws;
  int never;
  int pad;
};

typedef const __attribute__((address_space(4))) Params* KP;
__device__ __forceinline__ int lane_id_() { return (int)__builtin_amdgcn_mbcnt_hi(~0u, __builtin_amdgcn_mbcnt_lo(~0u, 0u)); }
__device__ __forceinline__ int opaque_tid(int wv_) { int t; asm volatile("v_mbcnt_lo_u32_b32 %0, -1, 0\n\tv_mbcnt_hi_u32_b32 %0, -1, %0\n\tv_lshl_add_u32 %0, %1, 6, %0" : "=&v"(t) : "s"(wv_)); return t; }
__device__ __forceinline__ float bf2f(bf16_t v) { return __uint_as_float(((unsigned)v) << 16); }
__device__ __forceinline__ bf16_t f2bf(float f) {
  unsigned u = __float_as_uint(f);
  u += 0x7fffu + ((u >> 16) & 1u);
  return (bf16_t)(u >> 16);
}
__device__ __forceinline__ unsigned pack2(float a, float b) { return (unsigned)f2bf(a) | ((unsigned)f2bf(b) << 16); }
__device__ __forceinline__ float sigmoidf_(float x) { return __builtin_amdgcn_rcpf(1.0f + __expf(-x)); }
__device__ __forceinline__ float siluf_(float x) { return x * __builtin_amdgcn_rcpf(1.0f + __expf(-x)); }
__device__ __forceinline__ float softplusf_(float x) { return fmaxf(x, 0.f) + log1pf(__expf(-fabsf(x))); }
__device__ __forceinline__ float softplus_fast(float x) { return fmaxf(x, 0.f) + __logf(1.0f + __expf(-fabsf(x))); }
__device__ __forceinline__ float dpp_add(float v, const int ctrl_sel) {
  return v;
}
__device__ __forceinline__ float bperm(float v, int srclane) { return __builtin_bit_cast(float, __builtin_amdgcn_ds_bpermute(srclane << 2, __builtin_bit_cast(int, v))); }
__device__ __forceinline__ float wave_sum(float v, int lane) {
  v += __builtin_bit_cast(float, __builtin_amdgcn_update_dpp(0, __builtin_bit_cast(int, v), 0xB1, 0xF, 0xF, true));
  v += __builtin_bit_cast(float, __builtin_amdgcn_update_dpp(0, __builtin_bit_cast(int, v), 0x4E, 0xF, 0xF, true));
  v += __builtin_bit_cast(float, __builtin_amdgcn_update_dpp(0, __builtin_bit_cast(int, v), 0x141, 0xF, 0xF, true));
  v += __builtin_bit_cast(float, __builtin_amdgcn_update_dpp(0, __builtin_bit_cast(int, v), 0x140, 0xF, 0xF, true));
  v += bperm(v, lane ^ 16);
  v += bperm(v, lane ^ 32);
  return v;
}
__device__ __forceinline__ float max8(float v) {
  v = fmaxf(v, __builtin_bit_cast(float, __builtin_amdgcn_update_dpp(0, __builtin_bit_cast(int, v), 0xB1, 0xF, 0xF, true)));
  v = fmaxf(v, __builtin_bit_cast(float, __builtin_amdgcn_update_dpp(0, __builtin_bit_cast(int, v), 0x4E, 0xF, 0xF, true)));
  v = fmaxf(v, __builtin_bit_cast(float, __builtin_amdgcn_update_dpp(0, __builtin_bit_cast(int, v), 0x141, 0xF, 0xF, true)));
  return v;
}
__device__ __forceinline__ float red8(float v) {
  v += __builtin_bit_cast(float, __builtin_amdgcn_update_dpp(0, __builtin_bit_cast(int, v), 0xB1, 0xF, 0xF, true));
  v += __builtin_bit_cast(float, __builtin_amdgcn_update_dpp(0, __builtin_bit_cast(int, v), 0x4E, 0xF, 0xF, true));
  v += __builtin_bit_cast(float, __builtin_amdgcn_update_dpp(0, __builtin_bit_cast(int, v), 0x141, 0xF, 0xF, true));
  return v;
}

#define LBAR() do { asm volatile("s_waitcnt lgkmcnt(0)" ::: "memory"); __builtin_amdgcn_s_barrier(); asm volatile("" ::: "memory"); } while (0)
#define XB_TMO      128
#define XB_XCNT(j)  (256  + 64 * (j))
#define XB_XSUB(j)  (1280 + 64 * (j))
#define XB_XGEN(j)  (2304 + 64 * (j))
#define XB_TOP      3328
#define XB_TOPGEN   3392
#define XCD_BAR_WORDS 3456
#define XB_SPIN_CAP (1u << 22)
__device__ __forceinline__ unsigned xb_ld(unsigned* p) { return __hip_atomic_load(p, __ATOMIC_RELAXED, __HIP_MEMORY_SCOPE_AGENT); }
__device__ __forceinline__ unsigned xb_add(unsigned* p, unsigned v) { return __hip_atomic_fetch_add(p, v, __ATOMIC_RELAXED, __HIP_MEMORY_SCOPE_AGENT); }
__device__ __forceinline__ unsigned xb_xcc_id() { return (unsigned)__builtin_amdgcn_s_getreg((3 << 11) | 20) & 0xFu; }
#define XB_SPIN(cond, bar) do { unsigned _sp = 0; while (cond) { __builtin_amdgcn_s_sleep(1); \
    if ((++_sp & 255u) == 0u) { if (xb_ld(&(bar)[XB_TMO])) break; if (_sp > XB_SPIN_CAP) { atomicAdd(&(bar)[XB_TMO], 1u); break; } } } } while (0)
struct XcdBarrier { unsigned* bar; unsigned x; volatile LAS unsigned* st; };
__device__ __forceinline__ XcdBarrier xcd_barrier_post(unsigned* bar, volatile LAS unsigned* st, int wv_) {
  XcdBarrier b; b.bar = bar; b.x = xb_xcc_id(); b.st = st;
  if (opaque_tid(wv_) == 0) (void)xb_add(&bar[XB_XCNT(b.x)], 1u);
  return b;
}
__device__ __forceinline__ void xcd_barrier_complete(unsigned* bar, unsigned x, unsigned& nloc, unsigned& nx) {
  const unsigned G = gridDim.x * gridDim.y * gridDim.z;
  unsigned sum, cnt, mine, sp = 0u;
  for (;;) {
    sum = 0u; cnt = 0u; mine = 0u;
#pragma unroll
    for (unsigned j = 0; j < 16; ++j) { const unsigned c = xb_ld(&bar[XB_XCNT(j)]); sum += c; cnt += (c > 0u) ? 1u : 0u; mine = (j == x) ? c : mine; }
    if (sum == G) break;
    __builtin_amdgcn_s_sleep(1);
    if ((++sp & 255u) == 0u) { if (xb_ld(&bar[XB_TMO])) break; if (sp > XB_SPIN_CAP) { atomicAdd(&bar[XB_TMO], 1u); break; } }
  }
  nloc = mine > 0u ? mine : 1u; nx = cnt > 0u ? cnt : 1u;
}
__device__ __forceinline__ void xcd_barrier(const XcdBarrier& b, int wv_) {
  asm volatile("s_waitcnt vmcnt(0)" ::: "memory");
  __syncthreads();
  if (opaque_tid(wv_) == 0) {
    unsigned* bar = b.bar;
    __builtin_amdgcn_s_waitcnt(0);
    unsigned bx = b.x; asm volatile("" : "+s"(bx));
    unsigned nloc = b.st[0], nx = b.st[1];
    if (nloc == 0u) { xcd_barrier_complete(bar, bx, nloc, nx); b.st[0] = nloc; b.st[1] = nx; }
    const unsigned old = xb_add(&bar[XB_XSUB(bx)], 1u);
    const unsigned gen = old / nloc;
    if (old + 1u == (gen + 1u) * nloc) {
      __builtin_amdgcn_fence(__ATOMIC_RELEASE, "agent");
      asm volatile("s_waitcnt vmcnt(0)" ::: "memory");
      const unsigned og = xb_add(&bar[XB_TOP], 1u);
      const unsigned tg = og / nx;
      if (og + 1u == (tg + 1u) * nx) xb_add(&bar[XB_TOPGEN], 1u);
      else XB_SPIN(xb_ld(&bar[XB_TOPGEN]) == tg, bar);
      __builtin_amdgcn_fence(__ATOMIC_ACQUIRE, "agent");
      xb_add(&bar[XB_XGEN(bx)], 1u);
      asm volatile("s_waitcnt vmcnt(0)" ::: "memory");
    } else {
      XB_SPIN(xb_ld(&bar[XB_XGEN(bx)]) == gen, bar);
      __builtin_amdgcn_fence(__ATOMIC_ACQUIRE, "agent");
      asm volatile("s_waitcnt vmcnt(0)" ::: "memory");
    }
  }
  __syncthreads();
}

#define G_STAGE 73728
#define G_BOFF 36864
template <int EPI>
__device__ __forceinline__ void gemm_tile(const bf16_t* __restrict__ A, int lda, int ao0, int ao1, int ao2, int ao3,
                                          const bf16_t* __restrict__ Bt, int m0, int n0, int N,
                                          void* out, const float* resid, int ldc, unsigned char* lds, int wv_) {
#ifdef OFF_gemm_tile
  return;
#endif

  const int tid = opaque_tid(wv_), lane = tid & 63, w = tid >> 6;
  const int wm = w >> 2, wn = w & 3, lr = lane & 31, lh = lane >> 5;
  f32x16 acc[4][2];
#pragma unroll
  for (int i = 0; i < 4; ++i)
#pragma unroll
    for (int j = 0; j < 2; ++j)
#pragma unroll
      for (int r = 0; r < 16; ++r) acc[i][j][r] = 0.f;
  uint4 ra[4], rb[4];
  const int crow = tid >> 3, ccol = (tid & 7) * 8;
  const bf16_t* Ap = A + (size_t)(m0 + crow) * lda + ccol;
  const bf16_t* Bp = Bt + (size_t)(n0 + crow) * 1024 + ccol;
#define G_LOAD(kt) { const int k0_ = (kt) * 64; const int seg_ = k0_ >> 8; const int ao_ = (seg_ == 0 ? ao0 : seg_ == 1 ? ao1 : seg_ == 2 ? ao2 : ao3) + (k0_ & 255); \
    _Pragma("unroll") for (int i_ = 0; i_ < 4; ++i_) { ra[i_] = *(const uint4*)(Ap + (size_t)(i_ * 64) * lda + ao_); rb[i_] = *(const uint4*)(Bp + (size_t)(i_ * 64) * 1024 + k0_); } }
#define G_WRITE(buf) { unsigned char* b_ = lds + (buf) * G_STAGE + crow * 144 + (tid & 7) * 16; \
    _Pragma("unroll") for (int i_ = 0; i_ < 4; ++i_) { *(uint4*)(b_ + i_ * 64 * 144) = ra[i_]; *(uint4*)(b_ + G_BOFF + i_ * 64 * 144) = rb[i_]; } }
  G_LOAD(0); G_WRITE(0); __syncthreads();
  for (int kt = 0; kt < 16; ++kt) {
    if (kt < 15) G_LOAD(kt + 1);
    const unsigned char* base = lds + (kt & 1) * G_STAGE;
    const unsigned char* ab = base + (wm * 128 + lr) * 144 + lh * 16;
    const unsigned char* bb = base + G_BOFF + (wn * 64 + lr) * 144 + lh * 16;
#pragma unroll
    for (int s = 0; s < 4; ++s) {
      bf16x8 a[4], b[2];
#pragma unroll
      for (int i = 0; i < 4; ++i) a[i] = *(const bf16x8*)(ab + i * 32 * 144 + s * 32);
#pragma unroll
      for (int j = 0; j < 2; ++j) b[j] = *(const bf16x8*)(bb + j * 32 * 144 + s * 32);
#pragma unroll
      for (int i = 0; i < 4; ++i)
#pragma unroll
        for (int j = 0; j < 2; ++j) acc[i][j] = __builtin_amdgcn_mfma_f32_32x32x16_bf16(a[i], b[j], acc[i][j], 0, 0, 0);
    }
    if (kt < 15) G_WRITE((kt + 1) & 1);
    __syncthreads();
  }
#undef G_LOAD
#undef G_WRITE
#pragma unroll
  for (int i = 0; i < 4; ++i)
#pragma unroll
    for (int j = 0; j < 2; ++j) {
      const int col = n0 + wn * 64 + j * 32 + lr;
#pragma unroll
      for (int r = 0; r < 16; ++r) {
        const int row = m0 + wm * 128 + i * 32 + (r & 3) + 8 * (r >> 2) + 4 * lh;
        if (EPI == 0) { if (col < N) ((bf16_t*)out)[(size_t)row * ldc + col] = f2bf(acc[i][j][r]); }
        else if (EPI == 2) { if (col < 1024) ((bf16_t*)out)[(size_t)row * ldc + col] = f2bf(acc[i][j][r]);
                             else ((bf16_t*)resid)[((size_t)((row >> 8) * 1024 + (col - 1024))) * 256 + (row & 255)] = f2bf(acc[i][j][r]); }
        else { ((float*)out)[(size_t)row * ldc + col] = resid[(size_t)row * ldc + col] + acc[i][j][r]; }
      }
    }
}

__device__ __forceinline__ void tile_map(int t, int nN, int& mi, int& ni) {
  const int rnd = t >> 8, blk = t & 255, x = blk & 7, y = blk >> 3;
  if (nN == 16) { mi = rnd * 16 + (x >> 1) * 4 + (y & 3); ni = (x & 1) * 8 + (y >> 2); }
  else { mi = rnd * 64 + x * 8 + (y & 7); ni = y >> 3; }
}

namespace pg8 {
#define PG8_LAS __attribute__((address_space(3)))
typedef unsigned u32x4 __attribute__((ext_vector_type(4)));
constexpr int BM = 256, BK = 64, HALF = 128, HTB = HALF * BK * 2  , STAGE_BYTES = 8 * HTB, NXCD = 8, WGM = 8;

__host__ __device__ __forceinline__ int lds_byte(int r, int c) { const int st = (r >> 4) * 2 + (c >> 5), rr = r & 15, cc = c & 31, ob = rr * 64 + cc * 2; return st * 1024 + (ob ^ (((ob >> 9) & 1) << 5)); }
__host__ __device__ __forceinline__ void stage_rc(int b, int& R, int& C) { const int st = b / 1024, sb = b % 1024, swz = sb ^ (((sb >> 9) & 1) << 5); R = (st >> 1) * 16 + swz / 64; C = (st & 1) * 32 + (swz % 64) / 2; }
__host__ __device__ __forceinline__ int perm32(int rho) { const int n = rho >> 4, i = rho & 15; return 8 * (i >> 2) + 4 * n + (i & 3); }

struct Unit { int pm, pn; };
struct Gemm { const bf16_t* A; const bf16_t* Bt; int M, N, K; int lda; int ao0, ao1, ao2, ao3; };

struct TileSched {
    int nt, G, c, nN;
    __device__ __forceinline__ bool next(int i, Unit& u) const { const int t = i * G + c; if (t >= nt) return false; tile_map(t, nN, u.pm, u.pn); return true; }
    __device__ __forceinline__ void a_ready(const Unit&) const {}
    __device__ __forceinline__ void done(const Unit&) const {}
};
__device__ __forceinline__ unsigned cvt_pk_bf16(float lo, float hi) { unsigned r; asm volatile("v_cvt_pk_bf16_f32 %0, %1, %2" : "=v"(r) : "v"(lo), "v"(hi)); return r; }
struct EpiStoreBf16 {
    static constexpr bool PERM = true, AFTER_DRAIN = false;
    bf16_t* O; int ldc; int N;
    __device__ __forceinline__ void operator()(const f32x4 (&acc)[2][2][4][2], const Unit& u, int wr, int wc, int fr, int fq) const {
        const int row0 = u.pm * BM + wr * 64 + fr, col0 = u.pn * BM + wc * 32 + 8 * fq;
#pragma unroll
        for (int ai = 0; ai < 2; ++ai)
#pragma unroll
            for (int m = 0; m < 4; ++m) { bf16_t* rowp = O + (size_t)(row0 + ai * HALF + m * 16) * ldc + col0;
#pragma unroll
                for (int bj = 0; bj < 2; ++bj) { if (col0 + bj * HALF < N) { const f32x4 v0 = acc[ai][bj][m][0], v1 = acc[ai][bj][m][1];
                    u32x4 w; w.x = cvt_pk_bf16(v0[0], v0[1]); w.y = cvt_pk_bf16(v0[2], v0[3]); w.z = cvt_pk_bf16(v1[0], v1[1]); w.w = cvt_pk_bf16(v1[2], v1[3]);
                    *(u32x4*)(rowp + bj * HALF) = w; } } }
    }
};
struct EpiDyn {
    static constexpr bool PERM = true, AFTER_DRAIN = false;
    int mode; bf16_t* O; int ldc; int N; const float* resid; float* out; const float* ssq_in; bf16_t* xb; float* ssq_out;
    __device__ __forceinline__ void operator()(const f32x4 (&acc)[2][2][4][2], const Unit& u, int wr, int wc, int fr, int fq) const {
        const int row0 = u.pm * BM + wr * 64 + fr, col0 = u.pn * BM + wc * 32 + 8 * fq;
        if (mode == 0) {
#pragma unroll
            for (int ai = 0; ai < 2; ++ai)
#pragma unroll
                for (int m = 0; m < 4; ++m) { const int row = row0 + ai * HALF + m * 16; bf16_t* rowp = O + (size_t)row * ldc + col0;
                    const float sc = __builtin_amdgcn_rsqf(ssq_in[row] * (1.0f / 1024.0f) + 1e-6f);
#pragma unroll
                    for (int bj = 0; bj < 2; ++bj) { if (col0 + bj * HALF < N) { const f32x4 v0 = acc[ai][bj][m][0] * sc, v1 = acc[ai][bj][m][1] * sc;
                        u32x4 w; w.x = cvt_pk_bf16(v0[0], v0[1]); w.y = cvt_pk_bf16(v0[2], v0[3]); w.z = cvt_pk_bf16(v1[0], v1[1]); w.w = cvt_pk_bf16(v1[2], v1[3]);
                        *(u32x4*)(rowp + bj * HALF) = w; } } }
        } else {
            const int lane_ = fq * 16 + fr;
#pragma unroll
            for (int ai = 0; ai < 2; ++ai)
#pragma unroll
                for (int m = 0; m < 4; ++m) { const int row = row0 + ai * HALF + m * 16; const size_t off = (size_t)row * ldc + col0; float s = 0.f;
#pragma unroll
                    for (int bj = 0; bj < 2; ++bj) { const u32x4 rv = *(const u32x4*)(xb + off + bj * HALF);
                        const f32x4 r0 = {__uint_as_float(rv.x << 16), __uint_as_float(rv.x & 0xffff0000u), __uint_as_float(rv.y << 16), __uint_as_float(rv.y & 0xffff0000u)};
                        const f32x4 r1 = {__uint_as_float(rv.z << 16), __uint_as_float(rv.z & 0xffff0000u), __uint_as_float(rv.w << 16), __uint_as_float(rv.w & 0xffff0000u)};
                        const f32x4 x0 = r0 + acc[ai][bj][m][0], x1 = r1 + acc[ai][bj][m][1];
                        u32x4 w; w.x = cvt_pk_bf16(x0[0], x0[1]); w.y = cvt_pk_bf16(x0[2], x0[3]); w.z = cvt_pk_bf16(x1[0], x1[1]); w.w = cvt_pk_bf16(x1[2], x1[3]);
                        *(u32x4*)(xb + off + bj * HALF) = w;
                        s += (x0[0] * x0[0] + x0[1] * x0[1]) + (x0[2] * x0[2] + x0[3] * x0[3]) + (x1[0] * x1[0] + x1[1] * x1[1]) + (x1[2] * x1[2] + x1[3] * x1[3]); }
                    s += bperm(s, lane_ ^ 16); s += bperm(s, lane_ ^ 32);
                    if (fq == 0) __hip_atomic_fetch_add(ssq_out + row, s, __ATOMIC_RELAXED, __HIP_MEMORY_SCOPE_AGENT); }
        }
    }
};
struct EpiResid {
    static constexpr bool PERM = true, AFTER_DRAIN = false;
    const float* resid; float* out; int ldc;
    __device__ __forceinline__ void operator()(const f32x4 (&acc)[2][2][4][2], const Unit& u, int wr, int wc, int fr, int fq) const {
        const int row0 = u.pm * BM + wr * 64 + fr, col0 = u.pn * BM + wc * 32 + 8 * fq;
#pragma unroll
        for (int ai = 0; ai < 2; ++ai)
#pragma unroll
            for (int m = 0; m < 4; ++m) { const size_t off = (size_t)(row0 + ai * HALF + m * 16) * ldc + col0;
#pragma unroll
                for (int bj = 0; bj < 2; ++bj) { const f32x4 r0 = *(const f32x4*)(resid + off + bj * HALF), r1 = *(const f32x4*)(resid + off + bj * HALF + 4);
                    *(f32x4*)(out + off + bj * HALF) = r0 + acc[ai][bj][m][0]; *(f32x4*)(out + off + bj * HALF + 4) = r1 + acc[ai][bj][m][1]; } }
    }
};

static_assert(true, "pg8 body adapted: SP2 path only is valid with lda/segment offsets");
template <class Epi, class Sched, bool ALIGN_EPI = false, bool SP2 = false>
__device__ __forceinline__ void gemm_phase(PG8_LAS unsigned char* lds, const Gemm g, const Sched& S, const Epi& E, int wv_) {
    const int tid = opaque_tid(wv_), wid = __builtin_amdgcn_readfirstlane(tid >> 6), lane = tid & 63, wr = wid >> 2, wc = wid & 3, fr = lane & 15, fq = lane >> 4;
    const int K = g.K, nt = K / BK;
    unsigned voffA, voffB;
    { int R, C; stage_rc(tid * 16, R, C); const int Rb = Epi::PERM ? ((R & ~31) + perm32(R & 31)) : R;
      voffA = (unsigned)(R * g.lda + C) * 2u; voffB = (unsigned)(Rb * K + C) * 2u; }
    const size_t rstepA = (size_t)64 * g.lda * 2, rstepB = (size_t)64 * K * 2;
    const size_t kstep = (size_t)(BK * 2);
    const size_t hstep = (size_t)HALF * K * 2; const size_t hstepA = (size_t)HALF * g.lda * 2, tstepA = 2 * hstepA;
#define PG8_KA(t_) ((size_t)((((t_) >> 2) == 0 ? g.ao0 : ((t_) >> 2) == 1 ? g.ao1 : ((t_) >> 2) == 2 ? g.ao2 : g.ao3) + ((t_) & 3) * 64) * 2)
    const size_t tstep = 2 * hstep;
    const unsigned ldsw = (unsigned)wid * 1024u;
    int aoff, boff;
#define PG8_SA(b, h) (((b) * 2 + (h)) * HTB)
#define PG8_SB(b, h) ((4 + (b) * 2 + (h)) * HTB)
#define PG8_STAGE(bufoff, gbase, voff) do { _Pragma("unroll") for (int _i = 0; _i < 2; ++_i) \
        __builtin_amdgcn_global_load_lds((const unsigned*)((const char*)(gbase) + (size_t)_i * r##voff + (voff)), (PG8_LAS unsigned*)(lds + (bufoff) + ldsw + _i * 8192), 16, 0, 0); } while (0)
#define rvoffA rstepA
#define rvoffB rstepB
#define PG8_LDA(dst, b, h) do { _Pragma("unroll") for (int m = 0; m < 4; ++m) _Pragma("unroll") for (int k = 0; k < 2; ++k) dst[m][k] = *(const PG8_LAS bf16x8*)(lds + (PG8_SA(b, h) + wr * 8192) + aoff + m * 2048 + k * 1024); } while (0)
#define PG8_LDB(dst, b, h) do { _Pragma("unroll") for (int n = 0; n < 2; ++n) _Pragma("unroll") for (int k = 0; k < 2; ++k) dst[n][k] = *(const PG8_LAS bf16x8*)(lds + (PG8_SB(b, h) + wc * 4096) + boff + n * 2048 + k * 1024); } while (0)
#define PG8_MMA(ai, bj, At, Bt) do { __builtin_amdgcn_s_setprio(1); _Pragma("unroll") for (int m = 0; m < 4; ++m) _Pragma("unroll") for (int n = 0; n < 2; ++n) _Pragma("unroll") for (int k = 0; k < 2; ++k) \
        acc[ai][bj][m][n] = __builtin_amdgcn_mfma_f32_16x16x32_bf16(Bt[n][k], At[m][k], acc[ai][bj][m][n], 0, 0, 0); __builtin_amdgcn_s_setprio(0); } while (0)
#define PG8_WAIT_V(n) asm volatile("s_waitcnt vmcnt(" #n ")" ::: "memory")
#define PG8_WAIT_L(n) asm volatile("s_waitcnt lgkmcnt(" #n ")" ::: "memory")
#define PG8_BAR __builtin_amdgcn_s_barrier()
#define PG8_SCHED __builtin_amdgcn_sched_barrier(0)
    Unit cur, nxt; int ui = 0;
    if (!S.next(0, cur)) return;
    f32x4 acc[2][2][4][2];
#pragma unroll
    for (int a = 0; a < 2; ++a)
#pragma unroll
        for (int b = 0; b < 2; ++b)
#pragma unroll
            for (int m = 0; m < 4; ++m)
#pragma unroll
                for (int n = 0; n < 2; ++n) acc[a][b][m][n] = (f32x4){0.f, 0.f, 0.f, 0.f};
    bf16x8 At[4][2], B0[2][2], B1[2][2];
    const char* cA = (const char*)g.A + (size_t)cur.pm * tstepA; const char* cB = (const char*)g.Bt + (size_t)cur.pn * tstep;
    S.a_ready(cur);
    if constexpr (SP2) {
        PG8_STAGE(PG8_SB(0, 0), cB, voffB); PG8_STAGE(PG8_SB(0, 1), cB + hstep, voffB); PG8_STAGE(PG8_SA(0, 0), cA + PG8_KA(0), voffA); PG8_STAGE(PG8_SA(0, 1), cA + hstepA + PG8_KA(0), voffA);
        if (wr == 1) PG8_BAR;
        PG8_WAIT_V(2); PG8_BAR;
        PG8_STAGE(PG8_SB(1, 0), cB + kstep, voffB); PG8_STAGE(PG8_SA(1, 0), cA + PG8_KA(1), voffA); PG8_STAGE(PG8_SB(1, 1), cB + hstep + kstep, voffB);
        PG8_WAIT_V(6); PG8_BAR;
    } else {
        PG8_STAGE(PG8_SB(0, 0), cB, voffB); PG8_STAGE(PG8_SA(0, 0), cA, voffA); PG8_STAGE(PG8_SB(0, 1), cB + hstep, voffB); PG8_STAGE(PG8_SA(0, 1), cA + hstep, voffA);
        if (wr == 1) PG8_BAR;
        PG8_WAIT_V(4); PG8_BAR;
        PG8_STAGE(PG8_SB(1, 0), cB + kstep, voffB); PG8_STAGE(PG8_SA(1, 0), cA + kstep, voffA); PG8_STAGE(PG8_SB(1, 1), cB + hstep + kstep, voffB);
        PG8_WAIT_V(6); PG8_BAR;
    }
    { const int t3_ = opaque_tid(wv_), l3_ = t3_ & 63, w3_ = __builtin_amdgcn_readfirstlane(t3_ >> 6); aoff = lds_byte((l3_ & 15), (l3_ >> 4) * 8); boff = aoff; }
    for (;;) {
        const bool has_next = S.next(ui + 1, nxt);
        const char* nA = has_next ? (const char*)g.A + (size_t)nxt.pm * tstepA : cA; const char* nB = has_next ? (const char*)g.Bt + (size_t)nxt.pn * tstep : cB;
        for (int t = 0; t < nt; t += 2) {
            const bool last = (t == nt - 2);
            const char* a1 = cA + PG8_KA(t + 1);
            const char* a2 = last ? nA + PG8_KA(0) : cA + PG8_KA(t + 2); const char* b2 = last ? nB : cB + (size_t)(t + 2) * kstep;
            const char* a3 = last ? nA + PG8_KA(1) : cA + PG8_KA(t + 3); const char* b3 = b2 + kstep;
            if (last && has_next) S.a_ready(nxt);
            if constexpr (SP2) {
            PG8_LDB(B0, 0, 0); PG8_LDB(B1, 0, 1); PG8_SCHED; PG8_LDA(At, 0, 0); PG8_STAGE(PG8_SA(1, 1), a1 + hstepA, voffA);
            PG8_WAIT_V(8); PG8_WAIT_L(0); PG8_BAR; PG8_MMA(0, 0, At, B0); PG8_MMA(0, 1, At, B1); PG8_BAR; PG8_SCHED;
            PG8_LDA(At, 0, 1); PG8_STAGE(PG8_SB(0, 0), b2, voffB); PG8_STAGE(PG8_SB(0, 1), b2 + hstep, voffB); PG8_STAGE(PG8_SA(0, 0), a2, voffA);
            PG8_WAIT_V(8); PG8_WAIT_L(0); PG8_BAR; PG8_MMA(1, 0, At, B0); PG8_MMA(1, 1, At, B1); PG8_BAR; PG8_SCHED;
            PG8_LDB(B0, 1, 0); PG8_LDB(B1, 1, 1); PG8_SCHED; PG8_LDA(At, 1, 0); PG8_STAGE(PG8_SA(0, 1), a2 + hstepA, voffA);
            PG8_WAIT_V(8); PG8_WAIT_L(0); PG8_BAR; PG8_MMA(0, 0, At, B0); PG8_MMA(0, 1, At, B1); PG8_BAR; PG8_SCHED;
            PG8_LDA(At, 1, 1); PG8_STAGE(PG8_SB(1, 0), b3, voffB); PG8_STAGE(PG8_SB(1, 1), b3 + hstep, voffB); PG8_STAGE(PG8_SA(1, 0), a3, voffA);
            PG8_WAIT_V(8); PG8_WAIT_L(0); PG8_BAR; PG8_MMA(1, 0, At, B0); PG8_MMA(1, 1, At, B1); PG8_BAR; PG8_SCHED;
            } else {
            PG8_LDB(B0, 0, 0); PG8_SCHED; PG8_LDA(At, 0, 0); PG8_STAGE(PG8_SA(1, 1), a1 + hstep, voffA);
            PG8_WAIT_L(8); PG8_BAR; PG8_WAIT_L(0); PG8_MMA(0, 0, At, B0); PG8_BAR; PG8_SCHED;
            PG8_LDB(B1, 0, 1); PG8_STAGE(PG8_SB(0, 0), b2, voffB);
            PG8_BAR; PG8_WAIT_L(0); PG8_MMA(0, 1, At, B1); PG8_BAR;
            PG8_LDA(At, 0, 1); PG8_STAGE(PG8_SA(0, 0), a2, voffA);
            PG8_BAR; PG8_WAIT_L(0); PG8_MMA(1, 0, At, B0); PG8_BAR; PG8_SCHED;
            PG8_STAGE(PG8_SB(0, 1), b2 + hstep, voffB);
            PG8_WAIT_V(6); PG8_BAR; PG8_MMA(1, 1, At, B1); PG8_BAR;
            PG8_LDB(B0, 1, 0); PG8_SCHED; PG8_LDA(At, 1, 0); PG8_STAGE(PG8_SA(0, 1), a2 + hstep, voffA);
            PG8_WAIT_L(8); PG8_BAR; PG8_WAIT_L(0); PG8_MMA(0, 0, At, B0); PG8_BAR; PG8_SCHED;
            PG8_LDB(B1, 1, 1); PG8_STAGE(PG8_SB(1, 0), b3, voffB);
            PG8_BAR; PG8_WAIT_L(0); PG8_MMA(0, 1, At, B1); PG8_BAR;
            PG8_LDA(At, 1, 1); PG8_STAGE(PG8_SA(1, 0), a3, voffA);
            PG8_BAR; PG8_WAIT_L(0); PG8_MMA(1, 0, At, B0); PG8_BAR; PG8_SCHED;
            PG8_STAGE(PG8_SB(1, 1), b3 + hstep, voffB);
            PG8_WAIT_V(6); PG8_BAR; PG8_MMA(1, 1, At, B1); PG8_BAR;
            }
        }
        if constexpr (ALIGN_EPI) { if (wr == 0) PG8_BAR; }
        if constexpr (!Epi::AFTER_DRAIN) { const int t2_ = opaque_tid(wv_), l2_ = t2_ & 63, w2_ = __builtin_amdgcn_readfirstlane(t2_ >> 6); E(acc, cur, w2_ >> 2, w2_ & 3, l2_ & 15, l2_ >> 4); S.done(cur); }
        if (!has_next) break;
#pragma unroll
        for (int a = 0; a < 2; ++a)
#pragma unroll
            for (int b = 0; b < 2; ++b)
#pragma unroll
                for (int m = 0; m < 4; ++m)
#pragma unroll
                    for (int n = 0; n < 2; ++n) acc[a][b][m][n] = (f32x4){0.f, 0.f, 0.f, 0.f};
        cur = nxt; cA = nA; cB = nB; ++ui;
        if constexpr (ALIGN_EPI) { if (wr == 1) PG8_BAR; }
    }
    PG8_WAIT_V(0);
    if constexpr (!ALIGN_EPI) { if (wr == 0) PG8_BAR; }
    PG8_BAR;
    if constexpr (Epi::AFTER_DRAIN) { E.fused(acc, cur, wr, wc, fr, fq, lds, wid, lane); S.done(cur); }
#undef PG8_SA
#undef PG8_SB
#undef PG8_STAGE
#undef rvoffA
#undef rvoffB
#undef PG8_LDA
#undef PG8_LDB
#undef PG8_MMA
#undef PG8_WAIT_V
#undef PG8_WAIT_L
#undef PG8_BAR
#undef PG8_SCHED
#undef PG8_KA
}
}

__device__ __forceinline__ void wt_tile(const float* __restrict__ W, int N, bf16_t* __restrict__ Wt, int kt, int nt, unsigned char* lds, int wv_, const float* gk = nullptr) {
#ifdef OFF_wt_tile
  return;
#endif

  float* tl = (float*)lds;
  const int tid = opaque_tid(wv_);
  const int r = tid >> 3, c8 = (tid & 7) * 8;
  const float* src = W + (size_t)(kt * 64 + r) * N + nt * 64 + c8;
  float4 v0 = *(const float4*)src, v1 = *(const float4*)(src + 4);
  if (gk) { const float g_ = gk[kt * 64 + r]; v0.x *= g_; v0.y *= g_; v0.z *= g_; v0.w *= g_; v1.x *= g_; v1.y *= g_; v1.z *= g_; v1.w *= g_; }
  float* d = tl + r * 65 + c8;
  d[0] = v0.x; d[1] = v0.y; d[2] = v0.z; d[3] = v0.w; d[4] = v1.x; d[5] = v1.y; d[6] = v1.z; d[7] = v1.w;
  __syncthreads();
  uint4 o;
  o.x = pack2(tl[(c8 + 0) * 65 + r], tl[(c8 + 1) * 65 + r]);
  o.y = pack2(tl[(c8 + 2) * 65 + r], tl[(c8 + 3) * 65 + r]);
  o.z = pack2(tl[(c8 + 4) * 65 + r], tl[(c8 + 5) * 65 + r]);
  o.w = pack2(tl[(c8 + 6) * 65 + r], tl[(c8 + 7) * 65 + r]);
  *(uint4*)(Wt + (size_t)(nt * 64 + r) * 1024 + kt * 64 + c8) = o;
  __syncthreads();
}

__device__ __forceinline__ void norm_rows(const bool F32OUT, const float* src, const float* __restrict__ g, void* dst, int nrows, float pd, int wv_, float* ssq_out = nullptr) {
#ifdef OFF_norm_rows
  return;
#endif

  const int tid = opaque_tid(wv_);
  const int lane = tid & 63;
  const int gw = blockIdx.x * 8 + (tid >> 6), nw = gridDim.x * 8;
  float4 gv[4];
#pragma unroll
  for (int i = 0; i < 4; ++i) gv[i] = ssq_out ? make_float4(1.f, 1.f, 1.f, 1.f) : *(const float4*)(g + i * 256 + lane * 4);
  for (int row = gw; row < nrows; row += nw) {
    const float* s = src + (size_t)row * 1024;
    float4 v[4]; float ss = 0.f;
#pragma unroll
    for (int i = 0; i < 4; ++i) { v[i] = *(const float4*)(s + i * 256 + lane * 4); ss += v[i].x * v[i].x + v[i].y * v[i].y + v[i].z * v[i].z + v[i].w * v[i].w; }
    ss = wave_sum(ss, lane);
    if (ssq_out) { if (lane == 0) ssq_out[row] = ss; }
    const float rs = ssq_out ? 1.0f : rsqrtf(ss * (1.0f / 1024.0f) + 1e-6f);
#pragma unroll
    for (int i = 0; i < 4; ++i) {
      const float a = v[i].x * rs * gv[i].x, b = v[i].y * rs * gv[i].y, c = v[i].z * rs * gv[i].z, d = v[i].w * rs * gv[i].w;
      if (F32OUT) { *(float4*)((float*)dst + (size_t)row * 1024 + i * 256 + lane * 4) = make_float4(a + pd, b + pd, c + pd, d + pd); }
      else { uint2 o; o.x = pack2(a, b); o.y = pack2(c, d); *(uint2*)((bf16_t*)dst + (size_t)row * 1024 + i * 256 + lane * 4) = o; }
    }
  }
}

__device__ __forceinline__ void rwkv_prep_item(KP P, int l, int item, int nitems, unsigned char* lds, int wv_) {
#ifdef OFF_rwkv_prep_item
  return;
#endif

  const bf16_t* p = (const bf16_t*)(P->ws + WS_P);
  float* PW = (float*)(P->ws + WS_PW); bf16_t* PV = (bf16_t*)(P->ws + WS_PV); float* RK = (float*)(P->ws + WS_RK);
  float* lora = (float*)lds;
  const int tid = opaque_tid(wv_), lane = tid & 63, w = tid >> 6, head = w & 3, sub = w >> 2;
  const int c = head * 64 + lane;
  const float* mu = P->in[4] + l * 832;
  const float mur = mu[c], muk = mu[256 + c], muv = mu[512 + c], mux = mu[768 + lane];
  const float w0 = P->in[5][l * 256 + c], a0 = P->in[7][l * 256 + c];
  const float kkw = P->in[9][l * 256 + c], kaw = P->in[10][l * 256 + c], rkw = P->in[11][l * 256 + c];
  float wup[32], aup[32];
#pragma unroll
  for (int j = 0; j < 32; ++j) { wup[j] = P->in[6][(l * 32 + j) * 256 + c]; aup[j] = P->in[8][(l * 32 + j) * 256 + c]; }
  bf16_t raw[4][8];
#define PREP_LOAD(g) { _Pragma("unroll") for (int j_ = 0; j_ < 4; ++j_) { const int t_ = item * 16 + sub + 2 * ((g) * 4 + j_); const bool hp_ = (t_ & (TSEQ - 1)) > 0; \
      const bf16_t* pr_ = p + (size_t)t_ * NIN; raw[j_][0] = pr_[c]; raw[j_][1] = pr_[256 + c]; raw[j_][2] = pr_[512 + c]; raw[j_][3] = pr_[768 + lane]; \
      raw[j_][4] = hp_ ? pr_[c - NIN] : (bf16_t)0; raw[j_][5] = hp_ ? pr_[256 + c - NIN] : (bf16_t)0; raw[j_][6] = hp_ ? pr_[512 + c - NIN] : (bf16_t)0; raw[j_][7] = hp_ ? pr_[768 + lane - NIN] : (bf16_t)0; } }
  PREP_LOAD(0);
  int ng_ = 2 * nitems; asm volatile("" : "+s"(ng_));
#pragma unroll 1
  for (int g = 0; g < ng_; ++g) {
    float rr[4], kk4[4], vv4[4];
#pragma unroll
    for (int j = 0; j < 4; ++j) {
      float r = bf2f(raw[j][0]), k = bf2f(raw[j][1]), v = bf2f(raw[j][2]), x = bf2f(raw[j][3]);
      r += (bf2f(raw[j][4]) - r) * mur; k += (bf2f(raw[j][5]) - k) * muk; v += (bf2f(raw[j][6]) - v) * muv; x += (bf2f(raw[j][7]) - x) * mux;
      rr[j] = r; kk4[j] = k; vv4[j] = v;
      lora[(w * 4 + j) * 64 + lane] = lane < 32 ? (1.0f - 2.0f * __builtin_amdgcn_rcpf(1.0f + __expf(2.0f * x))) : x;
    }
    if (g + 1 < ng_) PREP_LOAD(g + 1);
    __builtin_amdgcn_s_waitcnt(0xc07f);
    __builtin_amdgcn_wave_barrier();
    float wv4[4], av4[4];
#pragma unroll
    for (int j = 0; j < 4; ++j) { wv4[j] = w0; av4[j] = a0; }
#pragma unroll
    for (int jj = 0; jj < 32; jj += 4) {
#pragma unroll
      for (int j = 0; j < 4; ++j) { const float* lo = lora + (w * 4 + j) * 64; const float4 lw = *(const float4*)(lo + jj), la = *(const float4*)(lo + 32 + jj);
        wv4[j] += lw.x * wup[jj]; wv4[j] += lw.y * wup[jj + 1]; wv4[j] += lw.z * wup[jj + 2]; wv4[j] += lw.w * wup[jj + 3];
        av4[j] += la.x * aup[jj]; av4[j] += la.y * aup[jj + 1]; av4[j] += la.z * aup[jj + 2]; av4[j] += la.w * aup[jj + 3]; }
    }
    float dec4[4], ar4[4], kkq[4], kmod4[4], n24[4], rk4[4];
#pragma unroll
    for (int j = 0; j < 4; ++j) {
      const float wlog = -softplus_fast(-wv4[j]) - 0.5f;
      dec4[j] = __expf(-__expf(wlog));
      ar4[j] = sigmoidf_(av4[j]);
      kkq[j] = kk4[j] * kkw;
      kmod4[j] = kk4[j] * (1.0f + (ar4[j] - 1.0f) * kaw);
      n24[j] = kkq[j] * kkq[j]; rk4[j] = rr[j] * kmod4[j] * rkw;
    }
#pragma unroll
    for (int st = 0; st < 4; ++st) {
      const int ctrl = st == 0 ? 0xB1 : st == 1 ? 0x4E : st == 2 ? 0x141 : 0x140;
#pragma unroll
      for (int j = 0; j < 4; ++j) {
        if (st == 0) { n24[j] += __builtin_bit_cast(float, __builtin_amdgcn_update_dpp(0, __builtin_bit_cast(int, n24[j]), 0xB1, 0xF, 0xF, true)); rk4[j] += __builtin_bit_cast(float, __builtin_amdgcn_update_dpp(0, __builtin_bit_cast(int, rk4[j]), 0xB1, 0xF, 0xF, true)); }
        else if (st == 1) { n24[j] += __builtin_bit_cast(float, __builtin_amdgcn_update_dpp(0, __builtin_bit_cast(int, n24[j]), 0x4E, 0xF, 0xF, true)); rk4[j] += __builtin_bit_cast(float, __builtin_amdgcn_update_dpp(0, __builtin_bit_cast(int, rk4[j]), 0x4E, 0xF, 0xF, true)); }
        else if (st == 2) { n24[j] += __builtin_bit_cast(float, __builtin_amdgcn_update_dpp(0, __builtin_bit_cast(int, n24[j]), 0x141, 0xF, 0xF, true)); rk4[j] += __builtin_bit_cast(float, __builtin_amdgcn_update_dpp(0, __builtin_bit_cast(int, rk4[j]), 0x141, 0xF, 0xF, true)); }
        else { n24[j] += __builtin_bit_cast(float, __builtin_amdgcn_update_dpp(0, __builtin_bit_cast(int, n24[j]), 0x140, 0xF, 0xF, true)); rk4[j] += __builtin_bit_cast(float, __builtin_amdgcn_update_dpp(0, __builtin_bit_cast(int, rk4[j]), 0x140, 0xF, 0xF, true)); }
      }
      (void)ctrl;
    }
    { float t0[4], t1[4];
#pragma unroll
      for (int j = 0; j < 4; ++j) { t0[j] = bperm(n24[j], lane ^ 16); t1[j] = bperm(rk4[j], lane ^ 16); }
#pragma unroll
      for (int j = 0; j < 4; ++j) { n24[j] += t0[j]; rk4[j] += t1[j]; }
#pragma unroll
      for (int j = 0; j < 4; ++j) { t0[j] = bperm(n24[j], lane ^ 32); t1[j] = bperm(rk4[j], lane ^ 32); }
#pragma unroll
      for (int j = 0; j < 4; ++j) { n24[j] += t0[j]; rk4[j] += t1[j]; } }
#pragma unroll
    for (int j = 0; j < 4; ++j) {
      const int t = item * 16 + sub + 2 * (g * 4 + j);
      const int tt = t & (TSEQ - 1), b = t >> 13;
      const float kkn = kkq[j] * __builtin_amdgcn_rsqf(fmaxf(n24[j], 1e-24f));
      const size_t idx = (size_t)(b * 4 + head) * TSEQ + tt;
      PW[idx * 64 + lane] = dec4[j];
      bf16_t* pv = PV + idx * 320;
      pv[lane] = f2bf(rr[j]); pv[64 + lane] = f2bf(kmod4[j]); pv[128 + lane] = f2bf(vv4[j]); pv[192 + lane] = f2bf(-kkn); pv[256 + lane] = f2bf(kkn * ar4[j]);
      if (lane == 0) RK[idx] = rk4[j];
    }
    __builtin_amdgcn_s_waitcnt(0xc07f);
    __builtin_amdgcn_wave_barrier();
  }
#undef PREP_LOAD
  __syncthreads();
}

#define RW_TILE_B (RW_TT * 1536)
struct RwRegs { float4 pw; uint4 pv0, pv1; };
__device__ __forceinline__ void rw_issue(const float* __restrict__ PW, const bf16_t* __restrict__ PV, size_t idx0, int tid, RwRegs& r) {
  if (tid < RW_TT * 16) { const int s = tid >> 4, q = tid & 15; r.pw = *(const float4*)(PW + (idx0 + s) * 64 + q * 4); }
  { const int c = tid; const int s = c / 40, q = c % 40; r.pv0 = *(const uint4*)(PV + (idx0 + s) * 320 + q * 8); }
  if (tid < RW_TT * 40 - NTHR) { const int c = tid + NTHR; const int s = c / 40, q = c % 40; r.pv1 = *(const uint4*)(PV + (idx0 + s) * 320 + q * 8); }
}
__device__ __forceinline__ void rw_put(float* dst, int c, const uint4 u) {
  const int s = c / 40, q = c % 40;
  const int vec = q >> 3, off = (q & 7) * 8;
  const int slot = vec == 0 ? 4 : vec == 1 ? 3 : vec == 2 ? 5 : vec == 3 ? 1 : 2;
  float* d = dst + s * 384 + slot * 64 + off;
  *(float4*)d = make_float4(__uint_as_float(u.x << 16), __uint_as_float(u.x & 0xffff0000u), __uint_as_float(u.y << 16), __uint_as_float(u.y & 0xffff0000u));
  *(float4*)(d + 4) = make_float4(__uint_as_float(u.z << 16), __uint_as_float(u.z & 0xffff0000u), __uint_as_float(u.w << 16), __uint_as_float(u.w & 0xffff0000u));
}
__device__ __forceinline__ void rw_commit(unsigned char* dstb, int tid, const RwRegs& r) {
  float* dst = (float*)dstb;
  if (tid < RW_TT * 16) { const int s = tid >> 4, q = tid & 15; *(float4*)(dst + s * 384 + q * 4) = r.pw; }
  rw_put(dst, tid, r.pv0);
  if (tid < RW_TT * 40 - NTHR) rw_put(dst, tid + NTHR, r.pv1);
}

#define LD8(dst, ptr) { const float4 x0_ = *(const float4*)(ptr), x1_ = *(const float4*)((ptr) + 4); dst[0] = (f32x2){x0_.x, x0_.y}; dst[1] = (f32x2){x0_.z, x0_.w}; dst[2] = (f32x2){x1_.x, x1_.y}; dst[3] = (f32x2){x1_.z, x1_.w}; }
struct RwOps { f32x2 w[4], a[4], b[4], k[4], r[4]; float vA, vB; };
template <int MODE>
__device__ __forceinline__ void rw_ldops(RwOps& o, const float* tb, int s, int q, int rowA, int rowB) {
  const float* sp = tb + s * 384 + q * 8;
  LD8(o.w, sp); LD8(o.a, sp + 64); LD8(o.b, sp + 128); LD8(o.k, sp + 192);
  o.vA = tb[s * 384 + 320 + rowA];
  if (MODE == 0) { LD8(o.r, sp + 256); o.vB = tb[s * 384 + 320 + rowB]; }
}
template <int MODE>
__device__ __forceinline__ void rw_step(const RwOps& o, f32x2 (&SA)[4], f32x2 (&SB)[4], float* yb, int s, int q, int rowA, int rowB) {
  f32x2 dA = SA[0] * o.a[0], dB = SB[0] * o.a[0];
#pragma unroll
  for (int e = 1; e < 4; ++e) { dA = SA[e] * o.a[e] + dA; dB = SB[e] * o.a[e] + dB; }
  const float dotA = red8(dA.x + dA.y), dotB = red8(dB.x + dB.y);
  const f32x2 dA2 = {dotA, dotA}, dB2 = {dotB, dotB}, vA2 = {o.vA, o.vA};
  if (MODE == 0) {
    const f32x2 vB2 = {o.vB, o.vB};
#pragma unroll
    for (int e = 0; e < 4; ++e) { SA[e] = SA[e] * o.w[e] + vA2 * o.k[e]; SA[e] = dA2 * o.b[e] + SA[e]; SB[e] = SB[e] * o.w[e] + vB2 * o.k[e]; SB[e] = dB2 * o.b[e] + SB[e]; }
    f32x2 yA = SA[0] * o.r[0], yB = SB[0] * o.r[0];
#pragma unroll
    for (int e = 1; e < 4; ++e) { yA = SA[e] * o.r[e] + yA; yB = SB[e] * o.r[e] + yB; }
    const float ya = red8(yA.x + yA.y), ybv = red8(yB.x + yB.y);
    if (q == 0) { yb[s * 64 + rowA] = ya; yb[s * 64 + rowB] = ybv; }
  } else {
#pragma unroll
    for (int e = 0; e < 4; ++e) { SA[e] = dA2 * o.b[e] + SA[e] * o.w[e]; SB[e] = SB[e] * o.w[e] + vA2 * o.k[e]; SB[e] = dB2 * o.b[e] + SB[e]; }
  }
}
template <int MODE>
__device__ __forceinline__ void rwkv_scan_item(KP P, int l, int bh, int chunk, unsigned char* lds, int wv_) {
  const float* PW = (const float*)(P->ws + WS_PW); const bf16_t* PV = (const bf16_t*)(P->ws + WS_PV); const float* RK = (const float*)(P->ws + WS_RK);
  float* PQ = (float*)(P->ws + WS_PQ);
  bf16_t* p = (bf16_t*)(P->ws + WS_P);
  const int tid = opaque_tid(wv_), lane = tid & 63, w = tid >> 6;
  const int q = lane & 7;
  const int rowA = (MODE == 0) ? ((w & 3) * 16 + (lane >> 3)) : (w * 8 + (lane >> 3));
  const int rowB = rowA + 8;
  const int b = bh >> 2, head = bh & 3;
  unsigned char* tile0 = lds;
  float* ybuf = (float*)(lds + 3 * RW_TILE_B);
  float* Sl = (float*)(lds + 3 * RW_TILE_B + 2 * RW_TT * 256);
  f32x2 SA[4], SB[4];
#pragma unroll
  for (int e = 0; e < 4; ++e) { SA[e] = (f32x2){0.f, 0.f}; SB[e] = (f32x2){0.f, 0.f}; }
  if (MODE == 1) {
#pragma unroll
    for (int e = 0; e < 4; ++e) SA[e] = (f32x2){(q * 8 + 2 * e == rowA) ? 1.f : 0.f, (q * 8 + 2 * e + 1 == rowA) ? 1.f : 0.f};
  }
  if (MODE == 0 && chunk > 0) {
    const float* Q0 = PQ + ((size_t)(bh * RW_C + 0) * 2 + 1) * 4096;
    float* cur = Sl; float* nxt = Sl + 64 * 65;
    for (int i = tid; i < 1024; i += NTHR) { const float4 v_ = *(const float4*)(Q0 + i * 4); float* d_ = cur + (i >> 4) * 65 + (i & 15) * 4; d_[0] = v_.x; d_[1] = v_.y; d_[2] = v_.z; d_[3] = v_.w; }
    float* Pl = (float*)lds;
    const float4 z4_ = make_float4(0.f, 0.f, 0.f, 0.f); const f32x4 zq_ = {0.f, 0.f, 0.f, 0.f};
    float4 cs0p0 = z4_, cs0p1 = z4_, cs1p0 = z4_, cs1p1 = z4_, cs2p0 = z4_, cs2p1 = z4_, cs3p0 = z4_, cs3p1 = z4_;
    f32x4 cs0q0 = zq_, cs0q1 = zq_, cs1q0 = zq_, cs1q1 = zq_, cs2q0 = zq_, cs2q1 = zq_, cs3q0 = zq_, cs3q1 = zq_;
    const int ti = w >> 1;
    const int qoff0 = 4096 + (ti * 16 + (lane >> 4) * 4) * 64 + ((w & 1) * 2 + 0) * 16 + (lane & 15);
#define CS_LOAD(S_, c_) { const float* Pm_ = PQ + ((size_t)(bh * RW_C + (c_)) * 2 + 0) * 4096; S_##p0 = *(const float4*)(Pm_ + tid * 4); S_##p1 = *(const float4*)(Pm_ + (tid + NTHR) * 4); \
      S_##q0 = (f32x4){Pm_[qoff0], Pm_[qoff0 + 64], Pm_[qoff0 + 128], Pm_[qoff0 + 192]}; S_##q1 = (f32x4){Pm_[qoff0 + 16], Pm_[qoff0 + 80], Pm_[qoff0 + 144], Pm_[qoff0 + 208]}; }
#define CS_STEP(S_, c_) { LBAR(); *(float4*)(Pl + (tid >> 4) * 80 + (tid & 15) * 4) = S_##p0; *(float4*)(Pl + ((tid + NTHR) >> 4) * 80 + (tid & 15) * 4) = S_##p1; const f32x4 qc0 = S_##q0, qc1 = S_##q1; \
      if ((c_) + 4 < chunk) CS_LOAD(S_, (c_) + 4); \
      LBAR(); \
      _Pragma("unroll") for (int jj = 0; jj < 2; ++jj) { const int tj = (w & 1) * 2 + jj; f32x4 acc = jj == 0 ? qc0 : qc1; \
        _Pragma("unroll") for (int ks = 0; ks < 16; ++ks) { const float a = cur[(ti * 16 + (lane & 15)) * 65 + ks * 4 + (lane >> 4)]; const float bb = Pl[(ks * 4 + (lane >> 4)) * 80 + tj * 16 + (lane & 15)]; \
          acc = __builtin_amdgcn_mfma_f32_16x16x4f32(a, bb, acc, 0, 0, 0); } \
        _Pragma("unroll") for (int r = 0; r < 4; ++r) nxt[(ti * 16 + (lane >> 4) * 4 + r) * 65 + tj * 16 + (lane & 15)] = acc[r]; } \
      float* t_ = cur; cur = nxt; nxt = t_; }
    if (1 < chunk) CS_LOAD(cs0, 1);
    if (2 < chunk) CS_LOAD(cs1, 2);
    if (3 < chunk) CS_LOAD(cs2, 3);
    if (4 < chunk) CS_LOAD(cs3, 4);
#pragma unroll 1
    for (int cc = 1; cc < chunk; cc += 4) {
      CS_STEP(cs0, cc);
      if (cc + 1 < chunk) CS_STEP(cs1, cc + 1);
      if (cc + 2 < chunk) CS_STEP(cs2, cc + 2);
      if (cc + 3 < chunk) CS_STEP(cs3, cc + 3);
    }
#undef CS_LOAD
#undef CS_STEP
    __syncthreads();
#pragma unroll
    for (int e = 0; e < 4; ++e) { SA[e] = (f32x2){cur[rowA * 65 + q * 8 + 2 * e], cur[rowA * 65 + q * 8 + 2 * e + 1]}; SB[e] = (f32x2){cur[rowB * 65 + q * 8 + 2 * e], cur[rowB * 65 + q * 8 + 2 * e + 1]}; }
    __syncthreads();
  }
  const size_t idxb = (size_t)bh * TSEQ + (size_t)chunk * RW_CL;
  const int ntile = RW_CL / RW_TT;
  RwRegs rr;
  rw_issue(PW, PV, idxb, tid, rr);
  rw_commit(tile0, tid, rr);
  const int chh = head * 64 + lane;
  const float lng = P->in[12][l * 256 + chh], lnb = P->in[13][l * 256 + chh];
  __syncthreads();
  const int nit = (MODE == 0) ? ntile + 1 : ntile;
  for (int tl = 0; tl < nit; ++tl) {
    if (tl + 1 < ntile) rw_issue(PW, PV, idxb + (size_t)(tl + 1) * RW_TT, tid, rr);
    if (MODE == 1 || w < 4) {
      if (tl < ntile) {
        const float* tb = (const float*)(tile0 + (tl % 3) * RW_TILE_B);
        float* yb = ybuf + (tl & 1) * (RW_TT * 64);
        RwOps oa, ob;
        rw_ldops<MODE>(oa, tb, 0, q, rowA, rowB);
        __builtin_amdgcn_sched_barrier(0);
#pragma unroll 1
        for (int s = 0; s < RW_TT; s += 2) {
          rw_ldops<MODE>(ob, tb, s + 1, q, rowA, rowB);
          __builtin_amdgcn_sched_barrier(0);
          rw_step<MODE>(oa, SA, SB, yb, s, q, rowA, rowB);
          __builtin_amdgcn_sched_barrier(0);
          if (s + 2 < RW_TT) rw_ldops<MODE>(oa, tb, s + 2, q, rowA, rowB);
          __builtin_amdgcn_sched_barrier(0);
          rw_step<MODE>(ob, SA, SB, yb, s + 1, q, rowA, rowB);
          __builtin_amdgcn_sched_barrier(0);
        }
      }
      if (tl + 1 < ntile) rw_commit(tile0 + ((tl + 1) % 3) * RW_TILE_B, tid, rr);
    } else {
      const int fw = w - 4;
      f32x4 gcu = {0.f, 0.f, 0.f, 0.f}, rkcu = {0.f, 0.f, 0.f, 0.f};
      if (tl > 0) {
#pragma unroll
        for (int u = 0; u < 4; ++u) { const int tt = chunk * RW_CL + (tl - 1) * RW_TT + fw + 4 * u;
          gcu[u] = bf2f(p[(size_t)(b * TSEQ + tt) * NIN + C_GA + chh]); rkcu[u] = RK[(size_t)bh * TSEQ + tt]; }
      }
      asm volatile("s_waitcnt vmcnt(0)" ::: "memory");
      if (tl + 1 < ntile) rw_commit(tile0 + ((tl + 1) % 3) * RW_TILE_B, tid, rr);
      __builtin_amdgcn_sched_barrier(0);
      if (tl > 0) {
        const float* tb = (const float*)(tile0 + ((tl - 1) % 3) * RW_TILE_B);
        const float* yb = ybuf + ((tl - 1) & 1) * (RW_TT * 64);
#pragma unroll
        for (int u = 0; u < 4; ++u) {
          const int s = fw + 4 * u;
          const int tt = chunk * RW_CL + (tl - 1) * RW_TT + s;
          const float y = yb[s * 64 + lane];
          const float mean = wave_sum(y, lane) * (1.0f / 64.0f);
          const float dlt = y - mean;
          const float var = wave_sum(dlt * dlt, lane) * (1.0f / 64.0f);
          float o = dlt * rsqrtf(var + 64e-5f) * lng + lnb;
          const float vv = tb[s * 384 + 320 + lane];
          o += rkcu[u] * vv;
          p[(size_t)(b * TSEQ + tt) * NIN + C_GA + chh] = f2bf(o * siluf_(gcu[u]));
        }
      }
    }
    LBAR();
  }
  if (MODE == 1) {
    float* Pm = PQ + ((size_t)(bh * RW_C + chunk) * 2 + 0) * 4096 + rowA * 64 + q * 8;
    *(float4*)Pm = make_float4(SA[0].x, SA[0].y, SA[1].x, SA[1].y); *(float4*)(Pm + 4) = make_float4(SA[2].x, SA[2].y, SA[3].x, SA[3].y);
    *(float4*)(Pm + 4096) = make_float4(SB[0].x, SB[0].y, SB[1].x, SB[1].y); *(float4*)(Pm + 4100) = make_float4(SB[2].x, SB[2].y, SB[3].x, SB[3].y);
  } else if (chunk == 0 && w < 4) {
    float* Qm = PQ + ((size_t)(bh * RW_C + 0) * 2 + 1) * 4096 + q * 8;
    *(float4*)(Qm + rowA * 64) = make_float4(SA[0].x, SA[0].y, SA[1].x, SA[1].y); *(float4*)(Qm + rowA * 64 + 4) = make_float4(SA[2].x, SA[2].y, SA[3].x, SA[3].y);
    *(float4*)(Qm + rowB * 64) = make_float4(SB[0].x, SB[0].y, SB[1].x, SB[1].y); *(float4*)(Qm + rowB * 64 + 4) = make_float4(SB[2].x, SB[2].y, SB[3].x, SB[3].y);
  }
  __syncthreads();
}

__device__ __forceinline__ void conv_item(KP P, int l, int item, unsigned char* lds, int wv_) {
#ifdef OFF_conv_item
  return;
#endif

  bf16_t* p = (bf16_t*)(P->ws + WS_P);
  float* u = (float*)lds;
  float* yb = (float*)(lds + 62 * 1024);
  const int tid = opaque_tid(wv_), c = tid & 255, half = tid >> 8;
  const int t0 = item * 32, tt0 = t0 & (TSEQ - 1);
  {
    bf16_t rv[31], rg[31];
#pragma unroll
    for (int i = 0; i < 31; ++i) { const int r = half + 2 * i; const bool ok = (tt0 - 30 + r) >= 0; const bf16_t* pr = p + (size_t)(t0 - 30 + r) * NIN;
      rv[i] = ok ? pr[C_CVAL + c] : (bf16_t)0; rg[i] = ok ? pr[C_CGLU + c] : (bf16_t)0; }
#pragma unroll
    for (int i = 0; i < 31; ++i) u[(half + 2 * i) * 256 + c] = bf2f(rv[i]) * sigmoidf_(bf2f(rg[i]));
  }
  float wv[31];
#pragma unroll
  for (int j = 0; j < 31; ++j) wv[j] = P->in[14][(l * 31 + j) * 256 + c];
  const float bias = P->in[15][l * 256 + c];
  __syncthreads();
  {
    float win[46];
#pragma unroll
    for (int i = 0; i < 46; ++i) win[i] = u[(half * 16 + i) * 256 + c];
#pragma unroll
    for (int i = 0; i < 16; ++i) {
      float acc = bias;
#pragma unroll
      for (int j = 0; j < 31; ++j) acc = fmaf(wv[j], win[i + j], acc);
      yb[(half * 16 + i) * 256 + c] = acc;
    }
  }
  __syncthreads();
  const int lane = tid & 63, w = tid >> 6;
  const float4 g = *(const float4*)(P->in[16] + l * 256 + lane * 4), bb = *(const float4*)(P->in[17] + l * 256 + lane * 4);
  uint2 gpre[4];
#pragma unroll
  for (int i = 0; i < 4; ++i) gpre[i] = *(const uint2*)(p + (size_t)(t0 + w * 4 + i) * NIN + C_CGATE + lane * 4);
#pragma unroll
  for (int i = 0; i < 4; ++i) {
    const int tk = w * 4 + i;
    const float4 v = *(const float4*)(yb + tk * 256 + lane * 4);
    const float mean = wave_sum(v.x + v.y + v.z + v.w, lane) * (1.0f / 256.0f);
    const float d0 = v.x - mean, d1 = v.y - mean, d2 = v.z - mean, d3 = v.w - mean;
    const float var = wave_sum(d0 * d0 + d1 * d1 + d2 * d2 + d3 * d3, lane) * (1.0f / 256.0f);
    const float rs = rsqrtf(var + 1e-5f);
    bf16_t* gp = p + (size_t)(t0 + tk) * NIN + C_CGATE + lane * 4;
    const uint2 gu = gpre[i];
    const float o0 = siluf_(d0 * rs * g.x + bb.x) * siluf_(__uint_as_float(gu.x << 16));
    const float o1 = siluf_(d1 * rs * g.y + bb.y) * siluf_(__uint_as_float(gu.x & 0xffff0000u));
    const float o2 = siluf_(d2 * rs * g.z + bb.z) * siluf_(__uint_as_float(gu.y << 16));
    const float o3 = siluf_(d3 * rs * g.w + bb.w) * siluf_(__uint_as_float(gu.y & 0xffff0000u));
    uint2 o; o.x = pack2(o0, o1); o.y = pack2(o2, o3);
    *(uint2*)gp = o;
  }
  __syncthreads();
}

#define HG_WLDS 10240
__device__ __forceinline__ float hgrn_lb(KP P, int l, int ch) {
  if (l == 0) return 0.f;
  const float x0 = P->in[18][ch], x1 = P->in[18][256 + ch];
  return __builtin_amdgcn_rcpf(1.0f + __expf(x0 - x1));
}
template <int PASS>
__device__ __forceinline__ void hgrn_wave_item(KP P, int l, int wi, unsigned char* lds, int wv_) {
#ifdef OFF_hgrn_wave_item
  return;
#endif

  bf16_t* p = (bf16_t*)(P->ws + WS_P);
  float* HS = (float*)(P->ws + WS_HS); float* HF = (float*)(P->ws + WS_HF);
  const int tid = opaque_tid(wv_);
  const int lane = tid & 63, w = tid >> 6;
  const int bh = wi >> 7, chunk = wi & 127, b = bh >> 2, head = bh & 3;
  float* st = (float*)(lds + w * HG_WLDS);
  float* ob = st + 2048;
  const int kg = lane & 7, vg = lane >> 3;
  const int ch = head * 64 + lane;
  const float lb = hgrn_lb(P, l, ch);
  const float ng = P->in[19][l * 256 + ch];
  float S[8][8];
  float* slot = HS + (size_t)(bh * 128 + chunk) * 4096;
  if (PASS == 1) {
#pragma unroll
    for (int i = 0; i < 8; ++i) { const float4 x0 = *(const float4*)(slot + (kg * 8 + i) * 64 + vg * 8), x1 = *(const float4*)(slot + (kg * 8 + i) * 64 + vg * 8 + 4);
      S[i][0] = x0.x; S[i][1] = x0.y; S[i][2] = x0.z; S[i][3] = x0.w; S[i][4] = x1.x; S[i][5] = x1.y; S[i][6] = x1.z; S[i][7] = x1.w; }
  } else {
#pragma unroll
    for (int i = 0; i < 8; ++i)
#pragma unroll
      for (int j = 0; j < 8; ++j) S[i][j] = 0.f;
  }
  float Fp = 1.f;
  bf16_t rf[8], ri[8], rq[8], rg[8];
  {
    const int tb0 = b * TSEQ + chunk * 64;
#pragma unroll
    for (int s = 0; s < 8; ++s) { const bf16_t* pr = p + (size_t)(tb0 + s) * NIN; rf[s] = pr[C_HF + ch]; ri[s] = pr[C_HI + ch]; if (PASS == 1) { rq[s] = pr[C_HQ + ch]; rg[s] = pr[C_HG + ch]; } }
  }
#pragma unroll 1
  for (int sub = 0; sub < 8; ++sub) {
    const int tbase = b * TSEQ + chunk * 64 + sub * 8;
    bf16_t gc[8];
#pragma unroll
    for (int s = 0; s < 8; ++s) {
      const float f = lb + (1.0f - lb) * sigmoidf_(bf2f(rf[s]));
      Fp *= f;
      st[s * 256 + lane] = f; st[s * 256 + 64 + lane] = 1.0f - f;
      if (PASS == 1) { st[s * 256 + 128 + lane] = siluf_(bf2f(rq[s])); gc[s] = rg[s]; }
      st[s * 256 + 192 + lane] = bf2f(ri[s]);
    }
    if (sub < 7) {
#pragma unroll
      for (int s = 0; s < 8; ++s) { const bf16_t* pr = p + (size_t)(tbase + 8 + s) * NIN; rf[s] = pr[C_HF + ch]; ri[s] = pr[C_HI + ch]; if (PASS == 1) { rq[s] = pr[C_HQ + ch]; rg[s] = pr[C_HG + ch]; } }
    }
    __builtin_amdgcn_s_waitcnt(0xc07f);
    __builtin_amdgcn_wave_barrier();
#pragma unroll 1
    for (int s = 0; s < 8; ++s) {
      const float* sp = st + s * 256;
      const float4 f0 = *(const float4*)(sp + kg * 8), f1 = *(const float4*)(sp + kg * 8 + 4);
      const float4 k0 = *(const float4*)(sp + 64 + kg * 8), k1 = *(const float4*)(sp + 64 + kg * 8 + 4);
      const float4 v0 = *(const float4*)(sp + 192 + vg * 8), v1 = *(const float4*)(sp + 192 + vg * 8 + 4);
      const float fv[8] = {f0.x, f0.y, f0.z, f0.w, f1.x, f1.y, f1.z, f1.w};
      const float kv[8] = {k0.x, k0.y, k0.z, k0.w, k1.x, k1.y, k1.z, k1.w};
      const float vv[8] = {v0.x, v0.y, v0.z, v0.w, v1.x, v1.y, v1.z, v1.w};
      const f32x2 vv2[4] = {{vv[0], vv[1]}, {vv[2], vv[3]}, {vv[4], vv[5]}, {vv[6], vv[7]}};
#pragma unroll
      for (int i = 0; i < 8; ++i) { const f32x2 f2 = {fv[i], fv[i]}, k2 = {kv[i], kv[i]};
#pragma unroll
        for (int j = 0; j < 4; ++j) { f32x2 s2 = {S[i][2 * j], S[i][2 * j + 1]}; s2 = f2 * s2 + k2 * vv2[j]; S[i][2 * j] = s2.x; S[i][2 * j + 1] = s2.y; } }
      if (PASS == 1) {
        const float4 q0 = *(const float4*)(sp + 128 + kg * 8), q1 = *(const float4*)(sp + 128 + kg * 8 + 4);
        const float qv[8] = {q0.x, q0.y, q0.z, q0.w, q1.x, q1.y, q1.z, q1.w};
        float o[8];
#pragma unroll
        for (int j = 0; j < 4; ++j) { f32x2 a2 = (f32x2){qv[0], qv[0]} * (f32x2){S[0][2 * j], S[0][2 * j + 1]};
#pragma unroll
          for (int i = 1; i < 8; ++i) a2 = (f32x2){qv[i], qv[i]} * (f32x2){S[i][2 * j], S[i][2 * j + 1]} + a2;
          o[2 * j] = red8(a2.x); o[2 * j + 1] = red8(a2.y); }
        if (kg == 0) { *(float4*)(ob + s * 64 + vg * 8) = make_float4(o[0], o[1], o[2], o[3]); *(float4*)(ob + s * 64 + vg * 8 + 4) = make_float4(o[4], o[5], o[6], o[7]); }
      }
    }
    __builtin_amdgcn_s_waitcnt(0xc07f);
    __builtin_amdgcn_wave_barrier();
    if (PASS == 1) {
#pragma unroll
      for (int s = 0; s < 8; ++s) {
        const float o = ob[s * 64 + lane];
        const float ms = wave_sum(o * o, lane) * (1.0f / 64.0f);
        p[(size_t)(tbase + s) * NIN + C_HG + ch] = f2bf(o * rsqrtf(ms + 1e-6f) * ng * siluf_(bf2f(gc[s])));
      }
      __builtin_amdgcn_s_waitcnt(0xc07f);
      __builtin_amdgcn_wave_barrier();
    }
  }
  if (PASS == 0) {
#pragma unroll
    for (int i = 0; i < 8; ++i) { *(float4*)(slot + (kg * 8 + i) * 64 + vg * 8) = make_float4(S[i][0], S[i][1], S[i][2], S[i][3]);
      *(float4*)(slot + (kg * 8 + i) * 64 + vg * 8 + 4) = make_float4(S[i][4], S[i][5], S[i][6], S[i][7]); }
    HF[(size_t)(bh * 128 + chunk) * 64 + lane] = Fp;
  }
}
__device__ __forceinline__ void hgrn_combine_item(KP P, int bh, int wv_) {
#ifdef OFF_hgrn_combine_item
  return;
#endif

  float* HS = (float*)(P->ws + WS_HS); const float* HF = (const float*)(P->ws + WS_HF);
  const int tid = opaque_tid(wv_);
  const int krow = tid >> 3;
  float R[8];
#pragma unroll
  for (int e = 0; e < 8; ++e) R[e] = 0.f;
  float4 xa[8][2]; float fa[8];
#pragma unroll
  for (int u = 0; u < 8; ++u) { const float* sl = HS + (size_t)(bh * 128 + u) * 4096 + tid * 8; xa[u][0] = *(const float4*)sl; xa[u][1] = *(const float4*)(sl + 4); fa[u] = HF[(size_t)(bh * 128 + u) * 64 + krow]; }
#pragma unroll 1
  for (int c0 = 0; c0 < 128; c0 += 8) {
    float4 xn[8][2]; float fn[8];
    if (c0 + 8 < 128) {
#pragma unroll
      for (int u = 0; u < 8; ++u) { const float* sl = HS + (size_t)(bh * 128 + c0 + 8 + u) * 4096 + tid * 8; xn[u][0] = *(const float4*)sl; xn[u][1] = *(const float4*)(sl + 4); fn[u] = HF[(size_t)(bh * 128 + c0 + 8 + u) * 64 + krow]; }
    }
#pragma unroll
    for (int u = 0; u < 8; ++u) {
      float* sl = HS + (size_t)(bh * 128 + c0 + u) * 4096 + tid * 8;
      *(float4*)sl = make_float4(R[0], R[1], R[2], R[3]); *(float4*)(sl + 4) = make_float4(R[4], R[5], R[6], R[7]);
      const float f = fa[u];
      R[0] = fmaf(f, R[0], xa[u][0].x); R[1] = fmaf(f, R[1], xa[u][0].y); R[2] = fmaf(f, R[2], xa[u][0].z); R[3] = fmaf(f, R[3], xa[u][0].w);
      R[4] = fmaf(f, R[4], xa[u][1].x); R[5] = fmaf(f, R[5], xa[u][1].y); R[6] = fmaf(f, R[6], xa[u][1].z); R[7] = fmaf(f, R[7], xa[u][1].w);
    }
    if (c0 + 8 < 128) {
#pragma unroll
      for (int u = 0; u < 8; ++u) { xa[u][0] = xn[u][0]; xa[u][1] = xn[u][1]; fa[u] = fn[u]; }
    }
  }
}

__device__ __forceinline__ void sb_item(KP P, int item, unsigned char* lds, int wv_) {
#ifdef OFF_sb_item
  return;
#endif

  bf16_t* p = (bf16_t*)(P->ws + WS_P);
  const int tid = opaque_tid(wv_), lane = tid & 63, w = tid >> 6;
  const int qt = item & 127, bh = item >> 7, b = bh >> 2, head = bh & 3;
  unsigned char* Qs = lds;
  unsigned char* Ks = lds + 9216;
  unsigned char* Vt = lds + 18432;
  unsigned char* As = lds + 27648;
  float* Zs = (float*)(lds + 36864);
  volatile int* flag = (volatile int*)(lds + 36864 + 64 * 65 * 4);
  const int lrow = tid >> 3, lch = (tid & 7);
  const size_t tokq = (size_t)b * TSEQ + qt * 64;
  *(uint4*)(Qs + lrow * 144 + lch * 16) = *(const uint4*)(p + (tokq + lrow) * NIN + C_SQ + head * 64 + lch * 8);
  float carry = 0.f;
  f32x4 oacc[2] = {{0.f, 0.f, 0.f, 0.f}, {0.f, 0.f, 0.f, 0.f}};
  const int qi = w >> 1, t2 = (w & 1) * 2;
  f32x4 gpre0, gpre1;
#pragma unroll
  for (int r = 0; r < 4; ++r) { const bf16_t* gp_ = p + (tokq + qi * 16 + (lane >> 4) * 4 + r) * NIN + C_SG + head * 64 + t2 * 16 + (lane & 15); gpre0[r] = bf2f(gp_[0]); gpre1[r] = bf2f(gp_[16]); }
  const int q = tid >> 3, seg = tid & 7;
  uint4 kreg = *(const uint4*)(p + (tokq + lrow) * NIN + C_SK + head * 64 + lch * 8);
  const int vkey = tid & 63, vch = tid >> 6;
  uint4 vreg = *(const uint4*)(p + (tokq + vkey) * NIN + C_SV + head * 64 + vch * 8);
  for (int kt = qt; kt >= 0; --kt) {
    LBAR();
    *(uint4*)(Ks + lrow * 144 + lch * 16) = kreg;
    { const unsigned vw[4] = {vreg.x, vreg.y, vreg.z, vreg.w};
#pragma unroll
      for (int e = 0; e < 8; ++e) *(unsigned short*)(Vt + (vch * 8 + e) * 144 + vkey * 2) = (unsigned short)((e & 1) ? (vw[e >> 1] >> 16) : (vw[e >> 1] & 0xffffu)); }
    if (tid == 0) *flag = 0;
    if (kt > 0) { const size_t tokn = (size_t)b * TSEQ + (kt - 1) * 64;
      kreg = *(const uint4*)(p + (tokn + lrow) * NIN + C_SK + head * 64 + lch * 8);
      vreg = *(const uint4*)(p + (tokn + vkey) * NIN + C_SV + head * 64 + vch * 8); }
    LBAR();
#pragma unroll
    for (int jj = 0; jj < 2; ++jj) {
      const int ki = t2 + jj;
      f32x4 acc = {0.f, 0.f, 0.f, 0.f};
#pragma unroll
      for (int s = 0; s < 2; ++s) {
        const bf16x8 a = *(const bf16x8*)(Qs + (qi * 16 + (lane & 15)) * 144 + s * 64 + (lane >> 4) * 16);
        const bf16x8 bb = *(const bf16x8*)(Ks + (ki * 16 + (lane & 15)) * 144 + s * 64 + (lane >> 4) * 16);
        acc = __builtin_amdgcn_mfma_f32_16x16x32_bf16(a, bb, acc, 0, 0, 0);
      }
#pragma unroll
      for (int r = 0; r < 4; ++r) Zs[(qi * 16 + (lane >> 4) * 4 + r) * 65 + ki * 16 + (lane & 15)] = acc[r] * 0.125f;
    }
    LBAR();
    {
      const int tq = qt * 64 + q;
      float z[8], lk[8];
      float tot = 0.f;
#pragma unroll
      for (int e = 0; e < 8; ++e) {
        z[e] = Zs[q * 65 + seg * 8 + e];
        const bool m = (kt * 64 + seg * 8 + e) < tq;
        lk[e] = m ? -softplus_fast(z[e]) : 0.f;
        tot += lk[e];
      }
      float inc = tot;
      { float t_ = __builtin_bit_cast(float, __builtin_amdgcn_update_dpp(0, __builtin_bit_cast(int, inc), 0x101, 0xF, 0xF, true)); if (seg + 1 < 8) inc += t_; }
      { float t_ = __builtin_bit_cast(float, __builtin_amdgcn_update_dpp(0, __builtin_bit_cast(int, inc), 0x102, 0xF, 0xF, true)); if (seg + 2 < 8) inc += t_; }
      { float t_ = __builtin_bit_cast(float, __builtin_amdgcn_update_dpp(0, __builtin_bit_cast(int, inc), 0x104, 0xF, 0xF, true)); if (seg + 4 < 8) inc += t_; }
      const float rowtot = red8(tot);
      float tail = carry + (inc - tot);
      float av[8];
#pragma unroll
      for (int e = 7; e >= 0; --e) {
        const bool m = (kt * 64 + seg * 8 + e) < tq;
        av[e] = m ? __expf(z[e] + lk[e] + tail) : 0.f;
        tail += lk[e];
      }
      uint4 o; o.x = pack2(av[0], av[1]); o.y = pack2(av[2], av[3]); o.z = pack2(av[4], av[5]); o.w = pack2(av[6], av[7]);
      *(uint4*)(As + q * 144 + seg * 16) = o;
      carry += rowtot;
      if (carry > -104.f) *flag = 1;
    }
    LBAR();
#pragma unroll
    for (int jj = 0; jj < 2; ++jj) {
      const int di = t2 + jj;
#pragma unroll
      for (int s = 0; s < 2; ++s) {
        const bf16x8 a = *(const bf16x8*)(As + (qi * 16 + (lane & 15)) * 144 + s * 64 + (lane >> 4) * 16);
        const bf16x8 bb = *(const bf16x8*)(Vt + (di * 16 + (lane & 15)) * 144 + s * 64 + (lane >> 4) * 16);
        oacc[jj] = __builtin_amdgcn_mfma_f32_16x16x32_bf16(a, bb, oacc[jj], 0, 0, 0);
      }
    }
    if (*flag == 0) break;
  }
#pragma unroll
  for (int jj = 0; jj < 2; ++jj) {
    const int d = (t2 + jj) * 16 + (lane & 15);
#pragma unroll
    for (int r = 0; r < 4; ++r) {
      const int qq = qi * 16 + (lane >> 4) * 4 + r;
      bf16_t* gp = p + (tokq + qq) * NIN + C_SG + head * 64 + d;
      *gp = f2bf(oacc[jj][r] * siluf_(jj == 0 ? gpre0[r] : gpre1[r]));
    }
  }
  __syncthreads();
}

__device__ __forceinline__ void xattn_item(KP P, int l, int item, unsigned char* lds, int wv_) {
  const bf16_t* qb = (const bf16_t*)(P->ws + WS_P + 32ull * MiB);
  bf16_t* ob = (bf16_t*)(P->ws + WS_P + 64ull * MiB);
  const bf16_t* kv = (const bf16_t*)(P->ws + WS_KV) + (size_t)l * 512 * 2048;
  const bf16_t* vt = (const bf16_t*)(P->ws + WS_VT) + (size_t)l * 2 * 1024 * 256;
  const int tid = opaque_tid(wv_), lane = tid & 63, w = tid >> 6;
  const int qt = item & 127, bh = item >> 7, b = bh >> 2, head = bh & 3;
  unsigned char* Qs = lds;
  unsigned char* KVs = lds + 33792;
  float* Ss = (float*)(lds + 67584);
  const size_t tok0 = (size_t)b * TSEQ + qt * 64;
  const int pr = tid >> 5, pc = tid & 31;
  uint4 pg0, pg1, pg2, pg3;
#define XA_LOAD(p_) { const bf16_t* s_ = (p_) < 4 ? kv + (size_t)(b * 256 + (p_) * 64 + pr) * 2048 + head * 256 + pc * 8 : vt + (size_t)(b * 1024 + head * 256 + ((p_) - 4) * 64 + pr) * 256 + pc * 8; \
      const size_t st_ = (p_) < 4 ? (size_t)16 * 2048 : (size_t)16 * 256; \
      pg0 = *(const uint4*)(s_); pg1 = *(const uint4*)(s_ + st_); pg2 = *(const uint4*)(s_ + 2 * st_); pg3 = *(const uint4*)(s_ + 3 * st_); }
  __syncthreads();
#pragma unroll
  for (int i = 0; i < 4; ++i) { const int r = pr + 16 * i; *(uint4*)(Qs + r * 528 + pc * 16) = *(const uint4*)(qb + (tok0 + r) * 1024 + head * 256 + pc * 8); }
  XA_LOAD(0);
  const int qi = w >> 1, t2 = (w & 1) * 2;
#pragma unroll 1
  for (int p = 0; p < 8; ++p) {
    LBAR();
    { unsigned char* d_ = KVs + pr * 528 + pc * 16; *(uint4*)d_ = pg0; *(uint4*)(d_ + 16 * 528) = pg1; *(uint4*)(d_ + 32 * 528) = pg2; *(uint4*)(d_ + 48 * 528) = pg3; }
    if (p < 7) XA_LOAD(p + 1);
    LBAR();
    f32x4 acc0 = {0.f, 0.f, 0.f, 0.f}, acc1 = {0.f, 0.f, 0.f, 0.f};
#pragma unroll
    for (int s = 0; s < 8; ++s) {
      const bf16x8 a = *(const bf16x8*)(Qs + (qi * 16 + (lane & 15)) * 528 + s * 64 + (lane >> 4) * 16);
      const bf16x8 b0 = *(const bf16x8*)(KVs + (t2 * 16 + (lane & 15)) * 528 + s * 64 + (lane >> 4) * 16);
      const bf16x8 b1 = *(const bf16x8*)(KVs + ((t2 + 1) * 16 + (lane & 15)) * 528 + s * 64 + (lane >> 4) * 16);
      acc0 = __builtin_amdgcn_mfma_f32_16x16x32_bf16(a, b0, acc0, 0, 0, 0);
      acc1 = __builtin_amdgcn_mfma_f32_16x16x32_bf16(a, b1, acc1, 0, 0, 0);
    }
    if (p < 4) {
#pragma unroll
      for (int r = 0; r < 4; ++r) { float* d_ = Ss + (qi * 16 + (lane >> 4) * 4 + r) * 260 + p * 64 + t2 * 16 + (lane & 15); d_[0] = acc0[r] * 0.0625f; d_[16] = acc1[r] * 0.0625f; }
      if (p == 3) {
        LBAR();
        const int q = tid >> 3, seg = tid & 7;
        float x[32]; float mx = -3.0e38f;
#pragma unroll
        for (int i = 0; i < 8; ++i) { const float4 v = *(const float4*)(Ss + q * 260 + seg * 32 + i * 4); x[i * 4] = v.x; x[i * 4 + 1] = v.y; x[i * 4 + 2] = v.z; x[i * 4 + 3] = v.w;
          mx = fmaxf(mx, fmaxf(fmaxf(v.x, v.y), fmaxf(v.z, v.w))); }
        mx = max8(mx);
        float sum = 0.f;
#pragma unroll
        for (int i = 0; i < 32; ++i) { x[i] = __expf(x[i] - mx); sum += x[i]; }
        sum = red8(sum);
        const float inv = __builtin_amdgcn_rcpf(sum);
#pragma unroll
        for (int i = 0; i < 4; ++i) { uint4 o; o.x = pack2(x[i * 8] * inv, x[i * 8 + 1] * inv); o.y = pack2(x[i * 8 + 2] * inv, x[i * 8 + 3] * inv);
          o.z = pack2(x[i * 8 + 4] * inv, x[i * 8 + 5] * inv); o.w = pack2(x[i * 8 + 6] * inv, x[i * 8 + 7] * inv);
          *(uint4*)(Qs + q * 528 + seg * 64 + i * 16) = o; }
      }
    } else {
#pragma unroll
      for (int r = 0; r < 4; ++r) { bf16_t* d_ = ob + (tok0 + qi * 16 + (lane >> 4) * 4 + r) * 1024 + head * 256 + (p - 4) * 64 + t2 * 16 + (lane & 15); d_[0] = f2bf(acc0[r]); d_[16] = f2bf(acc1[r]); }
    }
  }
#undef XA_LOAD
  __syncthreads();
}

__device__ __forceinline__ void wt_item(KP P, int l, int r, unsigned char* lds, int wv_) {
  const float* W; int N; bf16_t* Wt; int kt, nt; const float* gk = nullptr;
  unsigned char* wl = P->ws + WS_WT + l * WT_LAYER;
  if (r < 976) { W = P->in[3] + (size_t)l * 1024 * NIN; N = NIN; Wt = (bf16_t*)(wl + WT_IN); kt = r / 61; nt = r % 61; gk = P->in[2] + l * 1024; }
  else { r -= 976; const int m = r >> 8; r &= 255; kt = r >> 4; nt = r & 15; N = 1024;
    if (m == 0) { W = P->in[20] + (size_t)l * 1048576; Wt = (bf16_t*)(wl + WT_OUT); }
    else if (m == 1) { W = P->in[23] + (size_t)l * 1048576; Wt = (bf16_t*)(wl + WT_Q); gk = P->in[21] + l * 1024; }
    else if (m == 2) { W = P->in[24] + (size_t)l * 1048576; Wt = (bf16_t*)(wl + WT_KV); }
    else if (m == 3) { W = P->in[25] + (size_t)l * 1048576; Wt = (bf16_t*)(wl + WT_KV) + 1024 * 1024; }
    else { W = P->in[26] + (size_t)l * 1048576; Wt = (bf16_t*)(wl + WT_O); } }
  wt_tile(W, N, Wt, kt, nt, lds, wv_, gk);
}
__device__ __forceinline__ void wt_deferred(KP P, int d, unsigned char* lds, int wv_) {
  if (d < 768) { const int m = d >> 8, r = d & 255; wt_item(P, 0, 976 + (m == 0 ? 0 : m == 1 ? 256 : 1024) + r, lds, wv_); }
  else wt_item(P, 1, d - 768, lds, wv_);
}
__device__ __forceinline__ int next_item(unsigned* ctr, volatile LAS int* slot, int wv_) {
  __syncthreads();
  if (opaque_tid(wv_) == 0) *slot = (int)__hip_atomic_fetch_add(ctr, 1u, __ATOMIC_RELAXED, __HIP_MEMORY_SCOPE_AGENT);
  __syncthreads();
  return *slot;
}
__global__ void __launch_bounds__(NTHR) fwd_megakernel(Params Pk_unused) {
  KP P = (KP)__builtin_amdgcn_kernarg_segment_ptr();
  extern __shared__ __attribute__((aligned(16))) unsigned char lds[];
  const int wv_ = __builtin_amdgcn_readfirstlane((int)threadIdx.x >> 6);
  __shared__ uint4 xb_words;
  __shared__ int4 wq_slot;
  if (opaque_tid(wv_) == 0) xb_words = make_uint4(0u, 0u, 0u, 0u);
  __syncthreads();
#ifdef PROBE_J
  __shared__ unsigned long long tacc[32];
  __shared__ unsigned long long tlast;
  __shared__ float pdelta;
  if (opaque_tid(wv_) == 0) { for (int i = 0; i < 32; ++i) tacc[i] = 0ull; tlast = __builtin_amdgcn_s_memrealtime(); pdelta = 0.f; }
#define STAMP(k) if (opaque_tid(wv_) == 0) { const unsigned long long n_ = __builtin_amdgcn_s_memrealtime(); tacc[k] += n_ - tlast; tlast = n_; }
#else
#define STAMP(k)
#endif
  XcdBarrier bar = xcd_barrier_post((unsigned*)(P->ws + WS_BAR), (volatile LAS unsigned*)&xb_words, wv_);
  if (P->never) cg::this_grid().sync();
  const int G = gridDim.x, bid0 = blockIdx.x;

  for (int it = bid0; it < 976 + 512; it += G) wt_item(P, 0, it < 976 ? it : it + 512, lds, wv_);
#pragma unroll 1
  for (int k = 0; k < 3; ++k) {
    const float* s_ = k < 2 ? P->in[1] : P->in[0];
    const float* g_ = k < 2 ? P->in[22] + k * 1024 : P->in[2];
    bf16_t* d_ = k < 2 ? (bf16_t*)(P->ws + WS_MEMN) + k * 512 * 1024 : (bf16_t*)((unsigned char*)P->out + 32ull * MiB);
    norm_rows(false, s_, g_, d_, k < 2 ? 512 : NT, 0.f, wv_, k < 2 ? nullptr : (float*)(P->ws + WS_SSQ));
  }
  { float* z_ = (float*)(P->ws + WS_SSQ) + NT; for (int i = bid0 * NTHR + opaque_tid(wv_); i < 4 * NT; i += G * NTHR) z_[i] = 0.f; }
  STAMP(16 + 10); xcd_barrier(bar, wv_); STAMP(10)
  asm volatile("" : "+s"(P));

#pragma unroll 1
  for (int it = 0; it < 17; ++it) {
    int l = it >> 3, ph = it & 7;
    ph = ph < 5 ? ph : ph + 1;
    if (it == 16) { l = 1; ph = 9; }
    asm volatile("" : "+s"(P));
    int bid = bid0; asm volatile("" : "+s"(bid));

    unsigned char* ws = P->ws;
    const unsigned char* wl = ws + WS_WT + l * WT_LAYER;
    bf16_t* hbuf = (bf16_t*)((unsigned char*)P->out + 32ull * MiB);
    float* ssq = (float*)(ws + WS_SSQ);
    bf16_t* pbuf = (bf16_t*)(ws + WS_P);
    bf16_t* hx = (bf16_t*)(ws + WS_P);
    bf16_t* qbuf = (bf16_t*)(ws + WS_P + 32ull * MiB);
    bf16_t* obuf = (bf16_t*)(ws + WS_P + 64ull * MiB);
    if (ph == 0 || ph == 4 || ph == 6 || ph == 8) {
      pg8::Gemm g; pg8::TileSched S; pg8::EpiDyn E;
      g.M = NT; g.K = 1024; S.G = G; S.c = bid;
      if (ph == 0) { g.A = hbuf; g.Bt = (const bf16_t*)(wl + WT_IN); g.N = 4096; g.lda = 1024; g.ao0 = 0; g.ao1 = 256; g.ao2 = 512; g.ao3 = 768; S.nt = 1024; S.nN = 16;
        E.mode = 0; E.O = pbuf; E.ldc = NIN; E.N = NIN; E.resid = nullptr; E.out = nullptr; E.ssq_in = ssq + (l == 0 ? 0 : 2) * NT; E.xb = nullptr; E.ssq_out = nullptr; }
      else if (ph == 4) { g.A = pbuf; g.Bt = (const bf16_t*)(wl + WT_OUT); g.N = 1024; g.lda = NIN; g.ao0 = C_GA; g.ao1 = C_CGATE; g.ao2 = C_HG; g.ao3 = C_SG; S.nt = 256; S.nN = 4;
        E.mode = 1; E.O = nullptr; E.ldc = 1024; E.N = 1024; E.resid = (l == 0) ? P->in[0] : P->out; E.out = P->out; E.ssq_in = nullptr; E.xb = hbuf; E.ssq_out = ssq + (l == 0 ? 1 : 3) * NT; }
      else if (ph == 6) { g.A = hbuf; g.Bt = (const bf16_t*)(wl + WT_Q); g.N = 1024; g.lda = 1024; g.ao0 = 0; g.ao1 = 256; g.ao2 = 512; g.ao3 = 768; S.nt = 256; S.nN = 4;
        E.mode = 0; E.O = qbuf; E.ldc = 1024; E.N = 1024; E.resid = nullptr; E.out = nullptr; E.ssq_in = ssq + (l == 0 ? 1 : 3) * NT; E.xb = nullptr; E.ssq_out = nullptr; }
      else { g.A = obuf; g.Bt = (const bf16_t*)(wl + WT_O); g.N = 1024; g.lda = 1024; g.ao0 = 0; g.ao1 = 256; g.ao2 = 512; g.ao3 = 768; S.nt = 256; S.nN = 4;
        E.mode = 1; E.O = nullptr; E.ldc = 1024; E.N = 1024; E.resid = P->out; E.out = P->out; E.ssq_in = nullptr; E.xb = hbuf; E.ssq_out = ssq + (l == 0 ? 2 : 4) * NT; }
      pg8::gemm_phase<pg8::EpiDyn, pg8::TileSched, true, true>((PG8_LAS unsigned char*)lds, g, S, E, wv_);
    } else if (ph == 1) {
      if (G == 256) {
        if (bid < 128) { hgrn_wave_item<0>(P, l, bid * 8 + wv_, lds, wv_); __syncthreads(); rwkv_prep_item(P, l, bid * 3, 3, lds, wv_); }
        else rwkv_prep_item(P, l, 384 + (bid - 128) * 5, 5, lds, wv_);
      } else {
        unsigned* ctr = (unsigned*)(ws + WS_BAR) + it;
        for (;;) {
          const int i2 = next_item(ctr, (volatile LAS int*)&wq_slot, wv_);
          if (i2 >= 128 + 1024) break;
          if (i2 < 128) hgrn_wave_item<0>(P, l, i2 * 8 + wv_, lds, wv_);
          else rwkv_prep_item(P, l, i2 - 128, 1, lds, wv_);
        }
      }
    } else if (ph == 2) {
      const int n_p1 = 8 * (RW_C - 2);
      const int n_rw = n_p1 + 8;
      const int n_oth = 8 + 512 + 1024;
      for (int i2 = bid; i2 < n_rw; i2 += G) {
        if (i2 < n_p1) rwkv_scan_item<1>(P, l, i2 & 7, 1 + (i2 >> 3), lds, wv_);
        else rwkv_scan_item<0>(P, l, i2 - n_p1, 0, lds, wv_);
      }
      {
        unsigned* ctr = (unsigned*)(ws + WS_BAR) + it;
        for (;;) {
          const int i2 = next_item(ctr, (volatile LAS int*)&wq_slot, wv_);
          if (i2 >= n_oth) break;
          if (i2 < 8) hgrn_combine_item(P, i2, wv_);
          else if (i2 < 8 + 512) conv_item(P, l, i2 - 8, lds, wv_);
          else sb_item(P, i2 - 8 - 512, lds, wv_);
        }
      }
    } else if (ph == 3) {
      const int n_p3 = 8 * (RW_C - 1);
      for (int i2 = bid; i2 < n_p3; i2 += G) rwkv_scan_item<0>(P, l, i2 & 7, 1 + (i2 >> 3), lds, wv_);
      {
        unsigned* ctr = (unsigned*)(ws + WS_BAR) + it;
        for (;;) {
          const int i2 = next_item(ctr, (volatile LAS int*)&wq_slot, wv_);
          if (i2 >= 16 + 128 + (l == 0 ? 189 : 0)) break;
          if (i2 >= 16 + 128) { for (int d = (i2 - 144) * 16; d < (i2 - 144) * 16 + 16; ++d) wt_deferred(P, d, lds, wv_); }
          else if (i2 < 16) gemm_tile<2>((const bf16_t*)(ws + WS_MEMN) + (size_t)l * 512 * 1024, 1024, 0, 256, 512, 768, (const bf16_t*)(wl + WT_KV), (i2 >> 3) * 256, (i2 & 7) * 256, 2048,
                                    (bf16_t*)(ws + WS_KV) + (size_t)l * 512 * 2048, (const float*)((bf16_t*)(ws + WS_VT) + (size_t)l * 2 * 1024 * 256), 2048, lds, wv_);
          else hgrn_wave_item<1>(P, l, (i2 - 16) * 8 + wv_, lds, wv_);
        }
      }
    } else if (ph == 7) {
      for (int i2 = bid * 4; i2 < 1024; i2 += G * 4) { for (int k2 = 0; k2 < 4; ++k2) xattn_item(P, l, i2 + k2, lds, wv_); }
    } else {
      const float* ssqf = ssq + 4 * NT;
      const float* gf = P->in[27];
      float* outp = P->out;
      const int tid = opaque_tid(wv_), lane = tid & 63, w = tid >> 6;
      float4 gv[4];
#pragma unroll
      for (int i = 0; i < 4; ++i) gv[i] = *(const float4*)(gf + lane * 16 + i * 4);
      const int rpb = (8192 + G - 1) / G;
      for (int c = tid; c < rpb * 128; c += NTHR) { const int j = c >> 7, ch = c & 127; const int row = 8192 + bid * rpb + j;
        if (row < NT) *(uint4*)(lds + (size_t)j * 2048 + ch * 16) = *(const uint4*)(hbuf + (size_t)row * 1024 + ch * 8); }
      for (int row = bid * 8 + w; row < 8192; row += G * 8) {
        const uint4 a = *(const uint4*)(hbuf + (size_t)row * 1024 + lane * 16), b2 = *(const uint4*)(hbuf + (size_t)row * 1024 + lane * 16 + 8);
        const float rs = __builtin_amdgcn_rsqf(ssqf[row] * (1.0f / 1024.0f) + 1e-6f);
        float* o_ = outp + (size_t)row * 1024 + lane * 16;
        *(float4*)(o_) = make_float4(__uint_as_float(a.x << 16) * rs * gv[0].x, __uint_as_float(a.x & 0xffff0000u) * rs * gv[0].y, __uint_as_float(a.y << 16) * rs * gv[0].z, __uint_as_float(a.y & 0xffff0000u) * rs * gv[0].w);
        *(float4*)(o_ + 4) = make_float4(__uint_as_float(a.z << 16) * rs * gv[1].x, __uint_as_float(a.z & 0xffff0000u) * rs * gv[1].y, __uint_as_float(a.w << 16) * rs * gv[1].z, __uint_as_float(a.w & 0xffff0000u) * rs * gv[1].w);
        *(float4*)(o_ + 8) = make_float4(__uint_as_float(b2.x << 16) * rs * gv[2].x, __uint_as_float(b2.x & 0xffff0000u) * rs * gv[2].y, __uint_as_float(b2.y << 16) * rs * gv[2].z, __uint_as_float(b2.y & 0xffff0000u) * rs * gv[2].w);
        *(float4*)(o_ + 12) = make_float4(__uint_as_float(b2.z << 16) * rs * gv[3].x, __uint_as_float(b2.z & 0xffff0000u) * rs * gv[3].y, __uint_as_float(b2.w << 16) * rs * gv[3].z, __uint_as_float(b2.w & 0xffff0000u) * rs * gv[3].w);
      }
      xcd_barrier(bar, wv_);
      for (int j = w; j < rpb; j += 8) { const int row = 8192 + bid * rpb + j;
        if (row < NT) {
          const uint4 a = *(const uint4*)(lds + (size_t)j * 2048 + lane * 32), b2 = *(const uint4*)(lds + (size_t)j * 2048 + lane * 32 + 16);
          const float rs = __builtin_amdgcn_rsqf(ssqf[row] * (1.0f / 1024.0f) + 1e-6f);
          float* o_ = outp + (size_t)row * 1024 + lane * 16;
          *(float4*)(o_) = make_float4(__uint_as_float(a.x << 16) * rs * gv[0].x, __uint_as_float(a.x & 0xffff0000u) * rs * gv[0].y, __uint_as_float(a.y << 16) * rs * gv[0].z, __uint_as_float(a.y & 0xffff0000u) * rs * gv[0].w);
          *(float4*)(o_ + 4) = make_float4(__uint_as_float(a.z << 16) * rs * gv[1].x, __uint_as_float(a.z & 0xffff0000u) * rs * gv[1].y, __uint_as_float(a.w << 16) * rs * gv[1].z, __uint_as_float(a.w & 0xffff0000u) * rs * gv[1].w);
          *(float4*)(o_ + 8) = make_float4(__uint_as_float(b2.x << 16) * rs * gv[2].x, __uint_as_float(b2.x & 0xffff0000u) * rs * gv[2].y, __uint_as_float(b2.y << 16) * rs * gv[2].z, __uint_as_float(b2.y & 0xffff0000u) * rs * gv[2].w);
          *(float4*)(o_ + 12) = make_float4(__uint_as_float(b2.z << 16) * rs * gv[3].x, __uint_as_float(b2.z & 0xffff0000u) * rs * gv[3].y, __uint_as_float(b2.w << 16) * rs * gv[3].z, __uint_as_float(b2.w & 0xffff0000u) * rs * gv[3].w);
        }
      }
    }
    if (it < 16) { STAMP(16 + ph); xcd_barrier(bar, wv_); STAMP(ph) }
  }
#ifdef PROBE_J
  if (bid0 == PROBE_B && opaque_tid(wv_) == 0) {
    const unsigned long long t0_ = __builtin_amdgcn_s_memrealtime();
    const unsigned long long w_ = 4ull * (PROBE_K < 32 ? tacc[PROBE_K & 31] : tacc[PROBE_K - 32] + tacc[PROBE_K - 16]);
    while (__builtin_amdgcn_s_memrealtime() - t0_ < w_) __builtin_amdgcn_s_sleep(8);
  }
#endif
}

extern "C" void kernel_launch(void* const* d_in, const int* in_sizes, int n_in, void* d_out, int out_size, void* d_ws, size_t ws_size, hipStream_t stream) {
  constexpr size_t kDynLds = 147456;
  static int grid_blocks = 0;
  if (!grid_blocks) {
    int dev = 0, cus = 0, per_cu = 0;
    hipGetDevice(&dev);
    hipDeviceGetAttribute(&cus, hipDeviceAttributeMultiprocessorCount, dev);
    hipFuncSetAttribute((const void*)fwd_megakernel, hipFuncAttributeMaxDynamicSharedMemorySize, (int)kDynLds);
    hipOccupancyMaxActiveBlocksPerMultiprocessor(&per_cu, fwd_megakernel, NTHR, kDynLds);
    if (per_cu < 1) per_cu = 1;
    if (per_cu > 1) per_cu = 1;
    grid_blocks = cus * per_cu;
    if (grid_blocks > 256) grid_blocks = 256;
  }
  Params p;
  memset(&p, 0, sizeof(p));
  for (int i = 0; i < 28; ++i) p.in[i] = (const float*)d_in[i];
  p.out = (float*)d_out; p.ws = (unsigned char*)d_ws; p.never = 0; p.pad = 0;
  hipMemsetAsync(d_ws, 0, XCD_BAR_WORDS * 4, stream);
  void* args[] = {&p};
  hipError_t e = hipLaunchCooperativeKernel((void*)fwd_megakernel, dim3(grid_blocks), dim3(NTHR), args, kDynLds, stream);
  if (e != hipSuccess) fprintf(stderr, "cooperative launch failed: %s (grid %d)\n", hipGetErrorString(e), grid_blocks);
}
```
